# Optimizing an MI355X kernel written in HIP

```python
import jax, jax.numpy as jnp
from jax import lax
import numpy as np

D_MODEL = 1024
BATCH = 2
SEQ = 16384
DEPTH = 4

HEAD_DIM = 64
ROT_DIM = HEAD_DIM // 4
ROPE_THETA = 500000.0
A_HEADS = D_MODEL // HEAD_DIM
A_KV_HEADS = 4
A_GROUP = A_HEADS // A_KV_HEADS
CMP_BLOCK = 32
CMP_STRIDE = 16
CMP_HID = 256
SLC_BLOCK = 64
N_SEL = 16
NSA_WIN = 512
Q_BLOCK = 128
A_Q = A_HEADS * HEAD_DIM
A_KV = A_KV_HEADS * HEAD_DIM
A_SPLITS = tuple(A_Q + i * A_KV for i in range(7))
A_IN = A_Q + 6 * A_KV + 3 * A_HEADS
B_HEADS = D_MODEL // HEAD_DIM
B_KV_HEADS = 2
B_GROUP = B_HEADS // B_KV_HEADS
SWA_WIN = 128
SWA_BLOCK = 128
B_Q = B_HEADS * HEAD_DIM
B_KV = B_KV_HEADS * HEAD_DIM
D_FF = 2816
N_EXPERTS = 8
TOP_K = 2
D_FF_EXPERT = 3584
MOE_BLOCK = 128
N_A_LAYERS = DEPTH // 2
N_B_LAYERS = DEPTH - N_A_LAYERS
N_DENSE = (DEPTH + 1) // 2
N_MOE = DEPTH // 2
ALPHA = (2 * DEPTH) ** 0.25
BETA = (8 * DEPTH) ** -0.25
LN_EPS = 1e-5
NEG = -1e30
FORCE = 1e9

kernel_name = "yoco_nsa_swa_sink_moe_deepnorm"


def layer_norm(x, g, b):
    xf = x.astype(jnp.float32)
    mu = xf.mean(-1, keepdims=True)
    var = jnp.square(xf - mu).mean(-1, keepdims=True)
    return ((xf - mu) * lax.rsqrt(var + LN_EPS) * g + b).astype(x.dtype)


def rope_tables(positions):
    inv = ROPE_THETA ** (-jnp.arange(0, ROT_DIM, 2, dtype=jnp.float32) / ROT_DIM)
    ang = positions.astype(jnp.float32)[..., None] * inv
    return jnp.cos(ang), jnp.sin(ang)


def apply_partial_rope(x, cos, sin):
    xr = x[..., :ROT_DIM].astype(jnp.float32)
    x1, x2 = xr[..., :ROT_DIM // 2], xr[..., ROT_DIM // 2:]
    c, s = cos[:, :, None, :], sin[:, :, None, :]
    rot = jnp.concatenate([x1 * c - x2 * s, x2 * c + x1 * s], axis=-1)
    return jnp.concatenate([rot.astype(x.dtype), x[..., ROT_DIM:]], axis=-1)


def masked_softmax(s, mask):
    p = jax.nn.softmax(jnp.where(mask, s, NEG), axis=-1)
    return jnp.where(mask, p, 0.0)


gather_blocks = jax.vmap(jax.vmap(lambda blocks, ix: blocks[ix]))


def compress_blocks(t, pos, w1, w2):
    bsz, seq, g, dh = t.shape
    r = CMP_BLOCK // CMP_STRIDE
    chunks = t.reshape(bsz, seq // CMP_STRIDE, CMP_STRIDE, g, dh)
    n_cmp = seq // CMP_STRIDE - r + 1
    blocks = jnp.concatenate([chunks[:, i:i + n_cmp] for i in range(r)], axis=2)
    blocks = blocks + pos[:, None, :]
    flat = blocks.transpose(0, 1, 3, 2, 4).reshape(bsz, n_cmp, g, CMP_BLOCK * dh)
    return (jax.nn.gelu(flat @ w1) @ w2).transpose(0, 2, 1, 3)


def nsa_mixer(h, cos, sin, w_in, w_out, cmp_pos, cmp_w1, cmp_w2):
    bsz, seq, _ = h.shape
    G, R, dh = A_KV_HEADS, A_GROUP, HEAD_DIM
    q, kc, vc, ks, vs, kw, vw, gl = jnp.split(h @ w_in, A_SPLITS, axis=-1)
    q = q.reshape(bsz, seq, A_HEADS, dh)
    kc, vc, ks, vs, kw, vw = (t.reshape(bsz, seq, G, dh) for t in (kc, vc, ks, vs, kw, vw))
    q_rot = apply_partial_rope(q, cos, sin)
    ks = apply_partial_rope(ks, cos, sin)
    kw = apply_partial_rope(kw, cos, sin)
    kc = compress_blocks(kc, cmp_pos[0], cmp_w1[0], cmp_w2[0])
    vc = compress_blocks(vc, cmp_pos[1], cmp_w1[1], cmp_w2[1])
    n_cmp = kc.shape[2]
    n_slc = seq // SLC_BLOCK
    n_sel = min(N_SEL, n_slc)

    def to_heads(t):
        return t.reshape(bsz, seq, G, R, dh).transpose(0, 2, 3, 1, 4)

    def to_blocks(t):
        return t.reshape(bsz, n_slc, SLC_BLOCK, G, dh).transpose(0, 3, 1, 2, 4)

    def to_window(t):
        return jnp.pad(t.transpose(0, 2, 1, 3), ((0, 0), (0, 0), (NSA_WIN, 0), (0, 0)))

    qg, qg_rot = to_heads(q), to_heads(q_rot)
    ks_b, vs_b = to_blocks(ks), to_blocks(vs)
    kw_p, vw_p = to_window(kw), to_window(vw)
    gates = jax.nn.sigmoid(gl.astype(jnp.float32)).reshape(bsz, seq, 3, G, R).transpose(0, 3, 4, 1, 2)
    cmp_end = jnp.arange(n_cmp) * CMP_STRIDE + CMP_BLOCK - 1
    n_idx = jnp.arange(n_cmp)[:, None]
    j_idx = jnp.arange(n_slc)[None, :]
    overlap = (jnp.minimum(n_idx * CMP_STRIDE + CMP_BLOCK, j_idx * SLC_BLOCK + SLC_BLOCK)
               - jnp.maximum(n_idx * CMP_STRIDE, j_idx * SLC_BLOCK))
    cmp_to_slc = jnp.clip(overlap, 0).astype(jnp.float32) / CMP_BLOCK
    jj = jnp.arange(n_slc)
    scale = dh ** -0.5

    def query_block(i):
        q0 = i * Q_BLOCK
        t = q0 + jnp.arange(Q_BLOCK)
        qb = lax.dynamic_slice_in_dim(qg, q0, Q_BLOCK, axis=3)
        qbr = lax.dynamic_slice_in_dim(qg_rot, q0, Q_BLOCK, axis=3)
        gb = lax.dynamic_slice_in_dim(gates, q0, Q_BLOCK, axis=3)
        s_c = jnp.einsum('bgrtd,bgnd->bgrtn', qb, kc).astype(jnp.float32) * scale
        p_c = masked_softmax(s_c, cmp_end[None, :] <= t[:, None])
        o_c = jnp.einsum('bgrtn,bgnd->bgrtd', p_c.astype(vc.dtype), vc)
        imp = jnp.einsum('bgtn,nj->bgtj', p_c.sum(2), cmp_to_slc)
        cur = t // SLC_BLOCK
        forced = (jj[None, :] == 0) | (jj[None, :] == cur[:, None]) | (jj[None, :] == cur[:, None] - 1)
        score = jnp.where(jj[None, :] > cur[:, None], -1.0, jnp.where(forced, FORCE, imp))
        _, idx = lax.top_k(score, n_sel)
        k_sel = gather_blocks(ks_b, idx).reshape(bsz, G, Q_BLOCK, n_sel * SLC_BLOCK, dh)
        v_sel = gather_blocks(vs_b, idx).reshape(bsz, G, Q_BLOCK, n_sel * SLC_BLOCK, dh)
        sel_pos = (idx[..., None] * SLC_BLOCK + jnp.arange(SLC_BLOCK)).reshape(bsz, G, Q_BLOCK, -1)
        m_s = (sel_pos <= t[:, None])[:, :, None]
        s_s = jnp.einsum('bgrtd,bgtkd->bgrtk', qbr, k_sel).astype(jnp.float32) * scale
        p_s = masked_softmax(s_s, m_s)
        o_s = jnp.einsum('bgrtk,bgtkd->bgrtd', p_s.astype(v_sel.dtype), v_sel)
        kwb = lax.dynamic_slice_in_dim(kw_p, q0, Q_BLOCK + NSA_WIN, axis=2)
        vwb = lax.dynamic_slice_in_dim(vw_p, q0, Q_BLOCK + NSA_WIN, axis=2)
        spos = q0 - NSA_WIN + jnp.arange(Q_BLOCK + NSA_WIN)
        diff = t[:, None] - spos[None, :]
        m_w = (diff >= 0) & (diff < NSA_WIN) & (spos[None, :] >= 0)
        s_w = jnp.einsum('bgrtd,bgkd->bgrtk', qbr, kwb).astype(jnp.float32) * scale
        p_w = masked_softmax(s_w, m_w)
        o_w = jnp.einsum('bgrtk,bgkd->bgrtd', p_w.astype(vwb.dtype), vwb)
        o = gb[..., 0:1] * o_c + gb[..., 1:2] * o_s + gb[..., 2:3] * o_w
        return o.astype(h.dtype)

    out = lax.map(query_block, jnp.arange(seq // Q_BLOCK))
    out = out.transpose(1, 0, 4, 2, 3, 5).reshape(bsz, seq, A_Q)
    return out @ w_out


def shared_kv(h, cos, sin, w_kv):
    bsz, seq, _ = h.shape
    nb = seq // SWA_BLOCK
    kv = h @ w_kv
    k = apply_partial_rope(kv[..., :B_KV].reshape(bsz, seq, B_KV_HEADS, HEAD_DIM), cos, sin)
    v = kv[..., B_KV:].reshape(bsz, seq, B_KV_HEADS, HEAD_DIM)

    def band(t):
        tb = t.reshape(bsz, nb, SWA_BLOCK, B_KV_HEADS, HEAD_DIM)
        prev = jnp.concatenate([jnp.zeros_like(tb[:, :1]), tb[:, :-1]], axis=1)
        return jnp.concatenate([prev, tb], axis=2).transpose(1, 0, 2, 3, 4)

    return band(k), band(v)


def swa_sink_mixer(h, cos, sin, k_band, v_band, w_q, w_out, sinks):
    bsz, seq, _ = h.shape
    G, R, dh = B_KV_HEADS, B_GROUP, HEAD_DIM
    nb = seq // SWA_BLOCK
    q = apply_partial_rope((h @ w_q).reshape(bsz, seq, B_HEADS, dh), cos, sin)
    q = q.reshape(bsz, nb, SWA_BLOCK, G, R, dh).transpose(1, 0, 2, 3, 4, 5)
    sink = sinks.astype(jnp.float32).reshape(1, G, R, 1, 1)
    ii = jnp.arange(SWA_BLOCK)[:, None]
    jj = jnp.arange(2 * SWA_BLOCK)[None, :]
    diff = SWA_BLOCK + ii - jj
    band = (diff >= 0) & (diff < SWA_WIN)
    scale = dh ** -0.5

    def block(args):
        qb, kb, vb, n = args
        s = jnp.einsum('bigrd,bjgd->bgrij', qb, kb).astype(jnp.float32) * scale
        mask = band & ((n > 0) | (jj >= SWA_BLOCK))
        s = jnp.where(mask, s, NEG)
        m = jnp.maximum(s.max(-1, keepdims=True), sink)
        e = jnp.exp(s - m)
        p = e / (e.sum(-1, keepdims=True) + jnp.exp(sink - m))
        return jnp.einsum('bgrij,bjgd->bigrd', p.astype(vb.dtype), vb)

    out = lax.map(block, (q, k_band, v_band, jnp.arange(nb)))
    out = out.transpose(1, 0, 2, 3, 4, 5).reshape(bsz, seq, B_Q)
    return out @ w_out


def dense_swiglu(h, w_in, w_out):
    g, u = jnp.split(h @ w_in, 2, axis=-1)
    return (jax.nn.silu(g) * u) @ w_out


def moe_swiglu(h, w_router, w_in, w_out):
    bsz, seq, d = h.shape
    n_tok = bsz * seq
    n_asg = n_tok * TOP_K
    xt = h.reshape(n_tok, d)
    logits = (xt @ w_router).astype(jnp.float32)
    top_logit, top_e = lax.top_k(logits, TOP_K)
    gate = jax.nn.softmax(top_logit, axis=-1)
    e_flat = top_e.reshape(-1)
    tok_flat = jnp.repeat(jnp.arange(n_tok, dtype=jnp.int32), TOP_K)
    order = jnp.argsort(e_flat)
    e_s, tok_s, g_s = e_flat[order], tok_flat[order], gate.reshape(-1)[order]
    counts = jnp.bincount(e_flat, length=N_EXPERTS)
    padded = (counts + MOE_BLOCK - 1) // MOE_BLOCK * MOE_BLOCK
    start = jnp.cumsum(counts) - counts
    pad_end = jnp.cumsum(padded)
    pad_start = pad_end - padded
    dest = pad_start[e_s] + jnp.arange(n_asg) - start[e_s]
    cap = n_asg + N_EXPERTS * MOE_BLOCK
    cap = (cap + MOE_BLOCK - 1) // MOE_BLOCK * MOE_BLOCK
    n_blk = cap // MOE_BLOCK
    buf_tok = jnp.zeros((cap,), jnp.int32).at[dest].set(tok_s)
    buf_w = jnp.zeros((cap,), jnp.float32).at[dest].set(g_s)
    blk_e = jnp.clip(jnp.searchsorted(pad_end, jnp.arange(n_blk) * MOE_BLOCK, side='right'), 0, N_EXPERTS - 1)
    xb = xt[buf_tok].reshape(n_blk, MOE_BLOCK, d)

    def expert_block(args):
        xblk, e = args
        g, u = jnp.split(xblk @ w_in[e], 2, axis=-1)
        return (jax.nn.silu(g) * u) @ w_out[e]

    yb = lax.map(expert_block, (xb, blk_e)).reshape(cap, d)
    yb = (yb.astype(jnp.float32) * buf_w[:, None]).astype(h.dtype)
    out = jnp.zeros((n_tok, d), h.dtype).at[buf_tok].add(yb)
    return out.reshape(bsz, seq, d)


def setup_inputs(seed: int = 0) -> dict:
    key = jax.random.key(seed)
    ks = jax.random.split(key, 20)
    f32 = jnp.float32
    nrm = lambda k, shape, s: jax.random.normal(k, shape, f32) * s
    return {
        "x": nrm(ks[0], (BATCH, SEQ, D_MODEL), 1.0),
        "positions": jnp.arange(SEQ, dtype=jnp.int32)[None, :] + jax.random.randint(ks[1], (BATCH, 1), 0, 4096, dtype=jnp.int32),
        "w_in_a": nrm(ks[2], (N_A_LAYERS, D_MODEL, A_IN), D_MODEL ** -0.5),
        "w_out_a": nrm(ks[3], (N_A_LAYERS, A_Q, D_MODEL), BETA * A_Q ** -0.5),
        "cmp_pos": nrm(ks[4], (N_A_LAYERS, 2, CMP_BLOCK, HEAD_DIM), 0.1),
        "cmp_w1": nrm(ks[5], (N_A_LAYERS, 2, CMP_BLOCK * HEAD_DIM, CMP_HID), (CMP_BLOCK * HEAD_DIM) ** -0.5),
        "cmp_w2": nrm(ks[6], (N_A_LAYERS, 2, CMP_HID, HEAD_DIM), CMP_HID ** -0.5),
        "w_kv_shared": nrm(ks[7], (D_MODEL, 2 * B_KV), D_MODEL ** -0.5),
        "w_q_b": nrm(ks[8], (N_B_LAYERS, D_MODEL, B_Q), D_MODEL ** -0.5),
        "w_out_b": nrm(ks[9], (N_B_LAYERS, B_Q, D_MODEL), BETA * B_Q ** -0.5),
        "sinks_b": nrm(ks[10], (N_B_LAYERS, B_HEADS), 0.5),
        "ln_g": 1.0 + nrm(ks[11], (DEPTH, 2, D_MODEL), 0.02),
        "ln_b": nrm(ks[12], (DEPTH, 2, D_MODEL), 0.02),
        "dense_w_in": nrm(ks[13], (N_DENSE, D_MODEL, 2 * D_FF), D_MODEL ** -0.5),
        "dense_w_out": nrm(ks[14], (N_DENSE, D_FF, D_MODEL), BETA * D_FF ** -0.5),
        "moe_router": nrm(ks[15], (N_MOE, D_MODEL, N_EXPERTS), D_MODEL ** -0.5),
        "moe_w_in": nrm(ks[16], (N_MOE, N_EXPERTS, D_MODEL, 2 * D_FF_EXPERT), D_MODEL ** -0.5),
        "moe_w_out": nrm(ks[17], (N_MOE, N_EXPERTS, D_FF_EXPERT, D_MODEL), BETA * D_FF_EXPERT ** -0.5),
    }


def reference(x, positions, w_in_a, w_out_a, cmp_pos, cmp_w1, cmp_w2, w_kv_shared, w_q_b, w_out_b,
              sinks_b, ln_g, ln_b, dense_w_in, dense_w_out, moe_router, moe_w_in, moe_w_out):
    cos, sin = rope_tables(positions)
    h = x
    k_band = v_band = None
    for l in range(DEPTH):
        if l < N_A_LAYERS:
            mix = nsa_mixer(h, cos, sin, w_in_a[l], w_out_a[l], cmp_pos[l], cmp_w1[l], cmp_w2[l])
        else:
            b = l - N_A_LAYERS
            mix = swa_sink_mixer(h, cos, sin, k_band, v_band, w_q_b[b], w_out_b[b], sinks_b[b])
        h = layer_norm(ALPHA * h + mix, ln_g[l, 0], ln_b[l, 0])
        if l % 2 == 0:
            ffn = dense_swiglu(h, dense_w_in[l // 2], dense_w_out[l // 2])
        else:
            ffn = moe_swiglu(h, moe_router[l // 2], moe_w_in[l // 2], moe_w_out[l // 2])
        h = layer_norm(ALPHA * h + ffn, ln_g[l, 1], ln_b[l, 1])
        if l == N_A_LAYERS - 1:
            k_band, v_band = shared_kv(h, cos, sin, w_kv_shared)
    return h
```

```cpp
#include <hip/hip_runtime.h>
#include <hip/hip_cooperative_groups.h>
#include <cstdio>
#include <cstdint>
namespace cg = cooperative_groups;

#ifndef DBG_DROP
#define DBG_DROP 0
#endif
#ifndef NAIVE_NSA
#define NAIVE_NSA 0
#endif
#ifndef NAIVE_SWA
#define NAIVE_SWA 0
#endif
#ifndef MK_SINGLE
#define MK_SINGLE 1
#endif

#define DEVI __device__ __forceinline__
#define LAS __attribute__((address_space(3)))
#define GAS __attribute__((address_space(1)))
typedef unsigned short bf16_t;
typedef short bf16x8 __attribute__((ext_vector_type(8)));
typedef float f32x4 __attribute__((ext_vector_type(4)));
typedef float f32x2 __attribute__((ext_vector_type(2)));
typedef unsigned u32x4 __attribute__((ext_vector_type(4)));
typedef unsigned u32x2 __attribute__((ext_vector_type(2)));

constexpr int BATCH = 2, SEQ = 16384, MTOK = BATCH * SEQ, DM = 1024, DEPTH = 4;
constexpr int HD = 64;
constexpr int A_G = 4, A_R = 4, A_IN = 2608, A_INP = 2816;
constexpr int NCMP = 1023, CMP_HID = 256;
constexpr int NSLC = SEQ / 64, NSEL = 16, NSA_WIN = 512;
constexpr int B_G = 2, B_R = 8, SWA_WIN = 128;
constexpr int DFF = 2816, NEXP = 8, DFFE = 3584;
constexpr int CAP = MTOK * 2 + NEXP * 256;
constexpr float ALPHA = 1.6817928305074292f;
constexpr float LN_EPS = 1e-5f;
constexpr float QSCALE = 0.125f;

constexpr size_t al256(size_t x) { return (x + 255) & ~(size_t)255; }
constexpr size_t WS_CTL = 0, CTL_BYTES = 1u << 20;
constexpr size_t WS_WINA = CTL_BYTES;
constexpr size_t WS_WOUTA = WS_WINA + (size_t)2 * A_INP * DM * 2;
constexpr size_t WS_WC1 = WS_WOUTA + (size_t)2 * DM * DM * 2;
constexpr size_t WS_WC2 = WS_WC1 + (size_t)4 * 256 * 2048 * 2;
constexpr size_t WS_WQKV2 = WS_WC2 + (size_t)4 * 256 * 256 * 2;
constexpr size_t WS_WQB1 = WS_WQKV2 + (size_t)1280 * DM * 2;
constexpr size_t WS_WOUTB = WS_WQB1 + (size_t)DM * DM * 2;
constexpr size_t WS_WDIN = WS_WOUTB + (size_t)2 * DM * DM * 2;
constexpr size_t WS_WDOUT = WS_WDIN + (size_t)2 * 2 * DFF * DM * 2;
constexpr size_t WS_WMIN = WS_WDOUT + (size_t)2 * DM * DFF * 2;
constexpr size_t WS_WMOUT = WS_WMIN + (size_t)16 * 2 * DFFE * DM * 2;
constexpr size_t WS_WEND = WS_WMOUT + (size_t)16 * DM * DFFE * 2;
constexpr size_t WS_H = al256(WS_WEND);
constexpr size_t WS_Y = WS_H + (size_t)MTOK * DM * 4;
constexpr size_t WS_HB = WS_Y + (size_t)MTOK * DM * 4;
constexpr size_t WS_CS = WS_HB + (size_t)MTOK * DM * 2;
constexpr size_t WS_KSH = WS_CS + (size_t)MTOK * 16 * 4;
constexpr size_t WS_VSH = WS_KSH + (size_t)MTOK * 128 * 2;
constexpr size_t WS_ROUTE = WS_VSH + (size_t)MTOK * 128 * 2;
constexpr size_t WS_XB = WS_ROUTE + (size_t)MTOK * 2 * 4 * 4;
constexpr size_t WS_ACT = WS_XB + (size_t)CAP * DM * 2;
constexpr size_t WS_RA = WS_ACT + (size_t)CAP * DFFE * 2;
constexpr size_t SLAB = (size_t)MTOK * 256 * 2;
constexpr size_t RA_Q = WS_RA;
constexpr size_t RA_ATT = RA_Q + (size_t)MTOK * DM * 2;
constexpr size_t RA_KCR = RA_ATT + (size_t)MTOK * DM * 2;
constexpr size_t RA_VCR = RA_KCR + SLAB + 4096;
constexpr size_t RA_KS = RA_VCR + SLAB + 4096;
constexpr size_t RA_VS = RA_KS + SLAB;
constexpr size_t RA_KW = RA_VS + SLAB;
constexpr size_t RA_VW = RA_KW + SLAB;
constexpr size_t RA_GATE = RA_VW + SLAB;
constexpr size_t RA_KC = RA_GATE + (size_t)MTOK * 48 * 4;
constexpr size_t RA_VC = RA_KC + (size_t)8192 * 64 * 2;
constexpr size_t RA_CH = RA_VC + (size_t)8192 * 64 * 2;
constexpr size_t RA_VST = RA_CH + (size_t)2 * 8192 * 256 * 2;
constexpr size_t RA_END = RA_VST + SLAB;
constexpr size_t WS_YB = WS_RA;
constexpr size_t YB_END = WS_YB + (size_t)CAP * DM * 4;
constexpr size_t WS_END = (RA_END > YB_END ? RA_END : YB_END);
static_assert(WS_END < (size_t)1879048192, "workspace map exceeds 4x the largest tensor");

constexpr int CW_BAR = 4096;
constexpr int CW_MOE = 16384;
constexpr int CW_WGCNT = 45056;
constexpr int CW_VMAX = 40000;
constexpr int CW_BIASP = 32768;

constexpr int RING_BYTES = 131072;
constexpr int LDS_X = RING_BYTES;
constexpr int MISC_OFF = RING_BYTES + 16384;
constexpr int LDS_BYTES = MISC_OFF + 1024;

DEVI unsigned f2bf(float f) { unsigned u = __builtin_bit_cast(unsigned, f); return (u + 0x7fffu + ((u >> 16) & 1u)) >> 16; }
DEVI unsigned pk2(float lo, float hi) { return f2bf(lo) | (f2bf(hi) << 16); }
DEVI float bf2f(unsigned h) { return __builtin_bit_cast(float, h << 16); }
DEVI float bflo(unsigned w) { return __builtin_bit_cast(float, w << 16); }
DEVI float bfhi(unsigned w) { return __builtin_bit_cast(float, w & 0xffff0000u); }
DEVI float shx(float v, int mask, int lane) { return __builtin_bit_cast(float, __builtin_amdgcn_ds_bpermute((lane ^ mask) << 2, __builtin_bit_cast(int, v))); }
DEVI int shxi(int v, int mask, int lane) { return __builtin_amdgcn_ds_bpermute((lane ^ mask) << 2, v); }
DEVI float wave_sum(float v, int lane) {
#pragma unroll
    for (int o = 1; o < 64; o <<= 1) v += shx(v, o, lane);
    return v;
}
DEVI float wave_max(float v, int lane) {
#pragma unroll
    for (int o = 1; o < 64; o <<= 1) v = fmaxf(v, shx(v, o, lane));
    return v;
}
DEVI int wave_id_sgpr() { return __builtin_amdgcn_readfirstlane((int)threadIdx.x >> 6); }
DEVI int opaque_tid(int wave) { asm volatile("" : "+s"(wave)); int l; asm volatile("v_mbcnt_lo_u32_b32 %0, -1, 0\n\tv_mbcnt_hi_u32_b32 %0, -1, %0" : "=v"(l)); return wave * 64 + l; }
#define LDS_WAIT() asm volatile("s_waitcnt lgkmcnt(0)" ::: "memory")
#define VM_WAIT() asm volatile("s_waitcnt vmcnt(0)" ::: "memory")

namespace pg8 {
constexpr int BM = 256, BK = 64, HALF = 128, HTB = HALF * BK * 2, STAGE_BYTES = 8 * HTB, NXCD = 8, WGM = 8;
DEVI int lds_byte(int r, int c) { const int st = (r >> 4) * 2 + (c >> 5), rr = r & 15, cc = c & 31, ob = rr * 64 + cc * 2; return st * 1024 + (ob ^ (((ob >> 9) & 1) << 5)); }
DEVI void stage_rc(int b, int& R, int& C) { const int st = b / 1024, sb = b % 1024, swz = sb ^ (((sb >> 9) & 1) << 5); R = (st >> 1) * 16 + swz / 64; C = (st & 1) * 32 + (swz % 64) / 2; }
DEVI int perm32(int rho) { const int n = rho >> 4, i = rho & 15; return 8 * (i >> 2) + 4 * n + (i & 3); }

struct Unit { int pm, pn; const bf16_t* bt; int koff, z; };
struct Gemm { const bf16_t* A; int lda; int K; int ldb; };

struct StaticOrder {
    int nM, nN, nwg, G, c; const bf16_t* bt;
    DEVI void init(int nM_, int nN_, int G_, int c_, const bf16_t* bt_) { nM = nM_; nN = nN_; nwg = nM * nN; G = G_; c = c_; bt = bt_; }
    DEVI bool tile(int i, int& pm, int& pn) const {
        const long L = (long)i * G + c; if (L >= nwg) return false;
        int wgid = (int)L; { const int q = nwg / NXCD, r = nwg % NXCD, xcd = wgid % NXCD, off = wgid / NXCD; wgid = (xcd < r ? xcd * (q + 1) : r * (q + 1) + (xcd - r) * q) + off; }
        const int nig = WGM * nN, gid = wgid / nig, fm = gid * WGM, gsz = (nM - fm) < WGM ? (nM - fm) : WGM;
        pm = fm + ((wgid % nig) % gsz); pn = (wgid % nig) / gsz; return true;
    }
    DEVI bool next(int i, Unit& u) const { if (!tile(i, u.pm, u.pn)) return false; u.bt = bt; u.koff = 0; u.z = 0; return true; }
};
struct GroupedOrder : StaticOrder {
    int t1, t2, t3, t4, t5, t6, t7; size_t estride;
    DEVI bool next(int i, Unit& u) const {
        if (!tile(i, u.pm, u.pn)) return false;
        const int tm = u.pm; const int e = (tm >= t1) + (tm >= t2) + (tm >= t3) + (tm >= t4) + (tm >= t5) + (tm >= t6) + (tm >= t7);
        u.bt = bt + (size_t)e * estride; u.koff = 0; u.z = 0; return true;
    }
};
struct SliceOrder {
    int nsl, G, c, kq; const bf16_t* bt; int t1, t2, t3, t4, t5, t6, t7; size_t estride;
    DEVI bool next(int i, Unit& u) const {
        const int L = i * G + c; if (L >= nsl) return false;
        u.pm = 256 + (L >> 4); u.pn = (L & 15) >> 2; u.z = L & 3; u.koff = u.z * kq;
        const int tm = u.pm; const int e = (tm >= t1) + (tm >= t2) + (tm >= t3) + (tm >= t4) + (tm >= t5) + (tm >= t6) + (tm >= t7);
        u.bt = bt + (size_t)e * estride; return true;
    }
};
struct DualOrder : StaticOrder {
    size_t estride;
    DEVI bool next(int i, Unit& u) const { if (!tile(i, u.pm, u.pn)) return false; u.bt = bt + (u.pm >= nM / 2 ? estride : 0); u.koff = 0; u.z = 0; return true; }
};

DEVI unsigned cvt_pk_bf16(float lo, float hi) { typedef __bf16 bf16x2_t __attribute__((ext_vector_type(2))); f32x2 v = {lo, hi}; bf16x2_t b = __builtin_convertvector(v, bf16x2_t); return __builtin_bit_cast(unsigned, b); }

template <class Epi, class Sched, bool ALIGN_EPI = true>
DEVI void gemm_phase(LAS unsigned char* lds, const Gemm g, const Sched& S, const Epi& E, int wave0) {
    const int tid = opaque_tid(wave0), wid = __builtin_amdgcn_readfirstlane(tid >> 6), lane = tid & 63, wr = wid >> 2, wc = wid & 3, fr = lane & 15, fq = lane >> 4;
    const int K = g.K, nt = K / BK, lda = g.lda, ldb = g.ldb;
    unsigned voffA[2], voffB[2];
#pragma unroll
    for (int i = 0; i < 2; ++i) { int R, C; stage_rc(tid * 16 + i * 8192, R, C); const int Rb = Epi::PERM ? ((R & ~31) + perm32(R & 31)) : R;
        voffA[i] = (unsigned)(R * lda + C) * 2u; voffB[i] = (unsigned)(Rb * ldb + C) * 2u; }
    const size_t kstep = (size_t)(BK * 2);
    const size_t hstepA = (size_t)HALF * lda * 2, tstepA = 2 * hstepA;
    const size_t hstepB = (size_t)HALF * ldb * 2, tstepB = 2 * hstepB;
    const unsigned ldsw = (unsigned)wid * 1024u;
    const int aoff = lds_byte(wr * 64 + fr, fq * 8), boff = lds_byte(wc * 32 + fr, fq * 8);
#define PG8_SA(b, h) (((b) * 2 + (h)) * HTB)
#define PG8_SB(b, h) ((4 + (b) * 2 + (h)) * HTB)
#define PG8_STAGE(bufoff, gbase, voff) do { _Pragma("unroll") for (int _i = 0; _i < 2; ++_i) \
        __builtin_amdgcn_global_load_lds((const unsigned*)((const char*)(gbase) + (voff)[_i]), (LAS unsigned*)(lds + (bufoff) + ldsw + _i * 8192), 16, 0, 0); } while (0)
#define PG8_LDA(dst, b, h) do { _Pragma("unroll") for (int m = 0; m < 4; ++m) _Pragma("unroll") for (int k = 0; k < 2; ++k) dst[m][k] = *(const LAS bf16x8*)(lds + PG8_SA(b, h) + aoff + m * 2048 + k * 1024); } while (0)
#define PG8_LDB(dst, b, h) do { _Pragma("unroll") for (int n = 0; n < 2; ++n) _Pragma("unroll") for (int k = 0; k < 2; ++k) dst[n][k] = *(const LAS bf16x8*)(lds + PG8_SB(b, h) + boff + n * 2048 + k * 1024); } while (0)
#define PG8_MMA(ai, bj, At, Bt) do { __builtin_amdgcn_s_setprio(1); _Pragma("unroll") for (int m = 0; m < 4; ++m) _Pragma("unroll") for (int n = 0; n < 2; ++n) _Pragma("unroll") for (int k = 0; k < 2; ++k) \
        acc[ai][bj][m][n] = __builtin_amdgcn_mfma_f32_16x16x32_bf16(Bt[n][k], At[m][k], acc[ai][bj][m][n], 0, 0, 0); __builtin_amdgcn_s_setprio(0); } while (0)
#define PG8_WAIT_V(n) asm volatile("s_waitcnt vmcnt(" #n ")" ::: "memory")
#define PG8_WAIT_L(n) asm volatile("s_waitcnt lgkmcnt(" #n ")" ::: "memory")
#define PG8_BAR __builtin_amdgcn_s_barrier()
#define PG8_SCHED __builtin_amdgcn_sched_barrier(0)
    Unit cur, nxt; int ui = 0;
    if (!S.next(0, cur)) return;
    f32x4 acc[2][2][4][2];
#pragma unroll
    for (int a = 0; a < 2; ++a)
#pragma unroll
        for (int b = 0; b < 2; ++b)
#pragma unroll
            for (int m = 0; m < 4; ++m)
#pragma unroll
                for (int n = 0; n < 2; ++n) acc[a][b][m][n] = (f32x4){0.f, 0.f, 0.f, 0.f};
    bf16x8 At[4][2], B0[2][2], B1[2][2];
    const char* cA = (const char*)g.A + (size_t)cur.pm * tstepA + (size_t)cur.koff * 2; const char* cB = (const char*)cur.bt + (size_t)cur.pn * tstepB + (size_t)cur.koff * 2;
    PG8_STAGE(PG8_SB(0, 0), cB, voffB); PG8_STAGE(PG8_SB(0, 1), cB + hstepB, voffB); PG8_STAGE(PG8_SA(0, 0), cA, voffA); PG8_STAGE(PG8_SA(0, 1), cA + hstepA, voffA);
    if (wr == 1) PG8_BAR;
    PG8_WAIT_V(2); PG8_BAR;
    PG8_STAGE(PG8_SB(1, 0), cB + kstep, voffB); PG8_STAGE(PG8_SA(1, 0), cA + kstep, voffA); PG8_STAGE(PG8_SB(1, 1), cB + hstepB + kstep, voffB);
    PG8_WAIT_V(6); PG8_BAR;
    for (;;) {
        const bool has_next = S.next(ui + 1, nxt);
        const char* nA = has_next ? (const char*)g.A + (size_t)nxt.pm * tstepA + (size_t)nxt.koff * 2 : cA; const char* nB = has_next ? (const char*)nxt.bt + (size_t)nxt.pn * tstepB + (size_t)nxt.koff * 2 : cB;
        for (int t = 0; t < nt; t += 2) {
            const bool last = (t == nt - 2);
            const char* a1 = cA + (size_t)(t + 1) * kstep;
            const char* a2 = last ? nA : cA + (size_t)(t + 2) * kstep; const char* b2 = last ? nB : cB + (size_t)(t + 2) * kstep;
            const char* a3 = a2 + kstep; const char* b3 = b2 + kstep;
            PG8_LDB(B0, 0, 0); PG8_LDB(B1, 0, 1); PG8_SCHED; PG8_LDA(At, 0, 0); PG8_STAGE(PG8_SA(1, 1), a1 + hstepA, voffA);
            PG8_WAIT_V(8); PG8_WAIT_L(0); PG8_BAR; PG8_MMA(0, 0, At, B0); PG8_MMA(0, 1, At, B1); PG8_BAR; PG8_SCHED;
            PG8_LDA(At, 0, 1); PG8_STAGE(PG8_SB(0, 0), b2, voffB); PG8_STAGE(PG8_SB(0, 1), b2 + hstepB, voffB); PG8_STAGE(PG8_SA(0, 0), a2, voffA);
            PG8_WAIT_V(8); PG8_WAIT_L(0); PG8_BAR; PG8_MMA(1, 0, At, B0); PG8_MMA(1, 1, At, B1); PG8_BAR; PG8_SCHED;
            PG8_LDB(B0, 1, 0); PG8_LDB(B1, 1, 1); PG8_SCHED; PG8_LDA(At, 1, 0); PG8_STAGE(PG8_SA(0, 1), a2 + hstepA, voffA);
            PG8_WAIT_V(8); PG8_WAIT_L(0); PG8_BAR; PG8_MMA(0, 0, At, B0); PG8_MMA(0, 1, At, B1); PG8_BAR; PG8_SCHED;
            PG8_LDA(At, 1, 1); PG8_STAGE(PG8_SB(1, 0), b3, voffB); PG8_STAGE(PG8_SB(1, 1), b3 + hstepB, voffB); PG8_STAGE(PG8_SA(1, 0), a3, voffA);
            PG8_WAIT_V(8); PG8_WAIT_L(0); PG8_BAR; PG8_MMA(1, 0, At, B0); PG8_MMA(1, 1, At, B1); PG8_BAR; PG8_SCHED;
        }
        if constexpr (ALIGN_EPI) { if (wr == 0) PG8_BAR; }
        E(acc, cur, wr, wc, fr, fq);
        if (!has_next) break;
#pragma unroll
        for (int a = 0; a < 2; ++a)
#pragma unroll
            for (int b = 0; b < 2; ++b)
#pragma unroll
                for (int m = 0; m < 4; ++m)
#pragma unroll
                    for (int n = 0; n < 2; ++n) acc[a][b][m][n] = (f32x4){0.f, 0.f, 0.f, 0.f};
        cur = nxt; cA = nA; cB = nB; ++ui;
        if constexpr (ALIGN_EPI) { if (wr == 1) PG8_BAR; }
    }
    PG8_WAIT_V(0);
    if constexpr (!ALIGN_EPI) { if (wr == 0) PG8_BAR; }
    PG8_BAR;
#undef PG8_SA
#undef PG8_SB
#undef PG8_STAGE
#undef PG8_LDA
#undef PG8_LDB
#undef PG8_MMA
#undef PG8_WAIT_V
#undef PG8_WAIT_L
#undef PG8_BAR
#undef PG8_SCHED
}
}

#define XB_TMO      128
#define XB_XCNT(j)  (256  + 64 * (j))
#define XB_XSUB(j)  (1280 + 64 * (j))
#define XB_XGEN(j)  (2304 + 64 * (j))
#define XB_TOP      3328
#define XB_TOPGEN   3392
#define XCD_BAR_WORDS 3456
#define XB_SPIN_CAP (1u << 22)
DEVI unsigned xb_ld(unsigned* p)              { return __hip_atomic_load(p, __ATOMIC_RELAXED, __HIP_MEMORY_SCOPE_AGENT); }
DEVI unsigned xb_add(unsigned* p, unsigned v) { return __hip_atomic_fetch_add(p, v, __ATOMIC_RELAXED, __HIP_MEMORY_SCOPE_AGENT); }
DEVI unsigned xb_xcc_id() { return (unsigned)__builtin_amdgcn_s_getreg((3 << 11) | 20) & 0xFu; }
#define XB_SPIN(cond, bar) do { unsigned _sp = 0; while (cond) { __builtin_amdgcn_s_sleep(1); \
    if ((++_sp & 255u) == 0u) { if (xb_ld(&(bar)[XB_TMO])) break; if (_sp > XB_SPIN_CAP) { atomicAdd(&(bar)[XB_TMO], 1u); break; } } } } while (0)
struct XcdBarrier { unsigned* bar; unsigned x; volatile LAS unsigned* st; };
DEVI XcdBarrier xcd_barrier_post(unsigned* bar, volatile LAS unsigned* st) {
    XcdBarrier b; b.bar = bar; b.x = xb_xcc_id(); b.st = st;
    if (threadIdx.x == 0) (void)xb_add(&bar[XB_XCNT(b.x)], 1u);
    return b;
}
DEVI void xcd_barrier_complete(unsigned* bar, unsigned x, unsigned& nloc, unsigned& nx) {
    const unsigned G = gridDim.x * gridDim.y * gridDim.z;
    unsigned sum, cnt, mine, sp = 0u;
    for (;;) {
        sum = 0u; cnt = 0u; mine = 0u;
#pragma unroll
        for (unsigned j = 0; j < 16; ++j) { const unsigned c = xb_ld(&bar[XB_XCNT(j)]); sum += c; cnt += (c > 0u) ? 1u : 0u; mine = (j == x) ? c : mine; }
        if (sum == G) break;
        __builtin_amdgcn_s_sleep(1);
        if ((++sp & 255u) == 0u) { if (xb_ld(&bar[XB_TMO])) break; if (sp > XB_SPIN_CAP) { atomicAdd(&bar[XB_TMO], 1u); break; } }
    }
    nloc = mine > 0u ? mine : 1u; nx = cnt > 0u ? cnt : 1u;
}
DEVI void xcd_barrier(const XcdBarrier& b) {
    asm volatile("s_waitcnt vmcnt(0)" ::: "memory");
    __syncthreads();
    if (threadIdx.x == 0) {
        unsigned* bar = b.bar;
        __builtin_amdgcn_s_waitcnt(0);
        unsigned nloc = b.st[0], nx = b.st[1];
        if (nloc == 0u) { xcd_barrier_complete(bar, b.x, nloc, nx); b.st[0] = nloc; b.st[1] = nx; }
        const unsigned old = xb_add(&bar[XB_XSUB(b.x)], 1u);
        const unsigned gen = old / nloc;
        if (old + 1u == (gen + 1u) * nloc) {
            __builtin_amdgcn_fence(__ATOMIC_RELEASE, "agent");
            asm volatile("s_waitcnt vmcnt(0)" ::: "memory");
            const unsigned og = xb_add(&bar[XB_TOP], 1u);
            const unsigned tg = og / nx;
            if (og + 1u == (tg + 1u) * nx) xb_add(&bar[XB_TOPGEN], 1u);
            else XB_SPIN(xb_ld(&bar[XB_TOPGEN]) == tg, bar);
            __builtin_amdgcn_fence(__ATOMIC_ACQUIRE, "agent");
            xb_add(&bar[XB_XGEN(b.x)], 1u);
            asm volatile("s_waitcnt vmcnt(0)" ::: "memory");
        } else {
            XB_SPIN(xb_ld(&bar[XB_XGEN(b.x)]) == gen, bar);
            __builtin_amdgcn_fence(__ATOMIC_ACQUIRE, "agent");
            asm volatile("s_waitcnt vmcnt(0)" ::: "memory");
        }
    }
    __syncthreads();
}

typedef const void* cvp_t;
DEVI const void* karg_ptr(int byte_off) { asm volatile("" : "+s"(byte_off)); const __attribute__((address_space(4))) char* kp = (const __attribute__((address_space(4))) char*)__builtin_amdgcn_kernarg_segment_ptr(); return *(const __attribute__((address_space(4))) cvp_t*)(kp + byte_off); }
#define ARG_IN(i) karg_ptr((i) * 8)
#define ARG_OUT() ((float*)karg_ptr(18 * 8))
#define ARG_WS() ((unsigned char*)karg_ptr(19 * 8))
struct Frame {
    LAS unsigned char* lds;
    unsigned char* ws;
    int tid, lane, wave, G, vcu, wave0;
    DEVI void refresh() { tid = opaque_tid(wave0); lane = tid & 63; wave = __builtin_amdgcn_readfirstlane(tid >> 6); }
};
constexpr int NWAVES = 8;

DEVI void transpose_item(const float* W, int K, int N, bf16_t* WT, int k0, int n0, int drow0, LAS float* scr, int lane) {
    const int nc = n0 + 4 * (lane & 7); const bool ok = nc < N;
#pragma unroll
    for (int i = 0; i < 8; ++i) { const int kk = 8 * i + (lane >> 3); const f32x4 v = ok ? *(const f32x4*)(W + (size_t)(k0 + kk) * N + nc) : (f32x4){0.f, 0.f, 0.f, 0.f};
        LAS float* d = scr + kk * 33 + 4 * (lane & 7); d[0] = v[0]; d[1] = v[1]; d[2] = v[2]; d[3] = v[3]; }
    LDS_WAIT(); asm volatile("" ::: "memory");
    const int c = lane & 7;
#pragma unroll
    for (int j = 0; j < 4; ++j) { const int n = (lane >> 3) + 8 * j; const LAS float* s = scr + (8 * c) * 33 + n;
        u32x4 o; o.x = pk2(s[0 * 33], s[1 * 33]); o.y = pk2(s[2 * 33], s[3 * 33]); o.z = pk2(s[4 * 33], s[5 * 33]); o.w = pk2(s[6 * 33], s[7 * 33]);
        *(u32x4*)(WT + (size_t)(drow0 + n) * K + k0 + 8 * c) = o; }
    LDS_WAIT(); asm volatile("" ::: "memory");
}
struct WFam { const float* src; size_t sstride; bf16_t* dst; size_t dstride; int count, K, N, Npad, mode; };
DEVI bool wfam_do(const WFam& f, int& it, LAS float* scr, int lane) {
    const int nkb = f.K / 64, nnb = f.Npad / 32, per = nkb * nnb, tot = per * f.count;
    if (it >= tot) { it -= tot; return false; }
    const int mi = it / per, r = it % per, kb = r / nnb, nb = r % nnb, n0 = nb * 32;
    int drow0 = n0;
    if (f.mode == 1) { const int F = f.N / 2; const int o = n0 < F ? n0 : n0 - F; drow0 = 256 * (o / 128) + (o % 128) + (n0 < F ? 0 : 128); }
    transpose_item(f.src + (size_t)mi * f.sstride, f.K, f.N, f.dst + (size_t)mi * f.dstride, kb * 64, n0, drow0, scr, lane);
    return true;
}

DEVI void phase_prologue(Frame& F) {
    F.refresh();
    LAS float* scr = (LAS float*)(F.lds + F.wave * 16384);
    const int gw = F.vcu * NWAVES + F.wave, NGW = F.G * NWAVES;
    unsigned char* ws = F.ws;
    const WFam fam[11] = {
        {(const float*)ARG_IN(2), (size_t)DM * A_IN, (bf16_t*)(ws + WS_WINA), (size_t)A_INP * DM, 2, DM, A_IN, A_INP, 0},
        {(const float*)ARG_IN(3), (size_t)DM * DM, (bf16_t*)(ws + WS_WOUTA), (size_t)DM * DM, 2, DM, DM, DM, 0},
        {(const float*)ARG_IN(5), (size_t)2048 * 256, (bf16_t*)(ws + WS_WC1), (size_t)256 * 2048, 4, 2048, 256, 256, 0},
        {(const float*)ARG_IN(6), (size_t)256 * 64, (bf16_t*)(ws + WS_WC2), (size_t)256 * 256, 4, 256, 64, 256, 0},
        {(const float*)ARG_IN(8), (size_t)DM * DM, (bf16_t*)(ws + WS_WQKV2), 0, 1, DM, DM, DM, 0},
        {(const float*)ARG_IN(7), 0, (bf16_t*)(ws + WS_WQKV2) + (size_t)DM * DM, 0, 1, DM, 256, 256, 0},
        {(const float*)ARG_IN(8) + (size_t)DM * DM, 0, (bf16_t*)(ws + WS_WQB1), 0, 1, DM, DM, DM, 0},
        {(const float*)ARG_IN(9), (size_t)DM * DM, (bf16_t*)(ws + WS_WOUTB), (size_t)DM * DM, 2, DM, DM, DM, 0},
        {(const float*)ARG_IN(13), (size_t)DM * 2 * DFF, (bf16_t*)(ws + WS_WDIN), (size_t)2 * DFF * DM, 2, DM, 2 * DFF, 2 * DFF, 1},
        {(const float*)ARG_IN(14), (size_t)DFF * DM, (bf16_t*)(ws + WS_WDOUT), (size_t)DM * DFF, 2, DFF, DM, DM, 0},
        {(const float*)ARG_IN(16), (size_t)DM * 2 * DFFE, (bf16_t*)(ws + WS_WMIN), (size_t)2 * DFFE * DM, 16, DM, 2 * DFFE, 2 * DFFE, 1},
    };
    const WFam famo = {(const float*)ARG_IN(17), (size_t)DFFE * DM, (bf16_t*)(ws + WS_WMOUT), (size_t)DM * DFFE, 16, DFFE, DM, DM, 0};
    int total = 0;
#pragma unroll
    for (int i = 0; i < 11; ++i) total += (fam[i].K / 64) * (fam[i].Npad / 32) * fam[i].count;
    total += (famo.K / 64) * (famo.Npad / 32) * famo.count;
    for (int it0 = gw; it0 < total; it0 += NGW) {
        int it = it0; bool done = false;
#pragma unroll
        for (int i = 0; i < 11; ++i) if (!done) done = wfam_do(fam[i], it, scr, F.lane);
        if (!done) wfam_do(famo, it, scr, F.lane);
    }
    { const float* x = (const float*)ARG_IN(0); bf16_t* hb = (bf16_t*)(ws + WS_HB);
      const size_t n8 = (size_t)MTOK * DM / 8;
      for (size_t i = (size_t)blockIdx.x * 512 + F.tid; i < n8; i += (size_t)F.G * 512) {
          const f32x4 v0 = *(const f32x4*)(x + i * 8), v1 = *(const f32x4*)(x + i * 8 + 4);
          u32x4 o; o.x = pk2(v0.x, v0.y); o.y = pk2(v0.z, v0.w); o.z = pk2(v1.x, v1.y); o.w = pk2(v1.z, v1.w);
          *(u32x4*)(hb + i * 8) = o; } }
    { const int* pos = (const int*)ARG_IN(1); float* cs = (float*)(ws + WS_CS);
      for (int i = blockIdx.x * 512 + F.tid; i < MTOK * 8; i += F.G * 512) {
          const int tok = i >> 3, j = i & 7;
          const float invf = (float)exp2(-(double)j * (18.931568569324174 / 8.0));
          const double ang = (double)((float)pos[tok] * invf);
          const double n = rint(ang * 0.15915494309189535); const double r = ang - n * 6.283185307179586476925;
          const float rf = (float)r;
          cs[tok * 16 + j] = cosf(rf); cs[tok * 16 + 8 + j] = sinf(rf); } }
    { const float* cp = (const float*)ARG_IN(4); const float* w1 = (const float*)ARG_IN(5); float* bp = (float*)((unsigned*)(ws + WS_CTL) + CW_BIASP);
      if (gw < 1024) { const int mi = gw >> 8, c = gw & 255; float s = 0.f;
#pragma unroll 8
          for (int i = 0; i < 32; ++i) { const int f = i * 64 + F.lane; s += cp[(size_t)mi * 2048 + f] * w1[((size_t)mi * 2048 + f) * 256 + c]; }
          s = wave_sum(s, F.lane);
          if (F.lane == 0) bp[gw] = s; } }
}

typedef f32x4 AccT[2][2][4][2];

DEVI u32x4 pack8(const f32x4 a, const f32x4 b) { u32x4 w; w.x = pg8::cvt_pk_bf16(a[0], a[1]); w.y = pg8::cvt_pk_bf16(a[2], a[3]); w.z = pg8::cvt_pk_bf16(b[0], b[1]); w.w = pg8::cvt_pk_bf16(b[2], b[3]); return w; }
DEVI void rope8(f32x4& v0, f32x4& v1, int dhead, const float* csrow, int lane) {
    f32x4 p0, p1;
#pragma unroll
    for (int i = 0; i < 4; ++i) { p0[i] = shx(v0[i], 16, lane); p1[i] = shx(v1[i], 16, lane); }
    if (dhead < 16) {
        const f32x4 c0 = *(const f32x4*)(csrow), c1 = *(const f32x4*)(csrow + 4), s0 = *(const f32x4*)(csrow + 8), s1 = *(const f32x4*)(csrow + 12);
        if (dhead == 0) { v0 = v0 * c0 - p0 * s0; v1 = v1 * c1 - p1 * s1; }
        else            { v0 = v0 * c0 + p0 * s0; v1 = v1 * c1 + p1 * s1; }
    }
}

struct EpiNsaIn {
    static constexpr bool PERM = true;
    unsigned char* ws; const float* cs;
    DEVI void operator()(const AccT& acc, const pg8::Unit& u, int wr, int wc, int fr, int fq) const {
        const int pn = u.pn;
        if (pn < 4) {
            bf16_t* Q = (bf16_t*)(ws + RA_Q);
#pragma unroll
            for (int ai = 0; ai < 2; ++ai)
#pragma unroll
                for (int m = 0; m < 4; ++m) { const int row = u.pm * 256 + ai * 128 + wr * 64 + m * 16 + fr;
#pragma unroll
                    for (int bj = 0; bj < 2; ++bj) *(u32x4*)(Q + (size_t)row * DM + pn * 256 + bj * 128 + wc * 32 + fq * 8) = pack8(acc[ai][bj][m][0], acc[ai][bj][m][1]); }
        } else if (pn < 10) {
            const size_t base = pn == 4 ? RA_KCR : pn == 5 ? RA_VCR : pn == 6 ? RA_KS : pn == 7 ? RA_VS : pn == 8 ? RA_KW : RA_VW;
            bf16_t* T = (bf16_t*)(ws + base);
            const bool rot = (pn == 6 || pn == 8);
            const int dh = (wc & 1) * 32 + fq * 8;
#pragma unroll
            for (int ai = 0; ai < 2; ++ai)
#pragma unroll
                for (int m = 0; m < 4; ++m) { const int row = u.pm * 256 + ai * 128 + wr * 64 + m * 16 + fr; const int b = row / SEQ, t = row % SEQ;
#pragma unroll
                    for (int bj = 0; bj < 2; ++bj) { f32x4 v0 = acc[ai][bj][m][0], v1 = acc[ai][bj][m][1];
                        if (rot) rope8(v0, v1, dh, cs + (size_t)row * 16, fq * 16 + fr);
                        const int g = bj * 2 + (wc >> 1);
                        *(u32x4*)(T + ((size_t)(b * A_G + g) * SEQ + t) * HD + dh) = pack8(v0, v1); } }
        } else {
            float* G = (float*)(ws + RA_GATE);
            if (wc < 2) {
#pragma unroll
                for (int ai = 0; ai < 2; ++ai)
#pragma unroll
                    for (int m = 0; m < 4; ++m) { const int row = u.pm * 256 + ai * 128 + wr * 64 + m * 16 + fr;
#pragma unroll
                        for (int n = 0; n < 2; ++n) { const int c = wc * 32 + fq * 8 + n * 4;
                            if (c < 48) { f32x4 v = acc[ai][0][m][n]; f32x4 o;
#pragma unroll
                                for (int i = 0; i < 4; ++i) o[i] = 1.f / (1.f + __expf(-v[i]));
                                *(f32x4*)(G + (size_t)row * 48 + c) = o; } } }
            }
        }
    }
};
struct EpiSwaIn {
    static constexpr bool PERM = true;
    unsigned char* ws; const float* cs;
    DEVI void operator()(const AccT& acc, const pg8::Unit& u, int wr, int wc, int fr, int fq) const {
        const int pn = u.pn; const int dh = (wc & 1) * 32 + fq * 8;
        bf16_t* Q = (bf16_t*)(ws + RA_Q); bf16_t* KS = (bf16_t*)(ws + WS_KSH); bf16_t* VS = (bf16_t*)(ws + WS_VSH);
#pragma unroll
        for (int ai = 0; ai < 2; ++ai)
#pragma unroll
            for (int m = 0; m < 4; ++m) { const int row = u.pm * 256 + ai * 128 + wr * 64 + m * 16 + fr; const int b = row / SEQ, t = row % SEQ;
#pragma unroll
                for (int bj = 0; bj < 2; ++bj) { f32x4 v0 = acc[ai][bj][m][0], v1 = acc[ai][bj][m][1];
                    const bool rot = (pn < 4) || (bj == 0);
                    if (rot) rope8(v0, v1, dh, cs + (size_t)row * 16, fq * 16 + fr);
                    const u32x4 w = pack8(v0, v1);
                    if (pn < 4) *(u32x4*)(Q + (size_t)row * DM + pn * 256 + bj * 128 + wc * 32 + fq * 8) = w;
                    else { bf16_t* T = bj == 0 ? KS : VS; const int g = wc >> 1; *(u32x4*)(T + ((size_t)(b * B_G + g) * SEQ + t) * HD + dh) = w; } } }
    }
};
DEVI float gelu_tanh(float x) { const float u = 0.7978845608028654f * (x + 0.044715f * x * x * x); const float e = __expf(2.f * u); const float th = 1.f - 2.f / (e + 1.f); return 0.5f * x * (1.f + th); }
struct EpiCmpHid {
    static constexpr bool PERM = true;
    bf16_t* out; const float* bias;
    DEVI void operator()(const AccT& acc, const pg8::Unit& u, int wr, int wc, int fr, int fq) const {
        const float* bs = bias;
#pragma unroll
        for (int bj = 0; bj < 2; ++bj) { const int c = bj * 128 + wc * 32 + fq * 8; const f32x4 b0 = *(const f32x4*)(bs + c), b1 = *(const f32x4*)(bs + c + 4);
#pragma unroll
            for (int ai = 0; ai < 2; ++ai)
#pragma unroll
                for (int m = 0; m < 4; ++m) { const int row = u.pm * 256 + ai * 128 + wr * 64 + m * 16 + fr; f32x4 v0 = acc[ai][bj][m][0] + b0, v1 = acc[ai][bj][m][1] + b1;
#pragma unroll
                    for (int i = 0; i < 4; ++i) { v0[i] = gelu_tanh(v0[i]); v1[i] = gelu_tanh(v1[i]); }
                    *(u32x4*)(out + (size_t)row * 256 + c) = pack8(v0, v1); } }
    }
};
struct EpiCmpOut {
    static constexpr bool PERM = true;
    bf16_t* kc; bf16_t* vc;
    DEVI void operator()(const AccT& acc, const pg8::Unit& u, int wr, int wc, int fr, int fq) const {
        if (wc >= 2) return;
        bf16_t* T = u.pm >= 32 ? vc : kc; const int rbase = (u.pm & 31) * 256;
#pragma unroll
        for (int ai = 0; ai < 2; ++ai)
#pragma unroll
            for (int m = 0; m < 4; ++m) { const int row = rbase + ai * 128 + wr * 64 + m * 16 + fr;
                u32x4 w = pack8(acc[ai][0][m][0], acc[ai][0][m][1]);
                if ((row & 1023) == 1023) w = (u32x4){0u, 0u, 0u, 0u};
                *(u32x4*)(T + (size_t)row * 64 + wc * 32 + fq * 8) = w; }
    }
};
struct EpiResid {
    static constexpr bool PERM = true;
    const bf16_t* res; bf16_t* y;
    DEVI void operator()(const AccT& acc, const pg8::Unit& u, int wr, int wc, int fr, int fq) const {
#pragma unroll
        for (int ai = 0; ai < 2; ++ai)
#pragma unroll
            for (int m = 0; m < 4; ++m) { const size_t off = (size_t)(u.pm * 256 + ai * 128 + wr * 64 + m * 16 + fr) * DM + u.pn * 256 + wc * 32 + fq * 8;
#pragma unroll
                for (int bj = 0; bj < 2; ++bj) { const u32x4 r = *(const u32x4*)(res + off + bj * 128);
                    const f32x4 r0 = {bflo(r.x), bfhi(r.x), bflo(r.y), bfhi(r.y)}, r1 = {bflo(r.z), bfhi(r.z), bflo(r.w), bfhi(r.w)};
                    *(u32x4*)(y + off + bj * 128) = pack8(r0 * ALPHA + acc[ai][bj][m][0], r1 * ALPHA + acc[ai][bj][m][1]); } }
    }
};
struct EpiBf16Out {
    static constexpr bool PERM = true;
    bf16_t* y;
    DEVI void operator()(const AccT& acc, const pg8::Unit& u, int wr, int wc, int fr, int fq) const {
#pragma unroll
        for (int ai = 0; ai < 2; ++ai)
#pragma unroll
            for (int m = 0; m < 4; ++m) { const size_t off = (size_t)(u.pm * 256 + ai * 128 + wr * 64 + m * 16 + fr) * DM + u.pn * 256 + wc * 32 + fq * 8;
#pragma unroll
                for (int bj = 0; bj < 2; ++bj) *(u32x4*)(y + off + bj * 128) = pack8(acc[ai][bj][m][0], acc[ai][bj][m][1]); }
    }
};
struct EpiPart {
    static constexpr bool PERM = false;
    float* part;
    DEVI void operator()(const AccT& acc, const pg8::Unit& u, int wr, int wc, int fr, int fq) const {
        float* base = part + (size_t)((u.pm - 256) * 4 + u.z) * 256 * DM;
#pragma unroll
        for (int ai = 0; ai < 2; ++ai)
#pragma unroll
            for (int m = 0; m < 4; ++m) { const size_t off = (size_t)(ai * 128 + wr * 64 + m * 16 + fr) * DM + u.pn * 256 + wc * 32 + fq * 4;
#pragma unroll
                for (int bj = 0; bj < 2; ++bj)
#pragma unroll
                    for (int n = 0; n < 2; ++n) *(f32x4*)(base + off + bj * 128 + n * 16) = acc[ai][bj][m][n]; }
    }
};
struct EpiSwiglu {
    static constexpr bool PERM = true;
    bf16_t* act; int ld;
    DEVI void operator()(const AccT& acc, const pg8::Unit& u, int wr, int wc, int fr, int fq) const {
#pragma unroll
        for (int ai = 0; ai < 2; ++ai)
#pragma unroll
            for (int m = 0; m < 4; ++m) { const size_t row = (size_t)(u.pm * 256 + ai * 128 + wr * 64 + m * 16 + fr); f32x4 o[2];
#pragma unroll
                for (int n = 0; n < 2; ++n)
#pragma unroll
                    for (int i = 0; i < 4; ++i) { const float gv = acc[ai][0][m][n][i], uv = acc[ai][1][m][n][i]; o[n][i] = gv * __builtin_amdgcn_rcpf(1.f + __expf(-gv)) * uv; }
                *(u32x4*)(act + row * ld + u.pn * 128 + wc * 32 + fq * 8) = pack8(o[0], o[1]); }
    }
};

DEVI void unpack8(const u32x4 w, float (&x)[8]) { x[0] = bflo(w.x); x[1] = bfhi(w.x); x[2] = bflo(w.y); x[3] = bfhi(w.y); x[4] = bflo(w.z); x[5] = bfhi(w.z); x[6] = bflo(w.w); x[7] = bfhi(w.w); }
DEVI void moe_row8(const bf16_t* YB, const float* PART, int p, int c, float (&x)[8]) {
    if (p < 65536) { unpack8(*(const u32x4*)(YB + (size_t)p * DM + c), x); return; }
    const float* q = PART + ((size_t)(((p >> 8) - 256) * 4) * 256 + (p & 255)) * DM + c;
    f32x4 a0 = *(const f32x4*)q, a1 = *(const f32x4*)(q + 4);
#pragma unroll
    for (int z = 1; z < 4; ++z) { a0 = a0 + *(const f32x4*)(q + (size_t)z * 256 * DM); a1 = a1 + *(const f32x4*)(q + (size_t)z * 256 * DM + 4); }
    x[0] = a0[0]; x[1] = a0[1]; x[2] = a0[2]; x[3] = a0[3]; x[4] = a1[0]; x[5] = a1[1]; x[6] = a1[2]; x[7] = a1[3];
}
template <int MODE, bool ROUTER, bool FINAL>
DEVI void phase_ln(Frame& F, int lnidx, float* outp, int moe_layer) {
    F.refresh();
    unsigned char* ws = F.ws;
    const bf16_t* Y = (const bf16_t*)(ws + WS_Y); const bf16_t* YB = (const bf16_t*)(ws + WS_YB); const float* PART = (const float*)(ws + WS_H);
    bf16_t* HB = (bf16_t*)(ws + WS_HB);
    const float* gam = (const float*)ARG_IN(11) + (size_t)lnidx * DM; const float* bet = (const float*)ARG_IN(12) + (size_t)lnidx * DM;
    int* TOKE = (int*)(ws + WS_ROUTE); int* TOKR = TOKE + MTOK * 2; float* TOKW = (float*)(TOKR + MTOK * 2); int* TOKP = (int*)(TOKW + MTOK * 2);
    const float* wr_ = ROUTER ? (const float*)ARG_IN(15) + (size_t)moe_layer * DM * NEXP : nullptr;
    LAS int* lcnt = (LAS int*)(F.lds + LDS_X);
    LAS int* lrec = lcnt + 16;
    LAS int* lrank = lrec + 256;
    if (ROUTER) { if (F.tid < 16) lcnt[F.tid] = 0; __syncthreads(); }
    const int gw = F.vcu * NWAVES + F.wave, NGW = F.G * NWAVES;
    int nloc = 0;
    for (int m = gw; m < MTOK; m += NGW, ++nloc) {
        float v[2][8];
        if (MODE == 0) {
#pragma unroll
            for (int j = 0; j < 2; ++j) unpack8(*(const u32x4*)(Y + (size_t)m * DM + j * 512 + F.lane * 8), v[j]);
        } else {
            const int p0 = TOKP[m * 2], p1 = TOKP[m * 2 + 1]; const float w0 = TOKW[m * 2], w1 = TOKW[m * 2 + 1];
#pragma unroll
            for (int j = 0; j < 2; ++j) { const int c = j * 512 + F.lane * 8; float h[8], a[8], b[8];
                unpack8(*(const u32x4*)(HB + (size_t)m * DM + c), h); moe_row8(YB, PART, p0, c, a); moe_row8(YB, PART, p1, c, b);
#pragma unroll
                for (int i = 0; i < 8; ++i) v[j][i] = h[i] * ALPHA + a[i] * w0 + b[i] * w1; }
        }
        float s = 0.f;
#pragma unroll
        for (int j = 0; j < 2; ++j)
#pragma unroll
            for (int i = 0; i < 8; ++i) s += v[j][i];
        const float mean = wave_sum(s, F.lane) * (1.f / DM); float s2 = 0.f;
#pragma unroll
        for (int j = 0; j < 2; ++j)
#pragma unroll
            for (int i = 0; i < 8; ++i) { v[j][i] -= mean; s2 += v[j][i] * v[j][i]; }
        const float rstd = 1.f / sqrtf(wave_sum(s2, F.lane) * (1.f / DM) + LN_EPS);
#pragma unroll
        for (int j = 0; j < 2; ++j) { const int c = j * 512 + F.lane * 8;
            const f32x4 g0 = *(const f32x4*)(gam + c), g1 = *(const f32x4*)(gam + c + 4), b0 = *(const f32x4*)(bet + c), b1 = *(const f32x4*)(bet + c + 4);
#pragma unroll
            for (int i = 0; i < 4; ++i) { v[j][i] = v[j][i] * rstd * g0[i] + b0[i]; v[j][4 + i] = v[j][4 + i] * rstd * g1[i] + b1[i]; }
            if (FINAL) { *(f32x4*)(outp + (size_t)m * DM + c) = (f32x4){v[j][0], v[j][1], v[j][2], v[j][3]}; *(f32x4*)(outp + (size_t)m * DM + c + 4) = (f32x4){v[j][4], v[j][5], v[j][6], v[j][7]}; }
            else { u32x4 w; w.x = pk2(v[j][0], v[j][1]); w.y = pk2(v[j][2], v[j][3]); w.z = pk2(v[j][4], v[j][5]); w.w = pk2(v[j][6], v[j][7]); *(u32x4*)(HB + (size_t)m * DM + c) = w; } }
        if (ROUTER) {
            float lg[NEXP];
#pragma unroll
            for (int e = 0; e < NEXP; ++e) lg[e] = 0.f;
#pragma unroll
            for (int j = 0; j < 2; ++j)
#pragma unroll
                for (int i = 0; i < 8; ++i) { const int c = j * 512 + F.lane * 8 + i; const f32x4 w0 = *(const f32x4*)(wr_ + (size_t)c * NEXP), w1 = *(const f32x4*)(wr_ + (size_t)c * NEXP + 4); const float x = v[j][i];
                    lg[0] += x * w0.x; lg[1] += x * w0.y; lg[2] += x * w0.z; lg[3] += x * w0.w; lg[4] += x * w1.x; lg[5] += x * w1.y; lg[6] += x * w1.z; lg[7] += x * w1.w; }
#pragma unroll
            for (int e = 0; e < NEXP; ++e) lg[e] = wave_sum(lg[e], F.lane);
            int e0 = 0; float l0 = lg[0];
#pragma unroll
            for (int e = 1; e < NEXP; ++e) if (lg[e] > l0) { l0 = lg[e]; e0 = e; }
            int e1 = -1; float l1 = -3.4e38f;
#pragma unroll
            for (int e = 0; e < NEXP; ++e) if (e != e0 && lg[e] > l1) { l1 = lg[e]; e1 = e; }
            if (e1 < 0) e1 = (e0 + 1) & 7;
            const float g1 = 1.f / (1.f + __expf(l0 - l1)), g0 = 1.f - g1;
            if (F.lane == 0) {
                const int idx = (F.wave * 16 + nloc) * 2;
                lrec[idx] = m * 16 + e0; lrec[idx + 1] = m * 16 + e1;
                TOKE[m * 2] = e0; TOKE[m * 2 + 1] = e1; TOKW[m * 2] = g0; TOKW[m * 2 + 1] = g1;
            }
        }
    }
    if (ROUTER) {
        __syncthreads();
        unsigned* cnt = (unsigned*)(ws + WS_CTL) + CW_MOE + moe_layer * 64;
        int* wgcnt = (int*)(ws + WS_CTL) + CW_WGCNT + moe_layer * 2048 + (int)blockIdx.x * 8;
        LAS int* wcnt = lrank;
        int rec = 0, e = 0, r = 0;
        if (F.wave < 4) { rec = lrec[F.tid]; e = rec & 15;
            const unsigned long long lt = (1ull << F.lane) - 1ull;
#pragma unroll
            for (int x = 0; x < 8; ++x) { const unsigned long long b = __builtin_amdgcn_ballot_w64(e == x); if (e == x) r = __builtin_popcountll(b & lt); if (F.lane == 0) wcnt[F.wave * 8 + x] = __builtin_popcountll(b); } }
        __syncthreads();
        if (F.wave < 4) { for (int w = 0; w < F.wave; ++w) r += wcnt[w * 8 + e]; TOKR[(rec >> 4) * 2 + (F.tid & 1)] = r; }
        if (F.tid < 8) lcnt[F.tid] = wcnt[F.tid] + wcnt[8 + F.tid] + wcnt[16 + F.tid] + wcnt[24 + F.tid];
        __syncthreads();
        if (F.tid < 8) { wgcnt[F.tid] = lcnt[F.tid]; __hip_atomic_fetch_add(cnt + F.tid, (unsigned)lcnt[F.tid], __ATOMIC_RELAXED, __HIP_MEMORY_SCOPE_AGENT); }
    }
}

DEVI void moe_tiles(const unsigned* cnt, int (&ts)[9]) { ts[0] = 0;
#pragma unroll
    for (int e = 0; e < 8; ++e) ts[e + 1] = ts[e] + (int)((__hip_atomic_load(cnt + e, __ATOMIC_RELAXED, __HIP_MEMORY_SCOPE_AGENT) + 255u) >> 8); }
DEVI void phase_moe_scatter(Frame& F, int moe_layer) {
    F.refresh();
    unsigned char* ws = F.ws;
    const unsigned* cnt = (const unsigned*)(ws + WS_CTL) + CW_MOE + moe_layer * 64;
    int ts[9]; moe_tiles(cnt, ts);
    LAS int* wbase = (LAS int*)(F.lds + LDS_X);
    if (F.tid < 8) wbase[F.tid] = 0;
    __syncthreads();
    if (F.tid < (int)blockIdx.x) { const int* wc = (const int*)(ws + WS_CTL) + CW_WGCNT + moe_layer * 2048 + F.tid * 8;
        const u32x4 c0 = *(const u32x4*)wc, c1 = *(const u32x4*)(wc + 4);
#pragma unroll
        for (int e = 0; e < 4; ++e) { __hip_atomic_fetch_add(wbase + e, (int)c0[e], __ATOMIC_RELAXED, __HIP_MEMORY_SCOPE_WORKGROUP); __hip_atomic_fetch_add(wbase + 4 + e, (int)c1[e], __ATOMIC_RELAXED, __HIP_MEMORY_SCOPE_WORKGROUP); } }
    __syncthreads();
    const int* TOKE = (const int*)(ws + WS_ROUTE); const int* TOKR = TOKE + MTOK * 2; int* TOKP = (int*)(ws + WS_ROUTE) + MTOK * 6;
    const bf16_t* HB = (const bf16_t*)(ws + WS_HB); bf16_t* XB = (bf16_t*)(ws + WS_XB);
    const int gw = F.vcu * NWAVES + F.wave, NGW = F.G * NWAVES;
    for (int m = gw; m < MTOK; m += NGW) {
        const u32x4 r0 = *(const u32x4*)(HB + (size_t)m * DM + F.lane * 8), r1 = *(const u32x4*)(HB + (size_t)m * DM + 512 + F.lane * 8);
#pragma unroll
        for (int k = 0; k < 2; ++k) { const int e = TOKE[m * 2 + k], r = TOKR[m * 2 + k];
            int st = 0;
#pragma unroll
            for (int j = 1; j < 8; ++j) st = (e >= j) ? ts[j] : st;
            const int pos = st * 256 + wbase[e] + r;
            *(u32x4*)(XB + (size_t)pos * DM + F.lane * 8) = r0; *(u32x4*)(XB + (size_t)pos * DM + 512 + F.lane * 8) = r1;
            if (F.lane == 0) TOKP[m * 2 + k] = pos; }
    }
}

DEVI void phase_nsa_naive(Frame& F) {
    F.refresh();
    unsigned char* ws = F.ws;
    const bf16_t* Q = (const bf16_t*)(ws + RA_Q); bf16_t* ATT = (bf16_t*)(ws + RA_ATT);
    const bf16_t* KC = (const bf16_t*)(ws + RA_KC); const bf16_t* VC = (const bf16_t*)(ws + RA_VC);
    const bf16_t* KS = (const bf16_t*)(ws + RA_KS); const bf16_t* VS = (const bf16_t*)(ws + RA_VS);
    const bf16_t* KW = (const bf16_t*)(ws + RA_KW); const bf16_t* VW = (const bf16_t*)(ws + RA_VW);
    const float* GT = (const float*)(ws + RA_GATE); const float* CS = (const float*)(ws + WS_CS);
    LAS float* sc = (LAS float*)(F.lds + F.wave * 16384);
    LAS float* qs_ = (LAS float*)(F.lds + LDS_X + F.wave * 2048);
    LAS float* qr_ = qs_ + 256;
    const int lane = F.lane;
    const int gw = F.vcu * NWAVES + F.wave, NGW = F.G * NWAVES;
    for (int u = gw; u < MTOK * A_G; u += NGW) {
        const int bg = u / SEQ, t = u % SEQ, b = bg / A_G, g = bg % A_G; const int tok = b * SEQ + t;
        { const bf16_t* qp = Q + (size_t)tok * DM + g * 256 + lane * 4; const u32x2 w = *(const u32x2*)qp;
          float x[4] = {bflo(w.x), bfhi(w.x), bflo(w.y), bfhi(w.y)};
#pragma unroll
          for (int i = 0; i < 4; ++i) qs_[lane * 4 + i] = x[i];
          LDS_WAIT();
          const int d0 = (lane * 4) & 63;
#pragma unroll
          for (int i = 0; i < 4; ++i) { const int d = d0 + i; float v = x[i];
              if (d < 8) v = x[i] * CS[(size_t)tok * 16 + d] - qs_[lane * 4 + i + 8] * CS[(size_t)tok * 16 + 8 + d];
              else if (d < 16) v = x[i] * CS[(size_t)tok * 16 + d - 8] + qs_[lane * 4 + i - 8] * CS[(size_t)tok * 16 + d];
              qr_[lane * 4 + i] = v; }
          LDS_WAIT(); }
        float oc[4] = {0.f, 0.f, 0.f, 0.f}, os[4] = {0.f, 0.f, 0.f, 0.f}, ow[4] = {0.f, 0.f, 0.f, 0.f};
        const int cur = t >> 6;
        const int nv = t >= 31 ? ((t - 31) >> 4) + 1 : 0;
        float impv[4] = {0.f, 0.f, 0.f, 0.f};
        if (nv > 0) {
            const bf16_t* kc = KC + (size_t)bg * 1024 * 64; const bf16_t* vc = VC + (size_t)bg * 1024 * 64;
            float mx[4] = {-3.0e38f, -3.0e38f, -3.0e38f, -3.0e38f};
            for (int c = 0; c * 64 < nv; ++c) { const int n = c * 64 + lane;
                if (n < nv) { float s[4] = {0.f, 0.f, 0.f, 0.f}; LAS float* qs = qs_; asm volatile("" : "+v"(qs));
#pragma unroll 2
                    for (int d8 = 0; d8 < 8; ++d8) { const u32x4 w = *(const u32x4*)(kc + (size_t)n * 64 + d8 * 8);
                        const float kf[8] = {bflo(w.x), bfhi(w.x), bflo(w.y), bfhi(w.y), bflo(w.z), bfhi(w.z), bflo(w.w), bfhi(w.w)};
#pragma unroll
                        for (int r = 0; r < 4; ++r) { const f32x4 qa = *(const LAS f32x4*)(qs + r * 64 + d8 * 8), qb = *(const LAS f32x4*)(qs + r * 64 + d8 * 8 + 4);
                            s[r] += qa.x * kf[0] + qa.y * kf[1] + qa.z * kf[2] + qa.w * kf[3] + qb.x * kf[4] + qb.y * kf[5] + qb.z * kf[6] + qb.w * kf[7]; } }
#pragma unroll
                    for (int r = 0; r < 4; ++r) { s[r] *= QSCALE; mx[r] = fmaxf(mx[r], s[r]); }
                    *(LAS f32x4*)(sc + n * 4) = (f32x4){s[0], s[1], s[2], s[3]}; } }
            float l[4] = {0.f, 0.f, 0.f, 0.f};
#pragma unroll
            for (int r = 0; r < 4; ++r) mx[r] = wave_max(mx[r], lane);
            LDS_WAIT();
            for (int c = 0; c * 64 < nv; ++c) { const int n = c * 64 + lane;
                if (n < nv) { f32x4 s = *(const LAS f32x4*)(sc + n * 4);
#pragma unroll
                    for (int r = 0; r < 4; ++r) { s[r] = __expf(s[r] - mx[r]); l[r] += s[r]; }
                    *(LAS f32x4*)(sc + n * 4) = s; } }
#pragma unroll
            for (int r = 0; r < 4; ++r) l[r] = 1.f / wave_sum(l[r], lane);
            LDS_WAIT();
            for (int c = 0; c * 64 < nv; ++c) { const int n = c * 64 + lane;
                if (n < nv) { f32x4 s = *(const LAS f32x4*)(sc + n * 4);
#pragma unroll
                    for (int r = 0; r < 4; ++r) s[r] *= l[r];
                    *(LAS f32x4*)(sc + n * 4) = s; } }
            LDS_WAIT();
#pragma unroll 4
            for (int n = 0; n < nv; ++n) { const float v = bf2f(vc[(size_t)n * 64 + lane]); const f32x4 p = *(const LAS f32x4*)(sc + n * 4);
#pragma unroll
                for (int r = 0; r < 4; ++r) oc[r] += p[r] * v; }
#pragma unroll
            for (int i = 0; i < 4; ++i) { const int j = lane + 64 * i; float acc = 0.f;
#pragma unroll
                for (int k = -1; k <= 3; ++k) { const int n = 4 * j + k; if (n >= 0 && n < nv) { const f32x4 p = *(const LAS f32x4*)(sc + n * 4); const float ps = (p.x + p.y) + (p.z + p.w); acc += (k == -1 || k == 3) ? 0.5f * ps : ps; } }
                impv[i] = acc; }
        }
        float scv[4];
#pragma unroll
        for (int i = 0; i < 4; ++i) { const int j = lane + 64 * i; scv[i] = j > cur ? -1.f : ((j == 0 || j == cur || j == cur - 1) ? 1e9f : impv[i]); }
        LAS int* sel = (LAS int*)(F.lds + MISC_OFF + 256) + F.wave * 16;
#pragma unroll 1
        for (int k = 0; k < NSEL; ++k) {
            float bv = -2.f; int bi = 1 << 20;
#pragma unroll
            for (int i = 0; i < 4; ++i) { const int j = lane + 64 * i; if (scv[i] > bv) { bv = scv[i]; bi = j; } }
#pragma unroll
            for (int o = 1; o < 64; o <<= 1) { const float ov = shx(bv, o, lane); const int oi = shxi(bi, o, lane); if (ov > bv || (ov == bv && oi < bi)) { bv = ov; bi = oi; } }
            if (lane == 0) sel[k] = bi;
#pragma unroll
            for (int i = 0; i < 4; ++i) if (lane + 64 * i == bi) scv[i] = -3.f;
        }
        LDS_WAIT();
        {   const bf16_t* ks = KS + (size_t)bg * SEQ * 64; const bf16_t* vs = VS + (size_t)bg * SEQ * 64;
            float mx[4] = {-3.0e38f, -3.0e38f, -3.0e38f, -3.0e38f};
#pragma unroll 1
            for (int k = 0; k < NSEL; ++k) { const int pos = sel[k] * 64 + lane; const bool ok = pos <= t;
                float s[4] = {-1e30f, -1e30f, -1e30f, -1e30f};
                if (ok) { LAS float* qr = qr_; asm volatile("" : "+v"(qr));
#pragma unroll
                    for (int r = 0; r < 4; ++r) s[r] = 0.f;
#pragma unroll 2
                    for (int d8 = 0; d8 < 8; ++d8) { const u32x4 w = *(const u32x4*)(ks + (size_t)pos * 64 + d8 * 8);
                        const float kf[8] = {bflo(w.x), bfhi(w.x), bflo(w.y), bfhi(w.y), bflo(w.z), bfhi(w.z), bflo(w.w), bfhi(w.w)};
#pragma unroll
                        for (int r = 0; r < 4; ++r) { const f32x4 qa = *(const LAS f32x4*)(qr + r * 64 + d8 * 8), qb = *(const LAS f32x4*)(qr + r * 64 + d8 * 8 + 4);
                            s[r] += qa.x * kf[0] + qa.y * kf[1] + qa.z * kf[2] + qa.w * kf[3] + qb.x * kf[4] + qb.y * kf[5] + qb.z * kf[6] + qb.w * kf[7]; } }
#pragma unroll
                    for (int r = 0; r < 4; ++r) { s[r] *= QSCALE; mx[r] = fmaxf(mx[r], s[r]); } }
                *(LAS f32x4*)(sc + (k * 64 + lane) * 4) = (f32x4){s[0], s[1], s[2], s[3]}; }
            float l[4] = {0.f, 0.f, 0.f, 0.f};
#pragma unroll
            for (int r = 0; r < 4; ++r) mx[r] = wave_max(mx[r], lane);
            LDS_WAIT();
#pragma unroll 1
            for (int k = 0; k < NSEL; ++k) { const int pos = sel[k] * 64 + lane; const bool ok = pos <= t; f32x4 s = *(const LAS f32x4*)(sc + (k * 64 + lane) * 4);
#pragma unroll
                for (int r = 0; r < 4; ++r) { s[r] = ok ? __expf(s[r] - mx[r]) : 0.f; l[r] += s[r]; }
                *(LAS f32x4*)(sc + (k * 64 + lane) * 4) = s; }
#pragma unroll
            for (int r = 0; r < 4; ++r) l[r] = 1.f / wave_sum(l[r], lane);
            LDS_WAIT();
#pragma unroll 1
            for (int k = 0; k < NSEL; ++k) { const int p0 = sel[k] * 64; if (p0 > t) continue;
#pragma unroll 4
                for (int i = 0; i < 64; ++i) { const int pos = p0 + i; if (pos > t) break; const float v = bf2f(vs[(size_t)pos * 64 + lane]); const f32x4 p = *(const LAS f32x4*)(sc + (k * 64 + i) * 4);
#pragma unroll
                    for (int r = 0; r < 4; ++r) os[r] += p[r] * v; } }
#pragma unroll
            for (int r = 0; r < 4; ++r) os[r] *= l[r];
            LDS_WAIT();
        }
        {   const bf16_t* kw = KW + (size_t)bg * SEQ * 64; const bf16_t* vw = VW + (size_t)bg * SEQ * 64;
            float mx[4] = {-3.0e38f, -3.0e38f, -3.0e38f, -3.0e38f};
#pragma unroll 1
            for (int c = 0; c < 8; ++c) { const int pos = t - 511 + c * 64 + lane; const bool ok = pos >= 0;
                float s[4] = {-1e30f, -1e30f, -1e30f, -1e30f};
                if (ok) { LAS float* qr = qr_; asm volatile("" : "+v"(qr));
#pragma unroll
                    for (int r = 0; r < 4; ++r) s[r] = 0.f;
#pragma unroll 2
                    for (int d8 = 0; d8 < 8; ++d8) { const u32x4 w = *(const u32x4*)(kw + (size_t)pos * 64 + d8 * 8);
                        const float kf[8] = {bflo(w.x), bfhi(w.x), bflo(w.y), bfhi(w.y), bflo(w.z), bfhi(w.z), bflo(w.w), bfhi(w.w)};
#pragma unroll
                        for (int r = 0; r < 4; ++r) { const f32x4 qa = *(const LAS f32x4*)(qr + r * 64 + d8 * 8), qb = *(const LAS f32x4*)(qr + r * 64 + d8 * 8 + 4);
                            s[r] += qa.x * kf[0] + qa.y * kf[1] + qa.z * kf[2] + qa.w * kf[3] + qb.x * kf[4] + qb.y * kf[5] + qb.z * kf[6] + qb.w * kf[7]; } }
#pragma unroll
                    for (int r = 0; r < 4; ++r) { s[r] *= QSCALE; mx[r] = fmaxf(mx[r], s[r]); } }
                *(LAS f32x4*)(sc + (c * 64 + lane) * 4) = (f32x4){s[0], s[1], s[2], s[3]}; }
            float l[4] = {0.f, 0.f, 0.f, 0.f};
#pragma unroll
            for (int r = 0; r < 4; ++r) mx[r] = wave_max(mx[r], lane);
            LDS_WAIT();
#pragma unroll 1
            for (int c = 0; c < 8; ++c) { const int pos = t - 511 + c * 64 + lane; const bool ok = pos >= 0; f32x4 s = *(const LAS f32x4*)(sc + (c * 64 + lane) * 4);
#pragma unroll
                for (int r = 0; r < 4; ++r) { s[r] = ok ? __expf(s[r] - mx[r]) : 0.f; l[r] += s[r]; }
                *(LAS f32x4*)(sc + (c * 64 + lane) * 4) = s; }
#pragma unroll
            for (int r = 0; r < 4; ++r) l[r] = 1.f / wave_sum(l[r], lane);
            LDS_WAIT();
#pragma unroll 4
            for (int i = (t >= 511 ? 0 : 511 - t); i < 512; ++i) { const int pos = t - 511 + i; const float v = bf2f(vw[(size_t)pos * 64 + lane]); const f32x4 p = *(const LAS f32x4*)(sc + i * 4);
#pragma unroll
                for (int r = 0; r < 4; ++r) ow[r] += p[r] * v; }
#pragma unroll
            for (int r = 0; r < 4; ++r) ow[r] *= l[r];
            LDS_WAIT();
        }
#pragma unroll
        for (int r = 0; r < 4; ++r) { const float gc = GT[(size_t)tok * 48 + 0 * 16 + g * 4 + r], gs = GT[(size_t)tok * 48 + 1 * 16 + g * 4 + r], gwv = GT[(size_t)tok * 48 + 2 * 16 + g * 4 + r];
            const float o = ((DBG_DROP & 1) ? 0.f : gc * oc[r]) + ((DBG_DROP & 2) ? 0.f : gs * os[r]) + ((DBG_DROP & 4) ? 0.f : gwv * ow[r]);
            ATT[(size_t)tok * DM + g * 256 + r * 64 + lane] = (bf16_t)f2bf(o); }
    }
}

DEVI void phase_swa_naive(Frame& F, const float* sinks) {
    F.refresh();
    unsigned char* ws = F.ws;
    const bf16_t* Q = (const bf16_t*)(ws + RA_Q); bf16_t* ATT = (bf16_t*)(ws + RA_ATT);
    const bf16_t* KS = (const bf16_t*)(ws + WS_KSH); const bf16_t* VS = (const bf16_t*)(ws + WS_VSH);
    LAS float* sc = (LAS float*)(F.lds + F.wave * 16384);
    LAS float* qs_ = (LAS float*)(F.lds + LDS_X + F.wave * 2048);
    const int lane = F.lane;
    const int gw = F.vcu * NWAVES + F.wave, NGW = F.G * NWAVES;
    for (int u = gw; u < MTOK * B_G; u += NGW) {
        const int bg = u / SEQ, t = u % SEQ, b = bg / B_G, g = bg % B_G; const int tok = b * SEQ + t;
        { const u32x4 w = *(const u32x4*)(Q + (size_t)tok * DM + g * 512 + lane * 8);
          const float x[8] = {bflo(w.x), bfhi(w.x), bflo(w.y), bfhi(w.y), bflo(w.z), bfhi(w.z), bflo(w.w), bfhi(w.w)};
#pragma unroll
          for (int i = 0; i < 8; ++i) qs_[lane * 8 + i] = x[i];
          LDS_WAIT(); }
        const bf16_t* kp = KS + (size_t)bg * SEQ * 64; const bf16_t* vp = VS + (size_t)bg * SEQ * 64;
        float mx[8], l[8], o[8];
#pragma unroll
        for (int r = 0; r < 8; ++r) { mx[r] = sinks[g * 8 + r]; l[r] = 0.f; o[r] = 0.f; }
#pragma unroll 1
        for (int c = 0; c < 2; ++c) { const int pos = t - 127 + c * 64 + lane; const bool ok = pos >= 0;
            float s[8];
#pragma unroll
            for (int r = 0; r < 8; ++r) s[r] = -1e30f;
            if (ok) { LAS float* qs = qs_; asm volatile("" : "+v"(qs));
#pragma unroll
                for (int r = 0; r < 8; ++r) s[r] = 0.f;
#pragma unroll 1
                for (int d8 = 0; d8 < 8; ++d8) { const u32x4 w = *(const u32x4*)(kp + (size_t)pos * 64 + d8 * 8);
                    const float kf[8] = {bflo(w.x), bfhi(w.x), bflo(w.y), bfhi(w.y), bflo(w.z), bfhi(w.z), bflo(w.w), bfhi(w.w)};
#pragma unroll
                    for (int r = 0; r < 8; ++r) { const f32x4 qa = *(const LAS f32x4*)(qs + r * 64 + d8 * 8), qb = *(const LAS f32x4*)(qs + r * 64 + d8 * 8 + 4);
                        s[r] += qa.x * kf[0] + qa.y * kf[1] + qa.z * kf[2] + qa.w * kf[3] + qb.x * kf[4] + qb.y * kf[5] + qb.z * kf[6] + qb.w * kf[7]; } }
#pragma unroll
                for (int r = 0; r < 8; ++r) { s[r] *= QSCALE; mx[r] = fmaxf(mx[r], s[r]); } }
            *(LAS f32x4*)(sc + (c * 64 + lane) * 8) = (f32x4){s[0], s[1], s[2], s[3]}; *(LAS f32x4*)(sc + (c * 64 + lane) * 8 + 4) = (f32x4){s[4], s[5], s[6], s[7]}; }
#pragma unroll
        for (int r = 0; r < 8; ++r) mx[r] = wave_max(mx[r], lane);
        LDS_WAIT();
#pragma unroll
        for (int c = 0; c < 2; ++c) { const int pos = t - 127 + c * 64 + lane; const bool ok = pos >= 0;
            f32x4 s0 = *(const LAS f32x4*)(sc + (c * 64 + lane) * 8), s1 = *(const LAS f32x4*)(sc + (c * 64 + lane) * 8 + 4);
#pragma unroll
            for (int r = 0; r < 4; ++r) { s0[r] = ok ? __expf(s0[r] - mx[r]) : 0.f; l[r] += s0[r]; s1[r] = ok ? __expf(s1[r] - mx[r + 4]) : 0.f; l[r + 4] += s1[r]; }
            *(LAS f32x4*)(sc + (c * 64 + lane) * 8) = s0; *(LAS f32x4*)(sc + (c * 64 + lane) * 8 + 4) = s1; }
#pragma unroll
        for (int r = 0; r < 8; ++r) l[r] = 1.f / (wave_sum(l[r], lane) + __expf(sinks[g * 8 + r] - mx[r]));
        LDS_WAIT();
#pragma unroll 4
        for (int i = (t >= 127 ? 0 : 127 - t); i < 128; ++i) { const int pos = t - 127 + i; const float v = bf2f(vp[(size_t)pos * 64 + lane]);
            const f32x4 p0 = *(const LAS f32x4*)(sc + i * 8), p1 = *(const LAS f32x4*)(sc + i * 8 + 4);
#pragma unroll
            for (int r = 0; r < 4; ++r) { o[r] += p0[r] * v; o[r + 4] += p1[r] * v; } }
#pragma unroll
        for (int r = 0; r < 8; ++r) ATT[(size_t)tok * DM + g * 512 + r * 64 + lane] = (bf16_t)f2bf(o[r] * l[r]);
        LDS_WAIT();
    }
}

namespace fa {
typedef short v4i16_t __attribute__((ext_vector_type(4)));
constexpr float CEXP = 0.125f * 1.4426950408889634f;
constexpr float NEGINF = -__builtin_huge_valf();
constexpr int VLD = 160;
constexpr int KVB = 8192 + 64 * VLD;
constexpr int L_KV = 0;
constexpr int L_IMP = 2 * KVB;
constexpr int IMP_LD = 264;
constexpr int OS_LD = 65;
constexpr int L_Q = L_IMP + 64 * IMP_LD * 4;
constexpr int L_ML = L_Q + 32768;
constexpr int L_MASK = L_ML + 2048;
constexpr int L_LIST = L_MASK + 2048;
constexpr int L_TOK = L_LIST + 1056;
constexpr int L_END = L_TOK + 2048;
static_assert(256 * OS_LD * 4 <= 64 * IMP_LD * 4, "accumulator fits the importance table");
static_assert(L_END <= MISC_OFF, "attention LDS map");

struct Stage { u32x4 k, v; };
template <bool WITHV> DEVI void stage_load(Stage& s, const bf16_t* K, const bf16_t* V, int tid) { s.k = *(const u32x4*)((const char*)K + tid * 16); if (WITHV) s.v = *(const u32x4*)((const char*)V + tid * 16); }
template <bool WITHV> DEVI void stage_write(const Stage& s, LAS unsigned char* buf, int tid) {
    const int r = tid >> 3, c = tid & 7;
    *(LAS u32x4*)(buf + r * 128 + ((c ^ (r & 7)) << 4)) = s.k;
    if (WITHV) *(LAS u32x4*)(buf + 8192 + r * VLD + (c << 4)) = s.v;
}
DEVI float max_quads(float x) {
    auto a = __builtin_amdgcn_permlane16_swap(__float_as_uint(x), __float_as_uint(x), false, false); x = fmaxf(__uint_as_float(a[0]), __uint_as_float(a[1]));
    auto b = __builtin_amdgcn_permlane32_swap(__float_as_uint(x), __float_as_uint(x), false, false); return fmaxf(__uint_as_float(b[0]), __uint_as_float(b[1]));
}
DEVI float sum_quads(float x) {
    auto a = __builtin_amdgcn_permlane16_swap(__float_as_uint(x), __float_as_uint(x), false, false); x = __uint_as_float(a[0]) + __uint_as_float(a[1]);
    auto b = __builtin_amdgcn_permlane32_swap(__float_as_uint(x), __float_as_uint(x), false, false); return __uint_as_float(b[0]) + __uint_as_float(b[1]);
}
template <int CTRL> DEVI float dppf(float v) { return __int_as_float(__builtin_amdgcn_update_dpp(0, __float_as_int(v), CTRL, 0xF, 0xF, false)); }
template <int CTRL> DEVI int dppi(int v) { return __builtin_amdgcn_update_dpp(0, v, CTRL, 0xF, 0xF, false); }
DEVI float bperm(float v, int src_lane) { return __builtin_bit_cast(float, __builtin_amdgcn_ds_bpermute(src_lane << 2, __builtin_bit_cast(int, v))); }
#define DPP_X1 0xB1
#define DPP_X2 0x4E
#define DPP_HM 0x141

DEVI void qk_slot(LAS const unsigned char* kb, const bf16x8 q0, const bf16x8 q1, int lane, f32x4 (&s)[4]) {
    const int l15 = lane & 15, quad = lane >> 4;
    LAS const unsigned char* p0 = kb + l15 * 128 + (((quad) ^ (l15 & 7)) << 4);
    LAS const unsigned char* p1 = kb + l15 * 128 + (((4 + quad) ^ (l15 & 7)) << 4);
#pragma unroll
    for (int kg = 0; kg < 4; ++kg) {
        const bf16x8 a0 = *(LAS const bf16x8*)(p0 + kg * 2048), a1 = *(LAS const bf16x8*)(p1 + kg * 2048);
        f32x4 z = {0.f, 0.f, 0.f, 0.f};
        z = __builtin_amdgcn_mfma_f32_16x16x32_bf16(a0, q0, z, 0, 0, 0);
        s[kg] = __builtin_amdgcn_mfma_f32_16x16x32_bf16(a1, q1, z, 0, 0, 0);
    }
}
DEVI float mask_max(f32x4 (&s)[4], int lo, int hi, int quad) {
    float mx = NEGINF; const int loq = lo - 4 * quad, hiq = hi - 4 * quad;
#pragma unroll
    for (int kg = 0; kg < 4; ++kg)
#pragma unroll
        for (int i = 0; i < 4; ++i) { const bool ok = (16 * kg + i >= loq) & (16 * kg + i <= hiq); s[kg][i] = ok ? s[kg][i] : NEGINF; mx = fmaxf(mx, s[kg][i]); }
    return max_quads(mx);
}
DEVI bf16x8 pack_p(const f32x4 a, const f32x4 b) { u32x4 w; w.x = pg8::cvt_pk_bf16(a[0], a[1]); w.y = pg8::cvt_pk_bf16(a[2], a[3]); w.z = pg8::cvt_pk_bf16(b[0], b[1]); w.w = pg8::cvt_pk_bf16(b[2], b[3]); return __builtin_bit_cast(bf16x8, w); }
DEVI void pv_slot(LAS const unsigned char* vb, const bf16x8 (&pb)[2], f32x4 (&o)[4], int lane) {
    const int i = lane & 15, quad = lane >> 4;
    LAS const unsigned char* a0 = vb + (4 * quad + (i >> 2)) * VLD + ((i & 3) << 3);
#pragma unroll
    for (int ks2 = 0; ks2 < 2; ++ks2) {
#pragma unroll
        for (int dg = 0; dg < 4; ++dg) {
            const v4i16_t t0 = __builtin_amdgcn_ds_read_tr16_b64_v4i16((LAS v4i16_t*)(a0 + (32 * ks2) * VLD + 32 * dg));
            const v4i16_t t1 = __builtin_amdgcn_ds_read_tr16_b64_v4i16((LAS v4i16_t*)(a0 + (32 * ks2 + 16) * VLD + 32 * dg));
            const bf16x8 a = {t0[0], t0[1], t0[2], t0[3], t1[0], t1[1], t1[2], t1[3]};
            o[dg] = __builtin_amdgcn_mfma_f32_16x16x32_bf16(a, pb[ks2], o[dg], 0, 0, 0);
        }
    }
}
template <bool PV> DEVI void online_step(LAS const unsigned char* buf, const bf16x8 q0, const bf16x8 q1, int lo, int hi, float& m, float& l, f32x4 (&o)[4], int lane) {
    __builtin_amdgcn_sched_barrier(0);
    f32x4 s[4]; qk_slot(buf, q0, q1, lane, s);
    __builtin_amdgcn_sched_barrier(0);
    const int quad = lane >> 4;
    float mx;
    if (__builtin_amdgcn_ballot_w64((lo > 0) | (hi < 63)) != 0ull) mx = mask_max(s, lo, hi, quad);
    else { float a = fmaxf(fmaxf(s[0][0], s[0][1]), fmaxf(s[0][2], s[0][3])), b = fmaxf(fmaxf(s[1][0], s[1][1]), fmaxf(s[1][2], s[1][3]));
           a = fmaxf(a, fmaxf(fmaxf(s[2][0], s[2][1]), fmaxf(s[2][2], s[2][3]))); b = fmaxf(b, fmaxf(fmaxf(s[3][0], s[3][1]), fmaxf(s[3][2], s[3][3]))); mx = max_quads(fmaxf(a, b)); }
    const float mnew = fmaxf(m, mx);
    const float msafe = (mnew == NEGINF) ? 0.f : mnew;
    const float alpha = __builtin_amdgcn_exp2f((m - msafe) * CEXP);
    const float mc = -msafe * CEXP;
    float ps = 0.f;
#pragma unroll
    for (int kg = 0; kg < 4; ++kg)
#pragma unroll
        for (int i = 0; i < 4; ++i) { s[kg][i] = __builtin_amdgcn_exp2f(__builtin_fmaf(s[kg][i], CEXP, mc)); ps += s[kg][i]; }
    l = l * alpha + ps; m = mnew;
    if (PV) {
        if (__builtin_amdgcn_ballot_w64(alpha != 1.f) != 0ull) {
#pragma unroll
            for (int dg = 0; dg < 4; ++dg) o[dg] = o[dg] * alpha;
        }
        bf16x8 pb[2]; pb[0] = pack_p(s[0], s[1]); pb[1] = pack_p(s[2], s[3]);
        pv_slot(buf + 8192, pb, o, lane);
    }
    __builtin_amdgcn_sched_barrier(0);
}
DEVI void load_q(const bf16_t* Q, size_t tok, int hcol, int quad, bf16x8 (&qf)[2]) {
    const bf16_t* p = Q + tok * DM + hcol + quad * 8;
    qf[0] = *(const bf16x8*)p; qf[1] = *(const bf16x8*)(p + 32);
}
DEVI bf16x8 rope_frag(const bf16x8 q, const float* csrow, int quad, int lane) {
    const u32x4 w = __builtin_bit_cast(u32x4, q); u32x4 pw;
#pragma unroll
    for (int i = 0; i < 4; ++i) pw[i] = (unsigned)shxi((int)w[i], 16, lane);
    if (quad >= 2) return q;
    const f32x4 c0 = *(const f32x4*)csrow, c1 = *(const f32x4*)(csrow + 4), s0 = *(const f32x4*)(csrow + 8), s1 = *(const f32x4*)(csrow + 12);
    const float sg = quad == 0 ? -1.f : 1.f;
    float x[8], xp[8];
#pragma unroll
    for (int i = 0; i < 4; ++i) { x[2 * i] = bflo(w[i]); x[2 * i + 1] = bfhi(w[i]); xp[2 * i] = bflo(pw[i]); xp[2 * i + 1] = bfhi(pw[i]); }
    const float cc[8] = {c0[0], c0[1], c0[2], c0[3], c1[0], c1[1], c1[2], c1[3]}, ss[8] = {s0[0], s0[1], s0[2], s0[3], s1[0], s1[1], s1[2], s1[3]};
    u32x4 o;
#pragma unroll
    for (int i = 0; i < 4; ++i) o[i] = pg8::cvt_pk_bf16(x[2 * i] * cc[2 * i] + sg * xp[2 * i] * ss[2 * i], x[2 * i + 1] * cc[2 * i + 1] + sg * xp[2 * i + 1] * ss[2 * i + 1]);
    return __builtin_bit_cast(bf16x8, o);
}

struct KFr { bf16x8 k[4][2]; };
struct VFr { bf16x8 v[4][2]; };
constexpr float LSCALE = 1048576.f;
template <int OFF> DEVI void gld16(bf16x8& d, const void* p) { asm volatile("global_load_dwordx4 %0, %1, off offset:%2" : "=v"(d) : "v"(p), "n"(OFF) : "memory"); }
DEVI void sel_load_k(KFr& f, const bf16_t* KS, int j, int lane) {
    const int l15 = lane & 15, quad = lane >> 4;
    const bf16_t* p0 = KS + ((size_t)(64 * j + l15)) * 64 + 8 * quad;
    const bf16_t* p1 = p0 + 32 * 64;
    gld16<0>(f.k[0][0], p0); gld16<64>(f.k[0][1], p0); gld16<2048>(f.k[1][0], p0); gld16<2112>(f.k[1][1], p0);
    gld16<0>(f.k[2][0], p1); gld16<64>(f.k[2][1], p1); gld16<2048>(f.k[3][0], p1); gld16<2112>(f.k[3][1], p1);
}
DEVI void sel_load_v(VFr& f, const bf16_t* VT, int j, int lane) {
    const int l15 = lane & 15, quad = lane >> 4;
    const bf16_t* p = VT + (size_t)j * 4096 + l15 * 64 + 8 * quad;
    gld16<0>(f.v[0][0], p); gld16<64>(f.v[0][1], p); gld16<2048>(f.v[1][0], p); gld16<2112>(f.v[1][1], p);
    const bf16_t* p1 = p + 32 * 64;
    gld16<0>(f.v[2][0], p1); gld16<64>(f.v[2][1], p1); gld16<2048>(f.v[3][0], p1); gld16<2112>(f.v[3][1], p1);
}
template <int N> DEVI void sel_wait_k(KFr& f) {
    asm volatile("s_waitcnt vmcnt(%8)" : "+v"(f.k[0][0]), "+v"(f.k[0][1]), "+v"(f.k[1][0]), "+v"(f.k[1][1]), "+v"(f.k[2][0]), "+v"(f.k[2][1]), "+v"(f.k[3][0]), "+v"(f.k[3][1]) : "n"(N) : "memory");
    __builtin_amdgcn_sched_barrier(0);
}
template <int N> DEVI void sel_wait_kv(KFr& f, VFr& g) {
    asm volatile("s_waitcnt vmcnt(%16)" : "+v"(f.k[0][0]), "+v"(f.k[0][1]), "+v"(f.k[1][0]), "+v"(f.k[1][1]), "+v"(f.k[2][0]), "+v"(f.k[2][1]), "+v"(f.k[3][0]), "+v"(f.k[3][1]),
                 "+v"(g.v[0][0]), "+v"(g.v[0][1]), "+v"(g.v[1][0]), "+v"(g.v[1][1]), "+v"(g.v[2][0]), "+v"(g.v[2][1]), "+v"(g.v[3][0]), "+v"(g.v[3][1]) : "n"(N) : "memory");
    __builtin_amdgcn_sched_barrier(0);
}
template <bool PASS2> DEVI void sel_block(const KFr& f, const VFr& fv, int j, bool active, int cur, LAS const unsigned* smask, LAS const unsigned char* Ql, LAS float* mrow, LAS int* lrow, LAS int* Os, float lg2k, float lratio, LAS int* tlist, int lane) {
    const int l15 = lane & 15, quad = lane >> 4, mem = l15 >> 2;
    const bool forced = (j == 0) || (j >= cur - 1);
    int cnt = 0;
    if (active) {
        if (forced) cnt = 64;
        else { const unsigned lo = (unsigned)__builtin_amdgcn_readfirstlane((int)smask[2 * j]), hi = (unsigned)__builtin_amdgcn_readfirstlane((int)smask[2 * j + 1]);
            const unsigned long long mk = ((unsigned long long)hi << 32) | lo;
            cnt = __builtin_popcountll(mk);
            const bool mine = (mk >> lane) & 1ull; const int rank = __builtin_popcountll(mk & ((1ull << lane) - 1ull));
            if (mine) tlist[rank] = lane;
            LDS_WAIT(); }
    }
    const int ngroups = (cnt + 3) >> 2;
    const bool diag = (j == cur);
#pragma unroll 1
    for (int gi = 0; gi < ngroups; ++gi) {
        const int slot = 4 * gi + mem;
        const bool valid = slot < cnt;
        int mt = forced ? slot : tlist[slot];
        mt = valid ? mt : 0;
        const int row = mt * 4 + (l15 & 3);
        const bf16x8 q0 = *(LAS const bf16x8*)(Ql + row * 128 + ((quad ^ (row & 7)) << 4));
        const bf16x8 q1 = *(LAS const bf16x8*)(Ql + row * 128 + (((4 + quad) ^ (row & 7)) << 4));
        f32x4 sc[4];
#pragma unroll
        for (int kg = 0; kg < 4; ++kg) { f32x4 z = {0.f, 0.f, 0.f, 0.f}; z = __builtin_amdgcn_mfma_f32_16x16x32_bf16(f.k[kg][0], q0, z, 0, 0, 0); sc[kg] = __builtin_amdgcn_mfma_f32_16x16x32_bf16(f.k[kg][1], q1, z, 0, 0, 0); }
        if (!PASS2) {
            float mx;
            if (diag) mx = mask_max(sc, 0, mt, quad);
            else { float a = fmaxf(fmaxf(sc[0][0], sc[0][1]), fmaxf(sc[0][2], sc[0][3])), b = fmaxf(fmaxf(sc[1][0], sc[1][1]), fmaxf(sc[1][2], sc[1][3]));
                   a = fmaxf(a, fmaxf(fmaxf(sc[2][0], sc[2][1]), fmaxf(sc[2][2], sc[2][3]))); b = fmaxf(b, fmaxf(fmaxf(sc[3][0], sc[3][1]), fmaxf(sc[3][2], sc[3][3]))); mx = max_quads(fmaxf(a, b)); }
            if (quad == 0 && valid) __hip_atomic_fetch_max(mrow + row, mx, __ATOMIC_RELAXED, __HIP_MEMORY_SCOPE_WORKGROUP);
        } else {
            const float mc = lg2k - mrow[row] * CEXP;
            float ps = 0.f;
            if (diag) { const int hiq = mt - 4 * quad;
#pragma unroll
                for (int kg = 0; kg < 4; ++kg)
#pragma unroll
                    for (int i = 0; i < 4; ++i) { sc[kg][i] = (16 * kg + i <= hiq) ? __builtin_amdgcn_exp2f(__builtin_fmaf(sc[kg][i], CEXP, mc)) : 0.f; ps += sc[kg][i]; }
            } else {
#pragma unroll
                for (int kg = 0; kg < 4; ++kg)
#pragma unroll
                    for (int i = 0; i < 4; ++i) { sc[kg][i] = __builtin_amdgcn_exp2f(__builtin_fmaf(sc[kg][i], CEXP, mc)); ps += sc[kg][i]; }
            }
            ps = sum_quads(ps);
            if (quad == 0 && valid) __hip_atomic_fetch_add(lrow + row, (int)(ps * lratio), __ATOMIC_RELAXED, __HIP_MEMORY_SCOPE_WORKGROUP);
            bf16x8 pb[2]; pb[0] = pack_p(sc[0], sc[1]); pb[1] = pack_p(sc[2], sc[3]);
            LAS int* orow = Os + row * OS_LD + 4 * quad;
#pragma unroll
            for (int dh = 0; dh < 2; ++dh) {
                f32x4 o[2];
#pragma unroll
                for (int d2 = 0; d2 < 2; ++d2) { const int dg = dh * 2 + d2; f32x4 z = {0.f, 0.f, 0.f, 0.f}; z = __builtin_amdgcn_mfma_f32_16x16x32_bf16(fv.v[dg][0], pb[0], z, 0, 0, 0); o[d2] = __builtin_amdgcn_mfma_f32_16x16x32_bf16(fv.v[dg][1], pb[1], z, 0, 0, 0); }
                if (valid) {
#pragma unroll
                    for (int d2 = 0; d2 < 2; ++d2)
#pragma unroll
                        for (int c = 0; c < 4; ++c) __hip_atomic_fetch_add(orow + 16 * (dh * 2 + d2) + c, (int)o[d2][c], __ATOMIC_RELAXED, __HIP_MEMORY_SCOPE_WORKGROUP);
                }
                __builtin_amdgcn_sched_barrier(0);
            }
        }
    }
}
#define BL(i) __builtin_amdgcn_readfirstlane(blist[(i) < nb ? (i) : nb - 1])
DEVI void sel_pass1(const bf16_t* KS, int nb, int cur, int wave, LAS const int* blist, LAS const unsigned* smask, LAS const unsigned char* Ql, LAS float* mrow, LAS int* tlist, int lane) {
    if (wave >= nb) return;
    KFr k0, k1, k2; VFr vdummy;
    asm volatile("s_waitcnt vmcnt(0)" ::: "memory");
    sel_load_k(k0, KS, BL(wave), lane);
    sel_load_k(k1, KS, BL(wave + 8), lane);
#pragma unroll 1
    for (int bi = wave; bi < nb; bi += 24) {
        sel_load_k(k2, KS, BL(bi + 16), lane); sel_wait_k<16>(k0);
        sel_block<false>(k0, vdummy, BL(bi), true, cur, smask, Ql, mrow, nullptr, nullptr, 0.f, 0.f, tlist, lane);
        sel_load_k(k0, KS, BL(bi + 24), lane); sel_wait_k<16>(k1);
        sel_block<false>(k1, vdummy, BL(bi + 8), bi + 8 < nb, cur, smask, Ql, mrow, nullptr, nullptr, 0.f, 0.f, tlist, lane);
        sel_load_k(k1, KS, BL(bi + 32), lane); sel_wait_k<16>(k2);
        sel_block<false>(k2, vdummy, BL(bi + 16), bi + 16 < nb, cur, smask, Ql, mrow, nullptr, nullptr, 0.f, 0.f, tlist, lane);
    }
    asm volatile("s_waitcnt vmcnt(0)" ::: "memory");
}
DEVI void sel_pass2(const bf16_t* KS, const bf16_t* VT, int nb, int cur, int wave, LAS const int* blist, LAS const unsigned* smask, LAS const unsigned char* Ql, LAS float* mrow, LAS int* lrow, LAS int* Os, float lg2k, float lratio, LAS int* tlist, int lane) {
    if (wave >= nb) return;
    KFr ka_, kb_; VFr va_, vb_;
    asm volatile("s_waitcnt vmcnt(0)" ::: "memory");
    sel_load_k(ka_, KS, BL(wave), lane); sel_load_v(va_, VT, BL(wave), lane);
#pragma unroll 1
    for (int bi = wave; bi < nb; bi += 16) {
        sel_load_k(kb_, KS, BL(bi + 8), lane); sel_load_v(vb_, VT, BL(bi + 8), lane); sel_wait_kv<16>(ka_, va_);
        sel_block<true>(ka_, va_, BL(bi), true, cur, smask, Ql, mrow, lrow, Os, lg2k, lratio, tlist, lane);
        sel_load_k(ka_, KS, BL(bi + 16), lane); sel_load_v(va_, VT, BL(bi + 16), lane); sel_wait_kv<16>(kb_, vb_);
        sel_block<true>(kb_, vb_, BL(bi + 8), bi + 8 < nb, cur, smask, Ql, mrow, lrow, Os, lg2k, lratio, tlist, lane);
    }
    asm volatile("s_waitcnt vmcnt(0)" ::: "memory");
}
#undef BL
}


DEVI void phase_vs_transpose(Frame& F, int l) {
    F.refresh();
    unsigned char* ws = F.ws;
    const bf16_t* VS = (const bf16_t*)(ws + RA_VS); bf16_t* VT = (bf16_t*)(ws + RA_VST);
    LAS unsigned short* T = (LAS unsigned short*)F.lds;
    const int tid = F.tid, r = tid >> 3, c = tid & 7;
    for (int it = (int)blockIdx.x - 64; it < 2048; it += 192) {
        const int bg = it >> 8, tile = it & 255;
        const u32x4 v = *(const u32x4*)(VS + ((size_t)bg * SEQ + tile * 64 + r) * 64 + c * 8);
        { float mx = 0.f;
#pragma unroll
          for (int e = 0; e < 4; ++e) mx = fmaxf(mx, fmaxf(fabsf(bflo(v[e])), fabsf(bfhi(v[e]))));
          mx = wave_max(mx, F.lane);
          if (F.lane == 0) atomicMax((unsigned*)(ws + WS_CTL) + CW_VMAX + l * 8 + bg, __float_as_uint(mx)); }
        *(LAS u32x4*)(T + r * 72 + c * 8) = v;
        __syncthreads();
        u32x4 w;
#pragma unroll
        for (int e = 0; e < 4; ++e) { const int k0 = 32 * (c >> 2) + 16 * ((2 * e) >> 2) + 4 * (c & 3) + ((2 * e) & 3);
            w[e] = (unsigned)T[k0 * 72 + r] | ((unsigned)T[(k0 + 1) * 72 + r] << 16); }
        *(u32x4*)(VT + ((size_t)bg * 256 + tile) * 4096 + r * 64 + c * 8) = w;
        __syncthreads();
    }
}

DEVI void phase_nsa_fast(Frame& F, int layer) {
    using namespace fa;
    F.refresh();
    unsigned char* ws = F.ws;
    const bf16_t* Q = (const bf16_t*)(ws + RA_Q); bf16_t* ATT = (bf16_t*)(ws + RA_ATT);
    const float* GT = (const float*)(ws + RA_GATE); const float* CS = (const float*)(ws + WS_CS);
    const int wave = F.wave;
    LAS unsigned char* kvb = F.lds + L_KV;
    LAS float* imp = (LAS float*)(F.lds + L_IMP);
    LAS unsigned* smask = (LAS unsigned*)(F.lds + L_MASK);
    LAS int* blist = (LAS int*)(F.lds + L_LIST);
#pragma unroll 1
    for (int ui = 0; ui < 8; ++ui) {
        int lane = F.lane; asm volatile("" : "+v"(lane));
        const int tid = wave * 64 + lane, quad = lane >> 4, l15 = lane & 15;
        int tile = (F.vcu & 31) + 32 * (ui >> 1); if (ui & 1) tile = 255 - tile;
        const int bg = F.vcu >> 5, b = bg >> 2, g = bg & 3, cur = tile, t0 = tile * 64;
        const bf16_t* KC = (const bf16_t*)(ws + RA_KC) + (size_t)bg * 1024 * 64; const bf16_t* VC = (const bf16_t*)(ws + RA_VC) + (size_t)bg * 1024 * 64;
        const bf16_t* KS = (const bf16_t*)(ws + RA_KS) + (size_t)bg * SEQ * 64; const bf16_t* VS = (const bf16_t*)(ws + RA_VS) + (size_t)bg * SEQ * 64;
        const bf16_t* KW = (const bf16_t*)(ws + RA_KW) + (size_t)bg * SEQ * 64; const bf16_t* VW = (const bf16_t*)(ws + RA_VW) + (size_t)bg * SEQ * 64;
        smask[tid] = 0u;
        int tl[2], tok[2]; bf16x8 qf[2][2];
#pragma unroll
        for (int s = 0; s < 2; ++s) { tl[s] = 8 * wave + 4 * s + (l15 >> 2); tok[s] = b * SEQ + t0 + tl[s]; load_q(Q, (size_t)tok[s], g * 256 + (l15 & 3) * 64, quad, qf[s]); }
        float gate[2][3];
#pragma unroll
        for (int s = 0; s < 2; ++s)
#pragma unroll
            for (int br = 0; br < 3; ++br) gate[s][br] = GT[(size_t)tok[s] * 48 + br * 16 + g * 4 + (l15 & 3)];
        const float vmax = fmaxf(__uint_as_float(__hip_atomic_load((const unsigned*)(ws + WS_CTL) + CW_VMAX + layer * 8 + bg, __ATOMIC_RELAXED, __HIP_MEMORY_SCOPE_AGENT)), 1e-30f);
        bf16x8 qr[2][2];
#pragma unroll
        for (int s = 0; s < 2; ++s) { qr[s][0] = rope_frag(qf[s][0], CS + (size_t)tok[s] * 16, quad, lane); qr[s][1] = qf[s][1]; }
        f32x4 out[2][4];
#pragma unroll
        for (int s = 0; s < 2; ++s)
#pragma unroll
            for (int dg = 0; dg < 4; ++dg) out[s][dg] = (f32x4){0.f, 0.f, 0.f, 0.f};
        Stage st;
        const int ntile = (4 * cur + 3 + 63) >> 6;
        int nval[2];
#pragma unroll
        for (int s = 0; s < 2; ++s) { const int t = t0 + tl[s]; nval[s] = t >= 31 ? ((t - 31) >> 4) + 1 : 0; }
        float m[2] = {NEGINF, NEGINF}, l[2] = {0.f, 0.f};
        {   stage_load<false>(st, KC, VC, tid); stage_write<false>(st, kvb, tid); __syncthreads();
#pragma unroll 1
            for (int i = 0; i < ntile; ++i) {
                LAS unsigned char* buf = kvb + (i & 1) * KVB;
                if (i + 1 < ntile) stage_load<false>(st, KC + (size_t)(i + 1) * 4096, VC, tid); else stage_load<true>(st, KC, VC, tid);
#pragma unroll
                for (int s = 0; s < 2; ++s) { f32x4 dummy[4]; online_step<false>(buf, qf[s][0], qf[s][1], 0, nval[s] - 64 * i - 1, m[s], l[s], dummy, lane); }
                if (i + 1 < ntile) stage_write<false>(st, kvb + ((i + 1) & 1) * KVB, tid);
                __syncthreads();
            }
        }
        float invl[2], msafe[2];
#pragma unroll
        for (int s = 0; s < 2; ++s) { const float lt = sum_quads(l[s]); invl[s] = lt > 0.f ? 1.f / lt : 0.f; msafe[s] = (m[s] == NEGINF) ? 0.f : m[s]; }
#ifndef NO_P2
        const int jbw0 = cur >= 8 ? cur - 8 : 0;
        {   float gcv[2] = {gate[0][0], gate[1][0]};
            float carry[2] = {0.f, 0.f};
            stage_write<true>(st, kvb, tid); __syncthreads();
#pragma unroll 1
            for (int i = 0; i < ntile; ++i) {
                LAS unsigned char* buf = kvb + (i & 1) * KVB;
                if (i + 1 < ntile) stage_load<true>(st, KC + (size_t)(i + 1) * 4096, VC + (size_t)(i + 1) * 4096, tid); else stage_load<true>(st, KW + (size_t)jbw0 * 4096, VW + (size_t)jbw0 * 4096, tid);
#pragma unroll
                for (int s = 0; s < 2; ++s) {
                    __builtin_amdgcn_sched_barrier(0);
                    f32x4 sc[4]; qk_slot(buf, qf[s][0], qf[s][1], lane, sc);
                    __builtin_amdgcn_sched_barrier(0);
                    const int hiq = nval[s] - 64 * i - 1 - 4 * quad; const float mc2 = -msafe[s] * CEXP;
#pragma unroll
                    for (int kg = 0; kg < 4; ++kg)
#pragma unroll
                        for (int k = 0; k < 4; ++k) sc[kg][k] = (16 * kg + k <= hiq) ? __builtin_amdgcn_exp2f(__builtin_fmaf(sc[kg][k], CEXP, mc2)) * invl[s] : 0.f;
                    bf16x8 pb[2]; pb[0] = pack_p(sc[0] * gcv[s], sc[1] * gcv[s]); pb[1] = pack_p(sc[2] * gcv[s], sc[3] * gcv[s]);
#ifndef NO_IMP
#pragma unroll
                    for (int kg = 0; kg < 4; ++kg) {
                        float a = (sc[kg][0] + sc[kg][1]) + (sc[kg][2] + 0.5f * sc[kg][3]), bq = 0.5f * sc[kg][3];
                        a += dppf<DPP_X1>(a); a += dppf<DPP_X2>(a); bq += dppf<DPP_X1>(bq); bq += dppf<DPP_X2>(bq);
                        const float fromprev = bperm(bq, (lane - 16) & 63);
                        const float add = quad == 0 ? carry[s] : fromprev;
                        carry[s] = bperm(bq, (lane + 48) & 63);
                        if ((l15 & 3) == 0) imp[(8 * wave + 4 * s + (l15 >> 2)) * IMP_LD + 16 * i + 4 * kg + quad] = a + add;
                    }
#endif
                    __builtin_amdgcn_sched_barrier(0);
                    pv_slot(buf + 8192, pb, out[s], lane);
                    __builtin_amdgcn_sched_barrier(0);
                }
                if (i + 1 < ntile) stage_write<true>(st, kvb + ((i + 1) & 1) * KVB, tid);
                __syncthreads();
            }
        }
#endif
#ifndef NO_TOPK
        {   const int tl8 = lane >> 3, chunk = lane & 7, trow = (8 * wave + tl8) * IMP_LD;
            const int ncand = cur - 2;
            const int wsel = ((8 * wave + tl8) >> 5), bsel = (8 * wave + tl8) & 31;
            if (ncand > 0 && ncand <= 13) {
#pragma unroll
                for (int i = 0; i < 2; ++i) { const int j = 8 * i + chunk; if (j >= 1 && j <= cur - 2) __hip_atomic_fetch_or(smask + j * 2 + wsel, 1u << bsel, __ATOMIC_RELAXED, __HIP_MEMORY_SCOPE_WORKGROUP); }
            } else if (ncand > 13) {
                float lv[13]; int li[13];
#pragma unroll
                for (int k = 0; k < 13; ++k) { lv[k] = -1.f; li[k] = 1 << 20; }
                const int imax = (cur - 2) >> 3;
#pragma unroll 1
                for (int i = 0; i <= imax; ++i) {
                    const int j = 8 * i + chunk; float x = (j >= 1 && j <= cur - 2) ? imp[trow + j] : -1.f; int xi = j;
                    if (__builtin_amdgcn_ballot_w64(x > lv[12]) != 0ull) {
#pragma unroll
                        for (int k = 0; k < 13; ++k) { const bool gt = x > lv[k]; const float tv = gt ? lv[k] : x; const int ti = gt ? li[k] : xi; lv[k] = gt ? x : lv[k]; li[k] = gt ? xi : li[k]; x = tv; xi = ti; }
                    }
                }
#pragma unroll 1
                for (int r = 0; r < 13; ++r) {
                    float bv = lv[0]; int bi = li[0];
                    { const float ov = dppf<DPP_X1>(bv); const int oi = dppi<DPP_X1>(bi); if (ov > bv || (ov == bv && oi < bi)) { bv = ov; bi = oi; } }
                    { const float ov = dppf<DPP_X2>(bv); const int oi = dppi<DPP_X2>(bi); if (ov > bv || (ov == bv && oi < bi)) { bv = ov; bi = oi; } }
                    { const float ov = dppf<DPP_HM>(bv); const int oi = dppi<DPP_HM>(bi); if (ov > bv || (ov == bv && oi < bi)) { bv = ov; bi = oi; } }
                    if (li[0] == bi) {
#pragma unroll
                        for (int k = 0; k < 12; ++k) { lv[k] = lv[k + 1]; li[k] = li[k + 1]; }
                        lv[12] = -1.f; li[12] = 1 << 20;
                    }
                    if (chunk == 0 && bv >= 0.f) __hip_atomic_fetch_or(smask + bi * 2 + wsel, 1u << bsel, __ATOMIC_RELAXED, __HIP_MEMORY_SCOPE_WORKGROUP);
                }
            }
        }
#endif
        __syncthreads();
        if (wave == 0) {
            int base = 0;
#pragma unroll 1
            for (int r = 0; r < 4; ++r) { const int j = 64 * r + lane; const bool on = (j <= cur) && (j == 0 || j >= cur - 1 || (smask[j * 2] | smask[j * 2 + 1]) != 0u);
                const unsigned long long bal = __builtin_amdgcn_ballot_w64(on); const int pos = base + __builtin_popcountll(bal & ((1ull << lane) - 1ull));
                if (on) blist[pos] = j; base += __builtin_popcountll(bal); }
            if (lane == 0) blist[259] = base;
        }
        __syncthreads();
        LAS float* stashf = imp + wave * 2048 + lane;
#pragma unroll
        for (int s = 0; s < 2; ++s)
#pragma unroll
            for (int dg = 0; dg < 4; ++dg)
#pragma unroll
                for (int c = 0; c < 4; ++c) stashf[(s * 16 + dg * 4 + c) * 64] = out[s][dg][c];
        {   const int jb0 = jbw0, nb = cur - jb0 + 1;
            f32x4 ob[2][4]; float mm[2] = {NEGINF, NEGINF}, ll[2] = {0.f, 0.f};
#pragma unroll
            for (int s = 0; s < 2; ++s)
#pragma unroll
                for (int dg = 0; dg < 4; ++dg) ob[s][dg] = (f32x4){0.f, 0.f, 0.f, 0.f};
            stage_write<true>(st, kvb, tid); __syncthreads();
#pragma unroll 1
            for (int i = 0; i < nb; ++i) {
                LAS unsigned char* buf = kvb + (i & 1) * KVB;
                const int j = jb0 + i;
                if (i + 1 < nb) stage_load<true>(st, KW + (size_t)(j + 1) * 4096, VW + (size_t)(j + 1) * 4096, tid);
#pragma unroll
                for (int s = 0; s < 2; ++s) {
                    const int lo = (j == cur - 8) ? tl[s] + 1 : 0, hi = (j == cur) ? tl[s] : 63;
                    online_step<true>(buf, qr[s][0], qr[s][1], lo, hi, mm[s], ll[s], ob[s], lane);
                }
                if (i + 1 < nb) stage_write<true>(st, kvb + ((i + 1) & 1) * KVB, tid);
                __syncthreads();
            }
#pragma unroll
            for (int s = 0; s < 2; ++s) { const float lt = sum_quads(ll[s]); const float gw = gate[s][2] * (lt > 0.f ? 1.f / lt : 0.f);
#pragma unroll
                for (int dg = 0; dg < 4; ++dg)
#pragma unroll
                    for (int c = 0; c < 4; ++c) out[s][dg][c] = stashf[(s * 16 + dg * 4 + c) * 64] + ob[s][dg][c] * gw; }
        }
        LAS unsigned* stashb = (LAS unsigned*)(F.lds + L_KV) + wave * 1024 + lane;
        LAS unsigned char* Ql = F.lds + L_Q;
        LAS float* mrow = (LAS float*)(F.lds + L_ML); LAS int* lrow = (LAS int*)(mrow + 256);
        LAS int* Os = (LAS int*)imp;
        const float oscale = 1048576.f / vmax;
#pragma unroll
        for (int s = 0; s < 2; ++s) {
#pragma unroll
            for (int dg = 0; dg < 4; ++dg) { stashb[((s * 4 + dg) * 2 + 0) * 64] = pg8::cvt_pk_bf16(out[s][dg][0], out[s][dg][1]); stashb[((s * 4 + dg) * 2 + 1) * 64] = pg8::cvt_pk_bf16(out[s][dg][2], out[s][dg][3]); }
            const int row = tl[s] * 4 + (l15 & 3);
            *(LAS bf16x8*)(Ql + row * 128 + ((quad ^ (row & 7)) << 4)) = qr[s][0];
            *(LAS bf16x8*)(Ql + row * 128 + (((4 + quad) ^ (row & 7)) << 4)) = qr[s][1];
        }
        __syncthreads();
        for (int i = lane; i < 32 * OS_LD; i += 64) Os[wave * 32 * OS_LD + i] = 0;
        if (lane < 32) { mrow[wave * 32 + lane] = NEGINF; lrow[wave * 32 + lane] = 0; }
        __syncthreads();
        {   const int nb = blist[259];
            int lane2 = lane; asm volatile("" : "+v"(lane2));
            const bf16_t* VT = (const bf16_t*)(ws + RA_VST) + (size_t)bg * 256 * 4096;
            LAS int* tlist = (LAS int*)(F.lds + L_TOK) + wave * 64;
            sel_pass1(KS, nb, cur, wave, blist, smask, Ql, mrow, tlist, lane2);
            __syncthreads();
            asm volatile("" : "+v"(lane2));
            sel_pass2(KS, VT, nb, cur, wave, blist, smask, Ql, mrow, lrow, Os, __builtin_amdgcn_logf(oscale), LSCALE / oscale, tlist, lane2);
            __syncthreads();
        }
        asm volatile("" : "+v"(tok[0]), "+v"(tok[1]), "+v"(tl[0]), "+v"(tl[1]));
        const float oinv = vmax * (1.f / 1048576.f);
#pragma unroll
        for (int s = 0; s < 2; ++s) { const int row = tl[s] * 4 + (l15 & 3); const float lt = (float)lrow[row] * (1.f / LSCALE);
            const float gs = gate[s][1] * (lt > 0.f ? 1.f / lt : 0.f) * oinv;
#pragma unroll
            for (int dg = 0; dg < 4; ++dg) { const unsigned w0 = stashb[((s * 4 + dg) * 2 + 0) * 64], w1 = stashb[((s * 4 + dg) * 2 + 1) * 64];
                LAS const int* orow = Os + row * OS_LD + 16 * dg + 4 * quad;
                const float r0 = bflo(w0) + (float)orow[0] * gs, r1 = bfhi(w0) + (float)orow[1] * gs, r2 = bflo(w1) + (float)orow[2] * gs, r3 = bfhi(w1) + (float)orow[3] * gs;
                u32x2 w; w.x = pg8::cvt_pk_bf16(r0, r1); w.y = pg8::cvt_pk_bf16(r2, r3);
                *(u32x2*)(ATT + (size_t)tok[s] * DM + g * 256 + (l15 & 3) * 64 + 16 * dg + 4 * quad) = w; } }
        __syncthreads();
    }
}

DEVI void phase_swa_fast(Frame& F, const float* sinks) {
    using namespace fa;
    F.refresh();
    unsigned char* ws = F.ws;
    const bf16_t* Q = (const bf16_t*)(ws + RA_Q); bf16_t* ATT = (bf16_t*)(ws + RA_ATT);
    const int tid = F.tid, lane = F.lane, wave = F.wave, quad = lane >> 4, l15 = lane & 15;
    LAS unsigned char* kvb = F.lds + L_KV;
#pragma unroll 1
    for (int ui = 0; ui < 8; ++ui) {
        const int bg = ui >> 1, b = bg >> 1, g = bg & 1, t0 = (F.vcu * 2 + (ui & 1)) * 32, cur = t0 >> 6;
        const bf16_t* KS = (const bf16_t*)(ws + WS_KSH) + (size_t)bg * SEQ * 64; const bf16_t* VS = (const bf16_t*)(ws + WS_VSH) + (size_t)bg * SEQ * 64;
        int tq[2]; size_t tok[2]; bf16x8 qf[2][2]; f32x4 o[2][4]; float mm[2], ll[2];
        const float sink_raw = sinks[g * 8 + (l15 & 7)] * 8.0f;
#pragma unroll
        for (int s = 0; s < 2; ++s) { tq[s] = t0 + 4 * wave + 2 * s + (l15 >> 3); tok[s] = (size_t)b * SEQ + tq[s]; load_q(Q, tok[s], g * 512 + (l15 & 7) * 64, quad, qf[s]);
            mm[s] = sink_raw; ll[s] = quad == 0 ? 1.f : 0.f;
#pragma unroll
            for (int dg = 0; dg < 4; ++dg) o[s][dg] = (f32x4){0.f, 0.f, 0.f, 0.f}; }
        const int jb0 = cur >= 2 ? cur - 2 : 0, nb = cur - jb0 + 1;
        Stage st; stage_load<true>(st, KS + (size_t)jb0 * 4096, VS + (size_t)jb0 * 4096, tid); stage_write<true>(st, kvb, tid); __syncthreads();
#pragma unroll 1
        for (int i = 0; i < nb; ++i) {
            LAS unsigned char* buf = kvb + (i & 1) * KVB;
            const int j = jb0 + i;
            if (i + 1 < nb) stage_load<true>(st, KS + (size_t)(j + 1) * 4096, VS + (size_t)(j + 1) * 4096, tid);
#pragma unroll
            for (int s = 0; s < 2; ++s) online_step<true>(buf, qf[s][0], qf[s][1], tq[s] - (SWA_WIN - 1) - 64 * j, tq[s] - 64 * j, mm[s], ll[s], o[s], lane);
            if (i + 1 < nb) stage_write<true>(st, kvb + ((i + 1) & 1) * KVB, tid);
            __syncthreads();
        }
#pragma unroll
        for (int s = 0; s < 2; ++s) { const float inv = 1.f / sum_quads(ll[s]);
#pragma unroll
            for (int dg = 0; dg < 4; ++dg) { u32x2 w; w.x = pg8::cvt_pk_bf16(o[s][dg][0] * inv, o[s][dg][1] * inv); w.y = pg8::cvt_pk_bf16(o[s][dg][2] * inv, o[s][dg][3] * inv);
                *(u32x2*)(ATT + tok[s] * DM + g * 512 + (l15 & 7) * 64 + 16 * dg + 4 * quad) = w; } }
    }
}

enum Kind { K_PRO = 0, K_NSA_IN, K_CMP_HID, K_CMP_OUT, K_NSA_ATT, K_SWA_IN, K_SWA_ATT, K_OUTPROJ, K_LN1, K_LN1R, K_FFN1, K_FFN2, K_LN2, K_SCATTER, K_MOE1, K_MOE2, K_LN2C, K_COUNT };
struct Args { const void* in[18]; float* out; unsigned char* ws; int ph_lo, ph_hi; };
struct PhaseEnt { int kind, layer; };
constexpr int NPH = 35;
static const PhaseEnt h_prog[NPH] = {
    {K_PRO, 0},
    {K_NSA_IN, 0}, {K_CMP_HID, 0}, {K_CMP_OUT, 0}, {K_NSA_ATT, 0}, {K_OUTPROJ, 0}, {K_LN1, 0}, {K_FFN1, 0}, {K_FFN2, 0}, {K_LN2, 0},
    {K_NSA_IN, 1}, {K_CMP_HID, 1}, {K_CMP_OUT, 1}, {K_NSA_ATT, 1}, {K_OUTPROJ, 1}, {K_LN1R, 1}, {K_SCATTER, 1}, {K_MOE1, 1}, {K_MOE2, 1}, {K_LN2C, 1},
    {K_SWA_IN, 2}, {K_SWA_ATT, 2}, {K_OUTPROJ, 2}, {K_LN1, 2}, {K_FFN1, 2}, {K_FFN2, 2}, {K_LN2, 2},
    {K_SWA_IN, 3}, {K_SWA_ATT, 3}, {K_OUTPROJ, 3}, {K_LN1R, 3}, {K_SCATTER, 3}, {K_MOE1, 3}, {K_MOE2, 3}, {K_LN2C, 3},
};

template <int KIND> DEVI void do_phase(Frame& F, int l) {
    unsigned char* ws = F.ws;
    unsigned* ctl = (unsigned*)(ws + WS_CTL);
    LAS unsigned char* ring = F.lds;
    const int bx = (int)blockIdx.x;
    if constexpr (KIND == K_PRO) { phase_prologue(F); }
    if constexpr (KIND == K_NSA_IN) { pg8::Gemm g{(const bf16_t*)(ws + WS_HB), DM, DM, DM}; pg8::StaticOrder S; S.init(MTOK / 256, A_INP / 256, F.G, bx, (const bf16_t*)(ws + WS_WINA) + (size_t)l * A_INP * DM);
        EpiNsaIn E{ws, (const float*)(ws + WS_CS)}; pg8::gemm_phase(ring, g, S, E, F.wave0); }
    if constexpr (KIND == K_CMP_HID) {
        const int kv = (bx >> 5) & 1;
        if (bx < 64) { pg8::Gemm g{(const bf16_t*)(ws + (kv ? RA_VCR : RA_KCR)), 1024, 2048, 2048};
            pg8::StaticOrder S; S.init(32, 1, 32, bx & 31, (const bf16_t*)(ws + WS_WC1) + (size_t)(l * 2 + kv) * 256 * 2048);
            EpiCmpHid E{(bf16_t*)(ws + RA_CH) + (size_t)kv * 8192 * 256, (const float*)(ctl + CW_BIASP) + (l * 2 + kv) * 256};
            pg8::gemm_phase(ring, g, S, E, F.wave0); }
        else phase_vs_transpose(F, l); }
    if constexpr (KIND == K_CMP_OUT) { pg8::Gemm g{(const bf16_t*)(ws + RA_CH), 256, 256, 256}; pg8::DualOrder S; S.init(64, 1, F.G, bx, (const bf16_t*)(ws + WS_WC2) + (size_t)(l * 2) * 256 * 256); S.estride = (size_t)256 * 256;
        EpiCmpOut E{(bf16_t*)(ws + RA_KC), (bf16_t*)(ws + RA_VC)}; pg8::gemm_phase(ring, g, S, E, F.wave0); }
#if NAIVE_NSA
    if constexpr (KIND == K_NSA_ATT) { phase_nsa_naive(F); }
#else
    if constexpr (KIND == K_NSA_ATT) { phase_nsa_fast(F, l); }
#endif
    if constexpr (KIND == K_SWA_IN) { pg8::Gemm g{(const bf16_t*)(ws + WS_HB), DM, DM, DM}; pg8::StaticOrder S;
        if (l == 2) S.init(MTOK / 256, 5, F.G, bx, (const bf16_t*)(ws + WS_WQKV2)); else S.init(MTOK / 256, 4, F.G, bx, (const bf16_t*)(ws + WS_WQB1));
        EpiSwaIn E{ws, (const float*)(ws + WS_CS)}; pg8::gemm_phase(ring, g, S, E, F.wave0); }
#if NAIVE_SWA
    if constexpr (KIND == K_SWA_ATT) { phase_swa_naive(F, (const float*)ARG_IN(10) + (l - 2) * 16); }
#else
    if constexpr (KIND == K_SWA_ATT) { phase_swa_fast(F, (const float*)ARG_IN(10) + (l - 2) * 16); }
#endif
    if constexpr (KIND == K_OUTPROJ) { pg8::Gemm g{(const bf16_t*)(ws + RA_ATT), DM, DM, DM}; pg8::StaticOrder S;
        S.init(MTOK / 256, 4, F.G, bx, l < 2 ? (const bf16_t*)(ws + WS_WOUTA) + (size_t)l * DM * DM : (const bf16_t*)(ws + WS_WOUTB) + (size_t)(l - 2) * DM * DM);
        EpiResid E{(const bf16_t*)(ws + WS_HB), (bf16_t*)(ws + WS_Y)}; pg8::gemm_phase(ring, g, S, E, F.wave0); }
    if constexpr (KIND == K_LN1) { phase_ln<0, false, false>(F, l * 2, nullptr, 0); }
    if constexpr (KIND == K_LN1R) { phase_ln<0, true, false>(F, l * 2, nullptr, l >> 1); }
    if constexpr (KIND == K_FFN1) { pg8::Gemm g{(const bf16_t*)(ws + WS_HB), DM, DM, DM}; pg8::StaticOrder S; S.init(MTOK / 256, 2 * DFF / 256, F.G, bx, (const bf16_t*)(ws + WS_WDIN) + (size_t)(l >> 1) * 2 * DFF * DM);
        EpiSwiglu E{(bf16_t*)(ws + WS_ACT), DFF}; pg8::gemm_phase(ring, g, S, E, F.wave0); }
    if constexpr (KIND == K_FFN2) { pg8::Gemm g{(const bf16_t*)(ws + WS_ACT), DFF, DFF, DFF}; pg8::StaticOrder S; S.init(MTOK / 256, 4, F.G, bx, (const bf16_t*)(ws + WS_WDOUT) + (size_t)(l >> 1) * DM * DFF);
        EpiResid E{(const bf16_t*)(ws + WS_HB), (bf16_t*)(ws + WS_Y)}; pg8::gemm_phase(ring, g, S, E, F.wave0); }
    if constexpr (KIND == K_LN2) { phase_ln<0, false, false>(F, l * 2 + 1, nullptr, 0); }
    if constexpr (KIND == K_SCATTER) { phase_moe_scatter(F, l >> 1); }
    if constexpr (KIND == K_MOE1) { const int ml = l >> 1; int ts[9]; moe_tiles((const unsigned*)ctl + CW_MOE + ml * 64, ts);
        pg8::Gemm g{(const bf16_t*)(ws + WS_XB), DM, DM, DM}; pg8::GroupedOrder S; S.init(ts[8], 2 * DFFE / 256, F.G, bx, (const bf16_t*)(ws + WS_WMIN) + (size_t)ml * 8 * 2 * DFFE * DM);
        S.t1 = ts[1]; S.t2 = ts[2]; S.t3 = ts[3]; S.t4 = ts[4]; S.t5 = ts[5]; S.t6 = ts[6]; S.t7 = ts[7]; S.estride = (size_t)2 * DFFE * DM;
        EpiSwiglu E{(bf16_t*)(ws + WS_ACT), DFFE}; pg8::gemm_phase(ring, g, S, E, F.wave0); }
    if constexpr (KIND == K_MOE2) { const int ml = l >> 1; int ts[9]; moe_tiles((const unsigned*)ctl + CW_MOE + ml * 64, ts);
        pg8::Gemm g{(const bf16_t*)(ws + WS_ACT), DFFE, DFFE, DFFE}; pg8::GroupedOrder S; S.init(256, 4, F.G, bx, (const bf16_t*)(ws + WS_WMOUT) + (size_t)ml * 8 * DM * DFFE);
        S.t1 = ts[1]; S.t2 = ts[2]; S.t3 = ts[3]; S.t4 = ts[4]; S.t5 = ts[5]; S.t6 = ts[6]; S.t7 = ts[7]; S.estride = (size_t)DM * DFFE;
        EpiBf16Out E{(bf16_t*)(ws + WS_YB)}; pg8::gemm_phase(ring, g, S, E, F.wave0);
        pg8::Gemm g4{(const bf16_t*)(ws + WS_ACT), DFFE, DFFE / 4, DFFE}; pg8::SliceOrder S4; S4.nsl = (ts[8] - 256) * 16; S4.G = F.G; S4.c = (bx + 128) & 255; S4.kq = DFFE / 4;
        S4.bt = (const bf16_t*)(ws + WS_WMOUT) + (size_t)ml * 8 * DM * DFFE; S4.t1 = ts[1]; S4.t2 = ts[2]; S4.t3 = ts[3]; S4.t4 = ts[4]; S4.t5 = ts[5]; S4.t6 = ts[6]; S4.t7 = ts[7]; S4.estride = (size_t)DM * DFFE;
        EpiPart E4{(float*)(ws + WS_H)}; pg8::gemm_phase(ring, g4, S4, E4, F.wave0); }
    if constexpr (KIND == K_LN2C) { if (l == DEPTH - 1) phase_ln<1, false, true>(F, l * 2 + 1, ARG_OUT(), 0); else phase_ln<1, false, false>(F, l * 2 + 1, nullptr, 0); }
}

DEVI void frame_init(Frame& F, unsigned char* lds_raw) {
    F.lds = (LAS unsigned char*)lds_raw; F.ws = ARG_WS();
    F.wave0 = wave_id_sgpr(); F.tid = threadIdx.x; F.lane = F.tid & 63; F.wave = F.wave0;
    F.G = gridDim.x; { const int bx = blockIdx.x; F.vcu = (F.G % 8 == 0) ? (bx % 8) * (F.G / 8) + bx / 8 : bx; }
}

#if !MK_SINGLE
template <int KIND> __global__ void __launch_bounds__(NWAVES * 64, 2) phase_kernel(Args args) {
    extern __shared__ __attribute__((aligned(16))) unsigned char lds_raw[];
    Frame F; frame_init(F, lds_raw);
    do_phase<KIND>(F, args.ph_lo);
}
template <int KIND> static void launch_kind(const Args& a, hipStream_t stream) {
    static bool attr = false;
    if (!attr) { (void)hipFuncSetAttribute((const void*)phase_kernel<KIND>, hipFuncAttributeMaxDynamicSharedMemorySize, LDS_BYTES); attr = true; }
    hipLaunchKernelGGL(phase_kernel<KIND>, dim3(256), dim3(NWAVES * 64), LDS_BYTES, stream, a);
}
#else
__global__ void __launch_bounds__(NWAVES * 64, 2) yoco_fwd(Args args) {
    extern __shared__ __attribute__((aligned(16))) unsigned char lds_raw[];
    Frame F; frame_init(F, lds_raw);
    volatile LAS unsigned* MISC = (volatile LAS unsigned*)(F.lds + MISC_OFF);
    for (int u = F.tid; u < 256; u += NWAVES * 64) MISC[u] = 0u;
    __syncthreads();
    XcdBarrier bar = xcd_barrier_post((unsigned*)(F.ws + WS_CTL) + CW_BAR, MISC + 8);
#define DUP_KIND 12
#ifndef DUP_KIND
#define DUP_KIND -1
#endif
#define PH(K, L, FIRST) do { do_phase<K>(F, L); if (FIRST) cg::this_grid().sync(); else xcd_barrier(bar); if (K == DUP_KIND) { do_phase<K>(F, L); xcd_barrier(bar); } } while (0)
    PH(K_PRO, 0, true);
#define NSA_LAYER(l) PH(K_NSA_IN, l, false); PH(K_CMP_HID, l, false); PH(K_CMP_OUT, l, false); PH(K_NSA_ATT, l, false); PH(K_OUTPROJ, l, false)
#define SWA_LAYER(l) PH(K_SWA_IN, l, false); PH(K_SWA_ATT, l, false); PH(K_OUTPROJ, l, false)
#define DENSE_FFN(l) PH(K_LN1, l, false); PH(K_FFN1, l, false); PH(K_FFN2, l, false); PH(K_LN2, l, false)
#define MOE_FFN(l, LAST) PH(K_LN1R, l, false); PH(K_SCATTER, l, false); PH(K_MOE1, l, false); PH(K_MOE2, l, false); do_phase<K_LN2C>(F, l); if (!(LAST)) xcd_barrier(bar)
    NSA_LAYER(0); DENSE_FFN(0);
    NSA_LAYER(1); MOE_FFN(1, false);
    SWA_LAYER(2); DENSE_FFN(2);
    SWA_LAYER(3); MOE_FFN(3, true);
}
#endif

extern "C" void kernel_launch(void* const* d_in, const int* in_sizes, int n_in, void* d_out, int out_size, void* d_ws, size_t ws_size, hipStream_t stream) {
    static int grid = 0;
    if (grid == 0) {
        if (n_in != 18 || out_size != MTOK * DM || ws_size < WS_END) { fprintf(stderr, "kernel_launch: unexpected shapes (n_in %d out %d ws %zu need %zu)\n", n_in, out_size, ws_size, (size_t)WS_END); grid = -1; return; }
        int dev = 0, cus = 0;
        (void)hipGetDevice(&dev); (void)hipDeviceGetAttribute(&cus, hipDeviceAttributeMultiprocessorCount, dev);
        if (cus < 256) { fprintf(stderr, "kernel_launch: needs 256 CUs, device has %d\n", cus); grid = -1; return; }
#if MK_SINGLE
        int per_cu = 0;
        (void)hipFuncSetAttribute((const void*)yoco_fwd, hipFuncAttributeMaxDynamicSharedMemorySize, LDS_BYTES);
        (void)hipOccupancyMaxActiveBlocksPerMultiprocessor(&per_cu, (const void*)yoco_fwd, NWAVES * 64, LDS_BYTES);
        if (per_cu < 1) fprintf(stderr, "kernel_launch: occupancy query says %d blocks per CU\n", per_cu);
        (void)hipGetLastError();
#endif
        grid = 256;
    }
    if (grid < 0) return;
    (void)hipMemsetAsync((char*)d_ws + WS_CTL, 0, CTL_BYTES, stream);
    Args a{};
    for (int i = 0; i < 18; ++i) a.in[i] = d_in[i];
    a.out = (float*)d_out; a.ws = (unsigned char*)d_ws;
#if MK_SINGLE
    a.ph_lo = 0; a.ph_hi = NPH;
    void* kargs[] = {&a};
    hipError_t e = hipLaunchCooperativeKernel((const void*)yoco_fwd, dim3(grid), dim3(NWAVES * 64), kargs, LDS_BYTES, stream);
    if (e != hipSuccess) fprintf(stderr, "cooperative launch failed: %s (grid %d)\n", hipGetErrorString(e), grid);
#else
    for (int p = 0; p < NPH; ++p) {
        a.ph_lo = h_prog[p].layer; a.ph_hi = 0;
        switch (h_prog[p].kind) {
#define LK(K) case K: launch_kind<K>(a, stream); break;
            LK(K_PRO) LK(K_NSA_IN) LK(K_CMP_HID) LK(K_CMP_OUT) LK(K_NSA_ATT) LK(K_SWA_IN) LK(K_SWA_ATT) LK(K_OUTPROJ) LK(K_LN1) LK(K_LN1R) LK(K_FFN1) LK(K_FFN2) LK(K_LN2) LK(K_SCATTER) LK(K_MOE1) LK(K_MOE2) LK(K_LN2C)
#undef LK
            default: break;
        }
    }
#endif
}
```

```cpp
#include <hip/hip_runtime.h>
#include <hip/hip_cooperative_groups.h>
#include <cstdio>
#include <cstdint>
namespace cg = cooperative_groups;

#ifndef DBG_DROP
#define DBG_DROP 0
#endif
#ifndef NAIVE_NSA
#define NAIVE_NSA 0
#endif
#ifndef NAIVE_SWA
#define NAIVE_SWA 0
#endif
#ifndef MK_SINGLE
#define MK_SINGLE 1
#endif

#define DEVI __device__ __forceinline__
#define LAS __attribute__((address_space(3)))
#define GAS __attribute__((address_space(1)))
typedef unsigned short bf16_t;
typedef short bf16x8 __attribute__((ext_vector_type(8)));
typedef float f32x4 __attribute__((ext_vector_type(4)));
typedef float f32x2 __attribute__((ext_vector_type(2)));
typedef unsigned u32x4 __attribute__((ext_vector_type(4)));
typedef unsigned u32x2 __attribute__((ext_vector_type(2)));

constexpr int BATCH = 2, SEQ = 16384, MTOK = BATCH * SEQ, DM = 1024, DEPTH = 4;
constexpr int HD = 64;
constexpr int A_G = 4, A_R = 4, A_IN = 2608, A_INP = 2816;
constexpr int NCMP = 1023, CMP_HID = 256;
constexpr int NSLC = SEQ / 64, NSEL = 16, NSA_WIN = 512;
constexpr int B_G = 2, B_R = 8, SWA_WIN = 128;
constexpr int DFF = 2816, NEXP = 8, DFFE = 3584;
constexpr int CAP = MTOK * 2 + NEXP * 256;
constexpr float ALPHA = 1.6817928305074292f;
constexpr float LN_EPS = 1e-5f;
constexpr float QSCALE = 0.125f;

constexpr size_t al256(size_t x) { return (x + 255) & ~(size_t)255; }
constexpr size_t WS_CTL = 0, CTL_BYTES = 1u << 20;
constexpr size_t WS_WINA = CTL_BYTES;
constexpr size_t WS_WOUTA = WS_WINA + (size_t)2 * A_INP * DM * 2;
constexpr size_t WS_WC1 = WS_WOUTA + (size_t)2 * DM * DM * 2;
constexpr size_t WS_WC2 = WS_WC1 + (size_t)4 * 256 * 2048 * 2;
constexpr size_t WS_WQKV2 = WS_WC2 + (size_t)4 * 256 * 256 * 2;
constexpr size_t WS_WQB1 = WS_WQKV2 + (size_t)1280 * DM * 2;
constexpr size_t WS_WOUTB = WS_WQB1 + (size_t)DM * DM * 2;
constexpr size_t WS_WDIN = WS_WOUTB + (size_t)2 * DM * DM * 2;
constexpr size_t WS_WDOUT = WS_WDIN + (size_t)2 * 2 * DFF * DM * 2;
constexpr size_t WS_WMIN = WS_WDOUT + (size_t)2 * DM * DFF * 2;
constexpr size_t WS_WMOUT = WS_WMIN + (size_t)16 * 2 * DFFE * DM * 2;
constexpr size_t WS_WEND = WS_WMOUT + (size_t)16 * DM * DFFE * 2;
constexpr size_t WS_H = al256(WS_WEND);
constexpr size_t WS_Y = WS_H + (size_t)MTOK * DM * 4;
constexpr size_t WS_HB = WS_Y + (size_t)MTOK * DM * 4;
constexpr size_t WS_CS = WS_HB + (size_t)MTOK * DM * 2;
constexpr size_t WS_KSH = WS_CS + (size_t)MTOK * 16 * 4;
constexpr size_t WS_VSH = WS_KSH + (size_t)MTOK * 128 * 2;
constexpr size_t WS_ROUTE = WS_VSH + (size_t)MTOK * 128 * 2;
constexpr size_t WS_XB = WS_ROUTE + (size_t)MTOK * 2 * 4 * 4;
constexpr size_t WS_ACT = WS_XB + (size_t)CAP * DM * 2;
constexpr size_t WS_RA = WS_ACT + (size_t)CAP * DFFE * 2;
constexpr size_t SLAB = (size_t)MTOK * 256 * 2;
constexpr size_t RA_Q = WS_RA;
constexpr size_t RA_ATT = RA_Q + (size_t)MTOK * DM * 2;
constexpr size_t RA_KCR = RA_ATT + (size_t)MTOK * DM * 2;
constexpr size_t RA_VCR = RA_KCR + SLAB + 4096;
constexpr size_t RA_KS = RA_VCR + SLAB + 4096;
constexpr size_t RA_VS = RA_KS + SLAB;
constexpr size_t RA_KW = RA_VS + SLAB;
constexpr size_t RA_VW = RA_KW + SLAB;
constexpr size_t RA_GATE = RA_VW + SLAB;
constexpr size_t RA_KC = RA_GATE + (size_t)MTOK * 48 * 4;
constexpr size_t RA_VC = RA_KC + (size_t)8192 * 64 * 2;
constexpr size_t RA_CH = RA_VC + (size_t)8192 * 64 * 2;
constexpr size_t RA_VST = RA_CH + (size_t)2 * 8192 * 256 * 2;
constexpr size_t RA_END = RA_VST + SLAB;
constexpr size_t WS_YB = WS_RA;
constexpr size_t YB_END = WS_YB + (size_t)CAP * DM * 4;
constexpr size_t WS_END = (RA_END > YB_END ? RA_END : YB_END);
static_assert(WS_END < (size_t)1879048192, "workspace map exceeds 4x the largest tensor");

constexpr int CW_BAR = 4096;
constexpr int CW_MOE = 16384;
constexpr int CW_WGCNT = 45056;
constexpr int CW_KMAX = 40064;
constexpr int CW_VMAX = 40000;
constexpr int CW_BIASP = 32768;

constexpr int RING_BYTES = 131072;
constexpr int LDS_X = RING_BYTES;
constexpr int MISC_OFF = RING_BYTES + 16384;
constexpr int LDS_BYTES = MISC_OFF + 1024;

DEVI unsigned f2bf(float f) { unsigned u = __builtin_bit_cast(unsigned, f); return (u + 0x7fffu + ((u >> 16) & 1u)) >> 16; }
DEVI unsigned pk2(float lo, float hi) { return f2bf(lo) | (f2bf(hi) << 16); }
DEVI float bf2f(unsigned h) { return __builtin_bit_cast(float, h << 16); }
DEVI float bflo(unsigned w) { return __builtin_bit_cast(float, w << 16); }
DEVI float bfhi(unsigned w) { return __builtin_bit_cast(float, w & 0xffff0000u); }
DEVI float shx(float v, int mask, int lane) { return __builtin_bit_cast(float, __builtin_amdgcn_ds_bpermute((lane ^ mask) << 2, __builtin_bit_cast(int, v))); }
DEVI int shxi(int v, int mask, int lane) { return __builtin_amdgcn_ds_bpermute((lane ^ mask) << 2, v); }
DEVI float wave_sum(float v, int lane) {
#pragma unroll
    for (int o = 1; o < 64; o <<= 1) v += shx(v, o, lane);
    return v;
}
DEVI float wave_max(float v, int lane) {
#pragma unroll
    for (int o = 1; o < 64; o <<= 1) v = fmaxf(v, shx(v, o, lane));
    return v;
}
DEVI int wave_id_sgpr() { return __builtin_amdgcn_readfirstlane((int)threadIdx.x >> 6); }
DEVI int opaque_tid(int wave) { asm volatile("" : "+s"(wave)); int l; asm volatile("v_mbcnt_lo_u32_b32 %0, -1, 0\n\tv_mbcnt_hi_u32_b32 %0, -1, %0" : "=v"(l)); return wave * 64 + l; }
#define LDS_WAIT() asm volatile("s_waitcnt lgkmcnt(0)" ::: "memory")
#define VM_WAIT() asm volatile("s_waitcnt vmcnt(0)" ::: "memory")

namespace pg8 {
constexpr int BM = 256, BK = 64, HALF = 128, HTB = HALF * BK * 2, STAGE_BYTES = 8 * HTB, NXCD = 8, WGM = 8;
DEVI int lds_byte(int r, int c) { const int st = (r >> 4) * 2 + (c >> 5), rr = r & 15, cc = c & 31, ob = rr * 64 + cc * 2; return st * 1024 + (ob ^ (((ob >> 9) & 1) << 5)); }
DEVI void stage_rc(int b, int& R, int& C) { const int st = b / 1024, sb = b % 1024, swz = sb ^ (((sb >> 9) & 1) << 5); R = (st >> 1) * 16 + swz / 64; C = (st & 1) * 32 + (swz % 64) / 2; }
DEVI int perm32(int rho) { const int n = rho >> 4, i = rho & 15; return 8 * (i >> 2) + 4 * n + (i & 3); }

struct Unit { int pm, pn; const bf16_t* bt; int koff, z; };
struct Gemm { const bf16_t* A; int lda; int K; int ldb; };

struct StaticOrder {
    int nM, nN, nwg, G, c; const bf16_t* bt;
    DEVI void init(int nM_, int nN_, int G_, int c_, const bf16_t* bt_) { nM = nM_; nN = nN_; nwg = nM * nN; G = G_; c = c_; bt = bt_; }
    DEVI bool tile(int i, int& pm, int& pn) const {
        const long L = (long)i * G + c; if (L >= nwg) return false;
        int wgid = (int)L; { const int q = nwg / NXCD, r = nwg % NXCD, xcd = wgid % NXCD, off = wgid / NXCD; wgid = (xcd < r ? xcd * (q + 1) : r * (q + 1) + (xcd - r) * q) + off; }
        const int nig = WGM * nN, gid = wgid / nig, fm = gid * WGM, gsz = (nM - fm) < WGM ? (nM - fm) : WGM;
        pm = fm + ((wgid % nig) % gsz); pn = (wgid % nig) / gsz; return true;
    }
    DEVI bool next(int i, Unit& u) const { if (!tile(i, u.pm, u.pn)) return false; u.bt = bt; u.koff = 0; u.z = 0; return true; }
};
struct GroupedOrder : StaticOrder {
    int t1, t2, t3, t4, t5, t6, t7; size_t estride;
    DEVI bool next(int i, Unit& u) const {
        if (!tile(i, u.pm, u.pn)) return false;
        const int tm = u.pm; const int e = (tm >= t1) + (tm >= t2) + (tm >= t3) + (tm >= t4) + (tm >= t5) + (tm >= t6) + (tm >= t7);
        u.bt = bt + (size_t)e * estride; u.koff = 0; u.z = 0; return true;
    }
};
struct SliceOrder {
    int nsl, G, c, kq; const bf16_t* bt; int t1, t2, t3, t4, t5, t6, t7; size_t estride;
    DEVI bool next(int i, Unit& u) const {
        const int L = i * G + c; if (L >= nsl) return false;
        u.pm = 256 + (L >> 4); u.pn = (L & 15) >> 2; u.z = L & 3; u.koff = u.z * kq;
        const int tm = u.pm; const int e = (tm >= t1) + (tm >= t2) + (tm >= t3) + (tm >= t4) + (tm >= t5) + (tm >= t6) + (tm >= t7);
        u.bt = bt + (size_t)e * estride; return true;
    }
};
struct DualOrder : StaticOrder {
    size_t estride;
    DEVI bool next(int i, Unit& u) const { if (!tile(i, u.pm, u.pn)) return false; u.bt = bt + (u.pm >= nM / 2 ? estride : 0); u.koff = 0; u.z = 0; return true; }
};

DEVI unsigned cvt_pk_bf16(float lo, float hi) { typedef __bf16 bf16x2_t __attribute__((ext_vector_type(2))); f32x2 v = {lo, hi}; bf16x2_t b = __builtin_convertvector(v, bf16x2_t); return __builtin_bit_cast(unsigned, b); }

template <class Epi, class Sched, bool ALIGN_EPI = true>
DEVI void gemm_phase(LAS unsigned char* lds, const Gemm g, const Sched& S, const Epi& E, int wave0) {
    const int tid = opaque_tid(wave0), wid = __builtin_amdgcn_readfirstlane(tid >> 6), lane = tid & 63, wr = wid >> 2, wc = wid & 3, fr = lane & 15, fq = lane >> 4;
    const int K = g.K, nt = K / BK, lda = g.lda, ldb = g.ldb;
    unsigned voffA[2], voffB[2];
#pragma unroll
    for (int i = 0; i < 2; ++i) { int R, C; stage_rc(tid * 16 + i * 8192, R, C); const int Rb = Epi::PERM ? ((R & ~31) + perm32(R & 31)) : R;
        voffA[i] = (unsigned)(R * lda + C) * 2u; voffB[i] = (unsigned)(Rb * ldb + C) * 2u; }
    const size_t kstep = (size_t)(BK * 2);
    const size_t hstepA = (size_t)HALF * lda * 2, tstepA = 2 * hstepA;
    const size_t hstepB = (size_t)HALF * ldb * 2, tstepB = 2 * hstepB;
    const unsigned ldsw = (unsigned)wid * 1024u;
    const int aoff = lds_byte(wr * 64 + fr, fq * 8), boff = lds_byte(wc * 32 + fr, fq * 8);
#define PG8_SA(b, h) (((b) * 2 + (h)) * HTB)
#define PG8_SB(b, h) ((4 + (b) * 2 + (h)) * HTB)
#define PG8_STAGE(bufoff, gbase, voff) do { _Pragma("unroll") for (int _i = 0; _i < 2; ++_i) \
        __builtin_amdgcn_global_load_lds((const unsigned*)((const char*)(gbase) + (voff)[_i]), (LAS unsigned*)(lds + (bufoff) + ldsw + _i * 8192), 16, 0, 0); } while (0)
#define PG8_LDA(dst, b, h) do { _Pragma("unroll") for (int m = 0; m < 4; ++m) _Pragma("unroll") for (int k = 0; k < 2; ++k) dst[m][k] = *(const LAS bf16x8*)(lds + PG8_SA(b, h) + aoff + m * 2048 + k * 1024); } while (0)
#define PG8_LDB(dst, b, h) do { _Pragma("unroll") for (int n = 0; n < 2; ++n) _Pragma("unroll") for (int k = 0; k < 2; ++k) dst[n][k] = *(const LAS bf16x8*)(lds + PG8_SB(b, h) + boff + n * 2048 + k * 1024); } while (0)
#define PG8_MMA(ai, bj, At, Bt) do { __builtin_amdgcn_s_setprio(1); _Pragma("unroll") for (int m = 0; m < 4; ++m) _Pragma("unroll") for (int n = 0; n < 2; ++n) _Pragma("unroll") for (int k = 0; k < 2; ++k) \
        acc[ai][bj][m][n] = __builtin_amdgcn_mfma_f32_16x16x32_bf16(Bt[n][k], At[m][k], acc[ai][bj][m][n], 0, 0, 0); __builtin_amdgcn_s_setprio(0); } while (0)
#define PG8_WAIT_V(n) asm volatile("s_waitcnt vmcnt(" #n ")" ::: "memory")
#define PG8_WAIT_L(n) asm volatile("s_waitcnt lgkmcnt(" #n ")" ::: "memory")
#define PG8_BAR __builtin_amdgcn_s_barrier()
#define PG8_SCHED __builtin_amdgcn_sched_barrier(0)
    Unit cur, nxt; int ui = 0;
    if (!S.next(0, cur)) return;
    f32x4 acc[2][2][4][2];
#pragma unroll
    for (int a = 0; a < 2; ++a)
#pragma unroll
        for (int b = 0; b < 2; ++b)
#pragma unroll
            for (int m = 0; m < 4; ++m)
#pragma unroll
                for (int n = 0; n < 2; ++n) acc[a][b][m][n] = (f32x4){0.f, 0.f, 0.f, 0.f};
    bf16x8 At[4][2], B0[2][2], B1[2][2];
    const char* cA = (const char*)g.A + (size_t)cur.pm * tstepA + (size_t)cur.koff * 2; const char* cB = (const char*)cur.bt + (size_t)cur.pn * tstepB + (size_t)cur.koff * 2;
    PG8_STAGE(PG8_SB(0, 0), cB, voffB); PG8_STAGE(PG8_SB(0, 1), cB + hstepB, voffB); PG8_STAGE(PG8_SA(0, 0), cA, voffA); PG8_STAGE(PG8_SA(0, 1), cA + hstepA, voffA);
    if (wr == 1) PG8_BAR;
    PG8_WAIT_V(2); PG8_BAR;
    PG8_STAGE(PG8_SB(1, 0), cB + kstep, voffB); PG8_STAGE(PG8_SA(1, 0), cA + kstep, voffA); PG8_STAGE(PG8_SB(1, 1), cB + hstepB + kstep, voffB);
    PG8_WAIT_V(6); PG8_BAR;
    for (;;) {
        const bool has_next = S.next(ui + 1, nxt);
        const char* nA = has_next ? (const char*)g.A + (size_t)nxt.pm * tstepA + (size_t)nxt.koff * 2 : cA; const char* nB = has_next ? (const char*)nxt.bt + (size_t)nxt.pn * tstepB + (size_t)nxt.koff * 2 : cB;
        for (int t = 0; t < nt; t += 2) {
            const bool last = (t == nt - 2);
            const char* a1 = cA + (size_t)(t + 1) * kstep;
            const char* a2 = last ? nA : cA + (size_t)(t + 2) * kstep; const char* b2 = last ? nB : cB + (size_t)(t + 2) * kstep;
            const char* a3 = a2 + kstep; const char* b3 = b2 + kstep;
            PG8_LDB(B0, 0, 0); PG8_LDB(B1, 0, 1); PG8_SCHED; PG8_LDA(At, 0, 0); PG8_STAGE(PG8_SA(1, 1), a1 + hstepA, voffA);
            PG8_WAIT_V(8); PG8_WAIT_L(0); PG8_BAR; PG8_MMA(0, 0, At, B0); PG8_MMA(0, 1, At, B1); PG8_BAR; PG8_SCHED;
            PG8_LDA(At, 0, 1); PG8_STAGE(PG8_SB(0, 0), b2, voffB); PG8_STAGE(PG8_SB(0, 1), b2 + hstepB, voffB); PG8_STAGE(PG8_SA(0, 0), a2, voffA);
            PG8_WAIT_V(8); PG8_WAIT_L(0); PG8_BAR; PG8_MMA(1, 0, At, B0); PG8_MMA(1, 1, At, B1); PG8_BAR; PG8_SCHED;
            PG8_LDB(B0, 1, 0); PG8_LDB(B1, 1, 1); PG8_SCHED; PG8_LDA(At, 1, 0); PG8_STAGE(PG8_SA(0, 1), a2 + hstepA, voffA);
            PG8_WAIT_V(8); PG8_WAIT_L(0); PG8_BAR; PG8_MMA(0, 0, At, B0); PG8_MMA(0, 1, At, B1); PG8_BAR; PG8_SCHED;
            PG8_LDA(At, 1, 1); PG8_STAGE(PG8_SB(1, 0), b3, voffB); PG8_STAGE(PG8_SB(1, 1), b3 + hstepB, voffB); PG8_STAGE(PG8_SA(1, 0), a3, voffA);
            PG8_WAIT_V(8); PG8_WAIT_L(0); PG8_BAR; PG8_MMA(1, 0, At, B0); PG8_MMA(1, 1, At, B1); PG8_BAR; PG8_SCHED;
        }
        if constexpr (ALIGN_EPI) { if (wr == 0) PG8_BAR; }
        E(acc, cur, wr, wc, fr, fq);
        if (!has_next) break;
#pragma unroll
        for (int a = 0; a < 2; ++a)
#pragma unroll
            for (int b = 0; b < 2; ++b)
#pragma unroll
                for (int m = 0; m < 4; ++m)
#pragma unroll
                    for (int n = 0; n < 2; ++n) acc[a][b][m][n] = (f32x4){0.f, 0.f, 0.f, 0.f};
        cur = nxt; cA = nA; cB = nB; ++ui;
        if constexpr (ALIGN_EPI) { if (wr == 1) PG8_BAR; }
    }
    PG8_WAIT_V(0);
    if constexpr (!ALIGN_EPI) { if (wr == 0) PG8_BAR; }
    PG8_BAR;
#undef PG8_SA
#undef PG8_SB
#undef PG8_STAGE
#undef PG8_LDA
#undef PG8_LDB
#undef PG8_MMA
#undef PG8_WAIT_V
#undef PG8_WAIT_L
#undef PG8_BAR
#undef PG8_SCHED
}
}

#define XB_TMO      128
#define XB_XCNT(j)  (256  + 64 * (j))
#define XB_XSUB(j)  (1280 + 64 * (j))
#define XB_XGEN(j)  (2304 + 64 * (j))
#define XB_TOP      3328
#define XB_TOPGEN   3392
#define XCD_BAR_WORDS 3456
#define XB_SPIN_CAP (1u << 22)
DEVI unsigned xb_ld(unsigned* p)              { return __hip_atomic_load(p, __ATOMIC_RELAXED, __HIP_MEMORY_SCOPE_AGENT); }
DEVI unsigned xb_add(unsigned* p, unsigned v) { return __hip_atomic_fetch_add(p, v, __ATOMIC_RELAXED, __HIP_MEMORY_SCOPE_AGENT); }
DEVI unsigned xb_xcc_id() { return (unsigned)__builtin_amdgcn_s_getreg((3 << 11) | 20) & 0xFu; }
#define XB_SPIN(cond, bar) do { unsigned _sp = 0; while (cond) { __builtin_amdgcn_s_sleep(1); \
    if ((++_sp & 255u) == 0u) { if (xb_ld(&(bar)[XB_TMO])) break; if (_sp > XB_SPIN_CAP) { atomicAdd(&(bar)[XB_TMO], 1u); break; } } } } while (0)
struct XcdBarrier { unsigned* bar; unsigned x; volatile LAS unsigned* st; };
DEVI XcdBarrier xcd_barrier_post(unsigned* bar, volatile LAS unsigned* st) {
    XcdBarrier b; b.bar = bar; b.x = xb_xcc_id(); b.st = st;
    if (threadIdx.x == 0) (void)xb_add(&bar[XB_XCNT(b.x)], 1u);
    return b;
}
DEVI void xcd_barrier_complete(unsigned* bar, unsigned x, unsigned& nloc, unsigned& nx) {
    const unsigned G = gridDim.x * gridDim.y * gridDim.z;
    unsigned sum, cnt, mine, sp = 0u;
    for (;;) {
        sum = 0u; cnt = 0u; mine = 0u;
#pragma unroll
        for (unsigned j = 0; j < 16; ++j) { const unsigned c = xb_ld(&bar[XB_XCNT(j)]); sum += c; cnt += (c > 0u) ? 1u : 0u; mine = (j == x) ? c : mine; }
        if (sum == G) break;
        __builtin_amdgcn_s_sleep(1);
        if ((++sp & 255u) == 0u) { if (xb_ld(&bar[XB_TMO])) break; if (sp > XB_SPIN_CAP) { atomicAdd(&bar[XB_TMO], 1u); break; } }
    }
    nloc = mine > 0u ? mine : 1u; nx = cnt > 0u ? cnt : 1u;
}
DEVI void xcd_barrier(const XcdBarrier& b) {
    asm volatile("s_waitcnt vmcnt(0)" ::: "memory");
    __syncthreads();
    if (threadIdx.x == 0) {
        unsigned* bar = b.bar;
        __builtin_amdgcn_s_waitcnt(0);
        unsigned nloc = b.st[0], nx = b.st[1];
        if (nloc == 0u) { xcd_barrier_complete(bar, b.x, nloc, nx); b.st[0] = nloc; b.st[1] = nx; }
        const unsigned old = xb_add(&bar[XB_XSUB(b.x)], 1u);
        const unsigned gen = old / nloc;
        if (old + 1u == (gen + 1u) * nloc) {
            __builtin_amdgcn_fence(__ATOMIC_RELEASE, "agent");
            asm volatile("s_waitcnt vmcnt(0)" ::: "memory");
            const unsigned og = xb_add(&bar[XB_TOP], 1u);
            const unsigned tg = og / nx;
            if (og + 1u == (tg + 1u) * nx) xb_add(&bar[XB_TOPGEN], 1u);
            else XB_SPIN(xb_ld(&bar[XB_TOPGEN]) == tg, bar);
            __builtin_amdgcn_fence(__ATOMIC_ACQUIRE, "agent");
            xb_add(&bar[XB_XGEN(b.x)], 1u);
            asm volatile("s_waitcnt vmcnt(0)" ::: "memory");
        } else {
            XB_SPIN(xb_ld(&bar[XB_XGEN(b.x)]) == gen, bar);
            __builtin_amdgcn_fence(__ATOMIC_ACQUIRE, "agent");
            asm volatile("s_waitcnt vmcnt(0)" ::: "memory");
        }
    }
    __syncthreads();
}

typedef const void* cvp_t;
DEVI const void* karg_ptr(int byte_off) { asm volatile("" : "+s"(byte_off)); const __attribute__((address_space(4))) char* kp = (const __attribute__((address_space(4))) char*)__builtin_amdgcn_kernarg_segment_ptr(); return *(const __attribute__((address_space(4))) cvp_t*)(kp + byte_off); }
#define ARG_IN(i) karg_ptr((i) * 8)
#define ARG_OUT() ((float*)karg_ptr(18 * 8))
#define ARG_WS() ((unsigned char*)karg_ptr(19 * 8))
struct Frame {
    LAS unsigned char* lds;
    unsigned char* ws;
    int tid, lane, wave, G, vcu, wave0;
    DEVI void refresh() { tid = opaque_tid(wave0); lane = tid & 63; wave = __builtin_amdgcn_readfirstlane(tid >> 6); }
};
constexpr int NWAVES = 8;

DEVI void transpose_item(const float* W, int K, int N, bf16_t* WT, int k0, int n0, int drow0, LAS float* scr, int lane) {
    const int nc = n0 + 4 * (lane & 7); const bool ok = nc < N;
#pragma unroll
    for (int i = 0; i < 8; ++i) { const int kk = 8 * i + (lane >> 3); const f32x4 v = ok ? *(const f32x4*)(W + (size_t)(k0 + kk) * N + nc) : (f32x4){0.f, 0.f, 0.f, 0.f};
        LAS float* d = scr + kk * 33 + 4 * (lane & 7); d[0] = v[0]; d[1] = v[1]; d[2] = v[2]; d[3] = v[3]; }
    LDS_WAIT(); asm volatile("" ::: "memory");
    const int c = lane & 7;
#pragma unroll
    for (int j = 0; j < 4; ++j) { const int n = (lane >> 3) + 8 * j; const LAS float* s = scr + (8 * c) * 33 + n;
        u32x4 o; o.x = pk2(s[0 * 33], s[1 * 33]); o.y = pk2(s[2 * 33], s[3 * 33]); o.z = pk2(s[4 * 33], s[5 * 33]); o.w = pk2(s[6 * 33], s[7 * 33]);
        *(u32x4*)(WT + (size_t)(drow0 + n) * K + k0 + 8 * c) = o; }
    LDS_WAIT(); asm volatile("" ::: "memory");
}
struct WFam { const float* src; size_t sstride; bf16_t* dst; size_t dstride; int count, K, N, Npad, mode; };
DEVI bool wfam_do(const WFam& f, int& it, LAS float* scr, int lane) {
    const int nkb = f.K / 64, nnb = f.Npad / 32, per = nkb * nnb, tot = per * f.count;
    if (it >= tot) { it -= tot; return false; }
    const int mi = it / per, r = it % per, kb = r / nnb, nb = r % nnb, n0 = nb * 32;
    int drow0 = n0;
    if (f.mode == 1) { const int F = f.N / 2; const int o = n0 < F ? n0 : n0 - F; drow0 = 256 * (o / 128) + (o % 128) + (n0 < F ? 0 : 128); }
    transpose_item(f.src + (size_t)mi * f.sstride, f.K, f.N, f.dst + (size_t)mi * f.dstride, kb * 64, n0, drow0, scr, lane);
    return true;
}

DEVI void phase_prologue(Frame& F) {
    F.refresh();
    LAS float* scr = (LAS float*)(F.lds + F.wave * 16384);
    const int gw = F.vcu * NWAVES + F.wave, NGW = F.G * NWAVES;
    unsigned char* ws = F.ws;
    const WFam fam[11] = {
        {(const float*)ARG_IN(2), (size_t)DM * A_IN, (bf16_t*)(ws + WS_WINA), (size_t)A_INP * DM, 2, DM, A_IN, A_INP, 0},
        {(const float*)ARG_IN(3), (size_t)DM * DM, (bf16_t*)(ws + WS_WOUTA), (size_t)DM * DM, 2, DM, DM, DM, 0},
        {(const float*)ARG_IN(5), (size_t)2048 * 256, (bf16_t*)(ws + WS_WC1), (size_t)256 * 2048, 4, 2048, 256, 256, 0},
        {(const float*)ARG_IN(6), (size_t)256 * 64, (bf16_t*)(ws + WS_WC2), (size_t)256 * 256, 4, 256, 64, 256, 0},
        {(const float*)ARG_IN(8), (size_t)DM * DM, (bf16_t*)(ws + WS_WQKV2), 0, 1, DM, DM, DM, 0},
        {(const float*)ARG_IN(7), 0, (bf16_t*)(ws + WS_WQKV2) + (size_t)DM * DM, 0, 1, DM, 256, 256, 0},
        {(const float*)ARG_IN(8) + (size_t)DM * DM, 0, (bf16_t*)(ws + WS_WQB1), 0, 1, DM, DM, DM, 0},
        {(const float*)ARG_IN(9), (size_t)DM * DM, (bf16_t*)(ws + WS_WOUTB), (size_t)DM * DM, 2, DM, DM, DM, 0},
        {(const float*)ARG_IN(13), (size_t)DM * 2 * DFF, (bf16_t*)(ws + WS_WDIN), (size_t)2 * DFF * DM, 2, DM, 2 * DFF, 2 * DFF, 1},
        {(const float*)ARG_IN(14), (size_t)DFF * DM, (bf16_t*)(ws + WS_WDOUT), (size_t)DM * DFF, 2, DFF, DM, DM, 0},
        {(const float*)ARG_IN(16), (size_t)DM * 2 * DFFE, (bf16_t*)(ws + WS_WMIN), (size_t)2 * DFFE * DM, 16, DM, 2 * DFFE, 2 * DFFE, 1},
    };
    const WFam famo = {(const float*)ARG_IN(17), (size_t)DFFE * DM, (bf16_t*)(ws + WS_WMOUT), (size_t)DM * DFFE, 16, DFFE, DM, DM, 0};
    int total = 0;
#pragma unroll
    for (int i = 0; i < 11; ++i) total += (fam[i].K / 64) * (fam[i].Npad / 32) * fam[i].count;
    total += (famo.K / 64) * (famo.Npad / 32) * famo.count;
    for (int it0 = gw; it0 < total; it0 += NGW) {
        int it = it0; bool done = false;
#pragma unroll
        for (int i = 0; i < 11; ++i) if (!done) done = wfam_do(fam[i], it, scr, F.lane);
        if (!done) wfam_do(famo, it, scr, F.lane);
    }
    { const float* x = (const float*)ARG_IN(0); bf16_t* hb = (bf16_t*)(ws + WS_HB);
      const size_t n8 = (size_t)MTOK * DM / 8;
      for (size_t i = (size_t)blockIdx.x * 512 + F.tid; i < n8; i += (size_t)F.G * 512) {
          const f32x4 v0 = *(const f32x4*)(x + i * 8), v1 = *(const f32x4*)(x + i * 8 + 4);
          u32x4 o; o.x = pk2(v0.x, v0.y); o.y = pk2(v0.z, v0.w); o.z = pk2(v1.x, v1.y); o.w = pk2(v1.z, v1.w);
          *(u32x4*)(hb + i * 8) = o; } }
    { const int* pos = (const int*)ARG_IN(1); float* cs = (float*)(ws + WS_CS);
      for (int i = blockIdx.x * 512 + F.tid; i < MTOK * 8; i += F.G * 512) {
          const int tok = i >> 3, j = i & 7;
          const float invf = (float)exp2(-(double)j * (18.931568569324174 / 8.0));
          const double ang = (double)((float)pos[tok] * invf);
          const double n = rint(ang * 0.15915494309189535); const double r = ang - n * 6.283185307179586476925;
          const float rf = (float)r;
          cs[tok * 16 + j] = cosf(rf); cs[tok * 16 + 8 + j] = sinf(rf); } }
    { const float* cp = (const float*)ARG_IN(4); const float* w1 = (const float*)ARG_IN(5); float* bp = (float*)((unsigned*)(ws + WS_CTL) + CW_BIASP);
      if (gw < 1024) { const int mi = gw >> 8, c = gw & 255; float s = 0.f;
#pragma unroll 8
          for (int i = 0; i < 32; ++i) { const int f = i * 64 + F.lane; s += cp[(size_t)mi * 2048 + f] * w1[((size_t)mi * 2048 + f) * 256 + c]; }
          s = wave_sum(s, F.lane);
          if (F.lane == 0) bp[gw] = s; } }
}

typedef f32x4 AccT[2][2][4][2];

DEVI u32x4 pack8(const f32x4 a, const f32x4 b) { u32x4 w; w.x = pg8::cvt_pk_bf16(a[0], a[1]); w.y = pg8::cvt_pk_bf16(a[2], a[3]); w.z = pg8::cvt_pk_bf16(b[0], b[1]); w.w = pg8::cvt_pk_bf16(b[2], b[3]); return w; }
DEVI void rope8(f32x4& v0, f32x4& v1, int dhead, const float* csrow, int lane) {
    f32x4 p0, p1;
#pragma unroll
    for (int i = 0; i < 4; ++i) { p0[i] = shx(v0[i], 16, lane); p1[i] = shx(v1[i], 16, lane); }
    if (dhead < 16) {
        const f32x4 c0 = *(const f32x4*)(csrow), c1 = *(const f32x4*)(csrow + 4), s0 = *(const f32x4*)(csrow + 8), s1 = *(const f32x4*)(csrow + 12);
        if (dhead == 0) { v0 = v0 * c0 - p0 * s0; v1 = v1 * c1 - p1 * s1; }
        else            { v0 = v0 * c0 + p0 * s0; v1 = v1 * c1 + p1 * s1; }
    }
}

struct EpiNsaIn {
    static constexpr bool PERM = true;
    unsigned char* ws; const float* cs;
    DEVI void operator()(const AccT& acc, const pg8::Unit& u, int wr, int wc, int fr, int fq) const {
        const int pn = u.pn;
        if (pn < 4) {
            bf16_t* Q = (bf16_t*)(ws + RA_Q);
#pragma unroll
            for (int ai = 0; ai < 2; ++ai)
#pragma unroll
                for (int m = 0; m < 4; ++m) { const int row = u.pm * 256 + ai * 128 + wr * 64 + m * 16 + fr;
#pragma unroll
                    for (int bj = 0; bj < 2; ++bj) *(u32x4*)(Q + (size_t)row * DM + pn * 256 + bj * 128 + wc * 32 + fq * 8) = pack8(acc[ai][bj][m][0], acc[ai][bj][m][1]); }
        } else if (pn < 10) {
            const size_t base = pn == 4 ? RA_KCR : pn == 5 ? RA_VCR : pn == 6 ? RA_KS : pn == 7 ? RA_VS : pn == 8 ? RA_KW : RA_VW;
            bf16_t* T = (bf16_t*)(ws + base);
            const bool rot = (pn == 6 || pn == 8);
            const int dh = (wc & 1) * 32 + fq * 8;
#pragma unroll
            for (int ai = 0; ai < 2; ++ai)
#pragma unroll
                for (int m = 0; m < 4; ++m) { const int row = u.pm * 256 + ai * 128 + wr * 64 + m * 16 + fr; const int b = row / SEQ, t = row % SEQ;
#pragma unroll
                    for (int bj = 0; bj < 2; ++bj) { f32x4 v0 = acc[ai][bj][m][0], v1 = acc[ai][bj][m][1];
                        if (rot) rope8(v0, v1, dh, cs + (size_t)row * 16, fq * 16 + fr);
                        const int g = bj * 2 + (wc >> 1);
                        *(u32x4*)(T + ((size_t)(b * A_G + g) * SEQ + t) * HD + dh) = pack8(v0, v1); } }
        } else {
            float* G = (float*)(ws + RA_GATE);
            if (wc < 2) {
#pragma unroll
                for (int ai = 0; ai < 2; ++ai)
#pragma unroll
                    for (int m = 0; m < 4; ++m) { const int row = u.pm * 256 + ai * 128 + wr * 64 + m * 16 + fr;
#pragma unroll
                        for (int n = 0; n < 2; ++n) { const int c = wc * 32 + fq * 8 + n * 4;
                            if (c < 48) { f32x4 v = acc[ai][0][m][n]; f32x4 o;
#pragma unroll
                                for (int i = 0; i < 4; ++i) o[i] = 1.f / (1.f + __expf(-v[i]));
                                *(f32x4*)(G + (size_t)row * 48 + c) = o; } } }
            }
        }
    }
};
struct EpiSwaIn {
    static constexpr bool PERM = true;
    unsigned char* ws; const float* cs;
    DEVI void operator()(const AccT& acc, const pg8::Unit& u, int wr, int wc, int fr, int fq) const {
        const int pn = u.pn; const int dh = (wc & 1) * 32 + fq * 8;
        bf16_t* Q = (bf16_t*)(ws + RA_Q); bf16_t* KS = (bf16_t*)(ws + WS_KSH); bf16_t* VS = (bf16_t*)(ws + WS_VSH);
#pragma unroll
        for (int ai = 0; ai < 2; ++ai)
#pragma unroll
            for (int m = 0; m < 4; ++m) { const int row = u.pm * 256 + ai * 128 + wr * 64 + m * 16 + fr; const int b = row / SEQ, t = row % SEQ;
#pragma unroll
                for (int bj = 0; bj < 2; ++bj) { f32x4 v0 = acc[ai][bj][m][0], v1 = acc[ai][bj][m][1];
                    const bool rot = (pn < 4) || (bj == 0);
                    if (rot) rope8(v0, v1, dh, cs + (size_t)row * 16, fq * 16 + fr);
                    const u32x4 w = pack8(v0, v1);
                    if (pn < 4) *(u32x4*)(Q + (size_t)row * DM + pn * 256 + bj * 128 + wc * 32 + fq * 8) = w;
                    else { bf16_t* T = bj == 0 ? KS : VS; const int g = wc >> 1; *(u32x4*)(T + ((size_t)(b * B_G + g) * SEQ + t) * HD + dh) = w; } } }
    }
};
DEVI float gelu_tanh(float x) { const float u = 0.7978845608028654f * (x + 0.044715f * x * x * x); const float e = __expf(2.f * u); const float th = 1.f - 2.f / (e + 1.f); return 0.5f * x * (1.f + th); }
struct EpiCmpHid {
    static constexpr bool PERM = true;
    bf16_t* out; const float* bias;
    DEVI void operator()(const AccT& acc, const pg8::Unit& u, int wr, int wc, int fr, int fq) const {
        const float* bs = bias;
#pragma unroll
        for (int bj = 0; bj < 2; ++bj) { const int c = bj * 128 + wc * 32 + fq * 8; const f32x4 b0 = *(const f32x4*)(bs + c), b1 = *(const f32x4*)(bs + c + 4);
#pragma unroll
            for (int ai = 0; ai < 2; ++ai)
#pragma unroll
                for (int m = 0; m < 4; ++m) { const int row = u.pm * 256 + ai * 128 + wr * 64 + m * 16 + fr; f32x4 v0 = acc[ai][bj][m][0] + b0, v1 = acc[ai][bj][m][1] + b1;
#pragma unroll
                    for (int i = 0; i < 4; ++i) { v0[i] = gelu_tanh(v0[i]); v1[i] = gelu_tanh(v1[i]); }
                    *(u32x4*)(out + (size_t)row * 256 + c) = pack8(v0, v1); } }
    }
};
struct EpiCmpOut {
    static constexpr bool PERM = true;
    bf16_t* kc; bf16_t* vc;
    DEVI void operator()(const AccT& acc, const pg8::Unit& u, int wr, int wc, int fr, int fq) const {
        if (wc >= 2) return;
        bf16_t* T = u.pm >= 32 ? vc : kc; const int rbase = (u.pm & 31) * 256;
#pragma unroll
        for (int ai = 0; ai < 2; ++ai)
#pragma unroll
            for (int m = 0; m < 4; ++m) { const int row = rbase + ai * 128 + wr * 64 + m * 16 + fr;
                u32x4 w = pack8(acc[ai][0][m][0], acc[ai][0][m][1]);
                if ((row & 1023) == 1023) w = (u32x4){0u, 0u, 0u, 0u};
                *(u32x4*)(T + (size_t)row * 64 + wc * 32 + fq * 8) = w; }
    }
};
struct EpiResid {
    static constexpr bool PERM = true;
    const bf16_t* res; bf16_t* y;
    DEVI void operator()(const AccT& acc, const pg8::Unit& u, int wr, int wc, int fr, int fq) const {
#pragma unroll
        for (int ai = 0; ai < 2; ++ai)
#pragma unroll
            for (int m = 0; m < 4; ++m) { const size_t off = (size_t)(u.pm * 256 + ai * 128 + wr * 64 + m * 16 + fr) * DM + u.pn * 256 + wc * 32 + fq * 8;
#pragma unroll
                for (int bj = 0; bj < 2; ++bj) { const u32x4 r = *(const u32x4*)(res + off + bj * 128);
                    const f32x4 r0 = {bflo(r.x), bfhi(r.x), bflo(r.y), bfhi(r.y)}, r1 = {bflo(r.z), bfhi(r.z), bflo(r.w), bfhi(r.w)};
                    *(u32x4*)(y + off + bj * 128) = pack8(r0 * ALPHA + acc[ai][bj][m][0], r1 * ALPHA + acc[ai][bj][m][1]); } }
    }
};
struct EpiBf16Out {
    static constexpr bool PERM = true;
    bf16_t* y;
    DEVI void operator()(const AccT& acc, const pg8::Unit& u, int wr, int wc, int fr, int fq) const {
#pragma unroll
        for (int ai = 0; ai < 2; ++ai)
#pragma unroll
            for (int m = 0; m < 4; ++m) { const size_t off = (size_t)(u.pm * 256 + ai * 128 + wr * 64 + m * 16 + fr) * DM + u.pn * 256 + wc * 32 + fq * 8;
#pragma unroll
                for (int bj = 0; bj < 2; ++bj) *(u32x4*)(y + off + bj * 128) = pack8(acc[ai][bj][m][0], acc[ai][bj][m][1]); }
    }
};
struct EpiPart {
    static constexpr bool PERM = false;
    float* part;
    DEVI void operator()(const AccT& acc, const pg8::Unit& u, int wr, int wc, int fr, int fq) const {
        float* base = part + (size_t)((u.pm - 256) * 4 + u.z) * 256 * DM;
#pragma unroll
        for (int ai = 0; ai < 2; ++ai)
#pragma unroll
            for (int m = 0; m < 4; ++m) { const size_t off = (size_t)(ai * 128 + wr * 64 + m * 16 + fr) * DM + u.pn * 256 + wc * 32 + fq * 4;
#pragma unroll
                for (int bj = 0; bj < 2; ++bj)
#pragma unroll
                    for (int n = 0; n < 2; ++n) *(f32x4*)(base + off + bj * 128 + n * 16) = acc[ai][bj][m][n]; }
    }
};
struct EpiSwiglu {
    static constexpr bool PERM = true;
    bf16_t* act; int ld;
    DEVI void operator()(const AccT& acc, const pg8::Unit& u, int wr, int wc, int fr, int fq) const {
#pragma unroll
        for (int ai = 0; ai < 2; ++ai)
#pragma unroll
            for (int m = 0; m < 4; ++m) { const size_t row = (size_t)(u.pm * 256 + ai * 128 + wr * 64 + m * 16 + fr); f32x4 o[2];
#pragma unroll
                for (int n = 0; n < 2; ++n)
#pragma unroll
                    for (int i = 0; i < 4; ++i) { const float gv = acc[ai][0][m][n][i], uv = acc[ai][1][m][n][i]; o[n][i] = gv * __builtin_amdgcn_rcpf(1.f + __expf(-gv)) * uv; }
                *(u32x4*)(act + row * ld + u.pn * 128 + wc * 32 + fq * 8) = pack8(o[0], o[1]); }
    }
};

DEVI void unpack8(const u32x4 w, float (&x)[8]) { x[0] = bflo(w.x); x[1] = bfhi(w.x); x[2] = bflo(w.y); x[3] = bfhi(w.y); x[4] = bflo(w.z); x[5] = bfhi(w.z); x[6] = bflo(w.w); x[7] = bfhi(w.w); }
DEVI void moe_row8(const bf16_t* YB, const float* PART, int p, int c, float (&x)[8]) {
    if (p < 65536) { unpack8(*(const u32x4*)(YB + (size_t)p * DM + c), x); return; }
    const float* q = PART + ((size_t)(((p >> 8) - 256) * 4) * 256 + (p & 255)) * DM + c;
    f32x4 a0 = *(const f32x4*)q, a1 = *(const f32x4*)(q + 4);
#pragma unroll
    for (int z = 1; z < 4; ++z) { a0 = a0 + *(const f32x4*)(q + (size_t)z * 256 * DM); a1 = a1 + *(const f32x4*)(q + (size_t)z * 256 * DM + 4); }
    x[0] = a0[0]; x[1] = a0[1]; x[2] = a0[2]; x[3] = a0[3]; x[4] = a1[0]; x[5] = a1[1]; x[6] = a1[2]; x[7] = a1[3];
}
template <int MODE, bool ROUTER, bool FINAL>
DEVI void phase_ln(Frame& F, int lnidx, float* outp, int moe_layer) {
    F.refresh();
    unsigned char* ws = F.ws;
    const bf16_t* Y = (const bf16_t*)(ws + WS_Y); const bf16_t* YB = (const bf16_t*)(ws + WS_YB); const float* PART = (const float*)(ws + WS_H);
    bf16_t* HB = (bf16_t*)(ws + WS_HB);
    const float* gam = (const float*)ARG_IN(11) + (size_t)lnidx * DM; const float* bet = (const float*)ARG_IN(12) + (size_t)lnidx * DM;
    int* TOKE = (int*)(ws + WS_ROUTE); int* TOKR = TOKE + MTOK * 2; float* TOKW = (float*)(TOKR + MTOK * 2); int* TOKP = (int*)(TOKW + MTOK * 2);
    const float* wr_ = ROUTER ? (const float*)ARG_IN(15) + (size_t)moe_layer * DM * NEXP : nullptr;
    LAS int* lcnt = (LAS int*)(F.lds + LDS_X);
    LAS int* lrec = lcnt + 16;
    LAS int* lrank = lrec + 256;
    if (ROUTER) { if (F.tid < 16) lcnt[F.tid] = 0; __syncthreads(); }
    const int gw = F.vcu * NWAVES + F.wave, NGW = F.G * NWAVES;
    int nloc = 0;
    for (int m = gw; m < MTOK; m += NGW, ++nloc) {
        float v[2][8];
        if (MODE == 0) {
#pragma unroll
            for (int j = 0; j < 2; ++j) unpack8(*(const u32x4*)(Y + (size_t)m * DM + j * 512 + F.lane * 8), v[j]);
        } else {
            const int p0 = TOKP[m * 2], p1 = TOKP[m * 2 + 1]; const float w0 = TOKW[m * 2], w1 = TOKW[m * 2 + 1];
#pragma unroll
            for (int j = 0; j < 2; ++j) { const int c = j * 512 + F.lane * 8; float h[8], a[8], b[8];
                unpack8(*(const u32x4*)(HB + (size_t)m * DM + c), h); moe_row8(YB, PART, p0, c, a); moe_row8(YB, PART, p1, c, b);
#pragma unroll
                for (int i = 0; i < 8; ++i) v[j][i] = h[i] * ALPHA + a[i] * w0 + b[i] * w1; }
        }
        float s = 0.f;
#pragma unroll
        for (int j = 0; j < 2; ++j)
#pragma unroll
            for (int i = 0; i < 8; ++i) s += v[j][i];
        const float mean = wave_sum(s, F.lane) * (1.f / DM); float s2 = 0.f;
#pragma unroll
        for (int j = 0; j < 2; ++j)
#pragma unroll
            for (int i = 0; i < 8; ++i) { v[j][i] -= mean; s2 += v[j][i] * v[j][i]; }
        const float rstd = 1.f / sqrtf(wave_sum(s2, F.lane) * (1.f / DM) + LN_EPS);
#pragma unroll
        for (int j = 0; j < 2; ++j) { const int c = j * 512 + F.lane * 8;
            const f32x4 g0 = *(const f32x4*)(gam + c), g1 = *(const f32x4*)(gam + c + 4), b0 = *(const f32x4*)(bet + c), b1 = *(const f32x4*)(bet + c + 4);
#pragma unroll
            for (int i = 0; i < 4; ++i) { v[j][i] = v[j][i] * rstd * g0[i] + b0[i]; v[j][4 + i] = v[j][4 + i] * rstd * g1[i] + b1[i]; }
            if (FINAL) { *(f32x4*)(outp + (size_t)m * DM + c) = (f32x4){v[j][0], v[j][1], v[j][2], v[j][3]}; *(f32x4*)(outp + (size_t)m * DM + c + 4) = (f32x4){v[j][4], v[j][5], v[j][6], v[j][7]}; }
            else { u32x4 w; w.x = pk2(v[j][0], v[j][1]); w.y = pk2(v[j][2], v[j][3]); w.z = pk2(v[j][4], v[j][5]); w.w = pk2(v[j][6], v[j][7]); *(u32x4*)(HB + (size_t)m * DM + c) = w; } }
        if (ROUTER) {
            float lg[NEXP];
#pragma unroll
            for (int e = 0; e < NEXP; ++e) lg[e] = 0.f;
#pragma unroll
            for (int j = 0; j < 2; ++j)
#pragma unroll
                for (int i = 0; i < 8; ++i) { const int c = j * 512 + F.lane * 8 + i; const f32x4 w0 = *(const f32x4*)(wr_ + (size_t)c * NEXP), w1 = *(const f32x4*)(wr_ + (size_t)c * NEXP + 4); const float x = v[j][i];
                    lg[0] += x * w0.x; lg[1] += x * w0.y; lg[2] += x * w0.z; lg[3] += x * w0.w; lg[4] += x * w1.x; lg[5] += x * w1.y; lg[6] += x * w1.z; lg[7] += x * w1.w; }
#pragma unroll
            for (int e = 0; e < NEXP; ++e) lg[e] = wave_sum(lg[e], F.lane);
            int e0 = 0; float l0 = lg[0];
#pragma unroll
            for (int e = 1; e < NEXP; ++e) if (lg[e] > l0) { l0 = lg[e]; e0 = e; }
            int e1 = -1; float l1 = -3.4e38f;
#pragma unroll
            for (int e = 0; e < NEXP; ++e) if (e != e0 && lg[e] > l1) { l1 = lg[e]; e1 = e; }
            if (e1 < 0) e1 = (e0 + 1) & 7;
            const float g1 = 1.f / (1.f + __expf(l0 - l1)), g0 = 1.f - g1;
            if (F.lane == 0) {
                const int idx = (F.wave * 16 + nloc) * 2;
                lrec[idx] = m * 16 + e0; lrec[idx + 1] = m * 16 + e1;
                TOKE[m * 2] = e0; TOKE[m * 2 + 1] = e1; TOKW[m * 2] = g0; TOKW[m * 2 + 1] = g1;
            }
        }
    }
    if (ROUTER) {
        __syncthreads();
        unsigned* cnt = (unsigned*)(ws + WS_CTL) + CW_MOE + moe_layer * 64;
        int* wgcnt = (int*)(ws + WS_CTL) + CW_WGCNT + moe_layer * 2048 + (int)blockIdx.x * 8;
        LAS int* wcnt = lrank;
        int rec = 0, e = 0, r = 0;
        if (F.wave < 4) { rec = lrec[F.tid]; e = rec & 15;
            const unsigned long long lt = (1ull << F.lane) - 1ull;
#pragma unroll
            for (int x = 0; x < 8; ++x) { const unsigned long long b = __builtin_amdgcn_ballot_w64(e == x); if (e == x) r = __builtin_popcountll(b & lt); if (F.lane == 0) wcnt[F.wave * 8 + x] = __builtin_popcountll(b); } }
        __syncthreads();
        if (F.wave < 4) { for (int w = 0; w < F.wave; ++w) r += wcnt[w * 8 + e]; TOKR[(rec >> 4) * 2 + (F.tid & 1)] = r; }
        if (F.tid < 8) lcnt[F.tid] = wcnt[F.tid] + wcnt[8 + F.tid] + wcnt[16 + F.tid] + wcnt[24 + F.tid];
        __syncthreads();
        if (F.tid < 8) { wgcnt[F.tid] = lcnt[F.tid]; __hip_atomic_fetch_add(cnt + F.tid, (unsigned)lcnt[F.tid], __ATOMIC_RELAXED, __HIP_MEMORY_SCOPE_AGENT); }
    }
}

DEVI void moe_tiles(const unsigned* cnt, int (&ts)[9]) { ts[0] = 0;
#pragma unroll
    for (int e = 0; e < 8; ++e) ts[e + 1] = ts[e] + (int)((__hip_atomic_load(cnt + e, __ATOMIC_RELAXED, __HIP_MEMORY_SCOPE_AGENT) + 255u) >> 8); }
DEVI void phase_moe_scatter(Frame& F, int moe_layer) {
    F.refresh();
    unsigned char* ws = F.ws;
    const unsigned* cnt = (const unsigned*)(ws + WS_CTL) + CW_MOE + moe_layer * 64;
    int ts[9]; moe_tiles(cnt, ts);
    LAS int* wbase = (LAS int*)(F.lds + LDS_X);
    if (F.tid < 8) wbase[F.tid] = 0;
    __syncthreads();
    if (F.tid < (int)blockIdx.x) { const int* wc = (const int*)(ws + WS_CTL) + CW_WGCNT + moe_layer * 2048 + F.tid * 8;
        const u32x4 c0 = *(const u32x4*)wc, c1 = *(const u32x4*)(wc + 4);
#pragma unroll
        for (int e = 0; e < 4; ++e) { __hip_atomic_fetch_add(wbase + e, (int)c0[e], __ATOMIC_RELAXED, __HIP_MEMORY_SCOPE_WORKGROUP); __hip_atomic_fetch_add(wbase + 4 + e, (int)c1[e], __ATOMIC_RELAXED, __HIP_MEMORY_SCOPE_WORKGROUP); } }
    __syncthreads();
    const int* TOKE = (const int*)(ws + WS_ROUTE); const int* TOKR = TOKE + MTOK * 2; int* TOKP = (int*)(ws + WS_ROUTE) + MTOK * 6;
    const bf16_t* HB = (const bf16_t*)(ws + WS_HB); bf16_t* XB = (bf16_t*)(ws + WS_XB);
    const int gw = F.vcu * NWAVES + F.wave, NGW = F.G * NWAVES;
    for (int m = gw; m < MTOK; m += NGW) {
        const u32x4 r0 = *(const u32x4*)(HB + (size_t)m * DM + F.lane * 8), r1 = *(const u32x4*)(HB + (size_t)m * DM + 512 + F.lane * 8);
#pragma unroll
        for (int k = 0; k < 2; ++k) { const int e = TOKE[m * 2 + k], r = TOKR[m * 2 + k];
            int st = 0;
#pragma unroll
            for (int j = 1; j < 8; ++j) st = (e >= j) ? ts[j] : st;
            const int pos = st * 256 + wbase[e] + r;
            *(u32x4*)(XB + (size_t)pos * DM + F.lane * 8) = r0; *(u32x4*)(XB + (size_t)pos * DM + 512 + F.lane * 8) = r1;
            if (F.lane == 0) TOKP[m * 2 + k] = pos; }
    }
}

DEVI void phase_nsa_naive(Frame& F) {
    F.refresh();
    unsigned char* ws = F.ws;
    const bf16_t* Q = (const bf16_t*)(ws + RA_Q); bf16_t* ATT = (bf16_t*)(ws + RA_ATT);
    const bf16_t* KC = (const bf16_t*)(ws + RA_KC); const bf16_t* VC = (const bf16_t*)(ws + RA_VC);
    const bf16_t* KS = (const bf16_t*)(ws + RA_KS); const bf16_t* VS = (const bf16_t*)(ws + RA_VS);
    const bf16_t* KW = (const bf16_t*)(ws + RA_KW); const bf16_t* VW = (const bf16_t*)(ws + RA_VW);
    const float* GT = (const float*)(ws + RA_GATE); const float* CS = (const float*)(ws + WS_CS);
    LAS float* sc = (LAS float*)(F.lds + F.wave * 16384);
    LAS float* qs_ = (LAS float*)(F.lds + LDS_X + F.wave * 2048);
    LAS float* qr_ = qs_ + 256;
    const int lane = F.lane;
    const int gw = F.vcu * NWAVES + F.wave, NGW = F.G * NWAVES;
    for (int u = gw; u < MTOK * A_G; u += NGW) {
        const int bg = u / SEQ, t = u % SEQ, b = bg / A_G, g = bg % A_G; const int tok = b * SEQ + t;
        { const bf16_t* qp = Q + (size_t)tok * DM + g * 256 + lane * 4; const u32x2 w = *(const u32x2*)qp;
          float x[4] = {bflo(w.x), bfhi(w.x), bflo(w.y), bfhi(w.y)};
#pragma unroll
          for (int i = 0; i < 4; ++i) qs_[lane * 4 + i] = x[i];
          LDS_WAIT();
          const int d0 = (lane * 4) & 63;
#pragma unroll
          for (int i = 0; i < 4; ++i) { const int d = d0 + i; float v = x[i];
              if (d < 8) v = x[i] * CS[(size_t)tok * 16 + d] - qs_[lane * 4 + i + 8] * CS[(size_t)tok * 16 + 8 + d];
              else if (d < 16) v = x[i] * CS[(size_t)tok * 16 + d - 8] + qs_[lane * 4 + i - 8] * CS[(size_t)tok * 16 + d];
              qr_[lane * 4 + i] = v; }
          LDS_WAIT(); }
        float oc[4] = {0.f, 0.f, 0.f, 0.f}, os[4] = {0.f, 0.f, 0.f, 0.f}, ow[4] = {0.f, 0.f, 0.f, 0.f};
        const int cur = t >> 6;
        const int nv = t >= 31 ? ((t - 31) >> 4) + 1 : 0;
        float impv[4] = {0.f, 0.f, 0.f, 0.f};
        if (nv > 0) {
            const bf16_t* kc = KC + (size_t)bg * 1024 * 64; const bf16_t* vc = VC + (size_t)bg * 1024 * 64;
            float mx[4] = {-3.0e38f, -3.0e38f, -3.0e38f, -3.0e38f};
            for (int c = 0; c * 64 < nv; ++c) { const int n = c * 64 + lane;
                if (n < nv) { float s[4] = {0.f, 0.f, 0.f, 0.f}; LAS float* qs = qs_; asm volatile("" : "+v"(qs));
#pragma unroll 2
                    for (int d8 = 0; d8 < 8; ++d8) { const u32x4 w = *(const u32x4*)(kc + (size_t)n * 64 + d8 * 8);
                        const float kf[8] = {bflo(w.x), bfhi(w.x), bflo(w.y), bfhi(w.y), bflo(w.z), bfhi(w.z), bflo(w.w), bfhi(w.w)};
#pragma unroll
                        for (int r = 0; r < 4; ++r) { const f32x4 qa = *(const LAS f32x4*)(qs + r * 64 + d8 * 8), qb = *(const LAS f32x4*)(qs + r * 64 + d8 * 8 + 4);
                            s[r] += qa.x * kf[0] + qa.y * kf[1] + qa.z * kf[2] + qa.w * kf[3] + qb.x * kf[4] + qb.y * kf[5] + qb.z * kf[6] + qb.w * kf[7]; } }
#pragma unroll
                    for (int r = 0; r < 4; ++r) { s[r] *= QSCALE; mx[r] = fmaxf(mx[r], s[r]); }
                    *(LAS f32x4*)(sc + n * 4) = (f32x4){s[0], s[1], s[2], s[3]}; } }
            float l[4] = {0.f, 0.f, 0.f, 0.f};
#pragma unroll
            for (int r = 0; r < 4; ++r) mx[r] = wave_max(mx[r], lane);
            LDS_WAIT();
            for (int c = 0; c * 64 < nv; ++c) { const int n = c * 64 + lane;
                if (n < nv) { f32x4 s = *(const LAS f32x4*)(sc + n * 4);
#pragma unroll
                    for (int r = 0; r < 4; ++r) { s[r] = __expf(s[r] - mx[r]); l[r] += s[r]; }
                    *(LAS f32x4*)(sc + n * 4) = s; } }
#pragma unroll
            for (int r = 0; r < 4; ++r) l[r] = 1.f / wave_sum(l[r], lane);
            LDS_WAIT();
            for (int c = 0; c * 64 < nv; ++c) { const int n = c * 64 + lane;
                if (n < nv) { f32x4 s = *(const LAS f32x4*)(sc + n * 4);
#pragma unroll
                    for (int r = 0; r < 4; ++r) s[r] *= l[r];
                    *(LAS f32x4*)(sc + n * 4) = s; } }
            LDS_WAIT();
#pragma unroll 4
            for (int n = 0; n < nv; ++n) { const float v = bf2f(vc[(size_t)n * 64 + lane]); const f32x4 p = *(const LAS f32x4*)(sc + n * 4);
#pragma unroll
                for (int r = 0; r < 4; ++r) oc[r] += p[r] * v; }
#pragma unroll
            for (int i = 0; i < 4; ++i) { const int j = lane + 64 * i; float acc = 0.f;
#pragma unroll
                for (int k = -1; k <= 3; ++k) { const int n = 4 * j + k; if (n >= 0 && n < nv) { const f32x4 p = *(const LAS f32x4*)(sc + n * 4); const float ps = (p.x + p.y) + (p.z + p.w); acc += (k == -1 || k == 3) ? 0.5f * ps : ps; } }
                impv[i] = acc; }
        }
        float scv[4];
#pragma unroll
        for (int i = 0; i < 4; ++i) { const int j = lane + 64 * i; scv[i] = j > cur ? -1.f : ((j == 0 || j == cur || j == cur - 1) ? 1e9f : impv[i]); }
        LAS int* sel = (LAS int*)(F.lds + MISC_OFF + 256) + F.wave * 16;
#pragma unroll 1
        for (int k = 0; k < NSEL; ++k) {
            float bv = -2.f; int bi = 1 << 20;
#pragma unroll
            for (int i = 0; i < 4; ++i) { const int j = lane + 64 * i; if (scv[i] > bv) { bv = scv[i]; bi = j; } }
#pragma unroll
            for (int o = 1; o < 64; o <<= 1) { const float ov = shx(bv, o, lane); const int oi = shxi(bi, o, lane); if (ov > bv || (ov == bv && oi < bi)) { bv = ov; bi = oi; } }
            if (lane == 0) sel[k] = bi;
#pragma unroll
            for (int i = 0; i < 4; ++i) if (lane + 64 * i == bi) scv[i] = -3.f;
        }
        LDS_WAIT();
        {   const bf16_t* ks = KS + (size_t)bg * SEQ * 64; const bf16_t* vs = VS + (size_t)bg * SEQ * 64;
            float mx[4] = {-3.0e38f, -3.0e38f, -3.0e38f, -3.0e38f};
#pragma unroll 1
            for (int k = 0; k < NSEL; ++k) { const int pos = sel[k] * 64 + lane; const bool ok = pos <= t;
                float s[4] = {-1e30f, -1e30f, -1e30f, -1e30f};
                if (ok) { LAS float* qr = qr_; asm volatile("" : "+v"(qr));
#pragma unroll
                    for (int r = 0; r < 4; ++r) s[r] = 0.f;
#pragma unroll 2
                    for (int d8 = 0; d8 < 8; ++d8) { const u32x4 w = *(const u32x4*)(ks + (size_t)pos * 64 + d8 * 8);
                        const float kf[8] = {bflo(w.x), bfhi(w.x), bflo(w.y), bfhi(w.y), bflo(w.z), bfhi(w.z), bflo(w.w), bfhi(w.w)};
#pragma unroll
                        for (int r = 0; r < 4; ++r) { const f32x4 qa = *(const LAS f32x4*)(qr + r * 64 + d8 * 8), qb = *(const LAS f32x4*)(qr + r * 64 + d8 * 8 + 4);
                            s[r] += qa.x * kf[0] + qa.y * kf[1] + qa.z * kf[2] + qa.w * kf[3] + qb.x * kf[4] + qb.y * kf[5] + qb.z * kf[6] + qb.w * kf[7]; } }
#pragma unroll
                    for (int r = 0; r < 4; ++r) { s[r] *= QSCALE; mx[r] = fmaxf(mx[r], s[r]); } }
                *(LAS f32x4*)(sc + (k * 64 + lane) * 4) = (f32x4){s[0], s[1], s[2], s[3]}; }
            float l[4] = {0.f, 0.f, 0.f, 0.f};
#pragma unroll
            for (int r = 0; r < 4; ++r) mx[r] = wave_max(mx[r], lane);
            LDS_WAIT();
#pragma unroll 1
            for (int k = 0; k < NSEL; ++k) { const int pos = sel[k] * 64 + lane; const bool ok = pos <= t; f32x4 s = *(const LAS f32x4*)(sc + (k * 64 + lane) * 4);
#pragma unroll
                for (int r = 0; r < 4; ++r) { s[r] = ok ? __expf(s[r] - mx[r]) : 0.f; l[r] += s[r]; }
                *(LAS f32x4*)(sc + (k * 64 + lane) * 4) = s; }
#pragma unroll
            for (int r = 0; r < 4; ++r) l[r] = 1.f / wave_sum(l[r], lane);
            LDS_WAIT();
#pragma unroll 1
            for (int k = 0; k < NSEL; ++k) { const int p0 = sel[k] * 64; if (p0 > t) continue;
#pragma unroll 4
                for (int i = 0; i < 64; ++i) { const int pos = p0 + i; if (pos > t) break; const float v = bf2f(vs[(size_t)pos * 64 + lane]); const f32x4 p = *(const LAS f32x4*)(sc + (k * 64 + i) * 4);
#pragma unroll
                    for (int r = 0; r < 4; ++r) os[r] += p[r] * v; } }
#pragma unroll
            for (int r = 0; r < 4; ++r) os[r] *= l[r];
            LDS_WAIT();
        }
        {   const bf16_t* kw = KW + (size_t)bg * SEQ * 64; const bf16_t* vw = VW + (size_t)bg * SEQ * 64;
            float mx[4] = {-3.0e38f, -3.0e38f, -3.0e38f, -3.0e38f};
#pragma unroll 1
            for (int c = 0; c < 8; ++c) { const int pos = t - 511 + c * 64 + lane; const bool ok = pos >= 0;
                float s[4] = {-1e30f, -1e30f, -1e30f, -1e30f};
                if (ok) { LAS float* qr = qr_; asm volatile("" : "+v"(qr));
#pragma unroll
                    for (int r = 0; r < 4; ++r) s[r] = 0.f;
#pragma unroll 2
                    for (int d8 = 0; d8 < 8; ++d8) { const u32x4 w = *(const u32x4*)(kw + (size_t)pos * 64 + d8 * 8);
                        const float kf[8] = {bflo(w.x), bfhi(w.x), bflo(w.y), bfhi(w.y), bflo(w.z), bfhi(w.z), bflo(w.w), bfhi(w.w)};
#pragma unroll
                        for (int r = 0; r < 4; ++r) { const f32x4 qa = *(const LAS f32x4*)(qr + r * 64 + d8 * 8), qb = *(const LAS f32x4*)(qr + r * 64 + d8 * 8 + 4);
                            s[r] += qa.x * kf[0] + qa.y * kf[1] + qa.z * kf[2] + qa.w * kf[3] + qb.x * kf[4] + qb.y * kf[5] + qb.z * kf[6] + qb.w * kf[7]; } }
#pragma unroll
                    for (int r = 0; r < 4; ++r) { s[r] *= QSCALE; mx[r] = fmaxf(mx[r], s[r]); } }
                *(LAS f32x4*)(sc + (c * 64 + lane) * 4) = (f32x4){s[0], s[1], s[2], s[3]}; }
            float l[4] = {0.f, 0.f, 0.f, 0.f};
#pragma unroll
            for (int r = 0; r < 4; ++r) mx[r] = wave_max(mx[r], lane);
            LDS_WAIT();
#pragma unroll 1
            for (int c = 0; c < 8; ++c) { const int pos = t - 511 + c * 64 + lane; const bool ok = pos >= 0; f32x4 s = *(const LAS f32x4*)(sc + (c * 64 + lane) * 4);
#pragma unroll
                for (int r = 0; r < 4; ++r) { s[r] = ok ? __expf(s[r] - mx[r]) : 0.f; l[r] += s[r]; }
                *(LAS f32x4*)(sc + (c * 64 + lane) * 4) = s; }
#pragma unroll
            for (int r = 0; r < 4; ++r) l[r] = 1.f / wave_sum(l[r], lane);
            LDS_WAIT();
#pragma unroll 4
            for (int i = (t >= 511 ? 0 : 511 - t); i < 512; ++i) { const int pos = t - 511 + i; const float v = bf2f(vw[(size_t)pos * 64 + lane]); const f32x4 p = *(const LAS f32x4*)(sc + i * 4);
#pragma unroll
                for (int r = 0; r < 4; ++r) ow[r] += p[r] * v; }
#pragma unroll
            for (int r = 0; r < 4; ++r) ow[r] *= l[r];
            LDS_WAIT();
        }
#pragma unroll
        for (int r = 0; r < 4; ++r) { const float gc = GT[(size_t)tok * 48 + 0 * 16 + g * 4 + r], gs = GT[(size_t)tok * 48 + 1 * 16 + g * 4 + r], gwv = GT[(size_t)tok * 48 + 2 * 16 + g * 4 + r];
            const float o = ((DBG_DROP & 1) ? 0.f : gc * oc[r]) + ((DBG_DROP & 2) ? 0.f : gs * os[r]) + ((DBG_DROP & 4) ? 0.f : gwv * ow[r]);
            ATT[(size_t)tok * DM + g * 256 + r * 64 + lane] = (bf16_t)f2bf(o); }
    }
}

DEVI void phase_swa_naive(Frame& F, const float* sinks) {
    F.refresh();
    unsigned char* ws = F.ws;
    const bf16_t* Q = (const bf16_t*)(ws + RA_Q); bf16_t* ATT = (bf16_t*)(ws + RA_ATT);
    const bf16_t* KS = (const bf16_t*)(ws + WS_KSH); const bf16_t* VS = (const bf16_t*)(ws + WS_VSH);
    LAS float* sc = (LAS float*)(F.lds + F.wave * 16384);
    LAS float* qs_ = (LAS float*)(F.lds + LDS_X + F.wave * 2048);
    const int lane = F.lane;
    const int gw = F.vcu * NWAVES + F.wave, NGW = F.G * NWAVES;
    for (int u = gw; u < MTOK * B_G; u += NGW) {
        const int bg = u / SEQ, t = u % SEQ, b = bg / B_G, g = bg % B_G; const int tok = b * SEQ + t;
        { const u32x4 w = *(const u32x4*)(Q + (size_t)tok * DM + g * 512 + lane * 8);
          const float x[8] = {bflo(w.x), bfhi(w.x), bflo(w.y), bfhi(w.y), bflo(w.z), bfhi(w.z), bflo(w.w), bfhi(w.w)};
#pragma unroll
          for (int i = 0; i < 8; ++i) qs_[lane * 8 + i] = x[i];
          LDS_WAIT(); }
        const bf16_t* kp = KS + (size_t)bg * SEQ * 64; const bf16_t* vp = VS + (size_t)bg * SEQ * 64;
        float mx[8], l[8], o[8];
#pragma unroll
        for (int r = 0; r < 8; ++r) { mx[r] = sinks[g * 8 + r]; l[r] = 0.f; o[r] = 0.f; }
#pragma unroll 1
        for (int c = 0; c < 2; ++c) { const int pos = t - 127 + c * 64 + lane; const bool ok = pos >= 0;
            float s[8];
#pragma unroll
            for (int r = 0; r < 8; ++r) s[r] = -1e30f;
            if (ok) { LAS float* qs = qs_; asm volatile("" : "+v"(qs));
#pragma unroll
                for (int r = 0; r < 8; ++r) s[r] = 0.f;
#pragma unroll 1
                for (int d8 = 0; d8 < 8; ++d8) { const u32x4 w = *(const u32x4*)(kp + (size_t)pos * 64 + d8 * 8);
                    const float kf[8] = {bflo(w.x), bfhi(w.x), bflo(w.y), bfhi(w.y), bflo(w.z), bfhi(w.z), bflo(w.w), bfhi(w.w)};
#pragma unroll
                    for (int r = 0; r < 8; ++r) { const f32x4 qa = *(const LAS f32x4*)(qs + r * 64 + d8 * 8), qb = *(const LAS f32x4*)(qs + r * 64 + d8 * 8 + 4);
                        s[r] += qa.x * kf[0] + qa.y * kf[1] + qa.z * kf[2] + qa.w * kf[3] + qb.x * kf[4] + qb.y * kf[5] + qb.z * kf[6] + qb.w * kf[7]; } }
#pragma unroll
                for (int r = 0; r < 8; ++r) { s[r] *= QSCALE; mx[r] = fmaxf(mx[r], s[r]); } }
            *(LAS f32x4*)(sc + (c * 64 + lane) * 8) = (f32x4){s[0], s[1], s[2], s[3]}; *(LAS f32x4*)(sc + (c * 64 + lane) * 8 + 4) = (f32x4){s[4], s[5], s[6], s[7]}; }
#pragma unroll
        for (int r = 0; r < 8; ++r) mx[r] = wave_max(mx[r], lane);
        LDS_WAIT();
#pragma unroll
        for (int c = 0; c < 2; ++c) { const int pos = t - 127 + c * 64 + lane; const bool ok = pos >= 0;
            f32x4 s0 = *(const LAS f32x4*)(sc + (c * 64 + lane) * 8), s1 = *(const LAS f32x4*)(sc + (c * 64 + lane) * 8 + 4);
#pragma unroll
            for (int r = 0; r < 4; ++r) { s0[r] = ok ? __expf(s0[r] - mx[r]) : 0.f; l[r] += s0[r]; s1[r] = ok ? __expf(s1[r] - mx[r + 4]) : 0.f; l[r + 4] += s1[r]; }
            *(LAS f32x4*)(sc + (c * 64 + lane) * 8) = s0; *(LAS f32x4*)(sc + (c * 64 + lane) * 8 + 4) = s1; }
#pragma unroll
        for (int r = 0; r < 8; ++r) l[r] = 1.f / (wave_sum(l[r], lane) + __expf(sinks[g * 8 + r] - mx[r]));
        LDS_WAIT();
#pragma unroll 4
        for (int i = (t >= 127 ? 0 : 127 - t); i < 128; ++i) { const int pos = t - 127 + i; const float v = bf2f(vp[(size_t)pos * 64 + lane]);
            const f32x4 p0 = *(const LAS f32x4*)(sc + i * 8), p1 = *(const LAS f32x4*)(sc + i * 8 + 4);
#pragma unroll
            for (int r = 0; r < 4; ++r) { o[r] += p0[r] * v; o[r + 4] += p1[r] * v; } }
#pragma unroll
        for (int r = 0; r < 8; ++r) ATT[(size_t)tok * DM + g * 512 + r * 64 + lane] = (bf16_t)f2bf(o[r] * l[r]);
        LDS_WAIT();
    }
}

namespace fa {
typedef short v4i16_t __attribute__((ext_vector_type(4)));
constexpr float CEXP = 0.125f * 1.4426950408889634f;
constexpr float NEGINF = -__builtin_huge_valf();
constexpr int VLD = 160;
constexpr int KVB = 8192 + 64 * VLD;
constexpr int L_KV = 0;
constexpr int L_IMP = 2 * KVB;
constexpr int IMP_LD = 264;
constexpr int OS_LD = 65;
constexpr int L_Q = L_IMP + 64 * IMP_LD * 4;
constexpr int L_ML = L_Q + 32768;
constexpr int L_MASK = L_ML + 2048;
constexpr int L_LIST = L_MASK + 2048;
constexpr int L_TOK = L_LIST + 1056;
constexpr int L_END = L_TOK + 2048;
static_assert(256 * OS_LD * 4 <= 64 * IMP_LD * 4, "accumulator fits the importance table");
static_assert(L_END <= MISC_OFF, "attention LDS map");

struct Stage { u32x4 k, v; };
template <bool WITHV> DEVI void stage_load(Stage& s, const bf16_t* K, const bf16_t* V, int tid) { s.k = *(const u32x4*)((const char*)K + tid * 16); if (WITHV) s.v = *(const u32x4*)((const char*)V + tid * 16); }
template <bool WITHV> DEVI void stage_write(const Stage& s, LAS unsigned char* buf, int tid) {
    const int r = tid >> 3, c = tid & 7;
    *(LAS u32x4*)(buf + r * 128 + ((c ^ (r & 7)) << 4)) = s.k;
    if (WITHV) *(LAS u32x4*)(buf + 8192 + r * VLD + (c << 4)) = s.v;
}
DEVI float max_quads(float x) {
    auto a = __builtin_amdgcn_permlane16_swap(__float_as_uint(x), __float_as_uint(x), false, false); x = fmaxf(__uint_as_float(a[0]), __uint_as_float(a[1]));
    auto b = __builtin_amdgcn_permlane32_swap(__float_as_uint(x), __float_as_uint(x), false, false); return fmaxf(__uint_as_float(b[0]), __uint_as_float(b[1]));
}
DEVI float sum_quads(float x) {
    auto a = __builtin_amdgcn_permlane16_swap(__float_as_uint(x), __float_as_uint(x), false, false); x = __uint_as_float(a[0]) + __uint_as_float(a[1]);
    auto b = __builtin_amdgcn_permlane32_swap(__float_as_uint(x), __float_as_uint(x), false, false); return __uint_as_float(b[0]) + __uint_as_float(b[1]);
}
template <int CTRL> DEVI float dppf(float v) { return __int_as_float(__builtin_amdgcn_update_dpp(0, __float_as_int(v), CTRL, 0xF, 0xF, false)); }
template <int CTRL> DEVI int dppi(int v) { return __builtin_amdgcn_update_dpp(0, v, CTRL, 0xF, 0xF, false); }
DEVI float bperm(float v, int src_lane) { return __builtin_bit_cast(float, __builtin_amdgcn_ds_bpermute(src_lane << 2, __builtin_bit_cast(int, v))); }
#define DPP_X1 0xB1
#define DPP_X2 0x4E
#define DPP_HM 0x141

DEVI void qk_slot(LAS const unsigned char* kb, const bf16x8 q0, const bf16x8 q1, int lane, f32x4 (&s)[4]) {
    const int l15 = lane & 15, quad = lane >> 4;
    LAS const unsigned char* p0 = kb + l15 * 128 + (((quad) ^ (l15 & 7)) << 4);
    LAS const unsigned char* p1 = kb + l15 * 128 + (((4 + quad) ^ (l15 & 7)) << 4);
#pragma unroll
    for (int kg = 0; kg < 4; ++kg) {
        const bf16x8 a0 = *(LAS const bf16x8*)(p0 + kg * 2048), a1 = *(LAS const bf16x8*)(p1 + kg * 2048);
        f32x4 z = {0.f, 0.f, 0.f, 0.f};
        z = __builtin_amdgcn_mfma_f32_16x16x32_bf16(a0, q0, z, 0, 0, 0);
        s[kg] = __builtin_amdgcn_mfma_f32_16x16x32_bf16(a1, q1, z, 0, 0, 0);
    }
}
DEVI float mask_max(f32x4 (&s)[4], int lo, int hi, int quad) {
    float mx = NEGINF; const int loq = lo - 4 * quad, hiq = hi - 4 * quad;
#pragma unroll
    for (int kg = 0; kg < 4; ++kg)
#pragma unroll
        for (int i = 0; i < 4; ++i) { const bool ok = (16 * kg + i >= loq) & (16 * kg + i <= hiq); s[kg][i] = ok ? s[kg][i] : NEGINF; mx = fmaxf(mx, s[kg][i]); }
    return max_quads(mx);
}
DEVI bf16x8 pack_p(const f32x4 a, const f32x4 b) { u32x4 w; w.x = pg8::cvt_pk_bf16(a[0], a[1]); w.y = pg8::cvt_pk_bf16(a[2], a[3]); w.z = pg8::cvt_pk_bf16(b[0], b[1]); w.w = pg8::cvt_pk_bf16(b[2], b[3]); return __builtin_bit_cast(bf16x8, w); }
DEVI void pv_slot(LAS const unsigned char* vb, const bf16x8 (&pb)[2], f32x4 (&o)[4], int lane) {
    const int i = lane & 15, quad = lane >> 4;
    LAS const unsigned char* a0 = vb + (4 * quad + (i >> 2)) * VLD + ((i & 3) << 3);
#pragma unroll
    for (int ks2 = 0; ks2 < 2; ++ks2) {
#pragma unroll
        for (int dg = 0; dg < 4; ++dg) {
            const v4i16_t t0 = __builtin_amdgcn_ds_read_tr16_b64_v4i16((LAS v4i16_t*)(a0 + (32 * ks2) * VLD + 32 * dg));
            const v4i16_t t1 = __builtin_amdgcn_ds_read_tr16_b64_v4i16((LAS v4i16_t*)(a0 + (32 * ks2 + 16) * VLD + 32 * dg));
            const bf16x8 a = {t0[0], t0[1], t0[2], t0[3], t1[0], t1[1], t1[2], t1[3]};
            o[dg] = __builtin_amdgcn_mfma_f32_16x16x32_bf16(a, pb[ks2], o[dg], 0, 0, 0);
        }
    }
}
template <bool PV> DEVI void online_step(LAS const unsigned char* buf, const bf16x8 q0, const bf16x8 q1, int lo, int hi, float& m, float& l, f32x4 (&o)[4], int lane) {
    __builtin_amdgcn_sched_barrier(0);
    f32x4 s[4]; qk_slot(buf, q0, q1, lane, s);
    __builtin_amdgcn_sched_barrier(0);
    const int quad = lane >> 4;
    float mx;
    if (__builtin_amdgcn_ballot_w64((lo > 0) | (hi < 63)) != 0ull) mx = mask_max(s, lo, hi, quad);
    else { float a = fmaxf(fmaxf(s[0][0], s[0][1]), fmaxf(s[0][2], s[0][3])), b = fmaxf(fmaxf(s[1][0], s[1][1]), fmaxf(s[1][2], s[1][3]));
           a = fmaxf(a, fmaxf(fmaxf(s[2][0], s[2][1]), fmaxf(s[2][2], s[2][3]))); b = fmaxf(b, fmaxf(fmaxf(s[3][0], s[3][1]), fmaxf(s[3][2], s[3][3]))); mx = max_quads(fmaxf(a, b)); }
    const float mnew = fmaxf(m, mx);
    const float msafe = (mnew == NEGINF) ? 0.f : mnew;
    const float alpha = __builtin_amdgcn_exp2f((m - msafe) * CEXP);
    const float mc = -msafe * CEXP;
    float ps = 0.f;
#pragma unroll
    for (int kg = 0; kg < 4; ++kg)
#pragma unroll
        for (int i = 0; i < 4; ++i) { s[kg][i] = __builtin_amdgcn_exp2f(__builtin_fmaf(s[kg][i], CEXP, mc)); ps += s[kg][i]; }
    l = l * alpha + ps; m = mnew;
    if (PV) {
        if (__builtin_amdgcn_ballot_w64(alpha != 1.f) != 0ull) {
#pragma unroll
            for (int dg = 0; dg < 4; ++dg) o[dg] = o[dg] * alpha;
        }
        bf16x8 pb[2]; pb[0] = pack_p(s[0], s[1]); pb[1] = pack_p(s[2], s[3]);
        pv_slot(buf + 8192, pb, o, lane);
    }
    __builtin_amdgcn_sched_barrier(0);
}
DEVI void load_q(const bf16_t* Q, size_t tok, int hcol, int quad, bf16x8 (&qf)[2]) {
    const bf16_t* p = Q + tok * DM + hcol + quad * 8;
    qf[0] = *(const bf16x8*)p; qf[1] = *(const bf16x8*)(p + 32);
}
DEVI bf16x8 rope_frag(const bf16x8 q, const float* csrow, int quad, int lane) {
    const u32x4 w = __builtin_bit_cast(u32x4, q); u32x4 pw;
#pragma unroll
    for (int i = 0; i < 4; ++i) pw[i] = (unsigned)shxi((int)w[i], 16, lane);
    if (quad >= 2) return q;
    const f32x4 c0 = *(const f32x4*)csrow, c1 = *(const f32x4*)(csrow + 4), s0 = *(const f32x4*)(csrow + 8), s1 = *(const f32x4*)(csrow + 12);
    const float sg = quad == 0 ? -1.f : 1.f;
    float x[8], xp[8];
#pragma unroll
    for (int i = 0; i < 4; ++i) { x[2 * i] = bflo(w[i]); x[2 * i + 1] = bfhi(w[i]); xp[2 * i] = bflo(pw[i]); xp[2 * i + 1] = bfhi(pw[i]); }
    const float cc[8] = {c0[0], c0[1], c0[2], c0[3], c1[0], c1[1], c1[2], c1[3]}, ss[8] = {s0[0], s0[1], s0[2], s0[3], s1[0], s1[1], s1[2], s1[3]};
    u32x4 o;
#pragma unroll
    for (int i = 0; i < 4; ++i) o[i] = pg8::cvt_pk_bf16(x[2 * i] * cc[2 * i] + sg * xp[2 * i] * ss[2 * i], x[2 * i + 1] * cc[2 * i + 1] + sg * xp[2 * i + 1] * ss[2 * i + 1]);
    return __builtin_bit_cast(bf16x8, o);
}

struct KFr { bf16x8 k[4][2]; };
struct VFr { bf16x8 v[4][2]; };
constexpr float LSCALE = 1048576.f;
template <int OFF> DEVI void gld16(bf16x8& d, const void* p) { asm volatile("global_load_dwordx4 %0, %1, off offset:%2" : "=v"(d) : "v"(p), "n"(OFF) : "memory"); }
DEVI void sel_load_k(KFr& f, const bf16_t* KS, int j, int lane) {
    const int l15 = lane & 15, quad = lane >> 4;
    const bf16_t* p0 = KS + ((size_t)(64 * j + l15)) * 64 + 8 * quad;
    const bf16_t* p1 = p0 + 32 * 64;
    gld16<0>(f.k[0][0], p0); gld16<64>(f.k[0][1], p0); gld16<2048>(f.k[1][0], p0); gld16<2112>(f.k[1][1], p0);
    gld16<0>(f.k[2][0], p1); gld16<64>(f.k[2][1], p1); gld16<2048>(f.k[3][0], p1); gld16<2112>(f.k[3][1], p1);
}
DEVI void sel_load_v(VFr& f, const bf16_t* VT, int j, int lane) {
    const int l15 = lane & 15, quad = lane >> 4;
    const bf16_t* p = VT + (size_t)j * 4096 + l15 * 64 + 8 * quad;
    gld16<0>(f.v[0][0], p); gld16<64>(f.v[0][1], p); gld16<2048>(f.v[1][0], p); gld16<2112>(f.v[1][1], p);
    const bf16_t* p1 = p + 32 * 64;
    gld16<0>(f.v[2][0], p1); gld16<64>(f.v[2][1], p1); gld16<2048>(f.v[3][0], p1); gld16<2112>(f.v[3][1], p1);
}
template <int N> DEVI void sel_wait_k(KFr& f) {
    asm volatile("s_waitcnt vmcnt(%8)" : "+v"(f.k[0][0]), "+v"(f.k[0][1]), "+v"(f.k[1][0]), "+v"(f.k[1][1]), "+v"(f.k[2][0]), "+v"(f.k[2][1]), "+v"(f.k[3][0]), "+v"(f.k[3][1]) : "n"(N) : "memory");
    __builtin_amdgcn_sched_barrier(0);
}
template <int N> DEVI void sel_wait_kv(KFr& f, VFr& g) {
    asm volatile("s_waitcnt vmcnt(%16)" : "+v"(f.k[0][0]), "+v"(f.k[0][1]), "+v"(f.k[1][0]), "+v"(f.k[1][1]), "+v"(f.k[2][0]), "+v"(f.k[2][1]), "+v"(f.k[3][0]), "+v"(f.k[3][1]),
                 "+v"(g.v[0][0]), "+v"(g.v[0][1]), "+v"(g.v[1][0]), "+v"(g.v[1][1]), "+v"(g.v[2][0]), "+v"(g.v[2][1]), "+v"(g.v[3][0]), "+v"(g.v[3][1]) : "n"(N) : "memory");
    __builtin_amdgcn_sched_barrier(0);
}
template <bool PASS2> DEVI void sel_block(const KFr& f, const VFr& fv, int j, bool active, int cur, LAS const unsigned* smask, LAS const unsigned char* Ql, LAS float* mrow, LAS int* lrow, LAS int* Os, float lg2k, float lratio, LAS int* tlist, int lane) {
    const int l15 = lane & 15, quad = lane >> 4, mem = l15 >> 2;
    const bool forced = (j == 0) || (j >= cur - 1);
    int cnt = 0;
    if (active) {
        if (forced) cnt = 64;
        else { const unsigned lo = (unsigned)__builtin_amdgcn_readfirstlane((int)smask[2 * j]), hi = (unsigned)__builtin_amdgcn_readfirstlane((int)smask[2 * j + 1]);
            const unsigned long long mk = ((unsigned long long)hi << 32) | lo;
            cnt = __builtin_popcountll(mk);
            const bool mine = (mk >> lane) & 1ull; const int rank = __builtin_popcountll(mk & ((1ull << lane) - 1ull));
            if (mine) tlist[rank] = lane;
            LDS_WAIT(); }
    }
    const int ngroups = (cnt + 3) >> 2;
    const bool diag = (j == cur);
#pragma unroll 1
    for (int gi = 0; gi < ngroups; ++gi) {
        const int slot = 4 * gi + mem;
        const bool valid = slot < cnt;
        int mt = forced ? slot : tlist[slot];
        mt = valid ? mt : 0;
        const int row = mt * 4 + (l15 & 3);
        const bf16x8 q0 = *(LAS const bf16x8*)(Ql + row * 128 + ((quad ^ (row & 7)) << 4));
        const bf16x8 q1 = *(LAS const bf16x8*)(Ql + row * 128 + (((4 + quad) ^ (row & 7)) << 4));
        f32x4 sc[4];
#pragma unroll
        for (int kg = 0; kg < 4; ++kg) { f32x4 z = {0.f, 0.f, 0.f, 0.f}; z = __builtin_amdgcn_mfma_f32_16x16x32_bf16(f.k[kg][0], q0, z, 0, 0, 0); sc[kg] = __builtin_amdgcn_mfma_f32_16x16x32_bf16(f.k[kg][1], q1, z, 0, 0, 0); }
        if (!PASS2) {
            float mx;
            if (diag) mx = mask_max(sc, 0, mt, quad);
            else { float a = fmaxf(fmaxf(sc[0][0], sc[0][1]), fmaxf(sc[0][2], sc[0][3])), b = fmaxf(fmaxf(sc[1][0], sc[1][1]), fmaxf(sc[1][2], sc[1][3]));
                   a = fmaxf(a, fmaxf(fmaxf(sc[2][0], sc[2][1]), fmaxf(sc[2][2], sc[2][3]))); b = fmaxf(b, fmaxf(fmaxf(sc[3][0], sc[3][1]), fmaxf(sc[3][2], sc[3][3]))); mx = max_quads(fmaxf(a, b)); }
            if (quad == 0 && valid) __hip_atomic_fetch_max(mrow + row, mx, __ATOMIC_RELAXED, __HIP_MEMORY_SCOPE_WORKGROUP);
        } else {
            const float mc = lg2k - mrow[row] * CEXP;
            float ps = 0.f;
            if (diag) { const int hiq = mt - 4 * quad;
#pragma unroll
                for (int kg = 0; kg < 4; ++kg)
#pragma unroll
                    for (int i = 0; i < 4; ++i) { sc[kg][i] = (16 * kg + i <= hiq) ? __builtin_amdgcn_exp2f(__builtin_fmaf(sc[kg][i], CEXP, mc)) : 0.f; ps += sc[kg][i]; }
            } else {
#pragma unroll
                for (int kg = 0; kg < 4; ++kg)
#pragma unroll
                    for (int i = 0; i < 4; ++i) { sc[kg][i] = __builtin_amdgcn_exp2f(__builtin_fmaf(sc[kg][i], CEXP, mc)); ps += sc[kg][i]; }
            }
            ps = sum_quads(ps);
            if (quad == 0 && valid) __hip_atomic_fetch_add(lrow + row, (int)(ps * lratio), __ATOMIC_RELAXED, __HIP_MEMORY_SCOPE_WORKGROUP);
            bf16x8 pb[2]; pb[0] = pack_p(sc[0], sc[1]); pb[1] = pack_p(sc[2], sc[3]);
            LAS int* orow = Os + row * OS_LD + 4 * quad;
#pragma unroll
            for (int dh = 0; dh < 2; ++dh) {
                f32x4 o[2];
#pragma unroll
                for (int d2 = 0; d2 < 2; ++d2) { const int dg = dh * 2 + d2; f32x4 z = {0.f, 0.f, 0.f, 0.f}; z = __builtin_amdgcn_mfma_f32_16x16x32_bf16(fv.v[dg][0], pb[0], z, 0, 0, 0); o[d2] = __builtin_amdgcn_mfma_f32_16x16x32_bf16(fv.v[dg][1], pb[1], z, 0, 0, 0); }
                if (valid) {
#pragma unroll
                    for (int d2 = 0; d2 < 2; ++d2)
#pragma unroll
                        for (int c = 0; c < 4; ++c) __hip_atomic_fetch_add(orow + 16 * (dh * 2 + d2) + c, (int)o[d2][c], __ATOMIC_RELAXED, __HIP_MEMORY_SCOPE_WORKGROUP);
                }
                __builtin_amdgcn_sched_barrier(0);
            }
        }
    }
}
#define BL(i) __builtin_amdgcn_readfirstlane(blist[(i) < nb ? (i) : nb - 1])
DEVI void sel_pass1(const bf16_t* KS, int nb, int cur, int wave, LAS const int* blist, LAS const unsigned* smask, LAS const unsigned char* Ql, LAS float* mrow, LAS int* tlist, int lane) {
    if (wave >= nb) return;
    KFr k0, k1, k2; VFr vdummy;
    asm volatile("s_waitcnt vmcnt(0)" ::: "memory");
    sel_load_k(k0, KS, BL(wave), lane);
    sel_load_k(k1, KS, BL(wave + 8), lane);
#pragma unroll 1
    for (int bi = wave; bi < nb; bi += 24) {
        sel_load_k(k2, KS, BL(bi + 16), lane); sel_wait_k<16>(k0);
        sel_block<false>(k0, vdummy, BL(bi), true, cur, smask, Ql, mrow, nullptr, nullptr, 0.f, 0.f, tlist, lane);
        sel_load_k(k0, KS, BL(bi + 24), lane); sel_wait_k<16>(k1);
        sel_block<false>(k1, vdummy, BL(bi + 8), bi + 8 < nb, cur, smask, Ql, mrow, nullptr, nullptr, 0.f, 0.f, tlist, lane);
        sel_load_k(k1, KS, BL(bi + 32), lane); sel_wait_k<16>(k2);
        sel_block<false>(k2, vdummy, BL(bi + 16), bi + 16 < nb, cur, smask, Ql, mrow, nullptr, nullptr, 0.f, 0.f, tlist, lane);
    }
    asm volatile("s_waitcnt vmcnt(0)" ::: "memory");
}
DEVI void sel_pass2(const bf16_t* KS, const bf16_t* VT, int nb, int cur, int wave, LAS const int* blist, LAS const unsigned* smask, LAS const unsigned char* Ql, LAS float* mrow, LAS int* lrow, LAS int* Os, float lg2k, float lratio, LAS int* tlist, int lane) {
    if (wave >= nb) return;
    KFr ka_, kb_; VFr va_, vb_;
    asm volatile("s_waitcnt vmcnt(0)" ::: "memory");
    sel_load_k(ka_, KS, BL(wave), lane); sel_load_v(va_, VT, BL(wave), lane);
#pragma unroll 1
    for (int bi = wave; bi < nb; bi += 16) {
        sel_load_k(kb_, KS, BL(bi + 8), lane); sel_load_v(vb_, VT, BL(bi + 8), lane); sel_wait_kv<16>(ka_, va_);
        sel_block<true>(ka_, va_, BL(bi), true, cur, smask, Ql, mrow, lrow, Os, lg2k, lratio, tlist, lane);
        sel_load_k(ka_, KS, BL(bi + 16), lane); sel_load_v(va_, VT, BL(bi + 16), lane); sel_wait_kv<16>(kb_, vb_);
        sel_block<true>(kb_, vb_, BL(bi + 8), bi + 8 < nb, cur, smask, Ql, mrow, lrow, Os, lg2k, lratio, tlist, lane);
    }
    asm volatile("s_waitcnt vmcnt(0)" ::: "memory");
}
#undef BL
}


DEVI void phase_vs_transpose(Frame& F, int l) {
    F.refresh();
    unsigned char* ws = F.ws;
    const bf16_t* VS = (const bf16_t*)(ws + RA_VS); bf16_t* VT = (bf16_t*)(ws + RA_VST); const bf16_t* KSG = (const bf16_t*)(ws + RA_KS);
    LAS unsigned short* T = (LAS unsigned short*)F.lds;
    const int tid = F.tid, r = tid >> 3, c = tid & 7;
    for (int it = (int)blockIdx.x - 64; it < 2048; it += 192) {
        const int bg = it >> 8, tile = it & 255;
        const u32x4 v = *(const u32x4*)(VS + ((size_t)bg * SEQ + tile * 64 + r) * 64 + c * 8);
        { float mx = 0.f;
#pragma unroll
          for (int e = 0; e < 4; ++e) mx = fmaxf(mx, fmaxf(fabsf(bflo(v[e])), fabsf(bfhi(v[e]))));
          mx = wave_max(mx, F.lane);
          if (F.lane == 0) atomicMax((unsigned*)(ws + WS_CTL) + CW_VMAX + l * 8 + bg, __float_as_uint(mx)); }
        *(LAS u32x4*)(T + r * 72 + c * 8) = v;
        { const u32x4 kq = *(const u32x4*)(KSG + ((size_t)bg * SEQ + tile * 64 + r) * 64 + c * 8); float n2 = 0.f;
#pragma unroll
          for (int e = 0; e < 4; ++e) { const float a = bflo(kq[e]), b2 = bfhi(kq[e]); n2 += a * a + b2 * b2; }
          n2 += fa::dppf<DPP_X1>(n2); n2 += fa::dppf<DPP_X2>(n2); n2 += fa::dppf<DPP_HM>(n2);
          n2 = wave_max(n2, F.lane);
          if (F.lane == 0) atomicMax((unsigned*)(ws + WS_CTL) + CW_KMAX + l * 8 + bg, __float_as_uint(n2)); }
        __syncthreads();
        u32x4 w;
#pragma unroll
        for (int e = 0; e < 4; ++e) { const int k0 = 32 * (c >> 2) + 16 * ((2 * e) >> 2) + 4 * (c & 3) + ((2 * e) & 3);
            w[e] = (unsigned)T[k0 * 72 + r] | ((unsigned)T[(k0 + 1) * 72 + r] << 16); }
        *(u32x4*)(VT + ((size_t)bg * 256 + tile) * 4096 + r * 64 + c * 8) = w;
        __syncthreads();
    }
}

DEVI void phase_nsa_fast(Frame& F, int layer) {
    using namespace fa;
    F.refresh();
    unsigned char* ws = F.ws;
    const bf16_t* Q = (const bf16_t*)(ws + RA_Q); bf16_t* ATT = (bf16_t*)(ws + RA_ATT);
    const float* GT = (const float*)(ws + RA_GATE); const float* CS = (const float*)(ws + WS_CS);
    const int wave = F.wave;
    LAS unsigned char* kvb = F.lds + L_KV;
    LAS float* imp = (LAS float*)(F.lds + L_IMP);
    LAS unsigned* smask = (LAS unsigned*)(F.lds + L_MASK);
    LAS int* blist = (LAS int*)(F.lds + L_LIST);
#pragma unroll 1
    for (int ui = 0; ui < 8; ++ui) {
        int lane = F.lane; asm volatile("" : "+v"(lane));
        const int tid = wave * 64 + lane, quad = lane >> 4, l15 = lane & 15;
        int tile = (F.vcu & 31) + 32 * (ui >> 1); if (ui & 1) tile = 255 - tile;
        const int bg = F.vcu >> 5, b = bg >> 2, g = bg & 3, cur = tile, t0 = tile * 64;
        const bf16_t* KC = (const bf16_t*)(ws + RA_KC) + (size_t)bg * 1024 * 64; const bf16_t* VC = (const bf16_t*)(ws + RA_VC) + (size_t)bg * 1024 * 64;
        const bf16_t* KS = (const bf16_t*)(ws + RA_KS) + (size_t)bg * SEQ * 64; const bf16_t* VS = (const bf16_t*)(ws + RA_VS) + (size_t)bg * SEQ * 64;
        const bf16_t* KW = (const bf16_t*)(ws + RA_KW) + (size_t)bg * SEQ * 64; const bf16_t* VW = (const bf16_t*)(ws + RA_VW) + (size_t)bg * SEQ * 64;
        smask[tid] = 0u;
        int tl[2], tok[2]; bf16x8 qf[2][2];
#pragma unroll
        for (int s = 0; s < 2; ++s) { tl[s] = 8 * wave + 4 * s + (l15 >> 2); tok[s] = b * SEQ + t0 + tl[s]; load_q(Q, (size_t)tok[s], g * 256 + (l15 & 3) * 64, quad, qf[s]); }
        float gate[2][3];
#pragma unroll
        for (int s = 0; s < 2; ++s)
#pragma unroll
            for (int br = 0; br < 3; ++br) gate[s][br] = GT[(size_t)tok[s] * 48 + br * 16 + g * 4 + (l15 & 3)];
        const float vmax = fmaxf(__uint_as_float(__hip_atomic_load((const unsigned*)(ws + WS_CTL) + CW_VMAX + layer * 8 + bg, __ATOMIC_RELAXED, __HIP_MEMORY_SCOPE_AGENT)), 1e-30f);
        bf16x8 qr[2][2];
#pragma unroll
        for (int s = 0; s < 2; ++s) { qr[s][0] = rope_frag(qf[s][0], CS + (size_t)tok[s] * 16, quad, lane); qr[s][1] = qf[s][1]; }
        f32x4 out[2][4];
#pragma unroll
        for (int s = 0; s < 2; ++s)
#pragma unroll
            for (int dg = 0; dg < 4; ++dg) out[s][dg] = (f32x4){0.f, 0.f, 0.f, 0.f};
        Stage st;
        const int ntile = (4 * cur + 3 + 63) >> 6;
        int nval[2];
#pragma unroll
        for (int s = 0; s < 2; ++s) { const int t = t0 + tl[s]; nval[s] = t >= 31 ? ((t - 31) >> 4) + 1 : 0; }
        float m[2] = {NEGINF, NEGINF}, l[2] = {0.f, 0.f};
        {   stage_load<false>(st, KC, VC, tid); stage_write<false>(st, kvb, tid); __syncthreads();
#pragma unroll 1
            for (int i = 0; i < ntile; ++i) {
                LAS unsigned char* buf = kvb + (i & 1) * KVB;
                if (i + 1 < ntile) stage_load<false>(st, KC + (size_t)(i + 1) * 4096, VC, tid); else stage_load<true>(st, KC, VC, tid);
#pragma unroll
                for (int s = 0; s < 2; ++s) { f32x4 dummy[4]; online_step<false>(buf, qf[s][0], qf[s][1], 0, nval[s] - 64 * i - 1, m[s], l[s], dummy, lane); }
                if (i + 1 < ntile) stage_write<false>(st, kvb + ((i + 1) & 1) * KVB, tid);
                __syncthreads();
            }
        }
        float invl[2], msafe[2];
#pragma unroll
        for (int s = 0; s < 2; ++s) { const float lt = sum_quads(l[s]); invl[s] = lt > 0.f ? 1.f / lt : 0.f; msafe[s] = (m[s] == NEGINF) ? 0.f : m[s]; }
#ifndef NO_P2
        const int jbw0 = cur >= 8 ? cur - 8 : 0;
        {   float gcv[2] = {gate[0][0], gate[1][0]};
            float carry[2] = {0.f, 0.f};
            stage_write<true>(st, kvb, tid); __syncthreads();
#pragma unroll 1
            for (int i = 0; i < ntile; ++i) {
                LAS unsigned char* buf = kvb + (i & 1) * KVB;
                if (i + 1 < ntile) stage_load<true>(st, KC + (size_t)(i + 1) * 4096, VC + (size_t)(i + 1) * 4096, tid); else stage_load<true>(st, KW + (size_t)jbw0 * 4096, VW + (size_t)jbw0 * 4096, tid);
#pragma unroll
                for (int s = 0; s < 2; ++s) {
                    __builtin_amdgcn_sched_barrier(0);
                    f32x4 sc[4]; qk_slot(buf, qf[s][0], qf[s][1], lane, sc);
                    __builtin_amdgcn_sched_barrier(0);
                    const int hiq = nval[s] - 64 * i - 1 - 4 * quad; const float mc2 = -msafe[s] * CEXP;
#pragma unroll
                    for (int kg = 0; kg < 4; ++kg)
#pragma unroll
                        for (int k = 0; k < 4; ++k) sc[kg][k] = (16 * kg + k <= hiq) ? __builtin_amdgcn_exp2f(__builtin_fmaf(sc[kg][k], CEXP, mc2)) * invl[s] : 0.f;
                    bf16x8 pb[2]; pb[0] = pack_p(sc[0] * gcv[s], sc[1] * gcv[s]); pb[1] = pack_p(sc[2] * gcv[s], sc[3] * gcv[s]);
#ifndef NO_IMP
#pragma unroll
                    for (int kg = 0; kg < 4; ++kg) {
                        float a = (sc[kg][0] + sc[kg][1]) + (sc[kg][2] + 0.5f * sc[kg][3]), bq = 0.5f * sc[kg][3];
                        a += dppf<DPP_X1>(a); a += dppf<DPP_X2>(a); bq += dppf<DPP_X1>(bq); bq += dppf<DPP_X2>(bq);
                        const float fromprev = bperm(bq, (lane - 16) & 63);
                        const float add = quad == 0 ? carry[s] : fromprev;
                        carry[s] = bperm(bq, (lane + 48) & 63);
                        if ((l15 & 3) == 0) imp[(8 * wave + 4 * s + (l15 >> 2)) * IMP_LD + 16 * i + 4 * kg + quad] = a + add;
                    }
#endif
                    __builtin_amdgcn_sched_barrier(0);
                    pv_slot(buf + 8192, pb, out[s], lane);
                    __builtin_amdgcn_sched_barrier(0);
                }
                if (i + 1 < ntile) stage_write<true>(st, kvb + ((i + 1) & 1) * KVB, tid);
                __syncthreads();
            }
        }
#endif
#ifndef NO_TOPK
        {   const int tl8 = lane >> 3, chunk = lane & 7, trow = (8 * wave + tl8) * IMP_LD;
            const int ncand = cur - 2;
            const int wsel = ((8 * wave + tl8) >> 5), bsel = (8 * wave + tl8) & 31;
            if (ncand > 0 && ncand <= 13) {
#pragma unroll
                for (int i = 0; i < 2; ++i) { const int j = 8 * i + chunk; if (j >= 1 && j <= cur - 2) __hip_atomic_fetch_or(smask + j * 2 + wsel, 1u << bsel, __ATOMIC_RELAXED, __HIP_MEMORY_SCOPE_WORKGROUP); }
            } else if (ncand > 13) {
                float lv[13]; int li[13];
#pragma unroll
                for (int k = 0; k < 13; ++k) { lv[k] = -1.f; li[k] = 1 << 20; }
                const int imax = (cur - 2) >> 3;
#pragma unroll 1
                for (int i = 0; i <= imax; ++i) {
                    const int j = 8 * i + chunk; float x = (j >= 1 && j <= cur - 2) ? imp[trow + j] : -1.f; int xi = j;
                    if (__builtin_amdgcn_ballot_w64(x > lv[12]) != 0ull) {
#pragma unroll
                        for (int k = 0; k < 13; ++k) { const bool gt = x > lv[k]; const float tv = gt ? lv[k] : x; const int ti = gt ? li[k] : xi; lv[k] = gt ? x : lv[k]; li[k] = gt ? xi : li[k]; x = tv; xi = ti; }
                    }
                }
#pragma unroll 1
                for (int r = 0; r < 13; ++r) {
                    float bv = lv[0]; int bi = li[0];
                    { const float ov = dppf<DPP_X1>(bv); const int oi = dppi<DPP_X1>(bi); if (ov > bv || (ov == bv && oi < bi)) { bv = ov; bi = oi; } }
                    { const float ov = dppf<DPP_X2>(bv); const int oi = dppi<DPP_X2>(bi); if (ov > bv || (ov == bv && oi < bi)) { bv = ov; bi = oi; } }
                    { const float ov = dppf<DPP_HM>(bv); const int oi = dppi<DPP_HM>(bi); if (ov > bv || (ov == bv && oi < bi)) { bv = ov; bi = oi; } }
                    if (li[0] == bi) {
#pragma unroll
                        for (int k = 0; k < 12; ++k) { lv[k] = lv[k + 1]; li[k] = li[k + 1]; }
                        lv[12] = -1.f; li[12] = 1 << 20;
                    }
                    if (chunk == 0 && bv >= 0.f) __hip_atomic_fetch_or(smask + bi * 2 + wsel, 1u << bsel, __ATOMIC_RELAXED, __HIP_MEMORY_SCOPE_WORKGROUP);
                }
            }
        }
#endif
        __syncthreads();
        if (wave == 0) {
            int base = 0;
#pragma unroll 1
            for (int r = 0; r < 4; ++r) { const int j = 64 * r + lane; const bool on = (j <= cur) && (j == 0 || j >= cur - 1 || (smask[j * 2] | smask[j * 2 + 1]) != 0u);
                const unsigned long long bal = __builtin_amdgcn_ballot_w64(on); const int pos = base + __builtin_popcountll(bal & ((1ull << lane) - 1ull));
                if (on) blist[pos] = j; base += __builtin_popcountll(bal); }
            if (lane == 0) blist[259] = base;
        }
        __syncthreads();
        LAS float* stashf = imp + wave * 2048 + lane;
#pragma unroll
        for (int s = 0; s < 2; ++s)
#pragma unroll
            for (int dg = 0; dg < 4; ++dg)
#pragma unroll
                for (int c = 0; c < 4; ++c) stashf[(s * 16 + dg * 4 + c) * 64] = out[s][dg][c];
        {   const int jb0 = jbw0, nb = cur - jb0 + 1;
            f32x4 ob[2][4]; float mm[2] = {NEGINF, NEGINF}, ll[2] = {0.f, 0.f};
#pragma unroll
            for (int s = 0; s < 2; ++s)
#pragma unroll
                for (int dg = 0; dg < 4; ++dg) ob[s][dg] = (f32x4){0.f, 0.f, 0.f, 0.f};
            stage_write<true>(st, kvb, tid); __syncthreads();
#pragma unroll 1
            for (int i = 0; i < nb; ++i) {
                LAS unsigned char* buf = kvb + (i & 1) * KVB;
                const int j = jb0 + i;
                if (i + 1 < nb) stage_load<true>(st, KW + (size_t)(j + 1) * 4096, VW + (size_t)(j + 1) * 4096, tid);
#pragma unroll
                for (int s = 0; s < 2; ++s) {
                    const int lo = (j == cur - 8) ? tl[s] + 1 : 0, hi = (j == cur) ? tl[s] : 63;
                    online_step<true>(buf, qr[s][0], qr[s][1], lo, hi, mm[s], ll[s], ob[s], lane);
                }
                if (i + 1 < nb) stage_write<true>(st, kvb + ((i + 1) & 1) * KVB, tid);
                __syncthreads();
            }
#pragma unroll
            for (int s = 0; s < 2; ++s) { const float lt = sum_quads(ll[s]); const float gw = gate[s][2] * (lt > 0.f ? 1.f / lt : 0.f);
#pragma unroll
                for (int dg = 0; dg < 4; ++dg)
#pragma unroll
                    for (int c = 0; c < 4; ++c) out[s][dg][c] = stashf[(s * 16 + dg * 4 + c) * 64] + ob[s][dg][c] * gw; }
        }
        LAS unsigned* stashb = (LAS unsigned*)(F.lds + L_KV) + wave * 1024 + lane;
        LAS unsigned char* Ql = F.lds + L_Q;
        LAS float* mrow = (LAS float*)(F.lds + L_ML); LAS int* lrow = (LAS int*)(mrow + 256);
        LAS int* Os = (LAS int*)imp;
        const float oscale = 1048576.f / vmax;
#pragma unroll
        for (int s = 0; s < 2; ++s) {
#pragma unroll
            for (int dg = 0; dg < 4; ++dg) { stashb[((s * 4 + dg) * 2 + 0) * 64] = pg8::cvt_pk_bf16(out[s][dg][0], out[s][dg][1]); stashb[((s * 4 + dg) * 2 + 1) * 64] = pg8::cvt_pk_bf16(out[s][dg][2], out[s][dg][3]); }
            const int row = tl[s] * 4 + (l15 & 3);
            *(LAS bf16x8*)(Ql + row * 128 + ((quad ^ (row & 7)) << 4)) = qr[s][0];
            *(LAS bf16x8*)(Ql + row * 128 + (((4 + quad) ^ (row & 7)) << 4)) = qr[s][1];
        }
        __syncthreads();
        for (int i = lane; i < 32 * OS_LD; i += 64) Os[wave * 32 * OS_LD + i] = 0;
        if (lane < 32) lrow[wave * 32 + lane] = 0;
        {
            const float kmax2 = __uint_as_float(__hip_atomic_load((const unsigned*)(ws + WS_CTL) + CW_KMAX + layer * 8 + bg, __ATOMIC_RELAXED, __HIP_MEMORY_SCOPE_AGENT));
#pragma unroll
            for (int s = 0; s < 2; ++s) { float n2 = 0.f;
#pragma unroll
                for (int ks = 0; ks < 2; ++ks) { const u32x4 w = __builtin_bit_cast(u32x4, qr[s][ks]);
#pragma unroll
                    for (int e = 0; e < 4; ++e) { const float a = bflo(w[e]), b2 = bfhi(w[e]); n2 += a * a + b2 * b2; } }
                n2 = sum_quads(n2);
                if (quad == 0) mrow[tl[s] * 4 + (l15 & 3)] = sqrtf(n2 * kmax2) * 1.0001f; } }
        __syncthreads();
        {   const int nb = blist[259];
            int lane2 = lane; asm volatile("" : "+v"(lane2));
            const bf16_t* VT = (const bf16_t*)(ws + RA_VST) + (size_t)bg * 256 * 4096;
            LAS int* tlist = (LAS int*)(F.lds + L_TOK) + wave * 64;
            asm volatile("" : "+v"(lane2));
            sel_pass2(KS, VT, nb, cur, wave, blist, smask, Ql, mrow, lrow, Os, __builtin_amdgcn_logf(oscale), LSCALE / oscale, tlist, lane2);
            __syncthreads();
        }
        asm volatile("" : "+v"(tok[0]), "+v"(tok[1]), "+v"(tl[0]), "+v"(tl[1]));
        const float oinv = vmax * (1.f / 1048576.f);
#pragma unroll
        for (int s = 0; s < 2; ++s) { const int row = tl[s] * 4 + (l15 & 3); const float lt = (float)lrow[row] * (1.f / LSCALE);
            const float gs = gate[s][1] * (lt > 0.f ? 1.f / lt : 0.f) * oinv;
#pragma unroll
            for (int dg = 0; dg < 4; ++dg) { const unsigned w0 = stashb[((s * 4 + dg) * 2 + 0) * 64], w1 = stashb[((s * 4 + dg) * 2 + 1) * 64];
                LAS const int* orow = Os + row * OS_LD + 16 * dg + 4 * quad;
                const float r0 = bflo(w0) + (float)orow[0] * gs, r1 = bfhi(w0) + (float)orow[1] * gs, r2 = bflo(w1) + (float)orow[2] * gs, r3 = bfhi(w1) + (float)orow[3] * gs;
                u32x2 w; w.x = pg8::cvt_pk_bf16(r0, r1); w.y = pg8::cvt_pk_bf16(r2, r3);
                *(u32x2*)(ATT + (size_t)tok[s] * DM + g * 256 + (l15 & 3) * 64 + 16 * dg + 4 * quad) = w; } }
        __syncthreads();
    }
}

DEVI void phase_swa_fast(Frame& F, const float* sinks) {
    using namespace fa;
    F.refresh();
    unsigned char* ws = F.ws;
    const bf16_t* Q = (const bf16_t*)(ws + RA_Q); bf16_t* ATT = (bf16_t*)(ws + RA_ATT);
    const int tid = F.tid, lane = F.lane, wave = F.wave, quad = lane >> 4, l15 = lane & 15;
    LAS unsigned char* kvb = F.lds + L_KV;
#pragma unroll 1
    for (int ui = 0; ui < 8; ++ui) {
        const int bg = ui >> 1, b = bg >> 1, g = bg & 1, t0 = (F.vcu * 2 + (ui & 1)) * 32, cur = t0 >> 6;
        const bf16_t* KS = (const bf16_t*)(ws + WS_KSH) + (size_t)bg * SEQ * 64; const bf16_t* VS = (const bf16_t*)(ws + WS_VSH) + (size_t)bg * SEQ * 64;
        int tq[2]; size_t tok[2]; bf16x8 qf[2][2]; f32x4 o[2][4]; float mm[2], ll[2];
        const float sink_raw = sinks[g * 8 + (l15 & 7)] * 8.0f;
#pragma unroll
        for (int s = 0; s < 2; ++s) { tq[s] = t0 + 4 * wave + 2 * s + (l15 >> 3); tok[s] = (size_t)b * SEQ + tq[s]; load_q(Q, tok[s], g * 512 + (l15 & 7) * 64, quad, qf[s]);
            mm[s] = sink_raw; ll[s] = quad == 0 ? 1.f : 0.f;
#pragma unroll
            for (int dg = 0; dg < 4; ++dg) o[s][dg] = (f32x4){0.f, 0.f, 0.f, 0.f}; }
        const int jb0 = cur >= 2 ? cur - 2 : 0, nb = cur - jb0 + 1;
        Stage st; stage_load<true>(st, KS + (size_t)jb0 * 4096, VS + (size_t)jb0 * 4096, tid); stage_write<true>(st, kvb, tid); __syncthreads();
#pragma unroll 1
        for (int i = 0; i < nb; ++i) {
            LAS unsigned char* buf = kvb + (i & 1) * KVB;
            const int j = jb0 + i;
            if (i + 1 < nb) stage_load<true>(st, KS + (size_t)(j + 1) * 4096, VS + (size_t)(j + 1) * 4096, tid);
#pragma unroll
            for (int s = 0; s < 2; ++s) online_step<true>(buf, qf[s][0], qf[s][1], tq[s] - (SWA_WIN - 1) - 64 * j, tq[s] - 64 * j, mm[s], ll[s], o[s], lane);
            if (i + 1 < nb) stage_write<true>(st, kvb + ((i + 1) & 1) * KVB, tid);
            __syncthreads();
        }
#pragma unroll
        for (int s = 0; s < 2; ++s) { const float inv = 1.f / sum_quads(ll[s]);
#pragma unroll
            for (int dg = 0; dg < 4; ++dg) { u32x2 w; w.x = pg8::cvt_pk_bf16(o[s][dg][0] * inv, o[s][dg][1] * inv); w.y = pg8::cvt_pk_bf16(o[s][dg][2] * inv, o[s][dg][3] * inv);
                *(u32x2*)(ATT + tok[s] * DM + g * 512 + (l15 & 7) * 64 + 16 * dg + 4 * quad) = w; } }
    }
}

enum Kind { K_PRO = 0, K_NSA_IN, K_CMP_HID, K_CMP_OUT, K_NSA_ATT, K_SWA_IN, K_SWA_ATT, K_OUTPROJ, K_LN1, K_LN1R, K_FFN1, K_FFN2, K_LN2, K_SCATTER, K_MOE1, K_MOE2, K_LN2C, K_COUNT };
struct Args { const void* in[18]; float* out; unsigned char* ws; int ph_lo, ph_hi; };
struct PhaseEnt { int kind, layer; };
constexpr int NPH = 35;
static const PhaseEnt h_prog[NPH] = {
    {K_PRO, 0},
    {K_NSA_IN, 0}, {K_CMP_HID, 0}, {K_CMP_OUT, 0}, {K_NSA_ATT, 0}, {K_OUTPROJ, 0}, {K_LN1, 0}, {K_FFN1, 0}, {K_FFN2, 0}, {K_LN2, 0},
    {K_NSA_IN, 1}, {K_CMP_HID, 1}, {K_CMP_OUT, 1}, {K_NSA_ATT, 1}, {K_OUTPROJ, 1}, {K_LN1R, 1}, {K_SCATTER, 1}, {K_MOE1, 1}, {K_MOE2, 1}, {K_LN2C, 1},
    {K_SWA_IN, 2}, {K_SWA_ATT, 2}, {K_OUTPROJ, 2}, {K_LN1, 2}, {K_FFN1, 2}, {K_FFN2, 2}, {K_LN2, 2},
    {K_SWA_IN, 3}, {K_SWA_ATT, 3}, {K_OUTPROJ, 3}, {K_LN1R, 3}, {K_SCATTER, 3}, {K_MOE1, 3}, {K_MOE2, 3}, {K_LN2C, 3},
};

template <int KIND> DEVI void do_phase(Frame& F, int l) {
    unsigned char* ws = F.ws;
    unsigned* ctl = (unsigned*)(ws + WS_CTL);
    LAS unsigned char* ring = F.lds;
    const int bx = (int)blockIdx.x;
    if constexpr (KIND == K_PRO) { phase_prologue(F); }
    if constexpr (KIND == K_NSA_IN) { pg8::Gemm g{(const bf16_t*)(ws + WS_HB), DM, DM, DM}; pg8::StaticOrder S; S.init(MTOK / 256, A_INP / 256, F.G, bx, (const bf16_t*)(ws + WS_WINA) + (size_t)l * A_INP * DM);
        EpiNsaIn E{ws, (const float*)(ws + WS_CS)}; pg8::gemm_phase(ring, g, S, E, F.wave0); }
    if constexpr (KIND == K_CMP_HID) {
        const int kv = (bx >> 5) & 1;
        if (bx < 64) { pg8::Gemm g{(const bf16_t*)(ws + (kv ? RA_VCR : RA_KCR)), 1024, 2048, 2048};
            pg8::StaticOrder S; S.init(32, 1, 32, bx & 31, (const bf16_t*)(ws + WS_WC1) + (size_t)(l * 2 + kv) * 256 * 2048);
            EpiCmpHid E{(bf16_t*)(ws + RA_CH) + (size_t)kv * 8192 * 256, (const float*)(ctl + CW_BIASP) + (l * 2 + kv) * 256};
            pg8::gemm_phase(ring, g, S, E, F.wave0); }
        else phase_vs_transpose(F, l); }
    if constexpr (KIND == K_CMP_OUT) { pg8::Gemm g{(const bf16_t*)(ws + RA_CH), 256, 256, 256}; pg8::DualOrder S; S.init(64, 1, F.G, bx, (const bf16_t*)(ws + WS_WC2) + (size_t)(l * 2) * 256 * 256); S.estride = (size_t)256 * 256;
        EpiCmpOut E{(bf16_t*)(ws + RA_KC), (bf16_t*)(ws + RA_VC)}; pg8::gemm_phase(ring, g, S, E, F.wave0); }
#if NAIVE_NSA
    if constexpr (KIND == K_NSA_ATT) { phase_nsa_naive(F); }
#else
    if constexpr (KIND == K_NSA_ATT) { phase_nsa_fast(F, l); }
#endif
    if constexpr (KIND == K_SWA_IN) { pg8::Gemm g{(const bf16_t*)(ws + WS_HB), DM, DM, DM}; pg8::StaticOrder S;
        if (l == 2) S.init(MTOK / 256, 5, F.G, bx, (const bf16_t*)(ws + WS_WQKV2)); else S.init(MTOK / 256, 4, F.G, bx, (const bf16_t*)(ws + WS_WQB1));
        EpiSwaIn E{ws, (const float*)(ws + WS_CS)}; pg8::gemm_phase(ring, g, S, E, F.wave0); }
#if NAIVE_SWA
    if constexpr (KIND == K_SWA_ATT) { phase_swa_naive(F, (const float*)ARG_IN(10) + (l - 2) * 16); }
#else
    if constexpr (KIND == K_SWA_ATT) { phase_swa_fast(F, (const float*)ARG_IN(10) + (l - 2) * 16); }
#endif
    if constexpr (KIND == K_OUTPROJ) { pg8::Gemm g{(const bf16_t*)(ws + RA_ATT), DM, DM, DM}; pg8::StaticOrder S;
        S.init(MTOK / 256, 4, F.G, bx, l < 2 ? (const bf16_t*)(ws + WS_WOUTA) + (size_t)l * DM * DM : (const bf16_t*)(ws + WS_WOUTB) + (size_t)(l - 2) * DM * DM);
        EpiResid E{(const bf16_t*)(ws + WS_HB), (bf16_t*)(ws + WS_Y)}; pg8::gemm_phase(ring, g, S, E, F.wave0); }
    if constexpr (KIND == K_LN1) { phase_ln<0, false, false>(F, l * 2, nullptr, 0); }
    if constexpr (KIND == K_LN1R) { phase_ln<0, true, false>(F, l * 2, nullptr, l >> 1); }
    if constexpr (KIND == K_FFN1) { pg8::Gemm g{(const bf16_t*)(ws + WS_HB), DM, DM, DM}; pg8::StaticOrder S; S.init(MTOK / 256, 2 * DFF / 256, F.G, bx, (const bf16_t*)(ws + WS_WDIN) + (size_t)(l >> 1) * 2 * DFF * DM);
        EpiSwiglu E{(bf16_t*)(ws + WS_ACT), DFF}; pg8::gemm_phase(ring, g, S, E, F.wave0); }
    if constexpr (KIND == K_FFN2) { pg8::Gemm g{(const bf16_t*)(ws + WS_ACT), DFF, DFF, DFF}; pg8::StaticOrder S; S.init(MTOK / 256, 4, F.G, bx, (const bf16_t*)(ws + WS_WDOUT) + (size_t)(l >> 1) * DM * DFF);
        EpiResid E{(const bf16_t*)(ws + WS_HB), (bf16_t*)(ws + WS_Y)}; pg8::gemm_phase(ring, g, S, E, F.wave0); }
    if constexpr (KIND == K_LN2) { phase_ln<0, false, false>(F, l * 2 + 1, nullptr, 0); }
    if constexpr (KIND == K_SCATTER) { phase_moe_scatter(F, l >> 1); }
    if constexpr (KIND == K_MOE1) { const int ml = l >> 1; int ts[9]; moe_tiles((const unsigned*)ctl + CW_MOE + ml * 64, ts);
        pg8::Gemm g{(const bf16_t*)(ws + WS_XB), DM, DM, DM}; pg8::GroupedOrder S; S.init(ts[8], 2 * DFFE / 256, F.G, bx, (const bf16_t*)(ws + WS_WMIN) + (size_t)ml * 8 * 2 * DFFE * DM);
        S.t1 = ts[1]; S.t2 = ts[2]; S.t3 = ts[3]; S.t4 = ts[4]; S.t5 = ts[5]; S.t6 = ts[6]; S.t7 = ts[7]; S.estride = (size_t)2 * DFFE * DM;
        EpiSwiglu E{(bf16_t*)(ws + WS_ACT), DFFE}; pg8::gemm_phase(ring, g, S, E, F.wave0); }
    if constexpr (KIND == K_MOE2) { const int ml = l >> 1; int ts[9]; moe_tiles((const unsigned*)ctl + CW_MOE + ml * 64, ts);
        pg8::Gemm g{(const bf16_t*)(ws + WS_ACT), DFFE, DFFE, DFFE}; pg8::GroupedOrder S; S.init(256, 4, F.G, bx, (const bf16_t*)(ws + WS_WMOUT) + (size_t)ml * 8 * DM * DFFE);
        S.t1 = ts[1]; S.t2 = ts[2]; S.t3 = ts[3]; S.t4 = ts[4]; S.t5 = ts[5]; S.t6 = ts[6]; S.t7 = ts[7]; S.estride = (size_t)DM * DFFE;
        EpiBf16Out E{(bf16_t*)(ws + WS_YB)}; pg8::gemm_phase(ring, g, S, E, F.wave0);
        pg8::Gemm g4{(const bf16_t*)(ws + WS_ACT), DFFE, DFFE / 4, DFFE}; pg8::SliceOrder S4; S4.nsl = (ts[8] - 256) * 16; S4.G = F.G; S4.c = (bx + 128) & 255; S4.kq = DFFE / 4;
        S4.bt = (const bf16_t*)(ws + WS_WMOUT) + (size_t)ml * 8 * DM * DFFE; S4.t1 = ts[1]; S4.t2 = ts[2]; S4.t3 = ts[3]; S4.t4 = ts[4]; S4.t5 = ts[5]; S4.t6 = ts[6]; S4.t7 = ts[7]; S4.estride = (size_t)DM * DFFE;
        EpiPart E4{(float*)(ws + WS_H)}; pg8::gemm_phase(ring, g4, S4, E4, F.wave0); }
    if constexpr (KIND == K_LN2C) { if (l == DEPTH - 1) phase_ln<1, false, true>(F, l * 2 + 1, ARG_OUT(), 0); else phase_ln<1, false, false>(F, l * 2 + 1, nullptr, 0); }
}

DEVI void frame_init(Frame& F, unsigned char* lds_raw) {
    F.lds = (LAS unsigned char*)lds_raw; F.ws = ARG_WS();
    F.wave0 = wave_id_sgpr(); F.tid = threadIdx.x; F.lane = F.tid & 63; F.wave = F.wave0;
    F.G = gridDim.x; { const int bx = blockIdx.x; F.vcu = (F.G % 8 == 0) ? (bx % 8) * (F.G / 8) + bx / 8 : bx; }
}

#if !MK_SINGLE
template <int KIND> __global__ void __launch_bounds__(NWAVES * 64, 2) phase_kernel(Args args) {
    extern __shared__ __attribute__((aligned(16))) unsigned char lds_raw[];
    Frame F; frame_init(F, lds_raw);
    do_phase<KIND>(F, args.ph_lo);
}
template <int KIND> static void launch_kind(const Args& a, hipStream_t stream) {
    static bool attr = false;
    if (!attr) { (void)hipFuncSetAttribute((const void*)phase_kernel<KIND>, hipFuncAttributeMaxDynamicSharedMemorySize, LDS_BYTES); attr = true; }
    hipLaunchKernelGGL(phase_kernel<KIND>, dim3(256), dim3(NWAVES * 64), LDS_BYTES, stream, a);
}
#else
__global__ void __launch_bounds__(NWAVES * 64, 2) yoco_fwd(Args args) {
    extern __shared__ __attribute__((aligned(16))) unsigned char lds_raw[];
    Frame F; frame_init(F, lds_raw);
    volatile LAS unsigned* MISC = (volatile LAS unsigned*)(F.lds + MISC_OFF);
    for (int u = F.tid; u < 256; u += NWAVES * 64) MISC[u] = 0u;
    __syncthreads();
    XcdBarrier bar = xcd_barrier_post((unsigned*)(F.ws + WS_CTL) + CW_BAR, MISC + 8);
#define DUP_KIND 12
#define DUP_KIND 13
#ifndef DUP_KIND
#define DUP_KIND -1
#endif
#define PH(K, L, FIRST) do { do_phase<K>(F, L); if (FIRST) cg::this_grid().sync(); else xcd_barrier(bar); if (K == DUP_KIND) { do_phase<K>(F, L); xcd_barrier(bar); } } while (0)
    PH(K_PRO, 0, true);
#define NSA_LAYER(l) PH(K_NSA_IN, l, false); PH(K_CMP_HID, l, false); PH(K_CMP_OUT, l, false); PH(K_NSA_ATT, l, false); PH(K_OUTPROJ, l, false)
#define SWA_LAYER(l) PH(K_SWA_IN, l, false); PH(K_SWA_ATT, l, false); PH(K_OUTPROJ, l, false)
#define DENSE_FFN(l) PH(K_LN1, l, false); PH(K_FFN1, l, false); PH(K_FFN2, l, false); PH(K_LN2, l, false)
#define MOE_FFN(l, LAST) PH(K_LN1R, l, false); PH(K_SCATTER, l, false); PH(K_MOE1, l, false); PH(K_MOE2, l, false); do_phase<K_LN2C>(F, l); if (!(LAST)) xcd_barrier(bar); else if (DUP_KIND == 16) { xcd_barrier(bar); do_phase<K_LN2C>(F, l); }
    NSA_LAYER(0); DENSE_FFN(0);
    NSA_LAYER(1); MOE_FFN(1, false);
    SWA_LAYER(2); DENSE_FFN(2);
    SWA_LAYER(3); MOE_FFN(3, true);
}
#endif

extern "C" void kernel_launch(void* const* d_in, const int* in_sizes, int n_in, void* d_out, int out_size, void* d_ws, size_t ws_size, hipStream_t stream) {
    static int grid = 0;
    if (grid == 0) {
        if (n_in != 18 || out_size != MTOK * DM || ws_size < WS_END) { fprintf(stderr, "kernel_launch: unexpected shapes (n_in %d out %d ws %zu need %zu)\n", n_in, out_size, ws_size, (size_t)WS_END); grid = -1; return; }
        int dev = 0, cus = 0;
        (void)hipGetDevice(&dev); (void)hipDeviceGetAttribute(&cus, hipDeviceAttributeMultiprocessorCount, dev);
        if (cus < 256) { fprintf(stderr, "kernel_launch: needs 256 CUs, device has %d\n", cus); grid = -1; return; }
#if MK_SINGLE
        int per_cu = 0;
        (void)hipFuncSetAttribute((const void*)yoco_fwd, hipFuncAttributeMaxDynamicSharedMemorySize, LDS_BYTES);
        (void)hipOccupancyMaxActiveBlocksPerMultiprocessor(&per_cu, (const void*)yoco_fwd, NWAVES * 64, LDS_BYTES);
        if (per_cu < 1) fprintf(stderr, "kernel_launch: occupancy query says %d blocks per CU\n", per_cu);
        (void)hipGetLastError();
#endif
        grid = 256;
    }
    if (grid < 0) return;
    (void)hipMemsetAsync((char*)d_ws + WS_CTL, 0, CTL_BYTES, stream);
    Args a{};
    for (int i = 0; i < 18; ++i) a.in[i] = d_in[i];
    a.out = (float*)d_out; a.ws = (unsigned char*)d_ws;
#if MK_SINGLE
    a.ph_lo = 0; a.ph_hi = NPH;
    void* kargs[] = {&a};
    hipError_t e = hipLaunchCooperativeKernel((const void*)yoco_fwd, dim3(grid), dim3(NWAVES * 64), kargs, LDS_BYTES, stream);
    if (e != hipSuccess) fprintf(stderr, "cooperative launch failed: %s (grid %d)\n", hipGetErrorString(e), grid);
#else
    for (int p = 0; p < NPH; ++p) {
        a.ph_lo = h_prog[p].layer; a.ph_hi = 0;
        switch (h_prog[p].kind) {
#define LK(K) case K: launch_kind<K>(a, stream); break;
            LK(K_PRO) LK(K_NSA_IN) LK(K_CMP_HID) LK(K_CMP_OUT) LK(K_NSA_ATT) LK(K_SWA_IN) LK(K_SWA_ATT) LK(K_OUTPROJ) LK(K_LN1) LK(K_LN1R) LK(K_FFN1) LK(K_FFN2) LK(K_LN2) LK(K_SCATTER) LK(K_MOE1) LK(K_MOE2) LK(K_LN2C)
#undef LK
            default: break;
        }
    }
#endif
}
```

```cpp
#include <hip/hip_runtime.h>
#include <hip/hip_cooperative_groups.h>
#include <cstdio>
#include <cstdint>
namespace cg = cooperative_groups;

#ifndef DBG_DROP
#define DBG_DROP 0
#endif
#ifndef NAIVE_NSA
#define NAIVE_NSA 0
#endif
#ifndef NAIVE_SWA
#define NAIVE_SWA 0
#endif
#ifndef MK_SINGLE
#define MK_SINGLE 1
#endif

#define DEVI __device__ __forceinline__
#define LAS __attribute__((address_space(3)))
#define GAS __attribute__((address_space(1)))
typedef unsigned short bf16_t;
typedef short bf16x8 __attribute__((ext_vector_type(8)));
typedef float f32x4 __attribute__((ext_vector_type(4)));
typedef float f32x2 __attribute__((ext_vector_type(2)));
typedef unsigned u32x4 __attribute__((ext_vector_type(4)));
typedef unsigned u32x2 __attribute__((ext_vector_type(2)));

constexpr int BATCH = 2, SEQ = 16384, MTOK = BATCH * SEQ, DM = 1024, DEPTH = 4;
constexpr int HD = 64;
constexpr int A_G = 4, A_R = 4, A_IN = 2608, A_INP = 2816;
constexpr int NCMP = 1023, CMP_HID = 256;
constexpr int NSLC = SEQ / 64, NSEL = 16, NSA_WIN = 512;
constexpr int B_G = 2, B_R = 8, SWA_WIN = 128;
constexpr int DFF = 2816, NEXP = 8, DFFE = 3584;
constexpr int CAP = MTOK * 2 + NEXP * 256;
constexpr float ALPHA = 1.6817928305074292f;
constexpr float LN_EPS = 1e-5f;
constexpr float QSCALE = 0.125f;

constexpr size_t al256(size_t x) { return (x + 255) & ~(size_t)255; }
constexpr size_t WS_CTL = 0, CTL_BYTES = 1u << 20;
constexpr size_t WS_WINA = CTL_BYTES;
constexpr size_t WS_WOUTA = WS_WINA + (size_t)2 * A_INP * DM * 2;
constexpr size_t WS_WC1 = WS_WOUTA + (size_t)2 * DM * DM * 2;
constexpr size_t WS_WC2 = WS_WC1 + (size_t)4 * 256 * 2048 * 2;
constexpr size_t WS_WQKV2 = WS_WC2 + (size_t)4 * 256 * 256 * 2;
constexpr size_t WS_WQB1 = WS_WQKV2 + (size_t)1280 * DM * 2;
constexpr size_t WS_WOUTB = WS_WQB1 + (size_t)DM * DM * 2;
constexpr size_t WS_WDIN = WS_WOUTB + (size_t)2 * DM * DM * 2;
constexpr size_t WS_WDOUT = WS_WDIN + (size_t)2 * 2 * DFF * DM * 2;
constexpr size_t WS_WMIN = WS_WDOUT + (size_t)2 * DM * DFF * 2;
constexpr size_t WS_WMOUT = WS_WMIN + (size_t)16 * 2 * DFFE * DM * 2;
constexpr size_t WS_WEND = WS_WMOUT + (size_t)16 * DM * DFFE * 2;
constexpr size_t WS_H = al256(WS_WEND);
constexpr size_t WS_Y = WS_H + (size_t)MTOK * DM * 4;
constexpr size_t WS_HB = WS_Y + (size_t)MTOK * DM * 4;
constexpr size_t WS_CS = WS_HB + (size_t)MTOK * DM * 2;
constexpr size_t WS_KSH = WS_CS + (size_t)MTOK * 16 * 4;
constexpr size_t WS_VSH = WS_KSH + (size_t)MTOK * 128 * 2;
constexpr size_t WS_ROUTE = WS_VSH + (size_t)MTOK * 128 * 2;
constexpr size_t WS_XB = WS_ROUTE + (size_t)MTOK * 2 * 4 * 4;
constexpr size_t WS_ACT = WS_XB + (size_t)CAP * DM * 2;
constexpr size_t WS_RA = WS_ACT + (size_t)CAP * DFFE * 2;
constexpr size_t SLAB = (size_t)MTOK * 256 * 2;
constexpr size_t RA_Q = WS_RA;
constexpr size_t RA_ATT = RA_Q + (size_t)MTOK * DM * 2;
constexpr size_t RA_KCR = RA_ATT + (size_t)MTOK * DM * 2;
constexpr size_t RA_VCR = RA_KCR + SLAB + 4096;
constexpr size_t RA_KS = RA_VCR + SLAB + 4096;
constexpr size_t RA_VS = RA_KS + SLAB;
constexpr size_t RA_KW = RA_VS + SLAB;
constexpr size_t RA_VW = RA_KW + SLAB;
constexpr size_t RA_GATE = RA_VW + SLAB;
constexpr size_t RA_KC = RA_GATE + (size_t)MTOK * 48 * 4;
constexpr size_t RA_VC = RA_KC + (size_t)8192 * 64 * 2;
constexpr size_t RA_CH = RA_VC + (size_t)8192 * 64 * 2;
constexpr size_t RA_VST = RA_CH + (size_t)2 * 8192 * 256 * 2;
constexpr size_t RA_END = RA_VST + SLAB;
constexpr size_t WS_YB = WS_RA;
constexpr size_t YB_END = WS_YB + (size_t)CAP * DM * 4;
constexpr size_t WS_END = (RA_END > YB_END ? RA_END : YB_END);
static_assert(WS_END < (size_t)1879048192, "workspace map exceeds 4x the largest tensor");

constexpr int CW_BAR = 4096;
constexpr int CW_MOE = 16384;
constexpr int CW_WGCNT = 45056;
constexpr int CW_KMAX = 40064;
constexpr int CW_VMAX = 40000;
constexpr int CW_BIASP = 32768;

constexpr int RING_BYTES = 131072;
constexpr int LDS_X = RING_BYTES;
constexpr int MISC_OFF = RING_BYTES + 16384;
constexpr int LDS_BYTES = MISC_OFF + 1024;

DEVI unsigned f2bf(float f) { unsigned u = __builtin_bit_cast(unsigned, f); return (u + 0x7fffu + ((u >> 16) & 1u)) >> 16; }
DEVI unsigned pk2(float lo, float hi) { return f2bf(lo) | (f2bf(hi) << 16); }
DEVI float bf2f(unsigned h) { return __builtin_bit_cast(float, h << 16); }
DEVI float bflo(unsigned w) { return __builtin_bit_cast(float, w << 16); }
DEVI float bfhi(unsigned w) { return __builtin_bit_cast(float, w & 0xffff0000u); }
DEVI float shx(float v, int mask, int lane) { return __builtin_bit_cast(float, __builtin_amdgcn_ds_bpermute((lane ^ mask) << 2, __builtin_bit_cast(int, v))); }
DEVI int shxi(int v, int mask, int lane) { return __builtin_amdgcn_ds_bpermute((lane ^ mask) << 2, v); }
DEVI float wave_sum(float v, int lane) {
#pragma unroll
    for (int o = 1; o < 64; o <<= 1) v += shx(v, o, lane);
    return v;
}
DEVI float wave_max(float v, int lane) {
#pragma unroll
    for (int o = 1; o < 64; o <<= 1) v = fmaxf(v, shx(v, o, lane));
    return v;
}
DEVI int wave_id_sgpr() { return __builtin_amdgcn_readfirstlane((int)threadIdx.x >> 6); }
DEVI int opaque_tid(int wave) { asm volatile("" : "+s"(wave)); int l; asm volatile("v_mbcnt_lo_u32_b32 %0, -1, 0\n\tv_mbcnt_hi_u32_b32 %0, -1, %0" : "=v"(l)); return wave * 64 + l; }
#define LDS_WAIT() asm volatile("s_waitcnt lgkmcnt(0)" ::: "memory")
#define VM_WAIT() asm volatile("s_waitcnt vmcnt(0)" ::: "memory")

namespace pg8 {
constexpr int BM = 256, BK = 64, HALF = 128, HTB = HALF * BK * 2, STAGE_BYTES = 8 * HTB, NXCD = 8, WGM = 8;
DEVI int lds_byte(int r, int c) { const int st = (r >> 4) * 2 + (c >> 5), rr = r & 15, cc = c & 31, ob = rr * 64 + cc * 2; return st * 1024 + (ob ^ (((ob >> 9) & 1) << 5)); }
DEVI void stage_rc(int b, int& R, int& C) { const int st = b / 1024, sb = b % 1024, swz = sb ^ (((sb >> 9) & 1) << 5); R = (st >> 1) * 16 + swz / 64; C = (st & 1) * 32 + (swz % 64) / 2; }
DEVI int perm32(int rho) { const int n = rho >> 4, i = rho & 15; return 8 * (i >> 2) + 4 * n + (i & 3); }

struct Unit { int pm, pn; const bf16_t* bt; int koff, z; };
struct Gemm { const bf16_t* A; int lda; int K; int ldb; };

struct StaticOrder {
    int nM, nN, nwg, G, c; const bf16_t* bt;
    DEVI void init(int nM_, int nN_, int G_, int c_, const bf16_t* bt_) { nM = nM_; nN = nN_; nwg = nM * nN; G = G_; c = c_; bt = bt_; }
    DEVI bool tile(int i, int& pm, int& pn) const {
        const long L = (long)i * G + c; if (L >= nwg) return false;
        int wgid = (int)L; { const int q = nwg / NXCD, r = nwg % NXCD, xcd = wgid % NXCD, off = wgid / NXCD; wgid = (xcd < r ? xcd * (q + 1) : r * (q + 1) + (xcd - r) * q) + off; }
        const int nig = WGM * nN, gid = wgid / nig, fm = gid * WGM, gsz = (nM - fm) < WGM ? (nM - fm) : WGM;
        pm = fm + ((wgid % nig) % gsz); pn = (wgid % nig) / gsz; return true;
    }
    DEVI bool next(int i, Unit& u) const { if (!tile(i, u.pm, u.pn)) return false; u.bt = bt; u.koff = 0; u.z = 0; return true; }
};
struct GroupedOrder : StaticOrder {
    int t1, t2, t3, t4, t5, t6, t7; size_t estride;
    DEVI bool next(int i, Unit& u) const {
        if (!tile(i, u.pm, u.pn)) return false;
        const int tm = u.pm; const int e = (tm >= t1) + (tm >= t2) + (tm >= t3) + (tm >= t4) + (tm >= t5) + (tm >= t6) + (tm >= t7);
        u.bt = bt + (size_t)e * estride; u.koff = 0; u.z = 0; return true;
    }
};
struct SliceOrder {
    int nsl, G, c, kq; const bf16_t* bt; int t1, t2, t3, t4, t5, t6, t7; size_t estride;
    DEVI bool next(int i, Unit& u) const {
        const int L = i * G + c; if (L >= nsl) return false;
        u.pm = 256 + (L >> 4); u.pn = (L & 15) >> 2; u.z = L & 3; u.koff = u.z * kq;
        const int tm = u.pm; const int e = (tm >= t1) + (tm >= t2) + (tm >= t3) + (tm >= t4) + (tm >= t5) + (tm >= t6) + (tm >= t7);
        u.bt = bt + (size_t)e * estride; return true;
    }
};
struct DualOrder : StaticOrder {
    size_t estride;
    DEVI bool next(int i, Unit& u) const { if (!tile(i, u.pm, u.pn)) return false; u.bt = bt + (u.pm >= nM / 2 ? estride : 0); u.koff = 0; u.z = 0; return true; }
};

DEVI unsigned cvt_pk_bf16(float lo, float hi) { typedef __bf16 bf16x2_t __attribute__((ext_vector_type(2))); f32x2 v = {lo, hi}; bf16x2_t b = __builtin_convertvector(v, bf16x2_t); return __builtin_bit_cast(unsigned, b); }

template <class Epi, class Sched, bool ALIGN_EPI = true>
DEVI void gemm_phase(LAS unsigned char* lds, const Gemm g, const Sched& S, const Epi& E, int wave0) {
    const int tid = opaque_tid(wave0), wid = __builtin_amdgcn_readfirstlane(tid >> 6), lane = tid & 63, wr = wid >> 2, wc = wid & 3, fr = lane & 15, fq = lane >> 4;
    const int K = g.K, nt = K / BK, lda = g.lda, ldb = g.ldb;
    unsigned voffA[2], voffB[2];
#pragma unroll
    for (int i = 0; i < 2; ++i) { int R, C; stage_rc(tid * 16 + i * 8192, R, C); const int Rb = Epi::PERM ? ((R & ~31) + perm32(R & 31)) : R;
        voffA[i] = (unsigned)(R * lda + C) * 2u; voffB[i] = (unsigned)(Rb * ldb + C) * 2u; }
    const size_t kstep = (size_t)(BK * 2);
    const size_t hstepA = (size_t)HALF * lda * 2, tstepA = 2 * hstepA;
    const size_t hstepB = (size_t)HALF * ldb * 2, tstepB = 2 * hstepB;
    const unsigned ldsw = (unsigned)wid * 1024u;
    const int aoff = lds_byte(wr * 64 + fr, fq * 8), boff = lds_byte(wc * 32 + fr, fq * 8);
#define PG8_SA(b, h) (((b) * 2 + (h)) * HTB)
#define PG8_SB(b, h) ((4 + (b) * 2 + (h)) * HTB)
#define PG8_STAGE(bufoff, gbase, voff) do { _Pragma("unroll") for (int _i = 0; _i < 2; ++_i) \
        __builtin_amdgcn_global_load_lds((const unsigned*)((const char*)(gbase) + (voff)[_i]), (LAS unsigned*)(lds + (bufoff) + ldsw + _i * 8192), 16, 0, 0); } while (0)
#define PG8_LDA(dst, b, h) do { _Pragma("unroll") for (int m = 0; m < 4; ++m) _Pragma("unroll") for (int k = 0; k < 2; ++k) dst[m][k] = *(const LAS bf16x8*)(lds + PG8_SA(b, h) + aoff + m * 2048 + k * 1024); } while (0)
#define PG8_LDB(dst, b, h) do { _Pragma("unroll") for (int n = 0; n < 2; ++n) _Pragma("unroll") for (int k = 0; k < 2; ++k) dst[n][k] = *(const LAS bf16x8*)(lds + PG8_SB(b, h) + boff + n * 2048 + k * 1024); } while (0)
#define PG8_MMA(ai, bj, At, Bt) do { __builtin_amdgcn_s_setprio(1); _Pragma("unroll") for (int m = 0; m < 4; ++m) _Pragma("unroll") for (int n = 0; n < 2; ++n) _Pragma("unroll") for (int k = 0; k < 2; ++k) \
        acc[ai][bj][m][n] = __builtin_amdgcn_mfma_f32_16x16x32_bf16(Bt[n][k], At[m][k], acc[ai][bj][m][n], 0, 0, 0); __builtin_amdgcn_s_setprio(0); } while (0)
#define PG8_WAIT_V(n) asm volatile("s_waitcnt vmcnt(" #n ")" ::: "memory")
#define PG8_WAIT_L(n) asm volatile("s_waitcnt lgkmcnt(" #n ")" ::: "memory")
#define PG8_BAR __builtin_amdgcn_s_barrier()
#define PG8_SCHED __builtin_amdgcn_sched_barrier(0)
    Unit cur, nxt; int ui = 0;
    if (!S.next(0, cur)) return;
    f32x4 acc[2][2][4][2];
#pragma unroll
    for (int a = 0; a < 2; ++a)
#pragma unroll
        for (int b = 0; b < 2; ++b)
#pragma unroll
            for (int m = 0; m < 4; ++m)
#pragma unroll
                for (int n = 0; n < 2; ++n) acc[a][b][m][n] = (f32x4){0.f, 0.f, 0.f, 0.f};
    bf16x8 At[4][2], B0[2][2], B1[2][2];
    const char* cA = (const char*)g.A + (size_t)cur.pm * tstepA + (size_t)cur.koff * 2; const char* cB = (const char*)cur.bt + (size_t)cur.pn * tstepB + (size_t)cur.koff * 2;
    PG8_STAGE(PG8_SB(0, 0), cB, voffB); PG8_STAGE(PG8_SB(0, 1), cB + hstepB, voffB); PG8_STAGE(PG8_SA(0, 0), cA, voffA); PG8_STAGE(PG8_SA(0, 1), cA + hstepA, voffA);
    if (wr == 1) PG8_BAR;
    PG8_WAIT_V(2); PG8_BAR;
    PG8_STAGE(PG8_SB(1, 0), cB + kstep, voffB); PG8_STAGE(PG8_SA(1, 0), cA + kstep, voffA); PG8_STAGE(PG8_SB(1, 1), cB + hstepB + kstep, voffB);
    PG8_WAIT_V(6); PG8_BAR;
    for (;;) {
        const bool has_next = S.next(ui + 1, nxt);
        const char* nA = has_next ? (const char*)g.A + (size_t)nxt.pm * tstepA + (size_t)nxt.koff * 2 : cA; const char* nB = has_next ? (const char*)nxt.bt + (size_t)nxt.pn * tstepB + (size_t)nxt.koff * 2 : cB;
        for (int t = 0; t < nt; t += 2) {
            const bool last = (t == nt - 2);
            const char* a1 = cA + (size_t)(t + 1) * kstep;
            const char* a2 = last ? nA : cA + (size_t)(t + 2) * kstep; const char* b2 = last ? nB : cB + (size_t)(t + 2) * kstep;
            const char* a3 = a2 + kstep; const char* b3 = b2 + kstep;
            PG8_LDB(B0, 0, 0); PG8_LDB(B1, 0, 1); PG8_SCHED; PG8_LDA(At, 0, 0); PG8_STAGE(PG8_SA(1, 1), a1 + hstepA, voffA);
            PG8_WAIT_V(8); PG8_WAIT_L(0); PG8_BAR; PG8_MMA(0, 0, At, B0); PG8_MMA(0, 1, At, B1); PG8_BAR; PG8_SCHED;
            PG8_LDA(At, 0, 1); PG8_STAGE(PG8_SB(0, 0), b2, voffB); PG8_STAGE(PG8_SB(0, 1), b2 + hstepB, voffB); PG8_STAGE(PG8_SA(0, 0), a2, voffA);
            PG8_WAIT_V(8); PG8_WAIT_L(0); PG8_BAR; PG8_MMA(1, 0, At, B0); PG8_MMA(1, 1, At, B1); PG8_BAR; PG8_SCHED;
            PG8_LDB(B0, 1, 0); PG8_LDB(B1, 1, 1); PG8_SCHED; PG8_LDA(At, 1, 0); PG8_STAGE(PG8_SA(0, 1), a2 + hstepA, voffA);
            PG8_WAIT_V(8); PG8_WAIT_L(0); PG8_BAR; PG8_MMA(0, 0, At, B0); PG8_MMA(0, 1, At, B1); PG8_BAR; PG8_SCHED;
            PG8_LDA(At, 1, 1); PG8_STAGE(PG8_SB(1, 0), b3, voffB); PG8_STAGE(PG8_SB(1, 1), b3 + hstepB, voffB); PG8_STAGE(PG8_SA(1, 0), a3, voffA);
            PG8_WAIT_V(8); PG8_WAIT_L(0); PG8_BAR; PG8_MMA(1, 0, At, B0); PG8_MMA(1, 1, At, B1); PG8_BAR; PG8_SCHED;
        }
        if constexpr (ALIGN_EPI) { if (wr == 0) PG8_BAR; }
        E(acc, cur, wr, wc, fr, fq);
        if (!has_next) break;
#pragma unroll
        for (int a = 0; a < 2; ++a)
#pragma unroll
            for (int b = 0; b < 2; ++b)
#pragma unroll
                for (int m = 0; m < 4; ++m)
#pragma unroll
                    for (int n = 0; n < 2; ++n) acc[a][b][m][n] = (f32x4){0.f, 0.f, 0.f, 0.f};
        cur = nxt; cA = nA; cB = nB; ++ui;
        if constexpr (ALIGN_EPI) { if (wr == 1) PG8_BAR; }
    }
    PG8_WAIT_V(0);
    if constexpr (!ALIGN_EPI) { if (wr == 0) PG8_BAR; }
    PG8_BAR;
#undef PG8_SA
#undef PG8_SB
#undef PG8_STAGE
#undef PG8_LDA
#undef PG8_LDB
#undef PG8_MMA
#undef PG8_WAIT_V
#undef PG8_WAIT_L
#undef PG8_BAR
#undef PG8_SCHED
}
}

#define XB_TMO      128
#define XB_XCNT(j)  (256  + 64 * (j))
#define XB_XSUB(j)  (1280 + 64 * (j))
#define XB_XGEN(j)  (2304 + 64 * (j))
#define XB_TOP      3328
#define XB_TOPGEN   3392
#define XCD_BAR_WORDS 3456
#define XB_SPIN_CAP (1u << 22)
DEVI unsigned xb_ld(unsigned* p)              { return __hip_atomic_load(p, __ATOMIC_RELAXED, __HIP_MEMORY_SCOPE_AGENT); }
DEVI unsigned xb_add(unsigned* p, unsigned v) { return __hip_atomic_fetch_add(p, v, __ATOMIC_RELAXED, __HIP_MEMORY_SCOPE_AGENT); }
DEVI unsigned xb_xcc_id() { return (unsigned)__builtin_amdgcn_s_getreg((3 << 11) | 20) & 0xFu; }
#define XB_SPIN(cond, bar) do { unsigned _sp = 0; while (cond) { __builtin_amdgcn_s_sleep(1); \
    if ((++_sp & 255u) == 0u) { if (xb_ld(&(bar)[XB_TMO])) break; if (_sp > XB_SPIN_CAP) { atomicAdd(&(bar)[XB_TMO], 1u); break; } } } } while (0)
struct XcdBarrier { unsigned* bar; unsigned x; volatile LAS unsigned* st; };
DEVI XcdBarrier xcd_barrier_post(unsigned* bar, volatile LAS unsigned* st) {
    XcdBarrier b; b.bar = bar; b.x = xb_xcc_id(); b.st = st;
    if (threadIdx.x == 0) (void)xb_add(&bar[XB_XCNT(b.x)], 1u);
    return b;
}
DEVI void xcd_barrier_complete(unsigned* bar, unsigned x, unsigned& nloc, unsigned& nx) {
    const unsigned G = gridDim.x * gridDim.y * gridDim.z;
    unsigned sum, cnt, mine, sp = 0u;
    for (;;) {
        sum = 0u; cnt = 0u; mine = 0u;
#pragma unroll
        for (unsigned j = 0; j < 16; ++j) { const unsigned c = xb_ld(&bar[XB_XCNT(j)]); sum += c; cnt += (c > 0u) ? 1u : 0u; mine = (j == x) ? c : mine; }
        if (sum == G) break;
        __builtin_amdgcn_s_sleep(1);
        if ((++sp & 255u) == 0u) { if (xb_ld(&bar[XB_TMO])) break; if (sp > XB_SPIN_CAP) { atomicAdd(&bar[XB_TMO], 1u); break; } }
    }
    nloc = mine > 0u ? mine : 1u; nx = cnt > 0u ? cnt : 1u;
}
DEVI void xcd_barrier(const XcdBarrier& b) {
    asm volatile("s_waitcnt vmcnt(0)" ::: "memory");
    __syncthreads();
    if (threadIdx.x == 0) {
        unsigned* bar = b.bar;
        __builtin_amdgcn_s_waitcnt(0);
        unsigned nloc = b.st[0], nx = b.st[1];
        if (nloc == 0u) { xcd_barrier_complete(bar, b.x, nloc, nx); b.st[0] = nloc; b.st[1] = nx; }
        const unsigned old = xb_add(&bar[XB_XSUB(b.x)], 1u);
        const unsigned gen = old / nloc;
        if (old + 1u == (gen + 1u) * nloc) {
            __builtin_amdgcn_fence(__ATOMIC_RELEASE, "agent");
            asm volatile("s_waitcnt vmcnt(0)" ::: "memory");
            const unsigned og = xb_add(&bar[XB_TOP], 1u);
            const unsigned tg = og / nx;
            if (og + 1u == (tg + 1u) * nx) xb_add(&bar[XB_TOPGEN], 1u);
            else XB_SPIN(xb_ld(&bar[XB_TOPGEN]) == tg, bar);
            __builtin_amdgcn_fence(__ATOMIC_ACQUIRE, "agent");
            xb_add(&bar[XB_XGEN(b.x)], 1u);
            asm volatile("s_waitcnt vmcnt(0)" ::: "memory");
        } else {
            XB_SPIN(xb_ld(&bar[XB_XGEN(b.x)]) == gen, bar);
            __builtin_amdgcn_fence(__ATOMIC_ACQUIRE, "agent");
            asm volatile("s_waitcnt vmcnt(0)" ::: "memory");
        }
    }
    __syncthreads();
}

typedef const void* cvp_t;
DEVI const void* karg_ptr(int byte_off) { asm volatile("" : "+s"(byte_off)); const __attribute__((address_space(4))) char* kp = (const __attribute__((address_space(4))) char*)__builtin_amdgcn_kernarg_segment_ptr(); return *(const __attribute__((address_space(4))) cvp_t*)(kp + byte_off); }
#define ARG_IN(i) karg_ptr((i) * 8)
#define ARG_OUT() ((float*)karg_ptr(18 * 8))
#define ARG_WS() ((unsigned char*)karg_ptr(19 * 8))
struct Frame {
    LAS unsigned char* lds;
    unsigned char* ws;
    int tid, lane, wave, G, vcu, wave0;
    DEVI void refresh() { tid = opaque_tid(wave0); lane = tid & 63; wave = __builtin_amdgcn_readfirstlane(tid >> 6); }
};
constexpr int NWAVES = 8;

DEVI void transpose_item(const float* W, int K, int N, bf16_t* WT, int k0, int n0, int drow0, LAS float* scr, int lane) {
    const int nc = n0 + 4 * (lane & 7); const bool ok = nc < N;
#pragma unroll
    for (int i = 0; i < 8; ++i) { const int kk = 8 * i + (lane >> 3); const f32x4 v = ok ? *(const f32x4*)(W + (size_t)(k0 + kk) * N + nc) : (f32x4){0.f, 0.f, 0.f, 0.f};
        LAS float* d = scr + kk * 33 + 4 * (lane & 7); d[0] = v[0]; d[1] = v[1]; d[2] = v[2]; d[3] = v[3]; }
    LDS_WAIT(); asm volatile("" ::: "memory");
    const int c = lane & 7;
#pragma unroll
    for (int j = 0; j < 4; ++j) { const int n = (lane >> 3) + 8 * j; const LAS float* s = scr + (8 * c) * 33 + n;
        u32x4 o; o.x = pk2(s[0 * 33], s[1 * 33]); o.y = pk2(s[2 * 33], s[3 * 33]); o.z = pk2(s[4 * 33], s[5 * 33]); o.w = pk2(s[6 * 33], s[7 * 33]);
        *(u32x4*)(WT + (size_t)(drow0 + n) * K + k0 + 8 * c) = o; }
    LDS_WAIT(); asm volatile("" ::: "memory");
}
struct WFam { const float* src; size_t sstride; bf16_t* dst; size_t dstride; int count, K, N, Npad, mode; };
DEVI bool wfam_do(const WFam& f, int& it, LAS float* scr, int lane) {
    const int nkb = f.K / 64, nnb = f.Npad / 32, per = nkb * nnb, tot = per * f.count;
    if (it >= tot) { it -= tot; return false; }
    const int mi = it / per, r = it % per, kb = r / nnb, nb = r % nnb, n0 = nb * 32;
    int drow0 = n0;
    if (f.mode == 1) { const int F = f.N / 2; const int o = n0 < F ? n0 : n0 - F; drow0 = 256 * (o / 128) + (o % 128) + (n0 < F ? 0 : 128); }
    transpose_item(f.src + (size_t)mi * f.sstride, f.K, f.N, f.dst + (size_t)mi * f.dstride, kb * 64, n0, drow0, scr, lane);
    return true;
}

DEVI void phase_prologue(Frame& F) {
    F.refresh();
    LAS float* scr = (LAS float*)(F.lds + F.wave * 16384);
    const int gw = F.vcu * NWAVES + F.wave, NGW = F.G * NWAVES;
    unsigned char* ws = F.ws;
    const WFam fam[11] = {
        {(const float*)ARG_IN(2), (size_t)DM * A_IN, (bf16_t*)(ws + WS_WINA), (size_t)A_INP * DM, 2, DM, A_IN, A_INP, 0},
        {(const float*)ARG_IN(3), (size_t)DM * DM, (bf16_t*)(ws + WS_WOUTA), (size_t)DM * DM, 2, DM, DM, DM, 0},
        {(const float*)ARG_IN(5), (size_t)2048 * 256, (bf16_t*)(ws + WS_WC1), (size_t)256 * 2048, 4, 2048, 256, 256, 0},
        {(const float*)ARG_IN(6), (size_t)256 * 64, (bf16_t*)(ws + WS_WC2), (size_t)256 * 256, 4, 256, 64, 256, 0},
        {(const float*)ARG_IN(8), (size_t)DM * DM, (bf16_t*)(ws + WS_WQKV2), 0, 1, DM, DM, DM, 0},
        {(const float*)ARG_IN(7), 0, (bf16_t*)(ws + WS_WQKV2) + (size_t)DM * DM, 0, 1, DM, 256, 256, 0},
        {(const float*)ARG_IN(8) + (size_t)DM * DM, 0, (bf16_t*)(ws + WS_WQB1), 0, 1, DM, DM, DM, 0},
        {(const float*)ARG_IN(9), (size_t)DM * DM, (bf16_t*)(ws + WS_WOUTB), (size_t)DM * DM, 2, DM, DM, DM, 0},
        {(const float*)ARG_IN(13), (size_t)DM * 2 * DFF, (bf16_t*)(ws + WS_WDIN), (size_t)2 * DFF * DM, 2, DM, 2 * DFF, 2 * DFF, 1},
        {(const float*)ARG_IN(14), (size_t)DFF * DM, (bf16_t*)(ws + WS_WDOUT), (size_t)DM * DFF, 2, DFF, DM, DM, 0},
        {(const float*)ARG_IN(16), (size_t)DM * 2 * DFFE, (bf16_t*)(ws + WS_WMIN), (size_t)2 * DFFE * DM, 16, DM, 2 * DFFE, 2 * DFFE, 1},
    };
    const WFam famo = {(const float*)ARG_IN(17), (size_t)DFFE * DM, (bf16_t*)(ws + WS_WMOUT), (size_t)DM * DFFE, 16, DFFE, DM, DM, 0};
    int total = 0;
#pragma unroll
    for (int i = 0; i < 11; ++i) total += (fam[i].K / 64) * (fam[i].Npad / 32) * fam[i].count;
    total += (famo.K / 64) * (famo.Npad / 32) * famo.count;
    for (int it0 = gw; it0 < total; it0 += NGW) {
        int it = it0; bool done = false;
#pragma unroll
        for (int i = 0; i < 11; ++i) if (!done) done = wfam_do(fam[i], it, scr, F.lane);
        if (!done) wfam_do(famo, it, scr, F.lane);
    }
    { const float* x = (const float*)ARG_IN(0); bf16_t* hb = (bf16_t*)(ws + WS_HB);
      const size_t n8 = (size_t)MTOK * DM / 8;
      for (size_t i = (size_t)blockIdx.x * 512 + F.tid; i < n8; i += (size_t)F.G * 512) {
          const f32x4 v0 = *(const f32x4*)(x + i * 8), v1 = *(const f32x4*)(x + i * 8 + 4);
          u32x4 o; o.x = pk2(v0.x, v0.y); o.y = pk2(v0.z, v0.w); o.z = pk2(v1.x, v1.y); o.w = pk2(v1.z, v1.w);
          *(u32x4*)(hb + i * 8) = o; } }
    { const int* pos = (const int*)ARG_IN(1); float* cs = (float*)(ws + WS_CS);
      for (int i = blockIdx.x * 512 + F.tid; i < MTOK * 8; i += F.G * 512) {
          const int tok = i >> 3, j = i & 7;
          const float invf = (float)exp2(-(double)j * (18.931568569324174 / 8.0));
          const double ang = (double)((float)pos[tok] * invf);
          const double n = rint(ang * 0.15915494309189535); const double r = ang - n * 6.283185307179586476925;
          const float rf = (float)r;
          cs[tok * 16 + j] = cosf(rf); cs[tok * 16 + 8 + j] = sinf(rf); } }
    { const float* cp = (const float*)ARG_IN(4); const float* w1 = (const float*)ARG_IN(5); float* bp = (float*)((unsigned*)(ws + WS_CTL) + CW_BIASP);
      if (gw < 1024) { const int mi = gw >> 8, c = gw & 255; float s = 0.f;
#pragma unroll 8
          for (int i = 0; i < 32; ++i) { const int f = i * 64 + F.lane; s += cp[(size_t)mi * 2048 + f] * w1[((size_t)mi * 2048 + f) * 256 + c]; }
          s = wave_sum(s, F.lane);
          if (F.lane == 0) bp[gw] = s; } }
}

typedef f32x4 AccT[2][2][4][2];

DEVI u32x4 pack8(const f32x4 a, const f32x4 b) { u32x4 w; w.x = pg8::cvt_pk_bf16(a[0], a[1]); w.y = pg8::cvt_pk_bf16(a[2], a[3]); w.z = pg8::cvt_pk_bf16(b[0], b[1]); w.w = pg8::cvt_pk_bf16(b[2], b[3]); return w; }
DEVI void rope8(f32x4& v0, f32x4& v1, int dhead, const float* csrow, int lane) {
    f32x4 p0, p1;
#pragma unroll
    for (int i = 0; i < 4; ++i) { p0[i] = shx(v0[i], 16, lane); p1[i] = shx(v1[i], 16, lane); }
    if (dhead < 16) {
        const f32x4 c0 = *(const f32x4*)(csrow), c1 = *(const f32x4*)(csrow + 4), s0 = *(const f32x4*)(csrow + 8), s1 = *(const f32x4*)(csrow + 12);
        if (dhead == 0) { v0 = v0 * c0 - p0 * s0; v1 = v1 * c1 - p1 * s1; }
        else            { v0 = v0 * c0 + p0 * s0; v1 = v1 * c1 + p1 * s1; }
    }
}

struct EpiNsaIn {
    static constexpr bool PERM = true;
    unsigned char* ws; const float* cs;
    DEVI void operator()(const AccT& acc, const pg8::Unit& u, int wr, int wc, int fr, int fq) const {
        const int pn = u.pn;
        if (pn < 4) {
            bf16_t* Q = (bf16_t*)(ws + RA_Q);
#pragma unroll
            for (int ai = 0; ai < 2; ++ai)
#pragma unroll
                for (int m = 0; m < 4; ++m) { const int row = u.pm * 256 + ai * 128 + wr * 64 + m * 16 + fr;
#pragma unroll
                    for (int bj = 0; bj < 2; ++bj) *(u32x4*)(Q + (size_t)row * DM + pn * 256 + bj * 128 + wc * 32 + fq * 8) = pack8(acc[ai][bj][m][0], acc[ai][bj][m][1]); }
        } else if (pn < 10) {
            const size_t base = pn == 4 ? RA_KCR : pn == 5 ? RA_VCR : pn == 6 ? RA_KS : pn == 7 ? RA_VS : pn == 8 ? RA_KW : RA_VW;
            bf16_t* T = (bf16_t*)(ws + base);
            const bool rot = (pn == 6 || pn == 8);
            const int dh = (wc & 1) * 32 + fq * 8;
#pragma unroll
            for (int ai = 0; ai < 2; ++ai)
#pragma unroll
                for (int m = 0; m < 4; ++m) { const int row = u.pm * 256 + ai * 128 + wr * 64 + m * 16 + fr; const int b = row / SEQ, t = row % SEQ;
#pragma unroll
                    for (int bj = 0; bj < 2; ++bj) { f32x4 v0 = acc[ai][bj][m][0], v1 = acc[ai][bj][m][1];
                        if (rot) rope8(v0, v1, dh, cs + (size_t)row * 16, fq * 16 + fr);
                        const int g = bj * 2 + (wc >> 1);
                        *(u32x4*)(T + ((size_t)(b * A_G + g) * SEQ + t) * HD + dh) = pack8(v0, v1); } }
        } else {
            float* G = (float*)(ws + RA_GATE);
            if (wc < 2) {
#pragma unroll
                for (int ai = 0; ai < 2; ++ai)
#pragma unroll
                    for (int m = 0; m < 4; ++m) { const int row = u.pm * 256 + ai * 128 + wr * 64 + m * 16 + fr;
#pragma unroll
                        for (int n = 0; n < 2; ++n) { const int c = wc * 32 + fq * 8 + n * 4;
                            if (c < 48) { f32x4 v = acc[ai][0][m][n]; f32x4 o;
#pragma unroll
                                for (int i = 0; i < 4; ++i) o[i] = 1.f / (1.f + __expf(-v[i]));
                                *(f32x4*)(G + (size_t)row * 48 + c) = o; } } }
            }
        }
    }
};
struct EpiSwaIn {
    static constexpr bool PERM = true;
    unsigned char* ws; const float* cs;
    DEVI void operator()(const AccT& acc, const pg8::Unit& u, int wr, int wc, int fr, int fq) const {
        const int pn = u.pn; const int dh = (wc & 1) * 32 + fq * 8;
        bf16_t* Q = (bf16_t*)(ws + RA_Q); bf16_t* KS = (bf16_t*)(ws + WS_KSH); bf16_t* VS = (bf16_t*)(ws + WS_VSH);
#pragma unroll
        for (int ai = 0; ai < 2; ++ai)
#pragma unroll
            for (int m = 0; m < 4; ++m) { const int row = u.pm * 256 + ai * 128 + wr * 64 + m * 16 + fr; const int b = row / SEQ, t = row % SEQ;
#pragma unroll
                for (int bj = 0; bj < 2; ++bj) { f32x4 v0 = acc[ai][bj][m][0], v1 = acc[ai][bj][m][1];
                    const bool rot = (pn < 4) || (bj == 0);
                    if (rot) rope8(v0, v1, dh, cs + (size_t)row * 16, fq * 16 + fr);
                    const u32x4 w = pack8(v0, v1);
                    if (pn < 4) *(u32x4*)(Q + (size_t)row * DM + pn * 256 + bj * 128 + wc * 32 + fq * 8) = w;
                    else { bf16_t* T = bj == 0 ? KS : VS; const int g = wc >> 1; *(u32x4*)(T + ((size_t)(b * B_G + g) * SEQ + t) * HD + dh) = w; } } }
    }
};
DEVI float gelu_tanh(float x) { const float u = 0.7978845608028654f * (x + 0.044715f * x * x * x); const float e = __expf(2.f * u); const float th = 1.f - 2.f / (e + 1.f); return 0.5f * x * (1.f + th); }
struct EpiCmpHid {
    static constexpr bool PERM = true;
    bf16_t* out; const float* bias;
    DEVI void operator()(const AccT& acc, const pg8::Unit& u, int wr, int wc, int fr, int fq) const {
        const float* bs = bias;
#pragma unroll
        for (int bj = 0; bj < 2; ++bj) { const int c = bj * 128 + wc * 32 + fq * 8; const f32x4 b0 = *(const f32x4*)(bs + c), b1 = *(const f32x4*)(bs + c + 4);
#pragma unroll
            for (int ai = 0; ai < 2; ++ai)
#pragma unroll
                for (int m = 0; m < 4; ++m) { const int row = u.pm * 256 + ai * 128 + wr * 64 + m * 16 + fr; f32x4 v0 = acc[ai][bj][m][0] + b0, v1 = acc[ai][bj][m][1] + b1;
#pragma unroll
                    for (int i = 0; i < 4; ++i) { v0[i] = gelu_tanh(v0[i]); v1[i] = gelu_tanh(v1[i]); }
                    *(u32x4*)(out + (size_t)row * 256 + c) = pack8(v0, v1); } }
    }
};
struct EpiCmpOut {
    static constexpr bool PERM = true;
    bf16_t* kc; bf16_t* vc;
    DEVI void operator()(const AccT& acc, const pg8::Unit& u, int wr, int wc, int fr, int fq) const {
        if (wc >= 2) return;
        bf16_t* T = u.pm >= 32 ? vc : kc; const int rbase = (u.pm & 31) * 256;
#pragma unroll
        for (int ai = 0; ai < 2; ++ai)
#pragma unroll
            for (int m = 0; m < 4; ++m) { const int row = rbase + ai * 128 + wr * 64 + m * 16 + fr;
                u32x4 w = pack8(acc[ai][0][m][0], acc[ai][0][m][1]);
                if ((row & 1023) == 1023) w = (u32x4){0u, 0u, 0u, 0u};
                *(u32x4*)(T + (size_t)row * 64 + wc * 32 + fq * 8) = w; }
    }
};
struct EpiResid {
    static constexpr bool PERM = true;
    const bf16_t* res; bf16_t* y;
    DEVI void operator()(const AccT& acc, const pg8::Unit& u, int wr, int wc, int fr, int fq) const {
#pragma unroll
        for (int ai = 0; ai < 2; ++ai)
#pragma unroll
            for (int m = 0; m < 4; ++m) { const size_t off = (size_t)(u.pm * 256 + ai * 128 + wr * 64 + m * 16 + fr) * DM + u.pn * 256 + wc * 32 + fq * 8;
#pragma unroll
                for (int bj = 0; bj < 2; ++bj) { const u32x4 r = *(const u32x4*)(res + off + bj * 128);
                    const f32x4 r0 = {bflo(r.x), bfhi(r.x), bflo(r.y), bfhi(r.y)}, r1 = {bflo(r.z), bfhi(r.z), bflo(r.w), bfhi(r.w)};
                    *(u32x4*)(y + off + bj * 128) = pack8(r0 * ALPHA + acc[ai][bj][m][0], r1 * ALPHA + acc[ai][bj][m][1]); } }
    }
};
struct EpiBf16Out {
    static constexpr bool PERM = true;
    bf16_t* y;
    DEVI void operator()(const AccT& acc, const pg8::Unit& u, int wr, int wc, int fr, int fq) const {
#pragma unroll
        for (int ai = 0; ai < 2; ++ai)
#pragma unroll
            for (int m = 0; m < 4; ++m) { const size_t off = (size_t)(u.pm * 256 + ai * 128 + wr * 64 + m * 16 + fr) * DM + u.pn * 256 + wc * 32 + fq * 8;
#pragma unroll
                for (int bj = 0; bj < 2; ++bj) *(u32x4*)(y + off + bj * 128) = pack8(acc[ai][bj][m][0], acc[ai][bj][m][1]); }
    }
};
struct EpiPart {
    static constexpr bool PERM = false;
    float* part;
    DEVI void operator()(const AccT& acc, const pg8::Unit& u, int wr, int wc, int fr, int fq) const {
        float* base = part + (size_t)((u.pm - 256) * 4 + u.z) * 256 * DM;
#pragma unroll
        for (int ai = 0; ai < 2; ++ai)
#pragma unroll
            for (int m = 0; m < 4; ++m) { const size_t off = (size_t)(ai * 128 + wr * 64 + m * 16 + fr) * DM + u.pn * 256 + wc * 32 + fq * 4;
#pragma unroll
                for (int bj = 0; bj < 2; ++bj)
#pragma unroll
                    for (int n = 0; n < 2; ++n) *(f32x4*)(base + off + bj * 128 + n * 16) = acc[ai][bj][m][n]; }
    }
};
struct EpiSwiglu {
    static constexpr bool PERM = true;
    bf16_t* act; int ld;
    DEVI void operator()(const AccT& acc, const pg8::Unit& u, int wr, int wc, int fr, int fq) const {
#pragma unroll
        for (int ai = 0; ai < 2; ++ai)
#pragma unroll
            for (int m = 0; m < 4; ++m) { const size_t row = (size_t)(u.pm * 256 + ai * 128 + wr * 64 + m * 16 + fr); f32x4 o[2];
#pragma unroll
                for (int n = 0; n < 2; ++n)
#pragma unroll
                    for (int i = 0; i < 4; ++i) { const float gv = acc[ai][0][m][n][i], uv = acc[ai][1][m][n][i]; o[n][i] = gv * __builtin_amdgcn_rcpf(1.f + __expf(-gv)) * uv; }
                *(u32x4*)(act + row * ld + u.pn * 128 + wc * 32 + fq * 8) = pack8(o[0], o[1]); }
    }
};

DEVI void unpack8(const u32x4 w, float (&x)[8]) { x[0] = bflo(w.x); x[1] = bfhi(w.x); x[2] = bflo(w.y); x[3] = bfhi(w.y); x[4] = bflo(w.z); x[5] = bfhi(w.z); x[6] = bflo(w.w); x[7] = bfhi(w.w); }
DEVI void moe_row8(const bf16_t* YB, const float* PART, int p, int c, float (&x)[8]) {
    if (p < 65536) { unpack8(*(const u32x4*)(YB + (size_t)p * DM + c), x); return; }
    const float* q = PART + ((size_t)(((p >> 8) - 256) * 4) * 256 + (p & 255)) * DM + c;
    f32x4 a0 = *(const f32x4*)q, a1 = *(const f32x4*)(q + 4);
#pragma unroll
    for (int z = 1; z < 4; ++z) { a0 = a0 + *(const f32x4*)(q + (size_t)z * 256 * DM); a1 = a1 + *(const f32x4*)(q + (size_t)z * 256 * DM + 4); }
    x[0] = a0[0]; x[1] = a0[1]; x[2] = a0[2]; x[3] = a0[3]; x[4] = a1[0]; x[5] = a1[1]; x[6] = a1[2]; x[7] = a1[3];
}
template <int MODE, bool ROUTER, bool FINAL>
DEVI void phase_ln(Frame& F, int lnidx, float* outp, int moe_layer) {
    F.refresh();
    unsigned char* ws = F.ws;
    const bf16_t* Y = (const bf16_t*)(ws + WS_Y); const bf16_t* YB = (const bf16_t*)(ws + WS_YB); const float* PART = (const float*)(ws + WS_H);
    bf16_t* HB = (bf16_t*)(ws + WS_HB);
    const float* gam = (const float*)ARG_IN(11) + (size_t)lnidx * DM; const float* bet = (const float*)ARG_IN(12) + (size_t)lnidx * DM;
    int* TOKE = (int*)(ws + WS_ROUTE); int* TOKR = TOKE + MTOK * 2; float* TOKW = (float*)(TOKR + MTOK * 2); int* TOKP = (int*)(TOKW + MTOK * 2);
    const float* wr_ = ROUTER ? (const float*)ARG_IN(15) + (size_t)moe_layer * DM * NEXP : nullptr;
    LAS int* lcnt = (LAS int*)(F.lds + LDS_X);
    LAS int* lrec = lcnt + 16;
    LAS int* lrank = lrec + 256;
    if (ROUTER) { if (F.tid < 16) lcnt[F.tid] = 0; __syncthreads(); }
    const int gw = F.vcu * NWAVES + F.wave, NGW = F.G * NWAVES;
    int nloc = 0;
    for (int m = gw; m < MTOK; m += NGW, ++nloc) {
        float v[2][8];
        if (MODE == 0) {
#pragma unroll
            for (int j = 0; j < 2; ++j) unpack8(*(const u32x4*)(Y + (size_t)m * DM + j * 512 + F.lane * 8), v[j]);
        } else {
            const int p0 = TOKP[m * 2], p1 = TOKP[m * 2 + 1]; const float w0 = TOKW[m * 2], w1 = TOKW[m * 2 + 1];
#pragma unroll
            for (int j = 0; j < 2; ++j) { const int c = j * 512 + F.lane * 8; float h[8], a[8], b[8];
                unpack8(*(const u32x4*)(HB + (size_t)m * DM + c), h); moe_row8(YB, PART, p0, c, a); moe_row8(YB, PART, p1, c, b);
#pragma unroll
                for (int i = 0; i < 8; ++i) v[j][i] = h[i] * ALPHA + a[i] * w0 + b[i] * w1; }
        }
        float s = 0.f;
#pragma unroll
        for (int j = 0; j < 2; ++j)
#pragma unroll
            for (int i = 0; i < 8; ++i) s += v[j][i];
        const float mean = wave_sum(s, F.lane) * (1.f / DM); float s2 = 0.f;
#pragma unroll
        for (int j = 0; j < 2; ++j)
#pragma unroll
            for (int i = 0; i < 8; ++i) { v[j][i] -= mean; s2 += v[j][i] * v[j][i]; }
        const float rstd = 1.f / sqrtf(wave_sum(s2, F.lane) * (1.f / DM) + LN_EPS);
#pragma unroll
        for (int j = 0; j < 2; ++j) { const int c = j * 512 + F.lane * 8;
            const f32x4 g0 = *(const f32x4*)(gam + c), g1 = *(const f32x4*)(gam + c + 4), b0 = *(const f32x4*)(bet + c), b1 = *(const f32x4*)(bet + c + 4);
#pragma unroll
            for (int i = 0; i < 4; ++i) { v[j][i] = v[j][i] * rstd * g0[i] + b0[i]; v[j][4 + i] = v[j][4 + i] * rstd * g1[i] + b1[i]; }
            if (FINAL) { *(f32x4*)(outp + (size_t)m * DM + c) = (f32x4){v[j][0], v[j][1], v[j][2], v[j][3]}; *(f32x4*)(outp + (size_t)m * DM + c + 4) = (f32x4){v[j][4], v[j][5], v[j][6], v[j][7]}; }
            else { u32x4 w; w.x = pk2(v[j][0], v[j][1]); w.y = pk2(v[j][2], v[j][3]); w.z = pk2(v[j][4], v[j][5]); w.w = pk2(v[j][6], v[j][7]); *(u32x4*)(HB + (size_t)m * DM + c) = w; } }
        if (ROUTER) {
            float lg[NEXP];
#pragma unroll
            for (int e = 0; e < NEXP; ++e) lg[e] = 0.f;
#pragma unroll
            for (int j = 0; j < 2; ++j)
#pragma unroll
                for (int i = 0; i < 8; ++i) { const int c = j * 512 + F.lane * 8 + i; const f32x4 w0 = *(const f32x4*)(wr_ + (size_t)c * NEXP), w1 = *(const f32x4*)(wr_ + (size_t)c * NEXP + 4); const float x = v[j][i];
                    lg[0] += x * w0.x; lg[1] += x * w0.y; lg[2] += x * w0.z; lg[3] += x * w0.w; lg[4] += x * w1.x; lg[5] += x * w1.y; lg[6] += x * w1.z; lg[7] += x * w1.w; }
#pragma unroll
            for (int e = 0; e < NEXP; ++e) lg[e] = wave_sum(lg[e], F.lane);
            int e0 = 0; float l0 = lg[0];
#pragma unroll
            for (int e = 1; e < NEXP; ++e) if (lg[e] > l0) { l0 = lg[e]; e0 = e; }
            int e1 = -1; float l1 = -3.4e38f;
#pragma unroll
            for (int e = 0; e < NEXP; ++e) if (e != e0 && lg[e] > l1) { l1 = lg[e]; e1 = e; }
            if (e1 < 0) e1 = (e0 + 1) & 7;
            const float g1 = 1.f / (1.f + __expf(l0 - l1)), g0 = 1.f - g1;
            if (F.lane == 0) {
                const int idx = (F.wave * 16 + nloc) * 2;
                lrec[idx] = m * 16 + e0; lrec[idx + 1] = m * 16 + e1;
                TOKE[m * 2] = e0; TOKE[m * 2 + 1] = e1; TOKW[m * 2] = g0; TOKW[m * 2 + 1] = g1;
            }
        }
    }
    if (ROUTER) {
        __syncthreads();
        unsigned* cnt = (unsigned*)(ws + WS_CTL) + CW_MOE + moe_layer * 64;
        int* wgcnt = (int*)(ws + WS_CTL) + CW_WGCNT + moe_layer * 2048 + (int)blockIdx.x * 8;
        LAS int* wcnt = lrank;
        int rec = 0, e = 0, r = 0;
        if (F.wave < 4) { rec = lrec[F.tid]; e = rec & 15;
            const unsigned long long lt = (1ull << F.lane) - 1ull;
#pragma unroll
            for (int x = 0; x < 8; ++x) { const unsigned long long b = __builtin_amdgcn_ballot_w64(e == x); if (e == x) r = __builtin_popcountll(b & lt); if (F.lane == 0) wcnt[F.wave * 8 + x] = __builtin_popcountll(b); } }
        __syncthreads();
        if (F.wave < 4) { for (int w = 0; w < F.wave; ++w) r += wcnt[w * 8 + e]; TOKR[(rec >> 4) * 2 + (F.tid & 1)] = r; }
        if (F.tid < 8) lcnt[F.tid] = wcnt[F.tid] + wcnt[8 + F.tid] + wcnt[16 + F.tid] + wcnt[24 + F.tid];
        __syncthreads();
        if (F.tid < 8) { wgcnt[F.tid] = lcnt[F.tid]; __hip_atomic_fetch_add(cnt + F.tid, (unsigned)lcnt[F.tid], __ATOMIC_RELAXED, __HIP_MEMORY_SCOPE_AGENT); }
    }
}

DEVI void moe_tiles(const unsigned* cnt, int (&ts)[9]) { ts[0] = 0;
#pragma unroll
    for (int e = 0; e < 8; ++e) ts[e + 1] = ts[e] + (int)((__hip_atomic_load(cnt + e, __ATOMIC_RELAXED, __HIP_MEMORY_SCOPE_AGENT) + 255u) >> 8); }
DEVI void phase_moe_scatter(Frame& F, int moe_layer) {
    F.refresh();
    unsigned char* ws = F.ws;
    const unsigned* cnt = (const unsigned*)(ws + WS_CTL) + CW_MOE + moe_layer * 64;
    int ts[9]; moe_tiles(cnt, ts);
    LAS int* wbase = (LAS int*)(F.lds + LDS_X);
    if (F.tid < 8) wbase[F.tid] = 0;
    __syncthreads();
    if (F.tid < (int)blockIdx.x) { const int* wc = (const int*)(ws + WS_CTL) + CW_WGCNT + moe_layer * 2048 + F.tid * 8;
        const u32x4 c0 = *(const u32x4*)wc, c1 = *(const u32x4*)(wc + 4);
#pragma unroll
        for (int e = 0; e < 4; ++e) { __hip_atomic_fetch_add(wbase + e, (int)c0[e], __ATOMIC_RELAXED, __HIP_MEMORY_SCOPE_WORKGROUP); __hip_atomic_fetch_add(wbase + 4 + e, (int)c1[e], __ATOMIC_RELAXED, __HIP_MEMORY_SCOPE_WORKGROUP); } }
    __syncthreads();
    const int* TOKE = (const int*)(ws + WS_ROUTE); const int* TOKR = TOKE + MTOK * 2; int* TOKP = (int*)(ws + WS_ROUTE) + MTOK * 6;
    const bf16_t* HB = (const bf16_t*)(ws + WS_HB); bf16_t* XB = (bf16_t*)(ws + WS_XB);
    const int gw = F.vcu * NWAVES + F.wave, NGW = F.G * NWAVES;
    for (int m = gw; m < MTOK; m += NGW) {
        const u32x4 r0 = *(const u32x4*)(HB + (size_t)m * DM + F.lane * 8), r1 = *(const u32x4*)(HB + (size_t)m * DM + 512 + F.lane * 8);
#pragma unroll
        for (int k = 0; k < 2; ++k) { const int e = TOKE[m * 2 + k], r = TOKR[m * 2 + k];
            int st = 0;
#pragma unroll
            for (int j = 1; j < 8; ++j) st = (e >= j) ? ts[j] : st;
            const int pos = st * 256 + wbase[e] + r;
            *(u32x4*)(XB + (size_t)pos * DM + F.lane * 8) = r0; *(u32x4*)(XB + (size_t)pos * DM + 512 + F.lane * 8) = r1;
            if (F.lane == 0) TOKP[m * 2 + k] = pos; }
    }
}

DEVI void phase_nsa_naive(Frame& F) {
    F.refresh();
    unsigned char* ws = F.ws;
    const bf16_t* Q = (const bf16_t*)(ws + RA_Q); bf16_t* ATT = (bf16_t*)(ws + RA_ATT);
    const bf16_t* KC = (const bf16_t*)(ws + RA_KC); const bf16_t* VC = (const bf16_t*)(ws + RA_VC);
    const bf16_t* KS = (const bf16_t*)(ws + RA_KS); const bf16_t* VS = (const bf16_t*)(ws + RA_VS);
    const bf16_t* KW = (const bf16_t*)(ws + RA_KW); const bf16_t* VW = (const bf16_t*)(ws + RA_VW);
    const float* GT = (const float*)(ws + RA_GATE); const float* CS = (const float*)(ws + WS_CS);
    LAS float* sc = (LAS float*)(F.lds + F.wave * 16384);
    LAS float* qs_ = (LAS float*)(F.lds + LDS_X + F.wave * 2048);
    LAS float* qr_ = qs_ + 256;
    const int lane = F.lane;
    const int gw = F.vcu * NWAVES + F.wave, NGW = F.G * NWAVES;
    for (int u = gw; u < MTOK * A_G; u += NGW) {
        const int bg = u / SEQ, t = u % SEQ, b = bg / A_G, g = bg % A_G; const int tok = b * SEQ + t;
        { const bf16_t* qp = Q + (size_t)tok * DM + g * 256 + lane * 4; const u32x2 w = *(const u32x2*)qp;
          float x[4] = {bflo(w.x), bfhi(w.x), bflo(w.y), bfhi(w.y)};
#pragma unroll
          for (int i = 0; i < 4; ++i) qs_[lane * 4 + i] = x[i];
          LDS_WAIT();
          const int d0 = (lane * 4) & 63;
#pragma unroll
          for (int i = 0; i < 4; ++i) { const int d = d0 + i; float v = x[i];
              if (d < 8) v = x[i] * CS[(size_t)tok * 16 + d] - qs_[lane * 4 + i + 8] * CS[(size_t)tok * 16 + 8 + d];
              else if (d < 16) v = x[i] * CS[(size_t)tok * 16 + d - 8] + qs_[lane * 4 + i - 8] * CS[(size_t)tok * 16 + d];
              qr_[lane * 4 + i] = v; }
          LDS_WAIT(); }
        float oc[4] = {0.f, 0.f, 0.f, 0.f}, os[4] = {0.f, 0.f, 0.f, 0.f}, ow[4] = {0.f, 0.f, 0.f, 0.f};
        const int cur = t >> 6;
        const int nv = t >= 31 ? ((t - 31) >> 4) + 1 : 0;
        float impv[4] = {0.f, 0.f, 0.f, 0.f};
        if (nv > 0) {
            const bf16_t* kc = KC + (size_t)bg * 1024 * 64; const bf16_t* vc = VC + (size_t)bg * 1024 * 64;
            float mx[4] = {-3.0e38f, -3.0e38f, -3.0e38f, -3.0e38f};
            for (int c = 0; c * 64 < nv; ++c) { const int n = c * 64 + lane;
                if (n < nv) { float s[4] = {0.f, 0.f, 0.f, 0.f}; LAS float* qs = qs_; asm volatile("" : "+v"(qs));
#pragma unroll 2
                    for (int d8 = 0; d8 < 8; ++d8) { const u32x4 w = *(const u32x4*)(kc + (size_t)n * 64 + d8 * 8);
                        const float kf[8] = {bflo(w.x), bfhi(w.x), bflo(w.y), bfhi(w.y), bflo(w.z), bfhi(w.z), bflo(w.w), bfhi(w.w)};
#pragma unroll
                        for (int r = 0; r < 4; ++r) { const f32x4 qa = *(const LAS f32x4*)(qs + r * 64 + d8 * 8), qb = *(const LAS f32x4*)(qs + r * 64 + d8 * 8 + 4);
                            s[r] += qa.x * kf[0] + qa.y * kf[1] + qa.z * kf[2] + qa.w * kf[3] + qb.x * kf[4] + qb.y * kf[5] + qb.z * kf[6] + qb.w * kf[7]; } }
#pragma unroll
                    for (int r = 0; r < 4; ++r) { s[r] *= QSCALE; mx[r] = fmaxf(mx[r], s[r]); }
                    *(LAS f32x4*)(sc + n * 4) = (f32x4){s[0], s[1], s[2], s[3]}; } }
            float l[4] = {0.f, 0.f, 0.f, 0.f};
#pragma unroll
            for (int r = 0; r < 4; ++r) mx[r] = wave_max(mx[r], lane);
            LDS_WAIT();
            for (int c = 0; c * 64 < nv; ++c) { const int n = c * 64 + lane;
                if (n < nv) { f32x4 s = *(const LAS f32x4*)(sc + n * 4);
#pragma unroll
                    for (int r = 0; r < 4; ++r) { s[r] = __expf(s[r] - mx[r]); l[r] += s[r]; }
                    *(LAS f32x4*)(sc + n * 4) = s; } }
#pragma unroll
            for (int r = 0; r < 4; ++r) l[r] = 1.f / wave_sum(l[r], lane);
            LDS_WAIT();
            for (int c = 0; c * 64 < nv; ++c) { const int n = c * 64 + lane;
                if (n < nv) { f32x4 s = *(const LAS f32x4*)(sc + n * 4);
#pragma unroll
                    for (int r = 0; r < 4; ++r) s[r] *= l[r];
                    *(LAS f32x4*)(sc + n * 4) = s; } }
            LDS_WAIT();
#pragma unroll 4
            for (int n = 0; n < nv; ++n) { const float v = bf2f(vc[(size_t)n * 64 + lane]); const f32x4 p = *(const LAS f32x4*)(sc + n * 4);
#pragma unroll
                for (int r = 0; r < 4; ++r) oc[r] += p[r] * v; }
#pragma unroll
            for (int i = 0; i < 4; ++i) { const int j = lane + 64 * i; float acc = 0.f;
#pragma unroll
                for (int k = -1; k <= 3; ++k) { const int n = 4 * j + k; if (n >= 0 && n < nv) { const f32x4 p = *(const LAS f32x4*)(sc + n * 4); const float ps = (p.x + p.y) + (p.z + p.w); acc += (k == -1 || k == 3) ? 0.5f * ps : ps; } }
                impv[i] = acc; }
        }
        float scv[4];
#pragma unroll
        for (int i = 0; i < 4; ++i) { const int j = lane + 64 * i; scv[i] = j > cur ? -1.f : ((j == 0 || j == cur || j == cur - 1) ? 1e9f : impv[i]); }
        LAS int* sel = (LAS int*)(F.lds + MISC_OFF + 256) + F.wave * 16;
#pragma unroll 1
        for (int k = 0; k < NSEL; ++k) {
            float bv = -2.f; int bi = 1 << 20;
#pragma unroll
            for (int i = 0; i < 4; ++i) { const int j = lane + 64 * i; if (scv[i] > bv) { bv = scv[i]; bi = j; } }
#pragma unroll
            for (int o = 1; o < 64; o <<= 1) { const float ov = shx(bv, o, lane); const int oi = shxi(bi, o, lane); if (ov > bv || (ov == bv && oi < bi)) { bv = ov; bi = oi; } }
            if (lane == 0) sel[k] = bi;
#pragma unroll
            for (int i = 0; i < 4; ++i) if (lane + 64 * i == bi) scv[i] = -3.f;
        }
        LDS_WAIT();
        {   const bf16_t* ks = KS + (size_t)bg * SEQ * 64; const bf16_t* vs = VS + (size_t)bg * SEQ * 64;
            float mx[4] = {-3.0e38f, -3.0e38f, -3.0e38f, -3.0e38f};
#pragma unroll 1
            for (int k = 0; k < NSEL; ++k) { const int pos = sel[k] * 64 + lane; const bool ok = pos <= t;
                float s[4] = {-1e30f, -1e30f, -1e30f, -1e30f};
                if (ok) { LAS float* qr = qr_; asm volatile("" : "+v"(qr));
#pragma unroll
                    for (int r = 0; r < 4; ++r) s[r] = 0.f;
#pragma unroll 2
                    for (int d8 = 0; d8 < 8; ++d8) { const u32x4 w = *(const u32x4*)(ks + (size_t)pos * 64 + d8 * 8);
                        const float kf[8] = {bflo(w.x), bfhi(w.x), bflo(w.y), bfhi(w.y), bflo(w.z), bfhi(w.z), bflo(w.w), bfhi(w.w)};
#pragma unroll
                        for (int r = 0; r < 4; ++r) { const f32x4 qa = *(const LAS f32x4*)(qr + r * 64 + d8 * 8), qb = *(const LAS f32x4*)(qr + r * 64 + d8 * 8 + 4);
                            s[r] += qa.x * kf[0] + qa.y * kf[1] + qa.z * kf[2] + qa.w * kf[3] + qb.x * kf[4] + qb.y * kf[5] + qb.z * kf[6] + qb.w * kf[7]; } }
#pragma unroll
                    for (int r = 0; r < 4; ++r) { s[r] *= QSCALE; mx[r] = fmaxf(mx[r], s[r]); } }
                *(LAS f32x4*)(sc + (k * 64 + lane) * 4) = (f32x4){s[0], s[1], s[2], s[3]}; }
            float l[4] = {0.f, 0.f, 0.f, 0.f};
#pragma unroll
            for (int r = 0; r < 4; ++r) mx[r] = wave_max(mx[r], lane);
            LDS_WAIT();
#pragma unroll 1
            for (int k = 0; k < NSEL; ++k) { const int pos = sel[k] * 64 + lane; const bool ok = pos <= t; f32x4 s = *(const LAS f32x4*)(sc + (k * 64 + lane) * 4);
#pragma unroll
                for (int r = 0; r < 4; ++r) { s[r] = ok ? __expf(s[r] - mx[r]) : 0.f; l[r] += s[r]; }
                *(LAS f32x4*)(sc + (k * 64 + lane) * 4) = s; }
#pragma unroll
            for (int r = 0; r < 4; ++r) l[r] = 1.f / wave_sum(l[r], lane);
            LDS_WAIT();
#pragma unroll 1
            for (int k = 0; k < NSEL; ++k) { const int p0 = sel[k] * 64; if (p0 > t) continue;
#pragma unroll 4
                for (int i = 0; i < 64; ++i) { const int pos = p0 + i; if (pos > t) break; const float v = bf2f(vs[(size_t)pos * 64 + lane]); const f32x4 p = *(const LAS f32x4*)(sc + (k * 64 + i) * 4);
#pragma unroll
                    for (int r = 0; r < 4; ++r) os[r] += p[r] * v; } }
#pragma unroll
            for (int r = 0; r < 4; ++r) os[r] *= l[r];
            LDS_WAIT();
        }
        {   const bf16_t* kw = KW + (size_t)bg * SEQ * 64; const bf16_t* vw = VW + (size_t)bg * SEQ * 64;
            float mx[4] = {-3.0e38f, -3.0e38f, -3.0e38f, -3.0e38f};
#pragma unroll 1
            for (int c = 0; c < 8; ++c) { const int pos = t - 511 + c * 64 + lane; const bool ok = pos >= 0;
                float s[4] = {-1e30f, -1e30f, -1e30f, -1e30f};
                if (ok) { LAS float* qr = qr_; asm volatile("" : "+v"(qr));
#pragma unroll
                    for (int r = 0; r < 4; ++r) s[r] = 0.f;
#pragma unroll 2
                    for (int d8 = 0; d8 < 8; ++d8) { const u32x4 w = *(const u32x4*)(kw + (size_t)pos * 64 + d8 * 8);
                        const float kf[8] = {bflo(w.x), bfhi(w.x), bflo(w.y), bfhi(w.y), bflo(w.z), bfhi(w.z), bflo(w.w), bfhi(w.w)};
#pragma unroll
                        for (int r = 0; r < 4; ++r) { const f32x4 qa = *(const LAS f32x4*)(qr + r * 64 + d8 * 8), qb = *(const LAS f32x4*)(qr + r * 64 + d8 * 8 + 4);
                            s[r] += qa.x * kf[0] + qa.y * kf[1] + qa.z * kf[2] + qa.w * kf[3] + qb.x * kf[4] + qb.y * kf[5] + qb.z * kf[6] + qb.w * kf[7]; } }
#pragma unroll
                    for (int r = 0; r < 4; ++r) { s[r] *= QSCALE; mx[r] = fmaxf(mx[r], s[r]); } }
                *(LAS f32x4*)(sc + (c * 64 + lane) * 4) = (f32x4){s[0], s[1], s[2], s[3]}; }
            float l[4] = {0.f, 0.f, 0.f, 0.f};
#pragma unroll
            for (int r = 0; r < 4; ++r) mx[r] = wave_max(mx[r], lane);
            LDS_WAIT();
#pragma unroll 1
            for (int c = 0; c < 8; ++c) { const int pos = t - 511 + c * 64 + lane; const bool ok = pos >= 0; f32x4 s = *(const LAS f32x4*)(sc + (c * 64 + lane) * 4);
#pragma unroll
                for (int r = 0; r < 4; ++r) { s[r] = ok ? __expf(s[r] - mx[r]) : 0.f; l[r] += s[r]; }
                *(LAS f32x4*)(sc + (c * 64 + lane) * 4) = s; }
#pragma unroll
            for (int r = 0; r < 4; ++r) l[r] = 1.f / wave_sum(l[r], lane);
            LDS_WAIT();
#pragma unroll 4
            for (int i = (t >= 511 ? 0 : 511 - t); i < 512; ++i) { const int pos = t - 511 + i; const float v = bf2f(vw[(size_t)pos * 64 + lane]); const f32x4 p = *(const LAS f32x4*)(sc + i * 4);
#pragma unroll
                for (int r = 0; r < 4; ++r) ow[r] += p[r] * v; }
#pragma unroll
            for (int r = 0; r < 4; ++r) ow[r] *= l[r];
            LDS_WAIT();
        }
#pragma unroll
        for (int r = 0; r < 4; ++r) { const float gc = GT[(size_t)tok * 48 + 0 * 16 + g * 4 + r], gs = GT[(size_t)tok * 48 + 1 * 16 + g * 4 + r], gwv = GT[(size_t)tok * 48 + 2 * 16 + g * 4 + r];
            const float o = ((DBG_DROP & 1) ? 0.f : gc * oc[r]) + ((DBG_DROP & 2) ? 0.f : gs * os[r]) + ((DBG_DROP & 4) ? 0.f : gwv * ow[r]);
            ATT[(size_t)tok * DM + g * 256 + r * 64 + lane] = (bf16_t)f2bf(o); }
    }
}

DEVI void phase_swa_naive(Frame& F, const float* sinks) {
    F.refresh();
    unsigned char* ws = F.ws;
    const bf16_t* Q = (const bf16_t*)(ws + RA_Q); bf16_t* ATT = (bf16_t*)(ws + RA_ATT);
    const bf16_t* KS = (const bf16_t*)(ws + WS_KSH); const bf16_t* VS = (const bf16_t*)(ws + WS_VSH);
    LAS float* sc = (LAS float*)(F.lds + F.wave * 16384);
    LAS float* qs_ = (LAS float*)(F.lds + LDS_X + F.wave * 2048);
    const int lane = F.lane;
    const int gw = F.vcu * NWAVES + F.wave, NGW = F.G * NWAVES;
    for (int u = gw; u < MTOK * B_G; u += NGW) {
        const int bg = u / SEQ, t = u % SEQ, b = bg / B_G, g = bg % B_G; const int tok = b * SEQ + t;
        { const u32x4 w = *(const u32x4*)(Q + (size_t)tok * DM + g * 512 + lane * 8);
          const float x[8] = {bflo(w.x), bfhi(w.x), bflo(w.y), bfhi(w.y), bflo(w.z), bfhi(w.z), bflo(w.w), bfhi(w.w)};
#pragma unroll
          for (int i = 0; i < 8; ++i) qs_[lane * 8 + i] = x[i];
          LDS_WAIT(); }
        const bf16_t* kp = KS + (size_t)bg * SEQ * 64; const bf16_t* vp = VS + (size_t)bg * SEQ * 64;
        float mx[8], l[8], o[8];
#pragma unroll
        for (int r = 0; r < 8; ++r) { mx[r] = sinks[g * 8 + r]; l[r] = 0.f; o[r] = 0.f; }
#pragma unroll 1
        for (int c = 0; c < 2; ++c) { const int pos = t - 127 + c * 64 + lane; const bool ok = pos >= 0;
            float s[8];
#pragma unroll
            for (int r = 0; r < 8; ++r) s[r] = -1e30f;
            if (ok) { LAS float* qs = qs_; asm volatile("" : "+v"(qs));
#pragma unroll
                for (int r = 0; r < 8; ++r) s[r] = 0.f;
#pragma unroll 1
                for (int d8 = 0; d8 < 8; ++d8) { const u32x4 w = *(const u32x4*)(kp + (size_t)pos * 64 + d8 * 8);
                    const float kf[8] = {bflo(w.x), bfhi(w.x), bflo(w.y), bfhi(w.y), bflo(w.z), bfhi(w.z), bflo(w.w), bfhi(w.w)};
#pragma unroll
                    for (int r = 0; r < 8; ++r) { const f32x4 qa = *(const LAS f32x4*)(qs + r * 64 + d8 * 8), qb = *(const LAS f32x4*)(qs + r * 64 + d8 * 8 + 4);
                        s[r] += qa.x * kf[0] + qa.y * kf[1] + qa.z * kf[2] + qa.w * kf[3] + qb.x * kf[4] + qb.y * kf[5] + qb.z * kf[6] + qb.w * kf[7]; } }
#pragma unroll
                for (int r = 0; r < 8; ++r) { s[r] *= QSCALE; mx[r] = fmaxf(mx[r], s[r]); } }
            *(LAS f32x4*)(sc + (c * 64 + lane) * 8) = (f32x4){s[0], s[1], s[2], s[3]}; *(LAS f32x4*)(sc + (c * 64 + lane) * 8 + 4) = (f32x4){s[4], s[5], s[6], s[7]}; }
#pragma unroll
        for (int r = 0; r < 8; ++r) mx[r] = wave_max(mx[r], lane);
        LDS_WAIT();
#pragma unroll
        for (int c = 0; c < 2; ++c) { const int pos = t - 127 + c * 64 + lane; const bool ok = pos >= 0;
            f32x4 s0 = *(const LAS f32x4*)(sc + (c * 64 + lane) * 8), s1 = *(const LAS f32x4*)(sc + (c * 64 + lane) * 8 + 4);
#pragma unroll
            for (int r = 0; r < 4; ++r) { s0[r] = ok ? __expf(s0[r] - mx[r]) : 0.f; l[r] += s0[r]; s1[r] = ok ? __expf(s1[r] - mx[r + 4]) : 0.f; l[r + 4] += s1[r]; }
            *(LAS f32x4*)(sc + (c * 64 + lane) * 8) = s0; *(LAS f32x4*)(sc + (c * 64 + lane) * 8 + 4) = s1; }
#pragma unroll
        for (int r = 0; r < 8; ++r) l[r] = 1.f / (wave_sum(l[r], lane) + __expf(sinks[g * 8 + r] - mx[r]));
        LDS_WAIT();
#pragma unroll 4
        for (int i = (t >= 127 ? 0 : 127 - t); i < 128; ++i) { const int pos = t - 127 + i; const float v = bf2f(vp[(size_t)pos * 64 + lane]);
            const f32x4 p0 = *(const LAS f32x4*)(sc + i * 8), p1 = *(const LAS f32x4*)(sc + i * 8 + 4);
#pragma unroll
            for (int r = 0; r < 4; ++r) { o[r] += p0[r] * v; o[r + 4] += p1[r] * v; } }
#pragma unroll
        for (int r = 0; r < 8; ++r) ATT[(size_t)tok * DM + g * 512 + r * 64 + lane] = (bf16_t)f2bf(o[r] * l[r]);
        LDS_WAIT();
    }
}

namespace fa {
typedef short v4i16_t __attribute__((ext_vector_type(4)));
constexpr float CEXP = 0.125f * 1.4426950408889634f;
constexpr float NEGINF = -__builtin_huge_valf();
constexpr int VLD = 160;
constexpr int KVB = 8192 + 64 * VLD;
constexpr int L_KV = 0;
constexpr int L_IMP = 2 * KVB;
constexpr int IMP_LD = 264;
constexpr int OS_LD = 65;
constexpr int L_Q = L_IMP + 64 * IMP_LD * 4;
constexpr int L_ML = L_Q + 32768;
constexpr int L_MASK = L_ML + 2048;
constexpr int L_LIST = L_MASK + 2048;
constexpr int L_TOK = L_LIST + 1056;
constexpr int L_END = L_TOK + 2048;
static_assert(256 * OS_LD * 4 <= 64 * IMP_LD * 4, "accumulator fits the importance table");
static_assert(L_END <= MISC_OFF, "attention LDS map");

struct Stage { u32x4 k, v; };
template <bool WITHV> DEVI void stage_load(Stage& s, const bf16_t* K, const bf16_t* V, int tid) { s.k = *(const u32x4*)((const char*)K + tid * 16); if (WITHV) s.v = *(const u32x4*)((const char*)V + tid * 16); }
template <bool WITHV> DEVI void stage_write(const Stage& s, LAS unsigned char* buf, int tid) {
    const int r = tid >> 3, c = tid & 7;
    *(LAS u32x4*)(buf + r * 128 + ((c ^ (r & 7)) << 4)) = s.k;
    if (WITHV) *(LAS u32x4*)(buf + 8192 + r * VLD + (c << 4)) = s.v;
}
DEVI float max_quads(float x) {
    auto a = __builtin_amdgcn_permlane16_swap(__float_as_uint(x), __float_as_uint(x), false, false); x = fmaxf(__uint_as_float(a[0]), __uint_as_float(a[1]));
    auto b = __builtin_amdgcn_permlane32_swap(__float_as_uint(x), __float_as_uint(x), false, false); return fmaxf(__uint_as_float(b[0]), __uint_as_float(b[1]));
}
DEVI float sum_quads(float x) {
    auto a = __builtin_amdgcn_permlane16_swap(__float_as_uint(x), __float_as_uint(x), false, false); x = __uint_as_float(a[0]) + __uint_as_float(a[1]);
    auto b = __builtin_amdgcn_permlane32_swap(__float_as_uint(x), __float_as_uint(x), false, false); return __uint_as_float(b[0]) + __uint_as_float(b[1]);
}
template <int CTRL> DEVI float dppf(float v) { return __int_as_float(__builtin_amdgcn_update_dpp(0, __float_as_int(v), CTRL, 0xF, 0xF, false)); }
template <int CTRL> DEVI int dppi(int v) { return __builtin_amdgcn_update_dpp(0, v, CTRL, 0xF, 0xF, false); }
DEVI float bperm(float v, int src_lane) { return __builtin_bit_cast(float, __builtin_amdgcn_ds_bpermute(src_lane << 2, __builtin_bit_cast(int, v))); }
#define DPP_X1 0xB1
#define DPP_X2 0x4E
#define DPP_HM 0x141

DEVI void qk_slot(LAS const unsigned char* kb, const bf16x8 q0, const bf16x8 q1, int lane, f32x4 (&s)[4]) {
    const int l15 = lane & 15, quad = lane >> 4;
    LAS const unsigned char* p0 = kb + l15 * 128 + (((quad) ^ (l15 & 7)) << 4);
    LAS const unsigned char* p1 = kb + l15 * 128 + (((4 + quad) ^ (l15 & 7)) << 4);
#pragma unroll
    for (int kg = 0; kg < 4; ++kg) {
        const bf16x8 a0 = *(LAS const bf16x8*)(p0 + kg * 2048), a1 = *(LAS const bf16x8*)(p1 + kg * 2048);
        f32x4 z = {0.f, 0.f, 0.f, 0.f};
        z = __builtin_amdgcn_mfma_f32_16x16x32_bf16(a0, q0, z, 0, 0, 0);
        s[kg] = __builtin_amdgcn_mfma_f32_16x16x32_bf16(a1, q1, z, 0, 0, 0);
    }
}
DEVI float mask_max(f32x4 (&s)[4], int lo, int hi, int quad) {
    float mx = NEGINF; const int loq = lo - 4 * quad, hiq = hi - 4 * quad;
#pragma unroll
    for (int kg = 0; kg < 4; ++kg)
#pragma unroll
        for (int i = 0; i < 4; ++i) { const bool ok = (16 * kg + i >= loq) & (16 * kg + i <= hiq); s[kg][i] = ok ? s[kg][i] : NEGINF; mx = fmaxf(mx, s[kg][i]); }
    return max_quads(mx);
}
DEVI bf16x8 pack_p(const f32x4 a, const f32x4 b) { u32x4 w; w.x = pg8::cvt_pk_bf16(a[0], a[1]); w.y = pg8::cvt_pk_bf16(a[2], a[3]); w.z = pg8::cvt_pk_bf16(b[0], b[1]); w.w = pg8::cvt_pk_bf16(b[2], b[3]); return __builtin_bit_cast(bf16x8, w); }
DEVI void pv_slot(LAS const unsigned char* vb, const bf16x8 (&pb)[2], f32x4 (&o)[4], int lane) {
    const int i = lane & 15, quad = lane >> 4;
    LAS const unsigned char* a0 = vb + (4 * quad + (i >> 2)) * VLD + ((i & 3) << 3);
#pragma unroll
    for (int ks2 = 0; ks2 < 2; ++ks2) {
#pragma unroll
        for (int dg = 0; dg < 4; ++dg) {
            const v4i16_t t0 = __builtin_amdgcn_ds_read_tr16_b64_v4i16((LAS v4i16_t*)(a0 + (32 * ks2) * VLD + 32 * dg));
            const v4i16_t t1 = __builtin_amdgcn_ds_read_tr16_b64_v4i16((LAS v4i16_t*)(a0 + (32 * ks2 + 16) * VLD + 32 * dg));
            const bf16x8 a = {t0[0], t0[1], t0[2], t0[3], t1[0], t1[1], t1[2], t1[3]};
            o[dg] = __builtin_amdgcn_mfma_f32_16x16x32_bf16(a, pb[ks2], o[dg], 0, 0, 0);
        }
    }
}
template <bool PV> DEVI void online_step(LAS const unsigned char* buf, const bf16x8 q0, const bf16x8 q1, int lo, int hi, float& m, float& l, f32x4 (&o)[4], int lane) {
    __builtin_amdgcn_sched_barrier(0);
    f32x4 s[4]; qk_slot(buf, q0, q1, lane, s);
    __builtin_amdgcn_sched_barrier(0);
    const int quad = lane >> 4;
    float mx;
    if (__builtin_amdgcn_ballot_w64((lo > 0) | (hi < 63)) != 0ull) mx = mask_max(s, lo, hi, quad);
    else { float a = fmaxf(fmaxf(s[0][0], s[0][1]), fmaxf(s[0][2], s[0][3])), b = fmaxf(fmaxf(s[1][0], s[1][1]), fmaxf(s[1][2], s[1][3]));
           a = fmaxf(a, fmaxf(fmaxf(s[2][0], s[2][1]), fmaxf(s[2][2], s[2][3]))); b = fmaxf(b, fmaxf(fmaxf(s[3][0], s[3][1]), fmaxf(s[3][2], s[3][3]))); mx = max_quads(fmaxf(a, b)); }
    const float mnew = fmaxf(m, mx);
    const float msafe = (mnew == NEGINF) ? 0.f : mnew;
    const float alpha = __builtin_amdgcn_exp2f((m - msafe) * CEXP);
    const float mc = -msafe * CEXP;
    float ps = 0.f;
#pragma unroll
    for (int kg = 0; kg < 4; ++kg)
#pragma unroll
        for (int i = 0; i < 4; ++i) { s[kg][i] = __builtin_amdgcn_exp2f(__builtin_fmaf(s[kg][i], CEXP, mc)); ps += s[kg][i]; }
    l = l * alpha + ps; m = mnew;
    if (PV) {
        if (__builtin_amdgcn_ballot_w64(alpha != 1.f) != 0ull) {
#pragma unroll
            for (int dg = 0; dg < 4; ++dg) o[dg] = o[dg] * alpha;
        }
        bf16x8 pb[2]; pb[0] = pack_p(s[0], s[1]); pb[1] = pack_p(s[2], s[3]);
        pv_slot(buf + 8192, pb, o, lane);
    }
    __builtin_amdgcn_sched_barrier(0);
}
DEVI void load_q(const bf16_t* Q, size_t tok, int hcol, int quad, bf16x8 (&qf)[2]) {
    const bf16_t* p = Q + tok * DM + hcol + quad * 8;
    qf[0] = *(const bf16x8*)p; qf[1] = *(const bf16x8*)(p + 32);
}
DEVI bf16x8 rope_frag(const bf16x8 q, const float* csrow, int quad, int lane) {
    const u32x4 w = __builtin_bit_cast(u32x4, q); u32x4 pw;
#pragma unroll
    for (int i = 0; i < 4; ++i) pw[i] = (unsigned)shxi((int)w[i], 16, lane);
    if (quad >= 2) return q;
    const f32x4 c0 = *(const f32x4*)csrow, c1 = *(const f32x4*)(csrow + 4), s0 = *(const f32x4*)(csrow + 8), s1 = *(const f32x4*)(csrow + 12);
    const float sg = quad == 0 ? -1.f : 1.f;
    float x[8], xp[8];
#pragma unroll
    for (int i = 0; i < 4; ++i) { x[2 * i] = bflo(w[i]); x[2 * i + 1] = bfhi(w[i]); xp[2 * i] = bflo(pw[i]); xp[2 * i + 1] = bfhi(pw[i]); }
    const float cc[8] = {c0[0], c0[1], c0[2], c0[3], c1[0], c1[1], c1[2], c1[3]}, ss[8] = {s0[0], s0[1], s0[2], s0[3], s1[0], s1[1], s1[2], s1[3]};
    u32x4 o;
#pragma unroll
    for (int i = 0; i < 4; ++i) o[i] = pg8::cvt_pk_bf16(x[2 * i] * cc[2 * i] + sg * xp[2 * i] * ss[2 * i], x[2 * i + 1] * cc[2 * i + 1] + sg * xp[2 * i + 1] * ss[2 * i + 1]);
    return __builtin_bit_cast(bf16x8, o);
}

struct KFr { bf16x8 k[4][2]; };
struct VFr { bf16x8 v[4][2]; };
constexpr float LSCALE = 1048576.f;
template <int OFF> DEVI void gld16(bf16x8& d, const void* p) { asm volatile("global_load_dwordx4 %0, %1, off offset:%2" : "=v"(d) : "v"(p), "n"(OFF) : "memory"); }
DEVI void sel_load_k(KFr& f, const bf16_t* KS, int j, int lane) {
    const int l15 = lane & 15, quad = lane >> 4;
    const bf16_t* p0 = KS + ((size_t)(64 * j + l15)) * 64 + 8 * quad;
    const bf16_t* p1 = p0 + 32 * 64;
    gld16<0>(f.k[0][0], p0); gld16<64>(f.k[0][1], p0); gld16<2048>(f.k[1][0], p0); gld16<2112>(f.k[1][1], p0);
    gld16<0>(f.k[2][0], p1); gld16<64>(f.k[2][1], p1); gld16<2048>(f.k[3][0], p1); gld16<2112>(f.k[3][1], p1);
}
DEVI void sel_load_v(VFr& f, const bf16_t* VT, int j, int lane) {
    const int l15 = lane & 15, quad = lane >> 4;
    const bf16_t* p = VT + (size_t)j * 4096 + l15 * 64 + 8 * quad;
    gld16<0>(f.v[0][0], p); gld16<64>(f.v[0][1], p); gld16<2048>(f.v[1][0], p); gld16<2112>(f.v[1][1], p);
    const bf16_t* p1 = p + 32 * 64;
    gld16<0>(f.v[2][0], p1); gld16<64>(f.v[2][1], p1); gld16<2048>(f.v[3][0], p1); gld16<2112>(f.v[3][1], p1);
}
template <int N> DEVI void sel_wait_k(KFr& f) {
    asm volatile("s_waitcnt vmcnt(%8)" : "+v"(f.k[0][0]), "+v"(f.k[0][1]), "+v"(f.k[1][0]), "+v"(f.k[1][1]), "+v"(f.k[2][0]), "+v"(f.k[2][1]), "+v"(f.k[3][0]), "+v"(f.k[3][1]) : "n"(N) : "memory");
    __builtin_amdgcn_sched_barrier(0);
}
template <int N> DEVI void sel_wait_kv(KFr& f, VFr& g) {
    asm volatile("s_waitcnt vmcnt(%16)" : "+v"(f.k[0][0]), "+v"(f.k[0][1]), "+v"(f.k[1][0]), "+v"(f.k[1][1]), "+v"(f.k[2][0]), "+v"(f.k[2][1]), "+v"(f.k[3][0]), "+v"(f.k[3][1]),
                 "+v"(g.v[0][0]), "+v"(g.v[0][1]), "+v"(g.v[1][0]), "+v"(g.v[1][1]), "+v"(g.v[2][0]), "+v"(g.v[2][1]), "+v"(g.v[3][0]), "+v"(g.v[3][1]) : "n"(N) : "memory");
    __builtin_amdgcn_sched_barrier(0);
}
template <bool PASS2> DEVI void sel_block(const KFr& f, const VFr& fv, int j, bool active, int cur, LAS const unsigned* smask, LAS const unsigned char* Ql, LAS float* mrow, LAS int* lrow, LAS int* Os, float lg2k, float lratio, LAS int* tlist, int lane) {
    const int l15 = lane & 15, quad = lane >> 4, mem = l15 >> 2;
    const bool forced = (j == 0) || (j >= cur - 1);
    int cnt = 0;
    if (active) {
        if (forced) cnt = 64;
        else { const unsigned lo = (unsigned)__builtin_amdgcn_readfirstlane((int)smask[2 * j]), hi = (unsigned)__builtin_amdgcn_readfirstlane((int)smask[2 * j + 1]);
            const unsigned long long mk = ((unsigned long long)hi << 32) | lo;
            cnt = __builtin_popcountll(mk);
            const bool mine = (mk >> lane) & 1ull; const int rank = __builtin_popcountll(mk & ((1ull << lane) - 1ull));
            if (mine) tlist[rank] = lane;
            LDS_WAIT(); }
    }
    const int ngroups = (cnt + 3) >> 2;
    const bool diag = (j == cur);
#pragma unroll 1
    for (int gi = 0; gi < ngroups; ++gi) {
        const int slot = 4 * gi + mem;
        const bool valid = slot < cnt;
        int mt = forced ? slot : tlist[slot];
        mt = valid ? mt : 0;
        const int row = mt * 4 + (l15 & 3);
        const bf16x8 q0 = *(LAS const bf16x8*)(Ql + row * 128 + ((quad ^ (row & 7)) << 4));
        const bf16x8 q1 = *(LAS const bf16x8*)(Ql + row * 128 + (((4 + quad) ^ (row & 7)) << 4));
        f32x4 sc[4];
#pragma unroll
        for (int kg = 0; kg < 4; ++kg) { f32x4 z = {0.f, 0.f, 0.f, 0.f}; z = __builtin_amdgcn_mfma_f32_16x16x32_bf16(f.k[kg][0], q0, z, 0, 0, 0); sc[kg] = __builtin_amdgcn_mfma_f32_16x16x32_bf16(f.k[kg][1], q1, z, 0, 0, 0); }
        if (!PASS2) {
            float mx;
            if (diag) mx = mask_max(sc, 0, mt, quad);
            else { float a = fmaxf(fmaxf(sc[0][0], sc[0][1]), fmaxf(sc[0][2], sc[0][3])), b = fmaxf(fmaxf(sc[1][0], sc[1][1]), fmaxf(sc[1][2], sc[1][3]));
                   a = fmaxf(a, fmaxf(fmaxf(sc[2][0], sc[2][1]), fmaxf(sc[2][2], sc[2][3]))); b = fmaxf(b, fmaxf(fmaxf(sc[3][0], sc[3][1]), fmaxf(sc[3][2], sc[3][3]))); mx = max_quads(fmaxf(a, b)); }
            if (quad == 0 && valid) __hip_atomic_fetch_max(mrow + row, mx, __ATOMIC_RELAXED, __HIP_MEMORY_SCOPE_WORKGROUP);
        } else {
            const float mc = lg2k - mrow[row] * CEXP;
            float ps = 0.f;
            if (diag) { const int hiq = mt - 4 * quad;
#pragma unroll
                for (int kg = 0; kg < 4; ++kg)
#pragma unroll
                    for (int i = 0; i < 4; ++i) { sc[kg][i] = (16 * kg + i <= hiq) ? __builtin_amdgcn_exp2f(__builtin_fmaf(sc[kg][i], CEXP, mc)) : 0.f; ps += sc[kg][i]; }
            } else {
#pragma unroll
                for (int kg = 0; kg < 4; ++kg)
#pragma unroll
                    for (int i = 0; i < 4; ++i) { sc[kg][i] = __builtin_amdgcn_exp2f(__builtin_fmaf(sc[kg][i], CEXP, mc)); ps += sc[kg][i]; }
            }
            ps = sum_quads(ps);
            if (quad == 0 && valid) __hip_atomic_fetch_add(lrow + row, (int)(ps * lratio), __ATOMIC_RELAXED, __HIP_MEMORY_SCOPE_WORKGROUP);
            bf16x8 pb[2]; pb[0] = pack_p(sc[0], sc[1]); pb[1] = pack_p(sc[2], sc[3]);
            LAS int* orow = Os + row * OS_LD + 4 * quad;
#pragma unroll
            for (int dh = 0; dh < 2; ++dh) {
                f32x4 o[2];
#pragma unroll
                for (int d2 = 0; d2 < 2; ++d2) { const int dg = dh * 2 + d2; f32x4 z = {0.f, 0.f, 0.f, 0.f}; z = __builtin_amdgcn_mfma_f32_16x16x32_bf16(fv.v[dg][0], pb[0], z, 0, 0, 0); o[d2] = __builtin_amdgcn_mfma_f32_16x16x32_bf16(fv.v[dg][1], pb[1], z, 0, 0, 0); }
                if (valid) {
#pragma unroll
                    for (int d2 = 0; d2 < 2; ++d2)
#pragma unroll
                        for (int c = 0; c < 4; ++c) __hip_atomic_fetch_add(orow + 16 * (dh * 2 + d2) + c, (int)o[d2][c], __ATOMIC_RELAXED, __HIP_MEMORY_SCOPE_WORKGROUP);
                }
                __builtin_amdgcn_sched_barrier(0);
            }
        }
    }
}
#define BL(i) __builtin_amdgcn_readfirstlane(blist[(i) < nb ? (i) : nb - 1])
DEVI void sel_pass1(const bf16_t* KS, int nb, int cur, int wave, LAS const int* blist, LAS const unsigned* smask, LAS const unsigned char* Ql, LAS float* mrow, LAS int* tlist, int lane) {
    if (wave >= nb) return;
    KFr k0, k1, k2; VFr vdummy;
    asm volatile("s_waitcnt vmcnt(0)" ::: "memory");
    sel_load_k(k0, KS, BL(wave), lane);
    sel_load_k(k1, KS, BL(wave + 8), lane);
#pragma unroll 1
    for (int bi = wave; bi < nb; bi += 24) {
        sel_load_k(k2, KS, BL(bi + 16), lane); sel_wait_k<16>(k0);
        sel_block<false>(k0, vdummy, BL(bi), true, cur, smask, Ql, mrow, nullptr, nullptr, 0.f, 0.f, tlist, lane);
        sel_load_k(k0, KS, BL(bi + 24), lane); sel_wait_k<16>(k1);
        sel_block<false>(k1, vdummy, BL(bi + 8), bi + 8 < nb, cur, smask, Ql, mrow, nullptr, nullptr, 0.f, 0.f, tlist, lane);
        sel_load_k(k1, KS, BL(bi + 32), lane); sel_wait_k<16>(k2);
        sel_block<false>(k2, vdummy, BL(bi + 16), bi + 16 < nb, cur, smask, Ql, mrow, nullptr, nullptr, 0.f, 0.f, tlist, lane);
    }
    asm volatile("s_waitcnt vmcnt(0)" ::: "memory");
}
DEVI void sel_pass2(const bf16_t* KS, const bf16_t* VT, int nb, int cur, int wave, LAS const int* blist, LAS const unsigned* smask, LAS const unsigned char* Ql, LAS float* mrow, LAS int* lrow, LAS int* Os, float lg2k, float lratio, LAS int* tlist, int lane) {
    if (wave >= nb) return;
    KFr ka_, kb_; VFr va_, vb_;
    asm volatile("s_waitcnt vmcnt(0)" ::: "memory");
    sel_load_k(ka_, KS, BL(wave), lane); sel_load_v(va_, VT, BL(wave), lane);
#pragma unroll 1
    for (int bi = wave; bi < nb; bi += 16) {
        sel_load_k(kb_, KS, BL(bi + 8), lane); sel_load_v(vb_, VT, BL(bi + 8), lane); sel_wait_kv<16>(ka_, va_);
        sel_block<true>(ka_, va_, BL(bi), true, cur, smask, Ql, mrow, lrow, Os, lg2k, lratio, tlist, lane);
        sel_load_k(ka_, KS, BL(bi + 16), lane); sel_load_v(va_, VT, BL(bi + 16), lane); sel_wait_kv<16>(kb_, vb_);
        sel_block<true>(kb_, vb_, BL(bi + 8), bi + 8 < nb, cur, smask, Ql, mrow, lrow, Os, lg2k, lratio, tlist, lane);
    }
    asm volatile("s_waitcnt vmcnt(0)" ::: "memory");
}
#undef BL
}


DEVI void phase_vs_transpose(Frame& F, int l) {
    F.refresh();
    unsigned char* ws = F.ws;
    const bf16_t* VS = (const bf16_t*)(ws + RA_VS); bf16_t* VT = (bf16_t*)(ws + RA_VST); const bf16_t* KSG = (const bf16_t*)(ws + RA_KS);
    LAS unsigned char* T = F.lds + F.wave * 9216;
    const int lane = F.lane, rr = lane >> 3, c = lane & 7, i16 = lane & 15, grp = lane >> 4;
    for (int it = ((int)blockIdx.x - 64) * NWAVES + F.wave; it < 2048; it += 192 * NWAVES) {
        const int bg = it >> 8, tile = it & 255;
        const bf16_t* vsrc = VS + ((size_t)bg * SEQ + tile * 64) * 64; const bf16_t* ksrc = KSG + ((size_t)bg * SEQ + tile * 64) * 64;
        u32x4 v[8], k[8];
#pragma unroll
        for (int i = 0; i < 8; ++i) { v[i] = *(const u32x4*)(vsrc + (size_t)(8 * i + rr) * 64 + c * 8); k[i] = *(const u32x4*)(ksrc + (size_t)(8 * i + rr) * 64 + c * 8); }
        float vmx = 0.f, kmx = 0.f;
#pragma unroll
        for (int i = 0; i < 8; ++i) { float n2 = 0.f;
#pragma unroll
            for (int e = 0; e < 4; ++e) { vmx = fmaxf(vmx, fmaxf(fabsf(bflo(v[i][e])), fabsf(bfhi(v[i][e])))); const float a = bflo(k[i][e]), b2 = bfhi(k[i][e]); n2 += a * a + b2 * b2; }
            n2 += fa::dppf<DPP_X1>(n2); n2 += fa::dppf<DPP_X2>(n2); n2 += fa::dppf<DPP_HM>(n2);
            kmx = fmaxf(kmx, n2);
            *(LAS u32x4*)(T + (8 * i + rr) * 144 + c * 16) = v[i]; }
        vmx = wave_max(vmx, lane); kmx = wave_max(kmx, lane);
        if (lane == 0) { atomicMax((unsigned*)(ws + WS_CTL) + CW_VMAX + l * 8 + bg, __float_as_uint(vmx)); atomicMax((unsigned*)(ws + WS_CTL) + CW_KMAX + l * 8 + bg, __float_as_uint(kmx)); }
        LDS_WAIT(); asm volatile("" ::: "memory");
        bf16_t* vdst = VT + ((size_t)bg * 256 + tile) * 4096;
#pragma unroll
        for (int n = 0; n < 16; ++n) { const int dc = n >> 2, kg4 = (n & 3) * 4 + grp;
            const fa::v4i16_t t = __builtin_amdgcn_ds_read_tr16_b64_v4i16((LAS fa::v4i16_t*)(T + (4 * kg4 + (i16 >> 2)) * 144 + (16 * dc + 4 * (i16 & 3)) * 2));
            const int p0 = 32 * (kg4 >> 3) + 8 * (kg4 & 3) + 4 * ((kg4 >> 2) & 1);
            *(fa::v4i16_t*)(vdst + (16 * dc + i16) * 64 + p0) = t; }
        LDS_WAIT(); asm volatile("" ::: "memory");
    }
}

DEVI void phase_nsa_fast(Frame& F, int layer) {
    using namespace fa;
    F.refresh();
    unsigned char* ws = F.ws;
    const bf16_t* Q = (const bf16_t*)(ws + RA_Q); bf16_t* ATT = (bf16_t*)(ws + RA_ATT);
    const float* GT = (const float*)(ws + RA_GATE); const float* CS = (const float*)(ws + WS_CS);
    const int wave = F.wave;
    LAS unsigned char* kvb = F.lds + L_KV;
    LAS float* imp = (LAS float*)(F.lds + L_IMP);
    LAS unsigned* smask = (LAS unsigned*)(F.lds + L_MASK);
    LAS int* blist = (LAS int*)(F.lds + L_LIST);
#pragma unroll 1
    for (int ui = 0; ui < 8; ++ui) {
        int lane = F.lane; asm volatile("" : "+v"(lane));
        const int tid = wave * 64 + lane, quad = lane >> 4, l15 = lane & 15;
        int tile = (F.vcu & 31) + 32 * (ui >> 1); if (ui & 1) tile = 255 - tile;
        const int bg = F.vcu >> 5, b = bg >> 2, g = bg & 3, cur = tile, t0 = tile * 64;
        const bf16_t* KC = (const bf16_t*)(ws + RA_KC) + (size_t)bg * 1024 * 64; const bf16_t* VC = (const bf16_t*)(ws + RA_VC) + (size_t)bg * 1024 * 64;
        const bf16_t* KS = (const bf16_t*)(ws + RA_KS) + (size_t)bg * SEQ * 64; const bf16_t* VS = (const bf16_t*)(ws + RA_VS) + (size_t)bg * SEQ * 64;
        const bf16_t* KW = (const bf16_t*)(ws + RA_KW) + (size_t)bg * SEQ * 64; const bf16_t* VW = (const bf16_t*)(ws + RA_VW) + (size_t)bg * SEQ * 64;
        smask[tid] = 0u;
        int tl[2], tok[2]; bf16x8 qf[2][2];
#pragma unroll
        for (int s = 0; s < 2; ++s) { tl[s] = 8 * wave + 4 * s + (l15 >> 2); tok[s] = b * SEQ + t0 + tl[s]; load_q(Q, (size_t)tok[s], g * 256 + (l15 & 3) * 64, quad, qf[s]); }
        float gate[2][3];
#pragma unroll
        for (int s = 0; s < 2; ++s)
#pragma unroll
            for (int br = 0; br < 3; ++br) gate[s][br] = GT[(size_t)tok[s] * 48 + br * 16 + g * 4 + (l15 & 3)];
        const float vmax = fmaxf(__uint_as_float(__hip_atomic_load((const unsigned*)(ws + WS_CTL) + CW_VMAX + layer * 8 + bg, __ATOMIC_RELAXED, __HIP_MEMORY_SCOPE_AGENT)), 1e-30f);
        bf16x8 qr[2][2];
#pragma unroll
        for (int s = 0; s < 2; ++s) { qr[s][0] = rope_frag(qf[s][0], CS + (size_t)tok[s] * 16, quad, lane); qr[s][1] = qf[s][1]; }
        f32x4 out[2][4];
#pragma unroll
        for (int s = 0; s < 2; ++s)
#pragma unroll
            for (int dg = 0; dg < 4; ++dg) out[s][dg] = (f32x4){0.f, 0.f, 0.f, 0.f};
        Stage st;
        const int ntile = (4 * cur + 3 + 63) >> 6;
        int nval[2];
#pragma unroll
        for (int s = 0; s < 2; ++s) { const int t = t0 + tl[s]; nval[s] = t >= 31 ? ((t - 31) >> 4) + 1 : 0; }
        float m[2] = {NEGINF, NEGINF}, l[2] = {0.f, 0.f};
        {   stage_load<false>(st, KC, VC, tid); stage_write<false>(st, kvb, tid); __syncthreads();
#pragma unroll 1
            for (int i = 0; i < ntile; ++i) {
                LAS unsigned char* buf = kvb + (i & 1) * KVB;
                if (i + 1 < ntile) stage_load<false>(st, KC + (size_t)(i + 1) * 4096, VC, tid); else stage_load<true>(st, KC, VC, tid);
#pragma unroll
                for (int s = 0; s < 2; ++s) { f32x4 dummy[4]; online_step<false>(buf, qf[s][0], qf[s][1], 0, nval[s] - 64 * i - 1, m[s], l[s], dummy, lane); }
                if (i + 1 < ntile) stage_write<false>(st, kvb + ((i + 1) & 1) * KVB, tid);
                __syncthreads();
            }
        }
        float invl[2], msafe[2];
#pragma unroll
        for (int s = 0; s < 2; ++s) { const float lt = sum_quads(l[s]); invl[s] = lt > 0.f ? 1.f / lt : 0.f; msafe[s] = (m[s] == NEGINF) ? 0.f : m[s]; }
#ifndef NO_P2
        const int jbw0 = cur >= 8 ? cur - 8 : 0;
        {   float gcv[2] = {gate[0][0], gate[1][0]};
            float carry[2] = {0.f, 0.f};
            stage_write<true>(st, kvb, tid); __syncthreads();
#pragma unroll 1
            for (int i = 0; i < ntile; ++i) {
                LAS unsigned char* buf = kvb + (i & 1) * KVB;
                if (i + 1 < ntile) stage_load<true>(st, KC + (size_t)(i + 1) * 4096, VC + (size_t)(i + 1) * 4096, tid); else stage_load<true>(st, KW + (size_t)jbw0 * 4096, VW + (size_t)jbw0 * 4096, tid);
#pragma unroll
                for (int s = 0; s < 2; ++s) {
                    __builtin_amdgcn_sched_barrier(0);
                    f32x4 sc[4]; qk_slot(buf, qf[s][0], qf[s][1], lane, sc);
                    __builtin_amdgcn_sched_barrier(0);
                    const int hiq = nval[s] - 64 * i - 1 - 4 * quad; const float mc2 = -msafe[s] * CEXP;
#pragma unroll
                    for (int kg = 0; kg < 4; ++kg)
#pragma unroll
                        for (int k = 0; k < 4; ++k) sc[kg][k] = (16 * kg + k <= hiq) ? __builtin_amdgcn_exp2f(__builtin_fmaf(sc[kg][k], CEXP, mc2)) * invl[s] : 0.f;
                    bf16x8 pb[2]; pb[0] = pack_p(sc[0] * gcv[s], sc[1] * gcv[s]); pb[1] = pack_p(sc[2] * gcv[s], sc[3] * gcv[s]);
#ifndef NO_IMP
#pragma unroll
                    for (int kg = 0; kg < 4; ++kg) {
                        float a = (sc[kg][0] + sc[kg][1]) + (sc[kg][2] + 0.5f * sc[kg][3]), bq = 0.5f * sc[kg][3];
                        a += dppf<DPP_X1>(a); a += dppf<DPP_X2>(a); bq += dppf<DPP_X1>(bq); bq += dppf<DPP_X2>(bq);
                        const float fromprev = bperm(bq, (lane - 16) & 63);
                        const float add = quad == 0 ? carry[s] : fromprev;
                        carry[s] = bperm(bq, (lane + 48) & 63);
                        if ((l15 & 3) == 0) imp[(8 * wave + 4 * s + (l15 >> 2)) * IMP_LD + 16 * i + 4 * kg + quad] = a + add;
                    }
#endif
                    __builtin_amdgcn_sched_barrier(0);
                    pv_slot(buf + 8192, pb, out[s], lane);
                    __builtin_amdgcn_sched_barrier(0);
                }
                if (i + 1 < ntile) stage_write<true>(st, kvb + ((i + 1) & 1) * KVB, tid);
                __syncthreads();
            }
        }
#endif
#ifndef NO_TOPK
        {   const int tl8 = lane >> 3, chunk = lane & 7, trow = (8 * wave + tl8) * IMP_LD;
            const int ncand = cur - 2;
            const int wsel = ((8 * wave + tl8) >> 5), bsel = (8 * wave + tl8) & 31;
            if (ncand > 0 && ncand <= 13) {
#pragma unroll
                for (int i = 0; i < 2; ++i) { const int j = 8 * i + chunk; if (j >= 1 && j <= cur - 2) __hip_atomic_fetch_or(smask + j * 2 + wsel, 1u << bsel, __ATOMIC_RELAXED, __HIP_MEMORY_SCOPE_WORKGROUP); }
            } else if (ncand > 13) {
                float lv[13]; int li[13];
#pragma unroll
                for (int k = 0; k < 13; ++k) { lv[k] = -1.f; li[k] = 1 << 20; }
                const int imax = (cur - 2) >> 3;
#pragma unroll 1
                for (int i = 0; i <= imax; ++i) {
                    const int j = 8 * i + chunk; float x = (j >= 1 && j <= cur - 2) ? imp[trow + j] : -1.f; int xi = j;
                    if (__builtin_amdgcn_ballot_w64(x > lv[12]) != 0ull) {
#pragma unroll
                        for (int k = 0; k < 13; ++k) { const bool gt = x > lv[k]; const float tv = gt ? lv[k] : x; const int ti = gt ? li[k] : xi; lv[k] = gt ? x : lv[k]; li[k] = gt ? xi : li[k]; x = tv; xi = ti; }
                    }
                }
#pragma unroll 1
                for (int r = 0; r < 13; ++r) {
                    float bv = lv[0]; int bi = li[0];
                    { const float ov = dppf<DPP_X1>(bv); const int oi = dppi<DPP_X1>(bi); if (ov > bv || (ov == bv && oi < bi)) { bv = ov; bi = oi; } }
                    { const float ov = dppf<DPP_X2>(bv); const int oi = dppi<DPP_X2>(bi); if (ov > bv || (ov == bv && oi < bi)) { bv = ov; bi = oi; } }
                    { const float ov = dppf<DPP_HM>(bv); const int oi = dppi<DPP_HM>(bi); if (ov > bv || (ov == bv && oi < bi)) { bv = ov; bi = oi; } }
                    if (li[0] == bi) {
#pragma unroll
                        for (int k = 0; k < 12; ++k) { lv[k] = lv[k + 1]; li[k] = li[k + 1]; }
                        lv[12] = -1.f; li[12] = 1 << 20;
                    }
                    if (chunk == 0 && bv >= 0.f) __hip_atomic_fetch_or(smask + bi * 2 + wsel, 1u << bsel, __ATOMIC_RELAXED, __HIP_MEMORY_SCOPE_WORKGROUP);
                }
            }
        }
#endif
        __syncthreads();
        if (wave == 0) {
            int base = 0;
#pragma unroll 1
            for (int r = 0; r < 4; ++r) { const int j = 64 * r + lane; const bool on = (j <= cur) && (j == 0 || j >= cur - 1 || (smask[j * 2] | smask[j * 2 + 1]) != 0u);
                const unsigned long long bal = __builtin_amdgcn_ballot_w64(on); const int pos = base + __builtin_popcountll(bal & ((1ull << lane) - 1ull));
                if (on) blist[pos] = j; base += __builtin_popcountll(bal); }
            if (lane == 0) blist[259] = base;
        }
        __syncthreads();
        LAS float* stashf = imp + wave * 2048 + lane;
#pragma unroll
        for (int s = 0; s < 2; ++s)
#pragma unroll
            for (int dg = 0; dg < 4; ++dg)
#pragma unroll
                for (int c = 0; c < 4; ++c) stashf[(s * 16 + dg * 4 + c) * 64] = out[s][dg][c];
        {   const int jb0 = jbw0, nb = cur - jb0 + 1;
            f32x4 ob[2][4]; float mm[2] = {NEGINF, NEGINF}, ll[2] = {0.f, 0.f};
#pragma unroll
            for (int s = 0; s < 2; ++s)
#pragma unroll
                for (int dg = 0; dg < 4; ++dg) ob[s][dg] = (f32x4){0.f, 0.f, 0.f, 0.f};
            stage_write<true>(st, kvb, tid); __syncthreads();
#pragma unroll 1
            for (int i = 0; i < nb; ++i) {
                LAS unsigned char* buf = kvb + (i & 1) * KVB;
                const int j = jb0 + i;
                if (i + 1 < nb) stage_load<true>(st, KW + (size_t)(j + 1) * 4096, VW + (size_t)(j + 1) * 4096, tid);
#pragma unroll
                for (int s = 0; s < 2; ++s) {
                    const int lo = (j == cur - 8) ? tl[s] + 1 : 0, hi = (j == cur) ? tl[s] : 63;
                    online_step<true>(buf, qr[s][0], qr[s][1], lo, hi, mm[s], ll[s], ob[s], lane);
                }
                if (i + 1 < nb) stage_write<true>(st, kvb + ((i + 1) & 1) * KVB, tid);
                __syncthreads();
            }
#pragma unroll
            for (int s = 0; s < 2; ++s) { const float lt = sum_quads(ll[s]); const float gw = gate[s][2] * (lt > 0.f ? 1.f / lt : 0.f);
#pragma unroll
                for (int dg = 0; dg < 4; ++dg)
#pragma unroll
                    for (int c = 0; c < 4; ++c) out[s][dg][c] = stashf[(s * 16 + dg * 4 + c) * 64] + ob[s][dg][c] * gw; }
        }
        LAS unsigned* stashb = (LAS unsigned*)(F.lds + L_KV) + wave * 1024 + lane;
        LAS unsigned char* Ql = F.lds + L_Q;
        LAS float* mrow = (LAS float*)(F.lds + L_ML); LAS int* lrow = (LAS int*)(mrow + 256);
        LAS int* Os = (LAS int*)imp;
        const float oscale = 1048576.f / vmax;
#pragma unroll
        for (int s = 0; s < 2; ++s) {
#pragma unroll
            for (int dg = 0; dg < 4; ++dg) { stashb[((s * 4 + dg) * 2 + 0) * 64] = pg8::cvt_pk_bf16(out[s][dg][0], out[s][dg][1]); stashb[((s * 4 + dg) * 2 + 1) * 64] = pg8::cvt_pk_bf16(out[s][dg][2], out[s][dg][3]); }
            const int row = tl[s] * 4 + (l15 & 3);
            *(LAS bf16x8*)(Ql + row * 128 + ((quad ^ (row & 7)) << 4)) = qr[s][0];
            *(LAS bf16x8*)(Ql + row * 128 + (((4 + quad) ^ (row & 7)) << 4)) = qr[s][1];
        }
        __syncthreads();
        for (int i = lane; i < 32 * OS_LD; i += 64) Os[wave * 32 * OS_LD + i] = 0;
        if (lane < 32) lrow[wave * 32 + lane] = 0;
        {
            const float kmax2 = __uint_as_float(__hip_atomic_load((const unsigned*)(ws + WS_CTL) + CW_KMAX + layer * 8 + bg, __ATOMIC_RELAXED, __HIP_MEMORY_SCOPE_AGENT));
#pragma unroll
            for (int s = 0; s < 2; ++s) { float n2 = 0.f;
#pragma unroll
                for (int ks = 0; ks < 2; ++ks) { const u32x4 w = __builtin_bit_cast(u32x4, qr[s][ks]);
#pragma unroll
                    for (int e = 0; e < 4; ++e) { const float a = bflo(w[e]), b2 = bfhi(w[e]); n2 += a * a + b2 * b2; } }
                n2 = sum_quads(n2);
                if (quad == 0) mrow[tl[s] * 4 + (l15 & 3)] = sqrtf(n2 * kmax2) * 1.0001f; } }
        __syncthreads();
        {   const int nb = blist[259];
            int lane2 = lane; asm volatile("" : "+v"(lane2));
            const bf16_t* VT = (const bf16_t*)(ws + RA_VST) + (size_t)bg * 256 * 4096;
            LAS int* tlist = (LAS int*)(F.lds + L_TOK) + wave * 64;
            asm volatile("" : "+v"(lane2));
            sel_pass2(KS, VT, nb, cur, wave, blist, smask, Ql, mrow, lrow, Os, __builtin_amdgcn_logf(oscale), LSCALE / oscale, tlist, lane2);
            __syncthreads();
        }
        asm volatile("" : "+v"(tok[0]), "+v"(tok[1]), "+v"(tl[0]), "+v"(tl[1]));
        const float oinv = vmax * (1.f / 1048576.f);
#pragma unroll
        for (int s = 0; s < 2; ++s) { const int row = tl[s] * 4 + (l15 & 3); const float lt = (float)lrow[row] * (1.f / LSCALE);
            const float gs = gate[s][1] * (lt > 0.f ? 1.f / lt : 0.f) * oinv;
#pragma unroll
            for (int dg = 0; dg < 4; ++dg) { const unsigned w0 = stashb[((s * 4 + dg) * 2 + 0) * 64], w1 = stashb[((s * 4 + dg) * 2 + 1) * 64];
                LAS const int* orow = Os + row * OS_LD + 16 * dg + 4 * quad;
                const float r0 = bflo(w0) + (float)orow[0] * gs, r1 = bfhi(w0) + (float)orow[1] * gs, r2 = bflo(w1) + (float)orow[2] * gs, r3 = bfhi(w1) + (float)orow[3] * gs;
                u32x2 w; w.x = pg8::cvt_pk_bf16(r0, r1); w.y = pg8::cvt_pk_bf16(r2, r3);
                *(u32x2*)(ATT + (size_t)tok[s] * DM + g * 256 + (l15 & 3) * 64 + 16 * dg + 4 * quad) = w; } }
        __syncthreads();
    }
}

DEVI void phase_swa_fast(Frame& F, const float* sinks) {
    using namespace fa;
    F.refresh();
    unsigned char* ws = F.ws;
    const bf16_t* Q = (const bf16_t*)(ws + RA_Q); bf16_t* ATT = (bf16_t*)(ws + RA_ATT);
    const int tid = F.tid, lane = F.lane, wave = F.wave, quad = lane >> 4, l15 = lane & 15;
    LAS unsigned char* kvb = F.lds + L_KV;
#pragma unroll 1
    for (int ui = 0; ui < 8; ++ui) {
        const int bg = ui >> 1, b = bg >> 1, g = bg & 1, t0 = (F.vcu * 2 + (ui & 1)) * 32, cur = t0 >> 6;
        const bf16_t* KS = (const bf16_t*)(ws + WS_KSH) + (size_t)bg * SEQ * 64; const bf16_t* VS = (const bf16_t*)(ws + WS_VSH) + (size_t)bg * SEQ * 64;
        int tq[2]; size_t tok[2]; bf16x8 qf[2][2]; f32x4 o[2][4]; float mm[2], ll[2];
        const float sink_raw = sinks[g * 8 + (l15 & 7)] * 8.0f;
#pragma unroll
        for (int s = 0; s < 2; ++s) { tq[s] = t0 + 4 * wave + 2 * s + (l15 >> 3); tok[s] = (size_t)b * SEQ + tq[s]; load_q(Q, tok[s], g * 512 + (l15 & 7) * 64, quad, qf[s]);
            mm[s] = sink_raw; ll[s] = quad == 0 ? 1.f : 0.f;
#pragma unroll
            for (int dg = 0; dg < 4; ++dg) o[s][dg] = (f32x4){0.f, 0.f, 0.f, 0.f}; }
        const int jb0 = cur >= 2 ? cur - 2 : 0, nb = cur - jb0 + 1;
        Stage st; stage_load<true>(st, KS + (size_t)jb0 * 4096, VS + (size_t)jb0 * 4096, tid); stage_write<true>(st, kvb, tid); __syncthreads();
#pragma unroll 1
        for (int i = 0; i < nb; ++i) {
            LAS unsigned char* buf = kvb + (i & 1) * KVB;
            const int j = jb0 + i;
            if (i + 1 < nb) stage_load<true>(st, KS + (size_t)(j + 1) * 4096, VS + (size_t)(j + 1) * 4096, tid);
#pragma unroll
            for (int s = 0; s < 2; ++s) online_step<true>(buf, qf[s][0], qf[s][1], tq[s] - (SWA_WIN - 1) - 64 * j, tq[s] - 64 * j, mm[s], ll[s], o[s], lane);
            if (i + 1 < nb) stage_write<true>(st, kvb + ((i + 1) & 1) * KVB, tid);
            __syncthreads();
        }
#pragma unroll
        for (int s = 0; s < 2; ++s) { const float inv = 1.f / sum_quads(ll[s]);
#pragma unroll
            for (int dg = 0; dg < 4; ++dg) { u32x2 w; w.x = pg8::cvt_pk_bf16(o[s][dg][0] * inv, o[s][dg][1] * inv); w.y = pg8::cvt_pk_bf16(o[s][dg][2] * inv, o[s][dg][3] * inv);
                *(u32x2*)(ATT + tok[s] * DM + g * 512 + (l15 & 7) * 64 + 16 * dg + 4 * quad) = w; } }
    }
}

enum Kind { K_PRO = 0, K_NSA_IN, K_CMP_HID, K_CMP_OUT, K_NSA_ATT, K_SWA_IN, K_SWA_ATT, K_OUTPROJ, K_LN1, K_LN1R, K_FFN1, K_FFN2, K_LN2, K_SCATTER, K_MOE1, K_MOE2, K_LN2C, K_COUNT };
struct Args { const void* in[18]; float* out; unsigned char* ws; int ph_lo, ph_hi; };
struct PhaseEnt { int kind, layer; };
constexpr int NPH = 35;
static const PhaseEnt h_prog[NPH] = {
    {K_PRO, 0},
    {K_NSA_IN, 0}, {K_CMP_HID, 0}, {K_CMP_OUT, 0}, {K_NSA_ATT, 0}, {K_OUTPROJ, 0}, {K_LN1, 0}, {K_FFN1, 0}, {K_FFN2, 0}, {K_LN2, 0},
    {K_NSA_IN, 1}, {K_CMP_HID, 1}, {K_CMP_OUT, 1}, {K_NSA_ATT, 1}, {K_OUTPROJ, 1}, {K_LN1R, 1}, {K_SCATTER, 1}, {K_MOE1, 1}, {K_MOE2, 1}, {K_LN2C, 1},
    {K_SWA_IN, 2}, {K_SWA_ATT, 2}, {K_OUTPROJ, 2}, {K_LN1, 2}, {K_FFN1, 2}, {K_FFN2, 2}, {K_LN2, 2},
    {K_SWA_IN, 3}, {K_SWA_ATT, 3}, {K_OUTPROJ, 3}, {K_LN1R, 3}, {K_SCATTER, 3}, {K_MOE1, 3}, {K_MOE2, 3}, {K_LN2C, 3},
};

template <int KIND> DEVI void do_phase(Frame& F, int l) {
    unsigned char* ws = F.ws;
    unsigned* ctl = (unsigned*)(ws + WS_CTL);
    LAS unsigned char* ring = F.lds;
    const int bx = (int)blockIdx.x;
    if constexpr (KIND == K_PRO) { phase_prologue(F); }
    if constexpr (KIND == K_NSA_IN) { pg8::Gemm g{(const bf16_t*)(ws + WS_HB), DM, DM, DM}; pg8::StaticOrder S; S.init(MTOK / 256, A_INP / 256, F.G, bx, (const bf16_t*)(ws + WS_WINA) + (size_t)l * A_INP * DM);
        EpiNsaIn E{ws, (const float*)(ws + WS_CS)}; pg8::gemm_phase(ring, g, S, E, F.wave0); }
    if constexpr (KIND == K_CMP_HID) {
        const int kv = (bx >> 5) & 1;
        if (bx < 64) { pg8::Gemm g{(const bf16_t*)(ws + (kv ? RA_VCR : RA_KCR)), 1024, 2048, 2048};
            pg8::StaticOrder S; S.init(32, 1, 32, bx & 31, (const bf16_t*)(ws + WS_WC1) + (size_t)(l * 2 + kv) * 256 * 2048);
            EpiCmpHid E{(bf16_t*)(ws + RA_CH) + (size_t)kv * 8192 * 256, (const float*)(ctl + CW_BIASP) + (l * 2 + kv) * 256};
            pg8::gemm_phase(ring, g, S, E, F.wave0); }
        else phase_vs_transpose(F, l); }
    if constexpr (KIND == K_CMP_OUT) { pg8::Gemm g{(const bf16_t*)(ws + RA_CH), 256, 256, 256}; pg8::DualOrder S; S.init(64, 1, F.G, bx, (const bf16_t*)(ws + WS_WC2) + (size_t)(l * 2) * 256 * 256); S.estride = (size_t)256 * 256;
        EpiCmpOut E{(bf16_t*)(ws + RA_KC), (bf16_t*)(ws + RA_VC)}; pg8::gemm_phase(ring, g, S, E, F.wave0); }
#if NAIVE_NSA
    if constexpr (KIND == K_NSA_ATT) { phase_nsa_naive(F); }
#else
    if constexpr (KIND == K_NSA_ATT) { phase_nsa_fast(F, l); }
#endif
    if constexpr (KIND == K_SWA_IN) { pg8::Gemm g{(const bf16_t*)(ws + WS_HB), DM, DM, DM}; pg8::StaticOrder S;
        if (l == 2) S.init(MTOK / 256, 5, F.G, bx, (const bf16_t*)(ws + WS_WQKV2)); else S.init(MTOK / 256, 4, F.G, bx, (const bf16_t*)(ws + WS_WQB1));
        EpiSwaIn E{ws, (const float*)(ws + WS_CS)}; pg8::gemm_phase(ring, g, S, E, F.wave0); }
#if NAIVE_SWA
    if constexpr (KIND == K_SWA_ATT) { phase_swa_naive(F, (const float*)ARG_IN(10) + (l - 2) * 16); }
#else
    if constexpr (KIND == K_SWA_ATT) { phase_swa_fast(F, (const float*)ARG_IN(10) + (l - 2) * 16); }
#endif
    if constexpr (KIND == K_OUTPROJ) { pg8::Gemm g{(const bf16_t*)(ws + RA_ATT), DM, DM, DM}; pg8::StaticOrder S;
        S.init(MTOK / 256, 4, F.G, bx, l < 2 ? (const bf16_t*)(ws + WS_WOUTA) + (size_t)l * DM * DM : (const bf16_t*)(ws + WS_WOUTB) + (size_t)(l - 2) * DM * DM);
        EpiResid E{(const bf16_t*)(ws + WS_HB), (bf16_t*)(ws + WS_Y)}; pg8::gemm_phase(ring, g, S, E, F.wave0); }
    if constexpr (KIND == K_LN1) { phase_ln<0, false, false>(F, l * 2, nullptr, 0); }
    if constexpr (KIND == K_LN1R) { phase_ln<0, true, false>(F, l * 2, nullptr, l >> 1); }
    if constexpr (KIND == K_FFN1) { pg8::Gemm g{(const bf16_t*)(ws + WS_HB), DM, DM, DM}; pg8::StaticOrder S; S.init(MTOK / 256, 2 * DFF / 256, F.G, bx, (const bf16_t*)(ws + WS_WDIN) + (size_t)(l >> 1) * 2 * DFF * DM);
        EpiSwiglu E{(bf16_t*)(ws + WS_ACT), DFF}; pg8::gemm_phase(ring, g, S, E, F.wave0); }
    if constexpr (KIND == K_FFN2) { pg8::Gemm g{(const bf16_t*)(ws + WS_ACT), DFF, DFF, DFF}; pg8::StaticOrder S; S.init(MTOK / 256, 4, F.G, bx, (const bf16_t*)(ws + WS_WDOUT) + (size_t)(l >> 1) * DM * DFF);
        EpiResid E{(const bf16_t*)(ws + WS_HB), (bf16_t*)(ws + WS_Y)}; pg8::gemm_phase(ring, g, S, E, F.wave0); }
    if constexpr (KIND == K_LN2) { phase_ln<0, false, false>(F, l * 2 + 1, nullptr, 0); }
    if constexpr (KIND == K_SCATTER) { phase_moe_scatter(F, l >> 1); }
    if constexpr (KIND == K_MOE1) { const int ml = l >> 1; int ts[9]; moe_tiles((const unsigned*)ctl + CW_MOE + ml * 64, ts);
        pg8::Gemm g{(const bf16_t*)(ws + WS_XB), DM, DM, DM}; pg8::GroupedOrder S; S.init(ts[8], 2 * DFFE / 256, F.G, bx, (const bf16_t*)(ws + WS_WMIN) + (size_t)ml * 8 * 2 * DFFE * DM);
        S.t1 = ts[1]; S.t2 = ts[2]; S.t3 = ts[3]; S.t4 = ts[4]; S.t5 = ts[5]; S.t6 = ts[6]; S.t7 = ts[7]; S.estride = (size_t)2 * DFFE * DM;
        EpiSwiglu E{(bf16_t*)(ws + WS_ACT), DFFE}; pg8::gemm_phase(ring, g, S, E, F.wave0); }
    if constexpr (KIND == K_MOE2) { const int ml = l >> 1; int ts[9]; moe_tiles((const unsigned*)ctl + CW_MOE + ml * 64, ts);
        pg8::Gemm g{(const bf16_t*)(ws + WS_ACT), DFFE, DFFE, DFFE}; pg8::GroupedOrder S; S.init(256, 4, F.G, bx, (const bf16_t*)(ws + WS_WMOUT) + (size_t)ml * 8 * DM * DFFE);
        S.t1 = ts[1]; S.t2 = ts[2]; S.t3 = ts[3]; S.t4 = ts[4]; S.t5 = ts[5]; S.t6 = ts[6]; S.t7 = ts[7]; S.estride = (size_t)DM * DFFE;
        EpiBf16Out E{(bf16_t*)(ws + WS_YB)}; pg8::gemm_phase(ring, g, S, E, F.wave0);
        pg8::Gemm g4{(const bf16_t*)(ws + WS_ACT), DFFE, DFFE / 4, DFFE}; pg8::SliceOrder S4; S4.nsl = (ts[8] - 256) * 16; S4.G = F.G; S4.c = (bx + 128) & 255; S4.kq = DFFE / 4;
        S4.bt = (const bf16_t*)(ws + WS_WMOUT) + (size_t)ml * 8 * DM * DFFE; S4.t1 = ts[1]; S4.t2 = ts[2]; S4.t3 = ts[3]; S4.t4 = ts[4]; S4.t5 = ts[5]; S4.t6 = ts[6]; S4.t7 = ts[7]; S4.estride = (size_t)DM * DFFE;
        EpiPart E4{(float*)(ws + WS_H)}; pg8::gemm_phase(ring, g4, S4, E4, F.wave0); }
    if constexpr (KIND == K_LN2C) { if (l == DEPTH - 1) phase_ln<1, false, true>(F, l * 2 + 1, ARG_OUT(), 0); else phase_ln<1, false, false>(F, l * 2 + 1, nullptr, 0); }
}

DEVI void frame_init(Frame& F, unsigned char* lds_raw) {
    F.lds = (LAS unsigned char*)lds_raw; F.ws = ARG_WS();
    F.wave0 = wave_id_sgpr(); F.tid = threadIdx.x; F.lane = F.tid & 63; F.wave = F.wave0;
    F.G = gridDim.x; { const int bx = blockIdx.x; F.vcu = (F.G % 8 == 0) ? (bx % 8) * (F.G / 8) + bx / 8 : bx; }
}

#if !MK_SINGLE
template <int KIND> __global__ void __launch_bounds__(NWAVES * 64, 2) phase_kernel(Args args) {
    extern __shared__ __attribute__((aligned(16))) unsigned char lds_raw[];
    Frame F; frame_init(F, lds_raw);
    do_phase<KIND>(F, args.ph_lo);
}
template <int KIND> static void launch_kind(const Args& a, hipStream_t stream) {
    static bool attr = false;
    if (!attr) { (void)hipFuncSetAttribute((const void*)phase_kernel<KIND>, hipFuncAttributeMaxDynamicSharedMemorySize, LDS_BYTES); attr = true; }
    hipLaunchKernelGGL(phase_kernel<KIND>, dim3(256), dim3(NWAVES * 64), LDS_BYTES, stream, a);
}
#else
__global__ void __launch_bounds__(NWAVES * 64, 2) yoco_fwd(Args args) {
    extern __shared__ __attribute__((aligned(16))) unsigned char lds_raw[];
    Frame F; frame_init(F, lds_raw);
    volatile LAS unsigned* MISC = (volatile LAS unsigned*)(F.lds + MISC_OFF);
    for (int u = F.tid; u < 256; u += NWAVES * 64) MISC[u] = 0u;
    __syncthreads();
    XcdBarrier bar = xcd_barrier_post((unsigned*)(F.ws + WS_CTL) + CW_BAR, MISC + 8);
#define DUP_KIND 12
#define DUP_KIND 13
#ifndef DUP_KIND
#define DUP_KIND -1
#endif
#define PH(K, L, FIRST) do { do_phase<K>(F, L); if (FIRST) cg::this_grid().sync(); else xcd_barrier(bar); if (K == DUP_KIND) { do_phase<K>(F, L); xcd_barrier(bar); } } while (0)
    PH(K_PRO, 0, true);
#define NSA_LAYER(l) PH(K_NSA_IN, l, false); PH(K_CMP_HID, l, false); PH(K_CMP_OUT, l, false); PH(K_NSA_ATT, l, false); PH(K_OUTPROJ, l, false)
#define SWA_LAYER(l) PH(K_SWA_IN, l, false); PH(K_SWA_ATT, l, false); PH(K_OUTPROJ, l, false)
#define DENSE_FFN(l) PH(K_LN1, l, false); PH(K_FFN1, l, false); PH(K_FFN2, l, false); PH(K_LN2, l, false)
#define MOE_FFN(l, LAST) PH(K_LN1R, l, false); PH(K_SCATTER, l, false); PH(K_MOE1, l, false); PH(K_MOE2, l, false); do_phase<K_LN2C>(F, l); if (!(LAST)) xcd_barrier(bar); else if (DUP_KIND == 16) { xcd_barrier(bar); do_phase<K_LN2C>(F, l); }
    NSA_LAYER(0); DENSE_FFN(0);
    NSA_LAYER(1); MOE_FFN(1, false);
    SWA_LAYER(2); DENSE_FFN(2);
    SWA_LAYER(3); MOE_FFN(3, true);
}
#endif

extern "C" void kernel_launch(void* const* d_in, const int* in_sizes, int n_in, void* d_out, int out_size, void* d_ws, size_t ws_size, hipStream_t stream) {
    static int grid = 0;
    if (grid == 0) {
        if (n_in != 18 || out_size != MTOK * DM || ws_size < WS_END) { fprintf(stderr, "kernel_launch: unexpected shapes (n_in %d out %d ws %zu need %zu)\n", n_in, out_size, ws_size, (size_t)WS_END); grid = -1; return; }
        int dev = 0, cus = 0;
        (void)hipGetDevice(&dev); (void)hipDeviceGetAttribute(&cus, hipDeviceAttributeMultiprocessorCount, dev);
        if (cus < 256) { fprintf(stderr, "kernel_launch: needs 256 CUs, device has %d\n", cus); grid = -1; return; }
#if MK_SINGLE
        int per_cu = 0;
        (void)hipFuncSetAttribute((const void*)yoco_fwd, hipFuncAttributeMaxDynamicSharedMemorySize, LDS_BYTES);
        (void)hipOccupancyMaxActiveBlocksPerMultiprocessor(&per_cu, (const void*)yoco_fwd, NWAVES * 64, LDS_BYTES);
        if (per_cu < 1) fprintf(stderr, "kernel_launch: occupancy query says %d blocks per CU\n", per_cu);
        (void)hipGetLastError();
#endif
        grid = 256;
    }
    if (grid < 0) return;
    (void)hipMemsetAsync((char*)d_ws + WS_CTL, 0, CTL_BYTES, stream);
    Args a{};
    for (int i = 0; i < 18; ++i) a.in[i] = d_in[i];
    a.out = (float*)d_out; a.ws = (unsigned char*)d_ws;
#if MK_SINGLE
    a.ph_lo = 0; a.ph_hi = NPH;
    void* kargs[] = {&a};
    hipError_t e = hipLaunchCooperativeKernel((const void*)yoco_fwd, dim3(grid), dim3(NWAVES * 64), kargs, LDS_BYTES, stream);
    if (e != hipSuccess) fprintf(stderr, "cooperative launch failed: %s (grid %d)\n", hipGetErrorString(e), grid);
#else
    for (int p = 0; p < NPH; ++p) {
        a.ph_lo = h_prog[p].layer; a.ph_hi = 0;
        switch (h_prog[p].kind) {
#define LK(K) case K: launch_kind<K>(a, stream); break;
            LK(K_PRO) LK(K_NSA_IN) LK(K_CMP_HID) LK(K_CMP_OUT) LK(K_NSA_ATT) LK(K_SWA_IN) LK(K_SWA_ATT) LK(K_OUTPROJ) LK(K_LN1) LK(K_LN1R) LK(K_FFN1) LK(K_FFN2) LK(K_LN2) LK(K_SCATTER) LK(K_MOE1) LK(K_MOE2) LK(K_LN2C)
#undef LK
            default: break;
        }
    }
#endif
}
```

```cpp
#include <hip/hip_runtime.h>
#include <hip/hip_cooperative_groups.h>
#include <cstdio>
#include <cstdint>
namespace cg = cooperative_groups;

#ifndef DBG_DROP
#define DBG_DROP 0
#endif
#ifndef NAIVE_NSA
#define NAIVE_NSA 0
#endif
#ifndef NAIVE_SWA
#define NAIVE_SWA 0
#endif
#ifndef MK_SINGLE
#define MK_SINGLE 1
#endif

#define DEVI __device__ __forceinline__
#define LAS __attribute__((address_space(3)))
#define GAS __attribute__((address_space(1)))
typedef unsigned short bf16_t;
typedef short bf16x8 __attribute__((ext_vector_type(8)));
typedef float f32x4 __attribute__((ext_vector_type(4)));
typedef float f32x2 __attribute__((ext_vector_type(2)));
typedef unsigned u32x4 __attribute__((ext_vector_type(4)));
typedef unsigned u32x2 __attribute__((ext_vector_type(2)));

constexpr int BATCH = 2, SEQ = 16384, MTOK = BATCH * SEQ, DM = 1024, DEPTH = 4;
constexpr int HD = 64;
constexpr int A_G = 4, A_R = 4, A_IN = 2608, A_INP = 2816;
constexpr int NCMP = 1023, CMP_HID = 256;
constexpr int NSLC = SEQ / 64, NSEL = 16, NSA_WIN = 512;
constexpr int B_G = 2, B_R = 8, SWA_WIN = 128;
constexpr int DFF = 2816, NEXP = 8, DFFE = 3584;
constexpr int CAP = MTOK * 2 + NEXP * 256;
constexpr float ALPHA = 1.6817928305074292f;
constexpr float LN_EPS = 1e-5f;
constexpr float QSCALE = 0.125f;

constexpr size_t al256(size_t x) { return (x + 255) & ~(size_t)255; }
constexpr size_t WS_CTL = 0, CTL_BYTES = 1u << 20;
constexpr size_t WS_WINA = CTL_BYTES;
constexpr size_t WS_WOUTA = WS_WINA + (size_t)2 * A_INP * DM * 2;
constexpr size_t WS_WC1 = WS_WOUTA + (size_t)2 * DM * DM * 2;
constexpr size_t WS_WC2 = WS_WC1 + (size_t)4 * 256 * 2048 * 2;
constexpr size_t WS_WQKV2 = WS_WC2 + (size_t)4 * 256 * 256 * 2;
constexpr size_t WS_WQB1 = WS_WQKV2 + (size_t)1280 * DM * 2;
constexpr size_t WS_WOUTB = WS_WQB1 + (size_t)DM * DM * 2;
constexpr size_t WS_WDIN = WS_WOUTB + (size_t)2 * DM * DM * 2;
constexpr size_t WS_WDOUT = WS_WDIN + (size_t)2 * 2 * DFF * DM * 2;
constexpr size_t WS_WMIN = WS_WDOUT + (size_t)2 * DM * DFF * 2;
constexpr size_t WS_WMOUT = WS_WMIN + (size_t)16 * 2 * DFFE * DM * 2;
constexpr size_t WS_WEND = WS_WMOUT + (size_t)16 * DM * DFFE * 2;
constexpr size_t WS_H = al256(WS_WEND);
constexpr size_t WS_Y = WS_H + (size_t)MTOK * DM * 4;
constexpr size_t WS_HB = WS_Y + (size_t)MTOK * DM * 4;
constexpr size_t WS_CS = WS_HB + (size_t)MTOK * DM * 2;
constexpr size_t WS_KSH = WS_CS + (size_t)MTOK * 16 * 4;
constexpr size_t WS_VSH = WS_KSH + (size_t)MTOK * 128 * 2;
constexpr size_t WS_ROUTE = WS_VSH + (size_t)MTOK * 128 * 2;
constexpr size_t WS_XB = WS_ROUTE + (size_t)MTOK * 2 * 4 * 4;
constexpr size_t WS_ACT = WS_XB + (size_t)CAP * DM * 2;
constexpr size_t WS_RA = WS_ACT + (size_t)CAP * DFFE * 2;
constexpr size_t SLAB = (size_t)MTOK * 256 * 2;
constexpr size_t RA_Q = WS_RA;
constexpr size_t RA_ATT = RA_Q + (size_t)MTOK * DM * 2;
constexpr size_t RA_KCR = RA_ATT + (size_t)MTOK * DM * 2;
constexpr size_t RA_VCR = RA_KCR + SLAB + 4096;
constexpr size_t RA_KS = RA_VCR + SLAB + 4096;
constexpr size_t RA_VS = RA_KS + SLAB;
constexpr size_t RA_KW = RA_VS + SLAB;
constexpr size_t RA_VW = RA_KW + SLAB;
constexpr size_t RA_GATE = RA_VW + SLAB;
constexpr size_t RA_KC = RA_GATE + (size_t)MTOK * 48 * 4;
constexpr size_t RA_VC = RA_KC + (size_t)8192 * 64 * 2;
constexpr size_t RA_CH = RA_VC + (size_t)8192 * 64 * 2;
constexpr size_t RA_VST = RA_CH + (size_t)2 * 8192 * 256 * 2;
constexpr size_t RA_END = RA_VST + SLAB;
constexpr size_t WS_YB = WS_RA;
constexpr size_t YB_END = WS_YB + (size_t)CAP * DM * 4;
constexpr size_t WS_END = (RA_END > YB_END ? RA_END : YB_END);
static_assert(WS_END < (size_t)1879048192, "workspace map exceeds 4x the largest tensor");

constexpr int CW_BAR = 4096;
constexpr int CW_MOE = 16384;
constexpr int CW_WGCNT = 45056;
constexpr int CW_KMAX = 40064;
constexpr int CW_VMAX = 40000;
constexpr int CW_BIASP = 32768;

constexpr int RING_BYTES = 131072;
constexpr int LDS_X = RING_BYTES;
constexpr int MISC_OFF = RING_BYTES + 16384;
constexpr int LDS_BYTES = MISC_OFF + 1024;

DEVI unsigned f2bf(float f) { unsigned u = __builtin_bit_cast(unsigned, f); return (u + 0x7fffu + ((u >> 16) & 1u)) >> 16; }
DEVI unsigned pk2(float lo, float hi) { return f2bf(lo) | (f2bf(hi) << 16); }
DEVI float bf2f(unsigned h) { return __builtin_bit_cast(float, h << 16); }
DEVI float bflo(unsigned w) { return __builtin_bit_cast(float, w << 16); }
DEVI float bfhi(unsigned w) { return __builtin_bit_cast(float, w & 0xffff0000u); }
DEVI float shx(float v, int mask, int lane) { return __builtin_bit_cast(float, __builtin_amdgcn_ds_bpermute((lane ^ mask) << 2, __builtin_bit_cast(int, v))); }
DEVI int shxi(int v, int mask, int lane) { return __builtin_amdgcn_ds_bpermute((lane ^ mask) << 2, v); }
DEVI float wave_sum(float v, int lane) {
#pragma unroll
    for (int o = 1; o < 64; o <<= 1) v += shx(v, o, lane);
    return v;
}
DEVI float wave_max(float v, int lane) {
#pragma unroll
    for (int o = 1; o < 64; o <<= 1) v = fmaxf(v, shx(v, o, lane));
    return v;
}
DEVI int wave_id_sgpr() { return __builtin_amdgcn_readfirstlane((int)threadIdx.x >> 6); }
DEVI int opaque_tid(int wave) { asm volatile("" : "+s"(wave)); int l; asm volatile("v_mbcnt_lo_u32_b32 %0, -1, 0\n\tv_mbcnt_hi_u32_b32 %0, -1, %0" : "=v"(l)); return wave * 64 + l; }
#define LDS_WAIT() asm volatile("s_waitcnt lgkmcnt(0)" ::: "memory")
#define VM_WAIT() asm volatile("s_waitcnt vmcnt(0)" ::: "memory")

namespace pg8 {
constexpr int BM = 256, BK = 64, HALF = 128, HTB = HALF * BK * 2, STAGE_BYTES = 8 * HTB, NXCD = 8, WGM = 8;
DEVI int lds_byte(int r, int c) { const int st = (r >> 4) * 2 + (c >> 5), rr = r & 15, cc = c & 31, ob = rr * 64 + cc * 2; return st * 1024 + (ob ^ (((ob >> 9) & 1) << 5)); }
DEVI void stage_rc(int b, int& R, int& C) { const int st = b / 1024, sb = b % 1024, swz = sb ^ (((sb >> 9) & 1) << 5); R = (st >> 1) * 16 + swz / 64; C = (st & 1) * 32 + (swz % 64) / 2; }
DEVI int perm32(int rho) { const int n = rho >> 4, i = rho & 15; return 8 * (i >> 2) + 4 * n + (i & 3); }

struct Unit { int pm, pn; const bf16_t* bt; int koff, z; };
struct Gemm { const bf16_t* A; int lda; int K; int ldb; };

struct StaticOrder {
    int nM, nN, nwg, G, c; const bf16_t* bt;
    DEVI void init(int nM_, int nN_, int G_, int c_, const bf16_t* bt_) { nM = nM_; nN = nN_; nwg = nM * nN; G = G_; c = c_; bt = bt_; }
    DEVI bool tile(int i, int& pm, int& pn) const {
        const long L = (long)i * G + c; if (L >= nwg) return false;
        int wgid = (int)L; { const int q = nwg / NXCD, r = nwg % NXCD, xcd = wgid % NXCD, off = wgid / NXCD; wgid = (xcd < r ? xcd * (q + 1) : r * (q + 1) + (xcd - r) * q) + off; }
        const int nig = WGM * nN, gid = wgid / nig, fm = gid * WGM, gsz = (nM - fm) < WGM ? (nM - fm) : WGM;
        pm = fm + ((wgid % nig) % gsz); pn = (wgid % nig) / gsz; return true;
    }
    DEVI bool next(int i, Unit& u) const { if (!tile(i, u.pm, u.pn)) return false; u.bt = bt; u.koff = 0; u.z = 0; return true; }
};
struct GroupedOrder : StaticOrder {
    int t1, t2, t3, t4, t5, t6, t7; size_t estride;
    DEVI bool next(int i, Unit& u) const {
        if (!tile(i, u.pm, u.pn)) return false;
        const int tm = u.pm; const int e = (tm >= t1) + (tm >= t2) + (tm >= t3) + (tm >= t4) + (tm >= t5) + (tm >= t6) + (tm >= t7);
        u.bt = bt + (size_t)e * estride; u.koff = 0; u.z = 0; return true;
    }
};
struct SliceOrder {
    int nsl, G, c, kq; const bf16_t* bt; int t1, t2, t3, t4, t5, t6, t7; size_t estride;
    DEVI bool next(int i, Unit& u) const {
        const int L = i * G + c; if (L >= nsl) return false;
        u.pm = 256 + (L >> 4); u.pn = (L & 15) >> 2; u.z = L & 3; u.koff = u.z * kq;
        const int tm = u.pm; const int e = (tm >= t1) + (tm >= t2) + (tm >= t3) + (tm >= t4) + (tm >= t5) + (tm >= t6) + (tm >= t7);
        u.bt = bt + (size_t)e * estride; return true;
    }
};
struct DualOrder : StaticOrder {
    size_t estride;
    DEVI bool next(int i, Unit& u) const { if (!tile(i, u.pm, u.pn)) return false; u.bt = bt + (u.pm >= nM / 2 ? estride : 0); u.koff = 0; u.z = 0; return true; }
};

DEVI unsigned cvt_pk_bf16(float lo, float hi) { typedef __bf16 bf16x2_t __attribute__((ext_vector_type(2))); f32x2 v = {lo, hi}; bf16x2_t b = __builtin_convertvector(v, bf16x2_t); return __builtin_bit_cast(unsigned, b); }

template <class Epi, class Sched, bool ALIGN_EPI = true>
DEVI void gemm_phase(LAS unsigned char* lds, const Gemm g, const Sched& S, const Epi& E, int wave0) {
    const int tid = opaque_tid(wave0), wid = __builtin_amdgcn_readfirstlane(tid >> 6), lane = tid & 63, wr = wid >> 2, wc = wid & 3, fr = lane & 15, fq = lane >> 4;
    const int K = g.K, nt = K / BK, lda = g.lda, ldb = g.ldb;
    unsigned voffA[2], voffB[2];
#pragma unroll
    for (int i = 0; i < 2; ++i) { int R, C; stage_rc(tid * 16 + i * 8192, R, C); const int Rb = Epi::PERM ? ((R & ~31) + perm32(R & 31)) : R;
        voffA[i] = (unsigned)(R * lda + C) * 2u; voffB[i] = (unsigned)(Rb * ldb + C) * 2u; }
    const size_t kstep = (size_t)(BK * 2);
    const size_t hstepA = (size_t)HALF * lda * 2, tstepA = 2 * hstepA;
    const size_t hstepB = (size_t)HALF * ldb * 2, tstepB = 2 * hstepB;
    const unsigned ldsw = (unsigned)wid * 1024u;
    const int aoff = lds_byte(wr * 64 + fr, fq * 8), boff = lds_byte(wc * 32 + fr, fq * 8);
#define PG8_SA(b, h) (((b) * 2 + (h)) * HTB)
#define PG8_SB(b, h) ((4 + (b) * 2 + (h)) * HTB)
#define PG8_STAGE(bufoff, gbase, voff) do { _Pragma("unroll") for (int _i = 0; _i < 2; ++_i) \
        __builtin_amdgcn_global_load_lds((const unsigned*)((const char*)(gbase) + (voff)[_i]), (LAS unsigned*)(lds + (bufoff) + ldsw + _i * 8192), 16, 0, 0); } while (0)
#define PG8_LDA(dst, b, h) do { _Pragma("unroll") for (int m = 0; m < 4; ++m) _Pragma("unroll") for (int k = 0; k < 2; ++k) dst[m][k] = *(const LAS bf16x8*)(lds + PG8_SA(b, h) + aoff + m * 2048 + k * 1024); } while (0)
#define PG8_LDB(dst, b, h) do { _Pragma("unroll") for (int n = 0; n < 2; ++n) _Pragma("unroll") for (int k = 0; k < 2; ++k) dst[n][k] = *(const LAS bf16x8*)(lds + PG8_SB(b, h) + boff + n * 2048 + k * 1024); } while (0)
#define PG8_MMA(ai, bj, At, Bt) do { __builtin_amdgcn_s_setprio(1); _Pragma("unroll") for (int m = 0; m < 4; ++m) _Pragma("unroll") for (int n = 0; n < 2; ++n) _Pragma("unroll") for (int k = 0; k < 2; ++k) \
        acc[ai][bj][m][n] = __builtin_amdgcn_mfma_f32_16x16x32_bf16(Bt[n][k], At[m][k], acc[ai][bj][m][n], 0, 0, 0); __builtin_amdgcn_s_setprio(0); } while (0)
#define PG8_WAIT_V(n) asm volatile("s_waitcnt vmcnt(" #n ")" ::: "memory")
#define PG8_WAIT_L(n) asm volatile("s_waitcnt lgkmcnt(" #n ")" ::: "memory")
#define PG8_BAR __builtin_amdgcn_s_barrier()
#define PG8_SCHED __builtin_amdgcn_sched_barrier(0)
    Unit cur, nxt; int ui = 0;
    if (!S.next(0, cur)) return;
    f32x4 acc[2][2][4][2];
#pragma unroll
    for (int a = 0; a < 2; ++a)
#pragma unroll
        for (int b = 0; b < 2; ++b)
#pragma unroll
            for (int m = 0; m < 4; ++m)
#pragma unroll
                for (int n = 0; n < 2; ++n) acc[a][b][m][n] = (f32x4){0.f, 0.f, 0.f, 0.f};
    bf16x8 At[4][2], B0[2][2], B1[2][2];
    const char* cA = (const char*)g.A + (size_t)cur.pm * tstepA + (size_t)cur.koff * 2; const char* cB = (const char*)cur.bt + (size_t)cur.pn * tstepB + (size_t)cur.koff * 2;
    PG8_STAGE(PG8_SB(0, 0), cB, voffB); PG8_STAGE(PG8_SB(0, 1), cB + hstepB, voffB); PG8_STAGE(PG8_SA(0, 0), cA, voffA); PG8_STAGE(PG8_SA(0, 1), cA + hstepA, voffA);
    if (wr == 1) PG8_BAR;
    PG8_WAIT_V(2); PG8_BAR;
    PG8_STAGE(PG8_SB(1, 0), cB + kstep, voffB); PG8_STAGE(PG8_SA(1, 0), cA + kstep, voffA); PG8_STAGE(PG8_SB(1, 1), cB + hstepB + kstep, voffB);
    PG8_WAIT_V(6); PG8_BAR;
    for (;;) {
        const bool has_next = S.next(ui + 1, nxt);
        const char* nA = has_next ? (const char*)g.A + (size_t)nxt.pm * tstepA + (size_t)nxt.koff * 2 : cA; const char* nB = has_next ? (const char*)nxt.bt + (size_t)nxt.pn * tstepB + (size_t)nxt.koff * 2 : cB;
        for (int t = 0; t < nt; t += 2) {
            const bool last = (t == nt - 2);
            const char* a1 = cA + (size_t)(t + 1) * kstep;
            const char* a2 = last ? nA : cA + (size_t)(t + 2) * kstep; const char* b2 = last ? nB : cB + (size_t)(t + 2) * kstep;
            const char* a3 = a2 + kstep; const char* b3 = b2 + kstep;
            PG8_LDB(B0, 0, 0); PG8_LDB(B1, 0, 1); PG8_SCHED; PG8_LDA(At, 0, 0); PG8_STAGE(PG8_SA(1, 1), a1 + hstepA, voffA);
            PG8_WAIT_V(8); PG8_WAIT_L(0); PG8_BAR; PG8_MMA(0, 0, At, B0); PG8_MMA(0, 1, At, B1); PG8_BAR; PG8_SCHED;
            PG8_LDA(At, 0, 1); PG8_STAGE(PG8_SB(0, 0), b2, voffB); PG8_STAGE(PG8_SB(0, 1), b2 + hstepB, voffB); PG8_STAGE(PG8_SA(0, 0), a2, voffA);
            PG8_WAIT_V(8); PG8_WAIT_L(0); PG8_BAR; PG8_MMA(1, 0, At, B0); PG8_MMA(1, 1, At, B1); PG8_BAR; PG8_SCHED;
            PG8_LDB(B0, 1, 0); PG8_LDB(B1, 1, 1); PG8_SCHED; PG8_LDA(At, 1, 0); PG8_STAGE(PG8_SA(0, 1), a2 + hstepA, voffA);
            PG8_WAIT_V(8); PG8_WAIT_L(0); PG8_BAR; PG8_MMA(0, 0, At, B0); PG8_MMA(0, 1, At, B1); PG8_BAR; PG8_SCHED;
            PG8_LDA(At, 1, 1); PG8_STAGE(PG8_SB(1, 0), b3, voffB); PG8_STAGE(PG8_SB(1, 1), b3 + hstepB, voffB); PG8_STAGE(PG8_SA(1, 0), a3, voffA);
            PG8_WAIT_V(8); PG8_WAIT_L(0); PG8_BAR; PG8_MMA(1, 0, At, B0); PG8_MMA(1, 1, At, B1); PG8_BAR; PG8_SCHED;
        }
        if constexpr (ALIGN_EPI) { if (wr == 0) PG8_BAR; }
        E(acc, cur, wr, wc, fr, fq);
        if (!has_next) break;
#pragma unroll
        for (int a = 0; a < 2; ++a)
#pragma unroll
            for (int b = 0; b < 2; ++b)
#pragma unroll
                for (int m = 0; m < 4; ++m)
#pragma unroll
                    for (int n = 0; n < 2; ++n) acc[a][b][m][n] = (f32x4){0.f, 0.f, 0.f, 0.f};
        cur = nxt; cA = nA; cB = nB; ++ui;
        if constexpr (ALIGN_EPI) { if (wr == 1) PG8_BAR; }
    }
    PG8_WAIT_V(0);
    if constexpr (!ALIGN_EPI) { if (wr == 0) PG8_BAR; }
    PG8_BAR;
#undef PG8_SA
#undef PG8_SB
#undef PG8_STAGE
#undef PG8_LDA
#undef PG8_LDB
#undef PG8_MMA
#undef PG8_WAIT_V
#undef PG8_WAIT_L
#undef PG8_BAR
#undef PG8_SCHED
}
}

#define XB_TMO      128
#define XB_XCNT(j)  (256  + 64 * (j))
#define XB_XSUB(j)  (1280 + 64 * (j))
#define XB_XGEN(j)  (2304 + 64 * (j))
#define XB_TOP      3328
#define XB_TOPGEN   3392
#define XCD_BAR_WORDS 3456
#define XB_SPIN_CAP (1u << 22)
DEVI unsigned xb_ld(unsigned* p)              { return __hip_atomic_load(p, __ATOMIC_RELAXED, __HIP_MEMORY_SCOPE_AGENT); }
DEVI unsigned xb_add(unsigned* p, unsigned v) { return __hip_atomic_fetch_add(p, v, __ATOMIC_RELAXED, __HIP_MEMORY_SCOPE_AGENT); }
DEVI unsigned xb_xcc_id() { return (unsigned)__builtin_amdgcn_s_getreg((3 << 11) | 20) & 0xFu; }
#define XB_SPIN(cond, bar) do { unsigned _sp = 0; while (cond) { __builtin_amdgcn_s_sleep(1); \
    if ((++_sp & 255u) == 0u) { if (xb_ld(&(bar)[XB_TMO])) break; if (_sp > XB_SPIN_CAP) { atomicAdd(&(bar)[XB_TMO], 1u); break; } } } } while (0)
struct XcdBarrier { unsigned* bar; unsigned x; volatile LAS unsigned* st; };
DEVI XcdBarrier xcd_barrier_post(unsigned* bar, volatile LAS unsigned* st) {
    XcdBarrier b; b.bar = bar; b.x = xb_xcc_id(); b.st = st;
    if (threadIdx.x == 0) (void)xb_add(&bar[XB_XCNT(b.x)], 1u);
    return b;
}
DEVI void xcd_barrier_complete(unsigned* bar, unsigned x, unsigned& nloc, unsigned& nx) {
    const unsigned G = gridDim.x * gridDim.y * gridDim.z;
    unsigned sum, cnt, mine, sp = 0u;
    for (;;) {
        sum = 0u; cnt = 0u; mine = 0u;
#pragma unroll
        for (unsigned j = 0; j < 16; ++j) { const unsigned c = xb_ld(&bar[XB_XCNT(j)]); sum += c; cnt += (c > 0u) ? 1u : 0u; mine = (j == x) ? c : mine; }
        if (sum == G) break;
        __builtin_amdgcn_s_sleep(1);
        if ((++sp & 255u) == 0u) { if (xb_ld(&bar[XB_TMO])) break; if (sp > XB_SPIN_CAP) { atomicAdd(&bar[XB_TMO], 1u); break; } }
    }
    nloc = mine > 0u ? mine : 1u; nx = cnt > 0u ? cnt : 1u;
}
DEVI void xcd_barrier(const XcdBarrier& b) {
    asm volatile("s_waitcnt vmcnt(0)" ::: "memory");
    __syncthreads();
    if (threadIdx.x == 0) {
        unsigned* bar = b.bar;
        __builtin_amdgcn_s_waitcnt(0);
        unsigned nloc = b.st[0], nx = b.st[1];
        if (nloc == 0u) { xcd_barrier_complete(bar, b.x, nloc, nx); b.st[0] = nloc; b.st[1] = nx; }
        const unsigned old = xb_add(&bar[XB_XSUB(b.x)], 1u);
        const unsigned gen = old / nloc;
        if (old + 1u == (gen + 1u) * nloc) {
            __builtin_amdgcn_fence(__ATOMIC_RELEASE, "agent");
            asm volatile("s_waitcnt vmcnt(0)" ::: "memory");
            const unsigned og = xb_add(&bar[XB_TOP], 1u);
            const unsigned tg = og / nx;
            if (og + 1u == (tg + 1u) * nx) xb_add(&bar[XB_TOPGEN], 1u);
            else XB_SPIN(xb_ld(&bar[XB_TOPGEN]) == tg, bar);
            __builtin_amdgcn_fence(__ATOMIC_ACQUIRE, "agent");
            xb_add(&bar[XB_XGEN(b.x)], 1u);
            asm volatile("s_waitcnt vmcnt(0)" ::: "memory");
        } else {
            XB_SPIN(xb_ld(&bar[XB_XGEN(b.x)]) == gen, bar);
            __builtin_amdgcn_fence(__ATOMIC_ACQUIRE, "agent");
            asm volatile("s_waitcnt vmcnt(0)" ::: "memory");
        }
    }
    __syncthreads();
}

typedef const void* cvp_t;
DEVI const void* karg_ptr(int byte_off) { asm volatile("" : "+s"(byte_off)); const __attribute__((address_space(4))) char* kp = (const __attribute__((address_space(4))) char*)__builtin_amdgcn_kernarg_segment_ptr(); return *(const __attribute__((address_space(4))) cvp_t*)(kp + byte_off); }
#define ARG_IN(i) karg_ptr((i) * 8)
#define ARG_OUT() ((float*)karg_ptr(18 * 8))
#define ARG_WS() ((unsigned char*)karg_ptr(19 * 8))
struct Frame {
    LAS unsigned char* lds;
    unsigned char* ws;
    int tid, lane, wave, G, vcu, wave0;
    DEVI void refresh() { tid = opaque_tid(wave0); lane = tid & 63; wave = __builtin_amdgcn_readfirstlane(tid >> 6); }
};
constexpr int NWAVES = 8;

DEVI void transpose_item(const float* W, int K, int N, bf16_t* WT, int k0, int n0, int drow0, LAS float* scr, int lane) {
    const int nc = n0 + 4 * (lane & 7); const bool ok = nc < N;
#pragma unroll
    for (int i = 0; i < 8; ++i) { const int kk = 8 * i + (lane >> 3); const f32x4 v = ok ? *(const f32x4*)(W + (size_t)(k0 + kk) * N + nc) : (f32x4){0.f, 0.f, 0.f, 0.f};
        LAS float* d = scr + kk * 33 + 4 * (lane & 7); d[0] = v[0]; d[1] = v[1]; d[2] = v[2]; d[3] = v[3]; }
    LDS_WAIT(); asm volatile("" ::: "memory");
    const int c = lane & 7;
#pragma unroll
    for (int j = 0; j < 4; ++j) { const int n = (lane >> 3) + 8 * j; const LAS float* s = scr + (8 * c) * 33 + n;
        u32x4 o; o.x = pk2(s[0 * 33], s[1 * 33]); o.y = pk2(s[2 * 33], s[3 * 33]); o.z = pk2(s[4 * 33], s[5 * 33]); o.w = pk2(s[6 * 33], s[7 * 33]);
        *(u32x4*)(WT + (size_t)(drow0 + n) * K + k0 + 8 * c) = o; }
    LDS_WAIT(); asm volatile("" ::: "memory");
}
struct WFam { const float* src; size_t sstride; bf16_t* dst; size_t dstride; int count, K, N, Npad, mode; };
DEVI bool wfam_do(const WFam& f, int& it, LAS float* scr, int lane) {
    const int nkb = f.K / 64, nnb = f.Npad / 32, per = nkb * nnb, tot = per * f.count;
    if (it >= tot) { it -= tot; return false; }
    const int mi = it / per, r = it % per, kb = r / nnb, nb = r % nnb, n0 = nb * 32;
    int drow0 = n0;
    if (f.mode == 1) { const int F = f.N / 2; const int o = n0 < F ? n0 : n0 - F; drow0 = 256 * (o / 128) + (o % 128) + (n0 < F ? 0 : 128); }
    transpose_item(f.src + (size_t)mi * f.sstride, f.K, f.N, f.dst + (size_t)mi * f.dstride, kb * 64, n0, drow0, scr, lane);
    return true;
}

DEVI void phase_prologue(Frame& F) {
    F.refresh();
    LAS float* scr = (LAS float*)(F.lds + F.wave * 16384);
    const int gw = F.vcu * NWAVES + F.wave, NGW = F.G * NWAVES;
    unsigned char* ws = F.ws;
    const WFam fam[11] = {
        {(const float*)ARG_IN(2), (size_t)DM * A_IN, (bf16_t*)(ws + WS_WINA), (size_t)A_INP * DM, 2, DM, A_IN, A_INP, 0},
        {(const float*)ARG_IN(3), (size_t)DM * DM, (bf16_t*)(ws + WS_WOUTA), (size_t)DM * DM, 2, DM, DM, DM, 0},
        {(const float*)ARG_IN(5), (size_t)2048 * 256, (bf16_t*)(ws + WS_WC1), (size_t)256 * 2048, 4, 2048, 256, 256, 0},
        {(const float*)ARG_IN(6), (size_t)256 * 64, (bf16_t*)(ws + WS_WC2), (size_t)256 * 256, 4, 256, 64, 256, 0},
        {(const float*)ARG_IN(8), (size_t)DM * DM, (bf16_t*)(ws + WS_WQKV2), 0, 1, DM, DM, DM, 0},
        {(const float*)ARG_IN(7), 0, (bf16_t*)(ws + WS_WQKV2) + (size_t)DM * DM, 0, 1, DM, 256, 256, 0},
        {(const float*)ARG_IN(8) + (size_t)DM * DM, 0, (bf16_t*)(ws + WS_WQB1), 0, 1, DM, DM, DM, 0},
        {(const float*)ARG_IN(9), (size_t)DM * DM, (bf16_t*)(ws + WS_WOUTB), (size_t)DM * DM, 2, DM, DM, DM, 0},
        {(const float*)ARG_IN(13), (size_t)DM * 2 * DFF, (bf16_t*)(ws + WS_WDIN), (size_t)2 * DFF * DM, 2, DM, 2 * DFF, 2 * DFF, 1},
        {(const float*)ARG_IN(14), (size_t)DFF * DM, (bf16_t*)(ws + WS_WDOUT), (size_t)DM * DFF, 2, DFF, DM, DM, 0},
        {(const float*)ARG_IN(16), (size_t)DM * 2 * DFFE, (bf16_t*)(ws + WS_WMIN), (size_t)2 * DFFE * DM, 16, DM, 2 * DFFE, 2 * DFFE, 1},
    };
    const WFam famo = {(const float*)ARG_IN(17), (size_t)DFFE * DM, (bf16_t*)(ws + WS_WMOUT), (size_t)DM * DFFE, 16, DFFE, DM, DM, 0};
    int total = 0;
#pragma unroll
    for (int i = 0; i < 11; ++i) total += (fam[i].K / 64) * (fam[i].Npad / 32) * fam[i].count;
    total += (famo.K / 64) * (famo.Npad / 32) * famo.count;
    for (int it0 = gw; it0 < total; it0 += NGW) {
        int it = it0; bool done = false;
#pragma unroll
        for (int i = 0; i < 11; ++i) if (!done) done = wfam_do(fam[i], it, scr, F.lane);
        if (!done) wfam_do(famo, it, scr, F.lane);
    }
    { const float* x = (const float*)ARG_IN(0); bf16_t* hb = (bf16_t*)(ws + WS_HB);
      const size_t n8 = (size_t)MTOK * DM / 8;
      for (size_t i = (size_t)blockIdx.x * 512 + F.tid; i < n8; i += (size_t)F.G * 512) {
          const f32x4 v0 = *(const f32x4*)(x + i * 8), v1 = *(const f32x4*)(x + i * 8 + 4);
          u32x4 o; o.x = pk2(v0.x, v0.y); o.y = pk2(v0.z, v0.w); o.z = pk2(v1.x, v1.y); o.w = pk2(v1.z, v1.w);
          *(u32x4*)(hb + i * 8) = o; } }
    { const int* pos = (const int*)ARG_IN(1); float* cs = (float*)(ws + WS_CS);
      for (int i = blockIdx.x * 512 + F.tid; i < MTOK * 8; i += F.G * 512) {
          const int tok = i >> 3, j = i & 7;
          const float invf = (float)exp2(-(double)j * (18.931568569324174 / 8.0));
          const double ang = (double)((float)pos[tok] * invf);
          const double n = rint(ang * 0.15915494309189535); const double r = ang - n * 6.283185307179586476925;
          const float rf = (float)r;
          cs[tok * 16 + j] = cosf(rf); cs[tok * 16 + 8 + j] = sinf(rf); } }
    { const float* cp = (const float*)ARG_IN(4); const float* w1 = (const float*)ARG_IN(5); float* bp = (float*)((unsigned*)(ws + WS_CTL) + CW_BIASP);
      if (gw < 1024) { const int mi = gw >> 8, c = gw & 255; float s = 0.f;
#pragma unroll 8
          for (int i = 0; i < 32; ++i) { const int f = i * 64 + F.lane; s += cp[(size_t)mi * 2048 + f] * w1[((size_t)mi * 2048 + f) * 256 + c]; }
          s = wave_sum(s, F.lane);
          if (F.lane == 0) bp[gw] = s; } }
}

typedef f32x4 AccT[2][2][4][2];

DEVI u32x4 pack8(const f32x4 a, const f32x4 b) { u32x4 w; w.x = pg8::cvt_pk_bf16(a[0], a[1]); w.y = pg8::cvt_pk_bf16(a[2], a[3]); w.z = pg8::cvt_pk_bf16(b[0], b[1]); w.w = pg8::cvt_pk_bf16(b[2], b[3]); return w; }
DEVI void rope8(f32x4& v0, f32x4& v1, int dhead, const float* csrow, int lane) {
    f32x4 p0, p1;
#pragma unroll
    for (int i = 0; i < 4; ++i) { p0[i] = shx(v0[i], 16, lane); p1[i] = shx(v1[i], 16, lane); }
    if (dhead < 16) {
        const f32x4 c0 = *(const f32x4*)(csrow), c1 = *(const f32x4*)(csrow + 4), s0 = *(const f32x4*)(csrow + 8), s1 = *(const f32x4*)(csrow + 12);
        if (dhead == 0) { v0 = v0 * c0 - p0 * s0; v1 = v1 * c1 - p1 * s1; }
        else            { v0 = v0 * c0 + p0 * s0; v1 = v1 * c1 + p1 * s1; }
    }
}

struct EpiNsaIn {
    static constexpr bool PERM = true;
    unsigned char* ws; const float* cs;
    DEVI void operator()(const AccT& acc, const pg8::Unit& u, int wr, int wc, int fr, int fq) const {
        const int pn = u.pn;
        if (pn < 4) {
            bf16_t* Q = (bf16_t*)(ws + RA_Q);
#pragma unroll
            for (int ai = 0; ai < 2; ++ai)
#pragma unroll
                for (int m = 0; m < 4; ++m) { const int row = u.pm * 256 + ai * 128 + wr * 64 + m * 16 + fr;
#pragma unroll
                    for (int bj = 0; bj < 2; ++bj) *(u32x4*)(Q + (size_t)row * DM + pn * 256 + bj * 128 + wc * 32 + fq * 8) = pack8(acc[ai][bj][m][0], acc[ai][bj][m][1]); }
        } else if (pn < 10) {
            const size_t base = pn == 4 ? RA_KCR : pn == 5 ? RA_VCR : pn == 6 ? RA_KS : pn == 7 ? RA_VS : pn == 8 ? RA_KW : RA_VW;
            bf16_t* T = (bf16_t*)(ws + base);
            const bool rot = (pn == 6 || pn == 8);
            const int dh = (wc & 1) * 32 + fq * 8;
#pragma unroll
            for (int ai = 0; ai < 2; ++ai)
#pragma unroll
                for (int m = 0; m < 4; ++m) { const int row = u.pm * 256 + ai * 128 + wr * 64 + m * 16 + fr; const int b = row / SEQ, t = row % SEQ;
#pragma unroll
                    for (int bj = 0; bj < 2; ++bj) { f32x4 v0 = acc[ai][bj][m][0], v1 = acc[ai][bj][m][1];
                        if (rot) rope8(v0, v1, dh, cs + (size_t)row * 16, fq * 16 + fr);
                        const int g = bj * 2 + (wc >> 1);
                        *(u32x4*)(T + ((size_t)(b * A_G + g) * SEQ + t) * HD + dh) = pack8(v0, v1); } }
        } else {
            float* G = (float*)(ws + RA_GATE);
            if (wc < 2) {
#pragma unroll
                for (int ai = 0; ai < 2; ++ai)
#pragma unroll
                    for (int m = 0; m < 4; ++m) { const int row = u.pm * 256 + ai * 128 + wr * 64 + m * 16 + fr;
#pragma unroll
                        for (int n = 0; n < 2; ++n) { const int c = wc * 32 + fq * 8 + n * 4;
                            if (c < 48) { f32x4 v = acc[ai][0][m][n]; f32x4 o;
#pragma unroll
                                for (int i = 0; i < 4; ++i) o[i] = 1.f / (1.f + __expf(-v[i]));
                                *(f32x4*)(G + (size_t)row * 48 + c) = o; } } }
            }
        }
    }
};
struct EpiSwaIn {
    static constexpr bool PERM = true;
    unsigned char* ws; const float* cs;
    DEVI void operator()(const AccT& acc, const pg8::Unit& u, int wr, int wc, int fr, int fq) const {
        const int pn = u.pn; const int dh = (wc & 1) * 32 + fq * 8;
        bf16_t* Q = (bf16_t*)(ws + RA_Q); bf16_t* KS = (bf16_t*)(ws + WS_KSH); bf16_t* VS = (bf16_t*)(ws + WS_VSH);
#pragma unroll
        for (int ai = 0; ai < 2; ++ai)
#pragma unroll
            for (int m = 0; m < 4; ++m) { const int row = u.pm * 256 + ai * 128 + wr * 64 + m * 16 + fr; const int b = row / SEQ, t = row % SEQ;
#pragma unroll
                for (int bj = 0; bj < 2; ++bj) { f32x4 v0 = acc[ai][bj][m][0], v1 = acc[ai][bj][m][1];
                    const bool rot = (pn < 4) || (bj == 0);
                    if (rot) rope8(v0, v1, dh, cs + (size_t)row * 16, fq * 16 + fr);
                    const u32x4 w = pack8(v0, v1);
                    if (pn < 4) *(u32x4*)(Q + (size_t)row * DM + pn * 256 + bj * 128 + wc * 32 + fq * 8) = w;
                    else { bf16_t* T = bj == 0 ? KS : VS; const int g = wc >> 1; *(u32x4*)(T + ((size_t)(b * B_G + g) * SEQ + t) * HD + dh) = w; } } }
    }
};
DEVI float gelu_tanh(float x) { const float u = 0.7978845608028654f * (x + 0.044715f * x * x * x); const float e = __expf(2.f * u); const float th = 1.f - 2.f / (e + 1.f); return 0.5f * x * (1.f + th); }
struct EpiCmpHid {
    static constexpr bool PERM = true;
    bf16_t* out; const float* bias;
    DEVI void operator()(const AccT& acc, const pg8::Unit& u, int wr, int wc, int fr, int fq) const {
        const float* bs = bias;
#pragma unroll
        for (int bj = 0; bj < 2; ++bj) { const int c = bj * 128 + wc * 32 + fq * 8; const f32x4 b0 = *(const f32x4*)(bs + c), b1 = *(const f32x4*)(bs + c + 4);
#pragma unroll
            for (int ai = 0; ai < 2; ++ai)
#pragma unroll
                for (int m = 0; m < 4; ++m) { const int row = u.pm * 256 + ai * 128 + wr * 64 + m * 16 + fr; f32x4 v0 = acc[ai][bj][m][0] + b0, v1 = acc[ai][bj][m][1] + b1;
#pragma unroll
                    for (int i = 0; i < 4; ++i) { v0[i] = gelu_tanh(v0[i]); v1[i] = gelu_tanh(v1[i]); }
                    *(u32x4*)(out + (size_t)row * 256 + c) = pack8(v0, v1); } }
    }
};
struct EpiCmpOut {
    static constexpr bool PERM = true;
    bf16_t* kc; bf16_t* vc;
    DEVI void operator()(const AccT& acc, const pg8::Unit& u, int wr, int wc, int fr, int fq) const {
        if (wc >= 2) return;
        bf16_t* T = u.pm >= 32 ? vc : kc; const int rbase = (u.pm & 31) * 256;
#pragma unroll
        for (int ai = 0; ai < 2; ++ai)
#pragma unroll
            for (int m = 0; m < 4; ++m) { const int row = rbase + ai * 128 + wr * 64 + m * 16 + fr;
                u32x4 w = pack8(acc[ai][0][m][0], acc[ai][0][m][1]);
                if ((row & 1023) == 1023) w = (u32x4){0u, 0u, 0u, 0u};
                *(u32x4*)(T + (size_t)row * 64 + wc * 32 + fq * 8) = w; }
    }
};
struct EpiResid {
    static constexpr bool PERM = true;
    const bf16_t* res; bf16_t* y;
    DEVI void operator()(const AccT& acc, const pg8::Unit& u, int wr, int wc, int fr, int fq) const {
#pragma unroll
        for (int ai = 0; ai < 2; ++ai)
#pragma unroll
            for (int m = 0; m < 4; ++m) { const size_t off = (size_t)(u.pm * 256 + ai * 128 + wr * 64 + m * 16 + fr) * DM + u.pn * 256 + wc * 32 + fq * 8;
#pragma unroll
                for (int bj = 0; bj < 2; ++bj) { const u32x4 r = *(const u32x4*)(res + off + bj * 128);
                    const f32x4 r0 = {bflo(r.x), bfhi(r.x), bflo(r.y), bfhi(r.y)}, r1 = {bflo(r.z), bfhi(r.z), bflo(r.w), bfhi(r.w)};
                    *(u32x4*)(y + off + bj * 128) = pack8(r0 * ALPHA + acc[ai][bj][m][0], r1 * ALPHA + acc[ai][bj][m][1]); } }
    }
};
struct EpiBf16Out {
    static constexpr bool PERM = true;
    bf16_t* y;
    DEVI void operator()(const AccT& acc, const pg8::Unit& u, int wr, int wc, int fr, int fq) const {
#pragma unroll
        for (int ai = 0; ai < 2; ++ai)
#pragma unroll
            for (int m = 0; m < 4; ++m) { const size_t off = (size_t)(u.pm * 256 + ai * 128 + wr * 64 + m * 16 + fr) * DM + u.pn * 256 + wc * 32 + fq * 8;
#pragma unroll
                for (int bj = 0; bj < 2; ++bj) *(u32x4*)(y + off + bj * 128) = pack8(acc[ai][bj][m][0], acc[ai][bj][m][1]); }
    }
};
struct EpiPart {
    static constexpr bool PERM = false;
    float* part;
    DEVI void operator()(const AccT& acc, const pg8::Unit& u, int wr, int wc, int fr, int fq) const {
        float* base = part + (size_t)((u.pm - 256) * 4 + u.z) * 256 * DM;
#pragma unroll
        for (int ai = 0; ai < 2; ++ai)
#pragma unroll
            for (int m = 0; m < 4; ++m) { const size_t off = (size_t)(ai * 128 + wr * 64 + m * 16 + fr) * DM + u.pn * 256 + wc * 32 + fq * 4;
#pragma unroll
                for (int bj = 0; bj < 2; ++bj)
#pragma unroll
                    for (int n = 0; n < 2; ++n) *(f32x4*)(base + off + bj * 128 + n * 16) = acc[ai][bj][m][n]; }
    }
};
struct EpiSwiglu {
    static constexpr bool PERM = true;
    bf16_t* act; int ld;
    DEVI void operator()(const AccT& acc, const pg8::Unit& u, int wr, int wc, int fr, int fq) const {
#pragma unroll
        for (int ai = 0; ai < 2; ++ai)
#pragma unroll
            for (int m = 0; m < 4; ++m) { const size_t row = (size_t)(u.pm * 256 + ai * 128 + wr * 64 + m * 16 + fr); f32x4 o[2];
#pragma unroll
                for (int n = 0; n < 2; ++n)
#pragma unroll
                    for (int i = 0; i < 4; ++i) { const float gv = acc[ai][0][m][n][i], uv = acc[ai][1][m][n][i]; o[n][i] = gv * __builtin_amdgcn_rcpf(1.f + __expf(-gv)) * uv; }
                *(u32x4*)(act + row * ld + u.pn * 128 + wc * 32 + fq * 8) = pack8(o[0], o[1]); }
    }
};

DEVI void unpack8(const u32x4 w, float (&x)[8]) { x[0] = bflo(w.x); x[1] = bfhi(w.x); x[2] = bflo(w.y); x[3] = bfhi(w.y); x[4] = bflo(w.z); x[5] = bfhi(w.z); x[6] = bflo(w.w); x[7] = bfhi(w.w); }
DEVI void moe_row8(const bf16_t* YB, const float* PART, int p, int c, float (&x)[8]) {
    if (p < 65536) { unpack8(*(const u32x4*)(YB + (size_t)p * DM + c), x); return; }
    const float* q = PART + ((size_t)(((p >> 8) - 256) * 4) * 256 + (p & 255)) * DM + c;
    f32x4 a0 = *(const f32x4*)q, a1 = *(const f32x4*)(q + 4);
#pragma unroll
    for (int z = 1; z < 4; ++z) { a0 = a0 + *(const f32x4*)(q + (size_t)z * 256 * DM); a1 = a1 + *(const f32x4*)(q + (size_t)z * 256 * DM + 4); }
    x[0] = a0[0]; x[1] = a0[1]; x[2] = a0[2]; x[3] = a0[3]; x[4] = a1[0]; x[5] = a1[1]; x[6] = a1[2]; x[7] = a1[3];
}
template <int MODE, bool ROUTER, bool FINAL>
DEVI void phase_ln(Frame& F, int lnidx, float* outp, int moe_layer) {
    F.refresh();
    unsigned char* ws = F.ws;
    const bf16_t* Y = (const bf16_t*)(ws + WS_Y); const bf16_t* YB = (const bf16_t*)(ws + WS_YB); const float* PART = (const float*)(ws + WS_H);
    bf16_t* HB = (bf16_t*)(ws + WS_HB);
    const float* gam = (const float*)ARG_IN(11) + (size_t)lnidx * DM; const float* bet = (const float*)ARG_IN(12) + (size_t)lnidx * DM;
    int* TOKE = (int*)(ws + WS_ROUTE); int* TOKR = TOKE + MTOK * 2; float* TOKW = (float*)(TOKR + MTOK * 2); int* TOKP = (int*)(TOKW + MTOK * 2);
    const float* wr_ = ROUTER ? (const float*)ARG_IN(15) + (size_t)moe_layer * DM * NEXP : nullptr;
    LAS int* lcnt = (LAS int*)(F.lds + LDS_X);
    LAS int* lrec = lcnt + 16;
    LAS int* lrank = lrec + 256;
    if (ROUTER) { if (F.tid < 16) lcnt[F.tid] = 0; __syncthreads(); }
    const int gw = F.vcu * NWAVES + F.wave, NGW = F.G * NWAVES;
    constexpr int RB = (MODE == 0) ? 4 : 2;
    const f32x4 g0_[2] = {*(const f32x4*)(gam + F.lane * 8), *(const f32x4*)(gam + 512 + F.lane * 8)}, g1_[2] = {*(const f32x4*)(gam + F.lane * 8 + 4), *(const f32x4*)(gam + 512 + F.lane * 8 + 4)};
    const f32x4 b0_[2] = {*(const f32x4*)(bet + F.lane * 8), *(const f32x4*)(bet + 512 + F.lane * 8)}, b1_[2] = {*(const f32x4*)(bet + F.lane * 8 + 4), *(const f32x4*)(bet + 512 + F.lane * 8 + 4)};
#pragma unroll 1
    for (int k0 = 0; k0 < 16; k0 += RB) {
        float v[RB][2][8];
        if (MODE == 0) {
            u32x4 raw[RB][2];
#pragma unroll
            for (int r = 0; r < RB; ++r)
#pragma unroll
                for (int j = 0; j < 2; ++j) raw[r][j] = *(const u32x4*)(Y + (size_t)(gw + (k0 + r) * NGW) * DM + j * 512 + F.lane * 8);
#pragma unroll
            for (int r = 0; r < RB; ++r)
#pragma unroll
                for (int j = 0; j < 2; ++j) unpack8(raw[r][j], v[r][j]);
        } else {
            int p0[RB], p1[RB]; float w0[RB], w1[RB];
#pragma unroll
            for (int r = 0; r < RB; ++r) { const int m = gw + (k0 + r) * NGW; p0[r] = TOKP[m * 2]; p1[r] = TOKP[m * 2 + 1]; w0[r] = TOKW[m * 2]; w1[r] = TOKW[m * 2 + 1]; }
            u32x4 hraw[RB][2];
#pragma unroll
            for (int r = 0; r < RB; ++r)
#pragma unroll
                for (int j = 0; j < 2; ++j) hraw[r][j] = *(const u32x4*)(HB + (size_t)(gw + (k0 + r) * NGW) * DM + j * 512 + F.lane * 8);
#pragma unroll
            for (int r = 0; r < RB; ++r)
#pragma unroll
                for (int j = 0; j < 2; ++j) { const int c = j * 512 + F.lane * 8; float h[8], a[8], b[8];
                    unpack8(hraw[r][j], h); moe_row8(YB, PART, p0[r], c, a); moe_row8(YB, PART, p1[r], c, b);
#pragma unroll
                    for (int i = 0; i < 8; ++i) v[r][j][i] = h[i] * ALPHA + a[i] * w0[r] + b[i] * w1[r]; }
        }
#pragma unroll
        for (int r = 0; r < RB; ++r) {
            const int m = gw + (k0 + r) * NGW;
            float s = 0.f;
#pragma unroll
            for (int j = 0; j < 2; ++j)
#pragma unroll
                for (int i = 0; i < 8; ++i) s += v[r][j][i];
            const float mean = wave_sum(s, F.lane) * (1.f / DM); float s2 = 0.f;
#pragma unroll
            for (int j = 0; j < 2; ++j)
#pragma unroll
                for (int i = 0; i < 8; ++i) { v[r][j][i] -= mean; s2 += v[r][j][i] * v[r][j][i]; }
            const float rstd = 1.f / sqrtf(wave_sum(s2, F.lane) * (1.f / DM) + LN_EPS);
#pragma unroll
            for (int j = 0; j < 2; ++j) { const int c = j * 512 + F.lane * 8;
#pragma unroll
                for (int i = 0; i < 4; ++i) { v[r][j][i] = v[r][j][i] * rstd * g0_[j][i] + b0_[j][i]; v[r][j][4 + i] = v[r][j][4 + i] * rstd * g1_[j][i] + b1_[j][i]; }
                if (FINAL) { *(f32x4*)(outp + (size_t)m * DM + c) = (f32x4){v[r][j][0], v[r][j][1], v[r][j][2], v[r][j][3]}; *(f32x4*)(outp + (size_t)m * DM + c + 4) = (f32x4){v[r][j][4], v[r][j][5], v[r][j][6], v[r][j][7]}; }
                else { u32x4 w; w.x = pk2(v[r][j][0], v[r][j][1]); w.y = pk2(v[r][j][2], v[r][j][3]); w.z = pk2(v[r][j][4], v[r][j][5]); w.w = pk2(v[r][j][6], v[r][j][7]); *(u32x4*)(HB + (size_t)m * DM + c) = w; } }
            if (ROUTER) {
                float lg[NEXP];
#pragma unroll
                for (int e = 0; e < NEXP; ++e) lg[e] = 0.f;
#pragma unroll
                for (int j = 0; j < 2; ++j)
#pragma unroll
                    for (int i = 0; i < 8; ++i) { const int c = j * 512 + F.lane * 8 + i; const f32x4 w0 = *(const f32x4*)(wr_ + (size_t)c * NEXP), w1 = *(const f32x4*)(wr_ + (size_t)c * NEXP + 4); const float x = v[r][j][i];
                        lg[0] += x * w0.x; lg[1] += x * w0.y; lg[2] += x * w0.z; lg[3] += x * w0.w; lg[4] += x * w1.x; lg[5] += x * w1.y; lg[6] += x * w1.z; lg[7] += x * w1.w; }
#pragma unroll
                for (int e = 0; e < NEXP; ++e) lg[e] = wave_sum(lg[e], F.lane);
                int e0 = 0; float l0 = lg[0];
#pragma unroll
                for (int e = 1; e < NEXP; ++e) if (lg[e] > l0) { l0 = lg[e]; e0 = e; }
                int e1 = -1; float l1 = -3.4e38f;
#pragma unroll
                for (int e = 0; e < NEXP; ++e) if (e != e0 && lg[e] > l1) { l1 = lg[e]; e1 = e; }
                if (e1 < 0) e1 = (e0 + 1) & 7;
                const float g1 = 1.f / (1.f + __expf(l0 - l1)), g0 = 1.f - g1;
                if (F.lane == 0) {
                    const int idx = (F.wave * 16 + k0 + r) * 2;
                    lrec[idx] = m * 16 + e0; lrec[idx + 1] = m * 16 + e1;
                    TOKE[m * 2] = e0; TOKE[m * 2 + 1] = e1; TOKW[m * 2] = g0; TOKW[m * 2 + 1] = g1;
                }
            }
        }
    }
    if (ROUTER) {
        __syncthreads();
        unsigned* cnt = (unsigned*)(ws + WS_CTL) + CW_MOE + moe_layer * 64;
        int* wgcnt = (int*)(ws + WS_CTL) + CW_WGCNT + moe_layer * 2048 + (int)blockIdx.x * 8;
        LAS int* wcnt = lrank;
        int rec = 0, e = 0, r = 0;
        if (F.wave < 4) { rec = lrec[F.tid]; e = rec & 15;
            const unsigned long long lt = (1ull << F.lane) - 1ull;
#pragma unroll
            for (int x = 0; x < 8; ++x) { const unsigned long long b = __builtin_amdgcn_ballot_w64(e == x); if (e == x) r = __builtin_popcountll(b & lt); if (F.lane == 0) wcnt[F.wave * 8 + x] = __builtin_popcountll(b); } }
        __syncthreads();
        if (F.wave < 4) { for (int w = 0; w < F.wave; ++w) r += wcnt[w * 8 + e]; TOKR[(rec >> 4) * 2 + (F.tid & 1)] = r; }
        if (F.tid < 8) lcnt[F.tid] = wcnt[F.tid] + wcnt[8 + F.tid] + wcnt[16 + F.tid] + wcnt[24 + F.tid];
        __syncthreads();
        if (F.tid < 8) { wgcnt[F.tid] = lcnt[F.tid]; __hip_atomic_fetch_add(cnt + F.tid, (unsigned)lcnt[F.tid], __ATOMIC_RELAXED, __HIP_MEMORY_SCOPE_AGENT); }
    }
}

DEVI void moe_tiles(const unsigned* cnt, int (&ts)[9]) { ts[0] = 0;
#pragma unroll
    for (int e = 0; e < 8; ++e) ts[e + 1] = ts[e] + (int)((__hip_atomic_load(cnt + e, __ATOMIC_RELAXED, __HIP_MEMORY_SCOPE_AGENT) + 255u) >> 8); }
DEVI void phase_moe_scatter(Frame& F, int moe_layer) {
    F.refresh();
    unsigned char* ws = F.ws;
    const unsigned* cnt = (const unsigned*)(ws + WS_CTL) + CW_MOE + moe_layer * 64;
    int ts[9]; moe_tiles(cnt, ts);
    LAS int* wbase = (LAS int*)(F.lds + LDS_X);
    if (F.tid < 8) wbase[F.tid] = 0;
    __syncthreads();
    if (F.tid < (int)blockIdx.x) { const int* wc = (const int*)(ws + WS_CTL) + CW_WGCNT + moe_layer * 2048 + F.tid * 8;
        const u32x4 c0 = *(const u32x4*)wc, c1 = *(const u32x4*)(wc + 4);
#pragma unroll
        for (int e = 0; e < 4; ++e) { __hip_atomic_fetch_add(wbase + e, (int)c0[e], __ATOMIC_RELAXED, __HIP_MEMORY_SCOPE_WORKGROUP); __hip_atomic_fetch_add(wbase + 4 + e, (int)c1[e], __ATOMIC_RELAXED, __HIP_MEMORY_SCOPE_WORKGROUP); } }
    __syncthreads();
    const int* TOKE = (const int*)(ws + WS_ROUTE); const int* TOKR = TOKE + MTOK * 2; int* TOKP = (int*)(ws + WS_ROUTE) + MTOK * 6;
    const bf16_t* HB = (const bf16_t*)(ws + WS_HB); bf16_t* XB = (bf16_t*)(ws + WS_XB);
    const int gw = F.vcu * NWAVES + F.wave, NGW = F.G * NWAVES;
#pragma unroll 1
    for (int k0 = 0; k0 < 16; k0 += 4) {
        u32x4 r0[4], r1[4]; int ee[4][2], rk[4][2];
#pragma unroll
        for (int q = 0; q < 4; ++q) { const int m = gw + (k0 + q) * NGW; r0[q] = *(const u32x4*)(HB + (size_t)m * DM + F.lane * 8); r1[q] = *(const u32x4*)(HB + (size_t)m * DM + 512 + F.lane * 8);
            ee[q][0] = TOKE[m * 2]; ee[q][1] = TOKE[m * 2 + 1]; rk[q][0] = TOKR[m * 2]; rk[q][1] = TOKR[m * 2 + 1]; }
#pragma unroll
        for (int q = 0; q < 4; ++q) { const int m = gw + (k0 + q) * NGW;
#pragma unroll
            for (int k = 0; k < 2; ++k) { const int e = ee[q][k], r = rk[q][k];
                int st = 0;
#pragma unroll
                for (int j = 1; j < 8; ++j) st = (e >= j) ? ts[j] : st;
                const int pos = st * 256 + wbase[e] + r;
                *(u32x4*)(XB + (size_t)pos * DM + F.lane * 8) = r0[q]; *(u32x4*)(XB + (size_t)pos * DM + 512 + F.lane * 8) = r1[q];
                if (F.lane == 0) TOKP[m * 2 + k] = pos; } }
    }
}

DEVI void phase_nsa_naive(Frame& F) {
    F.refresh();
    unsigned char* ws = F.ws;
    const bf16_t* Q = (const bf16_t*)(ws + RA_Q); bf16_t* ATT = (bf16_t*)(ws + RA_ATT);
    const bf16_t* KC = (const bf16_t*)(ws + RA_KC); const bf16_t* VC = (const bf16_t*)(ws + RA_VC);
    const bf16_t* KS = (const bf16_t*)(ws + RA_KS); const bf16_t* VS = (const bf16_t*)(ws + RA_VS);
    const bf16_t* KW = (const bf16_t*)(ws + RA_KW); const bf16_t* VW = (const bf16_t*)(ws + RA_VW);
    const float* GT = (const float*)(ws + RA_GATE); const float* CS = (const float*)(ws + WS_CS);
    LAS float* sc = (LAS float*)(F.lds + F.wave * 16384);
    LAS float* qs_ = (LAS float*)(F.lds + LDS_X + F.wave * 2048);
    LAS float* qr_ = qs_ + 256;
    const int lane = F.lane;
    const int gw = F.vcu * NWAVES + F.wave, NGW = F.G * NWAVES;
    for (int u = gw; u < MTOK * A_G; u += NGW) {
        const int bg = u / SEQ, t = u % SEQ, b = bg / A_G, g = bg % A_G; const int tok = b * SEQ + t;
        { const bf16_t* qp = Q + (size_t)tok * DM + g * 256 + lane * 4; const u32x2 w = *(const u32x2*)qp;
          float x[4] = {bflo(w.x), bfhi(w.x), bflo(w.y), bfhi(w.y)};
#pragma unroll
          for (int i = 0; i < 4; ++i) qs_[lane * 4 + i] = x[i];
          LDS_WAIT();
          const int d0 = (lane * 4) & 63;
#pragma unroll
          for (int i = 0; i < 4; ++i) { const int d = d0 + i; float v = x[i];
              if (d < 8) v = x[i] * CS[(size_t)tok * 16 + d] - qs_[lane * 4 + i + 8] * CS[(size_t)tok * 16 + 8 + d];
              else if (d < 16) v = x[i] * CS[(size_t)tok * 16 + d - 8] + qs_[lane * 4 + i - 8] * CS[(size_t)tok * 16 + d];
              qr_[lane * 4 + i] = v; }
          LDS_WAIT(); }
        float oc[4] = {0.f, 0.f, 0.f, 0.f}, os[4] = {0.f, 0.f, 0.f, 0.f}, ow[4] = {0.f, 0.f, 0.f, 0.f};
        const int cur = t >> 6;
        const int nv = t >= 31 ? ((t - 31) >> 4) + 1 : 0;
        float impv[4] = {0.f, 0.f, 0.f, 0.f};
        if (nv > 0) {
            const bf16_t* kc = KC + (size_t)bg * 1024 * 64; const bf16_t* vc = VC + (size_t)bg * 1024 * 64;
            float mx[4] = {-3.0e38f, -3.0e38f, -3.0e38f, -3.0e38f};
            for (int c = 0; c * 64 < nv; ++c) { const int n = c * 64 + lane;
                if (n < nv) { float s[4] = {0.f, 0.f, 0.f, 0.f}; LAS float* qs = qs_; asm volatile("" : "+v"(qs));
#pragma unroll 2
                    for (int d8 = 0; d8 < 8; ++d8) { const u32x4 w = *(const u32x4*)(kc + (size_t)n * 64 + d8 * 8);
                        const float kf[8] = {bflo(w.x), bfhi(w.x), bflo(w.y), bfhi(w.y), bflo(w.z), bfhi(w.z), bflo(w.w), bfhi(w.w)};
#pragma unroll
                        for (int r = 0; r < 4; ++r) { const f32x4 qa = *(const LAS f32x4*)(qs + r * 64 + d8 * 8), qb = *(const LAS f32x4*)(qs + r * 64 + d8 * 8 + 4);
                            s[r] += qa.x * kf[0] + qa.y * kf[1] + qa.z * kf[2] + qa.w * kf[3] + qb.x * kf[4] + qb.y * kf[5] + qb.z * kf[6] + qb.w * kf[7]; } }
#pragma unroll
                    for (int r = 0; r < 4; ++r) { s[r] *= QSCALE; mx[r] = fmaxf(mx[r], s[r]); }
                    *(LAS f32x4*)(sc + n * 4) = (f32x4){s[0], s[1], s[2], s[3]}; } }
            float l[4] = {0.f, 0.f, 0.f, 0.f};
#pragma unroll
            for (int r = 0; r < 4; ++r) mx[r] = wave_max(mx[r], lane);
            LDS_WAIT();
            for (int c = 0; c * 64 < nv; ++c) { const int n = c * 64 + lane;
                if (n < nv) { f32x4 s = *(const LAS f32x4*)(sc + n * 4);
#pragma unroll
                    for (int r = 0; r < 4; ++r) { s[r] = __expf(s[r] - mx[r]); l[r] += s[r]; }
                    *(LAS f32x4*)(sc + n * 4) = s; } }
#pragma unroll
            for (int r = 0; r < 4; ++r) l[r] = 1.f / wave_sum(l[r], lane);
            LDS_WAIT();
            for (int c = 0; c * 64 < nv; ++c) { const int n = c * 64 + lane;
                if (n < nv) { f32x4 s = *(const LAS f32x4*)(sc + n * 4);
#pragma unroll
                    for (int r = 0; r < 4; ++r) s[r] *= l[r];
                    *(LAS f32x4*)(sc + n * 4) = s; } }
            LDS_WAIT();
#pragma unroll 4
            for (int n = 0; n < nv; ++n) { const float v = bf2f(vc[(size_t)n * 64 + lane]); const f32x4 p = *(const LAS f32x4*)(sc + n * 4);
#pragma unroll
                for (int r = 0; r < 4; ++r) oc[r] += p[r] * v; }
#pragma unroll
            for (int i = 0; i < 4; ++i) { const int j = lane + 64 * i; float acc = 0.f;
#pragma unroll
                for (int k = -1; k <= 3; ++k) { const int n = 4 * j + k; if (n >= 0 && n < nv) { const f32x4 p = *(const LAS f32x4*)(sc + n * 4); const float ps = (p.x + p.y) + (p.z + p.w); acc += (k == -1 || k == 3) ? 0.5f * ps : ps; } }
                impv[i] = acc; }
        }
        float scv[4];
#pragma unroll
        for (int i = 0; i < 4; ++i) { const int j = lane + 64 * i; scv[i] = j > cur ? -1.f : ((j == 0 || j == cur || j == cur - 1) ? 1e9f : impv[i]); }
        LAS int* sel = (LAS int*)(F.lds + MISC_OFF + 256) + F.wave * 16;
#pragma unroll 1
        for (int k = 0; k < NSEL; ++k) {
            float bv = -2.f; int bi = 1 << 20;
#pragma unroll
            for (int i = 0; i < 4; ++i) { const int j = lane + 64 * i; if (scv[i] > bv) { bv = scv[i]; bi = j; } }
#pragma unroll
            for (int o = 1; o < 64; o <<= 1) { const float ov = shx(bv, o, lane); const int oi = shxi(bi, o, lane); if (ov > bv || (ov == bv && oi < bi)) { bv = ov; bi = oi; } }
            if (lane == 0) sel[k] = bi;
#pragma unroll
            for (int i = 0; i < 4; ++i) if (lane + 64 * i == bi) scv[i] = -3.f;
        }
        LDS_WAIT();
        {   const bf16_t* ks = KS + (size_t)bg * SEQ * 64; const bf16_t* vs = VS + (size_t)bg * SEQ * 64;
            float mx[4] = {-3.0e38f, -3.0e38f, -3.0e38f, -3.0e38f};
#pragma unroll 1
            for (int k = 0; k < NSEL; ++k) { const int pos = sel[k] * 64 + lane; const bool ok = pos <= t;
                float s[4] = {-1e30f, -1e30f, -1e30f, -1e30f};
                if (ok) { LAS float* qr = qr_; asm volatile("" : "+v"(qr));
#pragma unroll
                    for (int r = 0; r < 4; ++r) s[r] = 0.f;
#pragma unroll 2
                    for (int d8 = 0; d8 < 8; ++d8) { const u32x4 w = *(const u32x4*)(ks + (size_t)pos * 64 + d8 * 8);
                        const float kf[8] = {bflo(w.x), bfhi(w.x), bflo(w.y), bfhi(w.y), bflo(w.z), bfhi(w.z), bflo(w.w), bfhi(w.w)};
#pragma unroll
                        for (int r = 0; r < 4; ++r) { const f32x4 qa = *(const LAS f32x4*)(qr + r * 64 + d8 * 8), qb = *(const LAS f32x4*)(qr + r * 64 + d8 * 8 + 4);
                            s[r] += qa.x * kf[0] + qa.y * kf[1] + qa.z * kf[2] + qa.w * kf[3] + qb.x * kf[4] + qb.y * kf[5] + qb.z * kf[6] + qb.w * kf[7]; } }
#pragma unroll
                    for (int r = 0; r < 4; ++r) { s[r] *= QSCALE; mx[r] = fmaxf(mx[r], s[r]); } }
                *(LAS f32x4*)(sc + (k * 64 + lane) * 4) = (f32x4){s[0], s[1], s[2], s[3]}; }
            float l[4] = {0.f, 0.f, 0.f, 0.f};
#pragma unroll
            for (int r = 0; r < 4; ++r) mx[r] = wave_max(mx[r], lane);
            LDS_WAIT();
#pragma unroll 1
            for (int k = 0; k < NSEL; ++k) { const int pos = sel[k] * 64 + lane; const bool ok = pos <= t; f32x4 s = *(const LAS f32x4*)(sc + (k * 64 + lane) * 4);
#pragma unroll
                for (int r = 0; r < 4; ++r) { s[r] = ok ? __expf(s[r] - mx[r]) : 0.f; l[r] += s[r]; }
                *(LAS f32x4*)(sc + (k * 64 + lane) * 4) = s; }
#pragma unroll
            for (int r = 0; r < 4; ++r) l[r] = 1.f / wave_sum(l[r], lane);
            LDS_WAIT();
#pragma unroll 1
            for (int k = 0; k < NSEL; ++k) { const int p0 = sel[k] * 64; if (p0 > t) continue;
#pragma unroll 4
                for (int i = 0; i < 64; ++i) { const int pos = p0 + i; if (pos > t) break; const float v = bf2f(vs[(size_t)pos * 64 + lane]); const f32x4 p = *(const LAS f32x4*)(sc + (k * 64 + i) * 4);
#pragma unroll
                    for (int r = 0; r < 4; ++r) os[r] += p[r] * v; } }
#pragma unroll
            for (int r = 0; r < 4; ++r) os[r] *= l[r];
            LDS_WAIT();
        }
        {   const bf16_t* kw = KW + (size_t)bg * SEQ * 64; const bf16_t* vw = VW + (size_t)bg * SEQ * 64;
            float mx[4] = {-3.0e38f, -3.0e38f, -3.0e38f, -3.0e38f};
#pragma unroll 1
            for (int c = 0; c < 8; ++c) { const int pos = t - 511 + c * 64 + lane; const bool ok = pos >= 0;
                float s[4] = {-1e30f, -1e30f, -1e30f, -1e30f};
                if (ok) { LAS float* qr = qr_; asm volatile("" : "+v"(qr));
#pragma unroll
                    for (int r = 0; r < 4; ++r) s[r] = 0.f;
#pragma unroll 2
                    for (int d8 = 0; d8 < 8; ++d8) { const u32x4 w = *(const u32x4*)(kw + (size_t)pos * 64 + d8 * 8);
                        const float kf[8] = {bflo(w.x), bfhi(w.x), bflo(w.y), bfhi(w.y), bflo(w.z), bfhi(w.z), bflo(w.w), bfhi(w.w)};
#pragma unroll
                        for (int r = 0; r < 4; ++r) { const f32x4 qa = *(const LAS f32x4*)(qr + r * 64 + d8 * 8), qb = *(const LAS f32x4*)(qr + r * 64 + d8 * 8 + 4);
                            s[r] += qa.x * kf[0] + qa.y * kf[1] + qa.z * kf[2] + qa.w * kf[3] + qb.x * kf[4] + qb.y * kf[5] + qb.z * kf[6] + qb.w * kf[7]; } }
#pragma unroll
                    for (int r = 0; r < 4; ++r) { s[r] *= QSCALE; mx[r] = fmaxf(mx[r], s[r]); } }
                *(LAS f32x4*)(sc + (c * 64 + lane) * 4) = (f32x4){s[0], s[1], s[2], s[3]}; }
            float l[4] = {0.f, 0.f, 0.f, 0.f};
#pragma unroll
            for (int r = 0; r < 4; ++r) mx[r] = wave_max(mx[r], lane);
            LDS_WAIT();
#pragma unroll 1
            for (int c = 0; c < 8; ++c) { const int pos = t - 511 + c * 64 + lane; const bool ok = pos >= 0; f32x4 s = *(const LAS f32x4*)(sc + (c * 64 + lane) * 4);
#pragma unroll
                for (int r = 0; r < 4; ++r) { s[r] = ok ? __expf(s[r] - mx[r]) : 0.f; l[r] += s[r]; }
                *(LAS f32x4*)(sc + (c * 64 + lane) * 4) = s; }
#pragma unroll
            for (int r = 0; r < 4; ++r) l[r] = 1.f / wave_sum(l[r], lane);
            LDS_WAIT();
#pragma unroll 4
            for (int i = (t >= 511 ? 0 : 511 - t); i < 512; ++i) { const int pos = t - 511 + i; const float v = bf2f(vw[(size_t)pos * 64 + lane]); const f32x4 p = *(const LAS f32x4*)(sc + i * 4);
#pragma unroll
                for (int r = 0; r < 4; ++r) ow[r] += p[r] * v; }
#pragma unroll
            for (int r = 0; r < 4; ++r) ow[r] *= l[r];
            LDS_WAIT();
        }
#pragma unroll
        for (int r = 0; r < 4; ++r) { const float gc = GT[(size_t)tok * 48 + 0 * 16 + g * 4 + r], gs = GT[(size_t)tok * 48 + 1 * 16 + g * 4 + r], gwv = GT[(size_t)tok * 48 + 2 * 16 + g * 4 + r];
            const float o = ((DBG_DROP & 1) ? 0.f : gc * oc[r]) + ((DBG_DROP & 2) ? 0.f : gs * os[r]) + ((DBG_DROP & 4) ? 0.f : gwv * ow[r]);
            ATT[(size_t)tok * DM + g * 256 + r * 64 + lane] = (bf16_t)f2bf(o); }
    }
}

DEVI void phase_swa_naive(Frame& F, const float* sinks) {
    F.refresh();
    unsigned char* ws = F.ws;
    const bf16_t* Q = (const bf16_t*)(ws + RA_Q); bf16_t* ATT = (bf16_t*)(ws + RA_ATT);
    const bf16_t* KS = (const bf16_t*)(ws + WS_KSH); const bf16_t* VS = (const bf16_t*)(ws + WS_VSH);
    LAS float* sc = (LAS float*)(F.lds + F.wave * 16384);
    LAS float* qs_ = (LAS float*)(F.lds + LDS_X + F.wave * 2048);
    const int lane = F.lane;
    const int gw = F.vcu * NWAVES + F.wave, NGW = F.G * NWAVES;
    for (int u = gw; u < MTOK * B_G; u += NGW) {
        const int bg = u / SEQ, t = u % SEQ, b = bg / B_G, g = bg % B_G; const int tok = b * SEQ + t;
        { const u32x4 w = *(const u32x4*)(Q + (size_t)tok * DM + g * 512 + lane * 8);
          const float x[8] = {bflo(w.x), bfhi(w.x), bflo(w.y), bfhi(w.y), bflo(w.z), bfhi(w.z), bflo(w.w), bfhi(w.w)};
#pragma unroll
          for (int i = 0; i < 8; ++i) qs_[lane * 8 + i] = x[i];
          LDS_WAIT(); }
        const bf16_t* kp = KS + (size_t)bg * SEQ * 64; const bf16_t* vp = VS + (size_t)bg * SEQ * 64;
        float mx[8], l[8], o[8];
#pragma unroll
        for (int r = 0; r < 8; ++r) { mx[r] = sinks[g * 8 + r]; l[r] = 0.f; o[r] = 0.f; }
#pragma unroll 1
        for (int c = 0; c < 2; ++c) { const int pos = t - 127 + c * 64 + lane; const bool ok = pos >= 0;
            float s[8];
#pragma unroll
            for (int r = 0; r < 8; ++r) s[r] = -1e30f;
            if (ok) { LAS float* qs = qs_; asm volatile("" : "+v"(qs));
#pragma unroll
                for (int r = 0; r < 8; ++r) s[r] = 0.f;
#pragma unroll 1
                for (int d8 = 0; d8 < 8; ++d8) { const u32x4 w = *(const u32x4*)(kp + (size_t)pos * 64 + d8 * 8);
                    const float kf[8] = {bflo(w.x), bfhi(w.x), bflo(w.y), bfhi(w.y), bflo(w.z), bfhi(w.z), bflo(w.w), bfhi(w.w)};
#pragma unroll
                    for (int r = 0; r < 8; ++r) { const f32x4 qa = *(const LAS f32x4*)(qs + r * 64 + d8 * 8), qb = *(const LAS f32x4*)(qs + r * 64 + d8 * 8 + 4);
                        s[r] += qa.x * kf[0] + qa.y * kf[1] + qa.z * kf[2] + qa.w * kf[3] + qb.x * kf[4] + qb.y * kf[5] + qb.z * kf[6] + qb.w * kf[7]; } }
#pragma unroll
                for (int r = 0; r < 8; ++r) { s[r] *= QSCALE; mx[r] = fmaxf(mx[r], s[r]); } }
            *(LAS f32x4*)(sc + (c * 64 + lane) * 8) = (f32x4){s[0], s[1], s[2], s[3]}; *(LAS f32x4*)(sc + (c * 64 + lane) * 8 + 4) = (f32x4){s[4], s[5], s[6], s[7]}; }
#pragma unroll
        for (int r = 0; r < 8; ++r) mx[r] = wave_max(mx[r], lane);
        LDS_WAIT();
#pragma unroll
        for (int c = 0; c < 2; ++c) { const int pos = t - 127 + c * 64 + lane; const bool ok = pos >= 0;
            f32x4 s0 = *(const LAS f32x4*)(sc + (c * 64 + lane) * 8), s1 = *(const LAS f32x4*)(sc + (c * 64 + lane) * 8 + 4);
#pragma unroll
            for (int r = 0; r < 4; ++r) { s0[r] = ok ? __expf(s0[r] - mx[r]) : 0.f; l[r] += s0[r]; s1[r] = ok ? __expf(s1[r] - mx[r + 4]) : 0.f; l[r + 4] += s1[r]; }
            *(LAS f32x4*)(sc + (c * 64 + lane) * 8) = s0; *(LAS f32x4*)(sc + (c * 64 + lane) * 8 + 4) = s1; }
#pragma unroll
        for (int r = 0; r < 8; ++r) l[r] = 1.f / (wave_sum(l[r], lane) + __expf(sinks[g * 8 + r] - mx[r]));
        LDS_WAIT();
#pragma unroll 4
        for (int i = (t >= 127 ? 0 : 127 - t); i < 128; ++i) { const int pos = t - 127 + i; const float v = bf2f(vp[(size_t)pos * 64 + lane]);
            const f32x4 p0 = *(const LAS f32x4*)(sc + i * 8), p1 = *(const LAS f32x4*)(sc + i * 8 + 4);
#pragma unroll
            for (int r = 0; r < 4; ++r) { o[r] += p0[r] * v; o[r + 4] += p1[r] * v; } }
#pragma unroll
        for (int r = 0; r < 8; ++r) ATT[(size_t)tok * DM + g * 512 + r * 64 + lane] = (bf16_t)f2bf(o[r] * l[r]);
        LDS_WAIT();
    }
}

namespace fa {
typedef short v4i16_t __attribute__((ext_vector_type(4)));
constexpr float CEXP = 0.125f * 1.4426950408889634f;
constexpr float NEGINF = -__builtin_huge_valf();
constexpr int VLD = 160;
constexpr int KVB = 8192 + 64 * VLD;
constexpr int L_KV = 0;
constexpr int L_IMP = 2 * KVB;
constexpr int IMP_LD = 264;
constexpr int OS_LD = 65;
constexpr int L_Q = L_IMP + 64 * IMP_LD * 4;
constexpr int L_ML = L_Q + 32768;
constexpr int L_MASK = L_ML + 2048;
constexpr int L_LIST = L_MASK + 2048;
constexpr int L_TOK = L_LIST + 1056;
constexpr int L_END = L_TOK + 2048;
static_assert(256 * OS_LD * 4 <= 64 * IMP_LD * 4, "accumulator fits the importance table");
static_assert(L_END <= MISC_OFF, "attention LDS map");

struct Stage { u32x4 k, v; };
template <bool WITHV> DEVI void stage_load(Stage& s, const bf16_t* K, const bf16_t* V, int tid) { s.k = *(const u32x4*)((const char*)K + tid * 16); if (WITHV) s.v = *(const u32x4*)((const char*)V + tid * 16); }
template <bool WITHV> DEVI void stage_write(const Stage& s, LAS unsigned char* buf, int tid) {
    const int r = tid >> 3, c = tid & 7;
    *(LAS u32x4*)(buf + r * 128 + ((c ^ (r & 7)) << 4)) = s.k;
    if (WITHV) *(LAS u32x4*)(buf + 8192 + r * VLD + (c << 4)) = s.v;
}
DEVI float max_quads(float x) {
    auto a = __builtin_amdgcn_permlane16_swap(__float_as_uint(x), __float_as_uint(x), false, false); x = fmaxf(__uint_as_float(a[0]), __uint_as_float(a[1]));
    auto b = __builtin_amdgcn_permlane32_swap(__float_as_uint(x), __float_as_uint(x), false, false); return fmaxf(__uint_as_float(b[0]), __uint_as_float(b[1]));
}
DEVI float sum_quads(float x) {
    auto a = __builtin_amdgcn_permlane16_swap(__float_as_uint(x), __float_as_uint(x), false, false); x = __uint_as_float(a[0]) + __uint_as_float(a[1]);
    auto b = __builtin_amdgcn_permlane32_swap(__float_as_uint(x), __float_as_uint(x), false, false); return __uint_as_float(b[0]) + __uint_as_float(b[1]);
}
template <int CTRL> DEVI float dppf(float v) { return __int_as_float(__builtin_amdgcn_update_dpp(0, __float_as_int(v), CTRL, 0xF, 0xF, false)); }
template <int CTRL> DEVI int dppi(int v) { return __builtin_amdgcn_update_dpp(0, v, CTRL, 0xF, 0xF, false); }
DEVI float bperm(float v, int src_lane) { return __builtin_bit_cast(float, __builtin_amdgcn_ds_bpermute(src_lane << 2, __builtin_bit_cast(int, v))); }
#define DPP_X1 0xB1
#define DPP_X2 0x4E
#define DPP_HM 0x141

DEVI void qk_slot(LAS const unsigned char* kb, const bf16x8 q0, const bf16x8 q1, int lane, f32x4 (&s)[4]) {
    const int l15 = lane & 15, quad = lane >> 4;
    LAS const unsigned char* p0 = kb + l15 * 128 + (((quad) ^ (l15 & 7)) << 4);
    LAS const unsigned char* p1 = kb + l15 * 128 + (((4 + quad) ^ (l15 & 7)) << 4);
#pragma unroll
    for (int kg = 0; kg < 4; ++kg) {
        const bf16x8 a0 = *(LAS const bf16x8*)(p0 + kg * 2048), a1 = *(LAS const bf16x8*)(p1 + kg * 2048);
        f32x4 z = {0.f, 0.f, 0.f, 0.f};
        z = __builtin_amdgcn_mfma_f32_16x16x32_bf16(a0, q0, z, 0, 0, 0);
        s[kg] = __builtin_amdgcn_mfma_f32_16x16x32_bf16(a1, q1, z, 0, 0, 0);
    }
}
DEVI float mask_max(f32x4 (&s)[4], int lo, int hi, int quad) {
    float mx = NEGINF; const int loq = lo - 4 * quad, hiq = hi - 4 * quad;
#pragma unroll
    for (int kg = 0; kg < 4; ++kg)
#pragma unroll
        for (int i = 0; i < 4; ++i) { const bool ok = (16 * kg + i >= loq) & (16 * kg + i <= hiq); s[kg][i] = ok ? s[kg][i] : NEGINF; mx = fmaxf(mx, s[kg][i]); }
    return max_quads(mx);
}
DEVI bf16x8 pack_p(const f32x4 a, const f32x4 b) { u32x4 w; w.x = pg8::cvt_pk_bf16(a[0], a[1]); w.y = pg8::cvt_pk_bf16(a[2], a[3]); w.z = pg8::cvt_pk_bf16(b[0], b[1]); w.w = pg8::cvt_pk_bf16(b[2], b[3]); return __builtin_bit_cast(bf16x8, w); }
DEVI void pv_slot(LAS const unsigned char* vb, const bf16x8 (&pb)[2], f32x4 (&o)[4], int lane) {
    const int i = lane & 15, quad = lane >> 4;
    LAS const unsigned char* a0 = vb + (4 * quad + (i >> 2)) * VLD + ((i & 3) << 3);
#pragma unroll
    for (int ks2 = 0; ks2 < 2; ++ks2) {
#pragma unroll
        for (int dg = 0; dg < 4; ++dg) {
            const v4i16_t t0 = __builtin_amdgcn_ds_read_tr16_b64_v4i16((LAS v4i16_t*)(a0 + (32 * ks2) * VLD + 32 * dg));
            const v4i16_t t1 = __builtin_amdgcn_ds_read_tr16_b64_v4i16((LAS v4i16_t*)(a0 + (32 * ks2 + 16) * VLD + 32 * dg));
            const bf16x8 a = {t0[0], t0[1], t0[2], t0[3], t1[0], t1[1], t1[2], t1[3]};
            o[dg] = __builtin_amdgcn_mfma_f32_16x16x32_bf16(a, pb[ks2], o[dg], 0, 0, 0);
        }
    }
}
template <bool PV> DEVI void online_step(LAS const unsigned char* buf, const bf16x8 q0, const bf16x8 q1, int lo, int hi, float& m, float& l, f32x4 (&o)[4], int lane) {
    __builtin_amdgcn_sched_barrier(0);
    f32x4 s[4]; qk_slot(buf, q0, q1, lane, s);
    __builtin_amdgcn_sched_barrier(0);
    const int quad = lane >> 4;
    float mx;
    if (__builtin_amdgcn_ballot_w64((lo > 0) | (hi < 63)) != 0ull) mx = mask_max(s, lo, hi, quad);
    else { float a = fmaxf(fmaxf(s[0][0], s[0][1]), fmaxf(s[0][2], s[0][3])), b = fmaxf(fmaxf(s[1][0], s[1][1]), fmaxf(s[1][2], s[1][3]));
           a = fmaxf(a, fmaxf(fmaxf(s[2][0], s[2][1]), fmaxf(s[2][2], s[2][3]))); b = fmaxf(b, fmaxf(fmaxf(s[3][0], s[3][1]), fmaxf(s[3][2], s[3][3]))); mx = max_quads(fmaxf(a, b)); }
    const float mnew = fmaxf(m, mx);
    const float msafe = (mnew == NEGINF) ? 0.f : mnew;
    const float alpha = __builtin_amdgcn_exp2f((m - msafe) * CEXP);
    const float mc = -msafe * CEXP;
    float ps = 0.f;
#pragma unroll
    for (int kg = 0; kg < 4; ++kg)
#pragma unroll
        for (int i = 0; i < 4; ++i) { s[kg][i] = __builtin_amdgcn_exp2f(__builtin_fmaf(s[kg][i], CEXP, mc)); ps += s[kg][i]; }
    l = l * alpha + ps; m = mnew;
    if (PV) {
        if (__builtin_amdgcn_ballot_w64(alpha != 1.f) != 0ull) {
#pragma unroll
            for (int dg = 0; dg < 4; ++dg) o[dg] = o[dg] * alpha;
        }
        bf16x8 pb[2]; pb[0] = pack_p(s[0], s[1]); pb[1] = pack_p(s[2], s[3]);
        pv_slot(buf + 8192, pb, o, lane);
    }
    __builtin_amdgcn_sched_barrier(0);
}
DEVI void load_q(const bf16_t* Q, size_t tok, int hcol, int quad, bf16x8 (&qf)[2]) {
    const bf16_t* p = Q + tok * DM + hcol + quad * 8;
    qf[0] = *(const bf16x8*)p; qf[1] = *(const bf16x8*)(p + 32);
}
DEVI bf16x8 rope_frag(const bf16x8 q, const float* csrow, int quad, int lane) {
    const u32x4 w = __builtin_bit_cast(u32x4, q); u32x4 pw;
#pragma unroll
    for (int i = 0; i < 4; ++i) pw[i] = (unsigned)shxi((int)w[i], 16, lane);
    if (quad >= 2) return q;
    const f32x4 c0 = *(const f32x4*)csrow, c1 = *(const f32x4*)(csrow + 4), s0 = *(const f32x4*)(csrow + 8), s1 = *(const f32x4*)(csrow + 12);
    const float sg = quad == 0 ? -1.f : 1.f;
    float x[8], xp[8];
#pragma unroll
    for (int i = 0; i < 4; ++i) { x[2 * i] = bflo(w[i]); x[2 * i + 1] = bfhi(w[i]); xp[2 * i] = bflo(pw[i]); xp[2 * i + 1] = bfhi(pw[i]); }
    const float cc[8] = {c0[0], c0[1], c0[2], c0[3], c1[0], c1[1], c1[2], c1[3]}, ss[8] = {s0[0], s0[1], s0[2], s0[3], s1[0], s1[1], s1[2], s1[3]};
    u32x4 o;
#pragma unroll
    for (int i = 0; i < 4; ++i) o[i] = pg8::cvt_pk_bf16(x[2 * i] * cc[2 * i] + sg * xp[2 * i] * ss[2 * i], x[2 * i + 1] * cc[2 * i + 1] + sg * xp[2 * i + 1] * ss[2 * i + 1]);
    return __builtin_bit_cast(bf16x8, o);
}

struct KFr { bf16x8 k[4][2]; };
struct VFr { bf16x8 v[4][2]; };
constexpr float LSCALE = 1048576.f;
template <int OFF> DEVI void gld16(bf16x8& d, const void* p) { asm volatile("global_load_dwordx4 %0, %1, off offset:%2" : "=v"(d) : "v"(p), "n"(OFF) : "memory"); }
DEVI void sel_load_k(KFr& f, const bf16_t* KS, int j, int lane) {
    const int l15 = lane & 15, quad = lane >> 4;
    const bf16_t* p0 = KS + ((size_t)(64 * j + l15)) * 64 + 8 * quad;
    const bf16_t* p1 = p0 + 32 * 64;
    gld16<0>(f.k[0][0], p0); gld16<64>(f.k[0][1], p0); gld16<2048>(f.k[1][0], p0); gld16<2112>(f.k[1][1], p0);
    gld16<0>(f.k[2][0], p1); gld16<64>(f.k[2][1], p1); gld16<2048>(f.k[3][0], p1); gld16<2112>(f.k[3][1], p1);
}
DEVI void sel_load_v(VFr& f, const bf16_t* VT, int j, int lane) {
    const int l15 = lane & 15, quad = lane >> 4;
    const bf16_t* p = VT + (size_t)j * 4096 + l15 * 64 + 8 * quad;
    gld16<0>(f.v[0][0], p); gld16<64>(f.v[0][1], p); gld16<2048>(f.v[1][0], p); gld16<2112>(f.v[1][1], p);
    const bf16_t* p1 = p + 32 * 64;
    gld16<0>(f.v[2][0], p1); gld16<64>(f.v[2][1], p1); gld16<2048>(f.v[3][0], p1); gld16<2112>(f.v[3][1], p1);
}
template <int N> DEVI void sel_wait_k(KFr& f) {
    asm volatile("s_waitcnt vmcnt(%8)" : "+v"(f.k[0][0]), "+v"(f.k[0][1]), "+v"(f.k[1][0]), "+v"(f.k[1][1]), "+v"(f.k[2][0]), "+v"(f.k[2][1]), "+v"(f.k[3][0]), "+v"(f.k[3][1]) : "n"(N) : "memory");
    __builtin_amdgcn_sched_barrier(0);
}
template <int N> DEVI void sel_wait_kv(KFr& f, VFr& g) {
    asm volatile("s_waitcnt vmcnt(%16)" : "+v"(f.k[0][0]), "+v"(f.k[0][1]), "+v"(f.k[1][0]), "+v"(f.k[1][1]), "+v"(f.k[2][0]), "+v"(f.k[2][1]), "+v"(f.k[3][0]), "+v"(f.k[3][1]),
                 "+v"(g.v[0][0]), "+v"(g.v[0][1]), "+v"(g.v[1][0]), "+v"(g.v[1][1]), "+v"(g.v[2][0]), "+v"(g.v[2][1]), "+v"(g.v[3][0]), "+v"(g.v[3][1]) : "n"(N) : "memory");
    __builtin_amdgcn_sched_barrier(0);
}
template <bool PASS2> DEVI void sel_block(const KFr& f, const VFr& fv, int j, bool active, int cur, LAS const unsigned* smask, LAS const unsigned char* Ql, LAS float* mrow, LAS int* lrow, LAS int* Os, float lg2k, float lratio, LAS int* tlist, int lane) {
    const int l15 = lane & 15, quad = lane >> 4, mem = l15 >> 2;
    const bool forced = (j == 0) || (j >= cur - 1);
    int cnt = 0;
    if (active) {
        if (forced) cnt = 64;
        else { const unsigned lo = (unsigned)__builtin_amdgcn_readfirstlane((int)smask[2 * j]), hi = (unsigned)__builtin_amdgcn_readfirstlane((int)smask[2 * j + 1]);
            const unsigned long long mk = ((unsigned long long)hi << 32) | lo;
            cnt = __builtin_popcountll(mk);
            const bool mine = (mk >> lane) & 1ull; const int rank = __builtin_popcountll(mk & ((1ull << lane) - 1ull));
            if (mine) tlist[rank] = lane;
            LDS_WAIT(); }
    }
    const int ngroups = (cnt + 3) >> 2;
    const bool diag = (j == cur);
#pragma unroll 1
    for (int gi = 0; gi < ngroups; ++gi) {
        const int slot = 4 * gi + mem;
        const bool valid = slot < cnt;
        int mt = forced ? slot : tlist[slot];
        mt = valid ? mt : 0;
        const int row = mt * 4 + (l15 & 3);
        const bf16x8 q0 = *(LAS const bf16x8*)(Ql + row * 128 + ((quad ^ (row & 7)) << 4));
        const bf16x8 q1 = *(LAS const bf16x8*)(Ql + row * 128 + (((4 + quad) ^ (row & 7)) << 4));
        f32x4 sc[4];
#pragma unroll
        for (int kg = 0; kg < 4; ++kg) { f32x4 z = {0.f, 0.f, 0.f, 0.f}; z = __builtin_amdgcn_mfma_f32_16x16x32_bf16(f.k[kg][0], q0, z, 0, 0, 0); sc[kg] = __builtin_amdgcn_mfma_f32_16x16x32_bf16(f.k[kg][1], q1, z, 0, 0, 0); }
        if (!PASS2) {
            float mx;
            if (diag) mx = mask_max(sc, 0, mt, quad);
            else { float a = fmaxf(fmaxf(sc[0][0], sc[0][1]), fmaxf(sc[0][2], sc[0][3])), b = fmaxf(fmaxf(sc[1][0], sc[1][1]), fmaxf(sc[1][2], sc[1][3]));
                   a = fmaxf(a, fmaxf(fmaxf(sc[2][0], sc[2][1]), fmaxf(sc[2][2], sc[2][3]))); b = fmaxf(b, fmaxf(fmaxf(sc[3][0], sc[3][1]), fmaxf(sc[3][2], sc[3][3]))); mx = max_quads(fmaxf(a, b)); }
            if (quad == 0 && valid) __hip_atomic_fetch_max(mrow + row, mx, __ATOMIC_RELAXED, __HIP_MEMORY_SCOPE_WORKGROUP);
        } else {
            const float mc = lg2k - mrow[row] * CEXP;
            float ps = 0.f;
            if (diag) { const int hiq = mt - 4 * quad;
#pragma unroll
                for (int kg = 0; kg < 4; ++kg)
#pragma unroll
                    for (int i = 0; i < 4; ++i) { sc[kg][i] = (16 * kg + i <= hiq) ? __builtin_amdgcn_exp2f(__builtin_fmaf(sc[kg][i], CEXP, mc)) : 0.f; ps += sc[kg][i]; }
            } else {
#pragma unroll
                for (int kg = 0; kg < 4; ++kg)
#pragma unroll
                    for (int i = 0; i < 4; ++i) { sc[kg][i] = __builtin_amdgcn_exp2f(__builtin_fmaf(sc[kg][i], CEXP, mc)); ps += sc[kg][i]; }
            }
            ps = sum_quads(ps);
            if (quad == 0 && valid) __hip_atomic_fetch_add(lrow + row, (int)(ps * lratio), __ATOMIC_RELAXED, __HIP_MEMORY_SCOPE_WORKGROUP);
            bf16x8 pb[2]; pb[0] = pack_p(sc[0], sc[1]); pb[1] = pack_p(sc[2], sc[3]);
            LAS int* orow = Os + row * OS_LD + 4 * quad;
#pragma unroll
            for (int dh = 0; dh < 2; ++dh) {
                f32x4 o[2];
#pragma unroll
                for (int d2 = 0; d2 < 2; ++d2) { const int dg = dh * 2 + d2; f32x4 z = {0.f, 0.f, 0.f, 0.f}; z = __builtin_amdgcn_mfma_f32_16x16x32_bf16(fv.v[dg][0], pb[0], z, 0, 0, 0); o[d2] = __builtin_amdgcn_mfma_f32_16x16x32_bf16(fv.v[dg][1], pb[1], z, 0, 0, 0); }
                if (valid) {
#pragma unroll
                    for (int d2 = 0; d2 < 2; ++d2)
#pragma unroll
                        for (int c = 0; c < 4; ++c) __hip_atomic_fetch_add(orow + 16 * (dh * 2 + d2) + c, (int)o[d2][c], __ATOMIC_RELAXED, __HIP_MEMORY_SCOPE_WORKGROUP);
                }
                __builtin_amdgcn_sched_barrier(0);
            }
        }
    }
}
#define BL(i) __builtin_amdgcn_readfirstlane(blist[(i) < nb ? (i) : nb - 1])
DEVI void sel_pass1(const bf16_t* KS, int nb, int cur, int wave, LAS const int* blist, LAS const unsigned* smask, LAS const unsigned char* Ql, LAS float* mrow, LAS int* tlist, int lane) {
    if (wave >= nb) return;
    KFr k0, k1, k2; VFr vdummy;
    asm volatile("s_waitcnt vmcnt(0)" ::: "memory");
    sel_load_k(k0, KS, BL(wave), lane);
    sel_load_k(k1, KS, BL(wave + 8), lane);
#pragma unroll 1
    for (int bi = wave; bi < nb; bi += 24) {
        sel_load_k(k2, KS, BL(bi + 16), lane); sel_wait_k<16>(k0);
        sel_block<false>(k0, vdummy, BL(bi), true, cur, smask, Ql, mrow, nullptr, nullptr, 0.f, 0.f, tlist, lane);
        sel_load_k(k0, KS, BL(bi + 24), lane); sel_wait_k<16>(k1);
        sel_block<false>(k1, vdummy, BL(bi + 8), bi + 8 < nb, cur, smask, Ql, mrow, nullptr, nullptr, 0.f, 0.f, tlist, lane);
        sel_load_k(k1, KS, BL(bi + 32), lane); sel_wait_k<16>(k2);
        sel_block<false>(k2, vdummy, BL(bi + 16), bi + 16 < nb, cur, smask, Ql, mrow, nullptr, nullptr, 0.f, 0.f, tlist, lane);
    }
    asm volatile("s_waitcnt vmcnt(0)" ::: "memory");
}
DEVI void sel_pass2(const bf16_t* KS, const bf16_t* VT, int nb, int cur, int wave, LAS const int* blist, LAS const unsigned* smask, LAS const unsigned char* Ql, LAS float* mrow, LAS int* lrow, LAS int* Os, float lg2k, float lratio, LAS int* tlist, int lane) {
    if (wave >= nb) return;
    KFr ka_, kb_; VFr va_, vb_;
    asm volatile("s_waitcnt vmcnt(0)" ::: "memory");
    sel_load_k(ka_, KS, BL(wave), lane); sel_load_v(va_, VT, BL(wave), lane);
#pragma unroll 1
    for (int bi = wave; bi < nb; bi += 16) {
        sel_load_k(kb_, KS, BL(bi + 8), lane); sel_load_v(vb_, VT, BL(bi + 8), lane); sel_wait_kv<16>(ka_, va_);
        sel_block<true>(ka_, va_, BL(bi), true, cur, smask, Ql, mrow, lrow, Os, lg2k, lratio, tlist, lane);
        sel_load_k(ka_, KS, BL(bi + 16), lane); sel_load_v(va_, VT, BL(bi + 16), lane); sel_wait_kv<16>(kb_, vb_);
        sel_block<true>(kb_, vb_, BL(bi + 8), bi + 8 < nb, cur, smask, Ql, mrow, lrow, Os, lg2k, lratio, tlist, lane);
    }
    asm volatile("s_waitcnt vmcnt(0)" ::: "memory");
}
#undef BL
}


DEVI void phase_vs_transpose(Frame& F, int l) {
    F.refresh();
    unsigned char* ws = F.ws;
    const bf16_t* VS = (const bf16_t*)(ws + RA_VS); bf16_t* VT = (bf16_t*)(ws + RA_VST); const bf16_t* KSG = (const bf16_t*)(ws + RA_KS);
    LAS unsigned char* T = F.lds + F.wave * 9216;
    const int lane = F.lane, rr = lane >> 3, c = lane & 7, i16 = lane & 15, grp = lane >> 4;
    for (int it = ((int)blockIdx.x - 64) * NWAVES + F.wave; it < 2048; it += 192 * NWAVES) {
        const int bg = it >> 8, tile = it & 255;
        const bf16_t* vsrc = VS + ((size_t)bg * SEQ + tile * 64) * 64; const bf16_t* ksrc = KSG + ((size_t)bg * SEQ + tile * 64) * 64;
        u32x4 v[8], k[8];
#pragma unroll
        for (int i = 0; i < 8; ++i) { v[i] = *(const u32x4*)(vsrc + (size_t)(8 * i + rr) * 64 + c * 8); k[i] = *(const u32x4*)(ksrc + (size_t)(8 * i + rr) * 64 + c * 8); }
        float vmx = 0.f, kmx = 0.f;
#pragma unroll
        for (int i = 0; i < 8; ++i) { float n2 = 0.f;
#pragma unroll
            for (int e = 0; e < 4; ++e) { vmx = fmaxf(vmx, fmaxf(fabsf(bflo(v[i][e])), fabsf(bfhi(v[i][e])))); const float a = bflo(k[i][e]), b2 = bfhi(k[i][e]); n2 += a * a + b2 * b2; }
            n2 += fa::dppf<DPP_X1>(n2); n2 += fa::dppf<DPP_X2>(n2); n2 += fa::dppf<DPP_HM>(n2);
            kmx = fmaxf(kmx, n2);
            *(LAS u32x4*)(T + (8 * i + rr) * 144 + c * 16) = v[i]; }
        vmx = wave_max(vmx, lane); kmx = wave_max(kmx, lane);
        if (lane == 0) { atomicMax((unsigned*)(ws + WS_CTL) + CW_VMAX + l * 8 + bg, __float_as_uint(vmx)); atomicMax((unsigned*)(ws + WS_CTL) + CW_KMAX + l * 8 + bg, __float_as_uint(kmx)); }
        LDS_WAIT(); asm volatile("" ::: "memory");
        bf16_t* vdst = VT + ((size_t)bg * 256 + tile) * 4096;
#pragma unroll
        for (int n = 0; n < 16; ++n) { const int dc = n >> 2, kg4 = (n & 3) * 4 + grp;
            const fa::v4i16_t t = __builtin_amdgcn_ds_read_tr16_b64_v4i16((LAS fa::v4i16_t*)(T + (4 * kg4 + (i16 >> 2)) * 144 + (16 * dc + 4 * (i16 & 3)) * 2));
            const int p0 = 32 * (kg4 >> 3) + 8 * (kg4 & 3) + 4 * ((kg4 >> 2) & 1);
            *(fa::v4i16_t*)(vdst + (16 * dc + i16) * 64 + p0) = t; }
        LDS_WAIT(); asm volatile("" ::: "memory");
    }
}

DEVI void phase_nsa_fast(Frame& F, int layer) {
    using namespace fa;
    F.refresh();
    unsigned char* ws = F.ws;
    const bf16_t* Q = (const bf16_t*)(ws + RA_Q); bf16_t* ATT = (bf16_t*)(ws + RA_ATT);
    const float* GT = (const float*)(ws + RA_GATE); const float* CS = (const float*)(ws + WS_CS);
    const int wave = F.wave;
    LAS unsigned char* kvb = F.lds + L_KV;
    LAS float* imp = (LAS float*)(F.lds + L_IMP);
    LAS unsigned* smask = (LAS unsigned*)(F.lds + L_MASK);
    LAS int* blist = (LAS int*)(F.lds + L_LIST);
#pragma unroll 1
    for (int ui = 0; ui < 8; ++ui) {
        int lane = F.lane; asm volatile("" : "+v"(lane));
        const int tid = wave * 64 + lane, quad = lane >> 4, l15 = lane & 15;
        int tile = (F.vcu & 31) + 32 * (ui >> 1); if (ui & 1) tile = 255 - tile;
        const int bg = F.vcu >> 5, b = bg >> 2, g = bg & 3, cur = tile, t0 = tile * 64;
        const bf16_t* KC = (const bf16_t*)(ws + RA_KC) + (size_t)bg * 1024 * 64; const bf16_t* VC = (const bf16_t*)(ws + RA_VC) + (size_t)bg * 1024 * 64;
        const bf16_t* KS = (const bf16_t*)(ws + RA_KS) + (size_t)bg * SEQ * 64; const bf16_t* VS = (const bf16_t*)(ws + RA_VS) + (size_t)bg * SEQ * 64;
        const bf16_t* KW = (const bf16_t*)(ws + RA_KW) + (size_t)bg * SEQ * 64; const bf16_t* VW = (const bf16_t*)(ws + RA_VW) + (size_t)bg * SEQ * 64;
        smask[tid] = 0u;
        int tl[2], tok[2]; bf16x8 qf[2][2];
#pragma unroll
        for (int s = 0; s < 2; ++s) { tl[s] = 8 * wave + 4 * s + (l15 >> 2); tok[s] = b * SEQ + t0 + tl[s]; load_q(Q, (size_t)tok[s], g * 256 + (l15 & 3) * 64, quad, qf[s]); }
        float gate[2][3];
#pragma unroll
        for (int s = 0; s < 2; ++s)
#pragma unroll
            for (int br = 0; br < 3; ++br) gate[s][br] = GT[(size_t)tok[s] * 48 + br * 16 + g * 4 + (l15 & 3)];
        const float vmax = fmaxf(__uint_as_float(__hip_atomic_load((const unsigned*)(ws + WS_CTL) + CW_VMAX + layer * 8 + bg, __ATOMIC_RELAXED, __HIP_MEMORY_SCOPE_AGENT)), 1e-30f);
        bf16x8 qr[2][2];
#pragma unroll
        for (int s = 0; s < 2; ++s) { qr[s][0] = rope_frag(qf[s][0], CS + (size_t)tok[s] * 16, quad, lane); qr[s][1] = qf[s][1]; }
        f32x4 out[2][4];
#pragma unroll
        for (int s = 0; s < 2; ++s)
#pragma unroll
            for (int dg = 0; dg < 4; ++dg) out[s][dg] = (f32x4){0.f, 0.f, 0.f, 0.f};
        Stage st;
        const int ntile = (4 * cur + 3 + 63) >> 6;
        int nval[2];
#pragma unroll
        for (int s = 0; s < 2; ++s) { const int t = t0 + tl[s]; nval[s] = t >= 31 ? ((t - 31) >> 4) + 1 : 0; }
        float m[2] = {NEGINF, NEGINF}, l[2] = {0.f, 0.f};
        {   stage_load<false>(st, KC, VC, tid); stage_write<false>(st, kvb, tid); __syncthreads();
#pragma unroll 1
            for (int i = 0; i < ntile; ++i) {
                LAS unsigned char* buf = kvb + (i & 1) * KVB;
                if (i + 1 < ntile) stage_load<false>(st, KC + (size_t)(i + 1) * 4096, VC, tid); else stage_load<true>(st, KC, VC, tid);
#pragma unroll
                for (int s = 0; s < 2; ++s) { f32x4 dummy[4]; online_step<false>(buf, qf[s][0], qf[s][1], 0, nval[s] - 64 * i - 1, m[s], l[s], dummy, lane); }
                if (i + 1 < ntile) stage_write<false>(st, kvb + ((i + 1) & 1) * KVB, tid);
                __syncthreads();
            }
        }
        float invl[2], msafe[2];
#pragma unroll
        for (int s = 0; s < 2; ++s) { const float lt = sum_quads(l[s]); invl[s] = lt > 0.f ? 1.f / lt : 0.f; msafe[s] = (m[s] == NEGINF) ? 0.f : m[s]; }
#ifndef NO_P2
        const int jbw0 = cur >= 8 ? cur - 8 : 0;
        {   float gcv[2] = {gate[0][0], gate[1][0]};
            float carry[2] = {0.f, 0.f};
            stage_write<true>(st, kvb, tid); __syncthreads();
#pragma unroll 1
            for (int i = 0; i < ntile; ++i) {
                LAS unsigned char* buf = kvb + (i & 1) * KVB;
                if (i + 1 < ntile) stage_load<true>(st, KC + (size_t)(i + 1) * 4096, VC + (size_t)(i + 1) * 4096, tid); else stage_load<true>(st, KW + (size_t)jbw0 * 4096, VW + (size_t)jbw0 * 4096, tid);
#pragma unroll
                for (int s = 0; s < 2; ++s) {
                    __builtin_amdgcn_sched_barrier(0);
                    f32x4 sc[4]; qk_slot(buf, qf[s][0], qf[s][1], lane, sc);
                    __builtin_amdgcn_sched_barrier(0);
                    const int hiq = nval[s] - 64 * i - 1 - 4 * quad; const float mc2 = -msafe[s] * CEXP;
#pragma unroll
                    for (int kg = 0; kg < 4; ++kg)
#pragma unroll
                        for (int k = 0; k < 4; ++k) sc[kg][k] = (16 * kg + k <= hiq) ? __builtin_amdgcn_exp2f(__builtin_fmaf(sc[kg][k], CEXP, mc2)) * invl[s] : 0.f;
                    bf16x8 pb[2]; pb[0] = pack_p(sc[0] * gcv[s], sc[1] * gcv[s]); pb[1] = pack_p(sc[2] * gcv[s], sc[3] * gcv[s]);
#ifndef NO_IMP
#pragma unroll
                    for (int kg = 0; kg < 4; ++kg) {
                        float a = (sc[kg][0] + sc[kg][1]) + (sc[kg][2] + 0.5f * sc[kg][3]), bq = 0.5f * sc[kg][3];
                        a += dppf<DPP_X1>(a); a += dppf<DPP_X2>(a); bq += dppf<DPP_X1>(bq); bq += dppf<DPP_X2>(bq);
                        const float fromprev = bperm(bq, (lane - 16) & 63);
                        const float add = quad == 0 ? carry[s] : fromprev;
                        carry[s] = bperm(bq, (lane + 48) & 63);
                        if ((l15 & 3) == 0) imp[(8 * wave + 4 * s + (l15 >> 2)) * IMP_LD + 16 * i + 4 * kg + quad] = a + add;
                    }
#endif
                    __builtin_amdgcn_sched_barrier(0);
                    pv_slot(buf + 8192, pb, out[s], lane);
                    __builtin_amdgcn_sched_barrier(0);
                }
                if (i + 1 < ntile) stage_write<true>(st, kvb + ((i + 1) & 1) * KVB, tid);
                __syncthreads();
            }
        }
#endif
#ifndef NO_TOPK
        {   const int tl8 = lane >> 3, chunk = lane & 7, trow = (8 * wave + tl8) * IMP_LD;
            const int ncand = cur - 2;
            const int wsel = ((8 * wave + tl8) >> 5), bsel = (8 * wave + tl8) & 31;
            if (ncand > 0 && ncand <= 13) {
#pragma unroll
                for (int i = 0; i < 2; ++i) { const int j = 8 * i + chunk; if (j >= 1 && j <= cur - 2) __hip_atomic_fetch_or(smask + j * 2 + wsel, 1u << bsel, __ATOMIC_RELAXED, __HIP_MEMORY_SCOPE_WORKGROUP); }
            } else if (ncand > 13) {
                float lv[13]; int li[13];
#pragma unroll
                for (int k = 0; k < 13; ++k) { lv[k] = -1.f; li[k] = 1 << 20; }
                const int imax = (cur - 2) >> 3;
#pragma unroll 1
                for (int i = 0; i <= imax; ++i) {
                    const int j = 8 * i + chunk; float x = (j >= 1 && j <= cur - 2) ? imp[trow + j] : -1.f; int xi = j;
                    if (__builtin_amdgcn_ballot_w64(x > lv[12]) != 0ull) {
#pragma unroll
                        for (int k = 0; k < 13; ++k) { const bool gt = x > lv[k]; const float tv = gt ? lv[k] : x; const int ti = gt ? li[k] : xi; lv[k] = gt ? x : lv[k]; li[k] = gt ? xi : li[k]; x = tv; xi = ti; }
                    }
                }
#pragma unroll 1
                for (int r = 0; r < 13; ++r) {
                    float bv = lv[0]; int bi = li[0];
                    { const float ov = dppf<DPP_X1>(bv); const int oi = dppi<DPP_X1>(bi); if (ov > bv || (ov == bv && oi < bi)) { bv = ov; bi = oi; } }
                    { const float ov = dppf<DPP_X2>(bv); const int oi = dppi<DPP_X2>(bi); if (ov > bv || (ov == bv && oi < bi)) { bv = ov; bi = oi; } }
                    { const float ov = dppf<DPP_HM>(bv); const int oi = dppi<DPP_HM>(bi); if (ov > bv || (ov == bv && oi < bi)) { bv = ov; bi = oi; } }
                    if (li[0] == bi) {
#pragma unroll
                        for (int k = 0; k < 12; ++k) { lv[k] = lv[k + 1]; li[k] = li[k + 1]; }
                        lv[12] = -1.f; li[12] = 1 << 20;
                    }
                    if (chunk == 0 && bv >= 0.f) __hip_atomic_fetch_or(smask + bi * 2 + wsel, 1u << bsel, __ATOMIC_RELAXED, __HIP_MEMORY_SCOPE_WORKGROUP);
                }
            }
        }
#endif
        __syncthreads();
        if (wave == 0) {
            int base = 0;
#pragma unroll 1
            for (int r = 0; r < 4; ++r) { const int j = 64 * r + lane; const bool on = (j <= cur) && (j == 0 || j >= cur - 1 || (smask[j * 2] | smask[j * 2 + 1]) != 0u);
                const unsigned long long bal = __builtin_amdgcn_ballot_w64(on); const int pos = base + __builtin_popcountll(bal & ((1ull << lane) - 1ull));
                if (on) blist[pos] = j; base += __builtin_popcountll(bal); }
            if (lane == 0) blist[259] = base;
        }
        __syncthreads();
        LAS float* stashf = imp + wave * 2048 + lane;
#pragma unroll
        for (int s = 0; s < 2; ++s)
#pragma unroll
            for (int dg = 0; dg < 4; ++dg)
#pragma unroll
                for (int c = 0; c < 4; ++c) stashf[(s * 16 + dg * 4 + c) * 64] = out[s][dg][c];
        {   const int jb0 = jbw0, nb = cur - jb0 + 1;
            f32x4 ob[2][4]; float mm[2] = {NEGINF, NEGINF}, ll[2] = {0.f, 0.f};
#pragma unroll
            for (int s = 0; s < 2; ++s)
#pragma unroll
                for (int dg = 0; dg < 4; ++dg) ob[s][dg] = (f32x4){0.f, 0.f, 0.f, 0.f};
            stage_write<true>(st, kvb, tid); __syncthreads();
#pragma unroll 1
            for (int i = 0; i < nb; ++i) {
                LAS unsigned char* buf = kvb + (i & 1) * KVB;
                const int j = jb0 + i;
                if (i + 1 < nb) stage_load<true>(st, KW + (size_t)(j + 1) * 4096, VW + (size_t)(j + 1) * 4096, tid);
#pragma unroll
                for (int s = 0; s < 2; ++s) {
                    const int lo = (j == cur - 8) ? tl[s] + 1 : 0, hi = (j == cur) ? tl[s] : 63;
                    online_step<true>(buf, qr[s][0], qr[s][1], lo, hi, mm[s], ll[s], ob[s], lane);
                }
                if (i + 1 < nb) stage_write<true>(st, kvb + ((i + 1) & 1) * KVB, tid);
                __syncthreads();
            }
#pragma unroll
            for (int s = 0; s < 2; ++s) { const float lt = sum_quads(ll[s]); const float gw = gate[s][2] * (lt > 0.f ? 1.f / lt : 0.f);
#pragma unroll
                for (int dg = 0; dg < 4; ++dg)
#pragma unroll
                    for (int c = 0; c < 4; ++c) out[s][dg][c] = stashf[(s * 16 + dg * 4 + c) * 64] + ob[s][dg][c] * gw; }
        }
        LAS unsigned* stashb = (LAS unsigned*)(F.lds + L_KV) + wave * 1024 + lane;
        LAS unsigned char* Ql = F.lds + L_Q;
        LAS float* mrow = (LAS float*)(F.lds + L_ML); LAS int* lrow = (LAS int*)(mrow + 256);
        LAS int* Os = (LAS int*)imp;
        const float oscale = 1048576.f / vmax;
#pragma unroll
        for (int s = 0; s < 2; ++s) {
#pragma unroll
            for (int dg = 0; dg < 4; ++dg) { stashb[((s * 4 + dg) * 2 + 0) * 64] = pg8::cvt_pk_bf16(out[s][dg][0], out[s][dg][1]); stashb[((s * 4 + dg) * 2 + 1) * 64] = pg8::cvt_pk_bf16(out[s][dg][2], out[s][dg][3]); }
            const int row = tl[s] * 4 + (l15 & 3);
            *(LAS bf16x8*)(Ql + row * 128 + ((quad ^ (row & 7)) << 4)) = qr[s][0];
            *(LAS bf16x8*)(Ql + row * 128 + (((4 + quad) ^ (row & 7)) << 4)) = qr[s][1];
        }
        __syncthreads();
        for (int i = lane; i < 32 * OS_LD; i += 64) Os[wave * 32 * OS_LD + i] = 0;
        if (lane < 32) lrow[wave * 32 + lane] = 0;
        {
            const float kmax2 = __uint_as_float(__hip_atomic_load((const unsigned*)(ws + WS_CTL) + CW_KMAX + layer * 8 + bg, __ATOMIC_RELAXED, __HIP_MEMORY_SCOPE_AGENT));
#pragma unroll
            for (int s = 0; s < 2; ++s) { float n2 = 0.f;
#pragma unroll
                for (int ks = 0; ks < 2; ++ks) { const u32x4 w = __builtin_bit_cast(u32x4, qr[s][ks]);
#pragma unroll
                    for (int e = 0; e < 4; ++e) { const float a = bflo(w[e]), b2 = bfhi(w[e]); n2 += a * a + b2 * b2; } }
                n2 = sum_quads(n2);
                if (quad == 0) mrow[tl[s] * 4 + (l15 & 3)] = sqrtf(n2 * kmax2) * 1.0001f; } }
        __syncthreads();
        {   const int nb = blist[259];
            int lane2 = lane; asm volatile("" : "+v"(lane2));
            const bf16_t* VT = (const bf16_t*)(ws + RA_VST) + (size_t)bg * 256 * 4096;
            LAS int* tlist = (LAS int*)(F.lds + L_TOK) + wave * 64;
            asm volatile("" : "+v"(lane2));
            sel_pass2(KS, VT, nb, cur, wave, blist, smask, Ql, mrow, lrow, Os, __builtin_amdgcn_logf(oscale), LSCALE / oscale, tlist, lane2);
            __syncthreads();
        }
        asm volatile("" : "+v"(tok[0]), "+v"(tok[1]), "+v"(tl[0]), "+v"(tl[1]));
        const float oinv = vmax * (1.f / 1048576.f);
#pragma unroll
        for (int s = 0; s < 2; ++s) { const int row = tl[s] * 4 + (l15 & 3); const float lt = (float)lrow[row] * (1.f / LSCALE);
            const float gs = gate[s][1] * (lt > 0.f ? 1.f / lt : 0.f) * oinv;
#pragma unroll
            for (int dg = 0; dg < 4; ++dg) { const unsigned w0 = stashb[((s * 4 + dg) * 2 + 0) * 64], w1 = stashb[((s * 4 + dg) * 2 + 1) * 64];
                LAS const int* orow = Os + row * OS_LD + 16 * dg + 4 * quad;
                const float r0 = bflo(w0) + (float)orow[0] * gs, r1 = bfhi(w0) + (float)orow[1] * gs, r2 = bflo(w1) + (float)orow[2] * gs, r3 = bfhi(w1) + (float)orow[3] * gs;
                u32x2 w; w.x = pg8::cvt_pk_bf16(r0, r1); w.y = pg8::cvt_pk_bf16(r2, r3);
                *(u32x2*)(ATT + (size_t)tok[s] * DM + g * 256 + (l15 & 3) * 64 + 16 * dg + 4 * quad) = w; } }
        __syncthreads();
    }
}

DEVI void phase_swa_fast(Frame& F, const float* sinks) {
    using namespace fa;
    F.refresh();
    unsigned char* ws = F.ws;
    const bf16_t* Q = (const bf16_t*)(ws + RA_Q); bf16_t* ATT = (bf16_t*)(ws + RA_ATT);
    const int tid = F.tid, lane = F.lane, wave = F.wave, quad = lane >> 4, l15 = lane & 15;
    LAS unsigned char* kvb = F.lds + L_KV;
#pragma unroll 1
    for (int ui = 0; ui < 8; ++ui) {
        const int bg = ui >> 1, b = bg >> 1, g = bg & 1, t0 = (F.vcu * 2 + (ui & 1)) * 32, cur = t0 >> 6;
        const bf16_t* KS = (const bf16_t*)(ws + WS_KSH) + (size_t)bg * SEQ * 64; const bf16_t* VS = (const bf16_t*)(ws + WS_VSH) + (size_t)bg * SEQ * 64;
        int tq[2]; size_t tok[2]; bf16x8 qf[2][2]; f32x4 o[2][4]; float mm[2], ll[2];
        const float sink_raw = sinks[g * 8 + (l15 & 7)] * 8.0f;
#pragma unroll
        for (int s = 0; s < 2; ++s) { tq[s] = t0 + 4 * wave + 2 * s + (l15 >> 3); tok[s] = (size_t)b * SEQ + tq[s]; load_q(Q, tok[s], g * 512 + (l15 & 7) * 64, quad, qf[s]);
            mm[s] = sink_raw; ll[s] = quad == 0 ? 1.f : 0.f;
#pragma unroll
            for (int dg = 0; dg < 4; ++dg) o[s][dg] = (f32x4){0.f, 0.f, 0.f, 0.f}; }
        const int jb0 = cur >= 2 ? cur - 2 : 0, nb = cur - jb0 + 1;
        Stage st; stage_load<true>(st, KS + (size_t)jb0 * 4096, VS + (size_t)jb0 * 4096, tid); stage_write<true>(st, kvb, tid); __syncthreads();
#pragma unroll 1
        for (int i = 0; i < nb; ++i) {
            LAS unsigned char* buf = kvb + (i & 1) * KVB;
            const int j = jb0 + i;
            if (i + 1 < nb) stage_load<true>(st, KS + (size_t)(j + 1) * 4096, VS + (size_t)(j + 1) * 4096, tid);
#pragma unroll
            for (int s = 0; s < 2; ++s) online_step<true>(buf, qf[s][0], qf[s][1], tq[s] - (SWA_WIN - 1) - 64 * j, tq[s] - 64 * j, mm[s], ll[s], o[s], lane);
            if (i + 1 < nb) stage_write<true>(st, kvb + ((i + 1) & 1) * KVB, tid);
            __syncthreads();
        }
#pragma unroll
        for (int s = 0; s < 2; ++s) { const float inv = 1.f / sum_quads(ll[s]);
#pragma unroll
            for (int dg = 0; dg < 4; ++dg) { u32x2 w; w.x = pg8::cvt_pk_bf16(o[s][dg][0] * inv, o[s][dg][1] * inv); w.y = pg8::cvt_pk_bf16(o[s][dg][2] * inv, o[s][dg][3] * inv);
                *(u32x2*)(ATT + tok[s] * DM + g * 512 + (l15 & 7) * 64 + 16 * dg + 4 * quad) = w; } }
    }
}

enum Kind { K_PRO = 0, K_NSA_IN, K_CMP_HID, K_CMP_OUT, K_NSA_ATT, K_SWA_IN, K_SWA_ATT, K_OUTPROJ, K_LN1, K_LN1R, K_FFN1, K_FFN2, K_LN2, K_SCATTER, K_MOE1, K_MOE2, K_LN2C, K_COUNT };
struct Args { const void* in[18]; float* out; unsigned char* ws; int ph_lo, ph_hi; };
struct PhaseEnt { int kind, layer; };
constexpr int NPH = 35;
static const PhaseEnt h_prog[NPH] = {
    {K_PRO, 0},
    {K_NSA_IN, 0}, {K_CMP_HID, 0}, {K_CMP_OUT, 0}, {K_NSA_ATT, 0}, {K_OUTPROJ, 0}, {K_LN1, 0}, {K_FFN1, 0}, {K_FFN2, 0}, {K_LN2, 0},
    {K_NSA_IN, 1}, {K_CMP_HID, 1}, {K_CMP_OUT, 1}, {K_NSA_ATT, 1}, {K_OUTPROJ, 1}, {K_LN1R, 1}, {K_SCATTER, 1}, {K_MOE1, 1}, {K_MOE2, 1}, {K_LN2C, 1},
    {K_SWA_IN, 2}, {K_SWA_ATT, 2}, {K_OUTPROJ, 2}, {K_LN1, 2}, {K_FFN1, 2}, {K_FFN2, 2}, {K_LN2, 2},
    {K_SWA_IN, 3}, {K_SWA_ATT, 3}, {K_OUTPROJ, 3}, {K_LN1R, 3}, {K_SCATTER, 3}, {K_MOE1, 3}, {K_MOE2, 3}, {K_LN2C, 3},
};

template <int KIND> DEVI void do_phase(Frame& F, int l) {
    unsigned char* ws = F.ws;
    unsigned* ctl = (unsigned*)(ws + WS_CTL);
    LAS unsigned char* ring = F.lds;
    const int bx = (int)blockIdx.x;
    if constexpr (KIND == K_PRO) { phase_prologue(F); }
    if constexpr (KIND == K_NSA_IN) { pg8::Gemm g{(const bf16_t*)(ws + WS_HB), DM, DM, DM}; pg8::StaticOrder S; S.init(MTOK / 256, A_INP / 256, F.G, bx, (const bf16_t*)(ws + WS_WINA) + (size_t)l * A_INP * DM);
        EpiNsaIn E{ws, (const float*)(ws + WS_CS)}; pg8::gemm_phase(ring, g, S, E, F.wave0); }
    if constexpr (KIND == K_CMP_HID) {
        const int kv = (bx >> 5) & 1;
        if (bx < 64) { pg8::Gemm g{(const bf16_t*)(ws + (kv ? RA_VCR : RA_KCR)), 1024, 2048, 2048};
            pg8::StaticOrder S; S.init(32, 1, 32, bx & 31, (const bf16_t*)(ws + WS_WC1) + (size_t)(l * 2 + kv) * 256 * 2048);
            EpiCmpHid E{(bf16_t*)(ws + RA_CH) + (size_t)kv * 8192 * 256, (const float*)(ctl + CW_BIASP) + (l * 2 + kv) * 256};
            pg8::gemm_phase(ring, g, S, E, F.wave0); }
        else phase_vs_transpose(F, l); }
    if constexpr (KIND == K_CMP_OUT) { pg8::Gemm g{(const bf16_t*)(ws + RA_CH), 256, 256, 256}; pg8::DualOrder S; S.init(64, 1, F.G, bx, (const bf16_t*)(ws + WS_WC2) + (size_t)(l * 2) * 256 * 256); S.estride = (size_t)256 * 256;
        EpiCmpOut E{(bf16_t*)(ws + RA_KC), (bf16_t*)(ws + RA_VC)}; pg8::gemm_phase(ring, g, S, E, F.wave0); }
#if NAIVE_NSA
    if constexpr (KIND == K_NSA_ATT) { phase_nsa_naive(F); }
#else
    if constexpr (KIND == K_NSA_ATT) { phase_nsa_fast(F, l); }
#endif
    if constexpr (KIND == K_SWA_IN) { pg8::Gemm g{(const bf16_t*)(ws + WS_HB), DM, DM, DM}; pg8::StaticOrder S;
        if (l == 2) S.init(MTOK / 256, 5, F.G, bx, (const bf16_t*)(ws + WS_WQKV2)); else S.init(MTOK / 256, 4, F.G, bx, (const bf16_t*)(ws + WS_WQB1));
        EpiSwaIn E{ws, (const float*)(ws + WS_CS)}; pg8::gemm_phase(ring, g, S, E, F.wave0); }
#if NAIVE_SWA
    if constexpr (KIND == K_SWA_ATT) { phase_swa_naive(F, (const float*)ARG_IN(10) + (l - 2) * 16); }
#else
    if constexpr (KIND == K_SWA_ATT) { phase_swa_fast(F, (const float*)ARG_IN(10) + (l - 2) * 16); }
#endif
    if constexpr (KIND == K_OUTPROJ) { pg8::Gemm g{(const bf16_t*)(ws + RA_ATT), DM, DM, DM}; pg8::StaticOrder S;
        S.init(MTOK / 256, 4, F.G, bx, l < 2 ? (const bf16_t*)(ws + WS_WOUTA) + (size_t)l * DM * DM : (const bf16_t*)(ws + WS_WOUTB) + (size_t)(l - 2) * DM * DM);
        EpiResid E{(const bf16_t*)(ws + WS_HB), (bf16_t*)(ws + WS_Y)}; pg8::gemm_phase(ring, g, S, E, F.wave0); }
    if constexpr (KIND == K_LN1) { phase_ln<0, false, false>(F, l * 2, nullptr, 0); }
    if constexpr (KIND == K_LN1R) { phase_ln<0, true, false>(F, l * 2, nullptr, l >> 1); }
    if constexpr (KIND == K_FFN1) { pg8::Gemm g{(const bf16_t*)(ws + WS_HB), DM, DM, DM}; pg8::StaticOrder S; S.init(MTOK / 256, 2 * DFF / 256, F.G, bx, (const bf16_t*)(ws + WS_WDIN) + (size_t)(l >> 1) * 2 * DFF * DM);
        EpiSwiglu E{(bf16_t*)(ws + WS_ACT), DFF}; pg8::gemm_phase(ring, g, S, E, F.wave0); }
    if constexpr (KIND == K_FFN2) { pg8::Gemm g{(const bf16_t*)(ws + WS_ACT), DFF, DFF, DFF}; pg8::StaticOrder S; S.init(MTOK / 256, 4, F.G, bx, (const bf16_t*)(ws + WS_WDOUT) + (size_t)(l >> 1) * DM * DFF);
        EpiResid E{(const bf16_t*)(ws + WS_HB), (bf16_t*)(ws + WS_Y)}; pg8::gemm_phase(ring, g, S, E, F.wave0); }
    if constexpr (KIND == K_LN2) { phase_ln<0, false, false>(F, l * 2 + 1, nullptr, 0); }
    if constexpr (KIND == K_SCATTER) { phase_moe_scatter(F, l >> 1); }
    if constexpr (KIND == K_MOE1) { const int ml = l >> 1; int ts[9]; moe_tiles((const unsigned*)ctl + CW_MOE + ml * 64, ts);
        pg8::Gemm g{(const bf16_t*)(ws + WS_XB), DM, DM, DM}; pg8::GroupedOrder S; S.init(ts[8], 2 * DFFE / 256, F.G, bx, (const bf16_t*)(ws + WS_WMIN) + (size_t)ml * 8 * 2 * DFFE * DM);
        S.t1 = ts[1]; S.t2 = ts[2]; S.t3 = ts[3]; S.t4 = ts[4]; S.t5 = ts[5]; S.t6 = ts[6]; S.t7 = ts[7]; S.estride = (size_t)2 * DFFE * DM;
        EpiSwiglu E{(bf16_t*)(ws + WS_ACT), DFFE}; pg8::gemm_phase(ring, g, S, E, F.wave0); }
    if constexpr (KIND == K_MOE2) { const int ml = l >> 1; int ts[9]; moe_tiles((const unsigned*)ctl + CW_MOE + ml * 64, ts);
        pg8::Gemm g{(const bf16_t*)(ws + WS_ACT), DFFE, DFFE, DFFE}; pg8::GroupedOrder S; S.init(256, 4, F.G, bx, (const bf16_t*)(ws + WS_WMOUT) + (size_t)ml * 8 * DM * DFFE);
        S.t1 = ts[1]; S.t2 = ts[2]; S.t3 = ts[3]; S.t4 = ts[4]; S.t5 = ts[5]; S.t6 = ts[6]; S.t7 = ts[7]; S.estride = (size_t)DM * DFFE;
        EpiBf16Out E{(bf16_t*)(ws + WS_YB)}; pg8::gemm_phase(ring, g, S, E, F.wave0);
        pg8::Gemm g4{(const bf16_t*)(ws + WS_ACT), DFFE, DFFE / 4, DFFE}; pg8::SliceOrder S4; S4.nsl = (ts[8] - 256) * 16; S4.G = F.G; S4.c = (bx + 128) & 255; S4.kq = DFFE / 4;
        S4.bt = (const bf16_t*)(ws + WS_WMOUT) + (size_t)ml * 8 * DM * DFFE; S4.t1 = ts[1]; S4.t2 = ts[2]; S4.t3 = ts[3]; S4.t4 = ts[4]; S4.t5 = ts[5]; S4.t6 = ts[6]; S4.t7 = ts[7]; S4.estride = (size_t)DM * DFFE;
        EpiPart E4{(float*)(ws + WS_H)}; pg8::gemm_phase(ring, g4, S4, E4, F.wave0); }
    if constexpr (KIND == K_LN2C) { if (l == DEPTH - 1) phase_ln<1, false, true>(F, l * 2 + 1, ARG_OUT(), 0); else phase_ln<1, false, false>(F, l * 2 + 1, nullptr, 0); }
}

DEVI void frame_init(Frame& F, unsigned char* lds_raw) {
    F.lds = (LAS unsigned char*)lds_raw; F.ws = ARG_WS();
    F.wave0 = wave_id_sgpr(); F.tid = threadIdx.x; F.lane = F.tid & 63; F.wave = F.wave0;
    F.G = gridDim.x; { const int bx = blockIdx.x; F.vcu = (F.G % 8 == 0) ? (bx % 8) * (F.G / 8) + bx / 8 : bx; }
}

#if !MK_SINGLE
template <int KIND> __global__ void __launch_bounds__(NWAVES * 64, 2) phase_kernel(Args args) {
    extern __shared__ __attribute__((aligned(16))) unsigned char lds_raw[];
    Frame F; frame_init(F, lds_raw);
    do_phase<KIND>(F, args.ph_lo);
}
template <int KIND> static void launch_kind(const Args& a, hipStream_t stream) {
    static bool attr = false;
    if (!attr) { (void)hipFuncSetAttribute((const void*)phase_kernel<KIND>, hipFuncAttributeMaxDynamicSharedMemorySize, LDS_BYTES); attr = true; }
    hipLaunchKernelGGL(phase_kernel<KIND>, dim3(256), dim3(NWAVES * 64), LDS_BYTES, stream, a);
}
#else
__global__ void __launch_bounds__(NWAVES * 64, 2) yoco_fwd(Args args) {
    extern __shared__ __attribute__((aligned(16))) unsigned char lds_raw[];
    Frame F; frame_init(F, lds_raw);
    volatile LAS unsigned* MISC = (volatile LAS unsigned*)(F.lds + MISC_OFF);
    for (int u = F.tid; u < 256; u += NWAVES * 64) MISC[u] = 0u;
    __syncthreads();
    XcdBarrier bar = xcd_barrier_post((unsigned*)(F.ws + WS_CTL) + CW_BAR, MISC + 8);
#define DUP_KIND 12
#define DUP_KIND 13
#ifndef DUP_KIND
#define DUP_KIND -1
#endif
#define PH(K, L, FIRST) do { do_phase<K>(F, L); if (FIRST) cg::this_grid().sync(); else xcd_barrier(bar); if (K == DUP_KIND) { do_phase<K>(F, L); xcd_barrier(bar); } } while (0)
    PH(K_PRO, 0, true);
#define NSA_LAYER(l) PH(K_NSA_IN, l, false); PH(K_CMP_HID, l, false); PH(K_CMP_OUT, l, false); PH(K_NSA_ATT, l, false); PH(K_OUTPROJ, l, false)
#define SWA_LAYER(l) PH(K_SWA_IN, l, false); PH(K_SWA_ATT, l, false); PH(K_OUTPROJ, l, false)
#define DENSE_FFN(l) PH(K_LN1, l, false); PH(K_FFN1, l, false); PH(K_FFN2, l, false); PH(K_LN2, l, false)
#define MOE_FFN(l, LAST) PH(K_LN1R, l, false); PH(K_SCATTER, l, false); PH(K_MOE1, l, false); PH(K_MOE2, l, false); do_phase<K_LN2C>(F, l); if (!(LAST)) xcd_barrier(bar); else if (DUP_KIND == 16) { xcd_barrier(bar); do_phase<K_LN2C>(F, l); }
    NSA_LAYER(0); DENSE_FFN(0);
    NSA_LAYER(1); MOE_FFN(1, false);
    SWA_LAYER(2); DENSE_FFN(2);
    SWA_LAYER(3); MOE_FFN(3, true);
}
#endif

extern "C" void kernel_launch(void* const* d_in, const int* in_sizes, int n_in, void* d_out, int out_size, void* d_ws, size_t ws_size, hipStream_t stream) {
    static int grid = 0;
    if (grid == 0) {
        if (n_in != 18 || out_size != MTOK * DM || ws_size < WS_END) { fprintf(stderr, "kernel_launch: unexpected shapes (n_in %d out %d ws %zu need %zu)\n", n_in, out_size, ws_size, (size_t)WS_END); grid = -1; return; }
        int dev = 0, cus = 0;
        (void)hipGetDevice(&dev); (void)hipDeviceGetAttribute(&cus, hipDeviceAttributeMultiprocessorCount, dev);
        if (cus < 256) { fprintf(stderr, "kernel_launch: needs 256 CUs, device has %d\n", cus); grid = -1; return; }
#if MK_SINGLE
        int per_cu = 0;
        (void)hipFuncSetAttribute((const void*)yoco_fwd, hipFuncAttributeMaxDynamicSharedMemorySize, LDS_BYTES);
        (void)hipOccupancyMaxActiveBlocksPerMultiprocessor(&per_cu, (const void*)yoco_fwd, NWAVES * 64, LDS_BYTES);
        if (per_cu < 1) fprintf(stderr, "kernel_launch: occupancy query says %d blocks per CU\n", per_cu);
        (void)hipGetLastError();
#endif
        grid = 256;
    }
    if (grid < 0) return;
    (void)hipMemsetAsync((char*)d_ws + WS_CTL, 0, CTL_BYTES, stream);
    Args a{};
    for (int i = 0; i < 18; ++i) a.in[i] = d_in[i];
    a.out = (float*)d_out; a.ws = (unsigned char*)d_ws;
#if MK_SINGLE
    a.ph_lo = 0; a.ph_hi = NPH;
    void* kargs[] = {&a};
    hipError_t e = hipLaunchCooperativeKernel((const void*)yoco_fwd, dim3(grid), dim3(NWAVES * 64), kargs, LDS_BYTES, stream);
    if (e != hipSuccess) fprintf(stderr, "cooperative launch failed: %s (grid %d)\n", hipGetErrorString(e), grid);
#else
    for (int p = 0; p < NPH; ++p) {
        a.ph_lo = h_prog[p].layer; a.ph_hi = 0;
        switch (h_prog[p].kind) {
#define LK(K) case K: launch_kind<K>(a, stream); break;
            LK(K_PRO) LK(K_NSA_IN) LK(K_CMP_HID) LK(K_CMP_OUT) LK(K_NSA_ATT) LK(K_SWA_IN) LK(K_SWA_ATT) LK(K_OUTPROJ) LK(K_LN1) LK(K_LN1R) LK(K_FFN1) LK(K_FFN2) LK(K_LN2) LK(K_SCATTER) LK(K_MOE1) LK(K_MOE2) LK(K_LN2C)
#undef LK
            default: break;
        }
    }
#endif
}
```

```cpp
#include <hip/hip_runtime.h>
#include <hip/hip_cooperative_groups.h>
#include <cstdio>
#include <cstdint>
namespace cg = cooperative_groups;

#ifndef DBG_DROP
#define DBG_DROP 0
#endif
#ifndef NAIVE_NSA
#define NAIVE_NSA 0
#endif
#ifndef NAIVE_SWA
#define NAIVE_SWA 0
#endif
#ifndef MK_SINGLE
#define MK_SINGLE 1
#endif

#define DEVI __device__ __forceinline__
#define LAS __attribute__((address_space(3)))
#define GAS __attribute__((address_space(1)))
typedef unsigned short bf16_t;
typedef short bf16x8 __attribute__((ext_vector_type(8)));
typedef float f32x4 __attribute__((ext_vector_type(4)));
typedef float f32x2 __attribute__((ext_vector_type(2)));
typedef unsigned u32x4 __attribute__((ext_vector_type(4)));
typedef unsigned u32x2 __attribute__((ext_vector_type(2)));

constexpr int BATCH = 2, SEQ = 16384, MTOK = BATCH * SEQ, DM = 1024, DEPTH = 4;
constexpr int HD = 64;
constexpr int A_G = 4, A_R = 4, A_IN = 2608, A_INP = 2816;
constexpr int NCMP = 1023, CMP_HID = 256;
constexpr int NSLC = SEQ / 64, NSEL = 16, NSA_WIN = 512;
constexpr int B_G = 2, B_R = 8, SWA_WIN = 128;
constexpr int DFF = 2816, NEXP = 8, DFFE = 3584;
constexpr int CAP = MTOK * 2 + NEXP * 256;
constexpr float ALPHA = 1.6817928305074292f;
constexpr float LN_EPS = 1e-5f;
constexpr float QSCALE = 0.125f;

constexpr size_t al256(size_t x) { return (x + 255) & ~(size_t)255; }
constexpr size_t WS_CTL = 0, CTL_BYTES = 1u << 20;
constexpr size_t WS_WINA = CTL_BYTES;
constexpr size_t WS_WOUTA = WS_WINA + (size_t)2 * A_INP * DM * 2;
constexpr size_t WS_WC1 = WS_WOUTA + (size_t)2 * DM * DM * 2;
constexpr size_t WS_WC2 = WS_WC1 + (size_t)4 * 256 * 2048 * 2;
constexpr size_t WS_WQKV2 = WS_WC2 + (size_t)4 * 256 * 256 * 2;
constexpr size_t WS_WQB1 = WS_WQKV2 + (size_t)1280 * DM * 2;
constexpr size_t WS_WOUTB = WS_WQB1 + (size_t)DM * DM * 2;
constexpr size_t WS_WDIN = WS_WOUTB + (size_t)2 * DM * DM * 2;
constexpr size_t WS_WDOUT = WS_WDIN + (size_t)2 * 2 * DFF * DM * 2;
constexpr size_t WS_WMIN = WS_WDOUT + (size_t)2 * DM * DFF * 2;
constexpr size_t WS_WMOUT = WS_WMIN + (size_t)16 * 2 * DFFE * DM * 2;
constexpr size_t WS_WEND = WS_WMOUT + (size_t)16 * DM * DFFE * 2;
constexpr size_t WS_H = al256(WS_WEND);
constexpr size_t WS_Y = WS_H + (size_t)MTOK * DM * 4;
constexpr size_t WS_HB = WS_Y + (size_t)MTOK * DM * 4;
constexpr size_t WS_CS = WS_HB + (size_t)MTOK * DM * 2;
constexpr size_t WS_KSH = WS_CS + (size_t)MTOK * 16 * 4;
constexpr size_t WS_VSH = WS_KSH + (size_t)MTOK * 128 * 2;
constexpr size_t WS_ROUTE = WS_VSH + (size_t)MTOK * 128 * 2;
constexpr size_t WS_XB = WS_ROUTE + (size_t)MTOK * 2 * 4 * 4;
constexpr size_t WS_ACT = WS_XB + (size_t)CAP * DM * 2;
constexpr size_t WS_RA = WS_ACT + (size_t)CAP * DFFE * 2;
constexpr size_t SLAB = (size_t)MTOK * 256 * 2;
constexpr size_t RA_Q = WS_RA;
constexpr size_t RA_ATT = RA_Q + (size_t)MTOK * DM * 2;
constexpr size_t RA_KCR = RA_ATT + (size_t)MTOK * DM * 2;
constexpr size_t RA_VCR = RA_KCR + SLAB + 4096;
constexpr size_t RA_KS = RA_VCR + SLAB + 4096;
constexpr size_t RA_VS = RA_KS + SLAB;
constexpr size_t RA_KW = RA_VS + SLAB;
constexpr size_t RA_VW = RA_KW + SLAB;
constexpr size_t RA_GATE = RA_VW + SLAB;
constexpr size_t RA_KC = RA_GATE + (size_t)MTOK * 48 * 4;
constexpr size_t RA_VC = RA_KC + (size_t)8192 * 64 * 2;
constexpr size_t RA_CH = RA_VC + (size_t)8192 * 64 * 2;
constexpr size_t RA_VST = RA_CH + (size_t)2 * 8192 * 256 * 2;
constexpr size_t RA_K8 = RA_VST + SLAB / 2;
constexpr size_t RA_END = RA_VST + SLAB;
constexpr size_t WS_YB = WS_RA;
constexpr size_t YB_END = WS_YB + (size_t)CAP * DM * 4;
constexpr size_t WS_END = (RA_END > YB_END ? RA_END : YB_END);
static_assert(WS_END < (size_t)1879048192, "workspace map exceeds 4x the largest tensor");

constexpr int CW_BAR = 4096;
constexpr int CW_MOE = 16384;
constexpr int CW_WGCNT = 45056;
constexpr int CW_KWMAX = 40128;
constexpr int CW_KMAX = 40064;
constexpr int CW_VMAX = 40000;
constexpr int CW_BIASP = 32768;

constexpr int RING_BYTES = 131072;
constexpr int LDS_X = RING_BYTES;
constexpr int MISC_OFF = RING_BYTES + 16384;
constexpr int LDS_BYTES = MISC_OFF + 1024;

DEVI unsigned f2bf(float f) { unsigned u = __builtin_bit_cast(unsigned, f); return (u + 0x7fffu + ((u >> 16) & 1u)) >> 16; }
DEVI unsigned pk2(float lo, float hi) { return f2bf(lo) | (f2bf(hi) << 16); }
DEVI float bf2f(unsigned h) { return __builtin_bit_cast(float, h << 16); }
DEVI float bflo(unsigned w) { return __builtin_bit_cast(float, w << 16); }
DEVI float bfhi(unsigned w) { return __builtin_bit_cast(float, w & 0xffff0000u); }
DEVI float shx(float v, int mask, int lane) { return __builtin_bit_cast(float, __builtin_amdgcn_ds_bpermute((lane ^ mask) << 2, __builtin_bit_cast(int, v))); }
DEVI int shxi(int v, int mask, int lane) { return __builtin_amdgcn_ds_bpermute((lane ^ mask) << 2, v); }
DEVI float wave_sum(float v, int lane) {
#pragma unroll
    for (int o = 1; o < 64; o <<= 1) v += shx(v, o, lane);
    return v;
}
DEVI float wave_max(float v, int lane) {
#pragma unroll
    for (int o = 1; o < 64; o <<= 1) v = fmaxf(v, shx(v, o, lane));
    return v;
}
DEVI int wave_id_sgpr() { return __builtin_amdgcn_readfirstlane((int)threadIdx.x >> 6); }
DEVI int opaque_tid(int wave) { asm volatile("" : "+s"(wave)); int l; asm volatile("v_mbcnt_lo_u32_b32 %0, -1, 0\n\tv_mbcnt_hi_u32_b32 %0, -1, %0" : "=v"(l)); return wave * 64 + l; }
#define LDS_WAIT() asm volatile("s_waitcnt lgkmcnt(0)" ::: "memory")
#define VM_WAIT() asm volatile("s_waitcnt vmcnt(0)" ::: "memory")

namespace pg8 {
constexpr int BM = 256, BK = 64, HALF = 128, HTB = HALF * BK * 2, STAGE_BYTES = 8 * HTB, NXCD = 8, WGM = 8;
DEVI int lds_byte(int r, int c) { const int st = (r >> 4) * 2 + (c >> 5), rr = r & 15, cc = c & 31, ob = rr * 64 + cc * 2; return st * 1024 + (ob ^ (((ob >> 9) & 1) << 5)); }
DEVI void stage_rc(int b, int& R, int& C) { const int st = b / 1024, sb = b % 1024, swz = sb ^ (((sb >> 9) & 1) << 5); R = (st >> 1) * 16 + swz / 64; C = (st & 1) * 32 + (swz % 64) / 2; }
DEVI int perm32(int rho) { const int n = rho >> 4, i = rho & 15; return 8 * (i >> 2) + 4 * n + (i & 3); }

struct Unit { int pm, pn; const bf16_t* bt; int koff, z; };
struct Gemm { const bf16_t* A; int lda; int K; int ldb; };

struct StaticOrder {
    int nM, nN, nwg, G, c; const bf16_t* bt;
    DEVI void init(int nM_, int nN_, int G_, int c_, const bf16_t* bt_) { nM = nM_; nN = nN_; nwg = nM * nN; G = G_; c = c_; bt = bt_; }
    DEVI bool tile(int i, int& pm, int& pn) const {
        const long L = (long)i * G + c; if (L >= nwg) return false;
        int wgid = (int)L; { const int q = nwg / NXCD, r = nwg % NXCD, xcd = wgid % NXCD, off = wgid / NXCD; wgid = (xcd < r ? xcd * (q + 1) : r * (q + 1) + (xcd - r) * q) + off; }
        const int nig = WGM * nN, gid = wgid / nig, fm = gid * WGM, gsz = (nM - fm) < WGM ? (nM - fm) : WGM;
        pm = fm + ((wgid % nig) % gsz); pn = (wgid % nig) / gsz; return true;
    }
    DEVI bool next(int i, Unit& u) const { if (!tile(i, u.pm, u.pn)) return false; u.bt = bt; u.koff = 0; u.z = 0; return true; }
};
struct GroupedOrder : StaticOrder {
    int t1, t2, t3, t4, t5, t6, t7; size_t estride;
    DEVI bool next(int i, Unit& u) const {
        if (!tile(i, u.pm, u.pn)) return false;
        const int tm = u.pm; const int e = (tm >= t1) + (tm >= t2) + (tm >= t3) + (tm >= t4) + (tm >= t5) + (tm >= t6) + (tm >= t7);
        u.bt = bt + (size_t)e * estride; u.koff = 0; u.z = 0; return true;
    }
};
struct SliceOrder {
    int nsl, G, c, kq; const bf16_t* bt; int t1, t2, t3, t4, t5, t6, t7; size_t estride;
    DEVI bool next(int i, Unit& u) const {
        const int L = i * G + c; if (L >= nsl) return false;
        u.pm = 256 + (L >> 4); u.pn = (L & 15) >> 2; u.z = L & 3; u.koff = u.z * kq;
        const int tm = u.pm; const int e = (tm >= t1) + (tm >= t2) + (tm >= t3) + (tm >= t4) + (tm >= t5) + (tm >= t6) + (tm >= t7);
        u.bt = bt + (size_t)e * estride; return true;
    }
};
struct DualOrder : StaticOrder {
    size_t estride;
    DEVI bool next(int i, Unit& u) const { if (!tile(i, u.pm, u.pn)) return false; u.bt = bt + (u.pm >= nM / 2 ? estride : 0); u.koff = 0; u.z = 0; return true; }
};

DEVI unsigned cvt_pk_bf16(float lo, float hi) { typedef __bf16 bf16x2_t __attribute__((ext_vector_type(2))); f32x2 v = {lo, hi}; bf16x2_t b = __builtin_convertvector(v, bf16x2_t); return __builtin_bit_cast(unsigned, b); }

template <class Epi, class Sched, bool ALIGN_EPI = true>
DEVI void gemm_phase(LAS unsigned char* lds, const Gemm g, const Sched& S, const Epi& E, int wave0) {
    const int tid = opaque_tid(wave0), wid = __builtin_amdgcn_readfirstlane(tid >> 6), lane = tid & 63, wr = wid >> 2, wc = wid & 3, fr = lane & 15, fq = lane >> 4;
    const int K = g.K, nt = K / BK, lda = g.lda, ldb = g.ldb;
    unsigned voffA[2], voffB[2];
#pragma unroll
    for (int i = 0; i < 2; ++i) { int R, C; stage_rc(tid * 16 + i * 8192, R, C); const int Rb = Epi::PERM ? ((R & ~31) + perm32(R & 31)) : R;
        voffA[i] = (unsigned)(R * lda + C) * 2u; voffB[i] = (unsigned)(Rb * ldb + C) * 2u; }
    const size_t kstep = (size_t)(BK * 2);
    const size_t hstepA = (size_t)HALF * lda * 2, tstepA = 2 * hstepA;
    const size_t hstepB = (size_t)HALF * ldb * 2, tstepB = 2 * hstepB;
    const unsigned ldsw = (unsigned)wid * 1024u;
    const int aoff = lds_byte(wr * 64 + fr, fq * 8), boff = lds_byte(wc * 32 + fr, fq * 8);
#define PG8_SA(b, h) (((b) * 2 + (h)) * HTB)
#define PG8_SB(b, h) ((4 + (b) * 2 + (h)) * HTB)
#define PG8_STAGE(bufoff, gbase, voff) do { _Pragma("unroll") for (int _i = 0; _i < 2; ++_i) \
        __builtin_amdgcn_global_load_lds((const unsigned*)((const char*)(gbase) + (voff)[_i]), (LAS unsigned*)(lds + (bufoff) + ldsw + _i * 8192), 16, 0, 0); } while (0)
#define PG8_LDA(dst, b, h) do { _Pragma("unroll") for (int m = 0; m < 4; ++m) _Pragma("unroll") for (int k = 0; k < 2; ++k) dst[m][k] = *(const LAS bf16x8*)(lds + PG8_SA(b, h) + aoff + m * 2048 + k * 1024); } while (0)
#define PG8_LDB(dst, b, h) do { _Pragma("unroll") for (int n = 0; n < 2; ++n) _Pragma("unroll") for (int k = 0; k < 2; ++k) dst[n][k] = *(const LAS bf16x8*)(lds + PG8_SB(b, h) + boff + n * 2048 + k * 1024); } while (0)
#define PG8_MMA(ai, bj, At, Bt) do { __builtin_amdgcn_s_setprio(1); _Pragma("unroll") for (int m = 0; m < 4; ++m) _Pragma("unroll") for (int n = 0; n < 2; ++n) _Pragma("unroll") for (int k = 0; k < 2; ++k) \
        acc[ai][bj][m][n] = __builtin_amdgcn_mfma_f32_16x16x32_bf16(Bt[n][k], At[m][k], acc[ai][bj][m][n], 0, 0, 0); __builtin_amdgcn_s_setprio(0); } while (0)
#define PG8_WAIT_V(n) asm volatile("s_waitcnt vmcnt(" #n ")" ::: "memory")
#define PG8_WAIT_L(n) asm volatile("s_waitcnt lgkmcnt(" #n ")" ::: "memory")
#define PG8_BAR __builtin_amdgcn_s_barrier()
#define PG8_SCHED __builtin_amdgcn_sched_barrier(0)
    Unit cur, nxt; int ui = 0;
    if (!S.next(0, cur)) return;
    f32x4 acc[2][2][4][2];
#pragma unroll
    for (int a = 0; a < 2; ++a)
#pragma unroll
        for (int b = 0; b < 2; ++b)
#pragma unroll
            for (int m = 0; m < 4; ++m)
#pragma unroll
                for (int n = 0; n < 2; ++n) acc[a][b][m][n] = (f32x4){0.f, 0.f, 0.f, 0.f};
    bf16x8 At[4][2], B0[2][2], B1[2][2];
    const char* cA = (const char*)g.A + (size_t)cur.pm * tstepA + (size_t)cur.koff * 2; const char* cB = (const char*)cur.bt + (size_t)cur.pn * tstepB + (size_t)cur.koff * 2;
    PG8_STAGE(PG8_SB(0, 0), cB, voffB); PG8_STAGE(PG8_SB(0, 1), cB + hstepB, voffB); PG8_STAGE(PG8_SA(0, 0), cA, voffA); PG8_STAGE(PG8_SA(0, 1), cA + hstepA, voffA);
    if (wr == 1) PG8_BAR;
    PG8_WAIT_V(2); PG8_BAR;
    PG8_STAGE(PG8_SB(1, 0), cB + kstep, voffB); PG8_STAGE(PG8_SA(1, 0), cA + kstep, voffA); PG8_STAGE(PG8_SB(1, 1), cB + hstepB + kstep, voffB);
    PG8_WAIT_V(6); PG8_BAR;
    for (;;) {
        const bool has_next = S.next(ui + 1, nxt);
        const char* nA = has_next ? (const char*)g.A + (size_t)nxt.pm * tstepA + (size_t)nxt.koff * 2 : cA; const char* nB = has_next ? (const char*)nxt.bt + (size_t)nxt.pn * tstepB + (size_t)nxt.koff * 2 : cB;
        for (int t = 0; t < nt; t += 2) {
            const bool last = (t == nt - 2);
            const char* a1 = cA + (size_t)(t + 1) * kstep;
            const char* a2 = last ? nA : cA + (size_t)(t + 2) * kstep; const char* b2 = last ? nB : cB + (size_t)(t + 2) * kstep;
            const char* a3 = a2 + kstep; const char* b3 = b2 + kstep;
            PG8_LDB(B0, 0, 0); PG8_LDB(B1, 0, 1); PG8_SCHED; PG8_LDA(At, 0, 0); PG8_STAGE(PG8_SA(1, 1), a1 + hstepA, voffA);
            PG8_WAIT_V(8); PG8_WAIT_L(0); PG8_BAR; PG8_MMA(0, 0, At, B0); PG8_MMA(0, 1, At, B1); PG8_BAR; PG8_SCHED;
            PG8_LDA(At, 0, 1); PG8_STAGE(PG8_SB(0, 0), b2, voffB); PG8_STAGE(PG8_SB(0, 1), b2 + hstepB, voffB); PG8_STAGE(PG8_SA(0, 0), a2, voffA);
            PG8_WAIT_V(8); PG8_WAIT_L(0); PG8_BAR; PG8_MMA(1, 0, At, B0); PG8_MMA(1, 1, At, B1); PG8_BAR; PG8_SCHED;
            PG8_LDB(B0, 1, 0); PG8_LDB(B1, 1, 1); PG8_SCHED; PG8_LDA(At, 1, 0); PG8_STAGE(PG8_SA(0, 1), a2 + hstepA, voffA);
            PG8_WAIT_V(8); PG8_WAIT_L(0); PG8_BAR; PG8_MMA(0, 0, At, B0); PG8_MMA(0, 1, At, B1); PG8_BAR; PG8_SCHED;
            PG8_LDA(At, 1, 1); PG8_STAGE(PG8_SB(1, 0), b3, voffB); PG8_STAGE(PG8_SB(1, 1), b3 + hstepB, voffB); PG8_STAGE(PG8_SA(1, 0), a3, voffA);
            PG8_WAIT_V(8); PG8_WAIT_L(0); PG8_BAR; PG8_MMA(1, 0, At, B0); PG8_MMA(1, 1, At, B1); PG8_BAR; PG8_SCHED;
        }
        if constexpr (ALIGN_EPI) { if (wr == 0) PG8_BAR; }
        E(acc, cur, wr, wc, fr, fq);
        if (!has_next) break;
#pragma unroll
        for (int a = 0; a < 2; ++a)
#pragma unroll
            for (int b = 0; b < 2; ++b)
#pragma unroll
                for (int m = 0; m < 4; ++m)
#pragma unroll
                    for (int n = 0; n < 2; ++n) acc[a][b][m][n] = (f32x4){0.f, 0.f, 0.f, 0.f};
        cur = nxt; cA = nA; cB = nB; ++ui;
        if constexpr (ALIGN_EPI) { if (wr == 1) PG8_BAR; }
    }
    PG8_WAIT_V(0);
    if constexpr (!ALIGN_EPI) { if (wr == 0) PG8_BAR; }
    PG8_BAR;
#undef PG8_SA
#undef PG8_SB
#undef PG8_STAGE
#undef PG8_LDA
#undef PG8_LDB
#undef PG8_MMA
#undef PG8_WAIT_V
#undef PG8_WAIT_L
#undef PG8_BAR
#undef PG8_SCHED
}
}

#define XB_TMO      128
#define XB_XCNT(j)  (256  + 64 * (j))
#define XB_XSUB(j)  (1280 + 64 * (j))
#define XB_XGEN(j)  (2304 + 64 * (j))
#define XB_TOP      3328
#define XB_TOPGEN   3392
#define XCD_BAR_WORDS 3456
#define XB_SPIN_CAP (1u << 22)
DEVI unsigned xb_ld(unsigned* p)              { return __hip_atomic_load(p, __ATOMIC_RELAXED, __HIP_MEMORY_SCOPE_AGENT); }
DEVI unsigned xb_add(unsigned* p, unsigned v) { return __hip_atomic_fetch_add(p, v, __ATOMIC_RELAXED, __HIP_MEMORY_SCOPE_AGENT); }
DEVI unsigned xb_xcc_id() { return (unsigned)__builtin_amdgcn_s_getreg((3 << 11) | 20) & 0xFu; }
#define XB_SPIN(cond, bar) do { unsigned _sp = 0; while (cond) { __builtin_amdgcn_s_sleep(1); \
    if ((++_sp & 255u) == 0u) { if (xb_ld(&(bar)[XB_TMO])) break; if (_sp > XB_SPIN_CAP) { atomicAdd(&(bar)[XB_TMO], 1u); break; } } } } while (0)
struct XcdBarrier { unsigned* bar; unsigned x; volatile LAS unsigned* st; };
DEVI XcdBarrier xcd_barrier_post(unsigned* bar, volatile LAS unsigned* st) {
    XcdBarrier b; b.bar = bar; b.x = xb_xcc_id(); b.st = st;
    if (threadIdx.x == 0) (void)xb_add(&bar[XB_XCNT(b.x)], 1u);
    return b;
}
DEVI void xcd_barrier_complete(unsigned* bar, unsigned x, unsigned& nloc, unsigned& nx) {
    const unsigned G = gridDim.x * gridDim.y * gridDim.z;
    unsigned sum, cnt, mine, sp = 0u;
    for (;;) {
        sum = 0u; cnt = 0u; mine = 0u;
#pragma unroll
        for (unsigned j = 0; j < 16; ++j) { const unsigned c = xb_ld(&bar[XB_XCNT(j)]); sum += c; cnt += (c > 0u) ? 1u : 0u; mine = (j == x) ? c : mine; }
        if (sum == G) break;
        __builtin_amdgcn_s_sleep(1);
        if ((++sp & 255u) == 0u) { if (xb_ld(&bar[XB_TMO])) break; if (sp > XB_SPIN_CAP) { atomicAdd(&bar[XB_TMO], 1u); break; } }
    }
    nloc = mine > 0u ? mine : 1u; nx = cnt > 0u ? cnt : 1u;
}
DEVI void xcd_barrier(const XcdBarrier& b) {
    asm volatile("s_waitcnt vmcnt(0)" ::: "memory");
    __syncthreads();
    if (threadIdx.x == 0) {
        unsigned* bar = b.bar;
        __builtin_amdgcn_s_waitcnt(0);
        unsigned nloc = b.st[0], nx = b.st[1];
        if (nloc == 0u) { xcd_barrier_complete(bar, b.x, nloc, nx); b.st[0] = nloc; b.st[1] = nx; }
        const unsigned old = xb_add(&bar[XB_XSUB(b.x)], 1u);
        const unsigned gen = old / nloc;
        if (old + 1u == (gen + 1u) * nloc) {
            __builtin_amdgcn_fence(__ATOMIC_RELEASE, "agent");
            asm volatile("s_waitcnt vmcnt(0)" ::: "memory");
            const unsigned og = xb_add(&bar[XB_TOP], 1u);
            const unsigned tg = og / nx;
            if (og + 1u == (tg + 1u) * nx) xb_add(&bar[XB_TOPGEN], 1u);
            else XB_SPIN(xb_ld(&bar[XB_TOPGEN]) == tg, bar);
            __builtin_amdgcn_fence(__ATOMIC_ACQUIRE, "agent");
            xb_add(&bar[XB_XGEN(b.x)], 1u);
            asm volatile("s_waitcnt vmcnt(0)" ::: "memory");
        } else {
            XB_SPIN(xb_ld(&bar[XB_XGEN(b.x)]) == gen, bar);
            __builtin_amdgcn_fence(__ATOMIC_ACQUIRE, "agent");
            asm volatile("s_waitcnt vmcnt(0)" ::: "memory");
        }
    }
    __syncthreads();
}

typedef const void* cvp_t;
DEVI const void* karg_ptr(int byte_off) { asm volatile("" : "+s"(byte_off)); const __attribute__((address_space(4))) char* kp = (const __attribute__((address_space(4))) char*)__builtin_amdgcn_kernarg_segment_ptr(); return *(const __attribute__((address_space(4))) cvp_t*)(kp + byte_off); }
#define ARG_IN(i) karg_ptr((i) * 8)
#define ARG_OUT() ((float*)karg_ptr(18 * 8))
#define ARG_WS() ((unsigned char*)karg_ptr(19 * 8))
struct Frame {
    LAS unsigned char* lds;
    unsigned char* ws;
    int tid, lane, wave, G, vcu, wave0;
    DEVI void refresh() { tid = opaque_tid(wave0); lane = tid & 63; wave = __builtin_amdgcn_readfirstlane(tid >> 6); }
};
constexpr int NWAVES = 8;

DEVI void transpose_item(const float* W, int K, int N, bf16_t* WT, int k0, int n0, int drow0, LAS float* scr, int lane) {
    const int nc = n0 + 4 * (lane & 7); const bool ok = nc < N;
#pragma unroll
    for (int i = 0; i < 8; ++i) { const int kk = 8 * i + (lane >> 3); const f32x4 v = ok ? *(const f32x4*)(W + (size_t)(k0 + kk) * N + nc) : (f32x4){0.f, 0.f, 0.f, 0.f};
        LAS float* d = scr + kk * 33 + 4 * (lane & 7); d[0] = v[0]; d[1] = v[1]; d[2] = v[2]; d[3] = v[3]; }
    LDS_WAIT(); asm volatile("" ::: "memory");
    const int c = lane & 7;
#pragma unroll
    for (int j = 0; j < 4; ++j) { const int n = (lane >> 3) + 8 * j; const LAS float* s = scr + (8 * c) * 33 + n;
        u32x4 o; o.x = pk2(s[0 * 33], s[1 * 33]); o.y = pk2(s[2 * 33], s[3 * 33]); o.z = pk2(s[4 * 33], s[5 * 33]); o.w = pk2(s[6 * 33], s[7 * 33]);
        *(u32x4*)(WT + (size_t)(drow0 + n) * K + k0 + 8 * c) = o; }
    LDS_WAIT(); asm volatile("" ::: "memory");
}
struct WFam { const float* src; size_t sstride; bf16_t* dst; size_t dstride; int count, K, N, Npad, mode; };
DEVI bool wfam_do(const WFam& f, int& it, LAS float* scr, int lane) {
    const int nkb = f.K / 64, nnb = f.Npad / 32, per = nkb * nnb, tot = per * f.count;
    if (it >= tot) { it -= tot; return false; }
    const int mi = it / per, r = it % per, kb = r / nnb, nb = r % nnb, n0 = nb * 32;
    int drow0 = n0;
    if (f.mode == 1) { const int F = f.N / 2; const int o = n0 < F ? n0 : n0 - F; drow0 = 256 * (o / 128) + (o % 128) + (n0 < F ? 0 : 128); }
    transpose_item(f.src + (size_t)mi * f.sstride, f.K, f.N, f.dst + (size_t)mi * f.dstride, kb * 64, n0, drow0, scr, lane);
    return true;
}

DEVI void phase_prologue(Frame& F) {
    F.refresh();
    LAS float* scr = (LAS float*)(F.lds + F.wave * 16384);
    const int gw = F.vcu * NWAVES + F.wave, NGW = F.G * NWAVES;
    unsigned char* ws = F.ws;
    const WFam fam[11] = {
        {(const float*)ARG_IN(2), (size_t)DM * A_IN, (bf16_t*)(ws + WS_WINA), (size_t)A_INP * DM, 2, DM, A_IN, A_INP, 0},
        {(const float*)ARG_IN(3), (size_t)DM * DM, (bf16_t*)(ws + WS_WOUTA), (size_t)DM * DM, 2, DM, DM, DM, 0},
        {(const float*)ARG_IN(5), (size_t)2048 * 256, (bf16_t*)(ws + WS_WC1), (size_t)256 * 2048, 4, 2048, 256, 256, 0},
        {(const float*)ARG_IN(6), (size_t)256 * 64, (bf16_t*)(ws + WS_WC2), (size_t)256 * 256, 4, 256, 64, 256, 0},
        {(const float*)ARG_IN(8), (size_t)DM * DM, (bf16_t*)(ws + WS_WQKV2), 0, 1, DM, DM, DM, 0},
        {(const float*)ARG_IN(7), 0, (bf16_t*)(ws + WS_WQKV2) + (size_t)DM * DM, 0, 1, DM, 256, 256, 0},
        {(const float*)ARG_IN(8) + (size_t)DM * DM, 0, (bf16_t*)(ws + WS_WQB1), 0, 1, DM, DM, DM, 0},
        {(const float*)ARG_IN(9), (size_t)DM * DM, (bf16_t*)(ws + WS_WOUTB), (size_t)DM * DM, 2, DM, DM, DM, 0},
        {(const float*)ARG_IN(13), (size_t)DM * 2 * DFF, (bf16_t*)(ws + WS_WDIN), (size_t)2 * DFF * DM, 2, DM, 2 * DFF, 2 * DFF, 1},
        {(const float*)ARG_IN(14), (size_t)DFF * DM, (bf16_t*)(ws + WS_WDOUT), (size_t)DM * DFF, 2, DFF, DM, DM, 0},
        {(const float*)ARG_IN(16), (size_t)DM * 2 * DFFE, (bf16_t*)(ws + WS_WMIN), (size_t)2 * DFFE * DM, 16, DM, 2 * DFFE, 2 * DFFE, 1},
    };
    const WFam famo = {(const float*)ARG_IN(17), (size_t)DFFE * DM, (bf16_t*)(ws + WS_WMOUT), (size_t)DM * DFFE, 16, DFFE, DM, DM, 0};
    int total = 0;
#pragma unroll
    for (int i = 0; i < 11; ++i) total += (fam[i].K / 64) * (fam[i].Npad / 32) * fam[i].count;
    total += (famo.K / 64) * (famo.Npad / 32) * famo.count;
    for (int it0 = gw; it0 < total; it0 += NGW) {
        int it = it0; bool done = false;
#pragma unroll
        for (int i = 0; i < 11; ++i) if (!done) done = wfam_do(fam[i], it, scr, F.lane);
        if (!done) wfam_do(famo, it, scr, F.lane);
    }
    { const float* x = (const float*)ARG_IN(0); bf16_t* hb = (bf16_t*)(ws + WS_HB);
      const size_t n8 = (size_t)MTOK * DM / 8;
      for (size_t i = (size_t)blockIdx.x * 512 + F.tid; i < n8; i += (size_t)F.G * 512) {
          const f32x4 v0 = *(const f32x4*)(x + i * 8), v1 = *(const f32x4*)(x + i * 8 + 4);
          u32x4 o; o.x = pk2(v0.x, v0.y); o.y = pk2(v0.z, v0.w); o.z = pk2(v1.x, v1.y); o.w = pk2(v1.z, v1.w);
          *(u32x4*)(hb + i * 8) = o; } }
    { const int* pos = (const int*)ARG_IN(1); float* cs = (float*)(ws + WS_CS);
      for (int i = blockIdx.x * 512 + F.tid; i < MTOK * 8; i += F.G * 512) {
          const int tok = i >> 3, j = i & 7;
          const float invf = (float)exp2(-(double)j * (18.931568569324174 / 8.0));
          const double ang = (double)((float)pos[tok] * invf);
          const double n = rint(ang * 0.15915494309189535); const double r = ang - n * 6.283185307179586476925;
          const float rf = (float)r;
          cs[tok * 16 + j] = cosf(rf); cs[tok * 16 + 8 + j] = sinf(rf); } }
    { const float* cp = (const float*)ARG_IN(4); const float* w1 = (const float*)ARG_IN(5); float* bp = (float*)((unsigned*)(ws + WS_CTL) + CW_BIASP);
      if (gw < 1024) { const int mi = gw >> 8, c = gw & 255; float s = 0.f;
#pragma unroll 8
          for (int i = 0; i < 32; ++i) { const int f = i * 64 + F.lane; s += cp[(size_t)mi * 2048 + f] * w1[((size_t)mi * 2048 + f) * 256 + c]; }
          s = wave_sum(s, F.lane);
          if (F.lane == 0) bp[gw] = s; } }
}

typedef f32x4 AccT[2][2][4][2];

DEVI u32x4 pack8(const f32x4 a, const f32x4 b) { u32x4 w; w.x = pg8::cvt_pk_bf16(a[0], a[1]); w.y = pg8::cvt_pk_bf16(a[2], a[3]); w.z = pg8::cvt_pk_bf16(b[0], b[1]); w.w = pg8::cvt_pk_bf16(b[2], b[3]); return w; }
DEVI void rope8(f32x4& v0, f32x4& v1, int dhead, const float* csrow, int lane) {
    f32x4 p0, p1;
#pragma unroll
    for (int i = 0; i < 4; ++i) { p0[i] = shx(v0[i], 16, lane); p1[i] = shx(v1[i], 16, lane); }
    if (dhead < 16) {
        const f32x4 c0 = *(const f32x4*)(csrow), c1 = *(const f32x4*)(csrow + 4), s0 = *(const f32x4*)(csrow + 8), s1 = *(const f32x4*)(csrow + 12);
        if (dhead == 0) { v0 = v0 * c0 - p0 * s0; v1 = v1 * c1 - p1 * s1; }
        else            { v0 = v0 * c0 + p0 * s0; v1 = v1 * c1 + p1 * s1; }
    }
}

struct EpiNsaIn {
    static constexpr bool PERM = true;
    unsigned char* ws; const float* cs;
    DEVI void operator()(const AccT& acc, const pg8::Unit& u, int wr, int wc, int fr, int fq) const {
        const int pn = u.pn;
        if (pn < 4) {
            bf16_t* Q = (bf16_t*)(ws + RA_Q);
#pragma unroll
            for (int ai = 0; ai < 2; ++ai)
#pragma unroll
                for (int m = 0; m < 4; ++m) { const int row = u.pm * 256 + ai * 128 + wr * 64 + m * 16 + fr;
#pragma unroll
                    for (int bj = 0; bj < 2; ++bj) *(u32x4*)(Q + (size_t)row * DM + pn * 256 + bj * 128 + wc * 32 + fq * 8) = pack8(acc[ai][bj][m][0], acc[ai][bj][m][1]); }
        } else if (pn < 10) {
            const size_t base = pn == 4 ? RA_KCR : pn == 5 ? RA_VCR : pn == 6 ? RA_KS : pn == 7 ? RA_VS : pn == 8 ? RA_KW : RA_VW;
            bf16_t* T = (bf16_t*)(ws + base);
            const bool rot = (pn == 6 || pn == 8);
            const int dh = (wc & 1) * 32 + fq * 8;
#pragma unroll
            for (int ai = 0; ai < 2; ++ai)
#pragma unroll
                for (int m = 0; m < 4; ++m) { const int row = u.pm * 256 + ai * 128 + wr * 64 + m * 16 + fr; const int b = row / SEQ, t = row % SEQ;
#pragma unroll
                    for (int bj = 0; bj < 2; ++bj) { f32x4 v0 = acc[ai][bj][m][0], v1 = acc[ai][bj][m][1];
                        if (rot) rope8(v0, v1, dh, cs + (size_t)row * 16, fq * 16 + fr);
                        const int g = bj * 2 + (wc >> 1);
                        *(u32x4*)(T + ((size_t)(b * A_G + g) * SEQ + t) * HD + dh) = pack8(v0, v1); } }
        } else {
            float* G = (float*)(ws + RA_GATE);
            if (wc < 2) {
#pragma unroll
                for (int ai = 0; ai < 2; ++ai)
#pragma unroll
                    for (int m = 0; m < 4; ++m) { const int row = u.pm * 256 + ai * 128 + wr * 64 + m * 16 + fr;
#pragma unroll
                        for (int n = 0; n < 2; ++n) { const int c = wc * 32 + fq * 8 + n * 4;
                            if (c < 48) { f32x4 v = acc[ai][0][m][n]; f32x4 o;
#pragma unroll
                                for (int i = 0; i < 4; ++i) o[i] = 1.f / (1.f + __expf(-v[i]));
                                *(f32x4*)(G + (size_t)row * 48 + c) = o; } } }
            }
        }
    }
};
struct EpiSwaIn {
    static constexpr bool PERM = true;
    unsigned char* ws; const float* cs;
    DEVI void operator()(const AccT& acc, const pg8::Unit& u, int wr, int wc, int fr, int fq) const {
        const int pn = u.pn; const int dh = (wc & 1) * 32 + fq * 8;
        bf16_t* Q = (bf16_t*)(ws + RA_Q); bf16_t* KS = (bf16_t*)(ws + WS_KSH); bf16_t* VS = (bf16_t*)(ws + WS_VSH);
#pragma unroll
        for (int ai = 0; ai < 2; ++ai)
#pragma unroll
            for (int m = 0; m < 4; ++m) { const int row = u.pm * 256 + ai * 128 + wr * 64 + m * 16 + fr; const int b = row / SEQ, t = row % SEQ;
#pragma unroll
                for (int bj = 0; bj < 2; ++bj) { f32x4 v0 = acc[ai][bj][m][0], v1 = acc[ai][bj][m][1];
                    const bool rot = (pn < 4) || (bj == 0);
                    if (rot) rope8(v0, v1, dh, cs + (size_t)row * 16, fq * 16 + fr);
                    const u32x4 w = pack8(v0, v1);
                    if (pn < 4) *(u32x4*)(Q + (size_t)row * DM + pn * 256 + bj * 128 + wc * 32 + fq * 8) = w;
                    else { bf16_t* T = bj == 0 ? KS : VS; const int g = wc >> 1; *(u32x4*)(T + ((size_t)(b * B_G + g) * SEQ + t) * HD + dh) = w; } } }
    }
};
DEVI float gelu_tanh(float x) { const float u = 0.7978845608028654f * (x + 0.044715f * x * x * x); const float e = __expf(2.f * u); const float th = 1.f - 2.f / (e + 1.f); return 0.5f * x * (1.f + th); }
struct EpiCmpHid {
    static constexpr bool PERM = true;
    bf16_t* out; const float* bias;
    DEVI void operator()(const AccT& acc, const pg8::Unit& u, int wr, int wc, int fr, int fq) const {
        const float* bs = bias;
#pragma unroll
        for (int bj = 0; bj < 2; ++bj) { const int c = bj * 128 + wc * 32 + fq * 8; const f32x4 b0 = *(const f32x4*)(bs + c), b1 = *(const f32x4*)(bs + c + 4);
#pragma unroll
            for (int ai = 0; ai < 2; ++ai)
#pragma unroll
                for (int m = 0; m < 4; ++m) { const int row = u.pm * 256 + ai * 128 + wr * 64 + m * 16 + fr; f32x4 v0 = acc[ai][bj][m][0] + b0, v1 = acc[ai][bj][m][1] + b1;
#pragma unroll
                    for (int i = 0; i < 4; ++i) { v0[i] = gelu_tanh(v0[i]); v1[i] = gelu_tanh(v1[i]); }
                    *(u32x4*)(out + (size_t)row * 256 + c) = pack8(v0, v1); } }
    }
};
struct EpiCmpOut {
    static constexpr bool PERM = true;
    bf16_t* kc; bf16_t* vc;
    DEVI void operator()(const AccT& acc, const pg8::Unit& u, int wr, int wc, int fr, int fq) const {
        if (wc >= 2) return;
        bf16_t* T = u.pm >= 32 ? vc : kc; const int rbase = (u.pm & 31) * 256;
#pragma unroll
        for (int ai = 0; ai < 2; ++ai)
#pragma unroll
            for (int m = 0; m < 4; ++m) { const int row = rbase + ai * 128 + wr * 64 + m * 16 + fr;
                u32x4 w = pack8(acc[ai][0][m][0], acc[ai][0][m][1]);
                if ((row & 1023) == 1023) w = (u32x4){0u, 0u, 0u, 0u};
                *(u32x4*)(T + (size_t)row * 64 + wc * 32 + fq * 8) = w; }
    }
};
struct EpiResid {
    static constexpr bool PERM = true;
    const bf16_t* res; bf16_t* y;
    DEVI void operator()(const AccT& acc, const pg8::Unit& u, int wr, int wc, int fr, int fq) const {
#pragma unroll
        for (int ai = 0; ai < 2; ++ai)
#pragma unroll
            for (int m = 0; m < 4; ++m) { const size_t off = (size_t)(u.pm * 256 + ai * 128 + wr * 64 + m * 16 + fr) * DM + u.pn * 256 + wc * 32 + fq * 8;
#pragma unroll
                for (int bj = 0; bj < 2; ++bj) { const u32x4 r = *(const u32x4*)(res + off + bj * 128);
                    const f32x4 r0 = {bflo(r.x), bfhi(r.x), bflo(r.y), bfhi(r.y)}, r1 = {bflo(r.z), bfhi(r.z), bflo(r.w), bfhi(r.w)};
                    *(u32x4*)(y + off + bj * 128) = pack8(r0 * ALPHA + acc[ai][bj][m][0], r1 * ALPHA + acc[ai][bj][m][1]); } }
    }
};
struct EpiBf16Out {
    static constexpr bool PERM = true;
    bf16_t* y;
    DEVI void operator()(const AccT& acc, const pg8::Unit& u, int wr, int wc, int fr, int fq) const {
#pragma unroll
        for (int ai = 0; ai < 2; ++ai)
#pragma unroll
            for (int m = 0; m < 4; ++m) { const size_t off = (size_t)(u.pm * 256 + ai * 128 + wr * 64 + m * 16 + fr) * DM + u.pn * 256 + wc * 32 + fq * 8;
#pragma unroll
                for (int bj = 0; bj < 2; ++bj) *(u32x4*)(y + off + bj * 128) = pack8(acc[ai][bj][m][0], acc[ai][bj][m][1]); }
    }
};
struct EpiPart {
    static constexpr bool PERM = false;
    float* part;
    DEVI void operator()(const AccT& acc, const pg8::Unit& u, int wr, int wc, int fr, int fq) const {
        float* base = part + (size_t)((u.pm - 256) * 4 + u.z) * 256 * DM;
#pragma unroll
        for (int ai = 0; ai < 2; ++ai)
#pragma unroll
            for (int m = 0; m < 4; ++m) { const size_t off = (size_t)(ai * 128 + wr * 64 + m * 16 + fr) * DM + u.pn * 256 + wc * 32 + fq * 4;
#pragma unroll
                for (int bj = 0; bj < 2; ++bj)
#pragma unroll
                    for (int n = 0; n < 2; ++n) *(f32x4*)(base + off + bj * 128 + n * 16) = acc[ai][bj][m][n]; }
    }
};
struct EpiSwiglu {
    static constexpr bool PERM = true;
    bf16_t* act; int ld;
    DEVI void operator()(const AccT& acc, const pg8::Unit& u, int wr, int wc, int fr, int fq) const {
#pragma unroll
        for (int ai = 0; ai < 2; ++ai)
#pragma unroll
            for (int m = 0; m < 4; ++m) { const size_t row = (size_t)(u.pm * 256 + ai * 128 + wr * 64 + m * 16 + fr); f32x4 o[2];
#pragma unroll
                for (int n = 0; n < 2; ++n)
#pragma unroll
                    for (int i = 0; i < 4; ++i) { const float gv = acc[ai][0][m][n][i], uv = acc[ai][1][m][n][i]; o[n][i] = gv * __builtin_amdgcn_rcpf(1.f + __expf(-gv)) * uv; }
                *(u32x4*)(act + row * ld + u.pn * 128 + wc * 32 + fq * 8) = pack8(o[0], o[1]); }
    }
};

DEVI void unpack8(const u32x4 w, float (&x)[8]) { x[0] = bflo(w.x); x[1] = bfhi(w.x); x[2] = bflo(w.y); x[3] = bfhi(w.y); x[4] = bflo(w.z); x[5] = bfhi(w.z); x[6] = bflo(w.w); x[7] = bfhi(w.w); }
DEVI void moe_row8(const bf16_t* YB, const float* PART, int p, int c, float (&x)[8]) {
    if (p < 65536) { unpack8(*(const u32x4*)(YB + (size_t)p * DM + c), x); return; }
    const float* q = PART + ((size_t)(((p >> 8) - 256) * 4) * 256 + (p & 255)) * DM + c;
    f32x4 a0 = *(const f32x4*)q, a1 = *(const f32x4*)(q + 4);
#pragma unroll
    for (int z = 1; z < 4; ++z) { a0 = a0 + *(const f32x4*)(q + (size_t)z * 256 * DM); a1 = a1 + *(const f32x4*)(q + (size_t)z * 256 * DM + 4); }
    x[0] = a0[0]; x[1] = a0[1]; x[2] = a0[2]; x[3] = a0[3]; x[4] = a1[0]; x[5] = a1[1]; x[6] = a1[2]; x[7] = a1[3];
}
template <int MODE, bool ROUTER, bool FINAL>
DEVI void phase_ln(Frame& F, int lnidx, float* outp, int moe_layer) {
    F.refresh();
    unsigned char* ws = F.ws;
    const bf16_t* Y = (const bf16_t*)(ws + WS_Y); const bf16_t* YB = (const bf16_t*)(ws + WS_YB); const float* PART = (const float*)(ws + WS_H);
    bf16_t* HB = (bf16_t*)(ws + WS_HB);
    const float* gam = (const float*)ARG_IN(11) + (size_t)lnidx * DM; const float* bet = (const float*)ARG_IN(12) + (size_t)lnidx * DM;
    int* TOKE = (int*)(ws + WS_ROUTE); int* TOKR = TOKE + MTOK * 2; float* TOKW = (float*)(TOKR + MTOK * 2); int* TOKP = (int*)(TOKW + MTOK * 2);
    const float* wr_ = ROUTER ? (const float*)ARG_IN(15) + (size_t)moe_layer * DM * NEXP : nullptr;
    LAS int* lcnt = (LAS int*)(F.lds + LDS_X);
    LAS int* lrec = lcnt + 16;
    LAS int* lrank = lrec + 256;
    if (ROUTER) { if (F.tid < 16) lcnt[F.tid] = 0; __syncthreads(); }
    const int gw = F.vcu * NWAVES + F.wave, NGW = F.G * NWAVES;
    constexpr int RB = (MODE == 0) ? 4 : 2;
    const f32x4 g0_[2] = {*(const f32x4*)(gam + F.lane * 8), *(const f32x4*)(gam + 512 + F.lane * 8)}, g1_[2] = {*(const f32x4*)(gam + F.lane * 8 + 4), *(const f32x4*)(gam + 512 + F.lane * 8 + 4)};
    const f32x4 b0_[2] = {*(const f32x4*)(bet + F.lane * 8), *(const f32x4*)(bet + 512 + F.lane * 8)}, b1_[2] = {*(const f32x4*)(bet + F.lane * 8 + 4), *(const f32x4*)(bet + 512 + F.lane * 8 + 4)};
#pragma unroll 1
    for (int k0 = 0; k0 < 16; k0 += RB) {
        float v[RB][2][8];
        if (MODE == 0) {
            u32x4 raw[RB][2];
#pragma unroll
            for (int r = 0; r < RB; ++r)
#pragma unroll
                for (int j = 0; j < 2; ++j) raw[r][j] = *(const u32x4*)(Y + (size_t)(gw + (k0 + r) * NGW) * DM + j * 512 + F.lane * 8);
#pragma unroll
            for (int r = 0; r < RB; ++r)
#pragma unroll
                for (int j = 0; j < 2; ++j) unpack8(raw[r][j], v[r][j]);
        } else {
            int p0[RB], p1[RB]; float w0[RB], w1[RB];
#pragma unroll
            for (int r = 0; r < RB; ++r) { const int m = gw + (k0 + r) * NGW; p0[r] = TOKP[m * 2]; p1[r] = TOKP[m * 2 + 1]; w0[r] = TOKW[m * 2]; w1[r] = TOKW[m * 2 + 1]; }
            u32x4 hraw[RB][2];
#pragma unroll
            for (int r = 0; r < RB; ++r)
#pragma unroll
                for (int j = 0; j < 2; ++j) hraw[r][j] = *(const u32x4*)(HB + (size_t)(gw + (k0 + r) * NGW) * DM + j * 512 + F.lane * 8);
#pragma unroll
            for (int r = 0; r < RB; ++r)
#pragma unroll
                for (int j = 0; j < 2; ++j) { const int c = j * 512 + F.lane * 8; float h[8], a[8], b[8];
                    unpack8(hraw[r][j], h); moe_row8(YB, PART, p0[r], c, a); moe_row8(YB, PART, p1[r], c, b);
#pragma unroll
                    for (int i = 0; i < 8; ++i) v[r][j][i] = h[i] * ALPHA + a[i] * w0[r] + b[i] * w1[r]; }
        }
#pragma unroll
        for (int r = 0; r < RB; ++r) {
            const int m = gw + (k0 + r) * NGW;
            float s = 0.f;
#pragma unroll
            for (int j = 0; j < 2; ++j)
#pragma unroll
                for (int i = 0; i < 8; ++i) s += v[r][j][i];
            const float mean = wave_sum(s, F.lane) * (1.f / DM); float s2 = 0.f;
#pragma unroll
            for (int j = 0; j < 2; ++j)
#pragma unroll
                for (int i = 0; i < 8; ++i) { v[r][j][i] -= mean; s2 += v[r][j][i] * v[r][j][i]; }
            const float rstd = 1.f / sqrtf(wave_sum(s2, F.lane) * (1.f / DM) + LN_EPS);
#pragma unroll
            for (int j = 0; j < 2; ++j) { const int c = j * 512 + F.lane * 8;
#pragma unroll
                for (int i = 0; i < 4; ++i) { v[r][j][i] = v[r][j][i] * rstd * g0_[j][i] + b0_[j][i]; v[r][j][4 + i] = v[r][j][4 + i] * rstd * g1_[j][i] + b1_[j][i]; }
                if (FINAL) { *(f32x4*)(outp + (size_t)m * DM + c) = (f32x4){v[r][j][0], v[r][j][1], v[r][j][2], v[r][j][3]}; *(f32x4*)(outp + (size_t)m * DM + c + 4) = (f32x4){v[r][j][4], v[r][j][5], v[r][j][6], v[r][j][7]}; }
                else { u32x4 w; w.x = pk2(v[r][j][0], v[r][j][1]); w.y = pk2(v[r][j][2], v[r][j][3]); w.z = pk2(v[r][j][4], v[r][j][5]); w.w = pk2(v[r][j][6], v[r][j][7]); *(u32x4*)(HB + (size_t)m * DM + c) = w; } }
            if (ROUTER) {
                float lg[NEXP];
#pragma unroll
                for (int e = 0; e < NEXP; ++e) lg[e] = 0.f;
#pragma unroll
                for (int j = 0; j < 2; ++j)
#pragma unroll
                    for (int i = 0; i < 8; ++i) { const int c = j * 512 + F.lane * 8 + i; const f32x4 w0 = *(const f32x4*)(wr_ + (size_t)c * NEXP), w1 = *(const f32x4*)(wr_ + (size_t)c * NEXP + 4); const float x = v[r][j][i];
                        lg[0] += x * w0.x; lg[1] += x * w0.y; lg[2] += x * w0.z; lg[3] += x * w0.w; lg[4] += x * w1.x; lg[5] += x * w1.y; lg[6] += x * w1.z; lg[7] += x * w1.w; }
#pragma unroll
                for (int e = 0; e < NEXP; ++e) lg[e] = wave_sum(lg[e], F.lane);
                int e0 = 0; float l0 = lg[0];
#pragma unroll
                for (int e = 1; e < NEXP; ++e) if (lg[e] > l0) { l0 = lg[e]; e0 = e; }
                int e1 = -1; float l1 = -3.4e38f;
#pragma unroll
                for (int e = 0; e < NEXP; ++e) if (e != e0 && lg[e] > l1) { l1 = lg[e]; e1 = e; }
                if (e1 < 0) e1 = (e0 + 1) & 7;
                const float g1 = 1.f / (1.f + __expf(l0 - l1)), g0 = 1.f - g1;
                if (F.lane == 0) {
                    const int idx = (F.wave * 16 + k0 + r) * 2;
                    lrec[idx] = m * 16 + e0; lrec[idx + 1] = m * 16 + e1;
                    TOKE[m * 2] = e0; TOKE[m * 2 + 1] = e1; TOKW[m * 2] = g0; TOKW[m * 2 + 1] = g1;
                }
            }
        }
    }
    if (ROUTER) {
        __syncthreads();
        unsigned* cnt = (unsigned*)(ws + WS_CTL) + CW_MOE + moe_layer * 64;
        int* wgcnt = (int*)(ws + WS_CTL) + CW_WGCNT + moe_layer * 2048 + (int)blockIdx.x * 8;
        LAS int* wcnt = lrank;
        int rec = 0, e = 0, r = 0;
        if (F.wave < 4) { rec = lrec[F.tid]; e = rec & 15;
            const unsigned long long lt = (1ull << F.lane) - 1ull;
#pragma unroll
            for (int x = 0; x < 8; ++x) { const unsigned long long b = __builtin_amdgcn_ballot_w64(e == x); if (e == x) r = __builtin_popcountll(b & lt); if (F.lane == 0) wcnt[F.wave * 8 + x] = __builtin_popcountll(b); } }
        __syncthreads();
        if (F.wave < 4) { for (int w = 0; w < F.wave; ++w) r += wcnt[w * 8 + e]; TOKR[(rec >> 4) * 2 + (F.tid & 1)] = r; }
        if (F.tid < 8) lcnt[F.tid] = wcnt[F.tid] + wcnt[8 + F.tid] + wcnt[16 + F.tid] + wcnt[24 + F.tid];
        __syncthreads();
        if (F.tid < 8) { wgcnt[F.tid] = lcnt[F.tid]; __hip_atomic_fetch_add(cnt + F.tid, (unsigned)lcnt[F.tid], __ATOMIC_RELAXED, __HIP_MEMORY_SCOPE_AGENT); }
    }
}

DEVI void moe_tiles(const unsigned* cnt, int (&ts)[9]) { ts[0] = 0;
#pragma unroll
    for (int e = 0; e < 8; ++e) ts[e + 1] = ts[e] + (int)((__hip_atomic_load(cnt + e, __ATOMIC_RELAXED, __HIP_MEMORY_SCOPE_AGENT) + 255u) >> 8); }
DEVI void phase_moe_scatter(Frame& F, int moe_layer) {
    F.refresh();
    unsigned char* ws = F.ws;
    const unsigned* cnt = (const unsigned*)(ws + WS_CTL) + CW_MOE + moe_layer * 64;
    int ts[9]; moe_tiles(cnt, ts);
    LAS int* wbase = (LAS int*)(F.lds + LDS_X);
    if (F.tid < 8) wbase[F.tid] = 0;
    __syncthreads();
    if (F.tid < (int)blockIdx.x) { const int* wc = (const int*)(ws + WS_CTL) + CW_WGCNT + moe_layer * 2048 + F.tid * 8;
        const u32x4 c0 = *(const u32x4*)wc, c1 = *(const u32x4*)(wc + 4);
#pragma unroll
        for (int e = 0; e < 4; ++e) { __hip_atomic_fetch_add(wbase + e, (int)c0[e], __ATOMIC_RELAXED, __HIP_MEMORY_SCOPE_WORKGROUP); __hip_atomic_fetch_add(wbase + 4 + e, (int)c1[e], __ATOMIC_RELAXED, __HIP_MEMORY_SCOPE_WORKGROUP); } }
    __syncthreads();
    const int* TOKE = (const int*)(ws + WS_ROUTE); const int* TOKR = TOKE + MTOK * 2; int* TOKP = (int*)(ws + WS_ROUTE) + MTOK * 6;
    const bf16_t* HB = (const bf16_t*)(ws + WS_HB); bf16_t* XB = (bf16_t*)(ws + WS_XB);
    const int gw = F.vcu * NWAVES + F.wave, NGW = F.G * NWAVES;
#pragma unroll 1
    for (int k0 = 0; k0 < 16; k0 += 4) {
        u32x4 r0[4], r1[4]; int ee[4][2], rk[4][2];
#pragma unroll
        for (int q = 0; q < 4; ++q) { const int m = gw + (k0 + q) * NGW; r0[q] = *(const u32x4*)(HB + (size_t)m * DM + F.lane * 8); r1[q] = *(const u32x4*)(HB + (size_t)m * DM + 512 + F.lane * 8);
            ee[q][0] = TOKE[m * 2]; ee[q][1] = TOKE[m * 2 + 1]; rk[q][0] = TOKR[m * 2]; rk[q][1] = TOKR[m * 2 + 1]; }
#pragma unroll
        for (int q = 0; q < 4; ++q) { const int m = gw + (k0 + q) * NGW;
#pragma unroll
            for (int k = 0; k < 2; ++k) { const int e = ee[q][k], r = rk[q][k];
                int st = 0;
#pragma unroll
                for (int j = 1; j < 8; ++j) st = (e >= j) ? ts[j] : st;
                const int pos = st * 256 + wbase[e] + r;
                *(u32x4*)(XB + (size_t)pos * DM + F.lane * 8) = r0[q]; *(u32x4*)(XB + (size_t)pos * DM + 512 + F.lane * 8) = r1[q];
                if (F.lane == 0) TOKP[m * 2 + k] = pos; } }
    }
}

DEVI void phase_nsa_naive(Frame& F) {
    F.refresh();
    unsigned char* ws = F.ws;
    const bf16_t* Q = (const bf16_t*)(ws + RA_Q); bf16_t* ATT = (bf16_t*)(ws + RA_ATT);
    const bf16_t* KC = (const bf16_t*)(ws + RA_KC); const bf16_t* VC = (const bf16_t*)(ws + RA_VC);
    const bf16_t* KS = (const bf16_t*)(ws + RA_KS); const bf16_t* VS = (const bf16_t*)(ws + RA_VS);
    const bf16_t* KW = (const bf16_t*)(ws + RA_KW); const bf16_t* VW = (const bf16_t*)(ws + RA_VW);
    const float* GT = (const float*)(ws + RA_GATE); const float* CS = (const float*)(ws + WS_CS);
    LAS float* sc = (LAS float*)(F.lds + F.wave * 16384);
    LAS float* qs_ = (LAS float*)(F.lds + LDS_X + F.wave * 2048);
    LAS float* qr_ = qs_ + 256;
    const int lane = F.lane;
    const int gw = F.vcu * NWAVES + F.wave, NGW = F.G * NWAVES;
    for (int u = gw; u < MTOK * A_G; u += NGW) {
        const int bg = u / SEQ, t = u % SEQ, b = bg / A_G, g = bg % A_G; const int tok = b * SEQ + t;
        { const bf16_t* qp = Q + (size_t)tok * DM + g * 256 + lane * 4; const u32x2 w = *(const u32x2*)qp;
          float x[4] = {bflo(w.x), bfhi(w.x), bflo(w.y), bfhi(w.y)};
#pragma unroll
          for (int i = 0; i < 4; ++i) qs_[lane * 4 + i] = x[i];
          LDS_WAIT();
          const int d0 = (lane * 4) & 63;
#pragma unroll
          for (int i = 0; i < 4; ++i) { const int d = d0 + i; float v = x[i];
              if (d < 8) v = x[i] * CS[(size_t)tok * 16 + d] - qs_[lane * 4 + i + 8] * CS[(size_t)tok * 16 + 8 + d];
              else if (d < 16) v = x[i] * CS[(size_t)tok * 16 + d - 8] + qs_[lane * 4 + i - 8] * CS[(size_t)tok * 16 + d];
              qr_[lane * 4 + i] = v; }
          LDS_WAIT(); }
        float oc[4] = {0.f, 0.f, 0.f, 0.f}, os[4] = {0.f, 0.f, 0.f, 0.f}, ow[4] = {0.f, 0.f, 0.f, 0.f};
        const int cur = t >> 6;
        const int nv = t >= 31 ? ((t - 31) >> 4) + 1 : 0;
        float impv[4] = {0.f, 0.f, 0.f, 0.f};
        if (nv > 0) {
            const bf16_t* kc = KC + (size_t)bg * 1024 * 64; const bf16_t* vc = VC + (size_t)bg * 1024 * 64;
            float mx[4] = {-3.0e38f, -3.0e38f, -3.0e38f, -3.0e38f};
            for (int c = 0; c * 64 < nv; ++c) { const int n = c * 64 + lane;
                if (n < nv) { float s[4] = {0.f, 0.f, 0.f, 0.f}; LAS float* qs = qs_; asm volatile("" : "+v"(qs));
#pragma unroll 2
                    for (int d8 = 0; d8 < 8; ++d8) { const u32x4 w = *(const u32x4*)(kc + (size_t)n * 64 + d8 * 8);
                        const float kf[8] = {bflo(w.x), bfhi(w.x), bflo(w.y), bfhi(w.y), bflo(w.z), bfhi(w.z), bflo(w.w), bfhi(w.w)};
#pragma unroll
                        for (int r = 0; r < 4; ++r) { const f32x4 qa = *(const LAS f32x4*)(qs + r * 64 + d8 * 8), qb = *(const LAS f32x4*)(qs + r * 64 + d8 * 8 + 4);
                            s[r] += qa.x * kf[0] + qa.y * kf[1] + qa.z * kf[2] + qa.w * kf[3] + qb.x * kf[4] + qb.y * kf[5] + qb.z * kf[6] + qb.w * kf[7]; } }
#pragma unroll
                    for (int r = 0; r < 4; ++r) { s[r] *= QSCALE; mx[r] = fmaxf(mx[r], s[r]); }
                    *(LAS f32x4*)(sc + n * 4) = (f32x4){s[0], s[1], s[2], s[3]}; } }
            float l[4] = {0.f, 0.f, 0.f, 0.f};
#pragma unroll
            for (int r = 0; r < 4; ++r) mx[r] = wave_max(mx[r], lane);
            LDS_WAIT();
            for (int c = 0; c * 64 < nv; ++c) { const int n = c * 64 + lane;
                if (n < nv) { f32x4 s = *(const LAS f32x4*)(sc + n * 4);
#pragma unroll
                    for (int r = 0; r < 4; ++r) { s[r] = __expf(s[r] - mx[r]); l[r] += s[r]; }
                    *(LAS f32x4*)(sc + n * 4) = s; } }
#pragma unroll
            for (int r = 0; r < 4; ++r) l[r] = 1.f / wave_sum(l[r], lane);
            LDS_WAIT();
            for (int c = 0; c * 64 < nv; ++c) { const int n = c * 64 + lane;
                if (n < nv) { f32x4 s = *(const LAS f32x4*)(sc + n * 4);
#pragma unroll
                    for (int r = 0; r < 4; ++r) s[r] *= l[r];
                    *(LAS f32x4*)(sc + n * 4) = s; } }
            LDS_WAIT();
#pragma unroll 4
            for (int n = 0; n < nv; ++n) { const float v = bf2f(vc[(size_t)n * 64 + lane]); const f32x4 p = *(const LAS f32x4*)(sc + n * 4);
#pragma unroll
                for (int r = 0; r < 4; ++r) oc[r] += p[r] * v; }
#pragma unroll
            for (int i = 0; i < 4; ++i) { const int j = lane + 64 * i; float acc = 0.f;
#pragma unroll
                for (int k = -1; k <= 3; ++k) { const int n = 4 * j + k; if (n >= 0 && n < nv) { const f32x4 p = *(const LAS f32x4*)(sc + n * 4); const float ps = (p.x + p.y) + (p.z + p.w); acc += (k == -1 || k == 3) ? 0.5f * ps : ps; } }
                impv[i] = acc; }
        }
        float scv[4];
#pragma unroll
        for (int i = 0; i < 4; ++i) { const int j = lane + 64 * i; scv[i] = j > cur ? -1.f : ((j == 0 || j == cur || j == cur - 1) ? 1e9f : impv[i]); }
        LAS int* sel = (LAS int*)(F.lds + MISC_OFF + 256) + F.wave * 16;
#pragma unroll 1
        for (int k = 0; k < NSEL; ++k) {
            float bv = -2.f; int bi = 1 << 20;
#pragma unroll
            for (int i = 0; i < 4; ++i) { const int j = lane + 64 * i; if (scv[i] > bv) { bv = scv[i]; bi = j; } }
#pragma unroll
            for (int o = 1; o < 64; o <<= 1) { const float ov = shx(bv, o, lane); const int oi = shxi(bi, o, lane); if (ov > bv || (ov == bv && oi < bi)) { bv = ov; bi = oi; } }
            if (lane == 0) sel[k] = bi;
#pragma unroll
            for (int i = 0; i < 4; ++i) if (lane + 64 * i == bi) scv[i] = -3.f;
        }
        LDS_WAIT();
        {   const bf16_t* ks = KS + (size_t)bg * SEQ * 64; const bf16_t* vs = VS + (size_t)bg * SEQ * 64;
            float mx[4] = {-3.0e38f, -3.0e38f, -3.0e38f, -3.0e38f};
#pragma unroll 1
            for (int k = 0; k < NSEL; ++k) { const int pos = sel[k] * 64 + lane; const bool ok = pos <= t;
                float s[4] = {-1e30f, -1e30f, -1e30f, -1e30f};
                if (ok) { LAS float* qr = qr_; asm volatile("" : "+v"(qr));
#pragma unroll
                    for (int r = 0; r < 4; ++r) s[r] = 0.f;
#pragma unroll 2
                    for (int d8 = 0; d8 < 8; ++d8) { const u32x4 w = *(const u32x4*)(ks + (size_t)pos * 64 + d8 * 8);
                        const float kf[8] = {bflo(w.x), bfhi(w.x), bflo(w.y), bfhi(w.y), bflo(w.z), bfhi(w.z), bflo(w.w), bfhi(w.w)};
#pragma unroll
                        for (int r = 0; r < 4; ++r) { const f32x4 qa = *(const LAS f32x4*)(qr + r * 64 + d8 * 8), qb = *(const LAS f32x4*)(qr + r * 64 + d8 * 8 + 4);
                            s[r] += qa.x * kf[0] + qa.y * kf[1] + qa.z * kf[2] + qa.w * kf[3] + qb.x * kf[4] + qb.y * kf[5] + qb.z * kf[6] + qb.w * kf[7]; } }
#pragma unroll
                    for (int r = 0; r < 4; ++r) { s[r] *= QSCALE; mx[r] = fmaxf(mx[r], s[r]); } }
                *(LAS f32x4*)(sc + (k * 64 + lane) * 4) = (f32x4){s[0], s[1], s[2], s[3]}; }
            float l[4] = {0.f, 0.f, 0.f, 0.f};
#pragma unroll
            for (int r = 0; r < 4; ++r) mx[r] = wave_max(mx[r], lane);
            LDS_WAIT();
#pragma unroll 1
            for (int k = 0; k < NSEL; ++k) { const int pos = sel[k] * 64 + lane; const bool ok = pos <= t; f32x4 s = *(const LAS f32x4*)(sc + (k * 64 + lane) * 4);
#pragma unroll
                for (int r = 0; r < 4; ++r) { s[r] = ok ? __expf(s[r] - mx[r]) : 0.f; l[r] += s[r]; }
                *(LAS f32x4*)(sc + (k * 64 + lane) * 4) = s; }
#pragma unroll
            for (int r = 0; r < 4; ++r) l[r] = 1.f / wave_sum(l[r], lane);
            LDS_WAIT();
#pragma unroll 1
            for (int k = 0; k < NSEL; ++k) { const int p0 = sel[k] * 64; if (p0 > t) continue;
#pragma unroll 4
                for (int i = 0; i < 64; ++i) { const int pos = p0 + i; if (pos > t) break; const float v = bf2f(vs[(size_t)pos * 64 + lane]); const f32x4 p = *(const LAS f32x4*)(sc + (k * 64 + i) * 4);
#pragma unroll
                    for (int r = 0; r < 4; ++r) os[r] += p[r] * v; } }
#pragma unroll
            for (int r = 0; r < 4; ++r) os[r] *= l[r];
            LDS_WAIT();
        }
        {   const bf16_t* kw = KW + (size_t)bg * SEQ * 64; const bf16_t* vw = VW + (size_t)bg * SEQ * 64;
            float mx[4] = {-3.0e38f, -3.0e38f, -3.0e38f, -3.0e38f};
#pragma unroll 1
            for (int c = 0; c < 8; ++c) { const int pos = t - 511 + c * 64 + lane; const bool ok = pos >= 0;
                float s[4] = {-1e30f, -1e30f, -1e30f, -1e30f};
                if (ok) { LAS float* qr = qr_; asm volatile("" : "+v"(qr));
#pragma unroll
                    for (int r = 0; r < 4; ++r) s[r] = 0.f;
#pragma unroll 2
                    for (int d8 = 0; d8 < 8; ++d8) { const u32x4 w = *(const u32x4*)(kw + (size_t)pos * 64 + d8 * 8);
                        const float kf[8] = {bflo(w.x), bfhi(w.x), bflo(w.y), bfhi(w.y), bflo(w.z), bfhi(w.z), bflo(w.w), bfhi(w.w)};
#pragma unroll
                        for (int r = 0; r < 4; ++r) { const f32x4 qa = *(const LAS f32x4*)(qr + r * 64 + d8 * 8), qb = *(const LAS f32x4*)(qr + r * 64 + d8 * 8 + 4);
                            s[r] += qa.x * kf[0] + qa.y * kf[1] + qa.z * kf[2] + qa.w * kf[3] + qb.x * kf[4] + qb.y * kf[5] + qb.z * kf[6] + qb.w * kf[7]; } }
#pragma unroll
                    for (int r = 0; r < 4; ++r) { s[r] *= QSCALE; mx[r] = fmaxf(mx[r], s[r]); } }
                *(LAS f32x4*)(sc + (c * 64 + lane) * 4) = (f32x4){s[0], s[1], s[2], s[3]}; }
            float l[4] = {0.f, 0.f, 0.f, 0.f};
#pragma unroll
            for (int r = 0; r < 4; ++r) mx[r] = wave_max(mx[r], lane);
            LDS_WAIT();
#pragma unroll 1
            for (int c = 0; c < 8; ++c) { const int pos = t - 511 + c * 64 + lane; const bool ok = pos >= 0; f32x4 s = *(const LAS f32x4*)(sc + (c * 64 + lane) * 4);
#pragma unroll
                for (int r = 0; r < 4; ++r) { s[r] = ok ? __expf(s[r] - mx[r]) : 0.f; l[r] += s[r]; }
                *(LAS f32x4*)(sc + (c * 64 + lane) * 4) = s; }
#pragma unroll
            for (int r = 0; r < 4; ++r) l[r] = 1.f / wave_sum(l[r], lane);
            LDS_WAIT();
#pragma unroll 4
            for (int i = (t >= 511 ? 0 : 511 - t); i < 512; ++i) { const int pos = t - 511 + i; const float v = bf2f(vw[(size_t)pos * 64 + lane]); const f32x4 p = *(const LAS f32x4*)(sc + i * 4);
#pragma unroll
                for (int r = 0; r < 4; ++r) ow[r] += p[r] * v; }
#pragma unroll
            for (int r = 0; r < 4; ++r) ow[r] *= l[r];
            LDS_WAIT();
        }
#pragma unroll
        for (int r = 0; r < 4; ++r) { const float gc = GT[(size_t)tok * 48 + 0 * 16 + g * 4 + r], gs = GT[(size_t)tok * 48 + 1 * 16 + g * 4 + r], gwv = GT[(size_t)tok * 48 + 2 * 16 + g * 4 + r];
            const float o = ((DBG_DROP & 1) ? 0.f : gc * oc[r]) + ((DBG_DROP & 2) ? 0.f : gs * os[r]) + ((DBG_DROP & 4) ? 0.f : gwv * ow[r]);
            ATT[(size_t)tok * DM + g * 256 + r * 64 + lane] = (bf16_t)f2bf(o); }
    }
}

DEVI void phase_swa_naive(Frame& F, const float* sinks) {
    F.refresh();
    unsigned char* ws = F.ws;
    const bf16_t* Q = (const bf16_t*)(ws + RA_Q); bf16_t* ATT = (bf16_t*)(ws + RA_ATT);
    const bf16_t* KS = (const bf16_t*)(ws + WS_KSH); const bf16_t* VS = (const bf16_t*)(ws + WS_VSH);
    LAS float* sc = (LAS float*)(F.lds + F.wave * 16384);
    LAS float* qs_ = (LAS float*)(F.lds + LDS_X + F.wave * 2048);
    const int lane = F.lane;
    const int gw = F.vcu * NWAVES + F.wave, NGW = F.G * NWAVES;
    for (int u = gw; u < MTOK * B_G; u += NGW) {
        const int bg = u / SEQ, t = u % SEQ, b = bg / B_G, g = bg % B_G; const int tok = b * SEQ + t;
        { const u32x4 w = *(const u32x4*)(Q + (size_t)tok * DM + g * 512 + lane * 8);
          const float x[8] = {bflo(w.x), bfhi(w.x), bflo(w.y), bfhi(w.y), bflo(w.z), bfhi(w.z), bflo(w.w), bfhi(w.w)};
#pragma unroll
          for (int i = 0; i < 8; ++i) qs_[lane * 8 + i] = x[i];
          LDS_WAIT(); }
        const bf16_t* kp = KS + (size_t)bg * SEQ * 64; const bf16_t* vp = VS + (size_t)bg * SEQ * 64;
        float mx[8], l[8], o[8];
#pragma unroll
        for (int r = 0; r < 8; ++r) { mx[r] = sinks[g * 8 + r]; l[r] = 0.f; o[r] = 0.f; }
#pragma unroll 1
        for (int c = 0; c < 2; ++c) { const int pos = t - 127 + c * 64 + lane; const bool ok = pos >= 0;
            float s[8];
#pragma unroll
            for (int r = 0; r < 8; ++r) s[r] = -1e30f;
            if (ok) { LAS float* qs = qs_; asm volatile("" : "+v"(qs));
#pragma unroll
                for (int r = 0; r < 8; ++r) s[r] = 0.f;
#pragma unroll 1
                for (int d8 = 0; d8 < 8; ++d8) { const u32x4 w = *(const u32x4*)(kp + (size_t)pos * 64 + d8 * 8);
                    const float kf[8] = {bflo(w.x), bfhi(w.x), bflo(w.y), bfhi(w.y), bflo(w.z), bfhi(w.z), bflo(w.w), bfhi(w.w)};
#pragma unroll
                    for (int r = 0; r < 8; ++r) { const f32x4 qa = *(const LAS f32x4*)(qs + r * 64 + d8 * 8), qb = *(const LAS f32x4*)(qs + r * 64 + d8 * 8 + 4);
                        s[r] += qa.x * kf[0] + qa.y * kf[1] + qa.z * kf[2] + qa.w * kf[3] + qb.x * kf[4] + qb.y * kf[5] + qb.z * kf[6] + qb.w * kf[7]; } }
#pragma unroll
                for (int r = 0; r < 8; ++r) { s[r] *= QSCALE; mx[r] = fmaxf(mx[r], s[r]); } }
            *(LAS f32x4*)(sc + (c * 64 + lane) * 8) = (f32x4){s[0], s[1], s[2], s[3]}; *(LAS f32x4*)(sc + (c * 64 + lane) * 8 + 4) = (f32x4){s[4], s[5], s[6], s[7]}; }
#pragma unroll
        for (int r = 0; r < 8; ++r) mx[r] = wave_max(mx[r], lane);
        LDS_WAIT();
#pragma unroll
        for (int c = 0; c < 2; ++c) { const int pos = t - 127 + c * 64 + lane; const bool ok = pos >= 0;
            f32x4 s0 = *(const LAS f32x4*)(sc + (c * 64 + lane) * 8), s1 = *(const LAS f32x4*)(sc + (c * 64 + lane) * 8 + 4);
#pragma unroll
            for (int r = 0; r < 4; ++r) { s0[r] = ok ? __expf(s0[r] - mx[r]) : 0.f; l[r] += s0[r]; s1[r] = ok ? __expf(s1[r] - mx[r + 4]) : 0.f; l[r + 4] += s1[r]; }
            *(LAS f32x4*)(sc + (c * 64 + lane) * 8) = s0; *(LAS f32x4*)(sc + (c * 64 + lane) * 8 + 4) = s1; }
#pragma unroll
        for (int r = 0; r < 8; ++r) l[r] = 1.f / (wave_sum(l[r], lane) + __expf(sinks[g * 8 + r] - mx[r]));
        LDS_WAIT();
#pragma unroll 4
        for (int i = (t >= 127 ? 0 : 127 - t); i < 128; ++i) { const int pos = t - 127 + i; const float v = bf2f(vp[(size_t)pos * 64 + lane]);
            const f32x4 p0 = *(const LAS f32x4*)(sc + i * 8), p1 = *(const LAS f32x4*)(sc + i * 8 + 4);
#pragma unroll
            for (int r = 0; r < 4; ++r) { o[r] += p0[r] * v; o[r + 4] += p1[r] * v; } }
#pragma unroll
        for (int r = 0; r < 8; ++r) ATT[(size_t)tok * DM + g * 512 + r * 64 + lane] = (bf16_t)f2bf(o[r] * l[r]);
        LDS_WAIT();
    }
}

namespace fa {
typedef short v4i16_t __attribute__((ext_vector_type(4)));
constexpr float CEXP = 0.125f * 1.4426950408889634f;
constexpr float NEGINF = -__builtin_huge_valf();
constexpr int VLD = 160;
constexpr int KVB = 8192 + 64 * VLD;
constexpr int L_KV = 0;
constexpr int L_IMP = 2 * KVB;
constexpr int IMP_LD = 264;
constexpr int OS_LD = 65;
constexpr int L_Q = L_IMP + 64 * IMP_LD * 4;
constexpr int L_ML = L_Q + 32768;
constexpr int L_MASK = L_ML + 2048;
constexpr int L_LIST = L_MASK + 2048;
constexpr int L_TOK = L_LIST + 1056;
constexpr int L_END = L_TOK + 2048;
static_assert(256 * OS_LD * 4 <= 64 * IMP_LD * 4, "accumulator fits the importance table");
static_assert(L_END <= MISC_OFF, "attention LDS map");

struct Stage { u32x4 k, v; };
template <bool WITHV> DEVI void stage_load(Stage& s, const bf16_t* K, const bf16_t* V, int tid) { s.k = *(const u32x4*)((const char*)K + tid * 16); if (WITHV) s.v = *(const u32x4*)((const char*)V + tid * 16); }
template <bool WITHV> DEVI void stage_write(const Stage& s, LAS unsigned char* buf, int tid) {
    const int r = tid >> 3, c = tid & 7;
    *(LAS u32x4*)(buf + r * 128 + ((c ^ (r & 7)) << 4)) = s.k;
    if (WITHV) *(LAS u32x4*)(buf + 8192 + r * VLD + (c << 4)) = s.v;
}
DEVI float max_quads(float x) {
    auto a = __builtin_amdgcn_permlane16_swap(__float_as_uint(x), __float_as_uint(x), false, false); x = fmaxf(__uint_as_float(a[0]), __uint_as_float(a[1]));
    auto b = __builtin_amdgcn_permlane32_swap(__float_as_uint(x), __float_as_uint(x), false, false); return fmaxf(__uint_as_float(b[0]), __uint_as_float(b[1]));
}
DEVI float sum_quads(float x) {
    auto a = __builtin_amdgcn_permlane16_swap(__float_as_uint(x), __float_as_uint(x), false, false); x = __uint_as_float(a[0]) + __uint_as_float(a[1]);
    auto b = __builtin_amdgcn_permlane32_swap(__float_as_uint(x), __float_as_uint(x), false, false); return __uint_as_float(b[0]) + __uint_as_float(b[1]);
}
template <int CTRL> DEVI float dppf(float v) { return __int_as_float(__builtin_amdgcn_update_dpp(0, __float_as_int(v), CTRL, 0xF, 0xF, false)); }
template <int CTRL> DEVI int dppi(int v) { return __builtin_amdgcn_update_dpp(0, v, CTRL, 0xF, 0xF, false); }
DEVI float bperm(float v, int src_lane) { return __builtin_bit_cast(float, __builtin_amdgcn_ds_bpermute(src_lane << 2, __builtin_bit_cast(int, v))); }
#define DPP_X1 0xB1
#define DPP_X2 0x4E
#define DPP_HM 0x141

DEVI void qk_slot(LAS const unsigned char* kb, const bf16x8 q0, const bf16x8 q1, int lane, f32x4 (&s)[4]) {
    const int l15 = lane & 15, quad = lane >> 4;
    LAS const unsigned char* p0 = kb + l15 * 128 + (((quad) ^ (l15 & 7)) << 4);
    LAS const unsigned char* p1 = kb + l15 * 128 + (((4 + quad) ^ (l15 & 7)) << 4);
#pragma unroll
    for (int kg = 0; kg < 4; ++kg) {
        const bf16x8 a0 = *(LAS const bf16x8*)(p0 + kg * 2048), a1 = *(LAS const bf16x8*)(p1 + kg * 2048);
        f32x4 z = {0.f, 0.f, 0.f, 0.f};
        z = __builtin_amdgcn_mfma_f32_16x16x32_bf16(a0, q0, z, 0, 0, 0);
        s[kg] = __builtin_amdgcn_mfma_f32_16x16x32_bf16(a1, q1, z, 0, 0, 0);
    }
}
DEVI float mask_max(f32x4 (&s)[4], int lo, int hi, int quad) {
    float mx = NEGINF; const int loq = lo - 4 * quad, hiq = hi - 4 * quad;
#pragma unroll
    for (int kg = 0; kg < 4; ++kg)
#pragma unroll
        for (int i = 0; i < 4; ++i) { const bool ok = (16 * kg + i >= loq) & (16 * kg + i <= hiq); s[kg][i] = ok ? s[kg][i] : NEGINF; mx = fmaxf(mx, s[kg][i]); }
    return max_quads(mx);
}
DEVI bf16x8 pack_p(const f32x4 a, const f32x4 b) { u32x4 w; w.x = pg8::cvt_pk_bf16(a[0], a[1]); w.y = pg8::cvt_pk_bf16(a[2], a[3]); w.z = pg8::cvt_pk_bf16(b[0], b[1]); w.w = pg8::cvt_pk_bf16(b[2], b[3]); return __builtin_bit_cast(bf16x8, w); }
DEVI void pv_slot(LAS const unsigned char* vb, const bf16x8 (&pb)[2], f32x4 (&o)[4], int lane) {
    const int i = lane & 15, quad = lane >> 4;
    LAS const unsigned char* a0 = vb + (4 * quad + (i >> 2)) * VLD + ((i & 3) << 3);
#pragma unroll
    for (int ks2 = 0; ks2 < 2; ++ks2) {
#pragma unroll
        for (int dg = 0; dg < 4; ++dg) {
            const v4i16_t t0 = __builtin_amdgcn_ds_read_tr16_b64_v4i16((LAS v4i16_t*)(a0 + (32 * ks2) * VLD + 32 * dg));
            const v4i16_t t1 = __builtin_amdgcn_ds_read_tr16_b64_v4i16((LAS v4i16_t*)(a0 + (32 * ks2 + 16) * VLD + 32 * dg));
            const bf16x8 a = {t0[0], t0[1], t0[2], t0[3], t1[0], t1[1], t1[2], t1[3]};
            o[dg] = __builtin_amdgcn_mfma_f32_16x16x32_bf16(a, pb[ks2], o[dg], 0, 0, 0);
        }
    }
}
template <bool PV> DEVI void online_step(LAS const unsigned char* buf, const bf16x8 q0, const bf16x8 q1, int lo, int hi, float& m, float& l, f32x4 (&o)[4], int lane) {
    __builtin_amdgcn_sched_barrier(0);
    f32x4 s[4]; qk_slot(buf, q0, q1, lane, s);
    __builtin_amdgcn_sched_barrier(0);
    const int quad = lane >> 4;
    float mx;
    if (__builtin_amdgcn_ballot_w64((lo > 0) | (hi < 63)) != 0ull) mx = mask_max(s, lo, hi, quad);
    else { float a = fmaxf(fmaxf(s[0][0], s[0][1]), fmaxf(s[0][2], s[0][3])), b = fmaxf(fmaxf(s[1][0], s[1][1]), fmaxf(s[1][2], s[1][3]));
           a = fmaxf(a, fmaxf(fmaxf(s[2][0], s[2][1]), fmaxf(s[2][2], s[2][3]))); b = fmaxf(b, fmaxf(fmaxf(s[3][0], s[3][1]), fmaxf(s[3][2], s[3][3]))); mx = max_quads(fmaxf(a, b)); }
    const float mnew = fmaxf(m, mx);
    const float msafe = (mnew == NEGINF) ? 0.f : mnew;
    const float alpha = __builtin_amdgcn_exp2f((m - msafe) * CEXP);
    const float mc = -msafe * CEXP;
    float ps = 0.f;
#pragma unroll
    for (int kg = 0; kg < 4; ++kg)
#pragma unroll
        for (int i = 0; i < 4; ++i) { s[kg][i] = __builtin_amdgcn_exp2f(__builtin_fmaf(s[kg][i], CEXP, mc)); ps += s[kg][i]; }
    l = l * alpha + ps; m = mnew;
    if (PV) {
        if (__builtin_amdgcn_ballot_w64(alpha != 1.f) != 0ull) {
#pragma unroll
            for (int dg = 0; dg < 4; ++dg) o[dg] = o[dg] * alpha;
        }
        bf16x8 pb[2]; pb[0] = pack_p(s[0], s[1]); pb[1] = pack_p(s[2], s[3]);
        pv_slot(buf + 8192, pb, o, lane);
    }
    __builtin_amdgcn_sched_barrier(0);
}
template <bool PV> DEVI void fixed_step(LAS const unsigned char* buf, const bf16x8 q0, const bf16x8 q1, int lo, int hi, float mc, float& l, f32x4 (&o)[4], int lane) {
    __builtin_amdgcn_sched_barrier(0);
    f32x4 s[4]; qk_slot(buf, q0, q1, lane, s);
    __builtin_amdgcn_sched_barrier(0);
    const int quad = lane >> 4;
    float ps = 0.f;
    if (__builtin_amdgcn_ballot_w64((lo > 0) | (hi < 63)) != 0ull) { const int loq = lo - 4 * quad, hiq = hi - 4 * quad;
#pragma unroll
        for (int kg = 0; kg < 4; ++kg)
#pragma unroll
            for (int i = 0; i < 4; ++i) { const bool ok = (16 * kg + i >= loq) & (16 * kg + i <= hiq); s[kg][i] = ok ? __builtin_amdgcn_exp2f(__builtin_fmaf(s[kg][i], CEXP, mc)) : 0.f; ps += s[kg][i]; }
    } else {
#pragma unroll
        for (int kg = 0; kg < 4; ++kg)
#pragma unroll
            for (int i = 0; i < 4; ++i) { s[kg][i] = __builtin_amdgcn_exp2f(__builtin_fmaf(s[kg][i], CEXP, mc)); ps += s[kg][i]; }
    }
    l += ps;
    if (PV) { bf16x8 pb[2]; pb[0] = pack_p(s[0], s[1]); pb[1] = pack_p(s[2], s[3]); pv_slot(buf + 8192, pb, o, lane); }
    __builtin_amdgcn_sched_barrier(0);
}
DEVI void load_q(const bf16_t* Q, size_t tok, int hcol, int quad, bf16x8 (&qf)[2]) {
    const bf16_t* p = Q + tok * DM + hcol + quad * 8;
    qf[0] = *(const bf16x8*)p; qf[1] = *(const bf16x8*)(p + 32);
}
DEVI bf16x8 rope_frag(const bf16x8 q, const float* csrow, int quad, int lane) {
    const u32x4 w = __builtin_bit_cast(u32x4, q); u32x4 pw;
#pragma unroll
    for (int i = 0; i < 4; ++i) pw[i] = (unsigned)shxi((int)w[i], 16, lane);
    if (quad >= 2) return q;
    const f32x4 c0 = *(const f32x4*)csrow, c1 = *(const f32x4*)(csrow + 4), s0 = *(const f32x4*)(csrow + 8), s1 = *(const f32x4*)(csrow + 12);
    const float sg = quad == 0 ? -1.f : 1.f;
    float x[8], xp[8];
#pragma unroll
    for (int i = 0; i < 4; ++i) { x[2 * i] = bflo(w[i]); x[2 * i + 1] = bfhi(w[i]); xp[2 * i] = bflo(pw[i]); xp[2 * i + 1] = bfhi(pw[i]); }
    const float cc[8] = {c0[0], c0[1], c0[2], c0[3], c1[0], c1[1], c1[2], c1[3]}, ss[8] = {s0[0], s0[1], s0[2], s0[3], s1[0], s1[1], s1[2], s1[3]};
    u32x4 o;
#pragma unroll
    for (int i = 0; i < 4; ++i) o[i] = pg8::cvt_pk_bf16(x[2 * i] * cc[2 * i] + sg * xp[2 * i] * ss[2 * i], x[2 * i + 1] * cc[2 * i + 1] + sg * xp[2 * i + 1] * ss[2 * i + 1]);
    return __builtin_bit_cast(bf16x8, o);
}

struct KFr { bf16x8 k[4][2]; };
struct VFr { bf16x8 v[4][2]; };
constexpr float LSCALE = 1048576.f;
struct Raw8 { u32x4 k[4]; u32x4 v[4]; };
template <int OFF> DEVI void gld16(u32x4& d, const void* p) { asm volatile("global_load_dwordx4 %0, %1, off offset:%2" : "=v"(d) : "v"(p), "n"(OFF) : "memory"); }
DEVI void sel_load8(Raw8& r, const unsigned char* K8, const unsigned char* V8, int j, int lane) {
    const int l15 = lane & 15, quad = lane >> 4;
    const unsigned char* pk = K8 + ((size_t)(64 * j + l15)) * 64 + 16 * quad;
    const unsigned char* pv = V8 + (size_t)j * 4096 + l15 * 64 + 16 * quad;
    gld16<0>(r.k[0], pk); gld16<1024>(r.k[1], pk); gld16<2048>(r.k[2], pk); gld16<3072>(r.k[3], pk);
    gld16<0>(r.v[0], pv); gld16<1024>(r.v[1], pv); gld16<2048>(r.v[2], pv); gld16<3072>(r.v[3], pv);
}
template <int N> DEVI void sel_wait8(Raw8& r) {
    asm volatile("s_waitcnt vmcnt(%8)" : "+v"(r.k[0]), "+v"(r.k[1]), "+v"(r.k[2]), "+v"(r.k[3]), "+v"(r.v[0]), "+v"(r.v[1]), "+v"(r.v[2]), "+v"(r.v[3]) : "n"(N) : "memory");
    __builtin_amdgcn_sched_barrier(0);
}
typedef float f32x2v __attribute__((ext_vector_type(2)));
DEVI bf16x8 fp8x8_bf16(unsigned w0, unsigned w1) {
    const f32x2v a = __builtin_amdgcn_cvt_pk_f32_fp8((int)w0, false), b = __builtin_amdgcn_cvt_pk_f32_fp8((int)w0, true), c = __builtin_amdgcn_cvt_pk_f32_fp8((int)w1, false), d = __builtin_amdgcn_cvt_pk_f32_fp8((int)w1, true);
    u32x4 o;
    o[0] = __builtin_amdgcn_perm(__float_as_uint(a[1]), __float_as_uint(a[0]), 0x07060302u); o[1] = __builtin_amdgcn_perm(__float_as_uint(b[1]), __float_as_uint(b[0]), 0x07060302u);
    o[2] = __builtin_amdgcn_perm(__float_as_uint(c[1]), __float_as_uint(c[0]), 0x07060302u); o[3] = __builtin_amdgcn_perm(__float_as_uint(d[1]), __float_as_uint(d[0]), 0x07060302u);
    return __builtin_bit_cast(bf16x8, o);
}
DEVI void sel_expand(const Raw8& r, KFr& f, VFr& g) {
#pragma unroll
    for (int i = 0; i < 4; ++i) { f.k[i][0] = fp8x8_bf16(r.k[i][0], r.k[i][1]); f.k[i][1] = fp8x8_bf16(r.k[i][2], r.k[i][3]); g.v[i][0] = fp8x8_bf16(r.v[i][0], r.v[i][1]); g.v[i][1] = fp8x8_bf16(r.v[i][2], r.v[i][3]); }
}
template <bool PASS2> DEVI void sel_block(const KFr& f, const VFr& fv, int j, bool active, int cur, LAS const unsigned* smask, LAS const unsigned char* Ql, LAS float* mrow, LAS int* lrow, LAS int* Os, float lg2k, float lratio, LAS int* tlist, int lane) {
    const int l15 = lane & 15, quad = lane >> 4, mem = l15 >> 2;
    const bool forced = (j == 0) || (j >= cur - 1);
    int cnt = 0;
    if (active) {
        if (forced) cnt = 64;
        else { const unsigned lo = (unsigned)__builtin_amdgcn_readfirstlane((int)smask[2 * j]), hi = (unsigned)__builtin_amdgcn_readfirstlane((int)smask[2 * j + 1]);
            const unsigned long long mk = ((unsigned long long)hi << 32) | lo;
            cnt = __builtin_popcountll(mk);
            const bool mine = (mk >> lane) & 1ull; const int rank = __builtin_popcountll(mk & ((1ull << lane) - 1ull));
            if (mine) tlist[rank] = lane;
            LDS_WAIT(); }
    }
    const int ngroups = (cnt + 3) >> 2;
    const bool diag = (j == cur);
#pragma unroll 1
    for (int gi = 0; gi < ngroups; ++gi) {
        const int slot = 4 * gi + mem;
        const bool valid = slot < cnt;
        int mt = forced ? slot : tlist[slot];
        mt = valid ? mt : 0;
        const int row = mt * 4 + (l15 & 3);
        const bf16x8 q0 = *(LAS const bf16x8*)(Ql + row * 128 + (((2 * quad) ^ (row & 7)) << 4));
        const bf16x8 q1 = *(LAS const bf16x8*)(Ql + row * 128 + (((2 * quad + 1) ^ (row & 7)) << 4));
        f32x4 sc[4];
#pragma unroll
        for (int kg = 0; kg < 4; ++kg) { f32x4 z = {0.f, 0.f, 0.f, 0.f}; z = __builtin_amdgcn_mfma_f32_16x16x32_bf16(f.k[kg][0], q0, z, 0, 0, 0); sc[kg] = __builtin_amdgcn_mfma_f32_16x16x32_bf16(f.k[kg][1], q1, z, 0, 0, 0); }
        if (!PASS2) {
            float mx;
            if (diag) mx = mask_max(sc, 0, mt, quad);
            else { float a = fmaxf(fmaxf(sc[0][0], sc[0][1]), fmaxf(sc[0][2], sc[0][3])), b = fmaxf(fmaxf(sc[1][0], sc[1][1]), fmaxf(sc[1][2], sc[1][3]));
                   a = fmaxf(a, fmaxf(fmaxf(sc[2][0], sc[2][1]), fmaxf(sc[2][2], sc[2][3]))); b = fmaxf(b, fmaxf(fmaxf(sc[3][0], sc[3][1]), fmaxf(sc[3][2], sc[3][3]))); mx = max_quads(fmaxf(a, b)); }
            if (quad == 0 && valid) __hip_atomic_fetch_max(mrow + row, mx, __ATOMIC_RELAXED, __HIP_MEMORY_SCOPE_WORKGROUP);
        } else {
            const float mc = lg2k - mrow[row] * CEXP;
            float ps = 0.f;
            if (diag) { const int hiq = mt - 4 * quad;
#pragma unroll
                for (int kg = 0; kg < 4; ++kg)
#pragma unroll
                    for (int i = 0; i < 4; ++i) { sc[kg][i] = (16 * kg + i <= hiq) ? __builtin_amdgcn_exp2f(__builtin_fmaf(sc[kg][i], CEXP, mc)) : 0.f; ps += sc[kg][i]; }
            } else {
#pragma unroll
                for (int kg = 0; kg < 4; ++kg)
#pragma unroll
                    for (int i = 0; i < 4; ++i) { sc[kg][i] = __builtin_amdgcn_exp2f(__builtin_fmaf(sc[kg][i], CEXP, mc)); ps += sc[kg][i]; }
            }
            ps = sum_quads(ps);
            if (quad == 0 && valid) __hip_atomic_fetch_add(lrow + row, (int)(ps * lratio), __ATOMIC_RELAXED, __HIP_MEMORY_SCOPE_WORKGROUP);
            bf16x8 pb[2]; pb[0] = pack_p(sc[0], sc[1]); pb[1] = pack_p(sc[2], sc[3]);
            LAS int* orow = Os + row * OS_LD + 4 * quad;
#pragma unroll
            for (int dh = 0; dh < 2; ++dh) {
                f32x4 o[2];
#pragma unroll
                for (int d2 = 0; d2 < 2; ++d2) { const int dg = dh * 2 + d2; f32x4 z = {0.f, 0.f, 0.f, 0.f}; z = __builtin_amdgcn_mfma_f32_16x16x32_bf16(fv.v[dg][0], pb[0], z, 0, 0, 0); o[d2] = __builtin_amdgcn_mfma_f32_16x16x32_bf16(fv.v[dg][1], pb[1], z, 0, 0, 0); }
                if (valid) {
#pragma unroll
                    for (int d2 = 0; d2 < 2; ++d2)
#pragma unroll
                        for (int c = 0; c < 4; ++c) __hip_atomic_fetch_add(orow + 16 * (dh * 2 + d2) + c, (int)o[d2][c], __ATOMIC_RELAXED, __HIP_MEMORY_SCOPE_WORKGROUP);
                }
                __builtin_amdgcn_sched_barrier(0);
            }
        }
    }
}
#define BL(i) __builtin_amdgcn_readfirstlane(blist[(i) < nb ? (i) : nb - 1])
DEVI void sel_pass2(const unsigned char* K8, const unsigned char* V8, int nb, int cur, int wave, LAS const int* blist, LAS const unsigned* smask, LAS const unsigned char* Ql, LAS float* mrow, LAS int* lrow, LAS int* Os, float lg2k, float lratio, LAS int* tlist, int lane) {
    if (wave >= nb) return;
    Raw8 ra, rb; KFr kf; VFr vf;
    asm volatile("s_waitcnt vmcnt(0)" ::: "memory");
    sel_load8(ra, K8, V8, BL(wave), lane);
#pragma unroll 1
    for (int bi = wave; bi < nb; bi += 16) {
        sel_load8(rb, K8, V8, BL(bi + 8), lane); sel_wait8<8>(ra);
        sel_expand(ra, kf, vf);
        sel_block<true>(kf, vf, BL(bi), true, cur, smask, Ql, mrow, lrow, Os, lg2k, lratio, tlist, lane);
        sel_load8(ra, K8, V8, BL(bi + 16), lane); sel_wait8<8>(rb);
        sel_expand(rb, kf, vf);
        sel_block<true>(kf, vf, BL(bi + 8), bi + 8 < nb, cur, smask, Ql, mrow, lrow, Os, lg2k, lratio, tlist, lane);
    }
    asm volatile("s_waitcnt vmcnt(0)" ::: "memory");
}
#undef BL
}


DEVI float clamp8(float x) { return __builtin_fminf(__builtin_fmaxf(x, -448.f), 448.f); }
DEVI unsigned pack_fp8x4(float a, float b, float c, float d) {
    int w = __builtin_amdgcn_cvt_pk_fp8_f32(clamp8(a), clamp8(b), 0, false);
    return (unsigned)__builtin_amdgcn_cvt_pk_fp8_f32(clamp8(c), clamp8(d), w, true);
}
DEVI void phase_vs_transpose(Frame& F, int l) {
    F.refresh();
    unsigned char* ws = F.ws;
    const bf16_t* VS = (const bf16_t*)(ws + RA_VS); unsigned char* VT = ws + RA_VST; unsigned char* K8 = ws + RA_K8; const bf16_t* KSG = (const bf16_t*)(ws + RA_KS);
    LAS unsigned char* T = F.lds + F.wave * 9216;
    const int lane = F.lane, rr = lane >> 3, c = lane & 7, i16 = lane & 15, grp = lane >> 4;
    for (int it = ((int)blockIdx.x - 64) * NWAVES + F.wave; it < 2048; it += 192 * NWAVES) {
        const int bg = it >> 8, tile = it & 255;
        const bf16_t* vsrc = VS + ((size_t)bg * SEQ + tile * 64) * 64; const bf16_t* ksrc = KSG + ((size_t)bg * SEQ + tile * 64) * 64;
        const bf16_t* wsrc = (const bf16_t*)(ws + RA_KW) + ((size_t)bg * SEQ + tile * 64) * 64;
        unsigned char* kdst = K8 + ((size_t)bg * SEQ + tile * 64) * 64;
        u32x4 v[8], k[8], kw[8];
#pragma unroll
        for (int i = 0; i < 8; ++i) { v[i] = *(const u32x4*)(vsrc + (size_t)(8 * i + rr) * 64 + c * 8); k[i] = *(const u32x4*)(ksrc + (size_t)(8 * i + rr) * 64 + c * 8); kw[i] = *(const u32x4*)(wsrc + (size_t)(8 * i + rr) * 64 + c * 8); }
        float vmx = 0.f, kmx = 0.f, wmx = 0.f;
#pragma unroll
        for (int i = 0; i < 8; ++i) { float n2 = 0.f, w2 = 0.f;
            u32x2 k8; k8[0] = pack_fp8x4(bflo(k[i][0]), bfhi(k[i][0]), bflo(k[i][1]), bfhi(k[i][1])); k8[1] = pack_fp8x4(bflo(k[i][2]), bfhi(k[i][2]), bflo(k[i][3]), bfhi(k[i][3]));
            *(u32x2*)(kdst + (size_t)(8 * i + rr) * 64 + c * 8) = k8;
#pragma unroll
            for (int e = 0; e < 2; ++e) { const fa::f32x2v a = __builtin_amdgcn_cvt_pk_f32_fp8((int)k8[e], false), b2 = __builtin_amdgcn_cvt_pk_f32_fp8((int)k8[e], true); n2 += a[0] * a[0] + a[1] * a[1] + b2[0] * b2[0] + b2[1] * b2[1]; }
#pragma unroll
            for (int e = 0; e < 4; ++e) { const float a3 = bflo(kw[i][e]), b3 = bfhi(kw[i][e]); w2 += a3 * a3 + b3 * b3; }
            n2 += fa::dppf<DPP_X1>(n2); n2 += fa::dppf<DPP_X2>(n2); n2 += fa::dppf<DPP_HM>(n2);
            w2 += fa::dppf<DPP_X1>(w2); w2 += fa::dppf<DPP_X2>(w2); w2 += fa::dppf<DPP_HM>(w2);
            kmx = fmaxf(kmx, n2); wmx = fmaxf(wmx, w2);
            *(LAS u32x4*)(T + (8 * i + rr) * 144 + c * 16) = v[i]; }
        LDS_WAIT(); asm volatile("" ::: "memory");
        unsigned char* vdst = VT + ((size_t)bg * 256 + tile) * 4096;
#pragma unroll
        for (int dc = 0; dc < 4; ++dc) { u32x4 o;
#pragma unroll
            for (int n = 0; n < 4; ++n) { const int kg4 = n * 4 + grp;
                const fa::v4i16_t t = __builtin_amdgcn_ds_read_tr16_b64_v4i16((LAS fa::v4i16_t*)(T + (4 * kg4 + (i16 >> 2)) * 144 + (16 * dc + 4 * (i16 & 3)) * 2));
                const u32x2 tw = __builtin_bit_cast(u32x2, t);
                o[n] = pack_fp8x4(bflo(tw[0]), bfhi(tw[0]), bflo(tw[1]), bfhi(tw[1]));
                const fa::f32x2v a = __builtin_amdgcn_cvt_pk_f32_fp8((int)o[n], false), b2 = __builtin_amdgcn_cvt_pk_f32_fp8((int)o[n], true);
                vmx = fmaxf(vmx, fmaxf(fmaxf(fabsf(a[0]), fabsf(a[1])), fmaxf(fabsf(b2[0]), fabsf(b2[1])))); }
            *(u32x4*)(vdst + (16 * dc + i16) * 64 + 16 * grp) = o; }
        vmx = wave_max(vmx, lane); kmx = wave_max(kmx, lane); wmx = wave_max(wmx, lane);
        if (lane == 0) { atomicMax((unsigned*)(ws + WS_CTL) + CW_VMAX + l * 8 + bg, __float_as_uint(vmx)); atomicMax((unsigned*)(ws + WS_CTL) + CW_KMAX + l * 8 + bg, __float_as_uint(kmx));
            atomicMax((unsigned*)(ws + WS_CTL) + CW_KWMAX + l * 8 + bg, __float_as_uint(wmx)); }
        LDS_WAIT(); asm volatile("" ::: "memory");
    }
}

DEVI void phase_nsa_fast(Frame& F, int layer) {
    using namespace fa;
    F.refresh();
    unsigned char* ws = F.ws;
    const bf16_t* Q = (const bf16_t*)(ws + RA_Q); bf16_t* ATT = (bf16_t*)(ws + RA_ATT);
    const float* GT = (const float*)(ws + RA_GATE); const float* CS = (const float*)(ws + WS_CS);
    const int wave = F.wave;
    LAS unsigned char* kvb = F.lds + L_KV;
    LAS float* imp = (LAS float*)(F.lds + L_IMP);
    LAS unsigned* smask = (LAS unsigned*)(F.lds + L_MASK);
    LAS int* blist = (LAS int*)(F.lds + L_LIST);
    float kcmax2;
    {   const int bg0 = F.vcu >> 5; const bf16_t* kc0 = (const bf16_t*)(ws + RA_KC) + (size_t)bg0 * 1024 * 64;
        float mx = 0.f;
        for (int i = F.tid; i < 1024 * 8; i += NWAVES * 64) { const u32x4 w = *(const u32x4*)(kc0 + (size_t)i * 8); float n2 = 0.f;
#pragma unroll
            for (int e = 0; e < 4; ++e) { const float a = bflo(w[e]), b2 = bfhi(w[e]); n2 += a * a + b2 * b2; }
            n2 += dppf<DPP_X1>(n2); n2 += dppf<DPP_X2>(n2); n2 += dppf<DPP_HM>(n2);
            mx = fmaxf(mx, n2); }
        mx = wave_max(mx, F.lane);
        LAS float* red = (LAS float*)(F.lds + L_END);
        if (F.lane == 0) red[wave] = mx;
        __syncthreads();
        kcmax2 = fmaxf(fmaxf(fmaxf(red[0], red[1]), fmaxf(red[2], red[3])), fmaxf(fmaxf(red[4], red[5]), fmaxf(red[6], red[7])));
        __syncthreads(); }
#pragma unroll 1
    for (int ui = 0; ui < 8; ++ui) {
        int lane = F.lane; asm volatile("" : "+v"(lane));
        const int tid = wave * 64 + lane, quad = lane >> 4, l15 = lane & 15;
        int tile = (F.vcu & 31) + 32 * (ui >> 1); if (ui & 1) tile = 255 - tile;
        const int bg = F.vcu >> 5, b = bg >> 2, g = bg & 3, cur = tile, t0 = tile * 64;
        const bf16_t* KC = (const bf16_t*)(ws + RA_KC) + (size_t)bg * 1024 * 64; const bf16_t* VC = (const bf16_t*)(ws + RA_VC) + (size_t)bg * 1024 * 64;
        const bf16_t* KS = (const bf16_t*)(ws + RA_KS) + (size_t)bg * SEQ * 64; const bf16_t* VS = (const bf16_t*)(ws + RA_VS) + (size_t)bg * SEQ * 64;
        const bf16_t* KW = (const bf16_t*)(ws + RA_KW) + (size_t)bg * SEQ * 64; const bf16_t* VW = (const bf16_t*)(ws + RA_VW) + (size_t)bg * SEQ * 64;
        smask[tid] = 0u;
        int tl[2], tok[2]; bf16x8 qf[2][2];
#pragma unroll
        for (int s = 0; s < 2; ++s) { tl[s] = 8 * wave + 4 * s + (l15 >> 2); tok[s] = b * SEQ + t0 + tl[s]; load_q(Q, (size_t)tok[s], g * 256 + (l15 & 3) * 64, quad, qf[s]); }
        float gate[2][3];
#pragma unroll
        for (int s = 0; s < 2; ++s)
#pragma unroll
            for (int br = 0; br < 3; ++br) gate[s][br] = GT[(size_t)tok[s] * 48 + br * 16 + g * 4 + (l15 & 3)];
        const float vmax = fmaxf(__uint_as_float(__hip_atomic_load((const unsigned*)(ws + WS_CTL) + CW_VMAX + layer * 8 + bg, __ATOMIC_RELAXED, __HIP_MEMORY_SCOPE_AGENT)), 1e-30f);
        bf16x8 qr[2][2];
#pragma unroll
        for (int s = 0; s < 2; ++s) { qr[s][0] = rope_frag(qf[s][0], CS + (size_t)tok[s] * 16, quad, lane); qr[s][1] = qf[s][1]; }
        float qn2[2];
#pragma unroll
        for (int s = 0; s < 2; ++s) { float n2 = 0.f;
#pragma unroll
            for (int ks = 0; ks < 2; ++ks) { const u32x4 w = __builtin_bit_cast(u32x4, qf[s][ks]);
#pragma unroll
                for (int e = 0; e < 4; ++e) { const float a = bflo(w[e]), b2 = bfhi(w[e]); n2 += a * a + b2 * b2; } }
            qn2[s] = sum_quads(n2); }
        const float kwmax2 = __uint_as_float(__hip_atomic_load((const unsigned*)(ws + WS_CTL) + CW_KWMAX + layer * 8 + bg, __ATOMIC_RELAXED, __HIP_MEMORY_SCOPE_AGENT));
        f32x4 out[2][4];
#pragma unroll
        for (int s = 0; s < 2; ++s)
#pragma unroll
            for (int dg = 0; dg < 4; ++dg) out[s][dg] = (f32x4){0.f, 0.f, 0.f, 0.f};
        Stage st;
        const int ntile = (4 * cur + 3 + 63) >> 6;
        int nval[2];
#pragma unroll
        for (int s = 0; s < 2; ++s) { const int t = t0 + tl[s]; nval[s] = t >= 31 ? ((t - 31) >> 4) + 1 : 0; }
        float l[2] = {0.f, 0.f};
        const float mcc[2] = {-sqrtf(qn2[0] * kcmax2) * 1.0001f * CEXP, -sqrtf(qn2[1] * kcmax2) * 1.0001f * CEXP};
        {   stage_load<false>(st, KC, VC, tid); stage_write<false>(st, kvb, tid); __syncthreads();
#pragma unroll 1
            for (int i = 0; i < ntile; ++i) {
                LAS unsigned char* buf = kvb + (i & 1) * KVB;
                if (i + 1 < ntile) stage_load<false>(st, KC + (size_t)(i + 1) * 4096, VC, tid); else stage_load<true>(st, KC, VC, tid);
#pragma unroll
                for (int s = 0; s < 2; ++s) { f32x4 dummy[4]; fixed_step<false>(buf, qf[s][0], qf[s][1], 0, nval[s] - 64 * i - 1, mcc[s], l[s], dummy, lane); }
                if (i + 1 < ntile) stage_write<false>(st, kvb + ((i + 1) & 1) * KVB, tid);
                __syncthreads();
            }
        }
        float invl[2], msafe[2];
#pragma unroll
        for (int s = 0; s < 2; ++s) { const float lt = sum_quads(l[s]); invl[s] = lt > 0.f ? 1.f / lt : 0.f; msafe[s] = -mcc[s] * (1.f / CEXP); }
        const int jbw0 = cur >= 8 ? cur - 8 : 0;
        {   float gcv[2] = {gate[0][0], gate[1][0]};
            float carry[2] = {0.f, 0.f};
            stage_write<true>(st, kvb, tid); __syncthreads();
#pragma unroll 1
            for (int i = 0; i < ntile; ++i) {
                LAS unsigned char* buf = kvb + (i & 1) * KVB;
                if (i + 1 < ntile) stage_load<true>(st, KC + (size_t)(i + 1) * 4096, VC + (size_t)(i + 1) * 4096, tid); else stage_load<true>(st, KW + (size_t)jbw0 * 4096, VW + (size_t)jbw0 * 4096, tid);
#pragma unroll
                for (int s = 0; s < 2; ++s) {
                    __builtin_amdgcn_sched_barrier(0);
                    f32x4 sc[4]; qk_slot(buf, qf[s][0], qf[s][1], lane, sc);
                    __builtin_amdgcn_sched_barrier(0);
                    const int hiq = nval[s] - 64 * i - 1 - 4 * quad; const float mc2 = -msafe[s] * CEXP;
#pragma unroll
                    for (int kg = 0; kg < 4; ++kg)
#pragma unroll
                        for (int k = 0; k < 4; ++k) sc[kg][k] = (16 * kg + k <= hiq) ? __builtin_amdgcn_exp2f(__builtin_fmaf(sc[kg][k], CEXP, mc2)) * invl[s] : 0.f;
                    bf16x8 pb[2]; pb[0] = pack_p(sc[0] * gcv[s], sc[1] * gcv[s]); pb[1] = pack_p(sc[2] * gcv[s], sc[3] * gcv[s]);
#pragma unroll
                    for (int kg = 0; kg < 4; ++kg) {
                        float a = (sc[kg][0] + sc[kg][1]) + (sc[kg][2] + 0.5f * sc[kg][3]), bq = 0.5f * sc[kg][3];
                        a += dppf<DPP_X1>(a); a += dppf<DPP_X2>(a); bq += dppf<DPP_X1>(bq); bq += dppf<DPP_X2>(bq);
                        const float fromprev = bperm(bq, (lane - 16) & 63);
                        const float add = quad == 0 ? carry[s] : fromprev;
                        carry[s] = bperm(bq, (lane + 48) & 63);
                        if ((l15 & 3) == 0) imp[(8 * wave + 4 * s + (l15 >> 2)) * IMP_LD + 16 * i + 4 * kg + quad] = a + add;
                    }
                    __builtin_amdgcn_sched_barrier(0);
                    pv_slot(buf + 8192, pb, out[s], lane);
                    __builtin_amdgcn_sched_barrier(0);
                }
                if (i + 1 < ntile) stage_write<true>(st, kvb + ((i + 1) & 1) * KVB, tid);
                __syncthreads();
            }
        }
        {   const int tl8 = lane >> 3, chunk = lane & 7, trow = (8 * wave + tl8) * IMP_LD;
            const int ncand = cur - 2;
            const int wsel = ((8 * wave + tl8) >> 5), bsel = (8 * wave + tl8) & 31;
            if (ncand > 0 && ncand <= 13) {
#pragma unroll
                for (int i = 0; i < 2; ++i) { const int j = 8 * i + chunk; if (j >= 1 && j <= cur - 2) __hip_atomic_fetch_or(smask + j * 2 + wsel, 1u << bsel, __ATOMIC_RELAXED, __HIP_MEMORY_SCOPE_WORKGROUP); }
            } else if (ncand > 13) {
                unsigned lv[13];
#pragma unroll
                for (int k = 0; k < 13; ++k) lv[k] = 0u;
                const int imax = (cur - 2) >> 3;
#pragma unroll 1
                for (int i = 0; i <= imax; ++i) {
                    const int j = 8 * i + chunk;
                    unsigned x = (j >= 1 && j <= cur - 2) ? ((__float_as_uint(imp[trow + j]) & 0xFFFFFF00u) | (unsigned)(255 - j)) : 0u;
                    if (__builtin_amdgcn_ballot_w64(x > lv[12]) != 0ull) {
#pragma unroll
                        for (int k = 0; k < 13; ++k) { const unsigned hi_ = lv[k] > x ? lv[k] : x, lo_ = lv[k] > x ? x : lv[k]; lv[k] = hi_; x = lo_; }
                    }
                }
#pragma unroll 1
                for (int r = 0; r < 13; ++r) {
                    unsigned bv = lv[0];
                    { const unsigned ov = (unsigned)dppi<DPP_X1>((int)bv); bv = ov > bv ? ov : bv; }
                    { const unsigned ov = (unsigned)dppi<DPP_X2>((int)bv); bv = ov > bv ? ov : bv; }
                    { const unsigned ov = (unsigned)dppi<DPP_HM>((int)bv); bv = ov > bv ? ov : bv; }
                    if (lv[0] == bv && bv != 0u) {
#pragma unroll
                        for (int k = 0; k < 12; ++k) lv[k] = lv[k + 1];
                        lv[12] = 0u;
                    }
                    if (chunk == 0 && bv != 0u) __hip_atomic_fetch_or(smask + (255 - (int)(bv & 0xFFu)) * 2 + wsel, 1u << bsel, __ATOMIC_RELAXED, __HIP_MEMORY_SCOPE_WORKGROUP);
                }
            }
        }
        __syncthreads();
        if (wave == 0) {
            int base = 0;
#pragma unroll 1
            for (int r = 0; r < 4; ++r) { const int j = 64 * r + lane; const bool on = (j <= cur) && (j == 0 || j >= cur - 1 || (smask[j * 2] | smask[j * 2 + 1]) != 0u);
                const unsigned long long bal = __builtin_amdgcn_ballot_w64(on); const int pos = base + __builtin_popcountll(bal & ((1ull << lane) - 1ull));
                if (on) blist[pos] = j; base += __builtin_popcountll(bal); }
            if (lane == 0) blist[259] = base;
        }
        __syncthreads();
        LAS float* stashf = imp + wave * 2048 + lane;
#pragma unroll
        for (int s = 0; s < 2; ++s)
#pragma unroll
            for (int dg = 0; dg < 4; ++dg)
#pragma unroll
                for (int c = 0; c < 4; ++c) stashf[(s * 16 + dg * 4 + c) * 64] = out[s][dg][c];
        {   const int jb0 = jbw0, nb = cur - jb0 + 1;
            f32x4 ob[2][4]; float ll[2] = {0.f, 0.f};
            const float mcw[2] = {-sqrtf(qn2[0] * kwmax2) * 1.0001f * CEXP, -sqrtf(qn2[1] * kwmax2) * 1.0001f * CEXP};
#pragma unroll
            for (int s = 0; s < 2; ++s)
#pragma unroll
                for (int dg = 0; dg < 4; ++dg) ob[s][dg] = (f32x4){0.f, 0.f, 0.f, 0.f};
            stage_write<true>(st, kvb, tid); __syncthreads();
#pragma unroll 1
            for (int i = 0; i < nb; ++i) {
                LAS unsigned char* buf = kvb + (i & 1) * KVB;
                const int j = jb0 + i;
                if (i + 1 < nb) stage_load<true>(st, KW + (size_t)(j + 1) * 4096, VW + (size_t)(j + 1) * 4096, tid);
#pragma unroll
                for (int s = 0; s < 2; ++s) {
                    const int lo = (j == cur - 8) ? tl[s] + 1 : 0, hi = (j == cur) ? tl[s] : 63;
                    fixed_step<true>(buf, qr[s][0], qr[s][1], lo, hi, mcw[s], ll[s], ob[s], lane);
                }
                if (i + 1 < nb) stage_write<true>(st, kvb + ((i + 1) & 1) * KVB, tid);
                __syncthreads();
            }
#pragma unroll
            for (int s = 0; s < 2; ++s) { const float lt = sum_quads(ll[s]); const float gw = gate[s][2] * (lt > 0.f ? 1.f / lt : 0.f);
#pragma unroll
                for (int dg = 0; dg < 4; ++dg)
#pragma unroll
                    for (int c = 0; c < 4; ++c) out[s][dg][c] = stashf[(s * 16 + dg * 4 + c) * 64] + ob[s][dg][c] * gw; }
        }
        LAS unsigned* stashb = (LAS unsigned*)(F.lds + L_KV) + wave * 1024 + lane;
        LAS unsigned char* Ql = F.lds + L_Q;
        LAS float* mrow = (LAS float*)(F.lds + L_ML); LAS int* lrow = (LAS int*)(mrow + 256);
        LAS int* Os = (LAS int*)imp;
        const float oscale = 1048576.f / vmax;
#pragma unroll
        for (int s = 0; s < 2; ++s) {
#pragma unroll
            for (int dg = 0; dg < 4; ++dg) { stashb[((s * 4 + dg) * 2 + 0) * 64] = pg8::cvt_pk_bf16(out[s][dg][0], out[s][dg][1]); stashb[((s * 4 + dg) * 2 + 1) * 64] = pg8::cvt_pk_bf16(out[s][dg][2], out[s][dg][3]); }
            const int row = tl[s] * 4 + (l15 & 3);
            *(LAS bf16x8*)(Ql + row * 128 + ((quad ^ (row & 7)) << 4)) = qr[s][0];
            *(LAS bf16x8*)(Ql + row * 128 + (((4 + quad) ^ (row & 7)) << 4)) = qr[s][1];
        }
        __syncthreads();
        for (int i = lane; i < 32 * OS_LD; i += 64) Os[wave * 32 * OS_LD + i] = 0;
        if (lane < 32) lrow[wave * 32 + lane] = 0;
        {
            const float kmax2 = __uint_as_float(__hip_atomic_load((const unsigned*)(ws + WS_CTL) + CW_KMAX + layer * 8 + bg, __ATOMIC_RELAXED, __HIP_MEMORY_SCOPE_AGENT));
#pragma unroll
            for (int s = 0; s < 2; ++s) { float n2 = 0.f;
#pragma unroll
                for (int ks = 0; ks < 2; ++ks) { const u32x4 w = __builtin_bit_cast(u32x4, qr[s][ks]);
#pragma unroll
                    for (int e = 0; e < 4; ++e) { const float a = bflo(w[e]), b2 = bfhi(w[e]); n2 += a * a + b2 * b2; } }
                n2 = sum_quads(n2);
                if (quad == 0) mrow[tl[s] * 4 + (l15 & 3)] = sqrtf(n2 * kmax2) * 1.0001f; } }
        __syncthreads();
        {   const int nb = blist[259];
            int lane2 = lane; asm volatile("" : "+v"(lane2));
            const unsigned char* VT = ws + RA_VST + (size_t)bg * 256 * 4096; const unsigned char* K8 = ws + RA_K8 + (size_t)bg * SEQ * 64;
            LAS int* tlist = (LAS int*)(F.lds + L_TOK) + wave * 64;
            asm volatile("" : "+v"(lane2));
            sel_pass2(K8, VT, nb, cur, wave, blist, smask, Ql, mrow, lrow, Os, __builtin_amdgcn_logf(oscale), LSCALE / oscale, tlist, lane2);
            __syncthreads();
        }
        asm volatile("" : "+v"(tok[0]), "+v"(tok[1]), "+v"(tl[0]), "+v"(tl[1]));
        const float oinv = vmax * (1.f / 1048576.f);
#pragma unroll
        for (int s = 0; s < 2; ++s) { const int row = tl[s] * 4 + (l15 & 3); const float lt = (float)lrow[row] * (1.f / LSCALE);
            const float gs = gate[s][1] * (lt > 0.f ? 1.f / lt : 0.f) * oinv;
#pragma unroll
            for (int dg = 0; dg < 4; ++dg) { const unsigned w0 = stashb[((s * 4 + dg) * 2 + 0) * 64], w1 = stashb[((s * 4 + dg) * 2 + 1) * 64];
                LAS const int* orow = Os + row * OS_LD + 16 * dg + 4 * quad;
                const float r0 = bflo(w0) + (float)orow[0] * gs, r1 = bfhi(w0) + (float)orow[1] * gs, r2 = bflo(w1) + (float)orow[2] * gs, r3 = bfhi(w1) + (float)orow[3] * gs;
                u32x2 w; w.x = pg8::cvt_pk_bf16(r0, r1); w.y = pg8::cvt_pk_bf16(r2, r3);
                *(u32x2*)(ATT + (size_t)tok[s] * DM + g * 256 + (l15 & 3) * 64 + 16 * dg + 4 * quad) = w; } }
        __syncthreads();
    }
}

DEVI void phase_swa_fast(Frame& F, const float* sinks) {
    using namespace fa;
    F.refresh();
    unsigned char* ws = F.ws;
    const bf16_t* Q = (const bf16_t*)(ws + RA_Q); bf16_t* ATT = (bf16_t*)(ws + RA_ATT);
    const int tid = F.tid, lane = F.lane, wave = F.wave, quad = lane >> 4, l15 = lane & 15;
    LAS unsigned char* kvb = F.lds + L_KV;
#pragma unroll 1
    for (int ui = 0; ui < 8; ++ui) {
        const int bg = ui >> 1, b = bg >> 1, g = bg & 1, t0 = (F.vcu * 2 + (ui & 1)) * 32, cur = t0 >> 6;
        const bf16_t* KS = (const bf16_t*)(ws + WS_KSH) + (size_t)bg * SEQ * 64; const bf16_t* VS = (const bf16_t*)(ws + WS_VSH) + (size_t)bg * SEQ * 64;
        int tq[2]; size_t tok[2]; bf16x8 qf[2][2]; f32x4 o[2][4]; float mm[2], ll[2];
        const float sink_raw = sinks[g * 8 + (l15 & 7)] * 8.0f;
#pragma unroll
        for (int s = 0; s < 2; ++s) { tq[s] = t0 + 4 * wave + 2 * s + (l15 >> 3); tok[s] = (size_t)b * SEQ + tq[s]; load_q(Q, tok[s], g * 512 + (l15 & 7) * 64, quad, qf[s]);
            mm[s] = sink_raw; ll[s] = quad == 0 ? 1.f : 0.f;
#pragma unroll
            for (int dg = 0; dg < 4; ++dg) o[s][dg] = (f32x4){0.f, 0.f, 0.f, 0.f}; }
        const int jb0 = cur >= 2 ? cur - 2 : 0, nb = cur - jb0 + 1;
        Stage st; stage_load<true>(st, KS + (size_t)jb0 * 4096, VS + (size_t)jb0 * 4096, tid); stage_write<true>(st, kvb, tid); __syncthreads();
#pragma unroll 1
        for (int i = 0; i < nb; ++i) {
            LAS unsigned char* buf = kvb + (i & 1) * KVB;
            const int j = jb0 + i;
            if (i + 1 < nb) stage_load<true>(st, KS + (size_t)(j + 1) * 4096, VS + (size_t)(j + 1) * 4096, tid);
#pragma unroll
            for (int s = 0; s < 2; ++s) online_step<true>(buf, qf[s][0], qf[s][1], tq[s] - (SWA_WIN - 1) - 64 * j, tq[s] - 64 * j, mm[s], ll[s], o[s], lane);
            if (i + 1 < nb) stage_write<true>(st, kvb + ((i + 1) & 1) * KVB, tid);
            __syncthreads();
        }
#pragma unroll
        for (int s = 0; s < 2; ++s) { const float inv = 1.f / sum_quads(ll[s]);
#pragma unroll
            for (int dg = 0; dg < 4; ++dg) { u32x2 w; w.x = pg8::cvt_pk_bf16(o[s][dg][0] * inv, o[s][dg][1] * inv); w.y = pg8::cvt_pk_bf16(o[s][dg][2] * inv, o[s][dg][3] * inv);
                *(u32x2*)(ATT + tok[s] * DM + g * 512 + (l15 & 7) * 64 + 16 * dg + 4 * quad) = w; } }
    }
}

enum Kind { K_PRO = 0, K_NSA_IN, K_CMP_HID, K_CMP_OUT, K_NSA_ATT, K_SWA_IN, K_SWA_ATT, K_OUTPROJ, K_LN1, K_LN1R, K_FFN1, K_FFN2, K_LN2, K_SCATTER, K_MOE1, K_MOE2, K_LN2C, K_COUNT };
struct Args { const void* in[18]; float* out; unsigned char* ws; int ph_lo, ph_hi; };
struct PhaseEnt { int kind, layer; };
constexpr int NPH = 35;
static const PhaseEnt h_prog[NPH] = {
    {K_PRO, 0},
    {K_NSA_IN, 0}, {K_CMP_HID, 0}, {K_CMP_OUT, 0}, {K_NSA_ATT, 0}, {K_OUTPROJ, 0}, {K_LN1, 0}, {K_FFN1, 0}, {K_FFN2, 0}, {K_LN2, 0},
    {K_NSA_IN, 1}, {K_CMP_HID, 1}, {K_CMP_OUT, 1}, {K_NSA_ATT, 1}, {K_OUTPROJ, 1}, {K_LN1R, 1}, {K_SCATTER, 1}, {K_MOE1, 1}, {K_MOE2, 1}, {K_LN2C, 1},
    {K_SWA_IN, 2}, {K_SWA_ATT, 2}, {K_OUTPROJ, 2}, {K_LN1, 2}, {K_FFN1, 2}, {K_FFN2, 2}, {K_LN2, 2},
    {K_SWA_IN, 3}, {K_SWA_ATT, 3}, {K_OUTPROJ, 3}, {K_LN1R, 3}, {K_SCATTER, 3}, {K_MOE1, 3}, {K_MOE2, 3}, {K_LN2C, 3},
};

template <int KIND> DEVI void do_phase(Frame& F, int l) {
    unsigned char* ws = F.ws;
    unsigned* ctl = (unsigned*)(ws + WS_CTL);
    LAS unsigned char* ring = F.lds;
    const int bx = (int)blockIdx.x;
    if constexpr (KIND == K_PRO) { phase_prologue(F); }
    if constexpr (KIND == K_NSA_IN) { pg8::Gemm g{(const bf16_t*)(ws + WS_HB), DM, DM, DM}; pg8::StaticOrder S; S.init(MTOK / 256, A_INP / 256, F.G, bx, (const bf16_t*)(ws + WS_WINA) + (size_t)l * A_INP * DM);
        EpiNsaIn E{ws, (const float*)(ws + WS_CS)}; pg8::gemm_phase(ring, g, S, E, F.wave0); }
    if constexpr (KIND == K_CMP_HID) {
        const int kv = (bx >> 5) & 1;
        if (bx < 64) { pg8::Gemm g{(const bf16_t*)(ws + (kv ? RA_VCR : RA_KCR)), 1024, 2048, 2048};
            pg8::StaticOrder S; S.init(32, 1, 32, bx & 31, (const bf16_t*)(ws + WS_WC1) + (size_t)(l * 2 + kv) * 256 * 2048);
            EpiCmpHid E{(bf16_t*)(ws + RA_CH) + (size_t)kv * 8192 * 256, (const float*)(ctl + CW_BIASP) + (l * 2 + kv) * 256};
            pg8::gemm_phase(ring, g, S, E, F.wave0); }
        else phase_vs_transpose(F, l); }
    if constexpr (KIND == K_CMP_OUT) { pg8::Gemm g{(const bf16_t*)(ws + RA_CH), 256, 256, 256}; pg8::DualOrder S; S.init(64, 1, F.G, bx, (const bf16_t*)(ws + WS_WC2) + (size_t)(l * 2) * 256 * 256); S.estride = (size_t)256 * 256;
        EpiCmpOut E{(bf16_t*)(ws + RA_KC), (bf16_t*)(ws + RA_VC)}; pg8::gemm_phase(ring, g, S, E, F.wave0); }
#if NAIVE_NSA
    if constexpr (KIND == K_NSA_ATT) { phase_nsa_naive(F); }
#else
    if constexpr (KIND == K_NSA_ATT) { phase_nsa_fast(F, l); }
#endif
    if constexpr (KIND == K_SWA_IN) { pg8::Gemm g{(const bf16_t*)(ws + WS_HB), DM, DM, DM}; pg8::StaticOrder S;
        if (l == 2) S.init(MTOK / 256, 5, F.G, bx, (const bf16_t*)(ws + WS_WQKV2)); else S.init(MTOK / 256, 4, F.G, bx, (const bf16_t*)(ws + WS_WQB1));
        EpiSwaIn E{ws, (const float*)(ws + WS_CS)}; pg8::gemm_phase(ring, g, S, E, F.wave0); }
#if NAIVE_SWA
    if constexpr (KIND == K_SWA_ATT) { phase_swa_naive(F, (const float*)ARG_IN(10) + (l - 2) * 16); }
#else
    if constexpr (KIND == K_SWA_ATT) { phase_swa_fast(F, (const float*)ARG_IN(10) + (l - 2) * 16); }
#endif
    if constexpr (KIND == K_OUTPROJ) { pg8::Gemm g{(const bf16_t*)(ws + RA_ATT), DM, DM, DM}; pg8::StaticOrder S;
        S.init(MTOK / 256, 4, F.G, bx, l < 2 ? (const bf16_t*)(ws + WS_WOUTA) + (size_t)l * DM * DM : (const bf16_t*)(ws + WS_WOUTB) + (size_t)(l - 2) * DM * DM);
        EpiResid E{(const bf16_t*)(ws + WS_HB), (bf16_t*)(ws + WS_Y)}; pg8::gemm_phase(ring, g, S, E, F.wave0); }
    if constexpr (KIND == K_LN1) { phase_ln<0, false, false>(F, l * 2, nullptr, 0); }
    if constexpr (KIND == K_LN1R) { phase_ln<0, true, false>(F, l * 2, nullptr, l >> 1); }
    if constexpr (KIND == K_FFN1) { pg8::Gemm g{(const bf16_t*)(ws + WS_HB), DM, DM, DM}; pg8::StaticOrder S; S.init(MTOK / 256, 2 * DFF / 256, F.G, bx, (const bf16_t*)(ws + WS_WDIN) + (size_t)(l >> 1) * 2 * DFF * DM);
        EpiSwiglu E{(bf16_t*)(ws + WS_ACT), DFF}; pg8::gemm_phase(ring, g, S, E, F.wave0); }
    if constexpr (KIND == K_FFN2) { pg8::Gemm g{(const bf16_t*)(ws + WS_ACT), DFF, DFF, DFF}; pg8::StaticOrder S; S.init(MTOK / 256, 4, F.G, bx, (const bf16_t*)(ws + WS_WDOUT) + (size_t)(l >> 1) * DM * DFF);
        EpiResid E{(const bf16_t*)(ws + WS_HB), (bf16_t*)(ws + WS_Y)}; pg8::gemm_phase(ring, g, S, E, F.wave0); }
    if constexpr (KIND == K_LN2) { phase_ln<0, false, false>(F, l * 2 + 1, nullptr, 0); }
    if constexpr (KIND == K_SCATTER) { phase_moe_scatter(F, l >> 1); }
    if constexpr (KIND == K_MOE1) { const int ml = l >> 1; int ts[9]; moe_tiles((const unsigned*)ctl + CW_MOE + ml * 64, ts);
        pg8::Gemm g{(const bf16_t*)(ws + WS_XB), DM, DM, DM}; pg8::GroupedOrder S; S.init(ts[8], 2 * DFFE / 256, F.G, bx, (const bf16_t*)(ws + WS_WMIN) + (size_t)ml * 8 * 2 * DFFE * DM);
        S.t1 = ts[1]; S.t2 = ts[2]; S.t3 = ts[3]; S.t4 = ts[4]; S.t5 = ts[5]; S.t6 = ts[6]; S.t7 = ts[7]; S.estride = (size_t)2 * DFFE * DM;
        EpiSwiglu E{(bf16_t*)(ws + WS_ACT), DFFE}; pg8::gemm_phase(ring, g, S, E, F.wave0); }
    if constexpr (KIND == K_MOE2) { const int ml = l >> 1; int ts[9]; moe_tiles((const unsigned*)ctl + CW_MOE + ml * 64, ts);
        pg8::Gemm g{(const bf16_t*)(ws + WS_ACT), DFFE, DFFE, DFFE}; pg8::GroupedOrder S; S.init(256, 4, F.G, bx, (const bf16_t*)(ws + WS_WMOUT) + (size_t)ml * 8 * DM * DFFE);
        S.t1 = ts[1]; S.t2 = ts[2]; S.t3 = ts[3]; S.t4 = ts[4]; S.t5 = ts[5]; S.t6 = ts[6]; S.t7 = ts[7]; S.estride = (size_t)DM * DFFE;
        EpiBf16Out E{(bf16_t*)(ws + WS_YB)}; pg8::gemm_phase(ring, g, S, E, F.wave0);
        pg8::Gemm g4{(const bf16_t*)(ws + WS_ACT), DFFE, DFFE / 4, DFFE}; pg8::SliceOrder S4; S4.nsl = (ts[8] - 256) * 16; S4.G = F.G; S4.c = (bx + 128) & 255; S4.kq = DFFE / 4;
        S4.bt = (const bf16_t*)(ws + WS_WMOUT) + (size_t)ml * 8 * DM * DFFE; S4.t1 = ts[1]; S4.t2 = ts[2]; S4.t3 = ts[3]; S4.t4 = ts[4]; S4.t5 = ts[5]; S4.t6 = ts[6]; S4.t7 = ts[7]; S4.estride = (size_t)DM * DFFE;
        EpiPart E4{(float*)(ws + WS_H)}; pg8::gemm_phase(ring, g4, S4, E4, F.wave0); }
    if constexpr (KIND == K_LN2C) { if (l == DEPTH - 1) phase_ln<1, false, true>(F, l * 2 + 1, ARG_OUT(), 0); else phase_ln<1, false, false>(F, l * 2 + 1, nullptr, 0); }
}

DEVI void frame_init(Frame& F, unsigned char* lds_raw) {
    F.lds = (LAS unsigned char*)lds_raw; F.ws = ARG_WS();
    F.wave0 = wave_id_sgpr(); F.tid = threadIdx.x; F.lane = F.tid & 63; F.wave = F.wave0;
    F.G = gridDim.x; { const int bx = blockIdx.x; F.vcu = (F.G % 8 == 0) ? (bx % 8) * (F.G / 8) + bx / 8 : bx; }
}

#if !MK_SINGLE
template <int KIND> __global__ void __launch_bounds__(NWAVES * 64, 2) phase_kernel(Args args) {
    extern __shared__ __attribute__((aligned(16))) unsigned char lds_raw[];
    Frame F; frame_init(F, lds_raw);
    do_phase<KIND>(F, args.ph_lo);
}
template <int KIND> static void launch_kind(const Args& a, hipStream_t stream) {
    static bool attr = false;
    if (!attr) { (void)hipFuncSetAttribute((const void*)phase_kernel<KIND>, hipFuncAttributeMaxDynamicSharedMemorySize, LDS_BYTES); attr = true; }
    hipLaunchKernelGGL(phase_kernel<KIND>, dim3(256), dim3(NWAVES * 64), LDS_BYTES, stream, a);
}
#else
__global__ void __launch_bounds__(NWAVES * 64, 2) yoco_fwd(Args args) {
    extern __shared__ __attribute__((aligned(16))) unsigned char lds_raw[];
    Frame F; frame_init(F, lds_raw);
    volatile LAS unsigned* MISC = (volatile LAS unsigned*)(F.lds + MISC_OFF);
    for (int u = F.tid; u < 256; u += NWAVES * 64) MISC[u] = 0u;
    __syncthreads();
    XcdBarrier bar = xcd_barrier_post((unsigned*)(F.ws + WS_CTL) + CW_BAR, MISC + 8);
#define DUP_KIND 12
#define DUP_KIND 13
#ifndef DUP_KIND
#define DUP_KIND -1
#endif
#define PH(K, L, FIRST) do { do_phase<K>(F, L); if (FIRST) cg::this_grid().sync(); else xcd_barrier(bar); if (K == DUP_KIND) { do_phase<K>(F, L); xcd_barrier(bar); } } while (0)
    PH(K_PRO, 0, true);
#define NSA_LAYER(l) PH(K_NSA_IN, l, false); PH(K_CMP_HID, l, false); PH(K_CMP_OUT, l, false); PH(K_NSA_ATT, l, false); PH(K_OUTPROJ, l, false)
#define SWA_LAYER(l) PH(K_SWA_IN, l, false); PH(K_SWA_ATT, l, false); PH(K_OUTPROJ, l, false)
#define DENSE_FFN(l) PH(K_LN1, l, false); PH(K_FFN1, l, false); PH(K_FFN2, l, false); PH(K_LN2, l, false)
#define MOE_FFN(l, LAST) PH(K_LN1R, l, false); PH(K_SCATTER, l, false); PH(K_MOE1, l, false); PH(K_MOE2, l, false); do_phase<K_LN2C>(F, l); if (!(LAST)) xcd_barrier(bar); else if (DUP_KIND == 16) { xcd_barrier(bar); do_phase<K_LN2C>(F, l); }
    NSA_LAYER(0); DENSE_FFN(0);
    NSA_LAYER(1); MOE_FFN(1, false);
    SWA_LAYER(2); DENSE_FFN(2);
    SWA_LAYER(3); MOE_FFN(3, true);
}
#endif

extern "C" void kernel_launch(void* const* d_in, const int* in_sizes, int n_in, void* d_out, int out_size, void* d_ws, size_t ws_size, hipStream_t stream) {
    static int grid = 0;
    if (grid == 0) {
        if (n_in != 18 || out_size != MTOK * DM || ws_size < WS_END) { fprintf(stderr, "kernel_launch: unexpected shapes (n_in %d out %d ws %zu need %zu)\n", n_in, out_size, ws_size, (size_t)WS_END); grid = -1; return; }
        int dev = 0, cus = 0;
        (void)hipGetDevice(&dev); (void)hipDeviceGetAttribute(&cus, hipDeviceAttributeMultiprocessorCount, dev);
        if (cus < 256) { fprintf(stderr, "kernel_launch: needs 256 CUs, device has %d\n", cus); grid = -1; return; }
#if MK_SINGLE
        int per_cu = 0;
        (void)hipFuncSetAttribute((const void*)yoco_fwd, hipFuncAttributeMaxDynamicSharedMemorySize, LDS_BYTES);
        (void)hipOccupancyMaxActiveBlocksPerMultiprocessor(&per_cu, (const void*)yoco_fwd, NWAVES * 64, LDS_BYTES);
        if (per_cu < 1) fprintf(stderr, "kernel_launch: occupancy query says %d blocks per CU\n", per_cu);
        (void)hipGetLastError();
#endif
        grid = 256;
    }
    if (grid < 0) return;
    (void)hipMemsetAsync((char*)d_ws + WS_CTL, 0, CTL_BYTES, stream);
    Args a{};
    for (int i = 0; i < 18; ++i) a.in[i] = d_in[i];
    a.out = (float*)d_out; a.ws = (unsigned char*)d_ws;
#if MK_SINGLE
    a.ph_lo = 0; a.ph_hi = NPH;
    void* kargs[] = {&a};
    hipError_t e = hipLaunchCooperativeKernel((const void*)yoco_fwd, dim3(grid), dim3(NWAVES * 64), kargs, LDS_BYTES, stream);
    if (e != hipSuccess) fprintf(stderr, "cooperative launch failed: %s (grid %d)\n", hipGetErrorString(e), grid);
#else
    for (int p = 0; p < NPH; ++p) {
        a.ph_lo = h_prog[p].layer; a.ph_hi = 0;
        switch (h_prog[p].kind) {
#define LK(K) case K: launch_kind<K>(a, stream); break;
            LK(K_PRO) LK(K_NSA_IN) LK(K_CMP_HID) LK(K_CMP_OUT) LK(K_NSA_ATT) LK(K_SWA_IN) LK(K_SWA_ATT) LK(K_OUTPROJ) LK(K_LN1) LK(K_LN1R) LK(K_FFN1) LK(K_FFN2) LK(K_LN2) LK(K_SCATTER) LK(K_MOE1) LK(K_MOE2) LK(K_LN2C)
#undef LK
            default: break;
        }
    }
#endif
}
```

```cpp
#include <hip/hip_runtime.h>
#include <hip/hip_cooperative_groups.h>
#include <cstdio>
#include <cstdint>
namespace cg = cooperative_groups;

#ifndef DBG_DROP
#define DBG_DROP 0
#endif
#ifndef NAIVE_NSA
#define NAIVE_NSA 0
#endif
#ifndef NAIVE_SWA
#define NAIVE_SWA 0
#endif
#ifndef MK_SINGLE
#define MK_SINGLE 1
#endif

#define DEVI __device__ __forceinline__
#define LAS __attribute__((address_space(3)))
#define GAS __attribute__((address_space(1)))
typedef unsigned short bf16_t;
typedef short bf16x8 __attribute__((ext_vector_type(8)));
typedef float f32x4 __attribute__((ext_vector_type(4)));
typedef float f32x2 __attribute__((ext_vector_type(2)));
typedef unsigned u32x4 __attribute__((ext_vector_type(4)));
typedef unsigned u32x2 __attribute__((ext_vector_type(2)));

constexpr int BATCH = 2, SEQ = 16384, MTOK = BATCH * SEQ, DM = 1024, DEPTH = 4;
constexpr int HD = 64;
constexpr int A_G = 4, A_R = 4, A_IN = 2608, A_INP = 2816;
constexpr int NCMP = 1023, CMP_HID = 256;
constexpr int NSLC = SEQ / 64, NSEL = 16, NSA_WIN = 512;
constexpr int B_G = 2, B_R = 8, SWA_WIN = 128;
constexpr int DFF = 2816, NEXP = 8, DFFE = 3584;
constexpr int CAP = MTOK * 2 + NEXP * 256;
constexpr float ALPHA = 1.6817928305074292f;
constexpr float LN_EPS = 1e-5f;
constexpr float QSCALE = 0.125f;

constexpr size_t al256(size_t x) { return (x + 255) & ~(size_t)255; }
constexpr size_t WS_CTL = 0, CTL_BYTES = 1u << 20;
constexpr size_t WS_WINA = CTL_BYTES;
constexpr size_t WS_WOUTA = WS_WINA + (size_t)2 * A_INP * DM * 2;
constexpr size_t WS_WC1 = WS_WOUTA + (size_t)2 * DM * DM * 2;
constexpr size_t WS_WC2 = WS_WC1 + (size_t)4 * 256 * 2048 * 2;
constexpr size_t WS_WQKV2 = WS_WC2 + (size_t)4 * 256 * 256 * 2;
constexpr size_t WS_WQB1 = WS_WQKV2 + (size_t)1280 * DM * 2;
constexpr size_t WS_WOUTB = WS_WQB1 + (size_t)DM * DM * 2;
constexpr size_t WS_WDIN = WS_WOUTB + (size_t)2 * DM * DM * 2;
constexpr size_t WS_WDOUT = WS_WDIN + (size_t)2 * 2 * DFF * DM * 2;
constexpr size_t WS_WMIN = WS_WDOUT + (size_t)2 * DM * DFF * 2;
constexpr size_t WS_WMOUT = WS_WMIN + (size_t)16 * 2 * DFFE * DM * 2;
constexpr size_t WS_WEND = WS_WMOUT + (size_t)16 * DM * DFFE * 2;
constexpr size_t WS_H = al256(WS_WEND);
constexpr size_t WS_Y = WS_H + (size_t)MTOK * DM * 4;
constexpr size_t WS_HB = WS_Y + (size_t)MTOK * DM * 4;
constexpr size_t WS_CS = WS_HB + (size_t)MTOK * DM * 2;
constexpr size_t WS_KSH = WS_CS + (size_t)MTOK * 16 * 4;
constexpr size_t WS_VSH = WS_KSH + (size_t)MTOK * 128 * 2;
constexpr size_t WS_ROUTE = WS_VSH + (size_t)MTOK * 128 * 2;
constexpr size_t WS_XB = WS_ROUTE + (size_t)MTOK * 2 * 4 * 4;
constexpr size_t WS_ACT = WS_XB + (size_t)CAP * DM * 2;
constexpr size_t WS_RA = WS_ACT + (size_t)CAP * DFFE * 2;
constexpr size_t SLAB = (size_t)MTOK * 256 * 2;
constexpr size_t RA_Q = WS_RA;
constexpr size_t RA_ATT = RA_Q + (size_t)MTOK * DM * 2;
constexpr size_t RA_KCR = RA_ATT + (size_t)MTOK * DM * 2;
constexpr size_t RA_VCR = RA_KCR + SLAB + 4096;
constexpr size_t RA_KS = RA_VCR + SLAB + 4096;
constexpr size_t RA_VS = RA_KS + SLAB;
constexpr size_t RA_KW = RA_VS + SLAB;
constexpr size_t RA_VW = RA_KW + SLAB;
constexpr size_t RA_GATE = RA_VW + SLAB;
constexpr size_t RA_KC = RA_GATE + (size_t)MTOK * 48 * 4;
constexpr size_t RA_VC = RA_KC + (size_t)8192 * 64 * 2;
constexpr size_t RA_CH = RA_VC + (size_t)8192 * 64 * 2;
constexpr size_t RA_VST = RA_CH + (size_t)2 * 8192 * 256 * 2;
constexpr size_t RA_K8 = RA_VST + SLAB / 2;
constexpr size_t RA_END = RA_VST + SLAB;
constexpr size_t WS_YB = WS_RA;
constexpr size_t YB_END = WS_YB + (size_t)CAP * DM * 4;
constexpr size_t WS_END = (RA_END > YB_END ? RA_END : YB_END);
static_assert(WS_END < (size_t)1879048192, "workspace map exceeds 4x the largest tensor");

constexpr int CW_BAR = 4096;
constexpr int CW_MOE = 16384;
constexpr int CW_WGCNT = 45056;
constexpr int CW_KWMAX = 40128;
constexpr int CW_KMAX = 40064;
constexpr int CW_VMAX = 40000;
constexpr int CW_BIASP = 32768;

constexpr int RING_BYTES = 131072;
constexpr int LDS_X = RING_BYTES;
constexpr int MISC_OFF = RING_BYTES + 16384;
constexpr int LDS_BYTES = MISC_OFF + 1024;

DEVI unsigned f2bf(float f) { unsigned u = __builtin_bit_cast(unsigned, f); return (u + 0x7fffu + ((u >> 16) & 1u)) >> 16; }
DEVI unsigned pk2(float lo, float hi) { return f2bf(lo) | (f2bf(hi) << 16); }
DEVI float bf2f(unsigned h) { return __builtin_bit_cast(float, h << 16); }
DEVI float bflo(unsigned w) { return __builtin_bit_cast(float, w << 16); }
DEVI float bfhi(unsigned w) { return __builtin_bit_cast(float, w & 0xffff0000u); }
DEVI float clamp8(float x) { return __builtin_amdgcn_fmed3f(x, -448.f, 448.f); }
DEVI unsigned pack_fp8x4(float a, float b, float c, float d) {
    const int w = __builtin_amdgcn_cvt_pk_fp8_f32(clamp8(a), clamp8(b), 0, false);
    return (unsigned)__builtin_amdgcn_cvt_pk_fp8_f32(clamp8(c), clamp8(d), w, true);
}
DEVI float shx(float v, int mask, int lane) { return __builtin_bit_cast(float, __builtin_amdgcn_ds_bpermute((lane ^ mask) << 2, __builtin_bit_cast(int, v))); }
DEVI int shxi(int v, int mask, int lane) { return __builtin_amdgcn_ds_bpermute((lane ^ mask) << 2, v); }
DEVI float wave_sum(float v, int lane) {
#pragma unroll
    for (int o = 1; o < 64; o <<= 1) v += shx(v, o, lane);
    return v;
}
DEVI float wave_max(float v, int lane) {
#pragma unroll
    for (int o = 1; o < 64; o <<= 1) v = fmaxf(v, shx(v, o, lane));
    return v;
}
DEVI int wave_id_sgpr() { return __builtin_amdgcn_readfirstlane((int)threadIdx.x >> 6); }
DEVI int opaque_tid(int wave) { asm volatile("" : "+s"(wave)); int l; asm volatile("v_mbcnt_lo_u32_b32 %0, -1, 0\n\tv_mbcnt_hi_u32_b32 %0, -1, %0" : "=v"(l)); return wave * 64 + l; }
#define LDS_WAIT() asm volatile("s_waitcnt lgkmcnt(0)" ::: "memory")
#define VM_WAIT() asm volatile("s_waitcnt vmcnt(0)" ::: "memory")

namespace pg8 {
constexpr int BM = 256, BK = 64, HALF = 128, HTB = HALF * BK * 2, STAGE_BYTES = 8 * HTB, NXCD = 8, WGM = 8;
DEVI int lds_byte(int r, int c) { const int st = (r >> 4) * 2 + (c >> 5), rr = r & 15, cc = c & 31, ob = rr * 64 + cc * 2; return st * 1024 + (ob ^ (((ob >> 9) & 1) << 5)); }
DEVI void stage_rc(int b, int& R, int& C) { const int st = b / 1024, sb = b % 1024, swz = sb ^ (((sb >> 9) & 1) << 5); R = (st >> 1) * 16 + swz / 64; C = (st & 1) * 32 + (swz % 64) / 2; }
DEVI int perm32(int rho) { const int n = rho >> 4, i = rho & 15; return 8 * (i >> 2) + 4 * n + (i & 3); }

struct Unit { int pm, pn; const bf16_t* bt; int koff, z; };
struct Gemm { const bf16_t* A; int lda; int K; int ldb; };

struct StaticOrder {
    int nM, nN, nwg, G, c; const bf16_t* bt;
    DEVI void init(int nM_, int nN_, int G_, int c_, const bf16_t* bt_) { nM = nM_; nN = nN_; nwg = nM * nN; G = G_; c = c_; bt = bt_; }
    DEVI bool tile(int i, int& pm, int& pn) const {
        const long L = (long)i * G + c; if (L >= nwg) return false;
        int wgid = (int)L; { const int q = nwg / NXCD, r = nwg % NXCD, xcd = wgid % NXCD, off = wgid / NXCD; wgid = (xcd < r ? xcd * (q + 1) : r * (q + 1) + (xcd - r) * q) + off; }
        const int nig = WGM * nN, gid = wgid / nig, fm = gid * WGM, gsz = (nM - fm) < WGM ? (nM - fm) : WGM;
        pm = fm + ((wgid % nig) % gsz); pn = (wgid % nig) / gsz; return true;
    }
    DEVI bool next(int i, Unit& u) const { if (!tile(i, u.pm, u.pn)) return false; u.bt = bt; u.koff = 0; u.z = 0; return true; }
};
struct GroupedOrder : StaticOrder {
    int t1, t2, t3, t4, t5, t6, t7; size_t estride;
    DEVI bool next(int i, Unit& u) const {
        if (!tile(i, u.pm, u.pn)) return false;
        const int tm = u.pm; const int e = (tm >= t1) + (tm >= t2) + (tm >= t3) + (tm >= t4) + (tm >= t5) + (tm >= t6) + (tm >= t7);
        u.bt = bt + (size_t)e * estride; u.koff = 0; u.z = 0; return true;
    }
};
struct SliceOrder {
    int nsl, G, c, kq; const bf16_t* bt; int t1, t2, t3, t4, t5, t6, t7; size_t estride;
    DEVI bool next(int i, Unit& u) const {
        const int L = i * G + c; if (L >= nsl) return false;
        u.pm = 256 + (L >> 3); u.pn = (L & 7) >> 1; u.z = L & 1; u.koff = u.z * kq;
        const int tm = u.pm; const int e = (tm >= t1) + (tm >= t2) + (tm >= t3) + (tm >= t4) + (tm >= t5) + (tm >= t6) + (tm >= t7);
        u.bt = bt + (size_t)e * estride; return true;
    }
};
struct DualOrder : StaticOrder {
    size_t estride;
    DEVI bool next(int i, Unit& u) const { if (!tile(i, u.pm, u.pn)) return false; u.bt = bt + (u.pm >= nM / 2 ? estride : 0); u.koff = 0; u.z = 0; return true; }
};

DEVI unsigned cvt_pk_bf16(float lo, float hi) { typedef __bf16 bf16x2_t __attribute__((ext_vector_type(2))); f32x2 v = {lo, hi}; bf16x2_t b = __builtin_convertvector(v, bf16x2_t); return __builtin_bit_cast(unsigned, b); }

typedef int v4i_t __attribute__((ext_vector_type(4)));
typedef int v8i_t __attribute__((ext_vector_type(8)));
template <int F8SH> DEVI void mma_block(f32x4 (&acc)[4][2], const bf16x8 (&At)[4][2], const bf16x8 (&Bt)[2][2]) {
    if constexpr (F8SH < 0) {
#pragma unroll
        for (int m = 0; m < 4; ++m)
#pragma unroll
            for (int n = 0; n < 2; ++n)
#pragma unroll
                for (int k = 0; k < 2; ++k) acc[m][n] = __builtin_amdgcn_mfma_f32_16x16x32_bf16(Bt[n][k], At[m][k], acc[m][n], 0, 0, 0);
    } else {
#pragma unroll
        for (int m = 0; m < 4; ++m)
#pragma unroll
            for (int n = 0; n < 2; ++n) {
                const v8i_t a8 = __builtin_shufflevector(__builtin_bit_cast(v4i_t, At[m][0]), __builtin_bit_cast(v4i_t, At[m][1]), 0, 1, 2, 3, 4, 5, 6, 7);
                const v8i_t b8 = __builtin_shufflevector(__builtin_bit_cast(v4i_t, Bt[n][0]), __builtin_bit_cast(v4i_t, Bt[n][1]), 0, 1, 2, 3, 4, 5, 6, 7);
                asm volatile("v_mfma_f32_16x16x128_f8f6f4 %0, %1, %2, %0" : "+v"(acc[m][n]) : "v"(b8), "v"(a8)); }
    }
}
template <class Epi, class Sched, bool ALIGN_EPI = true, int F8SH = -1>
DEVI void gemm_phase(LAS unsigned char* lds, const Gemm g, const Sched& S, const Epi& E, int wave0) {
    const int tid = opaque_tid(wave0), wid = __builtin_amdgcn_readfirstlane(tid >> 6), lane = tid & 63, wr = wid >> 2, wc = wid & 3, fr = lane & 15, fq = lane >> 4;
    const int K = g.K, nt = K / BK, lda = g.lda, ldb = g.ldb;
    unsigned voffA[2], voffB[2];
#pragma unroll
    for (int i = 0; i < 2; ++i) { int R, C; stage_rc(tid * 16 + i * 8192, R, C); const int Rb = Epi::PERM ? ((R & ~31) + perm32(R & 31)) : R;
        voffA[i] = (unsigned)(R * lda + C) * 2u; voffB[i] = (unsigned)(Rb * ldb + C) * 2u; }
    const size_t kstep = (size_t)(BK * 2);
    const size_t hstepA = (size_t)HALF * lda * 2, tstepA = 2 * hstepA;
    const size_t hstepB = (size_t)HALF * ldb * 2, tstepB = 2 * hstepB;
    const unsigned ldsw = (unsigned)wid * 1024u;
    const int aoff = lds_byte(wr * 64 + fr, fq * 8), boff = lds_byte(wc * 32 + fr, fq * 8);
#define PG8_SA(b, h) (((b) * 2 + (h)) * HTB)
#define PG8_SB(b, h) ((4 + (b) * 2 + (h)) * HTB)
#define PG8_STAGE(bufoff, gbase, voff) do { _Pragma("unroll") for (int _i = 0; _i < 2; ++_i) \
        __builtin_amdgcn_global_load_lds((const unsigned*)((const char*)(gbase) + (voff)[_i]), (LAS unsigned*)(lds + (bufoff) + ldsw + _i * 8192), 16, 0, 0); } while (0)
#define PG8_LDA(dst, b, h) do { _Pragma("unroll") for (int m = 0; m < 4; ++m) _Pragma("unroll") for (int k = 0; k < 2; ++k) dst[m][k] = *(const LAS bf16x8*)(lds + PG8_SA(b, h) + aoff + m * 2048 + k * 1024); } while (0)
#define PG8_LDB(dst, b, h) do { _Pragma("unroll") for (int n = 0; n < 2; ++n) _Pragma("unroll") for (int k = 0; k < 2; ++k) dst[n][k] = *(const LAS bf16x8*)(lds + PG8_SB(b, h) + boff + n * 2048 + k * 1024); } while (0)
#define PG8_MMA(ai, bj, At, Bt) do { __builtin_amdgcn_s_setprio(1); mma_block<F8SH>(acc[ai][bj], At, Bt); __builtin_amdgcn_s_setprio(0); } while (0)
#define PG8_WAIT_V(n) asm volatile("s_waitcnt vmcnt(" #n ")" ::: "memory")
#define PG8_WAIT_L(n) asm volatile("s_waitcnt lgkmcnt(" #n ")" ::: "memory")
#define PG8_BAR __builtin_amdgcn_s_barrier()
#define PG8_SCHED __builtin_amdgcn_sched_barrier(0)
    Unit cur, nxt; int ui = 0;
    if (!S.next(0, cur)) return;
    f32x4 acc[2][2][4][2];
#pragma unroll
    for (int a = 0; a < 2; ++a)
#pragma unroll
        for (int b = 0; b < 2; ++b)
#pragma unroll
            for (int m = 0; m < 4; ++m)
#pragma unroll
                for (int n = 0; n < 2; ++n) acc[a][b][m][n] = (f32x4){0.f, 0.f, 0.f, 0.f};
    bf16x8 At[4][2], B0[2][2], B1[2][2];
    const char* cA = (const char*)g.A + (size_t)cur.pm * tstepA + (size_t)cur.koff * 2; const char* cB = (const char*)cur.bt + (size_t)cur.pn * tstepB + (size_t)cur.koff * 2;
    PG8_STAGE(PG8_SB(0, 0), cB, voffB); PG8_STAGE(PG8_SB(0, 1), cB + hstepB, voffB); PG8_STAGE(PG8_SA(0, 0), cA, voffA); PG8_STAGE(PG8_SA(0, 1), cA + hstepA, voffA);
    if (wr == 1) PG8_BAR;
    PG8_WAIT_V(2); PG8_BAR;
    PG8_STAGE(PG8_SB(1, 0), cB + kstep, voffB); PG8_STAGE(PG8_SA(1, 0), cA + kstep, voffA); PG8_STAGE(PG8_SB(1, 1), cB + hstepB + kstep, voffB);
    PG8_WAIT_V(6); PG8_BAR;
    for (;;) {
        const bool has_next = S.next(ui + 1, nxt);
        const char* nA = has_next ? (const char*)g.A + (size_t)nxt.pm * tstepA + (size_t)nxt.koff * 2 : cA; const char* nB = has_next ? (const char*)nxt.bt + (size_t)nxt.pn * tstepB + (size_t)nxt.koff * 2 : cB;
#pragma unroll 1
        for (int t = 0; t < nt; t += 2) {
            const bool last = (t == nt - 2);
            const char* a1 = cA + (size_t)(t + 1) * kstep;
            const char* a2 = last ? nA : cA + (size_t)(t + 2) * kstep; const char* b2 = last ? nB : cB + (size_t)(t + 2) * kstep;
            const char* a3 = a2 + kstep; const char* b3 = b2 + kstep;
            PG8_LDB(B0, 0, 0); PG8_LDB(B1, 0, 1); PG8_SCHED; PG8_LDA(At, 0, 0); PG8_STAGE(PG8_SA(1, 1), a1 + hstepA, voffA);
            PG8_WAIT_V(8); PG8_WAIT_L(0); PG8_BAR; PG8_MMA(0, 0, At, B0); PG8_MMA(0, 1, At, B1); PG8_BAR; PG8_SCHED;
            PG8_LDA(At, 0, 1); PG8_STAGE(PG8_SB(0, 0), b2, voffB); PG8_STAGE(PG8_SB(0, 1), b2 + hstepB, voffB); PG8_STAGE(PG8_SA(0, 0), a2, voffA);
            PG8_WAIT_V(8); PG8_WAIT_L(0); PG8_BAR; PG8_MMA(1, 0, At, B0); PG8_MMA(1, 1, At, B1); PG8_BAR; PG8_SCHED;
            PG8_LDB(B0, 1, 0); PG8_LDB(B1, 1, 1); PG8_SCHED; PG8_LDA(At, 1, 0); PG8_STAGE(PG8_SA(0, 1), a2 + hstepA, voffA);
            PG8_WAIT_V(8); PG8_WAIT_L(0); PG8_BAR; PG8_MMA(0, 0, At, B0); PG8_MMA(0, 1, At, B1); PG8_BAR; PG8_SCHED;
            PG8_LDA(At, 1, 1); PG8_STAGE(PG8_SB(1, 0), b3, voffB); PG8_STAGE(PG8_SB(1, 1), b3 + hstepB, voffB); PG8_STAGE(PG8_SA(1, 0), a3, voffA);
            PG8_WAIT_V(8); PG8_WAIT_L(0); PG8_BAR; PG8_MMA(1, 0, At, B0); PG8_MMA(1, 1, At, B1); PG8_BAR; PG8_SCHED;
        }
        if constexpr (F8SH >= 0) { asm volatile("s_nop 15\n\ts_nop 15" ::: "memory"); PG8_SCHED; }
        if constexpr (ALIGN_EPI) { if (wr == 0) PG8_BAR; }
        E(acc, cur, wr, wc, fr, fq);
        if (!has_next) break;
#pragma unroll
        for (int a = 0; a < 2; ++a)
#pragma unroll
            for (int b = 0; b < 2; ++b)
#pragma unroll
                for (int m = 0; m < 4; ++m)
#pragma unroll
                    for (int n = 0; n < 2; ++n) acc[a][b][m][n] = (f32x4){0.f, 0.f, 0.f, 0.f};
        cur = nxt; cA = nA; cB = nB; ++ui;
        if constexpr (ALIGN_EPI) { if (wr == 1) PG8_BAR; }
    }
    PG8_WAIT_V(0);
    if constexpr (!ALIGN_EPI) { if (wr == 0) PG8_BAR; }
    PG8_BAR;
#undef PG8_SA
#undef PG8_SB
#undef PG8_STAGE
#undef PG8_LDA
#undef PG8_LDB
#undef PG8_MMA
#undef PG8_WAIT_V
#undef PG8_WAIT_L
#undef PG8_BAR
#undef PG8_SCHED
}
}

#define XB_TMO      128
#define XB_XCNT(j)  (256  + 64 * (j))
#define XB_XSUB(j)  (1280 + 64 * (j))
#define XB_XGEN(j)  (2304 + 64 * (j))
#define XB_TOP      3328
#define XB_TOPGEN   3392
#define XCD_BAR_WORDS 3456
#define XB_SPIN_CAP (1u << 22)
DEVI unsigned xb_ld(unsigned* p)              { return __hip_atomic_load(p, __ATOMIC_RELAXED, __HIP_MEMORY_SCOPE_AGENT); }
DEVI unsigned xb_add(unsigned* p, unsigned v) { return __hip_atomic_fetch_add(p, v, __ATOMIC_RELAXED, __HIP_MEMORY_SCOPE_AGENT); }
DEVI unsigned xb_xcc_id() { return (unsigned)__builtin_amdgcn_s_getreg((3 << 11) | 20) & 0xFu; }
#define XB_SPIN(cond, bar) do { unsigned _sp = 0; while (cond) { __builtin_amdgcn_s_sleep(1); \
    if ((++_sp & 255u) == 0u) { if (xb_ld(&(bar)[XB_TMO])) break; if (_sp > XB_SPIN_CAP) { atomicAdd(&(bar)[XB_TMO], 1u); break; } } } } while (0)
struct XcdBarrier { unsigned* bar; unsigned x; volatile LAS unsigned* st; };
DEVI XcdBarrier xcd_barrier_post(unsigned* bar, volatile LAS unsigned* st) {
    XcdBarrier b; b.bar = bar; b.x = xb_xcc_id(); b.st = st;
    if (threadIdx.x == 0) (void)xb_add(&bar[XB_XCNT(b.x)], 1u);
    return b;
}
DEVI void xcd_barrier_complete(unsigned* bar, unsigned x, unsigned& nloc, unsigned& nx) {
    const unsigned G = gridDim.x * gridDim.y * gridDim.z;
    unsigned sum, cnt, mine, sp = 0u;
    for (;;) {
        sum = 0u; cnt = 0u; mine = 0u;
#pragma unroll
        for (unsigned j = 0; j < 16; ++j) { const unsigned c = xb_ld(&bar[XB_XCNT(j)]); sum += c; cnt += (c > 0u) ? 1u : 0u; mine = (j == x) ? c : mine; }
        if (sum == G) break;
        __builtin_amdgcn_s_sleep(1);
        if ((++sp & 255u) == 0u) { if (xb_ld(&bar[XB_TMO])) break; if (sp > XB_SPIN_CAP) { atomicAdd(&bar[XB_TMO], 1u); break; } }
    }
    nloc = mine > 0u ? mine : 1u; nx = cnt > 0u ? cnt : 1u;
}
DEVI void xcd_barrier(const XcdBarrier& b) {
    asm volatile("s_waitcnt vmcnt(0)" ::: "memory");
    __syncthreads();
    if (threadIdx.x == 0) {
        unsigned* bar = b.bar;
        __builtin_amdgcn_s_waitcnt(0);
        unsigned nloc = b.st[0], nx = b.st[1];
        if (nloc == 0u) { xcd_barrier_complete(bar, b.x, nloc, nx); b.st[0] = nloc; b.st[1] = nx; }
        const unsigned old = xb_add(&bar[XB_XSUB(b.x)], 1u);
        const unsigned gen = old / nloc;
        if (old + 1u == (gen + 1u) * nloc) {
            __builtin_amdgcn_fence(__ATOMIC_RELEASE, "agent");
            asm volatile("s_waitcnt vmcnt(0)" ::: "memory");
            const unsigned og = xb_add(&bar[XB_TOP], 1u);
            const unsigned tg = og / nx;
            if (og + 1u == (tg + 1u) * nx) xb_add(&bar[XB_TOPGEN], 1u);
            else XB_SPIN(xb_ld(&bar[XB_TOPGEN]) == tg, bar);
            __builtin_amdgcn_fence(__ATOMIC_ACQUIRE, "agent");
            xb_add(&bar[XB_XGEN(b.x)], 1u);
            asm volatile("s_waitcnt vmcnt(0)" ::: "memory");
        } else {
            XB_SPIN(xb_ld(&bar[XB_XGEN(b.x)]) == gen, bar);
            __builtin_amdgcn_fence(__ATOMIC_ACQUIRE, "agent");
            asm volatile("s_waitcnt vmcnt(0)" ::: "memory");
        }
    }
    __syncthreads();
}

typedef const void* cvp_t;
DEVI const void* karg_ptr(int byte_off) { asm volatile("" : "+s"(byte_off)); const __attribute__((address_space(4))) char* kp = (const __attribute__((address_space(4))) char*)__builtin_amdgcn_kernarg_segment_ptr(); return *(const __attribute__((address_space(4))) cvp_t*)(kp + byte_off); }
#define ARG_IN(i) karg_ptr((i) * 8)
#define ARG_OUT() ((float*)karg_ptr(18 * 8))
#define ARG_WS() ((unsigned char*)karg_ptr(19 * 8))
struct Frame {
    LAS unsigned char* lds;
    unsigned char* ws;
    int tid, lane, wave, G, vcu, wave0;
    DEVI void refresh() { tid = opaque_tid(wave0); lane = tid & 63; wave = __builtin_amdgcn_readfirstlane(tid >> 6); }
};
constexpr int NWAVES = 8;
constexpr int F8_WIN_SH = 5, F8_WOUT_SH = 6;
constexpr float F8_WIN_MUL = 32.f, F8_WOUT_MUL = 64.f;

DEVI void transpose_item(const float* W, int K, int N, bf16_t* WT, int k0, int n0, int drow0, LAS float* scr, int lane, float f8mul) {
    const int nc = n0 + 4 * (lane & 7); const bool ok = nc < N;
#pragma unroll
    for (int i = 0; i < 8; ++i) { const int kk = 8 * i + (lane >> 3); const f32x4 v = ok ? *(const f32x4*)(W + (size_t)(k0 + kk) * N + nc) : (f32x4){0.f, 0.f, 0.f, 0.f};
        LAS float* d = scr + kk * 33 + 4 * (lane & 7); d[0] = v[0]; d[1] = v[1]; d[2] = v[2]; d[3] = v[3]; }
    LDS_WAIT(); asm volatile("" ::: "memory");
    const int c = lane & 7;
#pragma unroll
    for (int j = 0; j < 4; ++j) { const int n = (lane >> 3) + 8 * j; const LAS float* s = scr + (8 * c) * 33 + n;
        if (f8mul > 0.f) { u32x2 o8; o8[0] = pack_fp8x4(s[0 * 33] * f8mul, s[1 * 33] * f8mul, s[2 * 33] * f8mul, s[3 * 33] * f8mul); o8[1] = pack_fp8x4(s[4 * 33] * f8mul, s[5 * 33] * f8mul, s[6 * 33] * f8mul, s[7 * 33] * f8mul);
            *(u32x2*)((unsigned char*)WT + (size_t)(drow0 + n) * K + k0 + 8 * c) = o8; continue; }
        u32x4 o; o.x = pk2(s[0 * 33], s[1 * 33]); o.y = pk2(s[2 * 33], s[3 * 33]); o.z = pk2(s[4 * 33], s[5 * 33]); o.w = pk2(s[6 * 33], s[7 * 33]);
        *(u32x4*)(WT + (size_t)(drow0 + n) * K + k0 + 8 * c) = o; }
    LDS_WAIT(); asm volatile("" ::: "memory");
}
struct WFam { const float* src; size_t sstride; bf16_t* dst; size_t dstride; int count, K, N, Npad, mode; float f8mul; };
DEVI bool wfam_do(const WFam& f, int& it, LAS float* scr, int lane) {
    const int nkb = f.K / 64, nnb = f.Npad / 32, per = nkb * nnb, tot = per * f.count;
    if (it >= tot) { it -= tot; return false; }
    const int mi = it / per, r = it % per, kb = r / nnb, nb = r % nnb, n0 = nb * 32;
    int drow0 = n0;
    if (f.mode == 1) { const int F = f.N / 2; const int o = n0 < F ? n0 : n0 - F; drow0 = 256 * (o / 128) + (o % 128) + (n0 < F ? 0 : 128); }
    transpose_item(f.src + (size_t)mi * f.sstride, f.K, f.N, f.dst + (size_t)mi * f.dstride, kb * 64, n0, drow0, scr, lane, f.f8mul);
    return true;
}

DEVI void phase_prologue(Frame& F) {
    F.refresh();
    LAS float* scr = (LAS float*)(F.lds + F.wave * 16384);
    const int gw = F.vcu * NWAVES + F.wave, NGW = F.G * NWAVES;
    unsigned char* ws = F.ws;
    const WFam fam[11] = {
        {(const float*)ARG_IN(2), (size_t)DM * A_IN, (bf16_t*)(ws + WS_WINA), (size_t)A_INP * DM, 2, DM, A_IN, A_INP, 0, 0.f},
        {(const float*)ARG_IN(3), (size_t)DM * DM, (bf16_t*)(ws + WS_WOUTA), (size_t)DM * DM, 2, DM, DM, DM, 0, 0.f},
        {(const float*)ARG_IN(5), (size_t)2048 * 256, (bf16_t*)(ws + WS_WC1), (size_t)256 * 2048, 4, 2048, 256, 256, 0, 0.f},
        {(const float*)ARG_IN(6), (size_t)256 * 64, (bf16_t*)(ws + WS_WC2), (size_t)256 * 256, 4, 256, 64, 256, 0, 0.f},
        {(const float*)ARG_IN(8), (size_t)DM * DM, (bf16_t*)(ws + WS_WQKV2), 0, 1, DM, DM, DM, 0, 0.f},
        {(const float*)ARG_IN(7), 0, (bf16_t*)(ws + WS_WQKV2) + (size_t)DM * DM, 0, 1, DM, 256, 256, 0, 0.f},
        {(const float*)ARG_IN(8) + (size_t)DM * DM, 0, (bf16_t*)(ws + WS_WQB1), 0, 1, DM, DM, DM, 0, 0.f},
        {(const float*)ARG_IN(9), (size_t)DM * DM, (bf16_t*)(ws + WS_WOUTB), (size_t)DM * DM, 2, DM, DM, DM, 0, 0.f},
        {(const float*)ARG_IN(13), (size_t)DM * 2 * DFF, (bf16_t*)(ws + WS_WDIN), (size_t)2 * DFF * DM, 2, DM, 2 * DFF, 2 * DFF, 1, 0.f},
        {(const float*)ARG_IN(14), (size_t)DFF * DM, (bf16_t*)(ws + WS_WDOUT), (size_t)DM * DFF, 2, DFF, DM, DM, 0, 0.f},
        {(const float*)ARG_IN(16), (size_t)DM * 2 * DFFE, (bf16_t*)(ws + WS_WMIN), (size_t)DFFE * DM, 16, DM, 2 * DFFE, 2 * DFFE, 1, F8_WIN_MUL},
    };
    const WFam famo = {(const float*)ARG_IN(17), (size_t)DFFE * DM, (bf16_t*)(ws + WS_WMOUT), (size_t)DM * DFFE / 2, 16, DFFE, DM, DM, 0, F8_WOUT_MUL};
    int total = 0;
#pragma unroll
    for (int i = 0; i < 11; ++i) total += (fam[i].K / 64) * (fam[i].Npad / 32) * fam[i].count;
    total += (famo.K / 64) * (famo.Npad / 32) * famo.count;
    for (int it0 = gw; it0 < total; it0 += NGW) {
        int it = it0; bool done = false;
#pragma unroll
        for (int i = 0; i < 11; ++i) if (!done) done = wfam_do(fam[i], it, scr, F.lane);
        if (!done) wfam_do(famo, it, scr, F.lane);
    }
    { const float* x = (const float*)ARG_IN(0); bf16_t* hb = (bf16_t*)(ws + WS_HB);
      const size_t n8 = (size_t)MTOK * DM / 8;
      for (size_t i = (size_t)blockIdx.x * 512 + F.tid; i < n8; i += (size_t)F.G * 512) {
          const f32x4 v0 = *(const f32x4*)(x + i * 8), v1 = *(const f32x4*)(x + i * 8 + 4);
          u32x4 o; o.x = pk2(v0.x, v0.y); o.y = pk2(v0.z, v0.w); o.z = pk2(v1.x, v1.y); o.w = pk2(v1.z, v1.w);
          *(u32x4*)(hb + i * 8) = o; } }
    { const int* pos = (const int*)ARG_IN(1); float* cs = (float*)(ws + WS_CS);
      for (int i = blockIdx.x * 512 + F.tid; i < MTOK * 8; i += F.G * 512) {
          const int tok = i >> 3, j = i & 7;
          const float invf = (float)exp2(-(double)j * (18.931568569324174 / 8.0));
          const double ang = (double)((float)pos[tok] * invf);
          const double n = rint(ang * 0.15915494309189535); const double r = ang - n * 6.283185307179586476925;
          const float rf = (float)r;
          cs[tok * 16 + j] = cosf(rf); cs[tok * 16 + 8 + j] = sinf(rf); } }
    { const float* cp = (const float*)ARG_IN(4); const float* w1 = (const float*)ARG_IN(5); float* bp = (float*)((unsigned*)(ws + WS_CTL) + CW_BIASP);
      if (gw < 1024) { const int mi = gw >> 8, c = gw & 255; float s = 0.f;
#pragma unroll 8
          for (int i = 0; i < 32; ++i) { const int f = i * 64 + F.lane; s += cp[(size_t)mi * 2048 + f] * w1[((size_t)mi * 2048 + f) * 256 + c]; }
          s = wave_sum(s, F.lane);
          if (F.lane == 0) bp[gw] = s; } }
}

typedef f32x4 AccT[2][2][4][2];

DEVI u32x4 pack8(const f32x4 a, const f32x4 b) { u32x4 w; w.x = pg8::cvt_pk_bf16(a[0], a[1]); w.y = pg8::cvt_pk_bf16(a[2], a[3]); w.z = pg8::cvt_pk_bf16(b[0], b[1]); w.w = pg8::cvt_pk_bf16(b[2], b[3]); return w; }
DEVI void rope8(f32x4& v0, f32x4& v1, int dhead, const float* csrow, int lane) {
    f32x4 p0, p1;
#pragma unroll
    for (int i = 0; i < 4; ++i) { p0[i] = shx(v0[i], 16, lane); p1[i] = shx(v1[i], 16, lane); }
    if (dhead < 16) {
        const f32x4 c0 = *(const f32x4*)(csrow), c1 = *(const f32x4*)(csrow + 4), s0 = *(const f32x4*)(csrow + 8), s1 = *(const f32x4*)(csrow + 12);
        if (dhead == 0) { v0 = v0 * c0 - p0 * s0; v1 = v1 * c1 - p1 * s1; }
        else            { v0 = v0 * c0 + p0 * s0; v1 = v1 * c1 + p1 * s1; }
    }
}

struct EpiNsaIn {
    static constexpr bool PERM = true;
    unsigned char* ws; const float* cs;
    DEVI void operator()(const AccT& acc, const pg8::Unit& u, int wr, int wc, int fr, int fq) const {
        const int pn = u.pn;
        if (pn < 4) {
            bf16_t* Q = (bf16_t*)(ws + RA_Q);
#pragma unroll
            for (int ai = 0; ai < 2; ++ai)
#pragma unroll
                for (int m = 0; m < 4; ++m) { const int row = u.pm * 256 + ai * 128 + wr * 64 + m * 16 + fr;
#pragma unroll
                    for (int bj = 0; bj < 2; ++bj) *(u32x4*)(Q + (size_t)row * DM + pn * 256 + bj * 128 + wc * 32 + fq * 8) = pack8(acc[ai][bj][m][0], acc[ai][bj][m][1]); }
        } else if (pn < 10) {
            const size_t base = pn == 4 ? RA_KCR : pn == 5 ? RA_VCR : pn == 6 ? RA_KS : pn == 7 ? RA_VS : pn == 8 ? RA_KW : RA_VW;
            bf16_t* T = (bf16_t*)(ws + base);
            const bool rot = (pn == 6 || pn == 8);
            const int dh = (wc & 1) * 32 + fq * 8;
#pragma unroll
            for (int ai = 0; ai < 2; ++ai)
#pragma unroll
                for (int m = 0; m < 4; ++m) { const int row = u.pm * 256 + ai * 128 + wr * 64 + m * 16 + fr; const int b = row / SEQ, t = row % SEQ;
#pragma unroll
                    for (int bj = 0; bj < 2; ++bj) { f32x4 v0 = acc[ai][bj][m][0], v1 = acc[ai][bj][m][1];
                        if (rot) rope8(v0, v1, dh, cs + (size_t)row * 16, fq * 16 + fr);
                        const int g = bj * 2 + (wc >> 1);
                        *(u32x4*)(T + ((size_t)(b * A_G + g) * SEQ + t) * HD + dh) = pack8(v0, v1); } }
        } else {
            float* G = (float*)(ws + RA_GATE);
            if (wc < 2) {
#pragma unroll
                for (int ai = 0; ai < 2; ++ai)
#pragma unroll
                    for (int m = 0; m < 4; ++m) { const int row = u.pm * 256 + ai * 128 + wr * 64 + m * 16 + fr;
#pragma unroll
                        for (int n = 0; n < 2; ++n) { const int c = wc * 32 + fq * 8 + n * 4;
                            if (c < 48) { f32x4 v = acc[ai][0][m][n]; f32x4 o;
#pragma unroll
                                for (int i = 0; i < 4; ++i) o[i] = 1.f / (1.f + __expf(-v[i]));
                                *(f32x4*)(G + (size_t)row * 48 + c) = o; } } }
            }
        }
    }
};
struct EpiSwaIn {
    static constexpr bool PERM = true;
    unsigned char* ws; const float* cs;
    DEVI void operator()(const AccT& acc, const pg8::Unit& u, int wr, int wc, int fr, int fq) const {
        const int pn = u.pn; const int dh = (wc & 1) * 32 + fq * 8;
        bf16_t* Q = (bf16_t*)(ws + RA_Q); bf16_t* KS = (bf16_t*)(ws + WS_KSH); bf16_t* VS = (bf16_t*)(ws + WS_VSH);
#pragma unroll
        for (int ai = 0; ai < 2; ++ai)
#pragma unroll
            for (int m = 0; m < 4; ++m) { const int row = u.pm * 256 + ai * 128 + wr * 64 + m * 16 + fr; const int b = row / SEQ, t = row % SEQ;
#pragma unroll
                for (int bj = 0; bj < 2; ++bj) { f32x4 v0 = acc[ai][bj][m][0], v1 = acc[ai][bj][m][1];
                    const bool rot = (pn < 4) || (bj == 0);
                    if (rot) rope8(v0, v1, dh, cs + (size_t)row * 16, fq * 16 + fr);
                    const u32x4 w = pack8(v0, v1);
                    if (pn < 4) *(u32x4*)(Q + (size_t)row * DM + pn * 256 + bj * 128 + wc * 32 + fq * 8) = w;
                    else { bf16_t* T = bj == 0 ? KS : VS; const int g = wc >> 1; *(u32x4*)(T + ((size_t)(b * B_G + g) * SEQ + t) * HD + dh) = w; } } }
    }
};
DEVI float gelu_tanh(float x) { const float u = 0.7978845608028654f * (x + 0.044715f * x * x * x); const float e = __expf(2.f * u); const float th = 1.f - 2.f / (e + 1.f); return 0.5f * x * (1.f + th); }
struct EpiCmpHid {
    static constexpr bool PERM = true;
    bf16_t* out; const float* bias;
    DEVI void operator()(const AccT& acc, const pg8::Unit& u, int wr, int wc, int fr, int fq) const {
        const float* bs = bias;
#pragma unroll
        for (int bj = 0; bj < 2; ++bj) { const int c = bj * 128 + wc * 32 + fq * 8; const f32x4 b0 = *(const f32x4*)(bs + c), b1 = *(const f32x4*)(bs + c + 4);
#pragma unroll
            for (int ai = 0; ai < 2; ++ai)
#pragma unroll
                for (int m = 0; m < 4; ++m) { const int row = u.pm * 256 + ai * 128 + wr * 64 + m * 16 + fr; f32x4 v0 = acc[ai][bj][m][0] + b0, v1 = acc[ai][bj][m][1] + b1;
#pragma unroll
                    for (int i = 0; i < 4; ++i) { v0[i] = gelu_tanh(v0[i]); v1[i] = gelu_tanh(v1[i]); }
                    *(u32x4*)(out + (size_t)row * 256 + c) = pack8(v0, v1); } }
    }
};
struct EpiCmpOut {
    static constexpr bool PERM = true;
    bf16_t* kc; bf16_t* vc;
    DEVI void operator()(const AccT& acc, const pg8::Unit& u, int wr, int wc, int fr, int fq) const {
        if (wc >= 2) return;
        bf16_t* T = u.pm >= 32 ? vc : kc; const int rbase = (u.pm & 31) * 256;
#pragma unroll
        for (int ai = 0; ai < 2; ++ai)
#pragma unroll
            for (int m = 0; m < 4; ++m) { const int row = rbase + ai * 128 + wr * 64 + m * 16 + fr;
                u32x4 w = pack8(acc[ai][0][m][0], acc[ai][0][m][1]);
                if ((row & 1023) == 1023) w = (u32x4){0u, 0u, 0u, 0u};
                *(u32x4*)(T + (size_t)row * 64 + wc * 32 + fq * 8) = w; }
    }
};
struct EpiResid {
    static constexpr bool PERM = true;
    const bf16_t* res; bf16_t* y;
    DEVI void operator()(const AccT& acc, const pg8::Unit& u, int wr, int wc, int fr, int fq) const {
#pragma unroll
        for (int ai = 0; ai < 2; ++ai)
#pragma unroll
            for (int m = 0; m < 4; ++m) { const size_t off = (size_t)(u.pm * 256 + ai * 128 + wr * 64 + m * 16 + fr) * DM + u.pn * 256 + wc * 32 + fq * 8;
#pragma unroll
                for (int bj = 0; bj < 2; ++bj) { const u32x4 r = *(const u32x4*)(res + off + bj * 128);
                    const f32x4 r0 = {bflo(r.x), bfhi(r.x), bflo(r.y), bfhi(r.y)}, r1 = {bflo(r.z), bfhi(r.z), bflo(r.w), bfhi(r.w)};
                    *(u32x4*)(y + off + bj * 128) = pack8(r0 * ALPHA + acc[ai][bj][m][0], r1 * ALPHA + acc[ai][bj][m][1]); } }
    }
};
struct EpiBf16Out {
    static constexpr bool PERM = true;
    bf16_t* y; float sc;
    DEVI void operator()(const AccT& acc, const pg8::Unit& u, int wr, int wc, int fr, int fq) const {
#pragma unroll
        for (int ai = 0; ai < 2; ++ai)
#pragma unroll
            for (int m = 0; m < 4; ++m) { const size_t off = (size_t)(u.pm * 256 + ai * 128 + wr * 64 + m * 16 + fr) * DM + u.pn * 256 + wc * 32 + fq * 8;
#pragma unroll
                for (int bj = 0; bj < 2; ++bj) *(u32x4*)(y + off + bj * 128) = pack8(acc[ai][bj][m][0] * sc, acc[ai][bj][m][1] * sc); }
    }
};
struct EpiPart {
    static constexpr bool PERM = false;
    float* part; float sc;
    DEVI void operator()(const AccT& acc, const pg8::Unit& u, int wr, int wc, int fr, int fq) const {
        float* base = part + (size_t)((u.pm - 256) * 2 + u.z) * 256 * DM;
#pragma unroll
        for (int ai = 0; ai < 2; ++ai)
#pragma unroll
            for (int m = 0; m < 4; ++m) { const size_t off = (size_t)(ai * 128 + wr * 64 + m * 16 + fr) * DM + u.pn * 256 + wc * 32 + fq * 4;
#pragma unroll
                for (int bj = 0; bj < 2; ++bj)
#pragma unroll
                    for (int n = 0; n < 2; ++n) *(f32x4*)(base + off + bj * 128 + n * 16) = acc[ai][bj][m][n] * sc; }
    }
};
struct EpiSwiglu {
    static constexpr bool PERM = true;
    bf16_t* act; int ld;
    DEVI void operator()(const AccT& acc, const pg8::Unit& u, int wr, int wc, int fr, int fq) const {
#pragma unroll
        for (int ai = 0; ai < 2; ++ai)
#pragma unroll
            for (int m = 0; m < 4; ++m) { const size_t row = (size_t)(u.pm * 256 + ai * 128 + wr * 64 + m * 16 + fr); f32x4 o[2];
#pragma unroll
                for (int n = 0; n < 2; ++n)
#pragma unroll
                    for (int i = 0; i < 4; ++i) { const float gv = acc[ai][0][m][n][i], uv = acc[ai][1][m][n][i]; o[n][i] = gv * __builtin_amdgcn_rcpf(1.f + __expf(-gv)) * uv; }
                *(u32x4*)(act + row * ld + u.pn * 128 + wc * 32 + fq * 8) = pack8(o[0], o[1]); }
    }
};

struct EpiSwiglu8 {
    static constexpr bool PERM = true;
    unsigned char* act; int ld; float sc;
    DEVI void operator()(const AccT& acc, const pg8::Unit& u, int wr, int wc, int fr, int fq) const {
#pragma unroll
        for (int ai = 0; ai < 2; ++ai)
#pragma unroll
            for (int m = 0; m < 4; ++m) { const size_t row = (size_t)(u.pm * 256 + ai * 128 + wr * 64 + m * 16 + fr); f32x4 o[2];
#pragma unroll
                for (int n = 0; n < 2; ++n)
#pragma unroll
                    for (int i = 0; i < 4; ++i) { const float gv = acc[ai][0][m][n][i] * sc, uv = acc[ai][1][m][n][i] * sc; o[n][i] = gv * __builtin_amdgcn_rcpf(1.f + __expf(-gv)) * uv; }
                u32x2 w; w[0] = pack_fp8x4(o[0][0], o[0][1], o[0][2], o[0][3]); w[1] = pack_fp8x4(o[1][0], o[1][1], o[1][2], o[1][3]);
                *(u32x2*)(act + row * ld + u.pn * 128 + wc * 32 + fq * 8) = w; }
    }
};

DEVI void unpack8(const u32x4 w, float (&x)[8]) { x[0] = bflo(w.x); x[1] = bfhi(w.x); x[2] = bflo(w.y); x[3] = bfhi(w.y); x[4] = bflo(w.z); x[5] = bfhi(w.z); x[6] = bflo(w.w); x[7] = bfhi(w.w); }
DEVI void moe_row8(const bf16_t* YB, const float* PART, int p, int c, float (&x)[8]) {
    if (p < 65536) { unpack8(*(const u32x4*)(YB + (size_t)p * DM + c), x); return; }
    const float* q = PART + ((size_t)(((p >> 8) - 256) * 2) * 256 + (p & 255)) * DM + c;
    f32x4 a0 = *(const f32x4*)q, a1 = *(const f32x4*)(q + 4);
    a0 = a0 + *(const f32x4*)(q + (size_t)256 * DM); a1 = a1 + *(const f32x4*)(q + (size_t)256 * DM + 4);
    x[0] = a0[0]; x[1] = a0[1]; x[2] = a0[2]; x[3] = a0[3]; x[4] = a1[0]; x[5] = a1[1]; x[6] = a1[2]; x[7] = a1[3];
}
template <int MODE, bool ROUTER, bool FINAL>
DEVI void phase_ln(Frame& F, int lnidx, float* outp, int moe_layer) {
    F.refresh();
    unsigned char* ws = F.ws;
    const bf16_t* Y = (const bf16_t*)(ws + WS_Y); const bf16_t* YB = (const bf16_t*)(ws + WS_YB); const float* PART = (const float*)(ws + WS_H);
    bf16_t* HB = (bf16_t*)(ws + WS_HB);
    const float* gam = (const float*)ARG_IN(11) + (size_t)lnidx * DM; const float* bet = (const float*)ARG_IN(12) + (size_t)lnidx * DM;
    int* TOKE = (int*)(ws + WS_ROUTE); int* TOKR = TOKE + MTOK * 2; float* TOKW = (float*)(TOKR + MTOK * 2); int* TOKP = (int*)(TOKW + MTOK * 2);
    const float* wr_ = ROUTER ? (const float*)ARG_IN(15) + (size_t)moe_layer * DM * NEXP : nullptr;
    LAS int* lcnt = (LAS int*)(F.lds + LDS_X);
    LAS int* lrec = lcnt + 16;
    LAS int* lrank = lrec + 256;
    if (ROUTER) { if (F.tid < 16) lcnt[F.tid] = 0; __syncthreads(); }
    const int gw = F.vcu * NWAVES + F.wave, NGW = F.G * NWAVES;
    constexpr int RB = (MODE == 0) ? 4 : 2;
    const f32x4 g0_[2] = {*(const f32x4*)(gam + F.lane * 8), *(const f32x4*)(gam + 512 + F.lane * 8)}, g1_[2] = {*(const f32x4*)(gam + F.lane * 8 + 4), *(const f32x4*)(gam + 512 + F.lane * 8 + 4)};
    const f32x4 b0_[2] = {*(const f32x4*)(bet + F.lane * 8), *(const f32x4*)(bet + 512 + F.lane * 8)}, b1_[2] = {*(const f32x4*)(bet + F.lane * 8 + 4), *(const f32x4*)(bet + 512 + F.lane * 8 + 4)};
#pragma unroll 1
    for (int k0 = 0; k0 < 16; k0 += RB) {
        float v[RB][2][8];
        if (MODE == 0) {
            u32x4 raw[RB][2];
#pragma unroll
            for (int r = 0; r < RB; ++r)
#pragma unroll
                for (int j = 0; j < 2; ++j) raw[r][j] = *(const u32x4*)(Y + (size_t)(gw + (k0 + r) * NGW) * DM + j * 512 + F.lane * 8);
#pragma unroll
            for (int r = 0; r < RB; ++r)
#pragma unroll
                for (int j = 0; j < 2; ++j) unpack8(raw[r][j], v[r][j]);
        } else {
            int p0[RB], p1[RB]; float w0[RB], w1[RB];
#pragma unroll
            for (int r = 0; r < RB; ++r) { const int m = gw + (k0 + r) * NGW; p0[r] = TOKP[m * 2]; p1[r] = TOKP[m * 2 + 1]; w0[r] = TOKW[m * 2]; w1[r] = TOKW[m * 2 + 1]; }
            u32x4 hraw[RB][2];
#pragma unroll
            for (int r = 0; r < RB; ++r)
#pragma unroll
                for (int j = 0; j < 2; ++j) hraw[r][j] = *(const u32x4*)(HB + (size_t)(gw + (k0 + r) * NGW) * DM + j * 512 + F.lane * 8);
#pragma unroll
            for (int r = 0; r < RB; ++r)
#pragma unroll
                for (int j = 0; j < 2; ++j) { const int c = j * 512 + F.lane * 8; float h[8], a[8], b[8];
                    unpack8(hraw[r][j], h); moe_row8(YB, PART, p0[r], c, a); moe_row8(YB, PART, p1[r], c, b);
#pragma unroll
                    for (int i = 0; i < 8; ++i) v[r][j][i] = h[i] * ALPHA + a[i] * w0[r] + b[i] * w1[r]; }
        }
#pragma unroll
        for (int r = 0; r < RB; ++r) {
            const int m = gw + (k0 + r) * NGW;
            float s = 0.f;
#pragma unroll
            for (int j = 0; j < 2; ++j)
#pragma unroll
                for (int i = 0; i < 8; ++i) s += v[r][j][i];
            const float mean = wave_sum(s, F.lane) * (1.f / DM); float s2 = 0.f;
#pragma unroll
            for (int j = 0; j < 2; ++j)
#pragma unroll
                for (int i = 0; i < 8; ++i) { v[r][j][i] -= mean; s2 += v[r][j][i] * v[r][j][i]; }
            const float rstd = 1.f / sqrtf(wave_sum(s2, F.lane) * (1.f / DM) + LN_EPS);
#pragma unroll
            for (int j = 0; j < 2; ++j) { const int c = j * 512 + F.lane * 8;
#pragma unroll
                for (int i = 0; i < 4; ++i) { v[r][j][i] = v[r][j][i] * rstd * g0_[j][i] + b0_[j][i]; v[r][j][4 + i] = v[r][j][4 + i] * rstd * g1_[j][i] + b1_[j][i]; }
                if (FINAL) { *(f32x4*)(outp + (size_t)m * DM + c) = (f32x4){v[r][j][0], v[r][j][1], v[r][j][2], v[r][j][3]}; *(f32x4*)(outp + (size_t)m * DM + c + 4) = (f32x4){v[r][j][4], v[r][j][5], v[r][j][6], v[r][j][7]}; }
                else { u32x4 w; w.x = pk2(v[r][j][0], v[r][j][1]); w.y = pk2(v[r][j][2], v[r][j][3]); w.z = pk2(v[r][j][4], v[r][j][5]); w.w = pk2(v[r][j][6], v[r][j][7]); *(u32x4*)(HB + (size_t)m * DM + c) = w; } }
            if (ROUTER) {
                float lg[NEXP];
#pragma unroll
                for (int e = 0; e < NEXP; ++e) lg[e] = 0.f;
#pragma unroll
                for (int j = 0; j < 2; ++j)
#pragma unroll
                    for (int i = 0; i < 8; ++i) { const int c = j * 512 + F.lane * 8 + i; const f32x4 w0 = *(const f32x4*)(wr_ + (size_t)c * NEXP), w1 = *(const f32x4*)(wr_ + (size_t)c * NEXP + 4); const float x = v[r][j][i];
                        lg[0] += x * w0.x; lg[1] += x * w0.y; lg[2] += x * w0.z; lg[3] += x * w0.w; lg[4] += x * w1.x; lg[5] += x * w1.y; lg[6] += x * w1.z; lg[7] += x * w1.w; }
#pragma unroll
                for (int e = 0; e < NEXP; ++e) lg[e] = wave_sum(lg[e], F.lane);
                int e0 = 0; float l0 = lg[0];
#pragma unroll
                for (int e = 1; e < NEXP; ++e) if (lg[e] > l0) { l0 = lg[e]; e0 = e; }
                int e1 = -1; float l1 = -3.4e38f;
#pragma unroll
                for (int e = 0; e < NEXP; ++e) if (e != e0 && lg[e] > l1) { l1 = lg[e]; e1 = e; }
                if (e1 < 0) e1 = (e0 + 1) & 7;
                const float g1 = 1.f / (1.f + __expf(l0 - l1)), g0 = 1.f - g1;
                if (F.lane == 0) {
                    const int idx = (F.wave * 16 + k0 + r) * 2;
                    lrec[idx] = m * 16 + e0; lrec[idx + 1] = m * 16 + e1;
                    TOKE[m * 2] = e0; TOKE[m * 2 + 1] = e1; TOKW[m * 2] = g0; TOKW[m * 2 + 1] = g1;
                }
            }
        }
    }
    if (ROUTER) {
        __syncthreads();
        unsigned* cnt = (unsigned*)(ws + WS_CTL) + CW_MOE + moe_layer * 64;
        int* wgcnt = (int*)(ws + WS_CTL) + CW_WGCNT + moe_layer * 2048 + (int)blockIdx.x * 8;
        LAS int* wcnt = lrank;
        int rec = 0, e = 0, r = 0;
        if (F.wave < 4) { rec = lrec[F.tid]; e = rec & 15;
            const unsigned long long lt = (1ull << F.lane) - 1ull;
#pragma unroll
            for (int x = 0; x < 8; ++x) { const unsigned long long b = __builtin_amdgcn_ballot_w64(e == x); if (e == x) r = __builtin_popcountll(b & lt); if (F.lane == 0) wcnt[F.wave * 8 + x] = __builtin_popcountll(b); } }
        __syncthreads();
        if (F.wave < 4) { for (int w = 0; w < F.wave; ++w) r += wcnt[w * 8 + e]; TOKR[(rec >> 4) * 2 + (F.tid & 1)] = r; }
        if (F.tid < 8) lcnt[F.tid] = wcnt[F.tid] + wcnt[8 + F.tid] + wcnt[16 + F.tid] + wcnt[24 + F.tid];
        __syncthreads();
        if (F.tid < 8) { wgcnt[F.tid] = lcnt[F.tid]; __hip_atomic_fetch_add(cnt + F.tid, (unsigned)lcnt[F.tid], __ATOMIC_RELAXED, __HIP_MEMORY_SCOPE_AGENT); }
    }
}

DEVI void moe_tiles(const unsigned* cnt, int (&ts)[9]) { ts[0] = 0;
#pragma unroll
    for (int e = 0; e < 8; ++e) ts[e + 1] = ts[e] + (int)((__hip_atomic_load(cnt + e, __ATOMIC_RELAXED, __HIP_MEMORY_SCOPE_AGENT) + 255u) >> 8); }
DEVI void phase_moe_scatter(Frame& F, int moe_layer) {
    F.refresh();
    unsigned char* ws = F.ws;
    const unsigned* cnt = (const unsigned*)(ws + WS_CTL) + CW_MOE + moe_layer * 64;
    int ts[9]; moe_tiles(cnt, ts);
    LAS int* wbase = (LAS int*)(F.lds + LDS_X);
    if (F.tid < 8) wbase[F.tid] = 0;
    __syncthreads();
    if (F.tid < (int)blockIdx.x) { const int* wc = (const int*)(ws + WS_CTL) + CW_WGCNT + moe_layer * 2048 + F.tid * 8;
        const u32x4 c0 = *(const u32x4*)wc, c1 = *(const u32x4*)(wc + 4);
#pragma unroll
        for (int e = 0; e < 4; ++e) { __hip_atomic_fetch_add(wbase + e, (int)c0[e], __ATOMIC_RELAXED, __HIP_MEMORY_SCOPE_WORKGROUP); __hip_atomic_fetch_add(wbase + 4 + e, (int)c1[e], __ATOMIC_RELAXED, __HIP_MEMORY_SCOPE_WORKGROUP); } }
    __syncthreads();
    const int* TOKE = (const int*)(ws + WS_ROUTE); const int* TOKR = TOKE + MTOK * 2; int* TOKP = (int*)(ws + WS_ROUTE) + MTOK * 6;
    const bf16_t* HB = (const bf16_t*)(ws + WS_HB); unsigned char* XB = ws + WS_XB;
    const int gw = F.vcu * NWAVES + F.wave, NGW = F.G * NWAVES;
#pragma unroll 1
    for (int k0 = 0; k0 < 16; k0 += 4) {
        u32x4 r0[4], r1[4]; int ee[4][2], rk[4][2];
#pragma unroll
        for (int q = 0; q < 4; ++q) { const int m = gw + (k0 + q) * NGW; r0[q] = *(const u32x4*)(HB + (size_t)m * DM + F.lane * 8); r1[q] = *(const u32x4*)(HB + (size_t)m * DM + 512 + F.lane * 8);
            ee[q][0] = TOKE[m * 2]; ee[q][1] = TOKE[m * 2 + 1]; rk[q][0] = TOKR[m * 2]; rk[q][1] = TOKR[m * 2 + 1]; }
#pragma unroll
        for (int q = 0; q < 4; ++q) { const int m = gw + (k0 + q) * NGW;
            u32x2 a8, b8; a8[0] = pack_fp8x4(bflo(r0[q][0]), bfhi(r0[q][0]), bflo(r0[q][1]), bfhi(r0[q][1])); a8[1] = pack_fp8x4(bflo(r0[q][2]), bfhi(r0[q][2]), bflo(r0[q][3]), bfhi(r0[q][3]));
            b8[0] = pack_fp8x4(bflo(r1[q][0]), bfhi(r1[q][0]), bflo(r1[q][1]), bfhi(r1[q][1])); b8[1] = pack_fp8x4(bflo(r1[q][2]), bfhi(r1[q][2]), bflo(r1[q][3]), bfhi(r1[q][3]));
#pragma unroll
            for (int k = 0; k < 2; ++k) { const int e = ee[q][k], r = rk[q][k];
                int st = 0;
#pragma unroll
                for (int j = 1; j < 8; ++j) st = (e >= j) ? ts[j] : st;
                const int pos = st * 256 + wbase[e] + r;
                *(u32x2*)(XB + (size_t)pos * DM + F.lane * 8) = a8; *(u32x2*)(XB + (size_t)pos * DM + 512 + F.lane * 8) = b8;
                if (F.lane == 0) TOKP[m * 2 + k] = pos; } }
    }
}

DEVI void phase_nsa_naive(Frame& F) {
    F.refresh();
    unsigned char* ws = F.ws;
    const bf16_t* Q = (const bf16_t*)(ws + RA_Q); bf16_t* ATT = (bf16_t*)(ws + RA_ATT);
    const bf16_t* KC = (const bf16_t*)(ws + RA_KC); const bf16_t* VC = (const bf16_t*)(ws + RA_VC);
    const bf16_t* KS = (const bf16_t*)(ws + RA_KS); const bf16_t* VS = (const bf16_t*)(ws + RA_VS);
    const bf16_t* KW = (const bf16_t*)(ws + RA_KW); const bf16_t* VW = (const bf16_t*)(ws + RA_VW);
    const float* GT = (const float*)(ws + RA_GATE); const float* CS = (const float*)(ws + WS_CS);
    LAS float* sc = (LAS float*)(F.lds + F.wave * 16384);
    LAS float* qs_ = (LAS float*)(F.lds + LDS_X + F.wave * 2048);
    LAS float* qr_ = qs_ + 256;
    const int lane = F.lane;
    const int gw = F.vcu * NWAVES + F.wave, NGW = F.G * NWAVES;
    for (int u = gw; u < MTOK * A_G; u += NGW) {
        const int bg = u / SEQ, t = u % SEQ, b = bg / A_G, g = bg % A_G; const int tok = b * SEQ + t;
        { const bf16_t* qp = Q + (size_t)tok * DM + g * 256 + lane * 4; const u32x2 w = *(const u32x2*)qp;
          float x[4] = {bflo(w.x), bfhi(w.x), bflo(w.y), bfhi(w.y)};
#pragma unroll
          for (int i = 0; i < 4; ++i) qs_[lane * 4 + i] = x[i];
          LDS_WAIT();
          const int d0 = (lane * 4) & 63;
#pragma unroll
          for (int i = 0; i < 4; ++i) { const int d = d0 + i; float v = x[i];
              if (d < 8) v = x[i] * CS[(size_t)tok * 16 + d] - qs_[lane * 4 + i + 8] * CS[(size_t)tok * 16 + 8 + d];
              else if (d < 16) v = x[i] * CS[(size_t)tok * 16 + d - 8] + qs_[lane * 4 + i - 8] * CS[(size_t)tok * 16 + d];
              qr_[lane * 4 + i] = v; }
          LDS_WAIT(); }
        float oc[4] = {0.f, 0.f, 0.f, 0.f}, os[4] = {0.f, 0.f, 0.f, 0.f}, ow[4] = {0.f, 0.f, 0.f, 0.f};
        const int cur = t >> 6;
        const int nv = t >= 31 ? ((t - 31) >> 4) + 1 : 0;
        float impv[4] = {0.f, 0.f, 0.f, 0.f};
        if (nv > 0) {
            const bf16_t* kc = KC + (size_t)bg * 1024 * 64; const bf16_t* vc = VC + (size_t)bg * 1024 * 64;
            float mx[4] = {-3.0e38f, -3.0e38f, -3.0e38f, -3.0e38f};
            for (int c = 0; c * 64 < nv; ++c) { const int n = c * 64 + lane;
                if (n < nv) { float s[4] = {0.f, 0.f, 0.f, 0.f}; LAS float* qs = qs_; asm volatile("" : "+v"(qs));
#pragma unroll 2
                    for (int d8 = 0; d8 < 8; ++d8) { const u32x4 w = *(const u32x4*)(kc + (size_t)n * 64 + d8 * 8);
                        const float kf[8] = {bflo(w.x), bfhi(w.x), bflo(w.y), bfhi(w.y), bflo(w.z), bfhi(w.z), bflo(w.w), bfhi(w.w)};
#pragma unroll
                        for (int r = 0; r < 4; ++r) { const f32x4 qa = *(const LAS f32x4*)(qs + r * 64 + d8 * 8), qb = *(const LAS f32x4*)(qs + r * 64 + d8 * 8 + 4);
                            s[r] += qa.x * kf[0] + qa.y * kf[1] + qa.z * kf[2] + qa.w * kf[3] + qb.x * kf[4] + qb.y * kf[5] + qb.z * kf[6] + qb.w * kf[7]; } }
#pragma unroll
                    for (int r = 0; r < 4; ++r) { s[r] *= QSCALE; mx[r] = fmaxf(mx[r], s[r]); }
                    *(LAS f32x4*)(sc + n * 4) = (f32x4){s[0], s[1], s[2], s[3]}; } }
            float l[4] = {0.f, 0.f, 0.f, 0.f};
#pragma unroll
            for (int r = 0; r < 4; ++r) mx[r] = wave_max(mx[r], lane);
            LDS_WAIT();
            for (int c = 0; c * 64 < nv; ++c) { const int n = c * 64 + lane;
                if (n < nv) { f32x4 s = *(const LAS f32x4*)(sc + n * 4);
#pragma unroll
                    for (int r = 0; r < 4; ++r) { s[r] = __expf(s[r] - mx[r]); l[r] += s[r]; }
                    *(LAS f32x4*)(sc + n * 4) = s; } }
#pragma unroll
            for (int r = 0; r < 4; ++r) l[r] = 1.f / wave_sum(l[r], lane);
            LDS_WAIT();
            for (int c = 0; c * 64 < nv; ++c) { const int n = c * 64 + lane;
                if (n < nv) { f32x4 s = *(const LAS f32x4*)(sc + n * 4);
#pragma unroll
                    for (int r = 0; r < 4; ++r) s[r] *= l[r];
                    *(LAS f32x4*)(sc + n * 4) = s; } }
            LDS_WAIT();
#pragma unroll 4
            for (int n = 0; n < nv; ++n) { const float v = bf2f(vc[(size_t)n * 64 + lane]); const f32x4 p = *(const LAS f32x4*)(sc + n * 4);
#pragma unroll
                for (int r = 0; r < 4; ++r) oc[r] += p[r] * v; }
#pragma unroll
            for (int i = 0; i < 4; ++i) { const int j = lane + 64 * i; float acc = 0.f;
#pragma unroll
                for (int k = -1; k <= 3; ++k) { const int n = 4 * j + k; if (n >= 0 && n < nv) { const f32x4 p = *(const LAS f32x4*)(sc + n * 4); const float ps = (p.x + p.y) + (p.z + p.w); acc += (k == -1 || k == 3) ? 0.5f * ps : ps; } }
                impv[i] = acc; }
        }
        float scv[4];
#pragma unroll
        for (int i = 0; i < 4; ++i) { const int j = lane + 64 * i; scv[i] = j > cur ? -1.f : ((j == 0 || j == cur || j == cur - 1) ? 1e9f : impv[i]); }
        LAS int* sel = (LAS int*)(F.lds + MISC_OFF + 256) + F.wave * 16;
#pragma unroll 1
        for (int k = 0; k < NSEL; ++k) {
            float bv = -2.f; int bi = 1 << 20;
#pragma unroll
            for (int i = 0; i < 4; ++i) { const int j = lane + 64 * i; if (scv[i] > bv) { bv = scv[i]; bi = j; } }
#pragma unroll
            for (int o = 1; o < 64; o <<= 1) { const float ov = shx(bv, o, lane); const int oi = shxi(bi, o, lane); if (ov > bv || (ov == bv && oi < bi)) { bv = ov; bi = oi; } }
            if (lane == 0) sel[k] = bi;
#pragma unroll
            for (int i = 0; i < 4; ++i) if (lane + 64 * i == bi) scv[i] = -3.f;
        }
        LDS_WAIT();
        {   const bf16_t* ks = KS + (size_t)bg * SEQ * 64; const bf16_t* vs = VS + (size_t)bg * SEQ * 64;
            float mx[4] = {-3.0e38f, -3.0e38f, -3.0e38f, -3.0e38f};
#pragma unroll 1
            for (int k = 0; k < NSEL; ++k) { const int pos = sel[k] * 64 + lane; const bool ok = pos <= t;
                float s[4] = {-1e30f, -1e30f, -1e30f, -1e30f};
                if (ok) { LAS float* qr = qr_; asm volatile("" : "+v"(qr));
#pragma unroll
                    for (int r = 0; r < 4; ++r) s[r] = 0.f;
#pragma unroll 2
                    for (int d8 = 0; d8 < 8; ++d8) { const u32x4 w = *(const u32x4*)(ks + (size_t)pos * 64 + d8 * 8);
                        const float kf[8] = {bflo(w.x), bfhi(w.x), bflo(w.y), bfhi(w.y), bflo(w.z), bfhi(w.z), bflo(w.w), bfhi(w.w)};
#pragma unroll
                        for (int r = 0; r < 4; ++r) { const f32x4 qa = *(const LAS f32x4*)(qr + r * 64 + d8 * 8), qb = *(const LAS f32x4*)(qr + r * 64 + d8 * 8 + 4);
                            s[r] += qa.x * kf[0] + qa.y * kf[1] + qa.z * kf[2] + qa.w * kf[3] + qb.x * kf[4] + qb.y * kf[5] + qb.z * kf[6] + qb.w * kf[7]; } }
#pragma unroll
                    for (int r = 0; r < 4; ++r) { s[r] *= QSCALE; mx[r] = fmaxf(mx[r], s[r]); } }
                *(LAS f32x4*)(sc + (k * 64 + lane) * 4) = (f32x4){s[0], s[1], s[2], s[3]}; }
            float l[4] = {0.f, 0.f, 0.f, 0.f};
#pragma unroll
            for (int r = 0; r < 4; ++r) mx[r] = wave_max(mx[r], lane);
            LDS_WAIT();
#pragma unroll 1
            for (int k = 0; k < NSEL; ++k) { const int pos = sel[k] * 64 + lane; const bool ok = pos <= t; f32x4 s = *(const LAS f32x4*)(sc + (k * 64 + lane) * 4);
#pragma unroll
                for (int r = 0; r < 4; ++r) { s[r] = ok ? __expf(s[r] - mx[r]) : 0.f; l[r] += s[r]; }
                *(LAS f32x4*)(sc + (k * 64 + lane) * 4) = s; }
#pragma unroll
            for (int r = 0; r < 4; ++r) l[r] = 1.f / wave_sum(l[r], lane);
            LDS_WAIT();
#pragma unroll 1
            for (int k = 0; k < NSEL; ++k) { const int p0 = sel[k] * 64; if (p0 > t) continue;
#pragma unroll 4
                for (int i = 0; i < 64; ++i) { const int pos = p0 + i; if (pos > t) break; const float v = bf2f(vs[(size_t)pos * 64 + lane]); const f32x4 p = *(const LAS f32x4*)(sc + (k * 64 + i) * 4);
#pragma unroll
                    for (int r = 0; r < 4; ++r) os[r] += p[r] * v; } }
#pragma unroll
            for (int r = 0; r < 4; ++r) os[r] *= l[r];
            LDS_WAIT();
        }
        {   const bf16_t* kw = KW + (size_t)bg * SEQ * 64; const bf16_t* vw = VW + (size_t)bg * SEQ * 64;
            float mx[4] = {-3.0e38f, -3.0e38f, -3.0e38f, -3.0e38f};
#pragma unroll 1
            for (int c = 0; c < 8; ++c) { const int pos = t - 511 + c * 64 + lane; const bool ok = pos >= 0;
                float s[4] = {-1e30f, -1e30f, -1e30f, -1e30f};
                if (ok) { LAS float* qr = qr_; asm volatile("" : "+v"(qr));
#pragma unroll
                    for (int r = 0; r < 4; ++r) s[r] = 0.f;
#pragma unroll 2
                    for (int d8 = 0; d8 < 8; ++d8) { const u32x4 w = *(const u32x4*)(kw + (size_t)pos * 64 + d8 * 8);
                        const float kf[8] = {bflo(w.x), bfhi(w.x), bflo(w.y), bfhi(w.y), bflo(w.z), bfhi(w.z), bflo(w.w), bfhi(w.w)};
#pragma unroll
                        for (int r = 0; r < 4; ++r) { const f32x4 qa = *(const LAS f32x4*)(qr + r * 64 + d8 * 8), qb = *(const LAS f32x4*)(qr + r * 64 + d8 * 8 + 4);
                            s[r] += qa.x * kf[0] + qa.y * kf[1] + qa.z * kf[2] + qa.w * kf[3] + qb.x * kf[4] + qb.y * kf[5] + qb.z * kf[6] + qb.w * kf[7]; } }
#pragma unroll
                    for (int r = 0; r < 4; ++r) { s[r] *= QSCALE; mx[r] = fmaxf(mx[r], s[r]); } }
                *(LAS f32x4*)(sc + (c * 64 + lane) * 4) = (f32x4){s[0], s[1], s[2], s[3]}; }
            float l[4] = {0.f, 0.f, 0.f, 0.f};
#pragma unroll
            for (int r = 0; r < 4; ++r) mx[r] = wave_max(mx[r], lane);
            LDS_WAIT();
#pragma unroll 1
            for (int c = 0; c < 8; ++c) { const int pos = t - 511 + c * 64 + lane; const bool ok = pos >= 0; f32x4 s = *(const LAS f32x4*)(sc + (c * 64 + lane) * 4);
#pragma unroll
                for (int r = 0; r < 4; ++r) { s[r] = ok ? __expf(s[r] - mx[r]) : 0.f; l[r] += s[r]; }
                *(LAS f32x4*)(sc + (c * 64 + lane) * 4) = s; }
#pragma unroll
            for (int r = 0; r < 4; ++r) l[r] = 1.f / wave_sum(l[r], lane);
            LDS_WAIT();
#pragma unroll 4
            for (int i = (t >= 511 ? 0 : 511 - t); i < 512; ++i) { const int pos = t - 511 + i; const float v = bf2f(vw[(size_t)pos * 64 + lane]); const f32x4 p = *(const LAS f32x4*)(sc + i * 4);
#pragma unroll
                for (int r = 0; r < 4; ++r) ow[r] += p[r] * v; }
#pragma unroll
            for (int r = 0; r < 4; ++r) ow[r] *= l[r];
            LDS_WAIT();
        }
#pragma unroll
        for (int r = 0; r < 4; ++r) { const float gc = GT[(size_t)tok * 48 + 0 * 16 + g * 4 + r], gs = GT[(size_t)tok * 48 + 1 * 16 + g * 4 + r], gwv = GT[(size_t)tok * 48 + 2 * 16 + g * 4 + r];
            const float o = ((DBG_DROP & 1) ? 0.f : gc * oc[r]) + ((DBG_DROP & 2) ? 0.f : gs * os[r]) + ((DBG_DROP & 4) ? 0.f : gwv * ow[r]);
            ATT[(size_t)tok * DM + g * 256 + r * 64 + lane] = (bf16_t)f2bf(o); }
    }
}

DEVI void phase_swa_naive(Frame& F, const float* sinks) {
    F.refresh();
    unsigned char* ws = F.ws;
    const bf16_t* Q = (const bf16_t*)(ws + RA_Q); bf16_t* ATT = (bf16_t*)(ws + RA_ATT);
    const bf16_t* KS = (const bf16_t*)(ws + WS_KSH); const bf16_t* VS = (const bf16_t*)(ws + WS_VSH);
    LAS float* sc = (LAS float*)(F.lds + F.wave * 16384);
    LAS float* qs_ = (LAS float*)(F.lds + LDS_X + F.wave * 2048);
    const int lane = F.lane;
    const int gw = F.vcu * NWAVES + F.wave, NGW = F.G * NWAVES;
    for (int u = gw; u < MTOK * B_G; u += NGW) {
        const int bg = u / SEQ, t = u % SEQ, b = bg / B_G, g = bg % B_G; const int tok = b * SEQ + t;
        { const u32x4 w = *(const u32x4*)(Q + (size_t)tok * DM + g * 512 + lane * 8);
          const float x[8] = {bflo(w.x), bfhi(w.x), bflo(w.y), bfhi(w.y), bflo(w.z), bfhi(w.z), bflo(w.w), bfhi(w.w)};
#pragma unroll
          for (int i = 0; i < 8; ++i) qs_[lane * 8 + i] = x[i];
          LDS_WAIT(); }
        const bf16_t* kp = KS + (size_t)bg * SEQ * 64; const bf16_t* vp = VS + (size_t)bg * SEQ * 64;
        float mx[8], l[8], o[8];
#pragma unroll
        for (int r = 0; r < 8; ++r) { mx[r] = sinks[g * 8 + r]; l[r] = 0.f; o[r] = 0.f; }
#pragma unroll 1
        for (int c = 0; c < 2; ++c) { const int pos = t - 127 + c * 64 + lane; const bool ok = pos >= 0;
            float s[8];
#pragma unroll
            for (int r = 0; r < 8; ++r) s[r] = -1e30f;
            if (ok) { LAS float* qs = qs_; asm volatile("" : "+v"(qs));
#pragma unroll
                for (int r = 0; r < 8; ++r) s[r] = 0.f;
#pragma unroll 1
                for (int d8 = 0; d8 < 8; ++d8) { const u32x4 w = *(const u32x4*)(kp + (size_t)pos * 64 + d8 * 8);
                    const float kf[8] = {bflo(w.x), bfhi(w.x), bflo(w.y), bfhi(w.y), bflo(w.z), bfhi(w.z), bflo(w.w), bfhi(w.w)};
#pragma unroll
                    for (int r = 0; r < 8; ++r) { const f32x4 qa = *(const LAS f32x4*)(qs + r * 64 + d8 * 8), qb = *(const LAS f32x4*)(qs + r * 64 + d8 * 8 + 4);
                        s[r] += qa.x * kf[0] + qa.y * kf[1] + qa.z * kf[2] + qa.w * kf[3] + qb.x * kf[4] + qb.y * kf[5] + qb.z * kf[6] + qb.w * kf[7]; } }
#pragma unroll
                for (int r = 0; r < 8; ++r) { s[r] *= QSCALE; mx[r] = fmaxf(mx[r], s[r]); } }
            *(LAS f32x4*)(sc + (c * 64 + lane) * 8) = (f32x4){s[0], s[1], s[2], s[3]}; *(LAS f32x4*)(sc + (c * 64 + lane) * 8 + 4) = (f32x4){s[4], s[5], s[6], s[7]}; }
#pragma unroll
        for (int r = 0; r < 8; ++r) mx[r] = wave_max(mx[r], lane);
        LDS_WAIT();
#pragma unroll
        for (int c = 0; c < 2; ++c) { const int pos = t - 127 + c * 64 + lane; const bool ok = pos >= 0;
            f32x4 s0 = *(const LAS f32x4*)(sc + (c * 64 + lane) * 8), s1 = *(const LAS f32x4*)(sc + (c * 64 + lane) * 8 + 4);
#pragma unroll
            for (int r = 0; r < 4; ++r) { s0[r] = ok ? __expf(s0[r] - mx[r]) : 0.f; l[r] += s0[r]; s1[r] = ok ? __expf(s1[r] - mx[r + 4]) : 0.f; l[r + 4] += s1[r]; }
            *(LAS f32x4*)(sc + (c * 64 + lane) * 8) = s0; *(LAS f32x4*)(sc + (c * 64 + lane) * 8 + 4) = s1; }
#pragma unroll
        for (int r = 0; r < 8; ++r) l[r] = 1.f / (wave_sum(l[r], lane) + __expf(sinks[g * 8 + r] - mx[r]));
        LDS_WAIT();
#pragma unroll 4
        for (int i = (t >= 127 ? 0 : 127 - t); i < 128; ++i) { const int pos = t - 127 + i; const float v = bf2f(vp[(size_t)pos * 64 + lane]);
            const f32x4 p0 = *(const LAS f32x4*)(sc + i * 8), p1 = *(const LAS f32x4*)(sc + i * 8 + 4);
#pragma unroll
            for (int r = 0; r < 4; ++r) { o[r] += p0[r] * v; o[r + 4] += p1[r] * v; } }
#pragma unroll
        for (int r = 0; r < 8; ++r) ATT[(size_t)tok * DM + g * 512 + r * 64 + lane] = (bf16_t)f2bf(o[r] * l[r]);
        LDS_WAIT();
    }
}

namespace fa {
typedef short v4i16_t __attribute__((ext_vector_type(4)));
constexpr float CEXP = 0.125f * 1.4426950408889634f;
constexpr float NEGINF = -__builtin_huge_valf();
constexpr int VLD = 160;
constexpr int KVB = 8192 + 64 * VLD;
constexpr int L_KV = 0;
constexpr int L_IMP = 2 * KVB;
constexpr int IMP_LD = 264;
constexpr int OS_LD = 65;
constexpr int L_Q = L_IMP + 64 * IMP_LD * 4;
constexpr int L_ML = L_Q + 32768;
constexpr int L_MASK = L_ML + 2048;
constexpr int L_LIST = L_MASK + 2048;
constexpr int L_TOK = L_LIST + 1056;
constexpr int L_END = L_TOK + 2048;
static_assert(256 * OS_LD * 4 <= 64 * IMP_LD * 4, "accumulator fits the importance table");
static_assert(L_END <= MISC_OFF, "attention LDS map");

struct Stage { u32x4 k, v; };
template <bool WITHV> DEVI void stage_load(Stage& s, const bf16_t* K, const bf16_t* V, int tid) { s.k = *(const u32x4*)((const char*)K + tid * 16); if (WITHV) s.v = *(const u32x4*)((const char*)V + tid * 16); }
template <bool WITHV> DEVI void stage_write(const Stage& s, LAS unsigned char* buf, int tid) {
    const int r = tid >> 3, c = tid & 7;
    *(LAS u32x4*)(buf + r * 128 + ((c ^ (r & 7)) << 4)) = s.k;
    if (WITHV) *(LAS u32x4*)(buf + 8192 + r * VLD + (c << 4)) = s.v;
}
DEVI float max_quads(float x) {
    auto a = __builtin_amdgcn_permlane16_swap(__float_as_uint(x), __float_as_uint(x), false, false); x = fmaxf(__uint_as_float(a[0]), __uint_as_float(a[1]));
    auto b = __builtin_amdgcn_permlane32_swap(__float_as_uint(x), __float_as_uint(x), false, false); return fmaxf(__uint_as_float(b[0]), __uint_as_float(b[1]));
}
DEVI float sum_quads(float x) {
    auto a = __builtin_amdgcn_permlane16_swap(__float_as_uint(x), __float_as_uint(x), false, false); x = __uint_as_float(a[0]) + __uint_as_float(a[1]);
    auto b = __builtin_amdgcn_permlane32_swap(__float_as_uint(x), __float_as_uint(x), false, false); return __uint_as_float(b[0]) + __uint_as_float(b[1]);
}
template <int CTRL> DEVI float dppf(float v) { return __int_as_float(__builtin_amdgcn_update_dpp(0, __float_as_int(v), CTRL, 0xF, 0xF, false)); }
template <int CTRL> DEVI int dppi(int v) { return __builtin_amdgcn_update_dpp(0, v, CTRL, 0xF, 0xF, false); }
DEVI float bperm(float v, int src_lane) { return __builtin_bit_cast(float, __builtin_amdgcn_ds_bpermute(src_lane << 2, __builtin_bit_cast(int, v))); }
#define DPP_X1 0xB1
#define DPP_X2 0x4E
#define DPP_HM 0x141

DEVI void qk_slot(LAS const unsigned char* kb, const bf16x8 q0, const bf16x8 q1, int lane, f32x4 (&s)[4]) {
    const int l15 = lane & 15, quad = lane >> 4;
    LAS const unsigned char* p0 = kb + l15 * 128 + (((quad) ^ (l15 & 7)) << 4);
    LAS const unsigned char* p1 = kb + l15 * 128 + (((4 + quad) ^ (l15 & 7)) << 4);
#pragma unroll
    for (int kg = 0; kg < 4; ++kg) {
        const bf16x8 a0 = *(LAS const bf16x8*)(p0 + kg * 2048), a1 = *(LAS const bf16x8*)(p1 + kg * 2048);
        f32x4 z = {0.f, 0.f, 0.f, 0.f};
        z = __builtin_amdgcn_mfma_f32_16x16x32_bf16(a0, q0, z, 0, 0, 0);
        s[kg] = __builtin_amdgcn_mfma_f32_16x16x32_bf16(a1, q1, z, 0, 0, 0);
    }
}
DEVI float mask_max(f32x4 (&s)[4], int lo, int hi, int quad) {
    float mx = NEGINF; const int loq = lo - 4 * quad, hiq = hi - 4 * quad;
#pragma unroll
    for (int kg = 0; kg < 4; ++kg)
#pragma unroll
        for (int i = 0; i < 4; ++i) { const bool ok = (16 * kg + i >= loq) & (16 * kg + i <= hiq); s[kg][i] = ok ? s[kg][i] : NEGINF; mx = fmaxf(mx, s[kg][i]); }
    return max_quads(mx);
}
DEVI bf16x8 pack_p(const f32x4 a, const f32x4 b) { u32x4 w; w.x = pg8::cvt_pk_bf16(a[0], a[1]); w.y = pg8::cvt_pk_bf16(a[2], a[3]); w.z = pg8::cvt_pk_bf16(b[0], b[1]); w.w = pg8::cvt_pk_bf16(b[2], b[3]); return __builtin_bit_cast(bf16x8, w); }
DEVI void pv_slot(LAS const unsigned char* vb, const bf16x8 (&pb)[2], f32x4 (&o)[4], int lane) {
    const int i = lane & 15, quad = lane >> 4;
    LAS const unsigned char* a0 = vb + (4 * quad + (i >> 2)) * VLD + ((i & 3) << 3);
#pragma unroll
    for (int ks2 = 0; ks2 < 2; ++ks2) {
#pragma unroll
        for (int dg = 0; dg < 4; ++dg) {
            const v4i16_t t0 = __builtin_amdgcn_ds_read_tr16_b64_v4i16((LAS v4i16_t*)(a0 + (32 * ks2) * VLD + 32 * dg));
            const v4i16_t t1 = __builtin_amdgcn_ds_read_tr16_b64_v4i16((LAS v4i16_t*)(a0 + (32 * ks2 + 16) * VLD + 32 * dg));
            const bf16x8 a = {t0[0], t0[1], t0[2], t0[3], t1[0], t1[1], t1[2], t1[3]};
            o[dg] = __builtin_amdgcn_mfma_f32_16x16x32_bf16(a, pb[ks2], o[dg], 0, 0, 0);
        }
    }
}
template <bool PV> DEVI void online_step(LAS const unsigned char* buf, const bf16x8 q0, const bf16x8 q1, int lo, int hi, float& m, float& l, f32x4 (&o)[4], int lane) {
    __builtin_amdgcn_sched_barrier(0);
    f32x4 s[4]; qk_slot(buf, q0, q1, lane, s);
    __builtin_amdgcn_sched_barrier(0);
    const int quad = lane >> 4;
    float mx;
    if (__builtin_amdgcn_ballot_w64((lo > 0) | (hi < 63)) != 0ull) mx = mask_max(s, lo, hi, quad);
    else { float a = fmaxf(fmaxf(s[0][0], s[0][1]), fmaxf(s[0][2], s[0][3])), b = fmaxf(fmaxf(s[1][0], s[1][1]), fmaxf(s[1][2], s[1][3]));
           a = fmaxf(a, fmaxf(fmaxf(s[2][0], s[2][1]), fmaxf(s[2][2], s[2][3]))); b = fmaxf(b, fmaxf(fmaxf(s[3][0], s[3][1]), fmaxf(s[3][2], s[3][3]))); mx = max_quads(fmaxf(a, b)); }
    const float mnew = fmaxf(m, mx);
    const float msafe = (mnew == NEGINF) ? 0.f : mnew;
    const float alpha = __builtin_amdgcn_exp2f((m - msafe) * CEXP);
    const float mc = -msafe * CEXP;
    float ps = 0.f;
#pragma unroll
    for (int kg = 0; kg < 4; ++kg)
#pragma unroll
        for (int i = 0; i < 4; ++i) { s[kg][i] = __builtin_amdgcn_exp2f(__builtin_fmaf(s[kg][i], CEXP, mc)); ps += s[kg][i]; }
    l = l * alpha + ps; m = mnew;
    if (PV) {
        if (__builtin_amdgcn_ballot_w64(alpha != 1.f) != 0ull) {
#pragma unroll
            for (int dg = 0; dg < 4; ++dg) o[dg] = o[dg] * alpha;
        }
        bf16x8 pb[2]; pb[0] = pack_p(s[0], s[1]); pb[1] = pack_p(s[2], s[3]);
        pv_slot(buf + 8192, pb, o, lane);
    }
    __builtin_amdgcn_sched_barrier(0);
}
template <bool PV> DEVI void fixed_step(LAS const unsigned char* buf, const bf16x8 q0, const bf16x8 q1, int lo, int hi, float mc, float& l, f32x4 (&o)[4], int lane) {
    __builtin_amdgcn_sched_barrier(0);
    f32x4 s[4]; qk_slot(buf, q0, q1, lane, s);
    __builtin_amdgcn_sched_barrier(0);
    const int quad = lane >> 4;
    float ps = 0.f;
    if (__builtin_amdgcn_ballot_w64((lo > 0) | (hi < 63)) != 0ull) { const int loq = lo - 4 * quad, hiq = hi - 4 * quad;
#pragma unroll
        for (int kg = 0; kg < 4; ++kg)
#pragma unroll
            for (int i = 0; i < 4; ++i) { const bool ok = (16 * kg + i >= loq) & (16 * kg + i <= hiq); s[kg][i] = ok ? __builtin_amdgcn_exp2f(__builtin_fmaf(s[kg][i], CEXP, mc)) : 0.f; ps += s[kg][i]; }
    } else {
#pragma unroll
        for (int kg = 0; kg < 4; ++kg)
#pragma unroll
            for (int i = 0; i < 4; ++i) { s[kg][i] = __builtin_amdgcn_exp2f(__builtin_fmaf(s[kg][i], CEXP, mc)); ps += s[kg][i]; }
    }
    l += ps;
    if (PV) { bf16x8 pb[2]; pb[0] = pack_p(s[0], s[1]); pb[1] = pack_p(s[2], s[3]); pv_slot(buf + 8192, pb, o, lane); }
    __builtin_amdgcn_sched_barrier(0);
}
DEVI void load_q(const bf16_t* Q, size_t tok, int hcol, int quad, bf16x8 (&qf)[2]) {
    const bf16_t* p = Q + tok * DM + hcol + quad * 8;
    qf[0] = *(const bf16x8*)p; qf[1] = *(const bf16x8*)(p + 32);
}
DEVI bf16x8 rope_frag(const bf16x8 q, const float* csrow, int quad, int lane) {
    const u32x4 w = __builtin_bit_cast(u32x4, q); u32x4 pw;
#pragma unroll
    for (int i = 0; i < 4; ++i) pw[i] = (unsigned)shxi((int)w[i], 16, lane);
    if (quad >= 2) return q;
    const f32x4 c0 = *(const f32x4*)csrow, c1 = *(const f32x4*)(csrow + 4), s0 = *(const f32x4*)(csrow + 8), s1 = *(const f32x4*)(csrow + 12);
    const float sg = quad == 0 ? -1.f : 1.f;
    float x[8], xp[8];
#pragma unroll
    for (int i = 0; i < 4; ++i) { x[2 * i] = bflo(w[i]); x[2 * i + 1] = bfhi(w[i]); xp[2 * i] = bflo(pw[i]); xp[2 * i + 1] = bfhi(pw[i]); }
    const float cc[8] = {c0[0], c0[1], c0[2], c0[3], c1[0], c1[1], c1[2], c1[3]}, ss[8] = {s0[0], s0[1], s0[2], s0[3], s1[0], s1[1], s1[2], s1[3]};
    u32x4 o;
#pragma unroll
    for (int i = 0; i < 4; ++i) o[i] = pg8::cvt_pk_bf16(x[2 * i] * cc[2 * i] + sg * xp[2 * i] * ss[2 * i], x[2 * i + 1] * cc[2 * i + 1] + sg * xp[2 * i + 1] * ss[2 * i + 1]);
    return __builtin_bit_cast(bf16x8, o);
}

struct KFr { bf16x8 k[4][2]; };
struct VFr { bf16x8 v[4][2]; };
constexpr float LSCALE = 1048576.f;
struct Raw8 { u32x4 k[4]; u32x4 v[4]; };
template <int OFF> DEVI void gld16(u32x4& d, const void* p) { asm volatile("global_load_dwordx4 %0, %1, off offset:%2" : "=v"(d) : "v"(p), "n"(OFF) : "memory"); }
DEVI void sel_load8(Raw8& r, const unsigned char* K8, const unsigned char* V8, int j, int lane) {
    const int l15 = lane & 15, quad = lane >> 4;
    const unsigned char* pk = K8 + ((size_t)(64 * j + l15)) * 64 + 16 * quad;
    const unsigned char* pv = V8 + (size_t)j * 4096 + l15 * 64 + 16 * quad;
    gld16<0>(r.k[0], pk); gld16<1024>(r.k[1], pk); gld16<2048>(r.k[2], pk); gld16<3072>(r.k[3], pk);
    gld16<0>(r.v[0], pv); gld16<1024>(r.v[1], pv); gld16<2048>(r.v[2], pv); gld16<3072>(r.v[3], pv);
}
template <int N> DEVI void sel_wait8(Raw8& r) {
    asm volatile("s_waitcnt vmcnt(%8)" : "+v"(r.k[0]), "+v"(r.k[1]), "+v"(r.k[2]), "+v"(r.k[3]), "+v"(r.v[0]), "+v"(r.v[1]), "+v"(r.v[2]), "+v"(r.v[3]) : "n"(N) : "memory");
    __builtin_amdgcn_sched_barrier(0);
}
typedef float f32x2v __attribute__((ext_vector_type(2)));
DEVI bf16x8 fp8x8_bf16(unsigned w0, unsigned w1) {
    const f32x2v a = __builtin_amdgcn_cvt_pk_f32_fp8((int)w0, false), b = __builtin_amdgcn_cvt_pk_f32_fp8((int)w0, true), c = __builtin_amdgcn_cvt_pk_f32_fp8((int)w1, false), d = __builtin_amdgcn_cvt_pk_f32_fp8((int)w1, true);
    u32x4 o;
    o[0] = __builtin_amdgcn_perm(__float_as_uint(a[1]), __float_as_uint(a[0]), 0x07060302u); o[1] = __builtin_amdgcn_perm(__float_as_uint(b[1]), __float_as_uint(b[0]), 0x07060302u);
    o[2] = __builtin_amdgcn_perm(__float_as_uint(c[1]), __float_as_uint(c[0]), 0x07060302u); o[3] = __builtin_amdgcn_perm(__float_as_uint(d[1]), __float_as_uint(d[0]), 0x07060302u);
    return __builtin_bit_cast(bf16x8, o);
}
DEVI void sel_expand(const Raw8& r, KFr& f, VFr& g) {
#pragma unroll
    for (int i = 0; i < 4; ++i) { f.k[i][0] = fp8x8_bf16(r.k[i][0], r.k[i][1]); f.k[i][1] = fp8x8_bf16(r.k[i][2], r.k[i][3]); g.v[i][0] = fp8x8_bf16(r.v[i][0], r.v[i][1]); g.v[i][1] = fp8x8_bf16(r.v[i][2], r.v[i][3]); }
}
template <bool PASS2> DEVI void sel_block(const KFr& f, const VFr& fv, int j, bool active, int cur, LAS const unsigned* smask, LAS const unsigned char* Ql, LAS float* mrow, LAS int* lrow, LAS int* Os, float lg2k, float lratio, LAS int* tlist, int lane) {
    const int l15 = lane & 15, quad = lane >> 4, mem = l15 >> 2;
    const bool forced = (j == 0) || (j >= cur - 1);
    int cnt = 0;
    if (active) {
        if (forced) cnt = 64;
        else { const unsigned lo = (unsigned)__builtin_amdgcn_readfirstlane((int)smask[2 * j]), hi = (unsigned)__builtin_amdgcn_readfirstlane((int)smask[2 * j + 1]);
            const unsigned long long mk = ((unsigned long long)hi << 32) | lo;
            cnt = __builtin_popcountll(mk);
            const bool mine = (mk >> lane) & 1ull; const int rank = __builtin_popcountll(mk & ((1ull << lane) - 1ull));
            if (mine) tlist[rank] = lane;
            LDS_WAIT(); }
    }
    const int ngroups = (cnt + 3) >> 2;
    const bool diag = (j == cur);
#pragma unroll 1
    for (int gi = 0; gi < ngroups; ++gi) {
        const int slot = 4 * gi + mem;
        const bool valid = slot < cnt;
        int mt = forced ? slot : tlist[slot];
        mt = valid ? mt : 0;
        const int row = mt * 4 + (l15 & 3);
        const bf16x8 q0 = *(LAS const bf16x8*)(Ql + row * 128 + (((2 * quad) ^ (row & 7)) << 4));
        const bf16x8 q1 = *(LAS const bf16x8*)(Ql + row * 128 + (((2 * quad + 1) ^ (row & 7)) << 4));
        f32x4 sc[4];
#pragma unroll
        for (int kg = 0; kg < 4; ++kg) { f32x4 z = {0.f, 0.f, 0.f, 0.f}; z = __builtin_amdgcn_mfma_f32_16x16x32_bf16(f.k[kg][0], q0, z, 0, 0, 0); sc[kg] = __builtin_amdgcn_mfma_f32_16x16x32_bf16(f.k[kg][1], q1, z, 0, 0, 0); }
        if (!PASS2) {
            float mx;
            if (diag) mx = mask_max(sc, 0, mt, quad);
            else { float a = fmaxf(fmaxf(sc[0][0], sc[0][1]), fmaxf(sc[0][2], sc[0][3])), b = fmaxf(fmaxf(sc[1][0], sc[1][1]), fmaxf(sc[1][2], sc[1][3]));
                   a = fmaxf(a, fmaxf(fmaxf(sc[2][0], sc[2][1]), fmaxf(sc[2][2], sc[2][3]))); b = fmaxf(b, fmaxf(fmaxf(sc[3][0], sc[3][1]), fmaxf(sc[3][2], sc[3][3]))); mx = max_quads(fmaxf(a, b)); }
            if (quad == 0 && valid) __hip_atomic_fetch_max(mrow + row, mx, __ATOMIC_RELAXED, __HIP_MEMORY_SCOPE_WORKGROUP);
        } else {
            const float mc = lg2k - mrow[row] * CEXP;
            float ps = 0.f;
            if (diag) { const int hiq = mt - 4 * quad;
#pragma unroll
                for (int kg = 0; kg < 4; ++kg)
#pragma unroll
                    for (int i = 0; i < 4; ++i) { sc[kg][i] = (16 * kg + i <= hiq) ? __builtin_amdgcn_exp2f(__builtin_fmaf(sc[kg][i], CEXP, mc)) : 0.f; ps += sc[kg][i]; }
            } else {
#pragma unroll
                for (int kg = 0; kg < 4; ++kg)
#pragma unroll
                    for (int i = 0; i < 4; ++i) { sc[kg][i] = __builtin_amdgcn_exp2f(__builtin_fmaf(sc[kg][i], CEXP, mc)); ps += sc[kg][i]; }
            }
            ps = sum_quads(ps);
            if (quad == 0 && valid) __hip_atomic_fetch_add(lrow + row, (int)(ps * lratio), __ATOMIC_RELAXED, __HIP_MEMORY_SCOPE_WORKGROUP);
            bf16x8 pb[2]; pb[0] = pack_p(sc[0], sc[1]); pb[1] = pack_p(sc[2], sc[3]);
            LAS int* orow = Os + row * OS_LD + 4 * quad;
#pragma unroll
            for (int dh = 0; dh < 2; ++dh) {
                f32x4 o[2];
#pragma unroll
                for (int d2 = 0; d2 < 2; ++d2) { const int dg = dh * 2 + d2; f32x4 z = {0.f, 0.f, 0.f, 0.f}; z = __builtin_amdgcn_mfma_f32_16x16x32_bf16(fv.v[dg][0], pb[0], z, 0, 0, 0); o[d2] = __builtin_amdgcn_mfma_f32_16x16x32_bf16(fv.v[dg][1], pb[1], z, 0, 0, 0); }
                if (valid) {
#pragma unroll
                    for (int d2 = 0; d2 < 2; ++d2)
#pragma unroll
                        for (int c = 0; c < 4; ++c) __hip_atomic_fetch_add(orow + 16 * (dh * 2 + d2) + c, (int)o[d2][c], __ATOMIC_RELAXED, __HIP_MEMORY_SCOPE_WORKGROUP);
                }
                __builtin_amdgcn_sched_barrier(0);
            }
        }
    }
}
#define BL(i) __builtin_amdgcn_readfirstlane(blist[(i) < nb ? (i) : nb - 1])
DEVI void sel_pass2(const unsigned char* K8, const unsigned char* V8, int nb, int cur, int wave, LAS const int* blist, LAS const unsigned* smask, LAS const unsigned char* Ql, LAS float* mrow, LAS int* lrow, LAS int* Os, float lg2k, float lratio, LAS int* tlist, int lane) {
    if (wave >= nb) return;
    Raw8 ra, rb; KFr kf; VFr vf;
    asm volatile("s_waitcnt vmcnt(0)" ::: "memory");
    sel_load8(ra, K8, V8, BL(wave), lane);
#pragma unroll 1
    for (int bi = wave; bi < nb; bi += 16) {
        sel_load8(rb, K8, V8, BL(bi + 8), lane); sel_wait8<8>(ra);
        sel_expand(ra, kf, vf);
        sel_block<true>(kf, vf, BL(bi), true, cur, smask, Ql, mrow, lrow, Os, lg2k, lratio, tlist, lane);
        sel_load8(ra, K8, V8, BL(bi + 16), lane); sel_wait8<8>(rb);
        sel_expand(rb, kf, vf);
        sel_block<true>(kf, vf, BL(bi + 8), bi + 8 < nb, cur, smask, Ql, mrow, lrow, Os, lg2k, lratio, tlist, lane);
    }
    asm volatile("s_waitcnt vmcnt(0)" ::: "memory");
}
#undef BL
}


DEVI void phase_vs_transpose(Frame& F, int l) {
    F.refresh();
    unsigned char* ws = F.ws;
    const bf16_t* VS = (const bf16_t*)(ws + RA_VS); unsigned char* VT = ws + RA_VST; unsigned char* K8 = ws + RA_K8; const bf16_t* KSG = (const bf16_t*)(ws + RA_KS);
    LAS unsigned char* T = F.lds + F.wave * 9216;
    const int lane = F.lane, rr = lane >> 3, c = lane & 7, i16 = lane & 15, grp = lane >> 4;
    for (int it = ((int)blockIdx.x - 64) * NWAVES + F.wave; it < 2048; it += 192 * NWAVES) {
        const int bg = it >> 8, tile = it & 255;
        const bf16_t* vsrc = VS + ((size_t)bg * SEQ + tile * 64) * 64; const bf16_t* ksrc = KSG + ((size_t)bg * SEQ + tile * 64) * 64;
        const bf16_t* wsrc = (const bf16_t*)(ws + RA_KW) + ((size_t)bg * SEQ + tile * 64) * 64;
        unsigned char* kdst = K8 + ((size_t)bg * SEQ + tile * 64) * 64;
        u32x4 v[8], k[8], kw[8];
#pragma unroll
        for (int i = 0; i < 8; ++i) { v[i] = *(const u32x4*)(vsrc + (size_t)(8 * i + rr) * 64 + c * 8); k[i] = *(const u32x4*)(ksrc + (size_t)(8 * i + rr) * 64 + c * 8); kw[i] = *(const u32x4*)(wsrc + (size_t)(8 * i + rr) * 64 + c * 8); }
        float vmx = 0.f, kmx = 0.f, wmx = 0.f;
#pragma unroll
        for (int i = 0; i < 8; ++i) { float n2 = 0.f, w2 = 0.f;
            u32x2 k8; k8[0] = pack_fp8x4(bflo(k[i][0]), bfhi(k[i][0]), bflo(k[i][1]), bfhi(k[i][1])); k8[1] = pack_fp8x4(bflo(k[i][2]), bfhi(k[i][2]), bflo(k[i][3]), bfhi(k[i][3]));
            *(u32x2*)(kdst + (size_t)(8 * i + rr) * 64 + c * 8) = k8;
#pragma unroll
            for (int e = 0; e < 2; ++e) { const fa::f32x2v a = __builtin_amdgcn_cvt_pk_f32_fp8((int)k8[e], false), b2 = __builtin_amdgcn_cvt_pk_f32_fp8((int)k8[e], true); n2 += a[0] * a[0] + a[1] * a[1] + b2[0] * b2[0] + b2[1] * b2[1]; }
#pragma unroll
            for (int e = 0; e < 4; ++e) { const float a3 = bflo(kw[i][e]), b3 = bfhi(kw[i][e]); w2 += a3 * a3 + b3 * b3; }
            n2 += fa::dppf<DPP_X1>(n2); n2 += fa::dppf<DPP_X2>(n2); n2 += fa::dppf<DPP_HM>(n2);
            w2 += fa::dppf<DPP_X1>(w2); w2 += fa::dppf<DPP_X2>(w2); w2 += fa::dppf<DPP_HM>(w2);
            kmx = fmaxf(kmx, n2); wmx = fmaxf(wmx, w2);
            *(LAS u32x4*)(T + (8 * i + rr) * 144 + c * 16) = v[i]; }
        LDS_WAIT(); asm volatile("" ::: "memory");
        unsigned char* vdst = VT + ((size_t)bg * 256 + tile) * 4096;
#pragma unroll
        for (int dc = 0; dc < 4; ++dc) { u32x4 o;
#pragma unroll
            for (int n = 0; n < 4; ++n) { const int kg4 = n * 4 + grp;
                const fa::v4i16_t t = __builtin_amdgcn_ds_read_tr16_b64_v4i16((LAS fa::v4i16_t*)(T + (4 * kg4 + (i16 >> 2)) * 144 + (16 * dc + 4 * (i16 & 3)) * 2));
                const u32x2 tw = __builtin_bit_cast(u32x2, t);
                o[n] = pack_fp8x4(bflo(tw[0]), bfhi(tw[0]), bflo(tw[1]), bfhi(tw[1]));
                const fa::f32x2v a = __builtin_amdgcn_cvt_pk_f32_fp8((int)o[n], false), b2 = __builtin_amdgcn_cvt_pk_f32_fp8((int)o[n], true);
                vmx = fmaxf(vmx, fmaxf(fmaxf(fabsf(a[0]), fabsf(a[1])), fmaxf(fabsf(b2[0]), fabsf(b2[1])))); }
            *(u32x4*)(vdst + (16 * dc + i16) * 64 + 16 * grp) = o; }
        vmx = wave_max(vmx, lane); kmx = wave_max(kmx, lane); wmx = wave_max(wmx, lane);
        if (lane == 0) { atomicMax((unsigned*)(ws + WS_CTL) + CW_VMAX + l * 8 + bg, __float_as_uint(vmx)); atomicMax((unsigned*)(ws + WS_CTL) + CW_KMAX + l * 8 + bg, __float_as_uint(kmx));
            atomicMax((unsigned*)(ws + WS_CTL) + CW_KWMAX + l * 8 + bg, __float_as_uint(wmx)); }
        LDS_WAIT(); asm volatile("" ::: "memory");
    }
}

DEVI void phase_nsa_fast(Frame& F, int layer) {
    using namespace fa;
    F.refresh();
    unsigned char* ws = F.ws;
    const bf16_t* Q = (const bf16_t*)(ws + RA_Q); bf16_t* ATT = (bf16_t*)(ws + RA_ATT);
    const float* GT = (const float*)(ws + RA_GATE); const float* CS = (const float*)(ws + WS_CS);
    const int wave = F.wave;
    LAS unsigned char* kvb = F.lds + L_KV;
    LAS float* imp = (LAS float*)(F.lds + L_IMP);
    LAS unsigned* smask = (LAS unsigned*)(F.lds + L_MASK);
    LAS int* blist = (LAS int*)(F.lds + L_LIST);
    float kcmax2;
    {   const int bg0 = F.vcu >> 5; const bf16_t* kc0 = (const bf16_t*)(ws + RA_KC) + (size_t)bg0 * 1024 * 64;
        float mx = 0.f;
        for (int i = F.tid; i < 1024 * 8; i += NWAVES * 64) { const u32x4 w = *(const u32x4*)(kc0 + (size_t)i * 8); float n2 = 0.f;
#pragma unroll
            for (int e = 0; e < 4; ++e) { const float a = bflo(w[e]), b2 = bfhi(w[e]); n2 += a * a + b2 * b2; }
            n2 += dppf<DPP_X1>(n2); n2 += dppf<DPP_X2>(n2); n2 += dppf<DPP_HM>(n2);
            mx = fmaxf(mx, n2); }
        mx = wave_max(mx, F.lane);
        LAS float* red = (LAS float*)(F.lds + L_END);
        if (F.lane == 0) red[wave] = mx;
        __syncthreads();
        kcmax2 = fmaxf(fmaxf(fmaxf(red[0], red[1]), fmaxf(red[2], red[3])), fmaxf(fmaxf(red[4], red[5]), fmaxf(red[6], red[7])));
        __syncthreads(); }
#pragma unroll 1
    for (int ui = 0; ui < 8; ++ui) {
        int lane = F.lane; asm volatile("" : "+v"(lane));
        const int tid = wave * 64 + lane, quad = lane >> 4, l15 = lane & 15;
        int tile = (F.vcu & 31) + 32 * (ui >> 1); if (ui & 1) tile = 255 - tile;
        const int bg = F.vcu >> 5, b = bg >> 2, g = bg & 3, cur = tile, t0 = tile * 64;
        const bf16_t* KC = (const bf16_t*)(ws + RA_KC) + (size_t)bg * 1024 * 64; const bf16_t* VC = (const bf16_t*)(ws + RA_VC) + (size_t)bg * 1024 * 64;
        const bf16_t* KS = (const bf16_t*)(ws + RA_KS) + (size_t)bg * SEQ * 64; const bf16_t* VS = (const bf16_t*)(ws + RA_VS) + (size_t)bg * SEQ * 64;
        const bf16_t* KW = (const bf16_t*)(ws + RA_KW) + (size_t)bg * SEQ * 64; const bf16_t* VW = (const bf16_t*)(ws + RA_VW) + (size_t)bg * SEQ * 64;
        smask[tid] = 0u;
        int tl[2], tok[2]; bf16x8 qf[2][2];
#pragma unroll
        for (int s = 0; s < 2; ++s) { tl[s] = 8 * wave + 4 * s + (l15 >> 2); tok[s] = b * SEQ + t0 + tl[s]; load_q(Q, (size_t)tok[s], g * 256 + (l15 & 3) * 64, quad, qf[s]); }
        float gate[2][3];
#pragma unroll
        for (int s = 0; s < 2; ++s)
#pragma unroll
            for (int br = 0; br < 3; ++br) gate[s][br] = GT[(size_t)tok[s] * 48 + br * 16 + g * 4 + (l15 & 3)];
        const float vmax = fmaxf(__uint_as_float(__hip_atomic_load((const unsigned*)(ws + WS_CTL) + CW_VMAX + layer * 8 + bg, __ATOMIC_RELAXED, __HIP_MEMORY_SCOPE_AGENT)), 1e-30f);
        bf16x8 qr[2][2];
#pragma unroll
        for (int s = 0; s < 2; ++s) { qr[s][0] = rope_frag(qf[s][0], CS + (size_t)tok[s] * 16, quad, lane); qr[s][1] = qf[s][1]; }
        float qn2[2];
#pragma unroll
        for (int s = 0; s < 2; ++s) { float n2 = 0.f;
#pragma unroll
            for (int ks = 0; ks < 2; ++ks) { const u32x4 w = __builtin_bit_cast(u32x4, qf[s][ks]);
#pragma unroll
                for (int e = 0; e < 4; ++e) { const float a = bflo(w[e]), b2 = bfhi(w[e]); n2 += a * a + b2 * b2; } }
            qn2[s] = sum_quads(n2); }
        const float kwmax2 = __uint_as_float(__hip_atomic_load((const unsigned*)(ws + WS_CTL) + CW_KWMAX + layer * 8 + bg, __ATOMIC_RELAXED, __HIP_MEMORY_SCOPE_AGENT));
        f32x4 out[2][4];
#pragma unroll
        for (int s = 0; s < 2; ++s)
#pragma unroll
            for (int dg = 0; dg < 4; ++dg) out[s][dg] = (f32x4){0.f, 0.f, 0.f, 0.f};
        Stage st;
        const int ntile = (4 * cur + 3 + 63) >> 6;
        int nval[2];
#pragma unroll
        for (int s = 0; s < 2; ++s) { const int t = t0 + tl[s]; nval[s] = t >= 31 ? ((t - 31) >> 4) + 1 : 0; }
        float l[2] = {0.f, 0.f};
        const float mcc[2] = {-sqrtf(qn2[0] * kcmax2) * 1.0001f * CEXP, -sqrtf(qn2[1] * kcmax2) * 1.0001f * CEXP};
        {   stage_load<false>(st, KC, VC, tid); stage_write<false>(st, kvb, tid); __syncthreads();
#pragma unroll 1
            for (int i = 0; i < ntile; ++i) {
                LAS unsigned char* buf = kvb + (i & 1) * KVB;
                if (i + 1 < ntile) stage_load<false>(st, KC + (size_t)(i + 1) * 4096, VC, tid); else stage_load<true>(st, KC, VC, tid);
#pragma unroll
                for (int s = 0; s < 2; ++s) { f32x4 dummy[4]; fixed_step<false>(buf, qf[s][0], qf[s][1], 0, nval[s] - 64 * i - 1, mcc[s], l[s], dummy, lane); }
                if (i + 1 < ntile) stage_write<false>(st, kvb + ((i + 1) & 1) * KVB, tid);
                __syncthreads();
            }
        }
        float invl[2], msafe[2];
#pragma unroll
        for (int s = 0; s < 2; ++s) { const float lt = sum_quads(l[s]); invl[s] = lt > 0.f ? 1.f / lt : 0.f; msafe[s] = -mcc[s] * (1.f / CEXP); }
        const int jbw0 = cur >= 8 ? cur - 8 : 0;
        {   float gcv[2] = {gate[0][0], gate[1][0]};
            float carry[2] = {0.f, 0.f};
            stage_write<true>(st, kvb, tid); __syncthreads();
#pragma unroll 1
            for (int i = 0; i < ntile; ++i) {
                LAS unsigned char* buf = kvb + (i & 1) * KVB;
                if (i + 1 < ntile) stage_load<true>(st, KC + (size_t)(i + 1) * 4096, VC + (size_t)(i + 1) * 4096, tid); else stage_load<true>(st, KW + (size_t)jbw0 * 4096, VW + (size_t)jbw0 * 4096, tid);
#pragma unroll
                for (int s = 0; s < 2; ++s) {
                    __builtin_amdgcn_sched_barrier(0);
                    f32x4 sc[4]; qk_slot(buf, qf[s][0], qf[s][1], lane, sc);
                    __builtin_amdgcn_sched_barrier(0);
                    const int hiq = nval[s] - 64 * i - 1 - 4 * quad; const float mc2 = -msafe[s] * CEXP;
#pragma unroll
                    for (int kg = 0; kg < 4; ++kg)
#pragma unroll
                        for (int k = 0; k < 4; ++k) sc[kg][k] = (16 * kg + k <= hiq) ? __builtin_amdgcn_exp2f(__builtin_fmaf(sc[kg][k], CEXP, mc2)) * invl[s] : 0.f;
                    bf16x8 pb[2]; pb[0] = pack_p(sc[0] * gcv[s], sc[1] * gcv[s]); pb[1] = pack_p(sc[2] * gcv[s], sc[3] * gcv[s]);
#pragma unroll
                    for (int kg = 0; kg < 4; ++kg) {
                        float a = (sc[kg][0] + sc[kg][1]) + (sc[kg][2] + 0.5f * sc[kg][3]), bq = 0.5f * sc[kg][3];
                        a += dppf<DPP_X1>(a); a += dppf<DPP_X2>(a); bq += dppf<DPP_X1>(bq); bq += dppf<DPP_X2>(bq);
                        const float fromprev = bperm(bq, (lane - 16) & 63);
                        const float add = quad == 0 ? carry[s] : fromprev;
                        carry[s] = bperm(bq, (lane + 48) & 63);
                        if ((l15 & 3) == 0) imp[(8 * wave + 4 * s + (l15 >> 2)) * IMP_LD + 16 * i + 4 * kg + quad] = a + add;
                    }
                    __builtin_amdgcn_sched_barrier(0);
                    pv_slot(buf + 8192, pb, out[s], lane);
                    __builtin_amdgcn_sched_barrier(0);
                }
                if (i + 1 < ntile) stage_write<true>(st, kvb + ((i + 1) & 1) * KVB, tid);
                __syncthreads();
            }
        }
        {   const int tl8 = lane >> 3, chunk = lane & 7, trow = (8 * wave + tl8) * IMP_LD;
            const int ncand = cur - 2;
            const int wsel = ((8 * wave + tl8) >> 5), bsel = (8 * wave + tl8) & 31;
            if (ncand > 0 && ncand <= 13) {
#pragma unroll
                for (int i = 0; i < 2; ++i) { const int j = 8 * i + chunk; if (j >= 1 && j <= cur - 2) __hip_atomic_fetch_or(smask + j * 2 + wsel, 1u << bsel, __ATOMIC_RELAXED, __HIP_MEMORY_SCOPE_WORKGROUP); }
            } else if (ncand > 13) {
                unsigned lv[13];
#pragma unroll
                for (int k = 0; k < 13; ++k) lv[k] = 0u;
                const int imax = (cur - 2) >> 3;
#pragma unroll 1
                for (int i = 0; i <= imax; ++i) {
                    const int j = 8 * i + chunk;
                    unsigned x = (j >= 1 && j <= cur - 2) ? ((__float_as_uint(imp[trow + j]) & 0xFFFFFF00u) | (unsigned)(255 - j)) : 0u;
                    if (__builtin_amdgcn_ballot_w64(x > lv[12]) != 0ull) {
#pragma unroll
                        for (int k = 0; k < 13; ++k) { const unsigned hi_ = lv[k] > x ? lv[k] : x, lo_ = lv[k] > x ? x : lv[k]; lv[k] = hi_; x = lo_; }
                    }
                }
#pragma unroll 1
                for (int r = 0; r < 13; ++r) {
                    unsigned bv = lv[0];
                    { const unsigned ov = (unsigned)dppi<DPP_X1>((int)bv); bv = ov > bv ? ov : bv; }
                    { const unsigned ov = (unsigned)dppi<DPP_X2>((int)bv); bv = ov > bv ? ov : bv; }
                    { const unsigned ov = (unsigned)dppi<DPP_HM>((int)bv); bv = ov > bv ? ov : bv; }
                    if (lv[0] == bv && bv != 0u) {
#pragma unroll
                        for (int k = 0; k < 12; ++k) lv[k] = lv[k + 1];
                        lv[12] = 0u;
                    }
                    if (chunk == 0 && bv != 0u) __hip_atomic_fetch_or(smask + (255 - (int)(bv & 0xFFu)) * 2 + wsel, 1u << bsel, __ATOMIC_RELAXED, __HIP_MEMORY_SCOPE_WORKGROUP);
                }
            }
        }
        __syncthreads();
        if (wave == 0) {
            int base = 0;
#pragma unroll 1
            for (int r = 0; r < 4; ++r) { const int j = 64 * r + lane; const bool on = (j <= cur) && (j == 0 || j >= cur - 1 || (smask[j * 2] | smask[j * 2 + 1]) != 0u);
                const unsigned long long bal = __builtin_amdgcn_ballot_w64(on); const int pos = base + __builtin_popcountll(bal & ((1ull << lane) - 1ull));
                if (on) blist[pos] = j; base += __builtin_popcountll(bal); }
            if (lane == 0) blist[259] = base;
        }
        __syncthreads();
        LAS float* stashf = imp + wave * 2048 + lane;
#pragma unroll
        for (int s = 0; s < 2; ++s)
#pragma unroll
            for (int dg = 0; dg < 4; ++dg)
#pragma unroll
                for (int c = 0; c < 4; ++c) stashf[(s * 16 + dg * 4 + c) * 64] = out[s][dg][c];
        {   const int jb0 = jbw0, nb = cur - jb0 + 1;
            f32x4 ob[2][4]; float ll[2] = {0.f, 0.f};
            const float mcw[2] = {-sqrtf(qn2[0] * kwmax2) * 1.0001f * CEXP, -sqrtf(qn2[1] * kwmax2) * 1.0001f * CEXP};
#pragma unroll
            for (int s = 0; s < 2; ++s)
#pragma unroll
                for (int dg = 0; dg < 4; ++dg) ob[s][dg] = (f32x4){0.f, 0.f, 0.f, 0.f};
            stage_write<true>(st, kvb, tid); __syncthreads();
#pragma unroll 1
            for (int i = 0; i < nb; ++i) {
                LAS unsigned char* buf = kvb + (i & 1) * KVB;
                const int j = jb0 + i;
                if (i + 1 < nb) stage_load<true>(st, KW + (size_t)(j + 1) * 4096, VW + (size_t)(j + 1) * 4096, tid);
#pragma unroll
                for (int s = 0; s < 2; ++s) {
                    const int lo = (j == cur - 8) ? tl[s] + 1 : 0, hi = (j == cur) ? tl[s] : 63;
                    fixed_step<true>(buf, qr[s][0], qr[s][1], lo, hi, mcw[s], ll[s], ob[s], lane);
                }
                if (i + 1 < nb) stage_write<true>(st, kvb + ((i + 1) & 1) * KVB, tid);
                __syncthreads();
            }
#pragma unroll
            for (int s = 0; s < 2; ++s) { const float lt = sum_quads(ll[s]); const float gw = gate[s][2] * (lt > 0.f ? 1.f / lt : 0.f);
#pragma unroll
                for (int dg = 0; dg < 4; ++dg)
#pragma unroll
                    for (int c = 0; c < 4; ++c) out[s][dg][c] = stashf[(s * 16 + dg * 4 + c) * 64] + ob[s][dg][c] * gw; }
        }
        LAS unsigned* stashb = (LAS unsigned*)(F.lds + L_KV) + wave * 1024 + lane;
        LAS unsigned char* Ql = F.lds + L_Q;
        LAS float* mrow = (LAS float*)(F.lds + L_ML); LAS int* lrow = (LAS int*)(mrow + 256);
        LAS int* Os = (LAS int*)imp;
        const float oscale = 1048576.f / vmax;
#pragma unroll
        for (int s = 0; s < 2; ++s) {
#pragma unroll
            for (int dg = 0; dg < 4; ++dg) { stashb[((s * 4 + dg) * 2 + 0) * 64] = pg8::cvt_pk_bf16(out[s][dg][0], out[s][dg][1]); stashb[((s * 4 + dg) * 2 + 1) * 64] = pg8::cvt_pk_bf16(out[s][dg][2], out[s][dg][3]); }
            const int row = tl[s] * 4 + (l15 & 3);
            *(LAS bf16x8*)(Ql + row * 128 + ((quad ^ (row & 7)) << 4)) = qr[s][0];
            *(LAS bf16x8*)(Ql + row * 128 + (((4 + quad) ^ (row & 7)) << 4)) = qr[s][1];
        }
        __syncthreads();
        for (int i = lane; i < 32 * OS_LD; i += 64) Os[wave * 32 * OS_LD + i] = 0;
        if (lane < 32) lrow[wave * 32 + lane] = 0;
        {
            const float kmax2 = __uint_as_float(__hip_atomic_load((const unsigned*)(ws + WS_CTL) + CW_KMAX + layer * 8 + bg, __ATOMIC_RELAXED, __HIP_MEMORY_SCOPE_AGENT));
#pragma unroll
            for (int s = 0; s < 2; ++s) { float n2 = 0.f;
#pragma unroll
                for (int ks = 0; ks < 2; ++ks) { const u32x4 w = __builtin_bit_cast(u32x4, qr[s][ks]);
#pragma unroll
                    for (int e = 0; e < 4; ++e) { const float a = bflo(w[e]), b2 = bfhi(w[e]); n2 += a * a + b2 * b2; } }
                n2 = sum_quads(n2);
                if (quad == 0) mrow[tl[s] * 4 + (l15 & 3)] = sqrtf(n2 * kmax2) * 1.0001f; } }
        __syncthreads();
        {   const int nb = blist[259];
            int lane2 = lane; asm volatile("" : "+v"(lane2));
            const unsigned char* VT = ws + RA_VST + (size_t)bg * 256 * 4096; const unsigned char* K8 = ws + RA_K8 + (size_t)bg * SEQ * 64;
            LAS int* tlist = (LAS int*)(F.lds + L_TOK) + wave * 64;
            asm volatile("" : "+v"(lane2));
            sel_pass2(K8, VT, nb, cur, wave, blist, smask, Ql, mrow, lrow, Os, __builtin_amdgcn_logf(oscale), LSCALE / oscale, tlist, lane2);
            __syncthreads();
        }
        asm volatile("" : "+v"(tok[0]), "+v"(tok[1]), "+v"(tl[0]), "+v"(tl[1]));
        const float oinv = vmax * (1.f / 1048576.f);
#pragma unroll
        for (int s = 0; s < 2; ++s) { const int row = tl[s] * 4 + (l15 & 3); const float lt = (float)lrow[row] * (1.f / LSCALE);
            const float gs = gate[s][1] * (lt > 0.f ? 1.f / lt : 0.f) * oinv;
#pragma unroll
            for (int dg = 0; dg < 4; ++dg) { const unsigned w0 = stashb[((s * 4 + dg) * 2 + 0) * 64], w1 = stashb[((s * 4 + dg) * 2 + 1) * 64];
                LAS const int* orow = Os + row * OS_LD + 16 * dg + 4 * quad;
                const float r0 = bflo(w0) + (float)orow[0] * gs, r1 = bfhi(w0) + (float)orow[1] * gs, r2 = bflo(w1) + (float)orow[2] * gs, r3 = bfhi(w1) + (float)orow[3] * gs;
                u32x2 w; w.x = pg8::cvt_pk_bf16(r0, r1); w.y = pg8::cvt_pk_bf16(r2, r3);
                *(u32x2*)(ATT + (size_t)tok[s] * DM + g * 256 + (l15 & 3) * 64 + 16 * dg + 4 * quad) = w; } }
        __syncthreads();
    }
}

DEVI void phase_swa_fast(Frame& F, const float* sinks) {
    using namespace fa;
    F.refresh();
    unsigned char* ws = F.ws;
    const bf16_t* Q = (const bf16_t*)(ws + RA_Q); bf16_t* ATT = (bf16_t*)(ws + RA_ATT);
    const int tid = F.tid, lane = F.lane, wave = F.wave, quad = lane >> 4, l15 = lane & 15;
    LAS unsigned char* kvb = F.lds + L_KV;
#pragma unroll 1
    for (int ui = 0; ui < 8; ++ui) {
        const int bg = ui >> 1, b = bg >> 1, g = bg & 1, t0 = (F.vcu * 2 + (ui & 1)) * 32, cur = t0 >> 6;
        const bf16_t* KS = (const bf16_t*)(ws + WS_KSH) + (size_t)bg * SEQ * 64; const bf16_t* VS = (const bf16_t*)(ws + WS_VSH) + (size_t)bg * SEQ * 64;
        int tq[2]; size_t tok[2]; bf16x8 qf[2][2]; f32x4 o[2][4]; float mm[2], ll[2];
        const float sink_raw = sinks[g * 8 + (l15 & 7)] * 8.0f;
#pragma unroll
        for (int s = 0; s < 2; ++s) { tq[s] = t0 + 4 * wave + 2 * s + (l15 >> 3); tok[s] = (size_t)b * SEQ + tq[s]; load_q(Q, tok[s], g * 512 + (l15 & 7) * 64, quad, qf[s]);
            mm[s] = sink_raw; ll[s] = quad == 0 ? 1.f : 0.f;
#pragma unroll
            for (int dg = 0; dg < 4; ++dg) o[s][dg] = (f32x4){0.f, 0.f, 0.f, 0.f}; }
        const int jb0 = cur >= 2 ? cur - 2 : 0, nb = cur - jb0 + 1;
        Stage st; stage_load<true>(st, KS + (size_t)jb0 * 4096, VS + (size_t)jb0 * 4096, tid); stage_write<true>(st, kvb, tid); __syncthreads();
#pragma unroll 1
        for (int i = 0; i < nb; ++i) {
            LAS unsigned char* buf = kvb + (i & 1) * KVB;
            const int j = jb0 + i;
            if (i + 1 < nb) stage_load<true>(st, KS + (size_t)(j + 1) * 4096, VS + (size_t)(j + 1) * 4096, tid);
#pragma unroll
            for (int s = 0; s < 2; ++s) online_step<true>(buf, qf[s][0], qf[s][1], tq[s] - (SWA_WIN - 1) - 64 * j, tq[s] - 64 * j, mm[s], ll[s], o[s], lane);
            if (i + 1 < nb) stage_write<true>(st, kvb + ((i + 1) & 1) * KVB, tid);
            __syncthreads();
        }
#pragma unroll
        for (int s = 0; s < 2; ++s) { const float inv = 1.f / sum_quads(ll[s]);
#pragma unroll
            for (int dg = 0; dg < 4; ++dg) { u32x2 w; w.x = pg8::cvt_pk_bf16(o[s][dg][0] * inv, o[s][dg][1] * inv); w.y = pg8::cvt_pk_bf16(o[s][dg][2] * inv, o[s][dg][3] * inv);
                *(u32x2*)(ATT + tok[s] * DM + g * 512 + (l15 & 7) * 64 + 16 * dg + 4 * quad) = w; } }
    }
}

enum Kind { K_PRO = 0, K_NSA_IN, K_CMP_HID, K_CMP_OUT, K_NSA_ATT, K_SWA_IN, K_SWA_ATT, K_OUTPROJ, K_LN1, K_LN1R, K_FFN1, K_FFN2, K_LN2, K_SCATTER, K_MOE1, K_MOE2, K_LN2C, K_COUNT };
struct Args { const void* in[18]; float* out; unsigned char* ws; int ph_lo, ph_hi; };
struct PhaseEnt { int kind, layer; };
constexpr int NPH = 35;
static const PhaseEnt h_prog[NPH] = {
    {K_PRO, 0},
    {K_NSA_IN, 0}, {K_CMP_HID, 0}, {K_CMP_OUT, 0}, {K_NSA_ATT, 0}, {K_OUTPROJ, 0}, {K_LN1, 0}, {K_FFN1, 0}, {K_FFN2, 0}, {K_LN2, 0},
    {K_NSA_IN, 1}, {K_CMP_HID, 1}, {K_CMP_OUT, 1}, {K_NSA_ATT, 1}, {K_OUTPROJ, 1}, {K_LN1R, 1}, {K_SCATTER, 1}, {K_MOE1, 1}, {K_MOE2, 1}, {K_LN2C, 1},
    {K_SWA_IN, 2}, {K_SWA_ATT, 2}, {K_OUTPROJ, 2}, {K_LN1, 2}, {K_FFN1, 2}, {K_FFN2, 2}, {K_LN2, 2},
    {K_SWA_IN, 3}, {K_SWA_ATT, 3}, {K_OUTPROJ, 3}, {K_LN1R, 3}, {K_SCATTER, 3}, {K_MOE1, 3}, {K_MOE2, 3}, {K_LN2C, 3},
};

template <int KIND> DEVI void do_phase(Frame& F, int l) {
    unsigned char* ws = F.ws;
    unsigned* ctl = (unsigned*)(ws + WS_CTL);
    LAS unsigned char* ring = F.lds;
    const int bx = (int)blockIdx.x;
    if constexpr (KIND == K_PRO) { phase_prologue(F); }
    if constexpr (KIND == K_NSA_IN) { pg8::Gemm g{(const bf16_t*)(ws + WS_HB), DM, DM, DM}; pg8::StaticOrder S; S.init(MTOK / 256, A_INP / 256, F.G, bx, (const bf16_t*)(ws + WS_WINA) + (size_t)l * A_INP * DM);
        EpiNsaIn E{ws, (const float*)(ws + WS_CS)}; pg8::gemm_phase(ring, g, S, E, F.wave0); }
    if constexpr (KIND == K_CMP_HID) {
        const int kv = (bx >> 5) & 1;
        if (bx < 64) { pg8::Gemm g{(const bf16_t*)(ws + (kv ? RA_VCR : RA_KCR)), 1024, 2048, 2048};
            pg8::StaticOrder S; S.init(32, 1, 32, bx & 31, (const bf16_t*)(ws + WS_WC1) + (size_t)(l * 2 + kv) * 256 * 2048);
            EpiCmpHid E{(bf16_t*)(ws + RA_CH) + (size_t)kv * 8192 * 256, (const float*)(ctl + CW_BIASP) + (l * 2 + kv) * 256};
            pg8::gemm_phase(ring, g, S, E, F.wave0); }
        else phase_vs_transpose(F, l); }
    if constexpr (KIND == K_CMP_OUT) { pg8::Gemm g{(const bf16_t*)(ws + RA_CH), 256, 256, 256}; pg8::DualOrder S; S.init(64, 1, F.G, bx, (const bf16_t*)(ws + WS_WC2) + (size_t)(l * 2) * 256 * 256); S.estride = (size_t)256 * 256;
        EpiCmpOut E{(bf16_t*)(ws + RA_KC), (bf16_t*)(ws + RA_VC)}; pg8::gemm_phase(ring, g, S, E, F.wave0); }
#if NAIVE_NSA
    if constexpr (KIND == K_NSA_ATT) { phase_nsa_naive(F); }
#else
    if constexpr (KIND == K_NSA_ATT) { phase_nsa_fast(F, l); }
#endif
    if constexpr (KIND == K_SWA_IN) { pg8::Gemm g{(const bf16_t*)(ws + WS_HB), DM, DM, DM}; pg8::StaticOrder S;
        if (l == 2) S.init(MTOK / 256, 5, F.G, bx, (const bf16_t*)(ws + WS_WQKV2)); else S.init(MTOK / 256, 4, F.G, bx, (const bf16_t*)(ws + WS_WQB1));
        EpiSwaIn E{ws, (const float*)(ws + WS_CS)}; pg8::gemm_phase(ring, g, S, E, F.wave0); }
#if NAIVE_SWA
    if constexpr (KIND == K_SWA_ATT) { phase_swa_naive(F, (const float*)ARG_IN(10) + (l - 2) * 16); }
#else
    if constexpr (KIND == K_SWA_ATT) { phase_swa_fast(F, (const float*)ARG_IN(10) + (l - 2) * 16); }
#endif
    if constexpr (KIND == K_OUTPROJ) { pg8::Gemm g{(const bf16_t*)(ws + RA_ATT), DM, DM, DM}; pg8::StaticOrder S;
        S.init(MTOK / 256, 4, F.G, bx, l < 2 ? (const bf16_t*)(ws + WS_WOUTA) + (size_t)l * DM * DM : (const bf16_t*)(ws + WS_WOUTB) + (size_t)(l - 2) * DM * DM);
        EpiResid E{(const bf16_t*)(ws + WS_HB), (bf16_t*)(ws + WS_Y)}; pg8::gemm_phase(ring, g, S, E, F.wave0); }
    if constexpr (KIND == K_LN1) { phase_ln<0, false, false>(F, l * 2, nullptr, 0); }
    if constexpr (KIND == K_LN1R) { phase_ln<0, true, false>(F, l * 2, nullptr, l >> 1); }
    if constexpr (KIND == K_FFN1) { pg8::Gemm g{(const bf16_t*)(ws + WS_HB), DM, DM, DM}; pg8::StaticOrder S; S.init(MTOK / 256, 2 * DFF / 256, F.G, bx, (const bf16_t*)(ws + WS_WDIN) + (size_t)(l >> 1) * 2 * DFF * DM);
        EpiSwiglu E{(bf16_t*)(ws + WS_ACT), DFF}; pg8::gemm_phase(ring, g, S, E, F.wave0); }
    if constexpr (KIND == K_FFN2) { pg8::Gemm g{(const bf16_t*)(ws + WS_ACT), DFF, DFF, DFF}; pg8::StaticOrder S; S.init(MTOK / 256, 4, F.G, bx, (const bf16_t*)(ws + WS_WDOUT) + (size_t)(l >> 1) * DM * DFF);
        EpiResid E{(const bf16_t*)(ws + WS_HB), (bf16_t*)(ws + WS_Y)}; pg8::gemm_phase(ring, g, S, E, F.wave0); }
    if constexpr (KIND == K_LN2) { phase_ln<0, false, false>(F, l * 2 + 1, nullptr, 0); }
    if constexpr (KIND == K_SCATTER) { phase_moe_scatter(F, l >> 1); }
    if constexpr (KIND == K_MOE1) { const int ml = l >> 1; int ts[9]; moe_tiles((const unsigned*)ctl + CW_MOE + ml * 64, ts);
        pg8::Gemm g{(const bf16_t*)(ws + WS_XB), DM / 2, DM / 2, DM / 2}; pg8::GroupedOrder S; S.init(ts[8], 2 * DFFE / 256, F.G, bx, (const bf16_t*)(ws + WS_WMIN) + (size_t)ml * 8 * DFFE * DM);
        S.t1 = ts[1]; S.t2 = ts[2]; S.t3 = ts[3]; S.t4 = ts[4]; S.t5 = ts[5]; S.t6 = ts[6]; S.t7 = ts[7]; S.estride = (size_t)DFFE * DM;
        EpiSwiglu8 E{ws + WS_ACT, DFFE, 1.f / F8_WIN_MUL}; pg8::gemm_phase<EpiSwiglu8, pg8::GroupedOrder, true, F8_WIN_SH>(ring, g, S, E, F.wave0); }
    if constexpr (KIND == K_MOE2) { const int ml = l >> 1; int ts[9]; moe_tiles((const unsigned*)ctl + CW_MOE + ml * 64, ts);
        pg8::Gemm g{(const bf16_t*)(ws + WS_ACT), DFFE / 2, DFFE / 2, DFFE / 2}; pg8::GroupedOrder S; S.init(256, 4, F.G, bx, (const bf16_t*)(ws + WS_WMOUT) + (size_t)ml * 8 * DM * DFFE / 2);
        S.t1 = ts[1]; S.t2 = ts[2]; S.t3 = ts[3]; S.t4 = ts[4]; S.t5 = ts[5]; S.t6 = ts[6]; S.t7 = ts[7]; S.estride = (size_t)DM * DFFE / 2;
        EpiBf16Out E{(bf16_t*)(ws + WS_YB), 1.f / F8_WOUT_MUL}; pg8::gemm_phase<EpiBf16Out, pg8::GroupedOrder, true, F8_WOUT_SH>(ring, g, S, E, F.wave0);
        pg8::Gemm g4{(const bf16_t*)(ws + WS_ACT), DFFE / 2, DFFE / 4, DFFE / 2}; pg8::SliceOrder S4; S4.nsl = (ts[8] - 256) * 8; S4.G = F.G; S4.c = (bx + 128) & 255; S4.kq = DFFE / 4;
        S4.bt = (const bf16_t*)(ws + WS_WMOUT) + (size_t)ml * 8 * DM * DFFE / 2; S4.t1 = ts[1]; S4.t2 = ts[2]; S4.t3 = ts[3]; S4.t4 = ts[4]; S4.t5 = ts[5]; S4.t6 = ts[6]; S4.t7 = ts[7]; S4.estride = (size_t)DM * DFFE / 2;
        EpiPart E4{(float*)(ws + WS_H), 1.f / F8_WOUT_MUL}; pg8::gemm_phase<EpiPart, pg8::SliceOrder, true, F8_WOUT_SH>(ring, g4, S4, E4, F.wave0); }
    if constexpr (KIND == K_LN2C) { if (l == DEPTH - 1) phase_ln<1, false, true>(F, l * 2 + 1, ARG_OUT(), 0); else phase_ln<1, false, false>(F, l * 2 + 1, nullptr, 0); }
}

DEVI void frame_init(Frame& F, unsigned char* lds_raw) {
    F.lds = (LAS unsigned char*)lds_raw; F.ws = ARG_WS();
    F.wave0 = wave_id_sgpr(); F.tid = threadIdx.x; F.lane = F.tid & 63; F.wave = F.wave0;
    F.G = gridDim.x; { const int bx = blockIdx.x; F.vcu = (F.G % 8 == 0) ? (bx % 8) * (F.G / 8) + bx / 8 : bx; }
}

#if !MK_SINGLE
template <int KIND> __global__ void __launch_bounds__(NWAVES * 64, 2) phase_kernel(Args args) {
    extern __shared__ __attribute__((aligned(16))) unsigned char lds_raw[];
    Frame F; frame_init(F, lds_raw);
    do_phase<KIND>(F, args.ph_lo);
}
template <int KIND> static void launch_kind(const Args& a, hipStream_t stream) {
    static bool attr = false;
    if (!attr) { (void)hipFuncSetAttribute((const void*)phase_kernel<KIND>, hipFuncAttributeMaxDynamicSharedMemorySize, LDS_BYTES); attr = true; }
    hipLaunchKernelGGL(phase_kernel<KIND>, dim3(256), dim3(NWAVES * 64), LDS_BYTES, stream, a);
}
#else
__global__ void __launch_bounds__(NWAVES * 64, 2) yoco_fwd(Args args) {
    extern __shared__ __attribute__((aligned(16))) unsigned char lds_raw[];
    Frame F; frame_init(F, lds_raw);
    volatile LAS unsigned* MISC = (volatile LAS unsigned*)(F.lds + MISC_OFF);
    for (int u = F.tid; u < 256; u += NWAVES * 64) MISC[u] = 0u;
    __syncthreads();
    XcdBarrier bar = xcd_barrier_post((unsigned*)(F.ws + WS_CTL) + CW_BAR, MISC + 8);
#define DUP_KIND 12
#define DUP_KIND 13
#ifndef DUP_KIND
#define DUP_KIND -1
#endif
#define PH(K, L, FIRST) do { do_phase<K>(F, L); if (FIRST) cg::this_grid().sync(); else xcd_barrier(bar); if (K == DUP_KIND) { do_phase<K>(F, L); xcd_barrier(bar); } } while (0)
    PH(K_PRO, 0, true);
#define NSA_LAYER(l) PH(K_NSA_IN, l, false); PH(K_CMP_HID, l, false); PH(K_CMP_OUT, l, false); PH(K_NSA_ATT, l, false); PH(K_OUTPROJ, l, false)
#define SWA_LAYER(l) PH(K_SWA_IN, l, false); PH(K_SWA_ATT, l, false); PH(K_OUTPROJ, l, false)
#define DENSE_FFN(l) PH(K_LN1, l, false); PH(K_FFN1, l, false); PH(K_FFN2, l, false); PH(K_LN2, l, false)
#define MOE_FFN(l, LAST) PH(K_LN1R, l, false); PH(K_SCATTER, l, false); PH(K_MOE1, l, false); PH(K_MOE2, l, false); do_phase<K_LN2C>(F, l); if (!(LAST)) xcd_barrier(bar); else if (DUP_KIND == 16) { xcd_barrier(bar); do_phase<K_LN2C>(F, l); }
    NSA_LAYER(0); DENSE_FFN(0);
    NSA_LAYER(1); MOE_FFN(1, false);
    SWA_LAYER(2); DENSE_FFN(2);
    SWA_LAYER(3); MOE_FFN(3, true);
}
#endif

extern "C" void kernel_launch(void* const* d_in, const int* in_sizes, int n_in, void* d_out, int out_size, void* d_ws, size_t ws_size, hipStream_t stream) {
    static int grid = 0;
    if (grid == 0) {
        if (n_in != 18 || out_size != MTOK * DM || ws_size < WS_END) { fprintf(stderr, "kernel_launch: unexpected shapes (n_in %d out %d ws %zu need %zu)\n", n_in, out_size, ws_size, (size_t)WS_END); grid = -1; return; }
        int dev = 0, cus = 0;
        (void)hipGetDevice(&dev); (void)hipDeviceGetAttribute(&cus, hipDeviceAttributeMultiprocessorCount, dev);
        if (cus < 256) { fprintf(stderr, "kernel_launch: needs 256 CUs, device has %d\n", cus); grid = -1; return; }
#if MK_SINGLE
        int per_cu = 0;
        (void)hipFuncSetAttribute((const void*)yoco_fwd, hipFuncAttributeMaxDynamicSharedMemorySize, LDS_BYTES);
        (void)hipOccupancyMaxActiveBlocksPerMultiprocessor(&per_cu, (const void*)yoco_fwd, NWAVES * 64, LDS_BYTES);
        if (per_cu < 1) fprintf(stderr, "kernel_launch: occupancy query says %d blocks per CU\n", per_cu);
        (void)hipGetLastError();
#endif
        grid = 256;
    }
    if (grid < 0) return;
    (void)hipMemsetAsync((char*)d_ws + WS_CTL, 0, CTL_BYTES, stream);
    Args a{};
    for (int i = 0; i < 18; ++i) a.in[i] = d_in[i];
    a.out = (float*)d_out; a.ws = (unsigned char*)d_ws;
#if MK_SINGLE
    a.ph_lo = 0; a.ph_hi = NPH;
    void* kargs[] = {&a};
    hipError_t e = hipLaunchCooperativeKernel((const void*)yoco_fwd, dim3(grid), dim3(NWAVES * 64), kargs, LDS_BYTES, stream);
    if (e != hipSuccess) fprintf(stderr, "cooperative launch failed: %s (grid %d)\n", hipGetErrorString(e), grid);
#else
    for (int p = 0; p < NPH; ++p) {
        a.ph_lo = h_prog[p].layer; a.ph_hi = 0;
        switch (h_prog[p].kind) {
#define LK(K) case K: launch_kind<K>(a, stream); break;
            LK(K_PRO) LK(K_NSA_IN) LK(K_CMP_HID) LK(K_CMP_OUT) LK(K_NSA_ATT) LK(K_SWA_IN) LK(K_SWA_ATT) LK(K_OUTPROJ) LK(K_LN1) LK(K_LN1R) LK(K_FFN1) LK(K_FFN2) LK(K_LN2) LK(K_SCATTER) LK(K_MOE1) LK(K_MOE2) LK(K_LN2C)
#undef LK
            default: break;
        }
    }
#endif
}
```

```cpp
#include <hip/hip_runtime.h>
#include <hip/hip_cooperative_groups.h>
#include <cstdio>
#include <cstdint>
namespace cg = cooperative_groups;

#ifndef DBG_DROP
#define DBG_DROP 0
#endif
#ifndef NAIVE_NSA
#define NAIVE_NSA 0
#endif
#ifndef NAIVE_SWA
#define NAIVE_SWA 0
#endif
#if NAIVE_NSA || NAIVE_SWA
#error "the naive attention references write bf16 attention rows; the out-projection now reads e4m3"
#endif
#ifndef MK_SINGLE
#define MK_SINGLE 1
#endif

#define DEVI __device__ __forceinline__
#define LAS __attribute__((address_space(3)))
#define GAS __attribute__((address_space(1)))
typedef unsigned short bf16_t;
typedef short bf16x8 __attribute__((ext_vector_type(8)));
typedef float f32x4 __attribute__((ext_vector_type(4)));
typedef float f32x2 __attribute__((ext_vector_type(2)));
typedef unsigned u32x4 __attribute__((ext_vector_type(4)));
typedef unsigned u32x2 __attribute__((ext_vector_type(2)));

constexpr int BATCH = 2, SEQ = 16384, MTOK = BATCH * SEQ, DM = 1024, DEPTH = 4;
constexpr int HD = 64;
constexpr int A_G = 4, A_R = 4, A_IN = 2608, A_INP = 2816;
constexpr int NCMP = 1023, CMP_HID = 256;
constexpr int NSLC = SEQ / 64, NSEL = 16, NSA_WIN = 512;
constexpr int B_G = 2, B_R = 8, SWA_WIN = 128;
constexpr int DFF = 2816, NEXP = 8, DFFE = 3584;
constexpr int CAP = MTOK * 2 + NEXP * 256;
constexpr float ALPHA = 1.6817928305074292f;
constexpr float LN_EPS = 1e-5f;
constexpr float QSCALE = 0.125f;

constexpr size_t al256(size_t x) { return (x + 255) & ~(size_t)255; }
constexpr size_t WS_CTL = 0, CTL_BYTES = 1u << 20;
constexpr size_t WS_WINA = CTL_BYTES;
constexpr size_t WS_WOUTA = WS_WINA + (size_t)2 * A_INP * DM * 2;
constexpr size_t WS_WC1 = WS_WOUTA + (size_t)2 * DM * DM * 2;
constexpr size_t WS_WC2 = WS_WC1 + (size_t)4 * 256 * 2048 * 2;
constexpr size_t WS_WQKV2 = WS_WC2 + (size_t)4 * 256 * 256 * 2;
constexpr size_t WS_WQB1 = WS_WQKV2 + (size_t)1280 * DM * 2;
constexpr size_t WS_WOUTB = WS_WQB1 + (size_t)DM * DM * 2;
constexpr size_t WS_WDIN = WS_WOUTB + (size_t)2 * DM * DM * 2;
constexpr size_t WS_WDOUT = WS_WDIN + (size_t)2 * 2 * DFF * DM * 2;
constexpr size_t WS_WMIN = WS_WDOUT + (size_t)2 * DM * DFF * 2;
constexpr size_t WS_WMOUT = WS_WMIN + (size_t)16 * 2 * DFFE * DM * 2;
constexpr size_t WS_HB8 = WS_WMIN + (size_t)16 * 2 * DFFE * DM;
constexpr size_t WS_WEND = WS_WMOUT + (size_t)16 * DM * DFFE * 2;
constexpr size_t WS_H = al256(WS_WEND);
constexpr size_t WS_Y = WS_H + (size_t)MTOK * DM * 4;
constexpr size_t WS_HB = WS_Y + (size_t)MTOK * DM * 4;
constexpr size_t WS_CS = WS_HB + (size_t)MTOK * DM * 2;
constexpr size_t WS_KSH = WS_CS + (size_t)MTOK * 16 * 4;
constexpr size_t WS_VSH = WS_KSH + (size_t)MTOK * 128 * 2;
constexpr size_t WS_ROUTE = WS_VSH + (size_t)MTOK * 128 * 2;
constexpr size_t WS_XB = WS_ROUTE + (size_t)MTOK * 2 * 4 * 4;
constexpr size_t WS_ACT = WS_XB + (size_t)CAP * DM * 2;
constexpr size_t WS_RA = WS_ACT + (size_t)CAP * DFFE * 2;
constexpr size_t SLAB = (size_t)MTOK * 256 * 2;
constexpr size_t RA_Q = WS_RA;
constexpr size_t RA_ATT = RA_Q + (size_t)MTOK * DM * 2;
constexpr size_t RA_KCR = RA_ATT + (size_t)MTOK * DM * 2;
constexpr size_t RA_VCR = RA_KCR + SLAB + 4096;
constexpr size_t RA_KS = RA_VCR + SLAB + 4096;
constexpr size_t RA_VS = RA_KS + SLAB;
constexpr size_t RA_KW = RA_VS + SLAB;
constexpr size_t RA_VW = RA_KW + SLAB;
constexpr size_t RA_GATE = RA_VW + SLAB;
constexpr size_t RA_KC = RA_GATE + (size_t)MTOK * 48 * 4;
constexpr size_t RA_VC = RA_KC + (size_t)8192 * 64 * 2;
constexpr size_t RA_CH = RA_VC + (size_t)8192 * 64 * 2;
constexpr size_t RA_VST = RA_CH + (size_t)2 * 8192 * 256 * 2;
constexpr size_t RA_K8 = RA_VST + SLAB / 2;
constexpr size_t RA_END = RA_VST + SLAB;
constexpr size_t WS_YB = WS_RA;
constexpr size_t YB_END = WS_YB + (size_t)CAP * DM * 4;
constexpr size_t WS_END = (RA_END > YB_END ? RA_END : YB_END);
static_assert(WS_END < (size_t)1879048192, "workspace map exceeds 4x the largest tensor");

constexpr int CW_BAR = 4096;
constexpr int CW_MOE = 16384;
constexpr int CW_WGCNT = 45056;
constexpr int CW_KWMAX = 40128;
constexpr int CW_KMAX = 40064;
constexpr int CW_VMAX = 40000;
constexpr int CW_BIASP = 32768;

constexpr int RING_BYTES = 131072;
constexpr int LDS_X = RING_BYTES;
constexpr int MISC_OFF = RING_BYTES + 16384;
constexpr int LDS_BYTES = MISC_OFF + 1024;

DEVI unsigned f2bf(float f) { unsigned u = __builtin_bit_cast(unsigned, f); return (u + 0x7fffu + ((u >> 16) & 1u)) >> 16; }
DEVI unsigned pk2(float lo, float hi) { return f2bf(lo) | (f2bf(hi) << 16); }
DEVI float bf2f(unsigned h) { return __builtin_bit_cast(float, h << 16); }
DEVI float bflo(unsigned w) { return __builtin_bit_cast(float, w << 16); }
DEVI float bfhi(unsigned w) { return __builtin_bit_cast(float, w & 0xffff0000u); }
DEVI float clamp8(float x) { return __builtin_amdgcn_fmed3f(x, -448.f, 448.f); }
DEVI unsigned pack_fp8x4(float a, float b, float c, float d) {
    const int w = __builtin_amdgcn_cvt_pk_fp8_f32(clamp8(a), clamp8(b), 0, false);
    return (unsigned)__builtin_amdgcn_cvt_pk_fp8_f32(clamp8(c), clamp8(d), w, true);
}
DEVI float shx(float v, int mask, int lane) { return __builtin_bit_cast(float, __builtin_amdgcn_ds_bpermute((lane ^ mask) << 2, __builtin_bit_cast(int, v))); }
DEVI int shxi(int v, int mask, int lane) { return __builtin_amdgcn_ds_bpermute((lane ^ mask) << 2, v); }
DEVI float wave_sum(float v, int lane) {
#pragma unroll
    for (int o = 1; o < 64; o <<= 1) v += shx(v, o, lane);
    return v;
}
DEVI float wave_max(float v, int lane) {
#pragma unroll
    for (int o = 1; o < 64; o <<= 1) v = fmaxf(v, shx(v, o, lane));
    return v;
}
DEVI int wave_id_sgpr() { return __builtin_amdgcn_readfirstlane((int)threadIdx.x >> 6); }
DEVI int opaque_tid(int wave) { asm volatile("" : "+s"(wave)); int l; asm volatile("v_mbcnt_lo_u32_b32 %0, -1, 0\n\tv_mbcnt_hi_u32_b32 %0, -1, %0" : "=v"(l)); return wave * 64 + l; }
#define LDS_WAIT() asm volatile("s_waitcnt lgkmcnt(0)" ::: "memory")
#define VM_WAIT() asm volatile("s_waitcnt vmcnt(0)" ::: "memory")

namespace pg8 {
constexpr int BM = 256, BK = 64, HALF = 128, HTB = HALF * BK * 2, STAGE_BYTES = 8 * HTB, NXCD = 8, WGM = 8;
DEVI int lds_byte(int r, int c) { const int st = (r >> 4) * 2 + (c >> 5), rr = r & 15, cc = c & 31, ob = rr * 64 + cc * 2; return st * 1024 + (ob ^ (((ob >> 9) & 1) << 5)); }
DEVI void stage_rc(int b, int& R, int& C) { const int st = b / 1024, sb = b % 1024, swz = sb ^ (((sb >> 9) & 1) << 5); R = (st >> 1) * 16 + swz / 64; C = (st & 1) * 32 + (swz % 64) / 2; }
DEVI int perm32(int rho) { const int n = rho >> 4, i = rho & 15; return 8 * (i >> 2) + 4 * n + (i & 3); }

struct Unit { int pm, pn; const bf16_t* bt; int koff, z; };
struct Gemm { const bf16_t* A; int lda; int K; int ldb; };

struct StaticOrder {
    int nM, nN, nwg, G, c; const bf16_t* bt;
    DEVI void init(int nM_, int nN_, int G_, int c_, const bf16_t* bt_) { nM = nM_; nN = nN_; nwg = nM * nN; G = G_; c = c_; bt = bt_; }
    DEVI bool tile(int i, int& pm, int& pn) const {
        const long L = (long)i * G + c; if (L >= nwg) return false;
        int wgid = (int)L; { const int q = nwg / NXCD, r = nwg % NXCD, xcd = wgid % NXCD, off = wgid / NXCD; wgid = (xcd < r ? xcd * (q + 1) : r * (q + 1) + (xcd - r) * q) + off; }
        const int nig = WGM * nN, gid = wgid / nig, fm = gid * WGM, gsz = (nM - fm) < WGM ? (nM - fm) : WGM;
        pm = fm + ((wgid % nig) % gsz); pn = (wgid % nig) / gsz; return true;
    }
    DEVI bool next(int i, Unit& u) const { if (!tile(i, u.pm, u.pn)) return false; u.bt = bt; u.koff = 0; u.z = 0; return true; }
};
struct GroupedOrder : StaticOrder {
    int t1, t2, t3, t4, t5, t6, t7; size_t estride;
    DEVI bool next(int i, Unit& u) const {
        if (!tile(i, u.pm, u.pn)) return false;
        const int tm = u.pm; const int e = (tm >= t1) + (tm >= t2) + (tm >= t3) + (tm >= t4) + (tm >= t5) + (tm >= t6) + (tm >= t7);
        u.bt = bt + (size_t)e * estride; u.koff = 0; u.z = 0; return true;
    }
};
struct SliceOrder {
    int nsl, G, c, kq; const bf16_t* bt; int t1, t2, t3, t4, t5, t6, t7; size_t estride;
    DEVI bool next(int i, Unit& u) const {
        const int L = i * G + c; if (L >= nsl) return false;
        u.pm = 256 + (L >> 3); u.pn = (L & 7) >> 1; u.z = L & 1; u.koff = u.z * kq;
        const int tm = u.pm; const int e = (tm >= t1) + (tm >= t2) + (tm >= t3) + (tm >= t4) + (tm >= t5) + (tm >= t6) + (tm >= t7);
        u.bt = bt + (size_t)e * estride; return true;
    }
};
struct DualOrder : StaticOrder {
    size_t estride;
    DEVI bool next(int i, Unit& u) const { if (!tile(i, u.pm, u.pn)) return false; u.bt = bt + (u.pm >= nM / 2 ? estride : 0); u.koff = 0; u.z = 0; return true; }
};

DEVI unsigned cvt_pk_bf16(float lo, float hi) { typedef __bf16 bf16x2_t __attribute__((ext_vector_type(2))); f32x2 v = {lo, hi}; bf16x2_t b = __builtin_convertvector(v, bf16x2_t); return __builtin_bit_cast(unsigned, b); }

typedef int v4i_t __attribute__((ext_vector_type(4)));
typedef int v8i_t __attribute__((ext_vector_type(8)));
template <int F8SH> DEVI void mma_block(f32x4 (&acc)[4][2], const bf16x8 (&At)[4][2], const bf16x8 (&Bt)[2][2]) {
    if constexpr (F8SH < 0) {
#pragma unroll
        for (int m = 0; m < 4; ++m)
#pragma unroll
            for (int n = 0; n < 2; ++n)
#pragma unroll
                for (int k = 0; k < 2; ++k) acc[m][n] = __builtin_amdgcn_mfma_f32_16x16x32_bf16(Bt[n][k], At[m][k], acc[m][n], 0, 0, 0);
    } else {
#pragma unroll
        for (int m = 0; m < 4; ++m)
#pragma unroll
            for (int n = 0; n < 2; ++n) {
                const v8i_t a8 = __builtin_shufflevector(__builtin_bit_cast(v4i_t, At[m][0]), __builtin_bit_cast(v4i_t, At[m][1]), 0, 1, 2, 3, 4, 5, 6, 7);
                const v8i_t b8 = __builtin_shufflevector(__builtin_bit_cast(v4i_t, Bt[n][0]), __builtin_bit_cast(v4i_t, Bt[n][1]), 0, 1, 2, 3, 4, 5, 6, 7);
                asm volatile("v_mfma_f32_16x16x128_f8f6f4 %0, %1, %2, %0" : "+v"(acc[m][n]) : "v"(b8), "v"(a8)); }
    }
}
template <class Epi, class Sched, bool ALIGN_EPI = true, int F8SH = -1>
DEVI void gemm_phase(LAS unsigned char* lds, const Gemm g, const Sched& S, const Epi& E, int wave0) {
    const int tid = opaque_tid(wave0), wid = __builtin_amdgcn_readfirstlane(tid >> 6), lane = tid & 63, wr = wid >> 2, wc = wid & 3, fr = lane & 15, fq = lane >> 4;
    const int K = g.K, nt = K / BK, lda = g.lda, ldb = g.ldb;
    unsigned voffA[2], voffB[2];
#pragma unroll
    for (int i = 0; i < 2; ++i) { int R, C; stage_rc(tid * 16 + i * 8192, R, C); const int Rb = Epi::PERM ? ((R & ~31) + perm32(R & 31)) : R;
        voffA[i] = (unsigned)(R * lda + C) * 2u; voffB[i] = (unsigned)(Rb * ldb + C) * 2u; }
    const size_t kstep = (size_t)(BK * 2);
    const size_t hstepA = (size_t)HALF * lda * 2, tstepA = 2 * hstepA;
    const size_t hstepB = (size_t)HALF * ldb * 2, tstepB = 2 * hstepB;
    const unsigned ldsw = (unsigned)wid * 1024u;
    const int aoff = lds_byte(wr * 64 + fr, fq * 8), boff = lds_byte(wc * 32 + fr, fq * 8);
#define PG8_SA(b, h) (((b) * 2 + (h)) * HTB)
#define PG8_SB(b, h) ((4 + (b) * 2 + (h)) * HTB)
#define PG8_STAGE(bufoff, gbase, voff) do { _Pragma("unroll") for (int _i = 0; _i < 2; ++_i) \
        __builtin_amdgcn_global_load_lds((const unsigned*)((const char*)(gbase) + (voff)[_i]), (LAS unsigned*)(lds + (bufoff) + ldsw + _i * 8192), 16, 0, 0); } while (0)
#define PG8_LDA(dst, b, h) do { _Pragma("unroll") for (int m = 0; m < 4; ++m) _Pragma("unroll") for (int k = 0; k < 2; ++k) dst[m][k] = *(const LAS bf16x8*)(lds + PG8_SA(b, h) + aoff + m * 2048 + k * 1024); } while (0)
#define PG8_LDB(dst, b, h) do { _Pragma("unroll") for (int n = 0; n < 2; ++n) _Pragma("unroll") for (int k = 0; k < 2; ++k) dst[n][k] = *(const LAS bf16x8*)(lds + PG8_SB(b, h) + boff + n * 2048 + k * 1024); } while (0)
#define PG8_MMA(ai, bj, At, Bt) do { __builtin_amdgcn_s_setprio(1); mma_block<F8SH>(acc[ai][bj], At, Bt); __builtin_amdgcn_s_setprio(0); } while (0)
#define PG8_WAIT_V(n) asm volatile("s_waitcnt vmcnt(" #n ")" ::: "memory")
#define PG8_WAIT_L(n) asm volatile("s_waitcnt lgkmcnt(" #n ")" ::: "memory")
#define PG8_BAR __builtin_amdgcn_s_barrier()
#define PG8_SCHED __builtin_amdgcn_sched_barrier(0)
    Unit cur, nxt; int ui = 0;
    if (!S.next(0, cur)) return;
    f32x4 acc[2][2][4][2];
#pragma unroll
    for (int a = 0; a < 2; ++a)
#pragma unroll
        for (int b = 0; b < 2; ++b)
#pragma unroll
            for (int m = 0; m < 4; ++m)
#pragma unroll
                for (int n = 0; n < 2; ++n) acc[a][b][m][n] = (f32x4){0.f, 0.f, 0.f, 0.f};
    bf16x8 At[4][2], B0[2][2], B1[2][2];
    const char* cA = (const char*)g.A + (size_t)cur.pm * tstepA + (size_t)cur.koff * 2; const char* cB = (const char*)cur.bt + (size_t)cur.pn * tstepB + (size_t)cur.koff * 2;
    PG8_STAGE(PG8_SB(0, 0), cB, voffB); PG8_STAGE(PG8_SB(0, 1), cB + hstepB, voffB); PG8_STAGE(PG8_SA(0, 0), cA, voffA); PG8_STAGE(PG8_SA(0, 1), cA + hstepA, voffA);
    if (wr == 1) PG8_BAR;
    PG8_WAIT_V(2); PG8_BAR;
    PG8_STAGE(PG8_SB(1, 0), cB + kstep, voffB); PG8_STAGE(PG8_SA(1, 0), cA + kstep, voffA); PG8_STAGE(PG8_SB(1, 1), cB + hstepB + kstep, voffB);
    PG8_WAIT_V(6); PG8_BAR;
    for (;;) {
        const bool has_next = S.next(ui + 1, nxt);
        const char* nA = has_next ? (const char*)g.A + (size_t)nxt.pm * tstepA + (size_t)nxt.koff * 2 : cA; const char* nB = has_next ? (const char*)nxt.bt + (size_t)nxt.pn * tstepB + (size_t)nxt.koff * 2 : cB;
#pragma unroll 1
        for (int t = 0; t < nt; t += 2) {
            const bool last = (t == nt - 2);
            const char* a1 = cA + (size_t)(t + 1) * kstep;
            const char* a2 = last ? nA : cA + (size_t)(t + 2) * kstep; const char* b2 = last ? nB : cB + (size_t)(t + 2) * kstep;
            const char* a3 = a2 + kstep; const char* b3 = b2 + kstep;
            PG8_LDB(B0, 0, 0); PG8_LDB(B1, 0, 1); PG8_SCHED; PG8_LDA(At, 0, 0); PG8_STAGE(PG8_SA(1, 1), a1 + hstepA, voffA);
            PG8_WAIT_V(8); PG8_WAIT_L(0); PG8_BAR; PG8_MMA(0, 0, At, B0); PG8_MMA(0, 1, At, B1); PG8_BAR; PG8_SCHED;
            PG8_LDA(At, 0, 1); PG8_STAGE(PG8_SB(0, 0), b2, voffB); PG8_STAGE(PG8_SB(0, 1), b2 + hstepB, voffB); PG8_STAGE(PG8_SA(0, 0), a2, voffA);
            PG8_WAIT_V(8); PG8_WAIT_L(0); PG8_BAR; PG8_MMA(1, 0, At, B0); PG8_MMA(1, 1, At, B1); PG8_BAR; PG8_SCHED;
            PG8_LDB(B0, 1, 0); PG8_LDB(B1, 1, 1); PG8_SCHED; PG8_LDA(At, 1, 0); PG8_STAGE(PG8_SA(0, 1), a2 + hstepA, voffA);
            PG8_WAIT_V(8); PG8_WAIT_L(0); PG8_BAR; PG8_MMA(0, 0, At, B0); PG8_MMA(0, 1, At, B1); PG8_BAR; PG8_SCHED;
            PG8_LDA(At, 1, 1); PG8_STAGE(PG8_SB(1, 0), b3, voffB); PG8_STAGE(PG8_SB(1, 1), b3 + hstepB, voffB); PG8_STAGE(PG8_SA(1, 0), a3, voffA);
            PG8_WAIT_V(8); PG8_WAIT_L(0); PG8_BAR; PG8_MMA(1, 0, At, B0); PG8_MMA(1, 1, At, B1); PG8_BAR; PG8_SCHED;
        }
        if constexpr (F8SH >= 0) { asm volatile("s_nop 15\n\ts_nop 15" ::: "memory"); PG8_SCHED; }
        if constexpr (F8SH >= 0) {
#pragma unroll
            for (int a = 0; a < 2; ++a)
#pragma unroll
                for (int b = 0; b < 2; ++b)
#pragma unroll
                    for (int m = 0; m < 4; ++m)
#pragma unroll
                        for (int n = 0; n < 2; ++n) acc[a][b][m][n] = acc[a][b][m][n] * (1.f / (float)(1 << F8SH));
        }
        if constexpr (ALIGN_EPI) { if (wr == 0) PG8_BAR; }
        E(acc, cur, wr, wc, fr, fq);
        if (!has_next) break;
#pragma unroll
        for (int a = 0; a < 2; ++a)
#pragma unroll
            for (int b = 0; b < 2; ++b)
#pragma unroll
                for (int m = 0; m < 4; ++m)
#pragma unroll
                    for (int n = 0; n < 2; ++n) acc[a][b][m][n] = (f32x4){0.f, 0.f, 0.f, 0.f};
        cur = nxt; cA = nA; cB = nB; ++ui;
        if constexpr (ALIGN_EPI) { if (wr == 1) PG8_BAR; }
    }
    PG8_WAIT_V(0);
    if constexpr (!ALIGN_EPI) { if (wr == 0) PG8_BAR; }
    PG8_BAR;
#undef PG8_SA
#undef PG8_SB
#undef PG8_STAGE
#undef PG8_LDA
#undef PG8_LDB
#undef PG8_MMA
#undef PG8_WAIT_V
#undef PG8_WAIT_L
#undef PG8_BAR
#undef PG8_SCHED
}
}

#define XB_TMO      128
#define XB_XCNT(j)  (256  + 64 * (j))
#define XB_XSUB(j)  (1280 + 64 * (j))
#define XB_XGEN(j)  (2304 + 64 * (j))
#define XB_TOP      3328
#define XB_TOPGEN   3392
#define XCD_BAR_WORDS 3456
#define XB_SPIN_CAP (1u << 22)
DEVI unsigned xb_ld(unsigned* p)              { return __hip_atomic_load(p, __ATOMIC_RELAXED, __HIP_MEMORY_SCOPE_AGENT); }
DEVI unsigned xb_add(unsigned* p, unsigned v) { return __hip_atomic_fetch_add(p, v, __ATOMIC_RELAXED, __HIP_MEMORY_SCOPE_AGENT); }
DEVI unsigned xb_xcc_id() { return (unsigned)__builtin_amdgcn_s_getreg((3 << 11) | 20) & 0xFu; }
#define XB_SPIN(cond, bar) do { unsigned _sp = 0; while (cond) { __builtin_amdgcn_s_sleep(1); \
    if ((++_sp & 255u) == 0u) { if (xb_ld(&(bar)[XB_TMO])) break; if (_sp > XB_SPIN_CAP) { atomicAdd(&(bar)[XB_TMO], 1u); break; } } } } while (0)
struct XcdBarrier { unsigned* bar; unsigned x; volatile LAS unsigned* st; };
DEVI XcdBarrier xcd_barrier_post(unsigned* bar, volatile LAS unsigned* st) {
    XcdBarrier b; b.bar = bar; b.x = xb_xcc_id(); b.st = st;
    if (threadIdx.x == 0) (void)xb_add(&bar[XB_XCNT(b.x)], 1u);
    return b;
}
DEVI void xcd_barrier_complete(unsigned* bar, unsigned x, unsigned& nloc, unsigned& nx) {
    const unsigned G = gridDim.x * gridDim.y * gridDim.z;
    unsigned sum, cnt, mine, sp = 0u;
    for (;;) {
        sum = 0u; cnt = 0u; mine = 0u;
#pragma unroll
        for (unsigned j = 0; j < 16; ++j) { const unsigned c = xb_ld(&bar[XB_XCNT(j)]); sum += c; cnt += (c > 0u) ? 1u : 0u; mine = (j == x) ? c : mine; }
        if (sum == G) break;
        __builtin_amdgcn_s_sleep(1);
        if ((++sp & 255u) == 0u) { if (xb_ld(&bar[XB_TMO])) break; if (sp > XB_SPIN_CAP) { atomicAdd(&bar[XB_TMO], 1u); break; } }
    }
    nloc = mine > 0u ? mine : 1u; nx = cnt > 0u ? cnt : 1u;
}
DEVI void xcd_barrier(const XcdBarrier& b) {
    asm volatile("s_waitcnt vmcnt(0)" ::: "memory");
    __syncthreads();
    if (threadIdx.x == 0) {
        unsigned* bar = b.bar;
        __builtin_amdgcn_s_waitcnt(0);
        unsigned nloc = b.st[0], nx = b.st[1];
        if (nloc == 0u) { xcd_barrier_complete(bar, b.x, nloc, nx); b.st[0] = nloc; b.st[1] = nx; }
        const unsigned old = xb_add(&bar[XB_XSUB(b.x)], 1u);
        const unsigned gen = old / nloc;
        if (old + 1u == (gen + 1u) * nloc) {
            __builtin_amdgcn_fence(__ATOMIC_RELEASE, "agent");
            asm volatile("s_waitcnt vmcnt(0)" ::: "memory");
            const unsigned og = xb_add(&bar[XB_TOP], 1u);
            const unsigned tg = og / nx;
            if (og + 1u == (tg + 1u) * nx) xb_add(&bar[XB_TOPGEN], 1u);
            else XB_SPIN(xb_ld(&bar[XB_TOPGEN]) == tg, bar);
            __builtin_amdgcn_fence(__ATOMIC_ACQUIRE, "agent");
            xb_add(&bar[XB_XGEN(b.x)], 1u);
            asm volatile("s_waitcnt vmcnt(0)" ::: "memory");
        } else {
            XB_SPIN(xb_ld(&bar[XB_XGEN(b.x)]) == gen, bar);
            __builtin_amdgcn_fence(__ATOMIC_ACQUIRE, "agent");
            asm volatile("s_waitcnt vmcnt(0)" ::: "memory");
        }
    }
    __syncthreads();
}

typedef const void* cvp_t;
DEVI const void* karg_ptr(int byte_off) { asm volatile("" : "+s"(byte_off)); const __attribute__((address_space(4))) char* kp = (const __attribute__((address_space(4))) char*)__builtin_amdgcn_kernarg_segment_ptr(); return *(const __attribute__((address_space(4))) cvp_t*)(kp + byte_off); }
#define ARG_IN(i) karg_ptr((i) * 8)
#define ARG_OUT() ((float*)karg_ptr(18 * 8))
#define ARG_WS() ((unsigned char*)karg_ptr(19 * 8))
struct Frame {
    LAS unsigned char* lds;
    unsigned char* ws;
    int tid, lane, wave, G, vcu, wave0;
    DEVI void refresh() { tid = opaque_tid(wave0); lane = tid & 63; wave = __builtin_amdgcn_readfirstlane(tid >> 6); }
};
constexpr int NWAVES = 8;
constexpr int F8_WIN_SH = 5, F8_WOUT_SH = 6;
constexpr float F8_WIN_MUL = 32.f, F8_WOUT_MUL = 64.f;

DEVI void transpose_item(const float* W, int K, int N, bf16_t* WT, int k0, int n0, int drow0, LAS float* scr, int lane, float f8mul) {
    const int nc = n0 + 4 * (lane & 7); const bool ok = nc < N;
#pragma unroll
    for (int i = 0; i < 8; ++i) { const int kk = 8 * i + (lane >> 3); const f32x4 v = ok ? *(const f32x4*)(W + (size_t)(k0 + kk) * N + nc) : (f32x4){0.f, 0.f, 0.f, 0.f};
        LAS float* d = scr + kk * 33 + 4 * (lane & 7); d[0] = v[0]; d[1] = v[1]; d[2] = v[2]; d[3] = v[3]; }
    LDS_WAIT(); asm volatile("" ::: "memory");
    const int c = lane & 7;
#pragma unroll
    for (int j = 0; j < 4; ++j) { const int n = (lane >> 3) + 8 * j; const LAS float* s = scr + (8 * c) * 33 + n;
        if (f8mul > 0.f) { u32x2 o8; o8[0] = pack_fp8x4(s[0 * 33] * f8mul, s[1 * 33] * f8mul, s[2 * 33] * f8mul, s[3 * 33] * f8mul); o8[1] = pack_fp8x4(s[4 * 33] * f8mul, s[5 * 33] * f8mul, s[6 * 33] * f8mul, s[7 * 33] * f8mul);
            *(u32x2*)((unsigned char*)WT + (size_t)(drow0 + n) * K + k0 + 8 * c) = o8; continue; }
        u32x4 o; o.x = pk2(s[0 * 33], s[1 * 33]); o.y = pk2(s[2 * 33], s[3 * 33]); o.z = pk2(s[4 * 33], s[5 * 33]); o.w = pk2(s[6 * 33], s[7 * 33]);
        *(u32x4*)(WT + (size_t)(drow0 + n) * K + k0 + 8 * c) = o; }
    LDS_WAIT(); asm volatile("" ::: "memory");
}
struct WFam { const float* src; size_t sstride; bf16_t* dst; size_t dstride; int count, K, N, Npad, mode; float f8mul; };
DEVI bool wfam_do(const WFam& f, int& it, LAS float* scr, int lane) {
    const int nkb = f.K / 64, nnb = f.Npad / 32, per = nkb * nnb, tot = per * f.count;
    if (it >= tot) { it -= tot; return false; }
    const int mi = it / per, r = it % per, kb = r / nnb, nb = r % nnb, n0 = nb * 32;
    int drow0 = n0;
    if (f.mode == 1) { const int F = f.N / 2; const int o = n0 < F ? n0 : n0 - F; drow0 = 256 * (o / 128) + (o % 128) + (n0 < F ? 0 : 128); }
    transpose_item(f.src + (size_t)mi * f.sstride, f.K, f.N, f.dst + (size_t)mi * f.dstride, kb * 64, n0, drow0, scr, lane, f.f8mul);
    return true;
}

DEVI void phase_prologue(Frame& F) {
    F.refresh();
    LAS float* scr = (LAS float*)(F.lds + F.wave * 16384);
    const int gw = F.vcu * NWAVES + F.wave, NGW = F.G * NWAVES;
    unsigned char* ws = F.ws;
    const WFam fam[11] = {
        {(const float*)ARG_IN(2), (size_t)DM * A_IN, (bf16_t*)(ws + WS_WINA), (size_t)A_INP * DM / 2, 2, DM, A_IN, A_INP, 0, F8_WIN_MUL},
        {(const float*)ARG_IN(3), (size_t)DM * DM, (bf16_t*)(ws + WS_WOUTA), (size_t)DM * DM / 2, 2, DM, DM, DM, 0, F8_WIN_MUL},
        {(const float*)ARG_IN(5), (size_t)2048 * 256, (bf16_t*)(ws + WS_WC1), (size_t)256 * 2048, 4, 2048, 256, 256, 0, 0.f},
        {(const float*)ARG_IN(6), (size_t)256 * 64, (bf16_t*)(ws + WS_WC2), (size_t)256 * 256, 4, 256, 64, 256, 0, 0.f},
        {(const float*)ARG_IN(8), (size_t)DM * DM, (bf16_t*)(ws + WS_WQKV2), 0, 1, DM, DM, DM, 0, F8_WIN_MUL},
        {(const float*)ARG_IN(7), 0, (bf16_t*)(ws + WS_WQKV2) + (size_t)DM * DM / 2, 0, 1, DM, 256, 256, 0, F8_WIN_MUL},
        {(const float*)ARG_IN(8) + (size_t)DM * DM, 0, (bf16_t*)(ws + WS_WQB1), 0, 1, DM, DM, DM, 0, F8_WIN_MUL},
        {(const float*)ARG_IN(9), (size_t)DM * DM, (bf16_t*)(ws + WS_WOUTB), (size_t)DM * DM / 2, 2, DM, DM, DM, 0, F8_WIN_MUL},
        {(const float*)ARG_IN(13), (size_t)DM * 2 * DFF, (bf16_t*)(ws + WS_WDIN), (size_t)2 * DFF * DM, 2, DM, 2 * DFF, 2 * DFF, 1, 0.f},
        {(const float*)ARG_IN(14), (size_t)DFF * DM, (bf16_t*)(ws + WS_WDOUT), (size_t)DM * DFF, 2, DFF, DM, DM, 0, 0.f},
        {(const float*)ARG_IN(16), (size_t)DM * 2 * DFFE, (bf16_t*)(ws + WS_WMIN), (size_t)DFFE * DM, 16, DM, 2 * DFFE, 2 * DFFE, 1, F8_WIN_MUL},
    };
    const WFam famo = {(const float*)ARG_IN(17), (size_t)DFFE * DM, (bf16_t*)(ws + WS_WMOUT), (size_t)DM * DFFE / 2, 16, DFFE, DM, DM, 0, F8_WOUT_MUL};
    int total = 0;
#pragma unroll
    for (int i = 0; i < 11; ++i) total += (fam[i].K / 64) * (fam[i].Npad / 32) * fam[i].count;
    total += (famo.K / 64) * (famo.Npad / 32) * famo.count;
    for (int it0 = gw; it0 < total; it0 += NGW) {
        int it = it0; bool done = false;
#pragma unroll
        for (int i = 0; i < 11; ++i) if (!done) done = wfam_do(fam[i], it, scr, F.lane);
        if (!done) wfam_do(famo, it, scr, F.lane);
    }
    { const float* x = (const float*)ARG_IN(0); bf16_t* hb = (bf16_t*)(ws + WS_HB);
      const size_t n8 = (size_t)MTOK * DM / 8;
      for (size_t i = (size_t)blockIdx.x * 512 + F.tid; i < n8; i += (size_t)F.G * 512) {
          const f32x4 v0 = *(const f32x4*)(x + i * 8), v1 = *(const f32x4*)(x + i * 8 + 4);
          u32x4 o; o.x = pk2(v0.x, v0.y); o.y = pk2(v0.z, v0.w); o.z = pk2(v1.x, v1.y); o.w = pk2(v1.z, v1.w);
          *(u32x4*)(hb + i * 8) = o;
          u32x2 o8; o8[0] = pack_fp8x4(v0.x, v0.y, v0.z, v0.w); o8[1] = pack_fp8x4(v1.x, v1.y, v1.z, v1.w); *(u32x2*)(ws + WS_HB8 + i * 8) = o8; } }
    { const int* pos = (const int*)ARG_IN(1); float* cs = (float*)(ws + WS_CS);
      for (int i = blockIdx.x * 512 + F.tid; i < MTOK * 8; i += F.G * 512) {
          const int tok = i >> 3, j = i & 7;
          const float invf = (float)exp2(-(double)j * (18.931568569324174 / 8.0));
          const double ang = (double)((float)pos[tok] * invf);
          const double n = rint(ang * 0.15915494309189535); const double r = ang - n * 6.283185307179586476925;
          const float rf = (float)r;
          cs[tok * 16 + j] = cosf(rf); cs[tok * 16 + 8 + j] = sinf(rf); } }
    { const float* cp = (const float*)ARG_IN(4); const float* w1 = (const float*)ARG_IN(5); float* bp = (float*)((unsigned*)(ws + WS_CTL) + CW_BIASP);
      if (gw < 1024) { const int mi = gw >> 8, c = gw & 255; float s = 0.f;
#pragma unroll 8
          for (int i = 0; i < 32; ++i) { const int f = i * 64 + F.lane; s += cp[(size_t)mi * 2048 + f] * w1[((size_t)mi * 2048 + f) * 256 + c]; }
          s = wave_sum(s, F.lane);
          if (F.lane == 0) bp[gw] = s; } }
}

typedef f32x4 AccT[2][2][4][2];

DEVI u32x4 pack8(const f32x4 a, const f32x4 b) { u32x4 w; w.x = pg8::cvt_pk_bf16(a[0], a[1]); w.y = pg8::cvt_pk_bf16(a[2], a[3]); w.z = pg8::cvt_pk_bf16(b[0], b[1]); w.w = pg8::cvt_pk_bf16(b[2], b[3]); return w; }
DEVI void rope8(f32x4& v0, f32x4& v1, int dhead, const float* csrow, int lane) {
    f32x4 p0, p1;
#pragma unroll
    for (int i = 0; i < 4; ++i) { p0[i] = shx(v0[i], 16, lane); p1[i] = shx(v1[i], 16, lane); }
    if (dhead < 16) {
        const f32x4 c0 = *(const f32x4*)(csrow), c1 = *(const f32x4*)(csrow + 4), s0 = *(const f32x4*)(csrow + 8), s1 = *(const f32x4*)(csrow + 12);
        if (dhead == 0) { v0 = v0 * c0 - p0 * s0; v1 = v1 * c1 - p1 * s1; }
        else            { v0 = v0 * c0 + p0 * s0; v1 = v1 * c1 + p1 * s1; }
    }
}

struct EpiNsaIn {
    static constexpr bool PERM = true;
    unsigned char* ws; const float* cs;
    DEVI void operator()(const AccT& acc, const pg8::Unit& u, int wr, int wc, int fr, int fq) const {
        const int pn = u.pn;
        if (pn < 4) {
            bf16_t* Q = (bf16_t*)(ws + RA_Q);
#pragma unroll
            for (int ai = 0; ai < 2; ++ai)
#pragma unroll
                for (int m = 0; m < 4; ++m) { const int row = u.pm * 256 + ai * 128 + wr * 64 + m * 16 + fr;
#pragma unroll
                    for (int bj = 0; bj < 2; ++bj) *(u32x4*)(Q + (size_t)row * DM + pn * 256 + bj * 128 + wc * 32 + fq * 8) = pack8(acc[ai][bj][m][0], acc[ai][bj][m][1]); }
        } else if (pn < 10) {
            const size_t base = pn == 4 ? RA_KCR : pn == 5 ? RA_VCR : pn == 6 ? RA_KS : pn == 7 ? RA_VS : pn == 8 ? RA_KW : RA_VW;
            bf16_t* T = (bf16_t*)(ws + base);
            const bool rot = (pn == 6 || pn == 8);
            const int dh = (wc & 1) * 32 + fq * 8;
#pragma unroll
            for (int ai = 0; ai < 2; ++ai)
#pragma unroll
                for (int m = 0; m < 4; ++m) { const int row = u.pm * 256 + ai * 128 + wr * 64 + m * 16 + fr; const int b = row / SEQ, t = row % SEQ;
#pragma unroll
                    for (int bj = 0; bj < 2; ++bj) { f32x4 v0 = acc[ai][bj][m][0], v1 = acc[ai][bj][m][1];
                        if (rot) rope8(v0, v1, dh, cs + (size_t)row * 16, fq * 16 + fr);
                        const int g = bj * 2 + (wc >> 1);
                        *(u32x4*)(T + ((size_t)(b * A_G + g) * SEQ + t) * HD + dh) = pack8(v0, v1); } }
        } else {
            float* G = (float*)(ws + RA_GATE);
            if (wc < 2) {
#pragma unroll
                for (int ai = 0; ai < 2; ++ai)
#pragma unroll
                    for (int m = 0; m < 4; ++m) { const int row = u.pm * 256 + ai * 128 + wr * 64 + m * 16 + fr;
#pragma unroll
                        for (int n = 0; n < 2; ++n) { const int c = wc * 32 + fq * 8 + n * 4;
                            if (c < 48) { f32x4 v = acc[ai][0][m][n]; f32x4 o;
#pragma unroll
                                for (int i = 0; i < 4; ++i) o[i] = 1.f / (1.f + __expf(-v[i]));
                                *(f32x4*)(G + (size_t)row * 48 + c) = o; } } }
            }
        }
    }
};
struct EpiSwaIn {
    static constexpr bool PERM = true;
    unsigned char* ws; const float* cs;
    DEVI void operator()(const AccT& acc, const pg8::Unit& u, int wr, int wc, int fr, int fq) const {
        const int pn = u.pn; const int dh = (wc & 1) * 32 + fq * 8;
        bf16_t* Q = (bf16_t*)(ws + RA_Q); bf16_t* KS = (bf16_t*)(ws + WS_KSH); bf16_t* VS = (bf16_t*)(ws + WS_VSH);
#pragma unroll
        for (int ai = 0; ai < 2; ++ai)
#pragma unroll
            for (int m = 0; m < 4; ++m) { const int row = u.pm * 256 + ai * 128 + wr * 64 + m * 16 + fr; const int b = row / SEQ, t = row % SEQ;
#pragma unroll
                for (int bj = 0; bj < 2; ++bj) { f32x4 v0 = acc[ai][bj][m][0], v1 = acc[ai][bj][m][1];
                    const bool rot = (pn < 4) || (bj == 0);
                    if (rot) rope8(v0, v1, dh, cs + (size_t)row * 16, fq * 16 + fr);
                    const u32x4 w = pack8(v0, v1);
                    if (pn < 4) *(u32x4*)(Q + (size_t)row * DM + pn * 256 + bj * 128 + wc * 32 + fq * 8) = w;
                    else { bf16_t* T = bj == 0 ? KS : VS; const int g = wc >> 1; *(u32x4*)(T + ((size_t)(b * B_G + g) * SEQ + t) * HD + dh) = w; } } }
    }
};
DEVI float gelu_tanh(float x) { const float u = 0.7978845608028654f * (x + 0.044715f * x * x * x); const float e = __expf(2.f * u); const float th = 1.f - 2.f / (e + 1.f); return 0.5f * x * (1.f + th); }
struct EpiCmpHid {
    static constexpr bool PERM = true;
    bf16_t* out; const float* bias;
    DEVI void operator()(const AccT& acc, const pg8::Unit& u, int wr, int wc, int fr, int fq) const {
        const float* bs = bias;
#pragma unroll
        for (int bj = 0; bj < 2; ++bj) { const int c = bj * 128 + wc * 32 + fq * 8; const f32x4 b0 = *(const f32x4*)(bs + c), b1 = *(const f32x4*)(bs + c + 4);
#pragma unroll
            for (int ai = 0; ai < 2; ++ai)
#pragma unroll
                for (int m = 0; m < 4; ++m) { const int row = u.pm * 256 + ai * 128 + wr * 64 + m * 16 + fr; f32x4 v0 = acc[ai][bj][m][0] + b0, v1 = acc[ai][bj][m][1] + b1;
#pragma unroll
                    for (int i = 0; i < 4; ++i) { v0[i] = gelu_tanh(v0[i]); v1[i] = gelu_tanh(v1[i]); }
                    *(u32x4*)(out + (size_t)row * 256 + c) = pack8(v0, v1); } }
    }
};
struct EpiCmpOut {
    static constexpr bool PERM = true;
    bf16_t* kc; bf16_t* vc;
    DEVI void operator()(const AccT& acc, const pg8::Unit& u, int wr, int wc, int fr, int fq) const {
        if (wc >= 2) return;
        bf16_t* T = u.pm >= 32 ? vc : kc; const int rbase = (u.pm & 31) * 256;
#pragma unroll
        for (int ai = 0; ai < 2; ++ai)
#pragma unroll
            for (int m = 0; m < 4; ++m) { const int row = rbase + ai * 128 + wr * 64 + m * 16 + fr;
                u32x4 w = pack8(acc[ai][0][m][0], acc[ai][0][m][1]);
                if ((row & 1023) == 1023) w = (u32x4){0u, 0u, 0u, 0u};
                *(u32x4*)(T + (size_t)row * 64 + wc * 32 + fq * 8) = w; }
    }
};
struct EpiResid {
    static constexpr bool PERM = true;
    const bf16_t* res; bf16_t* y;
    DEVI void operator()(const AccT& acc, const pg8::Unit& u, int wr, int wc, int fr, int fq) const {
#pragma unroll
        for (int ai = 0; ai < 2; ++ai)
#pragma unroll
            for (int m = 0; m < 4; ++m) { const size_t off = (size_t)(u.pm * 256 + ai * 128 + wr * 64 + m * 16 + fr) * DM + u.pn * 256 + wc * 32 + fq * 8;
#pragma unroll
                for (int bj = 0; bj < 2; ++bj) { const u32x4 r = *(const u32x4*)(res + off + bj * 128);
                    const f32x4 r0 = {bflo(r.x), bfhi(r.x), bflo(r.y), bfhi(r.y)}, r1 = {bflo(r.z), bfhi(r.z), bflo(r.w), bfhi(r.w)};
                    *(u32x4*)(y + off + bj * 128) = pack8(r0 * ALPHA + acc[ai][bj][m][0], r1 * ALPHA + acc[ai][bj][m][1]); } }
    }
};
struct EpiBf16Out {
    static constexpr bool PERM = true;
    bf16_t* y;
    DEVI void operator()(const AccT& acc, const pg8::Unit& u, int wr, int wc, int fr, int fq) const {
#pragma unroll
        for (int ai = 0; ai < 2; ++ai)
#pragma unroll
            for (int m = 0; m < 4; ++m) { const size_t off = (size_t)(u.pm * 256 + ai * 128 + wr * 64 + m * 16 + fr) * DM + u.pn * 256 + wc * 32 + fq * 8;
#pragma unroll
                for (int bj = 0; bj < 2; ++bj) *(u32x4*)(y + off + bj * 128) = pack8(acc[ai][bj][m][0], acc[ai][bj][m][1]); }
    }
};
struct EpiPart {
    static constexpr bool PERM = false;
    float* part;
    DEVI void operator()(const AccT& acc, const pg8::Unit& u, int wr, int wc, int fr, int fq) const {
        float* base = part + (size_t)((u.pm - 256) * 2 + u.z) * 256 * DM;
#pragma unroll
        for (int ai = 0; ai < 2; ++ai)
#pragma unroll
            for (int m = 0; m < 4; ++m) { const size_t off = (size_t)(ai * 128 + wr * 64 + m * 16 + fr) * DM + u.pn * 256 + wc * 32 + fq * 4;
#pragma unroll
                for (int bj = 0; bj < 2; ++bj)
#pragma unroll
                    for (int n = 0; n < 2; ++n) *(f32x4*)(base + off + bj * 128 + n * 16) = acc[ai][bj][m][n]; }
    }
};
struct EpiSwiglu {
    static constexpr bool PERM = true;
    bf16_t* act; int ld;
    DEVI void operator()(const AccT& acc, const pg8::Unit& u, int wr, int wc, int fr, int fq) const {
#pragma unroll
        for (int ai = 0; ai < 2; ++ai)
#pragma unroll
            for (int m = 0; m < 4; ++m) { const size_t row = (size_t)(u.pm * 256 + ai * 128 + wr * 64 + m * 16 + fr); f32x4 o[2];
#pragma unroll
                for (int n = 0; n < 2; ++n)
#pragma unroll
                    for (int i = 0; i < 4; ++i) { const float gv = acc[ai][0][m][n][i], uv = acc[ai][1][m][n][i]; o[n][i] = gv * __builtin_amdgcn_rcpf(1.f + __expf(-gv)) * uv; }
                *(u32x4*)(act + row * ld + u.pn * 128 + wc * 32 + fq * 8) = pack8(o[0], o[1]); }
    }
};

struct EpiSwiglu8 {
    static constexpr bool PERM = true;
    unsigned char* act; int ld;
    DEVI void operator()(const AccT& acc, const pg8::Unit& u, int wr, int wc, int fr, int fq) const {
#pragma unroll
        for (int ai = 0; ai < 2; ++ai)
#pragma unroll
            for (int m = 0; m < 4; ++m) { const size_t row = (size_t)(u.pm * 256 + ai * 128 + wr * 64 + m * 16 + fr); f32x4 o[2];
#pragma unroll
                for (int n = 0; n < 2; ++n)
#pragma unroll
                    for (int i = 0; i < 4; ++i) { const float gv = acc[ai][0][m][n][i], uv = acc[ai][1][m][n][i]; o[n][i] = gv * __builtin_amdgcn_rcpf(1.f + __expf(-gv)) * uv; }
                u32x2 w; w[0] = pack_fp8x4(o[0][0], o[0][1], o[0][2], o[0][3]); w[1] = pack_fp8x4(o[1][0], o[1][1], o[1][2], o[1][3]);
                *(u32x2*)(act + row * ld + u.pn * 128 + wc * 32 + fq * 8) = w; }
    }
};

DEVI void unpack8(const u32x4 w, float (&x)[8]) { x[0] = bflo(w.x); x[1] = bfhi(w.x); x[2] = bflo(w.y); x[3] = bfhi(w.y); x[4] = bflo(w.z); x[5] = bfhi(w.z); x[6] = bflo(w.w); x[7] = bfhi(w.w); }
DEVI void moe_row8(const bf16_t* YB, const float* PART, int p, int c, float (&x)[8]) {
    if (p < 65536) { unpack8(*(const u32x4*)(YB + (size_t)p * DM + c), x); return; }
    const float* q = PART + ((size_t)(((p >> 8) - 256) * 2) * 256 + (p & 255)) * DM + c;
    f32x4 a0 = *(const f32x4*)q, a1 = *(const f32x4*)(q + 4);
    a0 = a0 + *(const f32x4*)(q + (size_t)256 * DM); a1 = a1 + *(const f32x4*)(q + (size_t)256 * DM + 4);
    x[0] = a0[0]; x[1] = a0[1]; x[2] = a0[2]; x[3] = a0[3]; x[4] = a1[0]; x[5] = a1[1]; x[6] = a1[2]; x[7] = a1[3];
}
template <int MODE, bool ROUTER, bool FINAL>
DEVI void phase_ln(Frame& F, int lnidx, float* outp, int moe_layer) {
    F.refresh();
    unsigned char* ws = F.ws;
    const bf16_t* Y = (const bf16_t*)(ws + WS_Y); const bf16_t* YB = (const bf16_t*)(ws + WS_YB); const float* PART = (const float*)(ws + WS_H);
    bf16_t* HB = (bf16_t*)(ws + WS_HB);
    const float* gam = (const float*)ARG_IN(11) + (size_t)lnidx * DM; const float* bet = (const float*)ARG_IN(12) + (size_t)lnidx * DM;
    int* TOKE = (int*)(ws + WS_ROUTE); int* TOKR = TOKE + MTOK * 2; float* TOKW = (float*)(TOKR + MTOK * 2); int* TOKP = (int*)(TOKW + MTOK * 2);
    const float* wr_ = ROUTER ? (const float*)ARG_IN(15) + (size_t)moe_layer * DM * NEXP : nullptr;
    LAS int* lcnt = (LAS int*)(F.lds + LDS_X);
    LAS int* lrec = lcnt + 16;
    LAS int* lrank = lrec + 256;
    if (ROUTER) { if (F.tid < 16) lcnt[F.tid] = 0; __syncthreads(); }
    const int gw = F.vcu * NWAVES + F.wave, NGW = F.G * NWAVES;
    constexpr int RB = (MODE == 0) ? 4 : 2;
    const f32x4 g0_[2] = {*(const f32x4*)(gam + F.lane * 8), *(const f32x4*)(gam + 512 + F.lane * 8)}, g1_[2] = {*(const f32x4*)(gam + F.lane * 8 + 4), *(const f32x4*)(gam + 512 + F.lane * 8 + 4)};
    const f32x4 b0_[2] = {*(const f32x4*)(bet + F.lane * 8), *(const f32x4*)(bet + 512 + F.lane * 8)}, b1_[2] = {*(const f32x4*)(bet + F.lane * 8 + 4), *(const f32x4*)(bet + 512 + F.lane * 8 + 4)};
#pragma unroll 1
    for (int k0 = 0; k0 < 16; k0 += RB) {
        float v[RB][2][8];
        if (MODE == 0) {
            u32x4 raw[RB][2];
#pragma unroll
            for (int r = 0; r < RB; ++r)
#pragma unroll
                for (int j = 0; j < 2; ++j) raw[r][j] = *(const u32x4*)(Y + (size_t)(gw + (k0 + r) * NGW) * DM + j * 512 + F.lane * 8);
#pragma unroll
            for (int r = 0; r < RB; ++r)
#pragma unroll
                for (int j = 0; j < 2; ++j) unpack8(raw[r][j], v[r][j]);
        } else {
            int p0[RB], p1[RB]; float w0[RB], w1[RB];
#pragma unroll
            for (int r = 0; r < RB; ++r) { const int m = gw + (k0 + r) * NGW; p0[r] = TOKP[m * 2]; p1[r] = TOKP[m * 2 + 1]; w0[r] = TOKW[m * 2]; w1[r] = TOKW[m * 2 + 1]; }
            u32x4 hraw[RB][2];
#pragma unroll
            for (int r = 0; r < RB; ++r)
#pragma unroll
                for (int j = 0; j < 2; ++j) hraw[r][j] = *(const u32x4*)(HB + (size_t)(gw + (k0 + r) * NGW) * DM + j * 512 + F.lane * 8);
#pragma unroll
            for (int r = 0; r < RB; ++r)
#pragma unroll
                for (int j = 0; j < 2; ++j) { const int c = j * 512 + F.lane * 8; float h[8], a[8], b[8];
                    unpack8(hraw[r][j], h); moe_row8(YB, PART, p0[r], c, a); moe_row8(YB, PART, p1[r], c, b);
#pragma unroll
                    for (int i = 0; i < 8; ++i) v[r][j][i] = h[i] * ALPHA + a[i] * w0[r] + b[i] * w1[r]; }
        }
#pragma unroll
        for (int r = 0; r < RB; ++r) {
            const int m = gw + (k0 + r) * NGW;
            float s = 0.f;
#pragma unroll
            for (int j = 0; j < 2; ++j)
#pragma unroll
                for (int i = 0; i < 8; ++i) s += v[r][j][i];
            const float mean = wave_sum(s, F.lane) * (1.f / DM); float s2 = 0.f;
#pragma unroll
            for (int j = 0; j < 2; ++j)
#pragma unroll
                for (int i = 0; i < 8; ++i) { v[r][j][i] -= mean; s2 += v[r][j][i] * v[r][j][i]; }
            const float rstd = 1.f / sqrtf(wave_sum(s2, F.lane) * (1.f / DM) + LN_EPS);
#pragma unroll
            for (int j = 0; j < 2; ++j) { const int c = j * 512 + F.lane * 8;
#pragma unroll
                for (int i = 0; i < 4; ++i) { v[r][j][i] = v[r][j][i] * rstd * g0_[j][i] + b0_[j][i]; v[r][j][4 + i] = v[r][j][4 + i] * rstd * g1_[j][i] + b1_[j][i]; }
                if (FINAL) { *(f32x4*)(outp + (size_t)m * DM + c) = (f32x4){v[r][j][0], v[r][j][1], v[r][j][2], v[r][j][3]}; *(f32x4*)(outp + (size_t)m * DM + c + 4) = (f32x4){v[r][j][4], v[r][j][5], v[r][j][6], v[r][j][7]}; }
                else { u32x4 w; w.x = pk2(v[r][j][0], v[r][j][1]); w.y = pk2(v[r][j][2], v[r][j][3]); w.z = pk2(v[r][j][4], v[r][j][5]); w.w = pk2(v[r][j][6], v[r][j][7]); *(u32x4*)(HB + (size_t)m * DM + c) = w;
                    if (lnidx & 1) { u32x2 w8; w8[0] = pack_fp8x4(v[r][j][0], v[r][j][1], v[r][j][2], v[r][j][3]); w8[1] = pack_fp8x4(v[r][j][4], v[r][j][5], v[r][j][6], v[r][j][7]); *(u32x2*)(ws + WS_HB8 + (size_t)m * DM + c) = w8; } } }
            if (ROUTER) {
                float lg[NEXP];
#pragma unroll
                for (int e = 0; e < NEXP; ++e) lg[e] = 0.f;
#pragma unroll
                for (int j = 0; j < 2; ++j)
#pragma unroll
                    for (int i = 0; i < 8; ++i) { const int c = j * 512 + F.lane * 8 + i; const f32x4 w0 = *(const f32x4*)(wr_ + (size_t)c * NEXP), w1 = *(const f32x4*)(wr_ + (size_t)c * NEXP + 4); const float x = v[r][j][i];
                        lg[0] += x * w0.x; lg[1] += x * w0.y; lg[2] += x * w0.z; lg[3] += x * w0.w; lg[4] += x * w1.x; lg[5] += x * w1.y; lg[6] += x * w1.z; lg[7] += x * w1.w; }
#pragma unroll
                for (int e = 0; e < NEXP; ++e) lg[e] = wave_sum(lg[e], F.lane);
                int e0 = 0; float l0 = lg[0];
#pragma unroll
                for (int e = 1; e < NEXP; ++e) if (lg[e] > l0) { l0 = lg[e]; e0 = e; }
                int e1 = -1; float l1 = -3.4e38f;
#pragma unroll
                for (int e = 0; e < NEXP; ++e) if (e != e0 && lg[e] > l1) { l1 = lg[e]; e1 = e; }
                if (e1 < 0) e1 = (e0 + 1) & 7;
                const float g1 = 1.f / (1.f + __expf(l0 - l1)), g0 = 1.f - g1;
                if (F.lane == 0) {
                    const int idx = (F.wave * 16 + k0 + r) * 2;
                    lrec[idx] = m * 16 + e0; lrec[idx + 1] = m * 16 + e1;
                    TOKE[m * 2] = e0; TOKE[m * 2 + 1] = e1; TOKW[m * 2] = g0; TOKW[m * 2 + 1] = g1;
                }
            }
        }
    }
    if (ROUTER) {
        __syncthreads();
        unsigned* cnt = (unsigned*)(ws + WS_CTL) + CW_MOE + moe_layer * 64;
        int* wgcnt = (int*)(ws + WS_CTL) + CW_WGCNT + moe_layer * 2048 + (int)blockIdx.x * 8;
        LAS int* wcnt = lrank;
        int rec = 0, e = 0, r = 0;
        if (F.wave < 4) { rec = lrec[F.tid]; e = rec & 15;
            const unsigned long long lt = (1ull << F.lane) - 1ull;
#pragma unroll
            for (int x = 0; x < 8; ++x) { const unsigned long long b = __builtin_amdgcn_ballot_w64(e == x); if (e == x) r = __builtin_popcountll(b & lt); if (F.lane == 0) wcnt[F.wave * 8 + x] = __builtin_popcountll(b); } }
        __syncthreads();
        if (F.wave < 4) { for (int w = 0; w < F.wave; ++w) r += wcnt[w * 8 + e]; TOKR[(rec >> 4) * 2 + (F.tid & 1)] = r; }
        if (F.tid < 8) lcnt[F.tid] = wcnt[F.tid] + wcnt[8 + F.tid] + wcnt[16 + F.tid] + wcnt[24 + F.tid];
        __syncthreads();
        if (F.tid < 8) { wgcnt[F.tid] = lcnt[F.tid]; __hip_atomic_fetch_add(cnt + F.tid, (unsigned)lcnt[F.tid], __ATOMIC_RELAXED, __HIP_MEMORY_SCOPE_AGENT); }
    }
}

DEVI void moe_tiles(const unsigned* cnt, int (&ts)[9]) { ts[0] = 0;
#pragma unroll
    for (int e = 0; e < 8; ++e) ts[e + 1] = ts[e] + (int)((__hip_atomic_load(cnt + e, __ATOMIC_RELAXED, __HIP_MEMORY_SCOPE_AGENT) + 255u) >> 8); }
DEVI void phase_moe_scatter(Frame& F, int moe_layer) {
    F.refresh();
    unsigned char* ws = F.ws;
    const unsigned* cnt = (const unsigned*)(ws + WS_CTL) + CW_MOE + moe_layer * 64;
    int ts[9]; moe_tiles(cnt, ts);
    LAS int* wbase = (LAS int*)(F.lds + LDS_X);
    if (F.tid < 8) wbase[F.tid] = 0;
    __syncthreads();
    if (F.tid < (int)blockIdx.x) { const int* wc = (const int*)(ws + WS_CTL) + CW_WGCNT + moe_layer * 2048 + F.tid * 8;
        const u32x4 c0 = *(const u32x4*)wc, c1 = *(const u32x4*)(wc + 4);
#pragma unroll
        for (int e = 0; e < 4; ++e) { __hip_atomic_fetch_add(wbase + e, (int)c0[e], __ATOMIC_RELAXED, __HIP_MEMORY_SCOPE_WORKGROUP); __hip_atomic_fetch_add(wbase + 4 + e, (int)c1[e], __ATOMIC_RELAXED, __HIP_MEMORY_SCOPE_WORKGROUP); } }
    __syncthreads();
    const int* TOKE = (const int*)(ws + WS_ROUTE); const int* TOKR = TOKE + MTOK * 2; int* TOKP = (int*)(ws + WS_ROUTE) + MTOK * 6;
    const bf16_t* HB = (const bf16_t*)(ws + WS_HB); unsigned char* XB = ws + WS_XB;
    const int gw = F.vcu * NWAVES + F.wave, NGW = F.G * NWAVES;
#pragma unroll 1
    for (int k0 = 0; k0 < 16; k0 += 4) {
        u32x4 r0[4], r1[4]; int ee[4][2], rk[4][2];
#pragma unroll
        for (int q = 0; q < 4; ++q) { const int m = gw + (k0 + q) * NGW; r0[q] = *(const u32x4*)(HB + (size_t)m * DM + F.lane * 8); r1[q] = *(const u32x4*)(HB + (size_t)m * DM + 512 + F.lane * 8);
            ee[q][0] = TOKE[m * 2]; ee[q][1] = TOKE[m * 2 + 1]; rk[q][0] = TOKR[m * 2]; rk[q][1] = TOKR[m * 2 + 1]; }
#pragma unroll
        for (int q = 0; q < 4; ++q) { const int m = gw + (k0 + q) * NGW;
            u32x2 a8, b8; a8[0] = pack_fp8x4(bflo(r0[q][0]), bfhi(r0[q][0]), bflo(r0[q][1]), bfhi(r0[q][1])); a8[1] = pack_fp8x4(bflo(r0[q][2]), bfhi(r0[q][2]), bflo(r0[q][3]), bfhi(r0[q][3]));
            b8[0] = pack_fp8x4(bflo(r1[q][0]), bfhi(r1[q][0]), bflo(r1[q][1]), bfhi(r1[q][1])); b8[1] = pack_fp8x4(bflo(r1[q][2]), bfhi(r1[q][2]), bflo(r1[q][3]), bfhi(r1[q][3]));
#pragma unroll
            for (int k = 0; k < 2; ++k) { const int e = ee[q][k], r = rk[q][k];
                int st = 0;
#pragma unroll
                for (int j = 1; j < 8; ++j) st = (e >= j) ? ts[j] : st;
                const int pos = st * 256 + wbase[e] + r;
                *(u32x2*)(XB + (size_t)pos * DM + F.lane * 8) = a8; *(u32x2*)(XB + (size_t)pos * DM + 512 + F.lane * 8) = b8;
                if (F.lane == 0) TOKP[m * 2 + k] = pos; } }
    }
}

DEVI void phase_nsa_naive(Frame& F) {
    F.refresh();
    unsigned char* ws = F.ws;
    const bf16_t* Q = (const bf16_t*)(ws + RA_Q); bf16_t* ATT = (bf16_t*)(ws + RA_ATT);
    const bf16_t* KC = (const bf16_t*)(ws + RA_KC); const bf16_t* VC = (const bf16_t*)(ws + RA_VC);
    const bf16_t* KS = (const bf16_t*)(ws + RA_KS); const bf16_t* VS = (const bf16_t*)(ws + RA_VS);
    const bf16_t* KW = (const bf16_t*)(ws + RA_KW); const bf16_t* VW = (const bf16_t*)(ws + RA_VW);
    const float* GT = (const float*)(ws + RA_GATE); const float* CS = (const float*)(ws + WS_CS);
    LAS float* sc = (LAS float*)(F.lds + F.wave * 16384);
    LAS float* qs_ = (LAS float*)(F.lds + LDS_X + F.wave * 2048);
    LAS float* qr_ = qs_ + 256;
    const int lane = F.lane;
    const int gw = F.vcu * NWAVES + F.wave, NGW = F.G * NWAVES;
    for (int u = gw; u < MTOK * A_G; u += NGW) {
        const int bg = u / SEQ, t = u % SEQ, b = bg / A_G, g = bg % A_G; const int tok = b * SEQ + t;
        { const bf16_t* qp = Q + (size_t)tok * DM + g * 256 + lane * 4; const u32x2 w = *(const u32x2*)qp;
          float x[4] = {bflo(w.x), bfhi(w.x), bflo(w.y), bfhi(w.y)};
#pragma unroll
          for (int i = 0; i < 4; ++i) qs_[lane * 4 + i] = x[i];
          LDS_WAIT();
          const int d0 = (lane * 4) & 63;
#pragma unroll
          for (int i = 0; i < 4; ++i) { const int d = d0 + i; float v = x[i];
              if (d < 8) v = x[i] * CS[(size_t)tok * 16 + d] - qs_[lane * 4 + i + 8] * CS[(size_t)tok * 16 + 8 + d];
              else if (d < 16) v = x[i] * CS[(size_t)tok * 16 + d - 8] + qs_[lane * 4 + i - 8] * CS[(size_t)tok * 16 + d];
              qr_[lane * 4 + i] = v; }
          LDS_WAIT(); }
        float oc[4] = {0.f, 0.f, 0.f, 0.f}, os[4] = {0.f, 0.f, 0.f, 0.f}, ow[4] = {0.f, 0.f, 0.f, 0.f};
        const int cur = t >> 6;
        const int nv = t >= 31 ? ((t - 31) >> 4) + 1 : 0;
        float impv[4] = {0.f, 0.f, 0.f, 0.f};
        if (nv > 0) {
            const bf16_t* kc = KC + (size_t)bg * 1024 * 64; const bf16_t* vc = VC + (size_t)bg * 1024 * 64;
            float mx[4] = {-3.0e38f, -3.0e38f, -3.0e38f, -3.0e38f};
            for (int c = 0; c * 64 < nv; ++c) { const int n = c * 64 + lane;
                if (n < nv) { float s[4] = {0.f, 0.f, 0.f, 0.f}; LAS float* qs = qs_; asm volatile("" : "+v"(qs));
#pragma unroll 2
                    for (int d8 = 0; d8 < 8; ++d8) { const u32x4 w = *(const u32x4*)(kc + (size_t)n * 64 + d8 * 8);
                        const float kf[8] = {bflo(w.x), bfhi(w.x), bflo(w.y), bfhi(w.y), bflo(w.z), bfhi(w.z), bflo(w.w), bfhi(w.w)};
#pragma unroll
                        for (int r = 0; r < 4; ++r) { const f32x4 qa = *(const LAS f32x4*)(qs + r * 64 + d8 * 8), qb = *(const LAS f32x4*)(qs + r * 64 + d8 * 8 + 4);
                            s[r] += qa.x * kf[0] + qa.y * kf[1] + qa.z * kf[2] + qa.w * kf[3] + qb.x * kf[4] + qb.y * kf[5] + qb.z * kf[6] + qb.w * kf[7]; } }
#pragma unroll
                    for (int r = 0; r < 4; ++r) { s[r] *= QSCALE; mx[r] = fmaxf(mx[r], s[r]); }
                    *(LAS f32x4*)(sc + n * 4) = (f32x4){s[0], s[1], s[2], s[3]}; } }
            float l[4] = {0.f, 0.f, 0.f, 0.f};
#pragma unroll
            for (int r = 0; r < 4; ++r) mx[r] = wave_max(mx[r], lane);
            LDS_WAIT();
            for (int c = 0; c * 64 < nv; ++c) { const int n = c * 64 + lane;
                if (n < nv) { f32x4 s = *(const LAS f32x4*)(sc + n * 4);
#pragma unroll
                    for (int r = 0; r < 4; ++r) { s[r] = __expf(s[r] - mx[r]); l[r] += s[r]; }
                    *(LAS f32x4*)(sc + n * 4) = s; } }
#pragma unroll
            for (int r = 0; r < 4; ++r) l[r] = 1.f / wave_sum(l[r], lane);
            LDS_WAIT();
            for (int c = 0; c * 64 < nv; ++c) { const int n = c * 64 + lane;
                if (n < nv) { f32x4 s = *(const LAS f32x4*)(sc + n * 4);
#pragma unroll
                    for (int r = 0; r < 4; ++r) s[r] *= l[r];
                    *(LAS f32x4*)(sc + n * 4) = s; } }
            LDS_WAIT();
#pragma unroll 4
            for (int n = 0; n < nv; ++n) { const float v = bf2f(vc[(size_t)n * 64 + lane]); const f32x4 p = *(const LAS f32x4*)(sc + n * 4);
#pragma unroll
                for (int r = 0; r < 4; ++r) oc[r] += p[r] * v; }
#pragma unroll
            for (int i = 0; i < 4; ++i) { const int j = lane + 64 * i; float acc = 0.f;
#pragma unroll
                for (int k = -1; k <= 3; ++k) { const int n = 4 * j + k; if (n >= 0 && n < nv) { const f32x4 p = *(const LAS f32x4*)(sc + n * 4); const float ps = (p.x + p.y) + (p.z + p.w); acc += (k == -1 || k == 3) ? 0.5f * ps : ps; } }
                impv[i] = acc; }
        }
        float scv[4];
#pragma unroll
        for (int i = 0; i < 4; ++i) { const int j = lane + 64 * i; scv[i] = j > cur ? -1.f : ((j == 0 || j == cur || j == cur - 1) ? 1e9f : impv[i]); }
        LAS int* sel = (LAS int*)(F.lds + MISC_OFF + 256) + F.wave * 16;
#pragma unroll 1
        for (int k = 0; k < NSEL; ++k) {
            float bv = -2.f; int bi = 1 << 20;
#pragma unroll
            for (int i = 0; i < 4; ++i) { const int j = lane + 64 * i; if (scv[i] > bv) { bv = scv[i]; bi = j; } }
#pragma unroll
            for (int o = 1; o < 64; o <<= 1) { const float ov = shx(bv, o, lane); const int oi = shxi(bi, o, lane); if (ov > bv || (ov == bv && oi < bi)) { bv = ov; bi = oi; } }
            if (lane == 0) sel[k] = bi;
#pragma unroll
            for (int i = 0; i < 4; ++i) if (lane + 64 * i == bi) scv[i] = -3.f;
        }
        LDS_WAIT();
        {   const bf16_t* ks = KS + (size_t)bg * SEQ * 64; const bf16_t* vs = VS + (size_t)bg * SEQ * 64;
            float mx[4] = {-3.0e38f, -3.0e38f, -3.0e38f, -3.0e38f};
#pragma unroll 1
            for (int k = 0; k < NSEL; ++k) { const int pos = sel[k] * 64 + lane; const bool ok = pos <= t;
                float s[4] = {-1e30f, -1e30f, -1e30f, -1e30f};
                if (ok) { LAS float* qr = qr_; asm volatile("" : "+v"(qr));
#pragma unroll
                    for (int r = 0; r < 4; ++r) s[r] = 0.f;
#pragma unroll 2
                    for (int d8 = 0; d8 < 8; ++d8) { const u32x4 w = *(const u32x4*)(ks + (size_t)pos * 64 + d8 * 8);
                        const float kf[8] = {bflo(w.x), bfhi(w.x), bflo(w.y), bfhi(w.y), bflo(w.z), bfhi(w.z), bflo(w.w), bfhi(w.w)};
#pragma unroll
                        for (int r = 0; r < 4; ++r) { const f32x4 qa = *(const LAS f32x4*)(qr + r * 64 + d8 * 8), qb = *(const LAS f32x4*)(qr + r * 64 + d8 * 8 + 4);
                            s[r] += qa.x * kf[0] + qa.y * kf[1] + qa.z * kf[2] + qa.w * kf[3] + qb.x * kf[4] + qb.y * kf[5] + qb.z * kf[6] + qb.w * kf[7]; } }
#pragma unroll
                    for (int r = 0; r < 4; ++r) { s[r] *= QSCALE; mx[r] = fmaxf(mx[r], s[r]); } }
                *(LAS f32x4*)(sc + (k * 64 + lane) * 4) = (f32x4){s[0], s[1], s[2], s[3]}; }
            float l[4] = {0.f, 0.f, 0.f, 0.f};
#pragma unroll
            for (int r = 0; r < 4; ++r) mx[r] = wave_max(mx[r], lane);
            LDS_WAIT();
#pragma unroll 1
            for (int k = 0; k < NSEL; ++k) { const int pos = sel[k] * 64 + lane; const bool ok = pos <= t; f32x4 s = *(const LAS f32x4*)(sc + (k * 64 + lane) * 4);
#pragma unroll
                for (int r = 0; r < 4; ++r) { s[r] = ok ? __expf(s[r] - mx[r]) : 0.f; l[r] += s[r]; }
                *(LAS f32x4*)(sc + (k * 64 + lane) * 4) = s; }
#pragma unroll
            for (int r = 0; r < 4; ++r) l[r] = 1.f / wave_sum(l[r], lane);
            LDS_WAIT();
#pragma unroll 1
            for (int k = 0; k < NSEL; ++k) { const int p0 = sel[k] * 64; if (p0 > t) continue;
#pragma unroll 4
                for (int i = 0; i < 64; ++i) { const int pos = p0 + i; if (pos > t) break; const float v = bf2f(vs[(size_t)pos * 64 + lane]); const f32x4 p = *(const LAS f32x4*)(sc + (k * 64 + i) * 4);
#pragma unroll
                    for (int r = 0; r < 4; ++r) os[r] += p[r] * v; } }
#pragma unroll
            for (int r = 0; r < 4; ++r) os[r] *= l[r];
            LDS_WAIT();
        }
        {   const bf16_t* kw = KW + (size_t)bg * SEQ * 64; const bf16_t* vw = VW + (size_t)bg * SEQ * 64;
            float mx[4] = {-3.0e38f, -3.0e38f, -3.0e38f, -3.0e38f};
#pragma unroll 1
            for (int c = 0; c < 8; ++c) { const int pos = t - 511 + c * 64 + lane; const bool ok = pos >= 0;
                float s[4] = {-1e30f, -1e30f, -1e30f, -1e30f};
                if (ok) { LAS float* qr = qr_; asm volatile("" : "+v"(qr));
#pragma unroll
                    for (int r = 0; r < 4; ++r) s[r] = 0.f;
#pragma unroll 2
                    for (int d8 = 0; d8 < 8; ++d8) { const u32x4 w = *(const u32x4*)(kw + (size_t)pos * 64 + d8 * 8);
                        const float kf[8] = {bflo(w.x), bfhi(w.x), bflo(w.y), bfhi(w.y), bflo(w.z), bfhi(w.z), bflo(w.w), bfhi(w.w)};
#pragma unroll
                        for (int r = 0; r < 4; ++r) { const f32x4 qa = *(const LAS f32x4*)(qr + r * 64 + d8 * 8), qb = *(const LAS f32x4*)(qr + r * 64 + d8 * 8 + 4);
                            s[r] += qa.x * kf[0] + qa.y * kf[1] + qa.z * kf[2] + qa.w * kf[3] + qb.x * kf[4] + qb.y * kf[5] + qb.z * kf[6] + qb.w * kf[7]; } }
#pragma unroll
                    for (int r = 0; r < 4; ++r) { s[r] *= QSCALE; mx[r] = fmaxf(mx[r], s[r]); } }
                *(LAS f32x4*)(sc + (c * 64 + lane) * 4) = (f32x4){s[0], s[1], s[2], s[3]}; }
            float l[4] = {0.f, 0.f, 0.f, 0.f};
#pragma unroll
            for (int r = 0; r < 4; ++r) mx[r] = wave_max(mx[r], lane);
            LDS_WAIT();
#pragma unroll 1
            for (int c = 0; c < 8; ++c) { const int pos = t - 511 + c * 64 + lane; const bool ok = pos >= 0; f32x4 s = *(const LAS f32x4*)(sc + (c * 64 + lane) * 4);
#pragma unroll
                for (int r = 0; r < 4; ++r) { s[r] = ok ? __expf(s[r] - mx[r]) : 0.f; l[r] += s[r]; }
                *(LAS f32x4*)(sc + (c * 64 + lane) * 4) = s; }
#pragma unroll
            for (int r = 0; r < 4; ++r) l[r] = 1.f / wave_sum(l[r], lane);
            LDS_WAIT();
#pragma unroll 4
            for (int i = (t >= 511 ? 0 : 511 - t); i < 512; ++i) { const int pos = t - 511 + i; const float v = bf2f(vw[(size_t)pos * 64 + lane]); const f32x4 p = *(const LAS f32x4*)(sc + i * 4);
#pragma unroll
                for (int r = 0; r < 4; ++r) ow[r] += p[r] * v; }
#pragma unroll
            for (int r = 0; r < 4; ++r) ow[r] *= l[r];
            LDS_WAIT();
        }
#pragma unroll
        for (int r = 0; r < 4; ++r) { const float gc = GT[(size_t)tok * 48 + 0 * 16 + g * 4 + r], gs = GT[(size_t)tok * 48 + 1 * 16 + g * 4 + r], gwv = GT[(size_t)tok * 48 + 2 * 16 + g * 4 + r];
            const float o = ((DBG_DROP & 1) ? 0.f : gc * oc[r]) + ((DBG_DROP & 2) ? 0.f : gs * os[r]) + ((DBG_DROP & 4) ? 0.f : gwv * ow[r]);
            ATT[(size_t)tok * DM + g * 256 + r * 64 + lane] = (bf16_t)f2bf(o); }
    }
}

DEVI void phase_swa_naive(Frame& F, const float* sinks) {
    F.refresh();
    unsigned char* ws = F.ws;
    const bf16_t* Q = (const bf16_t*)(ws + RA_Q); bf16_t* ATT = (bf16_t*)(ws + RA_ATT);
    const bf16_t* KS = (const bf16_t*)(ws + WS_KSH); const bf16_t* VS = (const bf16_t*)(ws + WS_VSH);
    LAS float* sc = (LAS float*)(F.lds + F.wave * 16384);
    LAS float* qs_ = (LAS float*)(F.lds + LDS_X + F.wave * 2048);
    const int lane = F.lane;
    const int gw = F.vcu * NWAVES + F.wave, NGW = F.G * NWAVES;
    for (int u = gw; u < MTOK * B_G; u += NGW) {
        const int bg = u / SEQ, t = u % SEQ, b = bg / B_G, g = bg % B_G; const int tok = b * SEQ + t;
        { const u32x4 w = *(const u32x4*)(Q + (size_t)tok * DM + g * 512 + lane * 8);
          const float x[8] = {bflo(w.x), bfhi(w.x), bflo(w.y), bfhi(w.y), bflo(w.z), bfhi(w.z), bflo(w.w), bfhi(w.w)};
#pragma unroll
          for (int i = 0; i < 8; ++i) qs_[lane * 8 + i] = x[i];
          LDS_WAIT(); }
        const bf16_t* kp = KS + (size_t)bg * SEQ * 64; const bf16_t* vp = VS + (size_t)bg * SEQ * 64;
        float mx[8], l[8], o[8];
#pragma unroll
        for (int r = 0; r < 8; ++r) { mx[r] = sinks[g * 8 + r]; l[r] = 0.f; o[r] = 0.f; }
#pragma unroll 1
        for (int c = 0; c < 2; ++c) { const int pos = t - 127 + c * 64 + lane; const bool ok = pos >= 0;
            float s[8];
#pragma unroll
            for (int r = 0; r < 8; ++r) s[r] = -1e30f;
            if (ok) { LAS float* qs = qs_; asm volatile("" : "+v"(qs));
#pragma unroll
                for (int r = 0; r < 8; ++r) s[r] = 0.f;
#pragma unroll 1
                for (int d8 = 0; d8 < 8; ++d8) { const u32x4 w = *(const u32x4*)(kp + (size_t)pos * 64 + d8 * 8);
                    const float kf[8] = {bflo(w.x), bfhi(w.x), bflo(w.y), bfhi(w.y), bflo(w.z), bfhi(w.z), bflo(w.w), bfhi(w.w)};
#pragma unroll
                    for (int r = 0; r < 8; ++r) { const f32x4 qa = *(const LAS f32x4*)(qs + r * 64 + d8 * 8), qb = *(const LAS f32x4*)(qs + r * 64 + d8 * 8 + 4);
                        s[r] += qa.x * kf[0] + qa.y * kf[1] + qa.z * kf[2] + qa.w * kf[3] + qb.x * kf[4] + qb.y * kf[5] + qb.z * kf[6] + qb.w * kf[7]; } }
#pragma unroll
                for (int r = 0; r < 8; ++r) { s[r] *= QSCALE; mx[r] = fmaxf(mx[r], s[r]); } }
            *(LAS f32x4*)(sc + (c * 64 + lane) * 8) = (f32x4){s[0], s[1], s[2], s[3]}; *(LAS f32x4*)(sc + (c * 64 + lane) * 8 + 4) = (f32x4){s[4], s[5], s[6], s[7]}; }
#pragma unroll
        for (int r = 0; r < 8; ++r) mx[r] = wave_max(mx[r], lane);
        LDS_WAIT();
#pragma unroll
        for (int c = 0; c < 2; ++c) { const int pos = t - 127 + c * 64 + lane; const bool ok = pos >= 0;
            f32x4 s0 = *(const LAS f32x4*)(sc + (c * 64 + lane) * 8), s1 = *(const LAS f32x4*)(sc + (c * 64 + lane) * 8 + 4);
#pragma unroll
            for (int r = 0; r < 4; ++r) { s0[r] = ok ? __expf(s0[r] - mx[r]) : 0.f; l[r] += s0[r]; s1[r] = ok ? __expf(s1[r] - mx[r + 4]) : 0.f; l[r + 4] += s1[r]; }
            *(LAS f32x4*)(sc + (c * 64 + lane) * 8) = s0; *(LAS f32x4*)(sc + (c * 64 + lane) * 8 + 4) = s1; }
#pragma unroll
        for (int r = 0; r < 8; ++r) l[r] = 1.f / (wave_sum(l[r], lane) + __expf(sinks[g * 8 + r] - mx[r]));
        LDS_WAIT();
#pragma unroll 4
        for (int i = (t >= 127 ? 0 : 127 - t); i < 128; ++i) { const int pos = t - 127 + i; const float v = bf2f(vp[(size_t)pos * 64 + lane]);
            const f32x4 p0 = *(const LAS f32x4*)(sc + i * 8), p1 = *(const LAS f32x4*)(sc + i * 8 + 4);
#pragma unroll
            for (int r = 0; r < 4; ++r) { o[r] += p0[r] * v; o[r + 4] += p1[r] * v; } }
#pragma unroll
        for (int r = 0; r < 8; ++r) ATT[(size_t)tok * DM + g * 512 + r * 64 + lane] = (bf16_t)f2bf(o[r] * l[r]);
        LDS_WAIT();
    }
}

namespace fa {
typedef short v4i16_t __attribute__((ext_vector_type(4)));
constexpr float CEXP = 0.125f * 1.4426950408889634f;
constexpr float NEGINF = -__builtin_huge_valf();
constexpr int VLD = 160;
constexpr int KVB = 8192 + 64 * VLD;
constexpr int L_KV = 0;
constexpr int L_IMP = 2 * KVB;
constexpr int IMP_LD = 264;
constexpr int OS_LD = 65;
constexpr int L_Q = L_IMP + 64 * IMP_LD * 4;
constexpr int L_ML = L_Q + 32768;
constexpr int L_MASK = L_ML + 2048;
constexpr int L_LIST = L_MASK + 2048;
constexpr int L_TOK = L_LIST + 1056;
constexpr int L_END = L_TOK + 2048;
static_assert(256 * OS_LD * 4 <= 64 * IMP_LD * 4, "accumulator fits the importance table");
static_assert(L_END <= MISC_OFF, "attention LDS map");

struct Stage { u32x4 k, v; };
template <bool WITHV> DEVI void stage_load(Stage& s, const bf16_t* K, const bf16_t* V, int tid) { s.k = *(const u32x4*)((const char*)K + tid * 16); if (WITHV) s.v = *(const u32x4*)((const char*)V + tid * 16); }
template <bool WITHV> DEVI void stage_write(const Stage& s, LAS unsigned char* buf, int tid) {
    const int r = tid >> 3, c = tid & 7;
    *(LAS u32x4*)(buf + r * 128 + ((c ^ (r & 7)) << 4)) = s.k;
    if (WITHV) *(LAS u32x4*)(buf + 8192 + r * VLD + (c << 4)) = s.v;
}
DEVI float max_quads(float x) {
    auto a = __builtin_amdgcn_permlane16_swap(__float_as_uint(x), __float_as_uint(x), false, false); x = fmaxf(__uint_as_float(a[0]), __uint_as_float(a[1]));
    auto b = __builtin_amdgcn_permlane32_swap(__float_as_uint(x), __float_as_uint(x), false, false); return fmaxf(__uint_as_float(b[0]), __uint_as_float(b[1]));
}
DEVI float sum_quads(float x) {
    auto a = __builtin_amdgcn_permlane16_swap(__float_as_uint(x), __float_as_uint(x), false, false); x = __uint_as_float(a[0]) + __uint_as_float(a[1]);
    auto b = __builtin_amdgcn_permlane32_swap(__float_as_uint(x), __float_as_uint(x), false, false); return __uint_as_float(b[0]) + __uint_as_float(b[1]);
}
template <int CTRL> DEVI float dppf(float v) { return __int_as_float(__builtin_amdgcn_update_dpp(0, __float_as_int(v), CTRL, 0xF, 0xF, false)); }
template <int CTRL> DEVI int dppi(int v) { return __builtin_amdgcn_update_dpp(0, v, CTRL, 0xF, 0xF, false); }
DEVI float bperm(float v, int src_lane) { return __builtin_bit_cast(float, __builtin_amdgcn_ds_bpermute(src_lane << 2, __builtin_bit_cast(int, v))); }
#define DPP_X1 0xB1
#define DPP_X2 0x4E
#define DPP_HM 0x141

DEVI void qk_slot(LAS const unsigned char* kb, const bf16x8 q0, const bf16x8 q1, int lane, f32x4 (&s)[4]) {
    const int l15 = lane & 15, quad = lane >> 4;
    LAS const unsigned char* p0 = kb + l15 * 128 + (((quad) ^ (l15 & 7)) << 4);
    LAS const unsigned char* p1 = kb + l15 * 128 + (((4 + quad) ^ (l15 & 7)) << 4);
#pragma unroll
    for (int kg = 0; kg < 4; ++kg) {
        const bf16x8 a0 = *(LAS const bf16x8*)(p0 + kg * 2048), a1 = *(LAS const bf16x8*)(p1 + kg * 2048);
        f32x4 z = {0.f, 0.f, 0.f, 0.f};
        z = __builtin_amdgcn_mfma_f32_16x16x32_bf16(a0, q0, z, 0, 0, 0);
        s[kg] = __builtin_amdgcn_mfma_f32_16x16x32_bf16(a1, q1, z, 0, 0, 0);
    }
}
DEVI float mask_max(f32x4 (&s)[4], int lo, int hi, int quad) {
    float mx = NEGINF; const int loq = lo - 4 * quad, hiq = hi - 4 * quad;
#pragma unroll
    for (int kg = 0; kg < 4; ++kg)
#pragma unroll
        for (int i = 0; i < 4; ++i) { const bool ok = (16 * kg + i >= loq) & (16 * kg + i <= hiq); s[kg][i] = ok ? s[kg][i] : NEGINF; mx = fmaxf(mx, s[kg][i]); }
    return max_quads(mx);
}
DEVI bf16x8 pack_p(const f32x4 a, const f32x4 b) { u32x4 w; w.x = pg8::cvt_pk_bf16(a[0], a[1]); w.y = pg8::cvt_pk_bf16(a[2], a[3]); w.z = pg8::cvt_pk_bf16(b[0], b[1]); w.w = pg8::cvt_pk_bf16(b[2], b[3]); return __builtin_bit_cast(bf16x8, w); }
DEVI void pv_slot(LAS const unsigned char* vb, const bf16x8 (&pb)[2], f32x4 (&o)[4], int lane) {
    const int i = lane & 15, quad = lane >> 4;
    LAS const unsigned char* a0 = vb + (4 * quad + (i >> 2)) * VLD + ((i & 3) << 3);
#pragma unroll
    for (int ks2 = 0; ks2 < 2; ++ks2) {
#pragma unroll
        for (int dg = 0; dg < 4; ++dg) {
            const v4i16_t t0 = __builtin_amdgcn_ds_read_tr16_b64_v4i16((LAS v4i16_t*)(a0 + (32 * ks2) * VLD + 32 * dg));
            const v4i16_t t1 = __builtin_amdgcn_ds_read_tr16_b64_v4i16((LAS v4i16_t*)(a0 + (32 * ks2 + 16) * VLD + 32 * dg));
            const bf16x8 a = {t0[0], t0[1], t0[2], t0[3], t1[0], t1[1], t1[2], t1[3]};
            o[dg] = __builtin_amdgcn_mfma_f32_16x16x32_bf16(a, pb[ks2], o[dg], 0, 0, 0);
        }
    }
}
template <bool PV> DEVI void online_step(LAS const unsigned char* buf, const bf16x8 q0, const bf16x8 q1, int lo, int hi, float& m, float& l, f32x4 (&o)[4], int lane) {
    __builtin_amdgcn_sched_barrier(0);
    f32x4 s[4]; qk_slot(buf, q0, q1, lane, s);
    __builtin_amdgcn_sched_barrier(0);
    const int quad = lane >> 4;
    float mx;
    if (__builtin_amdgcn_ballot_w64((lo > 0) | (hi < 63)) != 0ull) mx = mask_max(s, lo, hi, quad);
    else { float a = fmaxf(fmaxf(s[0][0], s[0][1]), fmaxf(s[0][2], s[0][3])), b = fmaxf(fmaxf(s[1][0], s[1][1]), fmaxf(s[1][2], s[1][3]));
           a = fmaxf(a, fmaxf(fmaxf(s[2][0], s[2][1]), fmaxf(s[2][2], s[2][3]))); b = fmaxf(b, fmaxf(fmaxf(s[3][0], s[3][1]), fmaxf(s[3][2], s[3][3]))); mx = max_quads(fmaxf(a, b)); }
    const float mnew = fmaxf(m, mx);
    const float msafe = (mnew == NEGINF) ? 0.f : mnew;
    const float alpha = __builtin_amdgcn_exp2f((m - msafe) * CEXP);
    const float mc = -msafe * CEXP;
    float ps = 0.f;
#pragma unroll
    for (int kg = 0; kg < 4; ++kg)
#pragma unroll
        for (int i = 0; i < 4; ++i) { s[kg][i] = __builtin_amdgcn_exp2f(__builtin_fmaf(s[kg][i], CEXP, mc)); ps += s[kg][i]; }
    l = l * alpha + ps; m = mnew;
    if (PV) {
        if (__builtin_amdgcn_ballot_w64(alpha != 1.f) != 0ull) {
#pragma unroll
            for (int dg = 0; dg < 4; ++dg) o[dg] = o[dg] * alpha;
        }
        bf16x8 pb[2]; pb[0] = pack_p(s[0], s[1]); pb[1] = pack_p(s[2], s[3]);
        pv_slot(buf + 8192, pb, o, lane);
    }
    __builtin_amdgcn_sched_barrier(0);
}
template <bool PV> DEVI void fixed_step(LAS const unsigned char* buf, const bf16x8 q0, const bf16x8 q1, int lo, int hi, float mc, float& l, f32x4 (&o)[4], int lane) {
    __builtin_amdgcn_sched_barrier(0);
    f32x4 s[4]; qk_slot(buf, q0, q1, lane, s);
    __builtin_amdgcn_sched_barrier(0);
    const int quad = lane >> 4;
    float ps = 0.f;
    if (__builtin_amdgcn_ballot_w64((lo > 0) | (hi < 63)) != 0ull) { const int loq = lo - 4 * quad, hiq = hi - 4 * quad;
#pragma unroll
        for (int kg = 0; kg < 4; ++kg)
#pragma unroll
            for (int i = 0; i < 4; ++i) { const bool ok = (16 * kg + i >= loq) & (16 * kg + i <= hiq); s[kg][i] = ok ? __builtin_amdgcn_exp2f(__builtin_fmaf(s[kg][i], CEXP, mc)) : 0.f; ps += s[kg][i]; }
    } else {
#pragma unroll
        for (int kg = 0; kg < 4; ++kg)
#pragma unroll
            for (int i = 0; i < 4; ++i) { s[kg][i] = __builtin_amdgcn_exp2f(__builtin_fmaf(s[kg][i], CEXP, mc)); ps += s[kg][i]; }
    }
    l += ps;
    if (PV) { bf16x8 pb[2]; pb[0] = pack_p(s[0], s[1]); pb[1] = pack_p(s[2], s[3]); pv_slot(buf + 8192, pb, o, lane); }
    __builtin_amdgcn_sched_barrier(0);
}
DEVI void load_q(const bf16_t* Q, size_t tok, int hcol, int quad, bf16x8 (&qf)[2]) {
    const bf16_t* p = Q + tok * DM + hcol + quad * 8;
    qf[0] = *(const bf16x8*)p; qf[1] = *(const bf16x8*)(p + 32);
}
DEVI bf16x8 rope_frag(const bf16x8 q, const float* csrow, int quad, int lane) {
    const u32x4 w = __builtin_bit_cast(u32x4, q); u32x4 pw;
#pragma unroll
    for (int i = 0; i < 4; ++i) pw[i] = (unsigned)shxi((int)w[i], 16, lane);
    if (quad >= 2) return q;
    const f32x4 c0 = *(const f32x4*)csrow, c1 = *(const f32x4*)(csrow + 4), s0 = *(const f32x4*)(csrow + 8), s1 = *(const f32x4*)(csrow + 12);
    const float sg = quad == 0 ? -1.f : 1.f;
    float x[8], xp[8];
#pragma unroll
    for (int i = 0; i < 4; ++i) { x[2 * i] = bflo(w[i]); x[2 * i + 1] = bfhi(w[i]); xp[2 * i] = bflo(pw[i]); xp[2 * i + 1] = bfhi(pw[i]); }
    const float cc[8] = {c0[0], c0[1], c0[2], c0[3], c1[0], c1[1], c1[2], c1[3]}, ss[8] = {s0[0], s0[1], s0[2], s0[3], s1[0], s1[1], s1[2], s1[3]};
    u32x4 o;
#pragma unroll
    for (int i = 0; i < 4; ++i) o[i] = pg8::cvt_pk_bf16(x[2 * i] * cc[2 * i] + sg * xp[2 * i] * ss[2 * i], x[2 * i + 1] * cc[2 * i + 1] + sg * xp[2 * i + 1] * ss[2 * i + 1]);
    return __builtin_bit_cast(bf16x8, o);
}

struct KFr { bf16x8 k[4][2]; };
struct VFr { bf16x8 v[4][2]; };
constexpr float LSCALE = 1048576.f;
struct Raw8 { u32x4 k[4]; u32x4 v[4]; };
template <int OFF> DEVI void gld16(u32x4& d, const void* p) { asm volatile("global_load_dwordx4 %0, %1, off offset:%2" : "=v"(d) : "v"(p), "n"(OFF) : "memory"); }
DEVI void sel_load8(Raw8& r, const unsigned char* K8, const unsigned char* V8, int j, int lane) {
    const int l15 = lane & 15, quad = lane >> 4;
    const unsigned char* pk = K8 + ((size_t)(64 * j + l15)) * 64 + 16 * quad;
    const unsigned char* pv = V8 + (size_t)j * 4096 + l15 * 64 + 16 * quad;
    gld16<0>(r.k[0], pk); gld16<1024>(r.k[1], pk); gld16<2048>(r.k[2], pk); gld16<3072>(r.k[3], pk);
    gld16<0>(r.v[0], pv); gld16<1024>(r.v[1], pv); gld16<2048>(r.v[2], pv); gld16<3072>(r.v[3], pv);
}
template <int N> DEVI void sel_wait8(Raw8& r) {
    asm volatile("s_waitcnt vmcnt(%8)" : "+v"(r.k[0]), "+v"(r.k[1]), "+v"(r.k[2]), "+v"(r.k[3]), "+v"(r.v[0]), "+v"(r.v[1]), "+v"(r.v[2]), "+v"(r.v[3]) : "n"(N) : "memory");
    __builtin_amdgcn_sched_barrier(0);
}
typedef float f32x2v __attribute__((ext_vector_type(2)));
DEVI bf16x8 fp8x8_bf16(unsigned w0, unsigned w1) {
    const f32x2v a = __builtin_amdgcn_cvt_pk_f32_fp8((int)w0, false), b = __builtin_amdgcn_cvt_pk_f32_fp8((int)w0, true), c = __builtin_amdgcn_cvt_pk_f32_fp8((int)w1, false), d = __builtin_amdgcn_cvt_pk_f32_fp8((int)w1, true);
    u32x4 o;
    o[0] = __builtin_amdgcn_perm(__float_as_uint(a[1]), __float_as_uint(a[0]), 0x07060302u); o[1] = __builtin_amdgcn_perm(__float_as_uint(b[1]), __float_as_uint(b[0]), 0x07060302u);
    o[2] = __builtin_amdgcn_perm(__float_as_uint(c[1]), __float_as_uint(c[0]), 0x07060302u); o[3] = __builtin_amdgcn_perm(__float_as_uint(d[1]), __float_as_uint(d[0]), 0x07060302u);
    return __builtin_bit_cast(bf16x8, o);
}
DEVI void sel_expand(const Raw8& r, KFr& f, VFr& g) {
#pragma unroll
    for (int i = 0; i < 4; ++i) { f.k[i][0] = fp8x8_bf16(r.k[i][0], r.k[i][1]); f.k[i][1] = fp8x8_bf16(r.k[i][2], r.k[i][3]); g.v[i][0] = fp8x8_bf16(r.v[i][0], r.v[i][1]); g.v[i][1] = fp8x8_bf16(r.v[i][2], r.v[i][3]); }
}
template <bool PASS2> DEVI void sel_block(const KFr& f, const VFr& fv, int j, bool active, int cur, LAS const unsigned* smask, LAS const unsigned char* Ql, LAS float* mrow, LAS int* lrow, LAS int* Os, float lg2k, float lratio, LAS int* tlist, int lane) {
    const int l15 = lane & 15, quad = lane >> 4, mem = l15 >> 2;
    const bool forced = (j == 0) || (j >= cur - 1);
    int cnt = 0;
    if (active) {
        if (forced) cnt = 64;
        else { const unsigned lo = (unsigned)__builtin_amdgcn_readfirstlane((int)smask[2 * j]), hi = (unsigned)__builtin_amdgcn_readfirstlane((int)smask[2 * j + 1]);
            const unsigned long long mk = ((unsigned long long)hi << 32) | lo;
            cnt = __builtin_popcountll(mk);
            const bool mine = (mk >> lane) & 1ull; const int rank = __builtin_popcountll(mk & ((1ull << lane) - 1ull));
            if (mine) tlist[rank] = lane;
            LDS_WAIT(); }
    }
    const int ngroups = (cnt + 3) >> 2;
    const bool diag = (j == cur);
#pragma unroll 1
    for (int gi = 0; gi < ngroups; ++gi) {
        const int slot = 4 * gi + mem;
        const bool valid = slot < cnt;
        int mt = forced ? slot : tlist[slot];
        mt = valid ? mt : 0;
        const int row = mt * 4 + (l15 & 3);
        const bf16x8 q0 = *(LAS const bf16x8*)(Ql + row * 128 + (((2 * quad) ^ (row & 7)) << 4));
        const bf16x8 q1 = *(LAS const bf16x8*)(Ql + row * 128 + (((2 * quad + 1) ^ (row & 7)) << 4));
        f32x4 sc[4];
#pragma unroll
        for (int kg = 0; kg < 4; ++kg) { f32x4 z = {0.f, 0.f, 0.f, 0.f}; z = __builtin_amdgcn_mfma_f32_16x16x32_bf16(f.k[kg][0], q0, z, 0, 0, 0); sc[kg] = __builtin_amdgcn_mfma_f32_16x16x32_bf16(f.k[kg][1], q1, z, 0, 0, 0); }
        if (!PASS2) {
            float mx;
            if (diag) mx = mask_max(sc, 0, mt, quad);
            else { float a = fmaxf(fmaxf(sc[0][0], sc[0][1]), fmaxf(sc[0][2], sc[0][3])), b = fmaxf(fmaxf(sc[1][0], sc[1][1]), fmaxf(sc[1][2], sc[1][3]));
                   a = fmaxf(a, fmaxf(fmaxf(sc[2][0], sc[2][1]), fmaxf(sc[2][2], sc[2][3]))); b = fmaxf(b, fmaxf(fmaxf(sc[3][0], sc[3][1]), fmaxf(sc[3][2], sc[3][3]))); mx = max_quads(fmaxf(a, b)); }
            if (quad == 0 && valid) __hip_atomic_fetch_max(mrow + row, mx, __ATOMIC_RELAXED, __HIP_MEMORY_SCOPE_WORKGROUP);
        } else {
            const float mc = lg2k - mrow[row] * CEXP;
            float ps = 0.f;
            if (diag) { const int hiq = mt - 4 * quad;
#pragma unroll
                for (int kg = 0; kg < 4; ++kg)
#pragma unroll
                    for (int i = 0; i < 4; ++i) { sc[kg][i] = (16 * kg + i <= hiq) ? __builtin_amdgcn_exp2f(__builtin_fmaf(sc[kg][i], CEXP, mc)) : 0.f; ps += sc[kg][i]; }
            } else {
#pragma unroll
                for (int kg = 0; kg < 4; ++kg)
#pragma unroll
                    for (int i = 0; i < 4; ++i) { sc[kg][i] = __builtin_amdgcn_exp2f(__builtin_fmaf(sc[kg][i], CEXP, mc)); ps += sc[kg][i]; }
            }
            ps = sum_quads(ps);
            if (quad == 0 && valid) __hip_atomic_fetch_add(lrow + row, (int)(ps * lratio), __ATOMIC_RELAXED, __HIP_MEMORY_SCOPE_WORKGROUP);
            bf16x8 pb[2]; pb[0] = pack_p(sc[0], sc[1]); pb[1] = pack_p(sc[2], sc[3]);
            LAS int* orow = Os + row * OS_LD + 4 * quad;
#pragma unroll
            for (int dh = 0; dh < 2; ++dh) {
                f32x4 o[2];
#pragma unroll
                for (int d2 = 0; d2 < 2; ++d2) { const int dg = dh * 2 + d2; f32x4 z = {0.f, 0.f, 0.f, 0.f}; z = __builtin_amdgcn_mfma_f32_16x16x32_bf16(fv.v[dg][0], pb[0], z, 0, 0, 0); o[d2] = __builtin_amdgcn_mfma_f32_16x16x32_bf16(fv.v[dg][1], pb[1], z, 0, 0, 0); }
                if (valid) {
#pragma unroll
                    for (int d2 = 0; d2 < 2; ++d2)
#pragma unroll
                        for (int c = 0; c < 4; ++c) __hip_atomic_fetch_add(orow + 16 * (dh * 2 + d2) + c, (int)o[d2][c], __ATOMIC_RELAXED, __HIP_MEMORY_SCOPE_WORKGROUP);
                }
                __builtin_amdgcn_sched_barrier(0);
            }
        }
    }
}
#define BL(i) __builtin_amdgcn_readfirstlane(blist[(i) < nb ? (i) : nb - 1])
DEVI void sel_pass2(const unsigned char* K8, const unsigned char* V8, int nb, int cur, int wave, LAS const int* blist, LAS const unsigned* smask, LAS const unsigned char* Ql, LAS float* mrow, LAS int* lrow, LAS int* Os, float lg2k, float lratio, LAS int* tlist, int lane) {
    if (wave >= nb) return;
    Raw8 ra, rb; KFr kf; VFr vf;
    asm volatile("s_waitcnt vmcnt(0)" ::: "memory");
    sel_load8(ra, K8, V8, BL(wave), lane);
#pragma unroll 1
    for (int bi = wave; bi < nb; bi += 16) {
        sel_load8(rb, K8, V8, BL(bi + 8), lane); sel_wait8<8>(ra);
        sel_expand(ra, kf, vf);
        sel_block<true>(kf, vf, BL(bi), true, cur, smask, Ql, mrow, lrow, Os, lg2k, lratio, tlist, lane);
        sel_load8(ra, K8, V8, BL(bi + 16), lane); sel_wait8<8>(rb);
        sel_expand(rb, kf, vf);
        sel_block<true>(kf, vf, BL(bi + 8), bi + 8 < nb, cur, smask, Ql, mrow, lrow, Os, lg2k, lratio, tlist, lane);
    }
    asm volatile("s_waitcnt vmcnt(0)" ::: "memory");
}
#undef BL
}


DEVI void phase_vs_transpose(Frame& F, int l) {
    F.refresh();
    unsigned char* ws = F.ws;
    const bf16_t* VS = (const bf16_t*)(ws + RA_VS); unsigned char* VT = ws + RA_VST; unsigned char* K8 = ws + RA_K8; const bf16_t* KSG = (const bf16_t*)(ws + RA_KS);
    LAS unsigned char* T = F.lds + F.wave * 9216;
    const int lane = F.lane, rr = lane >> 3, c = lane & 7, i16 = lane & 15, grp = lane >> 4;
    for (int it = ((int)blockIdx.x - 64) * NWAVES + F.wave; it < 2048; it += 192 * NWAVES) {
        const int bg = it >> 8, tile = it & 255;
        const bf16_t* vsrc = VS + ((size_t)bg * SEQ + tile * 64) * 64; const bf16_t* ksrc = KSG + ((size_t)bg * SEQ + tile * 64) * 64;
        const bf16_t* wsrc = (const bf16_t*)(ws + RA_KW) + ((size_t)bg * SEQ + tile * 64) * 64;
        unsigned char* kdst = K8 + ((size_t)bg * SEQ + tile * 64) * 64;
        u32x4 v[8], k[8], kw[8];
#pragma unroll
        for (int i = 0; i < 8; ++i) { v[i] = *(const u32x4*)(vsrc + (size_t)(8 * i + rr) * 64 + c * 8); k[i] = *(const u32x4*)(ksrc + (size_t)(8 * i + rr) * 64 + c * 8); kw[i] = *(const u32x4*)(wsrc + (size_t)(8 * i + rr) * 64 + c * 8); }
        float vmx = 0.f, kmx = 0.f, wmx = 0.f;
#pragma unroll
        for (int i = 0; i < 8; ++i) { float n2 = 0.f, w2 = 0.f;
            u32x2 k8; k8[0] = pack_fp8x4(bflo(k[i][0]), bfhi(k[i][0]), bflo(k[i][1]), bfhi(k[i][1])); k8[1] = pack_fp8x4(bflo(k[i][2]), bfhi(k[i][2]), bflo(k[i][3]), bfhi(k[i][3]));
            *(u32x2*)(kdst + (size_t)(8 * i + rr) * 64 + c * 8) = k8;
#pragma unroll
            for (int e = 0; e < 2; ++e) { const fa::f32x2v a = __builtin_amdgcn_cvt_pk_f32_fp8((int)k8[e], false), b2 = __builtin_amdgcn_cvt_pk_f32_fp8((int)k8[e], true); n2 += a[0] * a[0] + a[1] * a[1] + b2[0] * b2[0] + b2[1] * b2[1]; }
#pragma unroll
            for (int e = 0; e < 4; ++e) { const float a3 = bflo(kw[i][e]), b3 = bfhi(kw[i][e]); w2 += a3 * a3 + b3 * b3; }
            n2 += fa::dppf<DPP_X1>(n2); n2 += fa::dppf<DPP_X2>(n2); n2 += fa::dppf<DPP_HM>(n2);
            w2 += fa::dppf<DPP_X1>(w2); w2 += fa::dppf<DPP_X2>(w2); w2 += fa::dppf<DPP_HM>(w2);
            kmx = fmaxf(kmx, n2); wmx = fmaxf(wmx, w2);
            *(LAS u32x4*)(T + (8 * i + rr) * 144 + c * 16) = v[i]; }
        LDS_WAIT(); asm volatile("" ::: "memory");
        unsigned char* vdst = VT + ((size_t)bg * 256 + tile) * 4096;
#pragma unroll
        for (int dc = 0; dc < 4; ++dc) { u32x4 o;
#pragma unroll
            for (int n = 0; n < 4; ++n) { const int kg4 = n * 4 + grp;
                const fa::v4i16_t t = __builtin_amdgcn_ds_read_tr16_b64_v4i16((LAS fa::v4i16_t*)(T + (4 * kg4 + (i16 >> 2)) * 144 + (16 * dc + 4 * (i16 & 3)) * 2));
                const u32x2 tw = __builtin_bit_cast(u32x2, t);
                o[n] = pack_fp8x4(bflo(tw[0]), bfhi(tw[0]), bflo(tw[1]), bfhi(tw[1]));
                const fa::f32x2v a = __builtin_amdgcn_cvt_pk_f32_fp8((int)o[n], false), b2 = __builtin_amdgcn_cvt_pk_f32_fp8((int)o[n], true);
                vmx = fmaxf(vmx, fmaxf(fmaxf(fabsf(a[0]), fabsf(a[1])), fmaxf(fabsf(b2[0]), fabsf(b2[1])))); }
            *(u32x4*)(vdst + (16 * dc + i16) * 64 + 16 * grp) = o; }
        vmx = wave_max(vmx, lane); kmx = wave_max(kmx, lane); wmx = wave_max(wmx, lane);
        if (lane == 0) { atomicMax((unsigned*)(ws + WS_CTL) + CW_VMAX + l * 8 + bg, __float_as_uint(vmx)); atomicMax((unsigned*)(ws + WS_CTL) + CW_KMAX + l * 8 + bg, __float_as_uint(kmx));
            atomicMax((unsigned*)(ws + WS_CTL) + CW_KWMAX + l * 8 + bg, __float_as_uint(wmx)); }
        LDS_WAIT(); asm volatile("" ::: "memory");
    }
}

DEVI void phase_nsa_fast(Frame& F, int layer) {
    using namespace fa;
    F.refresh();
    unsigned char* ws = F.ws;
    const bf16_t* Q = (const bf16_t*)(ws + RA_Q); unsigned char* ATT8 = ws + RA_ATT;
    const float* GT = (const float*)(ws + RA_GATE); const float* CS = (const float*)(ws + WS_CS);
    const int wave = F.wave;
    LAS unsigned char* kvb = F.lds + L_KV;
    LAS float* imp = (LAS float*)(F.lds + L_IMP);
    LAS unsigned* smask = (LAS unsigned*)(F.lds + L_MASK);
    LAS int* blist = (LAS int*)(F.lds + L_LIST);
    float kcmax2;
    {   const int bg0 = F.vcu >> 5; const bf16_t* kc0 = (const bf16_t*)(ws + RA_KC) + (size_t)bg0 * 1024 * 64;
        float mx = 0.f;
        for (int i = F.tid; i < 1024 * 8; i += NWAVES * 64) { const u32x4 w = *(const u32x4*)(kc0 + (size_t)i * 8); float n2 = 0.f;
#pragma unroll
            for (int e = 0; e < 4; ++e) { const float a = bflo(w[e]), b2 = bfhi(w[e]); n2 += a * a + b2 * b2; }
            n2 += dppf<DPP_X1>(n2); n2 += dppf<DPP_X2>(n2); n2 += dppf<DPP_HM>(n2);
            mx = fmaxf(mx, n2); }
        mx = wave_max(mx, F.lane);
        LAS float* red = (LAS float*)(F.lds + L_END);
        if (F.lane == 0) red[wave] = mx;
        __syncthreads();
        kcmax2 = fmaxf(fmaxf(fmaxf(red[0], red[1]), fmaxf(red[2], red[3])), fmaxf(fmaxf(red[4], red[5]), fmaxf(red[6], red[7])));
        __syncthreads(); }
#pragma unroll 1
    for (int ui = 0; ui < 8; ++ui) {
        int lane = F.lane; asm volatile("" : "+v"(lane));
        const int tid = wave * 64 + lane, quad = lane >> 4, l15 = lane & 15;
        int tile = (F.vcu & 31) + 32 * (ui >> 1); if (ui & 1) tile = 255 - tile;
        const int bg = F.vcu >> 5, b = bg >> 2, g = bg & 3, cur = tile, t0 = tile * 64;
        const bf16_t* KC = (const bf16_t*)(ws + RA_KC) + (size_t)bg * 1024 * 64; const bf16_t* VC = (const bf16_t*)(ws + RA_VC) + (size_t)bg * 1024 * 64;
        const bf16_t* KS = (const bf16_t*)(ws + RA_KS) + (size_t)bg * SEQ * 64; const bf16_t* VS = (const bf16_t*)(ws + RA_VS) + (size_t)bg * SEQ * 64;
        const bf16_t* KW = (const bf16_t*)(ws + RA_KW) + (size_t)bg * SEQ * 64; const bf16_t* VW = (const bf16_t*)(ws + RA_VW) + (size_t)bg * SEQ * 64;
        smask[tid] = 0u;
        int tl[2], tok[2]; bf16x8 qf[2][2];
#pragma unroll
        for (int s = 0; s < 2; ++s) { tl[s] = 8 * wave + 4 * s + (l15 >> 2); tok[s] = b * SEQ + t0 + tl[s]; load_q(Q, (size_t)tok[s], g * 256 + (l15 & 3) * 64, quad, qf[s]); }
        float gate[2][3];
#pragma unroll
        for (int s = 0; s < 2; ++s)
#pragma unroll
            for (int br = 0; br < 3; ++br) gate[s][br] = GT[(size_t)tok[s] * 48 + br * 16 + g * 4 + (l15 & 3)];
        const float vmax = fmaxf(__uint_as_float(__hip_atomic_load((const unsigned*)(ws + WS_CTL) + CW_VMAX + layer * 8 + bg, __ATOMIC_RELAXED, __HIP_MEMORY_SCOPE_AGENT)), 1e-30f);
        bf16x8 qr[2][2];
#pragma unroll
        for (int s = 0; s < 2; ++s) { qr[s][0] = rope_frag(qf[s][0], CS + (size_t)tok[s] * 16, quad, lane); qr[s][1] = qf[s][1]; }
        float qn2[2];
#pragma unroll
        for (int s = 0; s < 2; ++s) { float n2 = 0.f;
#pragma unroll
            for (int ks = 0; ks < 2; ++ks) { const u32x4 w = __builtin_bit_cast(u32x4, qf[s][ks]);
#pragma unroll
                for (int e = 0; e < 4; ++e) { const float a = bflo(w[e]), b2 = bfhi(w[e]); n2 += a * a + b2 * b2; } }
            qn2[s] = sum_quads(n2); }
        const float kwmax2 = __uint_as_float(__hip_atomic_load((const unsigned*)(ws + WS_CTL) + CW_KWMAX + layer * 8 + bg, __ATOMIC_RELAXED, __HIP_MEMORY_SCOPE_AGENT));
        f32x4 out[2][4];
#pragma unroll
        for (int s = 0; s < 2; ++s)
#pragma unroll
            for (int dg = 0; dg < 4; ++dg) out[s][dg] = (f32x4){0.f, 0.f, 0.f, 0.f};
        Stage st;
        const int ntile = (4 * cur + 3 + 63) >> 6;
        int nval[2];
#pragma unroll
        for (int s = 0; s < 2; ++s) { const int t = t0 + tl[s]; nval[s] = t >= 31 ? ((t - 31) >> 4) + 1 : 0; }
        float l[2] = {0.f, 0.f};
        const float mcc[2] = {-sqrtf(qn2[0] * kcmax2) * 1.0001f * CEXP, -sqrtf(qn2[1] * kcmax2) * 1.0001f * CEXP};
        {   stage_load<false>(st, KC, VC, tid); stage_write<false>(st, kvb, tid); __syncthreads();
#pragma unroll 1
            for (int i = 0; i < ntile; ++i) {
                LAS unsigned char* buf = kvb + (i & 1) * KVB;
                if (i + 1 < ntile) stage_load<false>(st, KC + (size_t)(i + 1) * 4096, VC, tid); else stage_load<true>(st, KC, VC, tid);
#pragma unroll
                for (int s = 0; s < 2; ++s) { f32x4 dummy[4]; fixed_step<false>(buf, qf[s][0], qf[s][1], 0, nval[s] - 64 * i - 1, mcc[s], l[s], dummy, lane); }
                if (i + 1 < ntile) stage_write<false>(st, kvb + ((i + 1) & 1) * KVB, tid);
                __syncthreads();
            }
        }
        float invl[2], msafe[2];
#pragma unroll
        for (int s = 0; s < 2; ++s) { const float lt = sum_quads(l[s]); invl[s] = lt > 0.f ? 1.f / lt : 0.f; msafe[s] = -mcc[s] * (1.f / CEXP); }
        const int jbw0 = cur >= 8 ? cur - 8 : 0;
        {   float gcv[2] = {gate[0][0], gate[1][0]};
            float carry[2] = {0.f, 0.f};
            stage_write<true>(st, kvb, tid); __syncthreads();
#pragma unroll 1
            for (int i = 0; i < ntile; ++i) {
                LAS unsigned char* buf = kvb + (i & 1) * KVB;
                if (i + 1 < ntile) stage_load<true>(st, KC + (size_t)(i + 1) * 4096, VC + (size_t)(i + 1) * 4096, tid); else stage_load<true>(st, KW + (size_t)jbw0 * 4096, VW + (size_t)jbw0 * 4096, tid);
#pragma unroll
                for (int s = 0; s < 2; ++s) {
                    __builtin_amdgcn_sched_barrier(0);
                    f32x4 sc[4]; qk_slot(buf, qf[s][0], qf[s][1], lane, sc);
                    __builtin_amdgcn_sched_barrier(0);
                    const int hiq = nval[s] - 64 * i - 1 - 4 * quad; const float mc2 = -msafe[s] * CEXP;
#pragma unroll
                    for (int kg = 0; kg < 4; ++kg)
#pragma unroll
                        for (int k = 0; k < 4; ++k) sc[kg][k] = (16 * kg + k <= hiq) ? __builtin_amdgcn_exp2f(__builtin_fmaf(sc[kg][k], CEXP, mc2)) * invl[s] : 0.f;
                    bf16x8 pb[2]; pb[0] = pack_p(sc[0] * gcv[s], sc[1] * gcv[s]); pb[1] = pack_p(sc[2] * gcv[s], sc[3] * gcv[s]);
#pragma unroll
                    for (int kg = 0; kg < 4; ++kg) {
                        float a = (sc[kg][0] + sc[kg][1]) + (sc[kg][2] + 0.5f * sc[kg][3]), bq = 0.5f * sc[kg][3];
                        a += dppf<DPP_X1>(a); a += dppf<DPP_X2>(a); bq += dppf<DPP_X1>(bq); bq += dppf<DPP_X2>(bq);
                        const float fromprev = bperm(bq, (lane - 16) & 63);
                        const float add = quad == 0 ? carry[s] : fromprev;
                        carry[s] = bperm(bq, (lane + 48) & 63);
                        if ((l15 & 3) == 0) imp[(8 * wave + 4 * s + (l15 >> 2)) * IMP_LD + 16 * i + 4 * kg + quad] = a + add;
                    }
                    __builtin_amdgcn_sched_barrier(0);
                    pv_slot(buf + 8192, pb, out[s], lane);
                    __builtin_amdgcn_sched_barrier(0);
                }
                if (i + 1 < ntile) stage_write<true>(st, kvb + ((i + 1) & 1) * KVB, tid);
                __syncthreads();
            }
        }
        {   const int tl8 = lane >> 3, chunk = lane & 7, trow = (8 * wave + tl8) * IMP_LD;
            const int ncand = cur - 2;
            const int wsel = ((8 * wave + tl8) >> 5), bsel = (8 * wave + tl8) & 31;
            if (ncand > 0 && ncand <= 13) {
#pragma unroll
                for (int i = 0; i < 2; ++i) { const int j = 8 * i + chunk; if (j >= 1 && j <= cur - 2) __hip_atomic_fetch_or(smask + j * 2 + wsel, 1u << bsel, __ATOMIC_RELAXED, __HIP_MEMORY_SCOPE_WORKGROUP); }
            } else if (ncand > 13) {
                unsigned lv[13];
#pragma unroll
                for (int k = 0; k < 13; ++k) lv[k] = 0u;
                const int imax = (cur - 2) >> 3;
#pragma unroll 1
                for (int i = 0; i <= imax; ++i) {
                    const int j = 8 * i + chunk;
                    unsigned x = (j >= 1 && j <= cur - 2) ? ((__float_as_uint(imp[trow + j]) & 0xFFFFFF00u) | (unsigned)(255 - j)) : 0u;
                    if (__builtin_amdgcn_ballot_w64(x > lv[12]) != 0ull) {
#pragma unroll
                        for (int k = 0; k < 13; ++k) { const unsigned hi_ = lv[k] > x ? lv[k] : x, lo_ = lv[k] > x ? x : lv[k]; lv[k] = hi_; x = lo_; }
                    }
                }
#pragma unroll 1
                for (int r = 0; r < 13; ++r) {
                    unsigned bv = lv[0];
                    { const unsigned ov = (unsigned)dppi<DPP_X1>((int)bv); bv = ov > bv ? ov : bv; }
                    { const unsigned ov = (unsigned)dppi<DPP_X2>((int)bv); bv = ov > bv ? ov : bv; }
                    { const unsigned ov = (unsigned)dppi<DPP_HM>((int)bv); bv = ov > bv ? ov : bv; }
                    if (lv[0] == bv && bv != 0u) {
#pragma unroll
                        for (int k = 0; k < 12; ++k) lv[k] = lv[k + 1];
                        lv[12] = 0u;
                    }
                    if (chunk == 0 && bv != 0u) __hip_atomic_fetch_or(smask + (255 - (int)(bv & 0xFFu)) * 2 + wsel, 1u << bsel, __ATOMIC_RELAXED, __HIP_MEMORY_SCOPE_WORKGROUP);
                }
            }
        }
        __syncthreads();
        if (wave == 0) {
            int base = 0;
#pragma unroll 1
            for (int r = 0; r < 4; ++r) { const int j = 64 * r + lane; const bool on = (j <= cur) && (j == 0 || j >= cur - 1 || (smask[j * 2] | smask[j * 2 + 1]) != 0u);
                const unsigned long long bal = __builtin_amdgcn_ballot_w64(on); const int pos = base + __builtin_popcountll(bal & ((1ull << lane) - 1ull));
                if (on) blist[pos] = j; base += __builtin_popcountll(bal); }
            if (lane == 0) blist[259] = base;
        }
        __syncthreads();
        LAS float* stashf = imp + wave * 2048 + lane;
#pragma unroll
        for (int s = 0; s < 2; ++s)
#pragma unroll
            for (int dg = 0; dg < 4; ++dg)
#pragma unroll
                for (int c = 0; c < 4; ++c) stashf[(s * 16 + dg * 4 + c) * 64] = out[s][dg][c];
        {   const int jb0 = jbw0, nb = cur - jb0 + 1;
            f32x4 ob[2][4]; float ll[2] = {0.f, 0.f};
            const float mcw[2] = {-sqrtf(qn2[0] * kwmax2) * 1.0001f * CEXP, -sqrtf(qn2[1] * kwmax2) * 1.0001f * CEXP};
#pragma unroll
            for (int s = 0; s < 2; ++s)
#pragma unroll
                for (int dg = 0; dg < 4; ++dg) ob[s][dg] = (f32x4){0.f, 0.f, 0.f, 0.f};
            stage_write<true>(st, kvb, tid); __syncthreads();
#pragma unroll 1
            for (int i = 0; i < nb; ++i) {
                LAS unsigned char* buf = kvb + (i & 1) * KVB;
                const int j = jb0 + i;
                if (i + 1 < nb) stage_load<true>(st, KW + (size_t)(j + 1) * 4096, VW + (size_t)(j + 1) * 4096, tid);
#pragma unroll
                for (int s = 0; s < 2; ++s) {
                    const int lo = (j == cur - 8) ? tl[s] + 1 : 0, hi = (j == cur) ? tl[s] : 63;
                    fixed_step<true>(buf, qr[s][0], qr[s][1], lo, hi, mcw[s], ll[s], ob[s], lane);
                }
                if (i + 1 < nb) stage_write<true>(st, kvb + ((i + 1) & 1) * KVB, tid);
                __syncthreads();
            }
#pragma unroll
            for (int s = 0; s < 2; ++s) { const float lt = sum_quads(ll[s]); const float gw = gate[s][2] * (lt > 0.f ? 1.f / lt : 0.f);
#pragma unroll
                for (int dg = 0; dg < 4; ++dg)
#pragma unroll
                    for (int c = 0; c < 4; ++c) out[s][dg][c] = stashf[(s * 16 + dg * 4 + c) * 64] + ob[s][dg][c] * gw; }
        }
        LAS unsigned* stashb = (LAS unsigned*)(F.lds + L_KV) + wave * 1024 + lane;
        LAS unsigned char* Ql = F.lds + L_Q;
        LAS float* mrow = (LAS float*)(F.lds + L_ML); LAS int* lrow = (LAS int*)(mrow + 256);
        LAS int* Os = (LAS int*)imp;
        const float oscale = 1048576.f / vmax;
#pragma unroll
        for (int s = 0; s < 2; ++s) {
#pragma unroll
            for (int dg = 0; dg < 4; ++dg) { stashb[((s * 4 + dg) * 2 + 0) * 64] = pg8::cvt_pk_bf16(out[s][dg][0], out[s][dg][1]); stashb[((s * 4 + dg) * 2 + 1) * 64] = pg8::cvt_pk_bf16(out[s][dg][2], out[s][dg][3]); }
            const int row = tl[s] * 4 + (l15 & 3);
            *(LAS bf16x8*)(Ql + row * 128 + ((quad ^ (row & 7)) << 4)) = qr[s][0];
            *(LAS bf16x8*)(Ql + row * 128 + (((4 + quad) ^ (row & 7)) << 4)) = qr[s][1];
        }
        __syncthreads();
        for (int i = lane; i < 32 * OS_LD; i += 64) Os[wave * 32 * OS_LD + i] = 0;
        if (lane < 32) lrow[wave * 32 + lane] = 0;
        {
            const float kmax2 = __uint_as_float(__hip_atomic_load((const unsigned*)(ws + WS_CTL) + CW_KMAX + layer * 8 + bg, __ATOMIC_RELAXED, __HIP_MEMORY_SCOPE_AGENT));
#pragma unroll
            for (int s = 0; s < 2; ++s) { float n2 = 0.f;
#pragma unroll
                for (int ks = 0; ks < 2; ++ks) { const u32x4 w = __builtin_bit_cast(u32x4, qr[s][ks]);
#pragma unroll
                    for (int e = 0; e < 4; ++e) { const float a = bflo(w[e]), b2 = bfhi(w[e]); n2 += a * a + b2 * b2; } }
                n2 = sum_quads(n2);
                if (quad == 0) mrow[tl[s] * 4 + (l15 & 3)] = sqrtf(n2 * kmax2) * 1.0001f; } }
        __syncthreads();
        {   const int nb = blist[259];
            int lane2 = lane; asm volatile("" : "+v"(lane2));
            const unsigned char* VT = ws + RA_VST + (size_t)bg * 256 * 4096; const unsigned char* K8 = ws + RA_K8 + (size_t)bg * SEQ * 64;
            LAS int* tlist = (LAS int*)(F.lds + L_TOK) + wave * 64;
            asm volatile("" : "+v"(lane2));
            sel_pass2(K8, VT, nb, cur, wave, blist, smask, Ql, mrow, lrow, Os, __builtin_amdgcn_logf(oscale), LSCALE / oscale, tlist, lane2);
            __syncthreads();
        }
        asm volatile("" : "+v"(tok[0]), "+v"(tok[1]), "+v"(tl[0]), "+v"(tl[1]));
        const float oinv = vmax * (1.f / 1048576.f);
#pragma unroll
        for (int s = 0; s < 2; ++s) { const int row = tl[s] * 4 + (l15 & 3); const float lt = (float)lrow[row] * (1.f / LSCALE);
            const float gs = gate[s][1] * (lt > 0.f ? 1.f / lt : 0.f) * oinv;
#pragma unroll
            for (int dg = 0; dg < 4; ++dg) { const unsigned w0 = stashb[((s * 4 + dg) * 2 + 0) * 64], w1 = stashb[((s * 4 + dg) * 2 + 1) * 64];
                LAS const int* orow = Os + row * OS_LD + 16 * dg + 4 * quad;
                const float r0 = bflo(w0) + (float)orow[0] * gs, r1 = bfhi(w0) + (float)orow[1] * gs, r2 = bflo(w1) + (float)orow[2] * gs, r3 = bfhi(w1) + (float)orow[3] * gs;
                *(unsigned*)(ATT8 + (size_t)tok[s] * DM + g * 256 + (l15 & 3) * 64 + 16 * dg + 4 * quad) = pack_fp8x4(r0, r1, r2, r3); } }
        __syncthreads();
    }
}

DEVI void phase_swa_fast(Frame& F, const float* sinks) {
    using namespace fa;
    F.refresh();
    unsigned char* ws = F.ws;
    const bf16_t* Q = (const bf16_t*)(ws + RA_Q); unsigned char* ATT8 = ws + RA_ATT;
    const int tid = F.tid, lane = F.lane, wave = F.wave, quad = lane >> 4, l15 = lane & 15;
    LAS unsigned char* kvb = F.lds + L_KV;
#pragma unroll 1
    for (int ui = 0; ui < 8; ++ui) {
        const int bg = ui >> 1, b = bg >> 1, g = bg & 1, t0 = (F.vcu * 2 + (ui & 1)) * 32, cur = t0 >> 6;
        const bf16_t* KS = (const bf16_t*)(ws + WS_KSH) + (size_t)bg * SEQ * 64; const bf16_t* VS = (const bf16_t*)(ws + WS_VSH) + (size_t)bg * SEQ * 64;
        int tq[2]; size_t tok[2]; bf16x8 qf[2][2]; f32x4 o[2][4]; float mm[2], ll[2];
        const float sink_raw = sinks[g * 8 + (l15 & 7)] * 8.0f;
#pragma unroll
        for (int s = 0; s < 2; ++s) { tq[s] = t0 + 4 * wave + 2 * s + (l15 >> 3); tok[s] = (size_t)b * SEQ + tq[s]; load_q(Q, tok[s], g * 512 + (l15 & 7) * 64, quad, qf[s]);
            mm[s] = sink_raw; ll[s] = quad == 0 ? 1.f : 0.f;
#pragma unroll
            for (int dg = 0; dg < 4; ++dg) o[s][dg] = (f32x4){0.f, 0.f, 0.f, 0.f}; }
        const int jb0 = cur >= 2 ? cur - 2 : 0, nb = cur - jb0 + 1;
        Stage st; stage_load<true>(st, KS + (size_t)jb0 * 4096, VS + (size_t)jb0 * 4096, tid); stage_write<true>(st, kvb, tid); __syncthreads();
#pragma unroll 1
        for (int i = 0; i < nb; ++i) {
            LAS unsigned char* buf = kvb + (i & 1) * KVB;
            const int j = jb0 + i;
            if (i + 1 < nb) stage_load<true>(st, KS + (size_t)(j + 1) * 4096, VS + (size_t)(j + 1) * 4096, tid);
#pragma unroll
            for (int s = 0; s < 2; ++s) online_step<true>(buf, qf[s][0], qf[s][1], tq[s] - (SWA_WIN - 1) - 64 * j, tq[s] - 64 * j, mm[s], ll[s], o[s], lane);
            if (i + 1 < nb) stage_write<true>(st, kvb + ((i + 1) & 1) * KVB, tid);
            __syncthreads();
        }
#pragma unroll
        for (int s = 0; s < 2; ++s) { const float inv = 1.f / sum_quads(ll[s]);
#pragma unroll
            for (int dg = 0; dg < 4; ++dg)
                *(unsigned*)(ATT8 + tok[s] * DM + g * 512 + (l15 & 7) * 64 + 16 * dg + 4 * quad) = pack_fp8x4(o[s][dg][0] * inv, o[s][dg][1] * inv, o[s][dg][2] * inv, o[s][dg][3] * inv); }
    }
}

enum Kind { K_PRO = 0, K_NSA_IN, K_CMP_HID, K_CMP_OUT, K_NSA_ATT, K_SWA_IN, K_SWA_ATT, K_OUTPROJ, K_LN1, K_LN1R, K_FFN1, K_FFN2, K_LN2, K_SCATTER, K_MOE1, K_MOE2, K_LN2C, K_COUNT };
struct Args { const void* in[18]; float* out; unsigned char* ws; int ph_lo, ph_hi; };
struct PhaseEnt { int kind, layer; };
constexpr int NPH = 35;
static const PhaseEnt h_prog[NPH] = {
    {K_PRO, 0},
    {K_NSA_IN, 0}, {K_CMP_HID, 0}, {K_CMP_OUT, 0}, {K_NSA_ATT, 0}, {K_OUTPROJ, 0}, {K_LN1, 0}, {K_FFN1, 0}, {K_FFN2, 0}, {K_LN2, 0},
    {K_NSA_IN, 1}, {K_CMP_HID, 1}, {K_CMP_OUT, 1}, {K_NSA_ATT, 1}, {K_OUTPROJ, 1}, {K_LN1R, 1}, {K_SCATTER, 1}, {K_MOE1, 1}, {K_MOE2, 1}, {K_LN2C, 1},
    {K_SWA_IN, 2}, {K_SWA_ATT, 2}, {K_OUTPROJ, 2}, {K_LN1, 2}, {K_FFN1, 2}, {K_FFN2, 2}, {K_LN2, 2},
    {K_SWA_IN, 3}, {K_SWA_ATT, 3}, {K_OUTPROJ, 3}, {K_LN1R, 3}, {K_SCATTER, 3}, {K_MOE1, 3}, {K_MOE2, 3}, {K_LN2C, 3},
};

template <int KIND> DEVI void do_phase(Frame& F, int l) {
    unsigned char* ws = F.ws;
    unsigned* ctl = (unsigned*)(ws + WS_CTL);
    LAS unsigned char* ring = F.lds;
    const int bx = (int)blockIdx.x;
    if constexpr (KIND == K_PRO) { phase_prologue(F); }
    if constexpr (KIND == K_NSA_IN) { pg8::Gemm g{(const bf16_t*)(ws + WS_HB8), DM / 2, DM / 2, DM / 2}; pg8::StaticOrder S; S.init(MTOK / 256, A_INP / 256, F.G, bx, (const bf16_t*)(ws + WS_WINA) + (size_t)l * A_INP * DM / 2);
        EpiNsaIn E{ws, (const float*)(ws + WS_CS)}; pg8::gemm_phase<EpiNsaIn, pg8::StaticOrder, true, F8_WIN_SH>(ring, g, S, E, F.wave0); }
    if constexpr (KIND == K_CMP_HID) {
        const int kv = (bx >> 5) & 1;
        if (bx < 64) { pg8::Gemm g{(const bf16_t*)(ws + (kv ? RA_VCR : RA_KCR)), 1024, 2048, 2048};
            pg8::StaticOrder S; S.init(32, 1, 32, bx & 31, (const bf16_t*)(ws + WS_WC1) + (size_t)(l * 2 + kv) * 256 * 2048);
            EpiCmpHid E{(bf16_t*)(ws + RA_CH) + (size_t)kv * 8192 * 256, (const float*)(ctl + CW_BIASP) + (l * 2 + kv) * 256};
            pg8::gemm_phase(ring, g, S, E, F.wave0); }
        else phase_vs_transpose(F, l); }
    if constexpr (KIND == K_CMP_OUT) { pg8::Gemm g{(const bf16_t*)(ws + RA_CH), 256, 256, 256}; pg8::DualOrder S; S.init(64, 1, F.G, bx, (const bf16_t*)(ws + WS_WC2) + (size_t)(l * 2) * 256 * 256); S.estride = (size_t)256 * 256;
        EpiCmpOut E{(bf16_t*)(ws + RA_KC), (bf16_t*)(ws + RA_VC)}; pg8::gemm_phase(ring, g, S, E, F.wave0); }
#if NAIVE_NSA
    if constexpr (KIND == K_NSA_ATT) { phase_nsa_naive(F); }
#else
    if constexpr (KIND == K_NSA_ATT) { phase_nsa_fast(F, l); }
#endif
    if constexpr (KIND == K_SWA_IN) { pg8::Gemm g{(const bf16_t*)(ws + WS_HB8), DM / 2, DM / 2, DM / 2}; pg8::StaticOrder S;
        if (l == 2) S.init(MTOK / 256, 5, F.G, bx, (const bf16_t*)(ws + WS_WQKV2)); else S.init(MTOK / 256, 4, F.G, bx, (const bf16_t*)(ws + WS_WQB1));
        EpiSwaIn E{ws, (const float*)(ws + WS_CS)}; pg8::gemm_phase<EpiSwaIn, pg8::StaticOrder, true, F8_WIN_SH>(ring, g, S, E, F.wave0); }
#if NAIVE_SWA
    if constexpr (KIND == K_SWA_ATT) { phase_swa_naive(F, (const float*)ARG_IN(10) + (l - 2) * 16); }
#else
    if constexpr (KIND == K_SWA_ATT) { phase_swa_fast(F, (const float*)ARG_IN(10) + (l - 2) * 16); }
#endif
    if constexpr (KIND == K_OUTPROJ) { pg8::Gemm g{(const bf16_t*)(ws + RA_ATT), DM / 2, DM / 2, DM / 2}; pg8::StaticOrder S;
        S.init(MTOK / 256, 4, F.G, bx, l < 2 ? (const bf16_t*)(ws + WS_WOUTA) + (size_t)l * DM * DM / 2 : (const bf16_t*)(ws + WS_WOUTB) + (size_t)(l - 2) * DM * DM / 2);
        EpiResid E{(const bf16_t*)(ws + WS_HB), (bf16_t*)(ws + WS_Y)}; pg8::gemm_phase<EpiResid, pg8::StaticOrder, true, F8_WIN_SH>(ring, g, S, E, F.wave0); }
    if constexpr (KIND == K_LN1) { phase_ln<0, false, false>(F, l * 2, nullptr, 0); }
    if constexpr (KIND == K_LN1R) { phase_ln<0, true, false>(F, l * 2, nullptr, l >> 1); }
    if constexpr (KIND == K_FFN1) { pg8::Gemm g{(const bf16_t*)(ws + WS_HB), DM, DM, DM}; pg8::StaticOrder S; S.init(MTOK / 256, 2 * DFF / 256, F.G, bx, (const bf16_t*)(ws + WS_WDIN) + (size_t)(l >> 1) * 2 * DFF * DM);
        EpiSwiglu E{(bf16_t*)(ws + WS_ACT), DFF}; pg8::gemm_phase(ring, g, S, E, F.wave0); }
    if constexpr (KIND == K_FFN2) { pg8::Gemm g{(const bf16_t*)(ws + WS_ACT), DFF, DFF, DFF}; pg8::StaticOrder S; S.init(MTOK / 256, 4, F.G, bx, (const bf16_t*)(ws + WS_WDOUT) + (size_t)(l >> 1) * DM * DFF);
        EpiResid E{(const bf16_t*)(ws + WS_HB), (bf16_t*)(ws + WS_Y)}; pg8::gemm_phase(ring, g, S, E, F.wave0); }
    if constexpr (KIND == K_LN2) { phase_ln<0, false, false>(F, l * 2 + 1, nullptr, 0); }
    if constexpr (KIND == K_SCATTER) { phase_moe_scatter(F, l >> 1); }
    if constexpr (KIND == K_MOE1) { const int ml = l >> 1; int ts[9]; moe_tiles((const unsigned*)ctl + CW_MOE + ml * 64, ts);
        pg8::Gemm g{(const bf16_t*)(ws + WS_XB), DM / 2, DM / 2, DM / 2}; pg8::GroupedOrder S; S.init(ts[8], 2 * DFFE / 256, F.G, bx, (const bf16_t*)(ws + WS_WMIN) + (size_t)ml * 8 * DFFE * DM);
        S.t1 = ts[1]; S.t2 = ts[2]; S.t3 = ts[3]; S.t4 = ts[4]; S.t5 = ts[5]; S.t6 = ts[6]; S.t7 = ts[7]; S.estride = (size_t)DFFE * DM;
        EpiSwiglu8 E{ws + WS_ACT, DFFE}; pg8::gemm_phase<EpiSwiglu8, pg8::GroupedOrder, true, F8_WIN_SH>(ring, g, S, E, F.wave0); }
    if constexpr (KIND == K_MOE2) { const int ml = l >> 1; int ts[9]; moe_tiles((const unsigned*)ctl + CW_MOE + ml * 64, ts);
        pg8::Gemm g{(const bf16_t*)(ws + WS_ACT), DFFE / 2, DFFE / 2, DFFE / 2}; pg8::GroupedOrder S; S.init(256, 4, F.G, bx, (const bf16_t*)(ws + WS_WMOUT) + (size_t)ml * 8 * DM * DFFE / 2);
        S.t1 = ts[1]; S.t2 = ts[2]; S.t3 = ts[3]; S.t4 = ts[4]; S.t5 = ts[5]; S.t6 = ts[6]; S.t7 = ts[7]; S.estride = (size_t)DM * DFFE / 2;
        EpiBf16Out E{(bf16_t*)(ws + WS_YB)}; pg8::gemm_phase<EpiBf16Out, pg8::GroupedOrder, true, F8_WOUT_SH>(ring, g, S, E, F.wave0);
        pg8::Gemm g4{(const bf16_t*)(ws + WS_ACT), DFFE / 2, DFFE / 4, DFFE / 2}; pg8::SliceOrder S4; S4.nsl = (ts[8] - 256) * 8; S4.G = F.G; S4.c = (bx + 128) & 255; S4.kq = DFFE / 4;
        S4.bt = (const bf16_t*)(ws + WS_WMOUT) + (size_t)ml * 8 * DM * DFFE / 2; S4.t1 = ts[1]; S4.t2 = ts[2]; S4.t3 = ts[3]; S4.t4 = ts[4]; S4.t5 = ts[5]; S4.t6 = ts[6]; S4.t7 = ts[7]; S4.estride = (size_t)DM * DFFE / 2;
        EpiPart E4{(float*)(ws + WS_H)}; pg8::gemm_phase<EpiPart, pg8::SliceOrder, true, F8_WOUT_SH>(ring, g4, S4, E4, F.wave0); }
    if constexpr (KIND == K_LN2C) { if (l == DEPTH - 1) phase_ln<1, false, true>(F, l * 2 + 1, ARG_OUT(), 0); else phase_ln<1, false, false>(F, l * 2 + 1, nullptr, 0); }
}

DEVI void frame_init(Frame& F, unsigned char* lds_raw) {
    F.lds = (LAS unsigned char*)lds_raw; F.ws = ARG_WS();
    F.wave0 = wave_id_sgpr(); F.tid = threadIdx.x; F.lane = F.tid & 63; F.wave = F.wave0;
    F.G = gridDim.x; { const int bx = blockIdx.x; F.vcu = (F.G % 8 == 0) ? (bx % 8) * (F.G / 8) + bx / 8 : bx; }
}

#if !MK_SINGLE
template <int KIND> __global__ void __launch_bounds__(NWAVES * 64, 2) phase_kernel(Args args) {
    extern __shared__ __attribute__((aligned(16))) unsigned char lds_raw[];
    Frame F; frame_init(F, lds_raw);
    do_phase<KIND>(F, args.ph_lo);
}
template <int KIND> static void launch_kind(const Args& a, hipStream_t stream) {
    static bool attr = false;
    if (!attr) { (void)hipFuncSetAttribute((const void*)phase_kernel<KIND>, hipFuncAttributeMaxDynamicSharedMemorySize, LDS_BYTES); attr = true; }
    hipLaunchKernelGGL(phase_kernel<KIND>, dim3(256), dim3(NWAVES * 64), LDS_BYTES, stream, a);
}
#else
__global__ void __launch_bounds__(NWAVES * 64, 2) yoco_fwd(Args args) {
    extern __shared__ __attribute__((aligned(16))) unsigned char lds_raw[];
    Frame F; frame_init(F, lds_raw);
    volatile LAS unsigned* MISC = (volatile LAS unsigned*)(F.lds + MISC_OFF);
    for (int u = F.tid; u < 256; u += NWAVES * 64) MISC[u] = 0u;
    __syncthreads();
    XcdBarrier bar = xcd_barrier_post((unsigned*)(F.ws + WS_CTL) + CW_BAR, MISC + 8);
#define DUP_KIND 12
#define DUP_KIND 13
#ifndef DUP_KIND
#define DUP_KIND -1
#endif
#define PH(K, L, FIRST) do { do_phase<K>(F, L); if (FIRST) cg::this_grid().sync(); else xcd_barrier(bar); if (K == DUP_KIND) { do_phase<K>(F, L); xcd_barrier(bar); } } while (0)
    PH(K_PRO, 0, true);
#define NSA_LAYER(l) PH(K_NSA_IN, l, false); PH(K_CMP_HID, l, false); PH(K_CMP_OUT, l, false); PH(K_NSA_ATT, l, false); PH(K_OUTPROJ, l, false)
#define SWA_LAYER(l) PH(K_SWA_IN, l, false); PH(K_SWA_ATT, l, false); PH(K_OUTPROJ, l, false)
#define DENSE_FFN(l) PH(K_LN1, l, false); PH(K_FFN1, l, false); PH(K_FFN2, l, false); PH(K_LN2, l, false)
#define MOE_FFN(l, LAST) PH(K_LN1R, l, false); PH(K_SCATTER, l, false); PH(K_MOE1, l, false); PH(K_MOE2, l, false); do_phase<K_LN2C>(F, l); if (!(LAST)) xcd_barrier(bar); else if (DUP_KIND == 16) { xcd_barrier(bar); do_phase<K_LN2C>(F, l); }
    NSA_LAYER(0); DENSE_FFN(0);
    NSA_LAYER(1); MOE_FFN(1, false);
    SWA_LAYER(2); DENSE_FFN(2);
    SWA_LAYER(3); MOE_FFN(3, true);
}
#endif

extern "C" void kernel_launch(void* const* d_in, const int* in_sizes, int n_in, void* d_out, int out_size, void* d_ws, size_t ws_size, hipStream_t stream) {
    static int grid = 0;
    if (grid == 0) {
        if (n_in != 18 || out_size != MTOK * DM || ws_size < WS_END) { fprintf(stderr, "kernel_launch: unexpected shapes (n_in %d out %d ws %zu need %zu)\n", n_in, out_size, ws_size, (size_t)WS_END); grid = -1; return; }
        int dev = 0, cus = 0;
        (void)hipGetDevice(&dev); (void)hipDeviceGetAttribute(&cus, hipDeviceAttributeMultiprocessorCount, dev);
        if (cus < 256) { fprintf(stderr, "kernel_launch: needs 256 CUs, device has %d\n", cus); grid = -1; return; }
#if MK_SINGLE
        int per_cu = 0;
        (void)hipFuncSetAttribute((const void*)yoco_fwd, hipFuncAttributeMaxDynamicSharedMemorySize, LDS_BYTES);
        (void)hipOccupancyMaxActiveBlocksPerMultiprocessor(&per_cu, (const void*)yoco_fwd, NWAVES * 64, LDS_BYTES);
        if (per_cu < 1) fprintf(stderr, "kernel_launch: occupancy query says %d blocks per CU\n", per_cu);
        (void)hipGetLastError();
#endif
        grid = 256;
    }
    if (grid < 0) return;
    (void)hipMemsetAsync((char*)d_ws + WS_CTL, 0, CTL_BYTES, stream);
    Args a{};
    for (int i = 0; i < 18; ++i) a.in[i] = d_in[i];
    a.out = (float*)d_out; a.ws = (unsigned char*)d_ws;
#if MK_SINGLE
    a.ph_lo = 0; a.ph_hi = NPH;
    void* kargs[] = {&a};
    hipError_t e = hipLaunchCooperativeKernel((const void*)yoco_fwd, dim3(grid), dim3(NWAVES * 64), kargs, LDS_BYTES, stream);
    if (e != hipSuccess) fprintf(stderr, "cooperative launch failed: %s (grid %d)\n", hipGetErrorString(e), grid);
#else
    for (int p = 0; p < NPH; ++p) {
        a.ph_lo = h_prog[p].layer; a.ph_hi = 0;
        switch (h_prog[p].kind) {
#define LK(K) case K: launch_kind<K>(a, stream); break;
            LK(K_PRO) LK(K_NSA_IN) LK(K_CMP_HID) LK(K_CMP_OUT) LK(K_NSA_ATT) LK(K_SWA_IN) LK(K_SWA_ATT) LK(K_OUTPROJ) LK(K_LN1) LK(K_LN1R) LK(K_FFN1) LK(K_FFN2) LK(K_LN2) LK(K_SCATTER) LK(K_MOE1) LK(K_MOE2) LK(K_LN2C)
#undef LK
            default: break;
        }
    }
#endif
}
```

```cpp
#include <hip/hip_runtime.h>
#include <hip/hip_cooperative_groups.h>
#include <cstdio>
#include <cstdint>
namespace cg = cooperative_groups;

#ifndef DBG_DROP
#define DBG_DROP 0
#endif
#ifndef NAIVE_NSA
#define NAIVE_NSA 0
#endif
#ifndef NAIVE_SWA
#define NAIVE_SWA 0
#endif
#if NAIVE_NSA || NAIVE_SWA
#error "the naive attention references write bf16 attention rows; the out-projection now reads e4m3"
#endif
#ifndef MK_SINGLE
#define MK_SINGLE 1
#endif

#define DEVI __device__ __forceinline__
#define LAS __attribute__((address_space(3)))
#define GAS __attribute__((address_space(1)))
typedef unsigned short bf16_t;
typedef short bf16x8 __attribute__((ext_vector_type(8)));
typedef float f32x4 __attribute__((ext_vector_type(4)));
typedef float f32x2 __attribute__((ext_vector_type(2)));
typedef unsigned u32x4 __attribute__((ext_vector_type(4)));
typedef unsigned u32x2 __attribute__((ext_vector_type(2)));

constexpr int BATCH = 2, SEQ = 16384, MTOK = BATCH * SEQ, DM = 1024, DEPTH = 4;
constexpr int HD = 64;
constexpr int A_G = 4, A_R = 4, A_IN = 2608, A_INP = 2816;
constexpr int NCMP = 1023, CMP_HID = 256;
constexpr int NSLC = SEQ / 64, NSEL = 16, NSA_WIN = 512;
constexpr int B_G = 2, B_R = 8, SWA_WIN = 128;
constexpr int DFF = 2816, NEXP = 8, DFFE = 3584;
constexpr int CAP = MTOK * 2 + NEXP * 256;
constexpr float ALPHA = 1.6817928305074292f;
constexpr float LN_EPS = 1e-5f;
constexpr float QSCALE = 0.125f;

constexpr size_t al256(size_t x) { return (x + 255) & ~(size_t)255; }
constexpr size_t WS_CTL = 0, CTL_BYTES = 1u << 20;
constexpr size_t WS_WINA = CTL_BYTES;
constexpr size_t WS_WOUTA = WS_WINA + (size_t)2 * A_INP * DM * 2;
constexpr size_t WS_WC1 = WS_WOUTA + (size_t)2 * DM * DM * 2;
constexpr size_t WS_WC2 = WS_WC1 + (size_t)4 * 256 * 2048 * 2;
constexpr size_t WS_WQKV2 = WS_WC2 + (size_t)4 * 256 * 256 * 2;
constexpr size_t WS_WQB1 = WS_WQKV2 + (size_t)1280 * DM * 2;
constexpr size_t WS_WOUTB = WS_WQB1 + (size_t)DM * DM * 2;
constexpr size_t WS_WDIN = WS_WOUTB + (size_t)2 * DM * DM * 2;
constexpr size_t WS_WDOUT = WS_WDIN + (size_t)2 * 2 * DFF * DM * 2;
constexpr size_t WS_WMIN = WS_WDOUT + (size_t)2 * DM * DFF * 2;
constexpr size_t WS_WMOUT = WS_WMIN + (size_t)16 * 2 * DFFE * DM * 2;
constexpr size_t WS_HB8 = WS_WMIN + (size_t)16 * 2 * DFFE * DM;
constexpr size_t WS_WEND = WS_WMOUT + (size_t)16 * DM * DFFE * 2;
constexpr size_t WS_H = al256(WS_WEND);
constexpr size_t WS_Y = WS_H + (size_t)MTOK * DM * 4;
constexpr size_t WS_HB = WS_Y + (size_t)MTOK * DM * 4;
constexpr size_t WS_CS = WS_HB + (size_t)MTOK * DM * 2;
constexpr size_t WS_KSH = WS_CS + (size_t)MTOK * 16 * 4;
constexpr size_t WS_VSH = WS_KSH + (size_t)MTOK * 128 * 2;
constexpr size_t WS_ROUTE = WS_VSH + (size_t)MTOK * 128 * 2;
constexpr size_t WS_XB = WS_ROUTE + (size_t)MTOK * 2 * 4 * 4;
constexpr size_t WS_ACT = WS_XB + (size_t)CAP * DM * 2;
constexpr size_t WS_RA = WS_ACT + (size_t)CAP * DFFE * 2;
constexpr size_t SLAB = (size_t)MTOK * 256 * 2;
constexpr size_t RA_Q = WS_RA;
constexpr size_t RA_ATT = RA_Q + (size_t)MTOK * DM * 2;
constexpr size_t RA_KCR = RA_ATT + (size_t)MTOK * DM * 2;
constexpr size_t RA_VCR = RA_KCR + SLAB + 4096;
constexpr size_t RA_KS = RA_VCR + SLAB + 4096;
constexpr size_t RA_VS = RA_KS + SLAB;
constexpr size_t RA_KW = RA_VS + SLAB;
constexpr size_t RA_VW = RA_KW + SLAB;
constexpr size_t RA_GATE = RA_VW + SLAB;
constexpr size_t RA_KC = RA_GATE + (size_t)MTOK * 48 * 4;
constexpr size_t RA_VC = RA_KC + (size_t)8192 * 64 * 2;
constexpr size_t RA_CH = RA_VC + (size_t)8192 * 64 * 2;
constexpr size_t RA_VST = RA_CH + (size_t)2 * 8192 * 256 * 2;
constexpr size_t RA_K8 = RA_VST + SLAB / 2;
constexpr size_t RA_END = RA_VST + SLAB;
constexpr size_t WS_YB = WS_RA;
constexpr size_t YB_END = WS_YB + (size_t)CAP * DM * 4;
constexpr size_t WS_END = (RA_END > YB_END ? RA_END : YB_END);
static_assert(WS_END < (size_t)1879048192, "workspace map exceeds 4x the largest tensor");

constexpr int CW_BAR = 4096;
constexpr int CW_MOE = 16384;
constexpr int CW_WGCNT = 45056;
constexpr int CW_KWMAX = 40128;
constexpr int CW_KMAX = 40064;
constexpr int CW_VMAX = 40000;
constexpr int CW_BIASP = 32768;

constexpr int RING_BYTES = 131072;
constexpr int LDS_X = RING_BYTES;
constexpr int MISC_OFF = RING_BYTES + 16384;
constexpr int LDS_BYTES = MISC_OFF + 1024;

DEVI unsigned f2bf(float f) { unsigned u = __builtin_bit_cast(unsigned, f); return (u + 0x7fffu + ((u >> 16) & 1u)) >> 16; }
DEVI unsigned pk2(float lo, float hi) { return f2bf(lo) | (f2bf(hi) << 16); }
DEVI float bf2f(unsigned h) { return __builtin_bit_cast(float, h << 16); }
DEVI float bflo(unsigned w) { return __builtin_bit_cast(float, w << 16); }
DEVI float bfhi(unsigned w) { return __builtin_bit_cast(float, w & 0xffff0000u); }
DEVI float clamp8(float x) { return __builtin_amdgcn_fmed3f(x, -448.f, 448.f); }
DEVI unsigned pack_fp8x4(float a, float b, float c, float d) {
    const int w = __builtin_amdgcn_cvt_pk_fp8_f32(clamp8(a), clamp8(b), 0, false);
    return (unsigned)__builtin_amdgcn_cvt_pk_fp8_f32(clamp8(c), clamp8(d), w, true);
}
DEVI float shx(float v, int mask, int lane) { return __builtin_bit_cast(float, __builtin_amdgcn_ds_bpermute((lane ^ mask) << 2, __builtin_bit_cast(int, v))); }
DEVI int shxi(int v, int mask, int lane) { return __builtin_amdgcn_ds_bpermute((lane ^ mask) << 2, v); }
DEVI float wave_sum(float v, int lane) {
#pragma unroll
    for (int o = 1; o < 64; o <<= 1) v += shx(v, o, lane);
    return v;
}
DEVI float wave_max(float v, int lane) {
#pragma unroll
    for (int o = 1; o < 64; o <<= 1) v = fmaxf(v, shx(v, o, lane));
    return v;
}
DEVI int wave_id_sgpr() { return __builtin_amdgcn_readfirstlane((int)threadIdx.x >> 6); }
DEVI int opaque_tid(int wave) { asm volatile("" : "+s"(wave)); int l; asm volatile("v_mbcnt_lo_u32_b32 %0, -1, 0\n\tv_mbcnt_hi_u32_b32 %0, -1, %0" : "=v"(l)); return wave * 64 + l; }
#define LDS_WAIT() asm volatile("s_waitcnt lgkmcnt(0)" ::: "memory")
#define VM_WAIT() asm volatile("s_waitcnt vmcnt(0)" ::: "memory")

namespace pg8 {
constexpr int BM = 256, BK = 64, HALF = 128, HTB = HALF * BK * 2, STAGE_BYTES = 8 * HTB, NXCD = 8, WGM = 8;
DEVI int lds_byte(int r, int c) { const int st = (r >> 4) * 2 + (c >> 5), rr = r & 15, cc = c & 31, ob = rr * 64 + cc * 2; return st * 1024 + (ob ^ (((ob >> 9) & 1) << 5)); }
DEVI void stage_rc(int b, int& R, int& C) { const int st = b / 1024, sb = b % 1024, swz = sb ^ (((sb >> 9) & 1) << 5); R = (st >> 1) * 16 + swz / 64; C = (st & 1) * 32 + (swz % 64) / 2; }
DEVI int perm32(int rho) { const int n = rho >> 4, i = rho & 15; return 8 * (i >> 2) + 4 * n + (i & 3); }

struct Unit { int pm, pn; const bf16_t* bt; int koff, z; };
struct Gemm { const bf16_t* A; int lda; int K; int ldb; };

struct StaticOrder {
    int nM, nN, nwg, G, c; const bf16_t* bt;
    DEVI void init(int nM_, int nN_, int G_, int c_, const bf16_t* bt_) { nM = nM_; nN = nN_; nwg = nM * nN; G = G_; c = c_; bt = bt_; }
    DEVI bool tile(int i, int& pm, int& pn) const {
        const long L = (long)i * G + c; if (L >= nwg) return false;
        int wgid = (int)L; { const int q = nwg / NXCD, r = nwg % NXCD, xcd = wgid % NXCD, off = wgid / NXCD; wgid = (xcd < r ? xcd * (q + 1) : r * (q + 1) + (xcd - r) * q) + off; }
        const int nig = WGM * nN, gid = wgid / nig, fm = gid * WGM, gsz = (nM - fm) < WGM ? (nM - fm) : WGM;
        pm = fm + ((wgid % nig) % gsz); pn = (wgid % nig) / gsz; return true;
    }
    DEVI bool next(int i, Unit& u) const { if (!tile(i, u.pm, u.pn)) return false; u.bt = bt; u.koff = 0; u.z = 0; return true; }
};
struct GroupedOrder : StaticOrder {
    int t1, t2, t3, t4, t5, t6, t7; size_t estride;
    DEVI bool next(int i, Unit& u) const {
        if (!tile(i, u.pm, u.pn)) return false;
        const int tm = u.pm; const int e = (tm >= t1) + (tm >= t2) + (tm >= t3) + (tm >= t4) + (tm >= t5) + (tm >= t6) + (tm >= t7);
        u.bt = bt + (size_t)e * estride; u.koff = 0; u.z = 0; return true;
    }
};
struct SliceOrder {
    int nsl, G, c, kq; const bf16_t* bt; int t1, t2, t3, t4, t5, t6, t7; size_t estride;
    DEVI bool next(int i, Unit& u) const {
        const int L = i * G + c; if (L >= nsl) return false;
        u.pm = 256 + (L >> 3); u.pn = (L & 7) >> 1; u.z = L & 1; u.koff = u.z * kq;
        const int tm = u.pm; const int e = (tm >= t1) + (tm >= t2) + (tm >= t3) + (tm >= t4) + (tm >= t5) + (tm >= t6) + (tm >= t7);
        u.bt = bt + (size_t)e * estride; return true;
    }
};
struct DualOrder : StaticOrder {
    size_t estride;
    DEVI bool next(int i, Unit& u) const { if (!tile(i, u.pm, u.pn)) return false; u.bt = bt + (u.pm >= nM / 2 ? estride : 0); u.koff = 0; u.z = 0; return true; }
};

DEVI unsigned cvt_pk_bf16(float lo, float hi) { typedef __bf16 bf16x2_t __attribute__((ext_vector_type(2))); f32x2 v = {lo, hi}; bf16x2_t b = __builtin_convertvector(v, bf16x2_t); return __builtin_bit_cast(unsigned, b); }

typedef int v4i_t __attribute__((ext_vector_type(4)));
typedef int v8i_t __attribute__((ext_vector_type(8)));
template <int F8SH> DEVI void mma_block(f32x4 (&acc)[4][2], const bf16x8 (&At)[4][2], const bf16x8 (&Bt)[2][2]) {
    if constexpr (F8SH < 0) {
#pragma unroll
        for (int m = 0; m < 4; ++m)
#pragma unroll
            for (int n = 0; n < 2; ++n)
#pragma unroll
                for (int k = 0; k < 2; ++k) acc[m][n] = __builtin_amdgcn_mfma_f32_16x16x32_bf16(Bt[n][k], At[m][k], acc[m][n], 0, 0, 0);
    } else {
#pragma unroll
        for (int m = 0; m < 4; ++m)
#pragma unroll
            for (int n = 0; n < 2; ++n) {
                const v8i_t a8 = __builtin_shufflevector(__builtin_bit_cast(v4i_t, At[m][0]), __builtin_bit_cast(v4i_t, At[m][1]), 0, 1, 2, 3, 4, 5, 6, 7);
                const v8i_t b8 = __builtin_shufflevector(__builtin_bit_cast(v4i_t, Bt[n][0]), __builtin_bit_cast(v4i_t, Bt[n][1]), 0, 1, 2, 3, 4, 5, 6, 7);
                asm volatile("v_mfma_f32_16x16x128_f8f6f4 %0, %1, %2, %0" : "+v"(acc[m][n]) : "v"(b8), "v"(a8)); }
    }
}
template <class Epi, class Sched, bool ALIGN_EPI = true, int F8SH = -1>
DEVI void gemm_phase(LAS unsigned char* lds, const Gemm g, const Sched& S, const Epi& E, int wave0) {
    const int tid = opaque_tid(wave0), wid = __builtin_amdgcn_readfirstlane(tid >> 6), lane = tid & 63, wr = wid >> 2, wc = wid & 3, fr = lane & 15, fq = lane >> 4;
    const int K = g.K, nt = K / BK, lda = g.lda, ldb = g.ldb;
    unsigned voffA[2], voffB[2];
#pragma unroll
    for (int i = 0; i < 2; ++i) { int R, C; stage_rc(tid * 16 + i * 8192, R, C); const int Rb = Epi::PERM ? ((R & ~31) + perm32(R & 31)) : R;
        voffA[i] = (unsigned)(R * lda + C) * 2u; voffB[i] = (unsigned)(Rb * ldb + C) * 2u; }
    const size_t kstep = (size_t)(BK * 2);
    const size_t hstepA = (size_t)HALF * lda * 2, tstepA = 2 * hstepA;
    const size_t hstepB = (size_t)HALF * ldb * 2, tstepB = 2 * hstepB;
    const unsigned ldsw = (unsigned)wid * 1024u;
    const int aoff = lds_byte(wr * 64 + fr, fq * 8), boff = lds_byte(wc * 32 + fr, fq * 8);
#define PG8_SA(b, h) (((b) * 2 + (h)) * HTB)
#define PG8_SB(b, h) ((4 + (b) * 2 + (h)) * HTB)
#define PG8_STAGE(bufoff, gbase, voff) do { _Pragma("unroll") for (int _i = 0; _i < 2; ++_i) \
        __builtin_amdgcn_global_load_lds((const unsigned*)((const char*)(gbase) + (voff)[_i]), (LAS unsigned*)(lds + (bufoff) + ldsw + _i * 8192), 16, 0, 0); } while (0)
#define PG8_LDA(dst, b, h) do { _Pragma("unroll") for (int m = 0; m < 4; ++m) _Pragma("unroll") for (int k = 0; k < 2; ++k) dst[m][k] = *(const LAS bf16x8*)(lds + PG8_SA(b, h) + aoff + m * 2048 + k * 1024); } while (0)
#define PG8_LDB(dst, b, h) do { _Pragma("unroll") for (int n = 0; n < 2; ++n) _Pragma("unroll") for (int k = 0; k < 2; ++k) dst[n][k] = *(const LAS bf16x8*)(lds + PG8_SB(b, h) + boff + n * 2048 + k * 1024); } while (0)
#define PG8_MMA(ai, bj, At, Bt) do { __builtin_amdgcn_s_setprio(1); mma_block<F8SH>(acc[ai][bj], At, Bt); __builtin_amdgcn_s_setprio(0); } while (0)
#define PG8_WAIT_V(n) asm volatile("s_waitcnt vmcnt(" #n ")" ::: "memory")
#define PG8_WAIT_L(n) asm volatile("s_waitcnt lgkmcnt(" #n ")" ::: "memory")
#define PG8_BAR __builtin_amdgcn_s_barrier()
#define PG8_SCHED __builtin_amdgcn_sched_barrier(0)
    Unit cur, nxt; int ui = 0;
    if (!S.next(0, cur)) return;
    f32x4 acc[2][2][4][2];
#pragma unroll
    for (int a = 0; a < 2; ++a)
#pragma unroll
        for (int b = 0; b < 2; ++b)
#pragma unroll
            for (int m = 0; m < 4; ++m)
#pragma unroll
                for (int n = 0; n < 2; ++n) acc[a][b][m][n] = (f32x4){0.f, 0.f, 0.f, 0.f};
    bf16x8 At[4][2], B0[2][2], B1[2][2];
    const char* cA = (const char*)g.A + (size_t)cur.pm * tstepA + (size_t)cur.koff * 2; const char* cB = (const char*)cur.bt + (size_t)cur.pn * tstepB + (size_t)cur.koff * 2;
    PG8_STAGE(PG8_SB(0, 0), cB, voffB); PG8_STAGE(PG8_SB(0, 1), cB + hstepB, voffB); PG8_STAGE(PG8_SA(0, 0), cA, voffA); PG8_STAGE(PG8_SA(0, 1), cA + hstepA, voffA);
    if (wr == 1) PG8_BAR;
    PG8_WAIT_V(2); PG8_BAR;
    PG8_STAGE(PG8_SB(1, 0), cB + kstep, voffB); PG8_STAGE(PG8_SA(1, 0), cA + kstep, voffA); PG8_STAGE(PG8_SB(1, 1), cB + hstepB + kstep, voffB);
    PG8_WAIT_V(6); PG8_BAR;
    for (;;) {
        const bool has_next = S.next(ui + 1, nxt);
        const char* nA = has_next ? (const char*)g.A + (size_t)nxt.pm * tstepA + (size_t)nxt.koff * 2 : cA; const char* nB = has_next ? (const char*)nxt.bt + (size_t)nxt.pn * tstepB + (size_t)nxt.koff * 2 : cB;
#pragma unroll 1
        for (int t = 0; t < nt; t += 2) {
            const bool last = (t == nt - 2);
            const char* a1 = cA + (size_t)(t + 1) * kstep;
            const char* a2 = last ? nA : cA + (size_t)(t + 2) * kstep; const char* b2 = last ? nB : cB + (size_t)(t + 2) * kstep;
            const char* a3 = a2 + kstep; const char* b3 = b2 + kstep;
            PG8_LDB(B0, 0, 0); PG8_LDB(B1, 0, 1); PG8_SCHED; PG8_LDA(At, 0, 0); PG8_STAGE(PG8_SA(1, 1), a1 + hstepA, voffA);
            PG8_WAIT_V(8); PG8_WAIT_L(0); PG8_BAR; PG8_MMA(0, 0, At, B0); PG8_MMA(0, 1, At, B1); PG8_BAR; PG8_SCHED;
            PG8_LDA(At, 0, 1); PG8_STAGE(PG8_SB(0, 0), b2, voffB); PG8_STAGE(PG8_SB(0, 1), b2 + hstepB, voffB); PG8_STAGE(PG8_SA(0, 0), a2, voffA);
            PG8_WAIT_V(8); PG8_WAIT_L(0); PG8_BAR; PG8_MMA(1, 0, At, B0); PG8_MMA(1, 1, At, B1); PG8_BAR; PG8_SCHED;
            PG8_LDB(B0, 1, 0); PG8_LDB(B1, 1, 1); PG8_SCHED; PG8_LDA(At, 1, 0); PG8_STAGE(PG8_SA(0, 1), a2 + hstepA, voffA);
            PG8_WAIT_V(8); PG8_WAIT_L(0); PG8_BAR; PG8_MMA(0, 0, At, B0); PG8_MMA(0, 1, At, B1); PG8_BAR; PG8_SCHED;
            PG8_LDA(At, 1, 1); PG8_STAGE(PG8_SB(1, 0), b3, voffB); PG8_STAGE(PG8_SB(1, 1), b3 + hstepB, voffB); PG8_STAGE(PG8_SA(1, 0), a3, voffA);
            PG8_WAIT_V(8); PG8_WAIT_L(0); PG8_BAR; PG8_MMA(1, 0, At, B0); PG8_MMA(1, 1, At, B1); PG8_BAR; PG8_SCHED;
        }
        if constexpr (F8SH >= 0) { asm volatile("s_nop 15\n\ts_nop 15" ::: "memory"); PG8_SCHED; }
        if constexpr (F8SH >= 0) {
#pragma unroll
            for (int a = 0; a < 2; ++a)
#pragma unroll
                for (int b = 0; b < 2; ++b)
#pragma unroll
                    for (int m = 0; m < 4; ++m)
#pragma unroll
                        for (int n = 0; n < 2; ++n) acc[a][b][m][n] = acc[a][b][m][n] * (1.f / (float)(1 << F8SH));
        }
        if constexpr (ALIGN_EPI) { if (wr == 0) PG8_BAR; }
        E(acc, cur, wr, wc, fr, fq);
        if (!has_next) break;
#pragma unroll
        for (int a = 0; a < 2; ++a)
#pragma unroll
            for (int b = 0; b < 2; ++b)
#pragma unroll
                for (int m = 0; m < 4; ++m)
#pragma unroll
                    for (int n = 0; n < 2; ++n) acc[a][b][m][n] = (f32x4){0.f, 0.f, 0.f, 0.f};
        cur = nxt; cA = nA; cB = nB; ++ui;
        if constexpr (ALIGN_EPI) { if (wr == 1) PG8_BAR; }
    }
    PG8_WAIT_V(0);
    if constexpr (!ALIGN_EPI) { if (wr == 0) PG8_BAR; }
    PG8_BAR;
#undef PG8_SA
#undef PG8_SB
#undef PG8_STAGE
#undef PG8_LDA
#undef PG8_LDB
#undef PG8_MMA
#undef PG8_WAIT_V
#undef PG8_WAIT_L
#undef PG8_BAR
#undef PG8_SCHED
}
}

#define XB_TMO      128
#define XB_XCNT(j)  (256  + 64 * (j))
#define XB_XSUB(j)  (1280 + 64 * (j))
#define XB_XGEN(j)  (2304 + 64 * (j))
#define XB_TOP      3328
#define XB_TOPGEN   3392
#define XCD_BAR_WORDS 3456
#define XB_SPIN_CAP (1u << 22)
DEVI unsigned xb_ld(unsigned* p)              { return __hip_atomic_load(p, __ATOMIC_RELAXED, __HIP_MEMORY_SCOPE_AGENT); }
DEVI unsigned xb_add(unsigned* p, unsigned v) { return __hip_atomic_fetch_add(p, v, __ATOMIC_RELAXED, __HIP_MEMORY_SCOPE_AGENT); }
DEVI unsigned xb_xcc_id() { return (unsigned)__builtin_amdgcn_s_getreg((3 << 11) | 20) & 0xFu; }
#define XB_SPIN(cond, bar) do { unsigned _sp = 0; while (cond) { __builtin_amdgcn_s_sleep(1); \
    if ((++_sp & 255u) == 0u) { if (xb_ld(&(bar)[XB_TMO])) break; if (_sp > XB_SPIN_CAP) { atomicAdd(&(bar)[XB_TMO], 1u); break; } } } } while (0)
struct XcdBarrier { unsigned* bar; unsigned x; volatile LAS unsigned* st; };
DEVI XcdBarrier xcd_barrier_post(unsigned* bar, volatile LAS unsigned* st) {
    XcdBarrier b; b.bar = bar; b.x = xb_xcc_id(); b.st = st;
    if (threadIdx.x == 0) (void)xb_add(&bar[XB_XCNT(b.x)], 1u);
    return b;
}
DEVI void xcd_barrier_complete(unsigned* bar, unsigned x, unsigned& nloc, unsigned& nx) {
    const unsigned G = gridDim.x * gridDim.y * gridDim.z;
    unsigned sum, cnt, mine, sp = 0u;
    for (;;) {
        sum = 0u; cnt = 0u; mine = 0u;
#pragma unroll
        for (unsigned j = 0; j < 16; ++j) { const unsigned c = xb_ld(&bar[XB_XCNT(j)]); sum += c; cnt += (c > 0u) ? 1u : 0u; mine = (j == x) ? c : mine; }
        if (sum == G) break;
        __builtin_amdgcn_s_sleep(1);
        if ((++sp & 255u) == 0u) { if (xb_ld(&bar[XB_TMO])) break; if (sp > XB_SPIN_CAP) { atomicAdd(&bar[XB_TMO], 1u); break; } }
    }
    nloc = mine > 0u ? mine : 1u; nx = cnt > 0u ? cnt : 1u;
}
DEVI void xcd_barrier(const XcdBarrier& b) {
    asm volatile("s_waitcnt vmcnt(0)" ::: "memory");
    __syncthreads();
    if (threadIdx.x == 0) {
        unsigned* bar = b.bar;
        __builtin_amdgcn_s_waitcnt(0);
        unsigned nloc = b.st[0], nx = b.st[1];
        if (nloc == 0u) { xcd_barrier_complete(bar, b.x, nloc, nx); b.st[0] = nloc; b.st[1] = nx; }
        const unsigned old = xb_add(&bar[XB_XSUB(b.x)], 1u);
        const unsigned gen = old / nloc;
        if (old + 1u == (gen + 1u) * nloc) {
            __builtin_amdgcn_fence(__ATOMIC_RELEASE, "agent");
            asm volatile("s_waitcnt vmcnt(0)" ::: "memory");
            const unsigned og = xb_add(&bar[XB_TOP], 1u);
            const unsigned tg = og / nx;
            if (og + 1u == (tg + 1u) * nx) xb_add(&bar[XB_TOPGEN], 1u);
            else XB_SPIN(xb_ld(&bar[XB_TOPGEN]) == tg, bar);
            __builtin_amdgcn_fence(__ATOMIC_ACQUIRE, "agent");
            xb_add(&bar[XB_XGEN(b.x)], 1u);
            asm volatile("s_waitcnt vmcnt(0)" ::: "memory");
        } else {
            XB_SPIN(xb_ld(&bar[XB_XGEN(b.x)]) == gen, bar);
            __builtin_amdgcn_fence(__ATOMIC_ACQUIRE, "agent");
            asm volatile("s_waitcnt vmcnt(0)" ::: "memory");
        }
    }
    __syncthreads();
}

typedef const void* cvp_t;
DEVI const void* karg_ptr(int byte_off) { asm volatile("" : "+s"(byte_off)); const __attribute__((address_space(4))) char* kp = (const __attribute__((address_space(4))) char*)__builtin_amdgcn_kernarg_segment_ptr(); return *(const __attribute__((address_space(4))) cvp_t*)(kp + byte_off); }
#define ARG_IN(i) karg_ptr((i) * 8)
#define ARG_OUT() ((float*)karg_ptr(18 * 8))
#define ARG_WS() ((unsigned char*)karg_ptr(19 * 8))
struct Frame {
    LAS unsigned char* lds;
    unsigned char* ws;
    int tid, lane, wave, G, vcu, wave0;
    DEVI void refresh() { tid = opaque_tid(wave0); lane = tid & 63; wave = __builtin_amdgcn_readfirstlane(tid >> 6); }
};
constexpr int NWAVES = 8;
constexpr int F8_WIN_SH = 5, F8_WOUT_SH = 6;
constexpr float F8_WIN_MUL = 32.f, F8_WOUT_MUL = 64.f;

DEVI void transpose_item(const float* W, int K, int N, bf16_t* WT, int k0, int n0, int drow0, LAS float* scr, int lane, float f8mul) {
    const int nc = n0 + 4 * (lane & 7); const bool ok = nc < N;
#pragma unroll
    for (int i = 0; i < 8; ++i) { const int kk = 8 * i + (lane >> 3); const f32x4 v = ok ? *(const f32x4*)(W + (size_t)(k0 + kk) * N + nc) : (f32x4){0.f, 0.f, 0.f, 0.f};
        LAS float* d = scr + kk * 33 + 4 * (lane & 7); d[0] = v[0]; d[1] = v[1]; d[2] = v[2]; d[3] = v[3]; }
    LDS_WAIT(); asm volatile("" ::: "memory");
    const int c = lane & 7;
#pragma unroll
    for (int j = 0; j < 4; ++j) { const int n = (lane >> 3) + 8 * j; const LAS float* s = scr + (8 * c) * 33 + n;
        if (f8mul > 0.f) { u32x2 o8; o8[0] = pack_fp8x4(s[0 * 33] * f8mul, s[1 * 33] * f8mul, s[2 * 33] * f8mul, s[3 * 33] * f8mul); o8[1] = pack_fp8x4(s[4 * 33] * f8mul, s[5 * 33] * f8mul, s[6 * 33] * f8mul, s[7 * 33] * f8mul);
            *(u32x2*)((unsigned char*)WT + (size_t)(drow0 + n) * K + k0 + 8 * c) = o8; continue; }
        u32x4 o; o.x = pk2(s[0 * 33], s[1 * 33]); o.y = pk2(s[2 * 33], s[3 * 33]); o.z = pk2(s[4 * 33], s[5 * 33]); o.w = pk2(s[6 * 33], s[7 * 33]);
        *(u32x4*)(WT + (size_t)(drow0 + n) * K + k0 + 8 * c) = o; }
    LDS_WAIT(); asm volatile("" ::: "memory");
}
struct WFam { const float* src; size_t sstride; bf16_t* dst; size_t dstride; int count, K, N, Npad, mode; float f8mul; };
DEVI bool wfam_do(const WFam& f, int& it, LAS float* scr, int lane) {
    const int nkb = f.K / 64, nnb = f.Npad / 32, per = nkb * nnb, tot = per * f.count;
    if (it >= tot) { it -= tot; return false; }
    const int mi = it / per, r = it % per, kb = r / nnb, nb = r % nnb, n0 = nb * 32;
    int drow0 = n0;
    if (f.mode == 1) { const int F = f.N / 2; const int o = n0 < F ? n0 : n0 - F; drow0 = 256 * (o / 128) + (o % 128) + (n0 < F ? 0 : 128); }
    transpose_item(f.src + (size_t)mi * f.sstride, f.K, f.N, f.dst + (size_t)mi * f.dstride, kb * 64, n0, drow0, scr, lane, f.f8mul);
    return true;
}

DEVI void phase_prologue(Frame& F) {
    F.refresh();
    LAS float* scr = (LAS float*)(F.lds + F.wave * 16384);
    const int gw = F.vcu * NWAVES + F.wave, NGW = F.G * NWAVES;
    unsigned char* ws = F.ws;
    const WFam fam[11] = {
        {(const float*)ARG_IN(2), (size_t)DM * A_IN, (bf16_t*)(ws + WS_WINA), (size_t)A_INP * DM / 2, 2, DM, A_IN, A_INP, 0, F8_WIN_MUL},
        {(const float*)ARG_IN(3), (size_t)DM * DM, (bf16_t*)(ws + WS_WOUTA), (size_t)DM * DM / 2, 2, DM, DM, DM, 0, F8_WIN_MUL},
        {(const float*)ARG_IN(5), (size_t)2048 * 256, (bf16_t*)(ws + WS_WC1), (size_t)256 * 2048, 4, 2048, 256, 256, 0, 0.f},
        {(const float*)ARG_IN(6), (size_t)256 * 64, (bf16_t*)(ws + WS_WC2), (size_t)256 * 256, 4, 256, 64, 256, 0, 0.f},
        {(const float*)ARG_IN(8), (size_t)DM * DM, (bf16_t*)(ws + WS_WQKV2), 0, 1, DM, DM, DM, 0, F8_WIN_MUL},
        {(const float*)ARG_IN(7), 0, (bf16_t*)(ws + WS_WQKV2) + (size_t)DM * DM / 2, 0, 1, DM, 256, 256, 0, F8_WIN_MUL},
        {(const float*)ARG_IN(8) + (size_t)DM * DM, 0, (bf16_t*)(ws + WS_WQB1), 0, 1, DM, DM, DM, 0, F8_WIN_MUL},
        {(const float*)ARG_IN(9), (size_t)DM * DM, (bf16_t*)(ws + WS_WOUTB), (size_t)DM * DM / 2, 2, DM, DM, DM, 0, F8_WIN_MUL},
        {(const float*)ARG_IN(13), (size_t)DM * 2 * DFF, (bf16_t*)(ws + WS_WDIN), (size_t)2 * DFF * DM, 2, DM, 2 * DFF, 2 * DFF, 1, 0.f},
        {(const float*)ARG_IN(14), (size_t)DFF * DM, (bf16_t*)(ws + WS_WDOUT), (size_t)DM * DFF, 2, DFF, DM, DM, 0, 0.f},
        {(const float*)ARG_IN(16), (size_t)DM * 2 * DFFE, (bf16_t*)(ws + WS_WMIN), (size_t)DFFE * DM, 16, DM, 2 * DFFE, 2 * DFFE, 1, F8_WIN_MUL},
    };
    const WFam famo = {(const float*)ARG_IN(17), (size_t)DFFE * DM, (bf16_t*)(ws + WS_WMOUT), (size_t)DM * DFFE / 2, 16, DFFE, DM, DM, 0, F8_WOUT_MUL};
    int total = 0;
#pragma unroll
    for (int i = 0; i < 11; ++i) total += (fam[i].K / 64) * (fam[i].Npad / 32) * fam[i].count;
    total += (famo.K / 64) * (famo.Npad / 32) * famo.count;
    for (int it0 = gw; it0 < total; it0 += NGW) {
        int it = it0; bool done = false;
#pragma unroll
        for (int i = 0; i < 11; ++i) if (!done) done = wfam_do(fam[i], it, scr, F.lane);
        if (!done) wfam_do(famo, it, scr, F.lane);
    }
    { const float* x = (const float*)ARG_IN(0); bf16_t* hb = (bf16_t*)(ws + WS_HB);
      const size_t n8 = (size_t)MTOK * DM / 8;
      for (size_t i = (size_t)blockIdx.x * 512 + F.tid; i < n8; i += (size_t)F.G * 512) {
          const f32x4 v0 = *(const f32x4*)(x + i * 8), v1 = *(const f32x4*)(x + i * 8 + 4);
          u32x4 o; o.x = pk2(v0.x, v0.y); o.y = pk2(v0.z, v0.w); o.z = pk2(v1.x, v1.y); o.w = pk2(v1.z, v1.w);
          *(u32x4*)(hb + i * 8) = o;
          u32x2 o8; o8[0] = pack_fp8x4(v0.x, v0.y, v0.z, v0.w); o8[1] = pack_fp8x4(v1.x, v1.y, v1.z, v1.w); *(u32x2*)(ws + WS_HB8 + i * 8) = o8; } }
    { const int* pos = (const int*)ARG_IN(1); float* cs = (float*)(ws + WS_CS);
      for (int i = blockIdx.x * 512 + F.tid; i < MTOK * 8; i += F.G * 512) {
          const int tok = i >> 3, j = i & 7;
          const float invf = (float)exp2(-(double)j * (18.931568569324174 / 8.0));
          const double ang = (double)((float)pos[tok] * invf);
          const double n = rint(ang * 0.15915494309189535); const double r = ang - n * 6.283185307179586476925;
          const float rf = (float)r;
          cs[tok * 16 + j] = cosf(rf); cs[tok * 16 + 8 + j] = sinf(rf); } }
    { const float* cp = (const float*)ARG_IN(4); const float* w1 = (const float*)ARG_IN(5); float* bp = (float*)((unsigned*)(ws + WS_CTL) + CW_BIASP);
      if (gw < 1024) { const int mi = gw >> 8, c = gw & 255; float s = 0.f;
#pragma unroll 8
          for (int i = 0; i < 32; ++i) { const int f = i * 64 + F.lane; s += cp[(size_t)mi * 2048 + f] * w1[((size_t)mi * 2048 + f) * 256 + c]; }
          s = wave_sum(s, F.lane);
          if (F.lane == 0) bp[gw] = s; } }
}

typedef f32x4 AccT[2][2][4][2];

DEVI u32x4 pack8(const f32x4 a, const f32x4 b) { u32x4 w; w.x = pg8::cvt_pk_bf16(a[0], a[1]); w.y = pg8::cvt_pk_bf16(a[2], a[3]); w.z = pg8::cvt_pk_bf16(b[0], b[1]); w.w = pg8::cvt_pk_bf16(b[2], b[3]); return w; }
DEVI void rope8(f32x4& v0, f32x4& v1, int dhead, const float* csrow, int lane) {
    f32x4 p0, p1;
#pragma unroll
    for (int i = 0; i < 4; ++i) { p0[i] = shx(v0[i], 16, lane); p1[i] = shx(v1[i], 16, lane); }
    if (dhead < 16) {
        const f32x4 c0 = *(const f32x4*)(csrow), c1 = *(const f32x4*)(csrow + 4), s0 = *(const f32x4*)(csrow + 8), s1 = *(const f32x4*)(csrow + 12);
        if (dhead == 0) { v0 = v0 * c0 - p0 * s0; v1 = v1 * c1 - p1 * s1; }
        else            { v0 = v0 * c0 + p0 * s0; v1 = v1 * c1 + p1 * s1; }
    }
}

struct EpiNsaIn {
    static constexpr bool PERM = true;
    unsigned char* ws; const float* cs;
    DEVI void operator()(const AccT& acc, const pg8::Unit& u, int wr, int wc, int fr, int fq) const {
        const int pn = u.pn;
        if (pn < 4) {
            bf16_t* Q = (bf16_t*)(ws + RA_Q);
#pragma unroll
            for (int ai = 0; ai < 2; ++ai)
#pragma unroll
                for (int m = 0; m < 4; ++m) { const int row = u.pm * 256 + ai * 128 + wr * 64 + m * 16 + fr;
#pragma unroll
                    for (int bj = 0; bj < 2; ++bj) *(u32x4*)(Q + (size_t)row * DM + pn * 256 + bj * 128 + wc * 32 + fq * 8) = pack8(acc[ai][bj][m][0], acc[ai][bj][m][1]); }
        } else if (pn < 10) {
            const size_t base = pn == 4 ? RA_KCR : pn == 5 ? RA_VCR : pn == 6 ? RA_KS : pn == 7 ? RA_VS : pn == 8 ? RA_KW : RA_VW;
            bf16_t* T = (bf16_t*)(ws + base);
            const bool rot = (pn == 6 || pn == 8);
            const int dh = (wc & 1) * 32 + fq * 8;
#pragma unroll
            for (int ai = 0; ai < 2; ++ai)
#pragma unroll
                for (int m = 0; m < 4; ++m) { const int row = u.pm * 256 + ai * 128 + wr * 64 + m * 16 + fr; const int b = row / SEQ, t = row % SEQ;
#pragma unroll
                    for (int bj = 0; bj < 2; ++bj) { f32x4 v0 = acc[ai][bj][m][0], v1 = acc[ai][bj][m][1];
                        if (rot) rope8(v0, v1, dh, cs + (size_t)row * 16, fq * 16 + fr);
                        const int g = bj * 2 + (wc >> 1);
                        *(u32x4*)(T + ((size_t)(b * A_G + g) * SEQ + t) * HD + dh) = pack8(v0, v1); } }
        } else {
            float* G = (float*)(ws + RA_GATE);
            if (wc < 2) {
#pragma unroll
                for (int ai = 0; ai < 2; ++ai)
#pragma unroll
                    for (int m = 0; m < 4; ++m) { const int row = u.pm * 256 + ai * 128 + wr * 64 + m * 16 + fr;
#pragma unroll
                        for (int n = 0; n < 2; ++n) { const int c = wc * 32 + fq * 8 + n * 4;
                            if (c < 48) { f32x4 v = acc[ai][0][m][n]; f32x4 o;
#pragma unroll
                                for (int i = 0; i < 4; ++i) o[i] = 1.f / (1.f + __expf(-v[i]));
                                *(f32x4*)(G + (size_t)row * 48 + c) = o; } } }
            }
        }
    }
};
struct EpiSwaIn {
    static constexpr bool PERM = true;
    unsigned char* ws; const float* cs;
    DEVI void operator()(const AccT& acc, const pg8::Unit& u, int wr, int wc, int fr, int fq) const {
        const int pn = u.pn; const int dh = (wc & 1) * 32 + fq * 8;
        bf16_t* Q = (bf16_t*)(ws + RA_Q); bf16_t* KS = (bf16_t*)(ws + WS_KSH); bf16_t* VS = (bf16_t*)(ws + WS_VSH);
#pragma unroll
        for (int ai = 0; ai < 2; ++ai)
#pragma unroll
            for (int m = 0; m < 4; ++m) { const int row = u.pm * 256 + ai * 128 + wr * 64 + m * 16 + fr; const int b = row / SEQ, t = row % SEQ;
#pragma unroll
                for (int bj = 0; bj < 2; ++bj) { f32x4 v0 = acc[ai][bj][m][0], v1 = acc[ai][bj][m][1];
                    const bool rot = (pn < 4) || (bj == 0);
                    if (rot) rope8(v0, v1, dh, cs + (size_t)row * 16, fq * 16 + fr);
                    const u32x4 w = pack8(v0, v1);
                    if (pn < 4) *(u32x4*)(Q + (size_t)row * DM + pn * 256 + bj * 128 + wc * 32 + fq * 8) = w;
                    else { bf16_t* T = bj == 0 ? KS : VS; const int g = wc >> 1; *(u32x4*)(T + ((size_t)(b * B_G + g) * SEQ + t) * HD + dh) = w; } } }
    }
};
DEVI float gelu_tanh(float x) { const float u = 0.7978845608028654f * (x + 0.044715f * x * x * x); const float e = __expf(2.f * u); const float th = 1.f - 2.f / (e + 1.f); return 0.5f * x * (1.f + th); }
struct EpiCmpHid {
    static constexpr bool PERM = true;
    bf16_t* out; const float* bias;
    DEVI void operator()(const AccT& acc, const pg8::Unit& u, int wr, int wc, int fr, int fq) const {
        const float* bs = bias;
#pragma unroll
        for (int bj = 0; bj < 2; ++bj) { const int c = bj * 128 + wc * 32 + fq * 8; const f32x4 b0 = *(const f32x4*)(bs + c), b1 = *(const f32x4*)(bs + c + 4);
#pragma unroll
            for (int ai = 0; ai < 2; ++ai)
#pragma unroll
                for (int m = 0; m < 4; ++m) { const int row = u.pm * 256 + ai * 128 + wr * 64 + m * 16 + fr; f32x4 v0 = acc[ai][bj][m][0] + b0, v1 = acc[ai][bj][m][1] + b1;
#pragma unroll
                    for (int i = 0; i < 4; ++i) { v0[i] = gelu_tanh(v0[i]); v1[i] = gelu_tanh(v1[i]); }
                    *(u32x4*)(out + (size_t)row * 256 + c) = pack8(v0, v1); } }
    }
};
struct EpiCmpOut {
    static constexpr bool PERM = true;
    bf16_t* kc; bf16_t* vc;
    DEVI void operator()(const AccT& acc, const pg8::Unit& u, int wr, int wc, int fr, int fq) const {
        if (wc >= 2) return;
        bf16_t* T = u.pm >= 32 ? vc : kc; const int rbase = (u.pm & 31) * 256;
#pragma unroll
        for (int ai = 0; ai < 2; ++ai)
#pragma unroll
            for (int m = 0; m < 4; ++m) { const int row = rbase + ai * 128 + wr * 64 + m * 16 + fr;
                u32x4 w = pack8(acc[ai][0][m][0], acc[ai][0][m][1]);
                if ((row & 1023) == 1023) w = (u32x4){0u, 0u, 0u, 0u};
                *(u32x4*)(T + (size_t)row * 64 + wc * 32 + fq * 8) = w; }
    }
};
struct EpiResid {
    static constexpr bool PERM = true;
    const bf16_t* res; bf16_t* y;
    DEVI void operator()(const AccT& acc, const pg8::Unit& u, int wr, int wc, int fr, int fq) const {
#pragma unroll
        for (int ai = 0; ai < 2; ++ai)
#pragma unroll
            for (int m = 0; m < 4; ++m) { const size_t off = (size_t)(u.pm * 256 + ai * 128 + wr * 64 + m * 16 + fr) * DM + u.pn * 256 + wc * 32 + fq * 8;
#pragma unroll
                for (int bj = 0; bj < 2; ++bj) { const u32x4 r = *(const u32x4*)(res + off + bj * 128);
                    const f32x4 r0 = {bflo(r.x), bfhi(r.x), bflo(r.y), bfhi(r.y)}, r1 = {bflo(r.z), bfhi(r.z), bflo(r.w), bfhi(r.w)};
                    *(u32x4*)(y + off + bj * 128) = pack8(r0 * ALPHA + acc[ai][bj][m][0], r1 * ALPHA + acc[ai][bj][m][1]); } }
    }
};
struct EpiBf16Out {
    static constexpr bool PERM = true;
    bf16_t* y;
    DEVI void operator()(const AccT& acc, const pg8::Unit& u, int wr, int wc, int fr, int fq) const {
#pragma unroll
        for (int ai = 0; ai < 2; ++ai)
#pragma unroll
            for (int m = 0; m < 4; ++m) { const size_t off = (size_t)(u.pm * 256 + ai * 128 + wr * 64 + m * 16 + fr) * DM + u.pn * 256 + wc * 32 + fq * 8;
#pragma unroll
                for (int bj = 0; bj < 2; ++bj) *(u32x4*)(y + off + bj * 128) = pack8(acc[ai][bj][m][0], acc[ai][bj][m][1]); }
    }
};
struct EpiPart {
    static constexpr bool PERM = false;
    float* part;
    DEVI void operator()(const AccT& acc, const pg8::Unit& u, int wr, int wc, int fr, int fq) const {
        float* base = part + (size_t)((u.pm - 256) * 2 + u.z) * 256 * DM;
#pragma unroll
        for (int ai = 0; ai < 2; ++ai)
#pragma unroll
            for (int m = 0; m < 4; ++m) { const size_t off = (size_t)(ai * 128 + wr * 64 + m * 16 + fr) * DM + u.pn * 256 + wc * 32 + fq * 4;
#pragma unroll
                for (int bj = 0; bj < 2; ++bj)
#pragma unroll
                    for (int n = 0; n < 2; ++n) *(f32x4*)(base + off + bj * 128 + n * 16) = acc[ai][bj][m][n]; }
    }
};
struct EpiSwiglu {
    static constexpr bool PERM = true;
    bf16_t* act; int ld;
    DEVI void operator()(const AccT& acc, const pg8::Unit& u, int wr, int wc, int fr, int fq) const {
#pragma unroll
        for (int ai = 0; ai < 2; ++ai)
#pragma unroll
            for (int m = 0; m < 4; ++m) { const size_t row = (size_t)(u.pm * 256 + ai * 128 + wr * 64 + m * 16 + fr); f32x4 o[2];
#pragma unroll
                for (int n = 0; n < 2; ++n)
#pragma unroll
                    for (int i = 0; i < 4; ++i) { const float gv = acc[ai][0][m][n][i], uv = acc[ai][1][m][n][i]; o[n][i] = gv * __builtin_amdgcn_rcpf(1.f + __expf(-gv)) * uv; }
                *(u32x4*)(act + row * ld + u.pn * 128 + wc * 32 + fq * 8) = pack8(o[0], o[1]); }
    }
};

struct EpiSwiglu8 {
    static constexpr bool PERM = true;
    unsigned char* act; int ld;
    DEVI void operator()(const AccT& acc, const pg8::Unit& u, int wr, int wc, int fr, int fq) const {
#pragma unroll
        for (int ai = 0; ai < 2; ++ai)
#pragma unroll
            for (int m = 0; m < 4; ++m) { const size_t row = (size_t)(u.pm * 256 + ai * 128 + wr * 64 + m * 16 + fr); f32x4 o[2];
#pragma unroll
                for (int n = 0; n < 2; ++n)
#pragma unroll
                    for (int i = 0; i < 4; ++i) { const float gv = acc[ai][0][m][n][i], uv = acc[ai][1][m][n][i]; o[n][i] = gv * __builtin_amdgcn_rcpf(1.f + __expf(-gv)) * uv; }
                u32x2 w; w[0] = pack_fp8x4(o[0][0], o[0][1], o[0][2], o[0][3]); w[1] = pack_fp8x4(o[1][0], o[1][1], o[1][2], o[1][3]);
                *(u32x2*)(act + row * ld + u.pn * 128 + wc * 32 + fq * 8) = w; }
    }
};

DEVI void unpack8(const u32x4 w, float (&x)[8]) { x[0] = bflo(w.x); x[1] = bfhi(w.x); x[2] = bflo(w.y); x[3] = bfhi(w.y); x[4] = bflo(w.z); x[5] = bfhi(w.z); x[6] = bflo(w.w); x[7] = bfhi(w.w); }
DEVI void moe_row8(const bf16_t* YB, const float* PART, int p, int c, float (&x)[8]) {
    if (p < 65536) { unpack8(*(const u32x4*)(YB + (size_t)p * DM + c), x); return; }
    const float* q = PART + ((size_t)(((p >> 8) - 256) * 2) * 256 + (p & 255)) * DM + c;
    f32x4 a0 = *(const f32x4*)q, a1 = *(const f32x4*)(q + 4);
    a0 = a0 + *(const f32x4*)(q + (size_t)256 * DM); a1 = a1 + *(const f32x4*)(q + (size_t)256 * DM + 4);
    x[0] = a0[0]; x[1] = a0[1]; x[2] = a0[2]; x[3] = a0[3]; x[4] = a1[0]; x[5] = a1[1]; x[6] = a1[2]; x[7] = a1[3];
}
template <int MODE, bool ROUTER, bool FINAL>
DEVI void phase_ln(Frame& F, int lnidx, float* outp, int moe_layer) {
    F.refresh();
    unsigned char* ws = F.ws;
    const bf16_t* Y = (const bf16_t*)(ws + WS_Y); const bf16_t* YB = (const bf16_t*)(ws + WS_YB); const float* PART = (const float*)(ws + WS_H);
    bf16_t* HB = (bf16_t*)(ws + WS_HB);
    const float* gam = (const float*)ARG_IN(11) + (size_t)lnidx * DM; const float* bet = (const float*)ARG_IN(12) + (size_t)lnidx * DM;
    int* TOKE = (int*)(ws + WS_ROUTE); int* TOKR = TOKE + MTOK * 2; float* TOKW = (float*)(TOKR + MTOK * 2); int* TOKP = (int*)(TOKW + MTOK * 2);
    const float* wr_ = ROUTER ? (const float*)ARG_IN(15) + (size_t)moe_layer * DM * NEXP : nullptr;
    LAS int* lcnt = (LAS int*)(F.lds + LDS_X);
    LAS int* lrec = lcnt + 16;
    LAS int* lrank = lrec + 256;
    if (ROUTER) { if (F.tid < 16) lcnt[F.tid] = 0; __syncthreads(); }
    const int gw = F.vcu * NWAVES + F.wave, NGW = F.G * NWAVES;
    constexpr int RB = (MODE == 0) ? 4 : 2;
    const f32x4 g0_[2] = {*(const f32x4*)(gam + F.lane * 8), *(const f32x4*)(gam + 512 + F.lane * 8)}, g1_[2] = {*(const f32x4*)(gam + F.lane * 8 + 4), *(const f32x4*)(gam + 512 + F.lane * 8 + 4)};
    const f32x4 b0_[2] = {*(const f32x4*)(bet + F.lane * 8), *(const f32x4*)(bet + 512 + F.lane * 8)}, b1_[2] = {*(const f32x4*)(bet + F.lane * 8 + 4), *(const f32x4*)(bet + 512 + F.lane * 8 + 4)};
#pragma unroll 1
    for (int k0 = 0; k0 < 16; k0 += RB) {
        float v[RB][2][8];
        if (MODE == 0) {
            u32x4 raw[RB][2];
#pragma unroll
            for (int r = 0; r < RB; ++r)
#pragma unroll
                for (int j = 0; j < 2; ++j) raw[r][j] = *(const u32x4*)(Y + (size_t)(gw + (k0 + r) * NGW) * DM + j * 512 + F.lane * 8);
#pragma unroll
            for (int r = 0; r < RB; ++r)
#pragma unroll
                for (int j = 0; j < 2; ++j) unpack8(raw[r][j], v[r][j]);
        } else {
            int p0[RB], p1[RB]; float w0[RB], w1[RB];
#pragma unroll
            for (int r = 0; r < RB; ++r) { const int m = gw + (k0 + r) * NGW; p0[r] = TOKP[m * 2]; p1[r] = TOKP[m * 2 + 1]; w0[r] = TOKW[m * 2]; w1[r] = TOKW[m * 2 + 1]; }
            u32x4 hraw[RB][2];
#pragma unroll
            for (int r = 0; r < RB; ++r)
#pragma unroll
                for (int j = 0; j < 2; ++j) hraw[r][j] = *(const u32x4*)(HB + (size_t)(gw + (k0 + r) * NGW) * DM + j * 512 + F.lane * 8);
#pragma unroll
            for (int r = 0; r < RB; ++r)
#pragma unroll
                for (int j = 0; j < 2; ++j) { const int c = j * 512 + F.lane * 8; float h[8], a[8], b[8];
                    unpack8(hraw[r][j], h); moe_row8(YB, PART, p0[r], c, a); moe_row8(YB, PART, p1[r], c, b);
#pragma unroll
                    for (int i = 0; i < 8; ++i) v[r][j][i] = h[i] * ALPHA + a[i] * w0[r] + b[i] * w1[r]; }
        }
#pragma unroll
        for (int r = 0; r < RB; ++r) {
            const int m = gw + (k0 + r) * NGW;
            float s = 0.f;
#pragma unroll
            for (int j = 0; j < 2; ++j)
#pragma unroll
                for (int i = 0; i < 8; ++i) s += v[r][j][i];
            const float mean = wave_sum(s, F.lane) * (1.f / DM); float s2 = 0.f;
#pragma unroll
            for (int j = 0; j < 2; ++j)
#pragma unroll
                for (int i = 0; i < 8; ++i) { v[r][j][i] -= mean; s2 += v[r][j][i] * v[r][j][i]; }
            const float rstd = 1.f / sqrtf(wave_sum(s2, F.lane) * (1.f / DM) + LN_EPS);
#pragma unroll
            for (int j = 0; j < 2; ++j) { const int c = j * 512 + F.lane * 8;
#pragma unroll
                for (int i = 0; i < 4; ++i) { v[r][j][i] = v[r][j][i] * rstd * g0_[j][i] + b0_[j][i]; v[r][j][4 + i] = v[r][j][4 + i] * rstd * g1_[j][i] + b1_[j][i]; }
                if (FINAL) { *(f32x4*)(outp + (size_t)m * DM + c) = (f32x4){v[r][j][0], v[r][j][1], v[r][j][2], v[r][j][3]}; *(f32x4*)(outp + (size_t)m * DM + c + 4) = (f32x4){v[r][j][4], v[r][j][5], v[r][j][6], v[r][j][7]}; }
                else { u32x4 w; w.x = pk2(v[r][j][0], v[r][j][1]); w.y = pk2(v[r][j][2], v[r][j][3]); w.z = pk2(v[r][j][4], v[r][j][5]); w.w = pk2(v[r][j][6], v[r][j][7]); *(u32x4*)(HB + (size_t)m * DM + c) = w;
                    if (lnidx & 1) { u32x2 w8; w8[0] = pack_fp8x4(v[r][j][0], v[r][j][1], v[r][j][2], v[r][j][3]); w8[1] = pack_fp8x4(v[r][j][4], v[r][j][5], v[r][j][6], v[r][j][7]); *(u32x2*)(ws + WS_HB8 + (size_t)m * DM + c) = w8; } } }
            if (ROUTER) {
                float lg[NEXP];
#pragma unroll
                for (int e = 0; e < NEXP; ++e) lg[e] = 0.f;
#pragma unroll
                for (int j = 0; j < 2; ++j)
#pragma unroll
                    for (int i = 0; i < 8; ++i) { const int c = j * 512 + F.lane * 8 + i; const f32x4 w0 = *(const f32x4*)(wr_ + (size_t)c * NEXP), w1 = *(const f32x4*)(wr_ + (size_t)c * NEXP + 4); const float x = v[r][j][i];
                        lg[0] += x * w0.x; lg[1] += x * w0.y; lg[2] += x * w0.z; lg[3] += x * w0.w; lg[4] += x * w1.x; lg[5] += x * w1.y; lg[6] += x * w1.z; lg[7] += x * w1.w; }
#pragma unroll
                for (int e = 0; e < NEXP; ++e) lg[e] = wave_sum(lg[e], F.lane);
                int e0 = 0; float l0 = lg[0];
#pragma unroll
                for (int e = 1; e < NEXP; ++e) if (lg[e] > l0) { l0 = lg[e]; e0 = e; }
                int e1 = -1; float l1 = -3.4e38f;
#pragma unroll
                for (int e = 0; e < NEXP; ++e) if (e != e0 && lg[e] > l1) { l1 = lg[e]; e1 = e; }
                if (e1 < 0) e1 = (e0 + 1) & 7;
                const float g1 = 1.f / (1.f + __expf(l0 - l1)), g0 = 1.f - g1;
                if (F.lane == 0) {
                    const int idx = (F.wave * 16 + k0 + r) * 2;
                    lrec[idx] = m * 16 + e0; lrec[idx + 1] = m * 16 + e1;
                    TOKE[m * 2] = e0; TOKE[m * 2 + 1] = e1; TOKW[m * 2] = g0; TOKW[m * 2 + 1] = g1;
                }
            }
        }
    }
    if (ROUTER) {
        __syncthreads();
        unsigned* cnt = (unsigned*)(ws + WS_CTL) + CW_MOE + moe_layer * 64;
        int* wgcnt = (int*)(ws + WS_CTL) + CW_WGCNT + moe_layer * 2048 + (int)blockIdx.x * 8;
        LAS int* wcnt = lrank;
        int rec = 0, e = 0, r = 0;
        if (F.wave < 4) { rec = lrec[F.tid]; e = rec & 15;
            const unsigned long long lt = (1ull << F.lane) - 1ull;
#pragma unroll
            for (int x = 0; x < 8; ++x) { const unsigned long long b = __builtin_amdgcn_ballot_w64(e == x); if (e == x) r = __builtin_popcountll(b & lt); if (F.lane == 0) wcnt[F.wave * 8 + x] = __builtin_popcountll(b); } }
        __syncthreads();
        if (F.wave < 4) { for (int w = 0; w < F.wave; ++w) r += wcnt[w * 8 + e]; TOKR[(rec >> 4) * 2 + (F.tid & 1)] = r; }
        if (F.tid < 8) lcnt[F.tid] = wcnt[F.tid] + wcnt[8 + F.tid] + wcnt[16 + F.tid] + wcnt[24 + F.tid];
        __syncthreads();
        if (F.tid < 8) { wgcnt[F.tid] = lcnt[F.tid]; __hip_atomic_fetch_add(cnt + F.tid, (unsigned)lcnt[F.tid], __ATOMIC_RELAXED, __HIP_MEMORY_SCOPE_AGENT); }
    }
}

DEVI void moe_tiles(const unsigned* cnt, int (&ts)[9]) { ts[0] = 0;
#pragma unroll
    for (int e = 0; e < 8; ++e) ts[e + 1] = ts[e] + (int)((__hip_atomic_load(cnt + e, __ATOMIC_RELAXED, __HIP_MEMORY_SCOPE_AGENT) + 255u) >> 8); }
DEVI void phase_moe_scatter(Frame& F, int moe_layer) {
    F.refresh();
    unsigned char* ws = F.ws;
    const unsigned* cnt = (const unsigned*)(ws + WS_CTL) + CW_MOE + moe_layer * 64;
    int ts[9]; moe_tiles(cnt, ts);
    LAS int* wbase = (LAS int*)(F.lds + LDS_X);
    if (F.tid < 8) wbase[F.tid] = 0;
    __syncthreads();
    if (F.tid < (int)blockIdx.x) { const int* wc = (const int*)(ws + WS_CTL) + CW_WGCNT + moe_layer * 2048 + F.tid * 8;
        const u32x4 c0 = *(const u32x4*)wc, c1 = *(const u32x4*)(wc + 4);
#pragma unroll
        for (int e = 0; e < 4; ++e) { __hip_atomic_fetch_add(wbase + e, (int)c0[e], __ATOMIC_RELAXED, __HIP_MEMORY_SCOPE_WORKGROUP); __hip_atomic_fetch_add(wbase + 4 + e, (int)c1[e], __ATOMIC_RELAXED, __HIP_MEMORY_SCOPE_WORKGROUP); } }
    __syncthreads();
    const int* TOKE = (const int*)(ws + WS_ROUTE); const int* TOKR = TOKE + MTOK * 2; int* TOKP = (int*)(ws + WS_ROUTE) + MTOK * 6;
    const bf16_t* HB = (const bf16_t*)(ws + WS_HB); unsigned char* XB = ws + WS_XB;
    const int gw = F.vcu * NWAVES + F.wave, NGW = F.G * NWAVES;
#pragma unroll 1
    for (int k0 = 0; k0 < 16; k0 += 4) {
        u32x4 r0[4], r1[4]; int ee[4][2], rk[4][2];
#pragma unroll
        for (int q = 0; q < 4; ++q) { const int m = gw + (k0 + q) * NGW; r0[q] = *(const u32x4*)(HB + (size_t)m * DM + F.lane * 8); r1[q] = *(const u32x4*)(HB + (size_t)m * DM + 512 + F.lane * 8);
            ee[q][0] = TOKE[m * 2]; ee[q][1] = TOKE[m * 2 + 1]; rk[q][0] = TOKR[m * 2]; rk[q][1] = TOKR[m * 2 + 1]; }
#pragma unroll
        for (int q = 0; q < 4; ++q) { const int m = gw + (k0 + q) * NGW;
            u32x2 a8, b8; a8[0] = pack_fp8x4(bflo(r0[q][0]), bfhi(r0[q][0]), bflo(r0[q][1]), bfhi(r0[q][1])); a8[1] = pack_fp8x4(bflo(r0[q][2]), bfhi(r0[q][2]), bflo(r0[q][3]), bfhi(r0[q][3]));
            b8[0] = pack_fp8x4(bflo(r1[q][0]), bfhi(r1[q][0]), bflo(r1[q][1]), bfhi(r1[q][1])); b8[1] = pack_fp8x4(bflo(r1[q][2]), bfhi(r1[q][2]), bflo(r1[q][3]), bfhi(r1[q][3]));
#pragma unroll
            for (int k = 0; k < 2; ++k) { const int e = ee[q][k], r = rk[q][k];
                int st = 0;
#pragma unroll
                for (int j = 1; j < 8; ++j) st = (e >= j) ? ts[j] : st;
                const int pos = st * 256 + wbase[e] + r;
                *(u32x2*)(XB + (size_t)pos * DM + F.lane * 8) = a8; *(u32x2*)(XB + (size_t)pos * DM + 512 + F.lane * 8) = b8;
                if (F.lane == 0) TOKP[m * 2 + k] = pos; } }
    }
}

DEVI void phase_nsa_naive(Frame& F) {
    F.refresh();
    unsigned char* ws = F.ws;
    const bf16_t* Q = (const bf16_t*)(ws + RA_Q); bf16_t* ATT = (bf16_t*)(ws + RA_ATT);
    const bf16_t* KC = (const bf16_t*)(ws + RA_KC); const bf16_t* VC = (const bf16_t*)(ws + RA_VC);
    const bf16_t* KS = (const bf16_t*)(ws + RA_KS); const bf16_t* VS = (const bf16_t*)(ws + RA_VS);
    const bf16_t* KW = (const bf16_t*)(ws + RA_KW); const bf16_t* VW = (const bf16_t*)(ws + RA_VW);
    const float* GT = (const float*)(ws + RA_GATE); const float* CS = (const float*)(ws + WS_CS);
    LAS float* sc = (LAS float*)(F.lds + F.wave * 16384);
    LAS float* qs_ = (LAS float*)(F.lds + LDS_X + F.wave * 2048);
    LAS float* qr_ = qs_ + 256;
    const int lane = F.lane;
    const int gw = F.vcu * NWAVES + F.wave, NGW = F.G * NWAVES;
    for (int u = gw; u < MTOK * A_G; u += NGW) {
        const int bg = u / SEQ, t = u % SEQ, b = bg / A_G, g = bg % A_G; const int tok = b * SEQ + t;
        { const bf16_t* qp = Q + (size_t)tok * DM + g * 256 + lane * 4; const u32x2 w = *(const u32x2*)qp;
          float x[4] = {bflo(w.x), bfhi(w.x), bflo(w.y), bfhi(w.y)};
#pragma unroll
          for (int i = 0; i < 4; ++i) qs_[lane * 4 + i] = x[i];
          LDS_WAIT();
          const int d0 = (lane * 4) & 63;
#pragma unroll
          for (int i = 0; i < 4; ++i) { const int d = d0 + i; float v = x[i];
              if (d < 8) v = x[i] * CS[(size_t)tok * 16 + d] - qs_[lane * 4 + i + 8] * CS[(size_t)tok * 16 + 8 + d];
              else if (d < 16) v = x[i] * CS[(size_t)tok * 16 + d - 8] + qs_[lane * 4 + i - 8] * CS[(size_t)tok * 16 + d];
              qr_[lane * 4 + i] = v; }
          LDS_WAIT(); }
        float oc[4] = {0.f, 0.f, 0.f, 0.f}, os[4] = {0.f, 0.f, 0.f, 0.f}, ow[4] = {0.f, 0.f, 0.f, 0.f};
        const int cur = t >> 6;
        const int nv = t >= 31 ? ((t - 31) >> 4) + 1 : 0;
        float impv[4] = {0.f, 0.f, 0.f, 0.f};
        if (nv > 0) {
            const bf16_t* kc = KC + (size_t)bg * 1024 * 64; const bf16_t* vc = VC + (size_t)bg * 1024 * 64;
            float mx[4] = {-3.0e38f, -3.0e38f, -3.0e38f, -3.0e38f};
            for (int c = 0; c * 64 < nv; ++c) { const int n = c * 64 + lane;
                if (n < nv) { float s[4] = {0.f, 0.f, 0.f, 0.f}; LAS float* qs = qs_; asm volatile("" : "+v"(qs));
#pragma unroll 2
                    for (int d8 = 0; d8 < 8; ++d8) { const u32x4 w = *(const u32x4*)(kc + (size_t)n * 64 + d8 * 8);
                        const float kf[8] = {bflo(w.x), bfhi(w.x), bflo(w.y), bfhi(w.y), bflo(w.z), bfhi(w.z), bflo(w.w), bfhi(w.w)};
#pragma unroll
                        for (int r = 0; r < 4; ++r) { const f32x4 qa = *(const LAS f32x4*)(qs + r * 64 + d8 * 8), qb = *(const LAS f32x4*)(qs + r * 64 + d8 * 8 + 4);
                            s[r] += qa.x * kf[0] + qa.y * kf[1] + qa.z * kf[2] + qa.w * kf[3] + qb.x * kf[4] + qb.y * kf[5] + qb.z * kf[6] + qb.w * kf[7]; } }
#pragma unroll
                    for (int r = 0; r < 4; ++r) { s[r] *= QSCALE; mx[r] = fmaxf(mx[r], s[r]); }
                    *(LAS f32x4*)(sc + n * 4) = (f32x4){s[0], s[1], s[2], s[3]}; } }
            float l[4] = {0.f, 0.f, 0.f, 0.f};
#pragma unroll
            for (int r = 0; r < 4; ++r) mx[r] = wave_max(mx[r], lane);
            LDS_WAIT();
            for (int c = 0; c * 64 < nv; ++c) { const int n = c * 64 + lane;
                if (n < nv) { f32x4 s = *(const LAS f32x4*)(sc + n * 4);
#pragma unroll
                    for (int r = 0; r < 4; ++r) { s[r] = __expf(s[r] - mx[r]); l[r] += s[r]; }
                    *(LAS f32x4*)(sc + n * 4) = s; } }
#pragma unroll
            for (int r = 0; r < 4; ++r) l[r] = 1.f / wave_sum(l[r], lane);
            LDS_WAIT();
            for (int c = 0; c * 64 < nv; ++c) { const int n = c * 64 + lane;
                if (n < nv) { f32x4 s = *(const LAS f32x4*)(sc + n * 4);
#pragma unroll
                    for (int r = 0; r < 4; ++r) s[r] *= l[r];
                    *(LAS f32x4*)(sc + n * 4) = s; } }
            LDS_WAIT();
#pragma unroll 4
            for (int n = 0; n < nv; ++n) { const float v = bf2f(vc[(size_t)n * 64 + lane]); const f32x4 p = *(const LAS f32x4*)(sc + n * 4);
#pragma unroll
                for (int r = 0; r < 4; ++r) oc[r] += p[r] * v; }
#pragma unroll
            for (int i = 0; i < 4; ++i) { const int j = lane + 64 * i; float acc = 0.f;
#pragma unroll
                for (int k = -1; k <= 3; ++k) { const int n = 4 * j + k; if (n >= 0 && n < nv) { const f32x4 p = *(const LAS f32x4*)(sc + n * 4); const float ps = (p.x + p.y) + (p.z + p.w); acc += (k == -1 || k == 3) ? 0.5f * ps : ps; } }
                impv[i] = acc; }
        }
        float scv[4];
#pragma unroll
        for (int i = 0; i < 4; ++i) { const int j = lane + 64 * i; scv[i] = j > cur ? -1.f : ((j == 0 || j == cur || j == cur - 1) ? 1e9f : impv[i]); }
        LAS int* sel = (LAS int*)(F.lds + MISC_OFF + 256) + F.wave * 16;
#pragma unroll 1
        for (int k = 0; k < NSEL; ++k) {
            float bv = -2.f; int bi = 1 << 20;
#pragma unroll
            for (int i = 0; i < 4; ++i) { const int j = lane + 64 * i; if (scv[i] > bv) { bv = scv[i]; bi = j; } }
#pragma unroll
            for (int o = 1; o < 64; o <<= 1) { const float ov = shx(bv, o, lane); const int oi = shxi(bi, o, lane); if (ov > bv || (ov == bv && oi < bi)) { bv = ov; bi = oi; } }
            if (lane == 0) sel[k] = bi;
#pragma unroll
            for (int i = 0; i < 4; ++i) if (lane + 64 * i == bi) scv[i] = -3.f;
        }
        LDS_WAIT();
        {   const bf16_t* ks = KS + (size_t)bg * SEQ * 64; const bf16_t* vs = VS + (size_t)bg * SEQ * 64;
            float mx[4] = {-3.0e38f, -3.0e38f, -3.0e38f, -3.0e38f};
#pragma unroll 1
            for (int k = 0; k < NSEL; ++k) { const int pos = sel[k] * 64 + lane; const bool ok = pos <= t;
                float s[4] = {-1e30f, -1e30f, -1e30f, -1e30f};
                if (ok) { LAS float* qr = qr_; asm volatile("" : "+v"(qr));
#pragma unroll
                    for (int r = 0; r < 4; ++r) s[r] = 0.f;
#pragma unroll 2
                    for (int d8 = 0; d8 < 8; ++d8) { const u32x4 w = *(const u32x4*)(ks + (size_t)pos * 64 + d8 * 8);
                        const float kf[8] = {bflo(w.x), bfhi(w.x), bflo(w.y), bfhi(w.y), bflo(w.z), bfhi(w.z), bflo(w.w), bfhi(w.w)};
#pragma unroll
                        for (int r = 0; r < 4; ++r) { const f32x4 qa = *(const LAS f32x4*)(qr + r * 64 + d8 * 8), qb = *(const LAS f32x4*)(qr + r * 64 + d8 * 8 + 4);
                            s[r] += qa.x * kf[0] + qa.y * kf[1] + qa.z * kf[2] + qa.w * kf[3] + qb.x * kf[4] + qb.y * kf[5] + qb.z * kf[6] + qb.w * kf[7]; } }
#pragma unroll
                    for (int r = 0; r < 4; ++r) { s[r] *= QSCALE; mx[r] = fmaxf(mx[r], s[r]); } }
                *(LAS f32x4*)(sc + (k * 64 + lane) * 4) = (f32x4){s[0], s[1], s[2], s[3]}; }
            float l[4] = {0.f, 0.f, 0.f, 0.f};
#pragma unroll
            for (int r = 0; r < 4; ++r) mx[r] = wave_max(mx[r], lane);
            LDS_WAIT();
#pragma unroll 1
            for (int k = 0; k < NSEL; ++k) { const int pos = sel[k] * 64 + lane; const bool ok = pos <= t; f32x4 s = *(const LAS f32x4*)(sc + (k * 64 + lane) * 4);
#pragma unroll
                for (int r = 0; r < 4; ++r) { s[r] = ok ? __expf(s[r] - mx[r]) : 0.f; l[r] += s[r]; }
                *(LAS f32x4*)(sc + (k * 64 + lane) * 4) = s; }
#pragma unroll
            for (int r = 0; r < 4; ++r) l[r] = 1.f / wave_sum(l[r], lane);
            LDS_WAIT();
#pragma unroll 1
            for (int k = 0; k < NSEL; ++k) { const int p0 = sel[k] * 64; if (p0 > t) continue;
#pragma unroll 4
                for (int i = 0; i < 64; ++i) { const int pos = p0 + i; if (pos > t) break; const float v = bf2f(vs[(size_t)pos * 64 + lane]); const f32x4 p = *(const LAS f32x4*)(sc + (k * 64 + i) * 4);
#pragma unroll
                    for (int r = 0; r < 4; ++r) os[r] += p[r] * v; } }
#pragma unroll
            for (int r = 0; r < 4; ++r) os[r] *= l[r];
            LDS_WAIT();
        }
        {   const bf16_t* kw = KW + (size_t)bg * SEQ * 64; const bf16_t* vw = VW + (size_t)bg * SEQ * 64;
            float mx[4] = {-3.0e38f, -3.0e38f, -3.0e38f, -3.0e38f};
#pragma unroll 1
            for (int c = 0; c < 8; ++c) { const int pos = t - 511 + c * 64 + lane; const bool ok = pos >= 0;
                float s[4] = {-1e30f, -1e30f, -1e30f, -1e30f};
                if (ok) { LAS float* qr = qr_; asm volatile("" : "+v"(qr));
#pragma unroll
                    for (int r = 0; r < 4; ++r) s[r] = 0.f;
#pragma unroll 2
                    for (int d8 = 0; d8 < 8; ++d8) { const u32x4 w = *(const u32x4*)(kw + (size_t)pos * 64 + d8 * 8);
                        const float kf[8] = {bflo(w.x), bfhi(w.x), bflo(w.y), bfhi(w.y), bflo(w.z), bfhi(w.z), bflo(w.w), bfhi(w.w)};
#pragma unroll
                        for (int r = 0; r < 4; ++r) { const f32x4 qa = *(const LAS f32x4*)(qr + r * 64 + d8 * 8), qb = *(const LAS f32x4*)(qr + r * 64 + d8 * 8 + 4);
                            s[r] += qa.x * kf[0] + qa.y * kf[1] + qa.z * kf[2] + qa.w * kf[3] + qb.x * kf[4] + qb.y * kf[5] + qb.z * kf[6] + qb.w * kf[7]; } }
#pragma unroll
                    for (int r = 0; r < 4; ++r) { s[r] *= QSCALE; mx[r] = fmaxf(mx[r], s[r]); } }
                *(LAS f32x4*)(sc + (c * 64 + lane) * 4) = (f32x4){s[0], s[1], s[2], s[3]}; }
            float l[4] = {0.f, 0.f, 0.f, 0.f};
#pragma unroll
            for (int r = 0; r < 4; ++r) mx[r] = wave_max(mx[r], lane);
            LDS_WAIT();
#pragma unroll 1
            for (int c = 0; c < 8; ++c) { const int pos = t - 511 + c * 64 + lane; const bool ok = pos >= 0; f32x4 s = *(const LAS f32x4*)(sc + (c * 64 + lane) * 4);
#pragma unroll
                for (int r = 0; r < 4; ++r) { s[r] = ok ? __expf(s[r] - mx[r]) : 0.f; l[r] += s[r]; }
                *(LAS f32x4*)(sc + (c * 64 + lane) * 4) = s; }
#pragma unroll
            for (int r = 0; r < 4; ++r) l[r] = 1.f / wave_sum(l[r], lane);
            LDS_WAIT();
#pragma unroll 4
            for (int i = (t >= 511 ? 0 : 511 - t); i < 512; ++i) { const int pos = t - 511 + i; const float v = bf2f(vw[(size_t)pos * 64 + lane]); const f32x4 p = *(const LAS f32x4*)(sc + i * 4);
#pragma unroll
                for (int r = 0; r < 4; ++r) ow[r] += p[r] * v; }
#pragma unroll
            for (int r = 0; r < 4; ++r) ow[r] *= l[r];
            LDS_WAIT();
        }
#pragma unroll
        for (int r = 0; r < 4; ++r) { const float gc = GT[(size_t)tok * 48 + 0 * 16 + g * 4 + r], gs = GT[(size_t)tok * 48 + 1 * 16 + g * 4 + r], gwv = GT[(size_t)tok * 48 + 2 * 16 + g * 4 + r];
            const float o = ((DBG_DROP & 1) ? 0.f : gc * oc[r]) + ((DBG_DROP & 2) ? 0.f : gs * os[r]) + ((DBG_DROP & 4) ? 0.f : gwv * ow[r]);
            ATT[(size_t)tok * DM + g * 256 + r * 64 + lane] = (bf16_t)f2bf(o); }
    }
}

DEVI void phase_swa_naive(Frame& F, const float* sinks) {
    F.refresh();
    unsigned char* ws = F.ws;
    const bf16_t* Q = (const bf16_t*)(ws + RA_Q); bf16_t* ATT = (bf16_t*)(ws + RA_ATT);
    const bf16_t* KS = (const bf16_t*)(ws + WS_KSH); const bf16_t* VS = (const bf16_t*)(ws + WS_VSH);
    LAS float* sc = (LAS float*)(F.lds + F.wave * 16384);
    LAS float* qs_ = (LAS float*)(F.lds + LDS_X + F.wave * 2048);
    const int lane = F.lane;
    const int gw = F.vcu * NWAVES + F.wave, NGW = F.G * NWAVES;
    for (int u = gw; u < MTOK * B_G; u += NGW) {
        const int bg = u / SEQ, t = u % SEQ, b = bg / B_G, g = bg % B_G; const int tok = b * SEQ + t;
        { const u32x4 w = *(const u32x4*)(Q + (size_t)tok * DM + g * 512 + lane * 8);
          const float x[8] = {bflo(w.x), bfhi(w.x), bflo(w.y), bfhi(w.y), bflo(w.z), bfhi(w.z), bflo(w.w), bfhi(w.w)};
#pragma unroll
          for (int i = 0; i < 8; ++i) qs_[lane * 8 + i] = x[i];
          LDS_WAIT(); }
        const bf16_t* kp = KS + (size_t)bg * SEQ * 64; const bf16_t* vp = VS + (size_t)bg * SEQ * 64;
        float mx[8], l[8], o[8];
#pragma unroll
        for (int r = 0; r < 8; ++r) { mx[r] = sinks[g * 8 + r]; l[r] = 0.f; o[r] = 0.f; }
#pragma unroll 1
        for (int c = 0; c < 2; ++c) { const int pos = t - 127 + c * 64 + lane; const bool ok = pos >= 0;
            float s[8];
#pragma unroll
            for (int r = 0; r < 8; ++r) s[r] = -1e30f;
            if (ok) { LAS float* qs = qs_; asm volatile("" : "+v"(qs));
#pragma unroll
                for (int r = 0; r < 8; ++r) s[r] = 0.f;
#pragma unroll 1
                for (int d8 = 0; d8 < 8; ++d8) { const u32x4 w = *(const u32x4*)(kp + (size_t)pos * 64 + d8 * 8);
                    const float kf[8] = {bflo(w.x), bfhi(w.x), bflo(w.y), bfhi(w.y), bflo(w.z), bfhi(w.z), bflo(w.w), bfhi(w.w)};
#pragma unroll
                    for (int r = 0; r < 8; ++r) { const f32x4 qa = *(const LAS f32x4*)(qs + r * 64 + d8 * 8), qb = *(const LAS f32x4*)(qs + r * 64 + d8 * 8 + 4);
                        s[r] += qa.x * kf[0] + qa.y * kf[1] + qa.z * kf[2] + qa.w * kf[3] + qb.x * kf[4] + qb.y * kf[5] + qb.z * kf[6] + qb.w * kf[7]; } }
#pragma unroll
                for (int r = 0; r < 8; ++r) { s[r] *= QSCALE; mx[r] = fmaxf(mx[r], s[r]); } }
            *(LAS f32x4*)(sc + (c * 64 + lane) * 8) = (f32x4){s[0], s[1], s[2], s[3]}; *(LAS f32x4*)(sc + (c * 64 + lane) * 8 + 4) = (f32x4){s[4], s[5], s[6], s[7]}; }
#pragma unroll
        for (int r = 0; r < 8; ++r) mx[r] = wave_max(mx[r], lane);
        LDS_WAIT();
#pragma unroll
        for (int c = 0; c < 2; ++c) { const int pos = t - 127 + c * 64 + lane; const bool ok = pos >= 0;
            f32x4 s0 = *(const LAS f32x4*)(sc + (c * 64 + lane) * 8), s1 = *(const LAS f32x4*)(sc + (c * 64 + lane) * 8 + 4);
#pragma unroll
            for (int r = 0; r < 4; ++r) { s0[r] = ok ? __expf(s0[r] - mx[r]) : 0.f; l[r] += s0[r]; s1[r] = ok ? __expf(s1[r] - mx[r + 4]) : 0.f; l[r + 4] += s1[r]; }
            *(LAS f32x4*)(sc + (c * 64 + lane) * 8) = s0; *(LAS f32x4*)(sc + (c * 64 + lane) * 8 + 4) = s1; }
#pragma unroll
        for (int r = 0; r < 8; ++r) l[r] = 1.f / (wave_sum(l[r], lane) + __expf(sinks[g * 8 + r] - mx[r]));
        LDS_WAIT();
#pragma unroll 4
        for (int i = (t >= 127 ? 0 : 127 - t); i < 128; ++i) { const int pos = t - 127 + i; const float v = bf2f(vp[(size_t)pos * 64 + lane]);
            const f32x4 p0 = *(const LAS f32x4*)(sc + i * 8), p1 = *(const LAS f32x4*)(sc + i * 8 + 4);
#pragma unroll
            for (int r = 0; r < 4; ++r) { o[r] += p0[r] * v; o[r + 4] += p1[r] * v; } }
#pragma unroll
        for (int r = 0; r < 8; ++r) ATT[(size_t)tok * DM + g * 512 + r * 64 + lane] = (bf16_t)f2bf(o[r] * l[r]);
        LDS_WAIT();
    }
}

namespace fa {
typedef short v4i16_t __attribute__((ext_vector_type(4)));
constexpr float CEXP = 0.125f * 1.4426950408889634f;
constexpr float NEGINF = -__builtin_huge_valf();
constexpr int VLD = 160;
constexpr int KVB = 8192 + 64 * VLD;
constexpr int L_KV = 0;
constexpr int L_IMP = 2 * KVB;
constexpr int IMP_LD = 264;
constexpr int OS_LD = 65;
constexpr int L_Q = L_IMP + 64 * IMP_LD * 4;
constexpr int L_ML = L_Q + 32768;
constexpr int L_MASK = L_ML + 2048;
constexpr int L_LIST = L_MASK + 2048;
constexpr int L_TOK = L_LIST + 1056;
constexpr int L_END = L_TOK + 2048;
static_assert(256 * OS_LD * 4 <= 64 * IMP_LD * 4, "accumulator fits the importance table");
static_assert(L_END <= MISC_OFF, "attention LDS map");

struct Stage { u32x4 k, v; };
template <bool WITHV> DEVI void stage_load(Stage& s, const bf16_t* K, const bf16_t* V, int tid) { s.k = *(const u32x4*)((const char*)K + tid * 16); if (WITHV) s.v = *(const u32x4*)((const char*)V + tid * 16); }
template <bool WITHV> DEVI void stage_write(const Stage& s, LAS unsigned char* buf, int tid) {
    const int r = tid >> 3, c = tid & 7;
    *(LAS u32x4*)(buf + r * 128 + ((c ^ (r & 7)) << 4)) = s.k;
    if (WITHV) *(LAS u32x4*)(buf + 8192 + r * VLD + (c << 4)) = s.v;
}
DEVI float max_quads(float x) {
    auto a = __builtin_amdgcn_permlane16_swap(__float_as_uint(x), __float_as_uint(x), false, false); x = fmaxf(__uint_as_float(a[0]), __uint_as_float(a[1]));
    auto b = __builtin_amdgcn_permlane32_swap(__float_as_uint(x), __float_as_uint(x), false, false); return fmaxf(__uint_as_float(b[0]), __uint_as_float(b[1]));
}
DEVI float sum_quads(float x) {
    auto a = __builtin_amdgcn_permlane16_swap(__float_as_uint(x), __float_as_uint(x), false, false); x = __uint_as_float(a[0]) + __uint_as_float(a[1]);
    auto b = __builtin_amdgcn_permlane32_swap(__float_as_uint(x), __float_as_uint(x), false, false); return __uint_as_float(b[0]) + __uint_as_float(b[1]);
}
template <int CTRL> DEVI float dppf(float v) { return __int_as_float(__builtin_amdgcn_update_dpp(0, __float_as_int(v), CTRL, 0xF, 0xF, false)); }
template <int CTRL> DEVI int dppi(int v) { return __builtin_amdgcn_update_dpp(0, v, CTRL, 0xF, 0xF, false); }
DEVI float bperm(float v, int src_lane) { return __builtin_bit_cast(float, __builtin_amdgcn_ds_bpermute(src_lane << 2, __builtin_bit_cast(int, v))); }
#define DPP_X1 0xB1
#define DPP_X2 0x4E
#define DPP_HM 0x141

DEVI void qk_slot(LAS const unsigned char* kb, const bf16x8 q0, const bf16x8 q1, int lane, f32x4 (&s)[4]) {
    const int l15 = lane & 15, quad = lane >> 4;
    LAS const unsigned char* p0 = kb + l15 * 128 + (((quad) ^ (l15 & 7)) << 4);
    LAS const unsigned char* p1 = kb + l15 * 128 + (((4 + quad) ^ (l15 & 7)) << 4);
#pragma unroll
    for (int kg = 0; kg < 4; ++kg) {
        const bf16x8 a0 = *(LAS const bf16x8*)(p0 + kg * 2048), a1 = *(LAS const bf16x8*)(p1 + kg * 2048);
        f32x4 z = {0.f, 0.f, 0.f, 0.f};
        z = __builtin_amdgcn_mfma_f32_16x16x32_bf16(a0, q0, z, 0, 0, 0);
        s[kg] = __builtin_amdgcn_mfma_f32_16x16x32_bf16(a1, q1, z, 0, 0, 0);
    }
}
DEVI float mask_max(f32x4 (&s)[4], int lo, int hi, int quad) {
    float mx = NEGINF; const int loq = lo - 4 * quad, hiq = hi - 4 * quad;
#pragma unroll
    for (int kg = 0; kg < 4; ++kg)
#pragma unroll
        for (int i = 0; i < 4; ++i) { const bool ok = (16 * kg + i >= loq) & (16 * kg + i <= hiq); s[kg][i] = ok ? s[kg][i] : NEGINF; mx = fmaxf(mx, s[kg][i]); }
    return max_quads(mx);
}
DEVI bf16x8 pack_p(const f32x4 a, const f32x4 b) { u32x4 w; w.x = pg8::cvt_pk_bf16(a[0], a[1]); w.y = pg8::cvt_pk_bf16(a[2], a[3]); w.z = pg8::cvt_pk_bf16(b[0], b[1]); w.w = pg8::cvt_pk_bf16(b[2], b[3]); return __builtin_bit_cast(bf16x8, w); }
DEVI void pv_slot(LAS const unsigned char* vb, const bf16x8 (&pb)[2], f32x4 (&o)[4], int lane) {
    const int i = lane & 15, quad = lane >> 4;
    LAS const unsigned char* a0 = vb + (4 * quad + (i >> 2)) * VLD + ((i & 3) << 3);
#pragma unroll
    for (int ks2 = 0; ks2 < 2; ++ks2) {
#pragma unroll
        for (int dg = 0; dg < 4; ++dg) {
            const v4i16_t t0 = __builtin_amdgcn_ds_read_tr16_b64_v4i16((LAS v4i16_t*)(a0 + (32 * ks2) * VLD + 32 * dg));
            const v4i16_t t1 = __builtin_amdgcn_ds_read_tr16_b64_v4i16((LAS v4i16_t*)(a0 + (32 * ks2 + 16) * VLD + 32 * dg));
            const bf16x8 a = {t0[0], t0[1], t0[2], t0[3], t1[0], t1[1], t1[2], t1[3]};
            o[dg] = __builtin_amdgcn_mfma_f32_16x16x32_bf16(a, pb[ks2], o[dg], 0, 0, 0);
        }
    }
}
template <bool PV> DEVI void online_step(LAS const unsigned char* buf, const bf16x8 q0, const bf16x8 q1, int lo, int hi, float& m, float& l, f32x4 (&o)[4], int lane) {
    __builtin_amdgcn_sched_barrier(0);
    f32x4 s[4]; qk_slot(buf, q0, q1, lane, s);
    __builtin_amdgcn_sched_barrier(0);
    const int quad = lane >> 4;
    float mx;
    if (__builtin_amdgcn_ballot_w64((lo > 0) | (hi < 63)) != 0ull) mx = mask_max(s, lo, hi, quad);
    else { float a = fmaxf(fmaxf(s[0][0], s[0][1]), fmaxf(s[0][2], s[0][3])), b = fmaxf(fmaxf(s[1][0], s[1][1]), fmaxf(s[1][2], s[1][3]));
           a = fmaxf(a, fmaxf(fmaxf(s[2][0], s[2][1]), fmaxf(s[2][2], s[2][3]))); b = fmaxf(b, fmaxf(fmaxf(s[3][0], s[3][1]), fmaxf(s[3][2], s[3][3]))); mx = max_quads(fmaxf(a, b)); }
    const float mnew = fmaxf(m, mx);
    const float msafe = (mnew == NEGINF) ? 0.f : mnew;
    const float alpha = __builtin_amdgcn_exp2f((m - msafe) * CEXP);
    const float mc = -msafe * CEXP;
    float ps = 0.f;
#pragma unroll
    for (int kg = 0; kg < 4; ++kg)
#pragma unroll
        for (int i = 0; i < 4; ++i) { s[kg][i] = __builtin_amdgcn_exp2f(__builtin_fmaf(s[kg][i], CEXP, mc)); ps += s[kg][i]; }
    l = l * alpha + ps; m = mnew;
    if (PV) {
        if (__builtin_amdgcn_ballot_w64(alpha != 1.f) != 0ull) {
#pragma unroll
            for (int dg = 0; dg < 4; ++dg) o[dg] = o[dg] * alpha;
        }
        bf16x8 pb[2]; pb[0] = pack_p(s[0], s[1]); pb[1] = pack_p(s[2], s[3]);
        pv_slot(buf + 8192, pb, o, lane);
    }
    __builtin_amdgcn_sched_barrier(0);
}
template <bool PV> DEVI void fixed_step(LAS const unsigned char* buf, const bf16x8 q0, const bf16x8 q1, int lo, int hi, float mc, float& l, f32x4 (&o)[4], int lane) {
    __builtin_amdgcn_sched_barrier(0);
    f32x4 s[4]; qk_slot(buf, q0, q1, lane, s);
    __builtin_amdgcn_sched_barrier(0);
    const int quad = lane >> 4;
    float ps = 0.f;
    if (__builtin_amdgcn_ballot_w64((lo > 0) | (hi < 63)) != 0ull) { const int loq = lo - 4 * quad, hiq = hi - 4 * quad;
#pragma unroll
        for (int kg = 0; kg < 4; ++kg)
#pragma unroll
            for (int i = 0; i < 4; ++i) { const bool ok = (16 * kg + i >= loq) & (16 * kg + i <= hiq); s[kg][i] = ok ? __builtin_amdgcn_exp2f(__builtin_fmaf(s[kg][i], CEXP, mc)) : 0.f; ps += s[kg][i]; }
    } else {
#pragma unroll
        for (int kg = 0; kg < 4; ++kg)
#pragma unroll
            for (int i = 0; i < 4; ++i) { s[kg][i] = __builtin_amdgcn_exp2f(__builtin_fmaf(s[kg][i], CEXP, mc)); ps += s[kg][i]; }
    }
    l += ps;
    if (PV) { bf16x8 pb[2]; pb[0] = pack_p(s[0], s[1]); pb[1] = pack_p(s[2], s[3]); pv_slot(buf + 8192, pb, o, lane); }
    __builtin_amdgcn_sched_barrier(0);
}
DEVI void load_q(const bf16_t* Q, size_t tok, int hcol, int quad, bf16x8 (&qf)[2]) {
    const bf16_t* p = Q + tok * DM + hcol + quad * 8;
    qf[0] = *(const bf16x8*)p; qf[1] = *(const bf16x8*)(p + 32);
}
DEVI bf16x8 rope_frag(const bf16x8 q, const float* csrow, int quad, int lane) {
    const u32x4 w = __builtin_bit_cast(u32x4, q); u32x4 pw;
#pragma unroll
    for (int i = 0; i < 4; ++i) pw[i] = (unsigned)shxi((int)w[i], 16, lane);
    if (quad >= 2) return q;
    const f32x4 c0 = *(const f32x4*)csrow, c1 = *(const f32x4*)(csrow + 4), s0 = *(const f32x4*)(csrow + 8), s1 = *(const f32x4*)(csrow + 12);
    const float sg = quad == 0 ? -1.f : 1.f;
    float x[8], xp[8];
#pragma unroll
    for (int i = 0; i < 4; ++i) { x[2 * i] = bflo(w[i]); x[2 * i + 1] = bfhi(w[i]); xp[2 * i] = bflo(pw[i]); xp[2 * i + 1] = bfhi(pw[i]); }
    const float cc[8] = {c0[0], c0[1], c0[2], c0[3], c1[0], c1[1], c1[2], c1[3]}, ss[8] = {s0[0], s0[1], s0[2], s0[3], s1[0], s1[1], s1[2], s1[3]};
    u32x4 o;
#pragma unroll
    for (int i = 0; i < 4; ++i) o[i] = pg8::cvt_pk_bf16(x[2 * i] * cc[2 * i] + sg * xp[2 * i] * ss[2 * i], x[2 * i + 1] * cc[2 * i + 1] + sg * xp[2 * i + 1] * ss[2 * i + 1]);
    return __builtin_bit_cast(bf16x8, o);
}

struct KFr { bf16x8 k[4][2]; };
struct VFr { bf16x8 v[4][2]; };
constexpr float LSCALE = 1048576.f;
struct Raw8 { u32x4 k[4]; u32x4 v[4]; };
template <int OFF> DEVI void gld16(u32x4& d, const void* p) { asm volatile("global_load_dwordx4 %0, %1, off offset:%2" : "=v"(d) : "v"(p), "n"(OFF) : "memory"); }
DEVI void sel_load8(Raw8& r, const unsigned char* K8, const unsigned char* V8, int j, int lane) {
    const int l15 = lane & 15, quad = lane >> 4;
    const unsigned char* pk = K8 + ((size_t)(64 * j + l15)) * 64 + 16 * quad;
    const unsigned char* pv = V8 + (size_t)j * 4096 + l15 * 64 + 16 * quad;
    gld16<0>(r.k[0], pk); gld16<1024>(r.k[1], pk); gld16<2048>(r.k[2], pk); gld16<3072>(r.k[3], pk);
    gld16<0>(r.v[0], pv); gld16<1024>(r.v[1], pv); gld16<2048>(r.v[2], pv); gld16<3072>(r.v[3], pv);
}
template <int N> DEVI void sel_wait8(Raw8& r) {
    asm volatile("s_waitcnt vmcnt(%8)" : "+v"(r.k[0]), "+v"(r.k[1]), "+v"(r.k[2]), "+v"(r.k[3]), "+v"(r.v[0]), "+v"(r.v[1]), "+v"(r.v[2]), "+v"(r.v[3]) : "n"(N) : "memory");
    __builtin_amdgcn_sched_barrier(0);
}
typedef float f32x2v __attribute__((ext_vector_type(2)));
DEVI bf16x8 fp8x8_bf16(unsigned w0, unsigned w1) {
    const f32x2v a = __builtin_amdgcn_cvt_pk_f32_fp8((int)w0, false), b = __builtin_amdgcn_cvt_pk_f32_fp8((int)w0, true), c = __builtin_amdgcn_cvt_pk_f32_fp8((int)w1, false), d = __builtin_amdgcn_cvt_pk_f32_fp8((int)w1, true);
    u32x4 o;
    o[0] = __builtin_amdgcn_perm(__float_as_uint(a[1]), __float_as_uint(a[0]), 0x07060302u); o[1] = __builtin_amdgcn_perm(__float_as_uint(b[1]), __float_as_uint(b[0]), 0x07060302u);
    o[2] = __builtin_amdgcn_perm(__float_as_uint(c[1]), __float_as_uint(c[0]), 0x07060302u); o[3] = __builtin_amdgcn_perm(__float_as_uint(d[1]), __float_as_uint(d[0]), 0x07060302u);
    return __builtin_bit_cast(bf16x8, o);
}
DEVI void sel_expand(const Raw8& r, KFr& f, VFr& g) {
#pragma unroll
    for (int i = 0; i < 4; ++i) { f.k[i][0] = fp8x8_bf16(r.k[i][0], r.k[i][1]); f.k[i][1] = fp8x8_bf16(r.k[i][2], r.k[i][3]); g.v[i][0] = fp8x8_bf16(r.v[i][0], r.v[i][1]); g.v[i][1] = fp8x8_bf16(r.v[i][2], r.v[i][3]); }
}
template <bool PASS2> DEVI void sel_block(const KFr& f, const VFr& fv, int j, bool active, int cur, LAS const unsigned* smask, LAS const unsigned char* Ql, LAS float* mrow, LAS int* lrow, LAS int* Os, float lg2k, float lratio, LAS int* tlist, int lane) {
    const int l15 = lane & 15, quad = lane >> 4, mem = l15 >> 2;
    const bool forced = (j == 0) || (j >= cur - 1);
    int cnt = 0;
    if (active) {
        if (forced) cnt = 64;
        else { const unsigned lo = (unsigned)__builtin_amdgcn_readfirstlane((int)smask[2 * j]), hi = (unsigned)__builtin_amdgcn_readfirstlane((int)smask[2 * j + 1]);
            const unsigned long long mk = ((unsigned long long)hi << 32) | lo;
            cnt = __builtin_popcountll(mk);
            const bool mine = (mk >> lane) & 1ull; const int rank = __builtin_popcountll(mk & ((1ull << lane) - 1ull));
            if (mine) tlist[rank] = lane;
            LDS_WAIT(); }
    }
    const int ngroups = (cnt + 3) >> 2;
    const bool diag = (j == cur);
#pragma unroll 1
    for (int gi = 0; gi < ngroups; ++gi) {
        const int slot = 4 * gi + mem;
        const bool valid = slot < cnt;
        int mt = forced ? slot : tlist[slot];
        mt = valid ? mt : 0;
        const int row = mt * 4 + (l15 & 3);
        const bf16x8 q0 = *(LAS const bf16x8*)(Ql + row * 128 + (((2 * quad) ^ (row & 7)) << 4));
        const bf16x8 q1 = *(LAS const bf16x8*)(Ql + row * 128 + (((2 * quad + 1) ^ (row & 7)) << 4));
        f32x4 sc[4];
#pragma unroll
        for (int kg = 0; kg < 4; ++kg) { f32x4 z = {0.f, 0.f, 0.f, 0.f}; z = __builtin_amdgcn_mfma_f32_16x16x32_bf16(f.k[kg][0], q0, z, 0, 0, 0); sc[kg] = __builtin_amdgcn_mfma_f32_16x16x32_bf16(f.k[kg][1], q1, z, 0, 0, 0); }
        if (!PASS2) {
            float mx;
            if (diag) mx = mask_max(sc, 0, mt, quad);
            else { float a = fmaxf(fmaxf(sc[0][0], sc[0][1]), fmaxf(sc[0][2], sc[0][3])), b = fmaxf(fmaxf(sc[1][0], sc[1][1]), fmaxf(sc[1][2], sc[1][3]));
                   a = fmaxf(a, fmaxf(fmaxf(sc[2][0], sc[2][1]), fmaxf(sc[2][2], sc[2][3]))); b = fmaxf(b, fmaxf(fmaxf(sc[3][0], sc[3][1]), fmaxf(sc[3][2], sc[3][3]))); mx = max_quads(fmaxf(a, b)); }
            if (quad == 0 && valid) __hip_atomic_fetch_max(mrow + row, mx, __ATOMIC_RELAXED, __HIP_MEMORY_SCOPE_WORKGROUP);
        } else {
            const float mc = lg2k - mrow[row] * CEXP;
            float ps = 0.f;
            if (diag) { const int hiq = mt - 4 * quad;
#pragma unroll
                for (int kg = 0; kg < 4; ++kg)
#pragma unroll
                    for (int i = 0; i < 4; ++i) { sc[kg][i] = (16 * kg + i <= hiq) ? __builtin_amdgcn_exp2f(__builtin_fmaf(sc[kg][i], CEXP, mc)) : 0.f; ps += sc[kg][i]; }
            } else {
#pragma unroll
                for (int kg = 0; kg < 4; ++kg)
#pragma unroll
                    for (int i = 0; i < 4; ++i) { sc[kg][i] = __builtin_amdgcn_exp2f(__builtin_fmaf(sc[kg][i], CEXP, mc)); ps += sc[kg][i]; }
            }
            ps = sum_quads(ps);
            if (quad == 0 && valid) __hip_atomic_fetch_add(lrow + row, (int)(ps * lratio), __ATOMIC_RELAXED, __HIP_MEMORY_SCOPE_WORKGROUP);
            bf16x8 pb[2]; pb[0] = pack_p(sc[0], sc[1]); pb[1] = pack_p(sc[2], sc[3]);
            LAS int* orow = Os + row * OS_LD + 4 * quad;
#pragma unroll
            for (int dh = 0; dh < 2; ++dh) {
                f32x4 o[2];
#pragma unroll
                for (int d2 = 0; d2 < 2; ++d2) { const int dg = dh * 2 + d2; f32x4 z = {0.f, 0.f, 0.f, 0.f}; z = __builtin_amdgcn_mfma_f32_16x16x32_bf16(fv.v[dg][0], pb[0], z, 0, 0, 0); o[d2] = __builtin_amdgcn_mfma_f32_16x16x32_bf16(fv.v[dg][1], pb[1], z, 0, 0, 0); }
                if (valid) {
#pragma unroll
                    for (int d2 = 0; d2 < 2; ++d2)
#pragma unroll
                        for (int c = 0; c < 4; ++c) __hip_atomic_fetch_add(orow + 16 * (dh * 2 + d2) + c, (int)o[d2][c], __ATOMIC_RELAXED, __HIP_MEMORY_SCOPE_WORKGROUP);
                }
                __builtin_amdgcn_sched_barrier(0);
            }
        }
    }
}
#define BL(i) __builtin_amdgcn_readfirstlane(blist[(i) < nb ? (i) : nb - 1])
DEVI void sel_pass2(const unsigned char* K8, const unsigned char* V8, int nb, int cur, int wave, LAS const int* blist, LAS const unsigned* smask, LAS const unsigned char* Ql, LAS float* mrow, LAS int* lrow, LAS int* Os, float lg2k, float lratio, LAS int* tlist, int lane) {
    if (wave >= nb) return;
    Raw8 ra, rb; KFr kf; VFr vf;
    asm volatile("s_waitcnt vmcnt(0)" ::: "memory");
    sel_load8(ra, K8, V8, BL(wave), lane);
#pragma unroll 1
    for (int bi = wave; bi < nb; bi += 16) {
        sel_load8(rb, K8, V8, BL(bi + 8), lane); sel_wait8<8>(ra);
        sel_expand(ra, kf, vf);
        sel_block<true>(kf, vf, BL(bi), true, cur, smask, Ql, mrow, lrow, Os, lg2k, lratio, tlist, lane);
        sel_load8(ra, K8, V8, BL(bi + 16), lane); sel_wait8<8>(rb);
        sel_expand(rb, kf, vf);
        sel_block<true>(kf, vf, BL(bi + 8), bi + 8 < nb, cur, smask, Ql, mrow, lrow, Os, lg2k, lratio, tlist, lane);
    }
    asm volatile("s_waitcnt vmcnt(0)" ::: "memory");
}
#undef BL
}


DEVI void phase_vs_transpose(Frame& F, int l) {
    F.refresh();
    unsigned char* ws = F.ws;
    const bf16_t* VS = (const bf16_t*)(ws + RA_VS); unsigned char* VT = ws + RA_VST; unsigned char* K8 = ws + RA_K8; const bf16_t* KSG = (const bf16_t*)(ws + RA_KS);
    LAS unsigned char* T = F.lds + F.wave * 9216;
    const int lane = F.lane, rr = lane >> 3, c = lane & 7, i16 = lane & 15, grp = lane >> 4;
    for (int it = ((int)blockIdx.x - 64) * NWAVES + F.wave; it < 2048; it += 192 * NWAVES) {
        const int bg = it >> 8, tile = it & 255;
        const bf16_t* vsrc = VS + ((size_t)bg * SEQ + tile * 64) * 64; const bf16_t* ksrc = KSG + ((size_t)bg * SEQ + tile * 64) * 64;
        const bf16_t* wsrc = (const bf16_t*)(ws + RA_KW) + ((size_t)bg * SEQ + tile * 64) * 64;
        unsigned char* kdst = K8 + ((size_t)bg * SEQ + tile * 64) * 64;
        u32x4 v[8], k[8], kw[8];
#pragma unroll
        for (int i = 0; i < 8; ++i) { v[i] = *(const u32x4*)(vsrc + (size_t)(8 * i + rr) * 64 + c * 8); k[i] = *(const u32x4*)(ksrc + (size_t)(8 * i + rr) * 64 + c * 8); kw[i] = *(const u32x4*)(wsrc + (size_t)(8 * i + rr) * 64 + c * 8); }
        float vmx = 0.f, kmx = 0.f, wmx = 0.f;
#pragma unroll
        for (int i = 0; i < 8; ++i) { float n2 = 0.f, w2 = 0.f;
            u32x2 k8; k8[0] = pack_fp8x4(bflo(k[i][0]), bfhi(k[i][0]), bflo(k[i][1]), bfhi(k[i][1])); k8[1] = pack_fp8x4(bflo(k[i][2]), bfhi(k[i][2]), bflo(k[i][3]), bfhi(k[i][3]));
            *(u32x2*)(kdst + (size_t)(8 * i + rr) * 64 + c * 8) = k8;
#pragma unroll
            for (int e = 0; e < 2; ++e) { const fa::f32x2v a = __builtin_amdgcn_cvt_pk_f32_fp8((int)k8[e], false), b2 = __builtin_amdgcn_cvt_pk_f32_fp8((int)k8[e], true); n2 += a[0] * a[0] + a[1] * a[1] + b2[0] * b2[0] + b2[1] * b2[1]; }
#pragma unroll
            for (int e = 0; e < 4; ++e) { const float a3 = bflo(kw[i][e]), b3 = bfhi(kw[i][e]); w2 += a3 * a3 + b3 * b3; }
            n2 += fa::dppf<DPP_X1>(n2); n2 += fa::dppf<DPP_X2>(n2); n2 += fa::dppf<DPP_HM>(n2);
            w2 += fa::dppf<DPP_X1>(w2); w2 += fa::dppf<DPP_X2>(w2); w2 += fa::dppf<DPP_HM>(w2);
            kmx = fmaxf(kmx, n2); wmx = fmaxf(wmx, w2);
            *(LAS u32x4*)(T + (8 * i + rr) * 144 + c * 16) = v[i]; }
        LDS_WAIT(); asm volatile("" ::: "memory");
        unsigned char* vdst = VT + ((size_t)bg * 256 + tile) * 4096;
#pragma unroll
        for (int dc = 0; dc < 4; ++dc) { u32x4 o;
#pragma unroll
            for (int n = 0; n < 4; ++n) { const int kg4 = n * 4 + grp;
                const fa::v4i16_t t = __builtin_amdgcn_ds_read_tr16_b64_v4i16((LAS fa::v4i16_t*)(T + (4 * kg4 + (i16 >> 2)) * 144 + (16 * dc + 4 * (i16 & 3)) * 2));
                const u32x2 tw = __builtin_bit_cast(u32x2, t);
                o[n] = pack_fp8x4(bflo(tw[0]), bfhi(tw[0]), bflo(tw[1]), bfhi(tw[1]));
                const fa::f32x2v a = __builtin_amdgcn_cvt_pk_f32_fp8((int)o[n], false), b2 = __builtin_amdgcn_cvt_pk_f32_fp8((int)o[n], true);
                vmx = fmaxf(vmx, fmaxf(fmaxf(fabsf(a[0]), fabsf(a[1])), fmaxf(fabsf(b2[0]), fabsf(b2[1])))); }
            *(u32x4*)(vdst + (16 * dc + i16) * 64 + 16 * grp) = o; }
        vmx = wave_max(vmx, lane); kmx = wave_max(kmx, lane); wmx = wave_max(wmx, lane);
        if (lane == 0) { atomicMax((unsigned*)(ws + WS_CTL) + CW_VMAX + l * 8 + bg, __float_as_uint(vmx)); atomicMax((unsigned*)(ws + WS_CTL) + CW_KMAX + l * 8 + bg, __float_as_uint(kmx));
            atomicMax((unsigned*)(ws + WS_CTL) + CW_KWMAX + l * 8 + bg, __float_as_uint(wmx)); }
        LDS_WAIT(); asm volatile("" ::: "memory");
    }
}

DEVI void phase_nsa_fast(Frame& F, int layer) {
    using namespace fa;
    F.refresh();
    unsigned char* ws = F.ws;
    const bf16_t* Q = (const bf16_t*)(ws + RA_Q); unsigned char* ATT8 = ws + RA_ATT;
    const float* GT = (const float*)(ws + RA_GATE); const float* CS = (const float*)(ws + WS_CS);
    const int wave = F.wave;
    LAS unsigned char* kvb = F.lds + L_KV;
    LAS float* imp = (LAS float*)(F.lds + L_IMP);
    LAS unsigned* smask = (LAS unsigned*)(F.lds + L_MASK);
    LAS int* blist = (LAS int*)(F.lds + L_LIST);
    float kcmax2;
    {   const int bg0 = F.vcu >> 5; const bf16_t* kc0 = (const bf16_t*)(ws + RA_KC) + (size_t)bg0 * 1024 * 64;
        float mx = 0.f;
        for (int i = F.tid; i < 1024 * 8; i += NWAVES * 64) { const u32x4 w = *(const u32x4*)(kc0 + (size_t)i * 8); float n2 = 0.f;
#pragma unroll
            for (int e = 0; e < 4; ++e) { const float a = bflo(w[e]), b2 = bfhi(w[e]); n2 += a * a + b2 * b2; }
            n2 += dppf<DPP_X1>(n2); n2 += dppf<DPP_X2>(n2); n2 += dppf<DPP_HM>(n2);
            mx = fmaxf(mx, n2); }
        mx = wave_max(mx, F.lane);
        LAS float* red = (LAS float*)(F.lds + L_END);
        if (F.lane == 0) red[wave] = mx;
        __syncthreads();
        kcmax2 = fmaxf(fmaxf(fmaxf(red[0], red[1]), fmaxf(red[2], red[3])), fmaxf(fmaxf(red[4], red[5]), fmaxf(red[6], red[7])));
        __syncthreads(); }
#pragma unroll 1
    for (int ui = 0; ui < 8; ++ui) {
        int lane = F.lane; asm volatile("" : "+v"(lane));
        const int tid = wave * 64 + lane, quad = lane >> 4, l15 = lane & 15;
        int tile = (F.vcu & 31) + 32 * (ui >> 1); if (ui & 1) tile = 255 - tile;
        const int bg = F.vcu >> 5, b = bg >> 2, g = bg & 3, cur = tile, t0 = tile * 64;
        const bf16_t* KC = (const bf16_t*)(ws + RA_KC) + (size_t)bg * 1024 * 64; const bf16_t* VC = (const bf16_t*)(ws + RA_VC) + (size_t)bg * 1024 * 64;
        const bf16_t* KS = (const bf16_t*)(ws + RA_KS) + (size_t)bg * SEQ * 64; const bf16_t* VS = (const bf16_t*)(ws + RA_VS) + (size_t)bg * SEQ * 64;
        const bf16_t* KW = (const bf16_t*)(ws + RA_KW) + (size_t)bg * SEQ * 64; const bf16_t* VW = (const bf16_t*)(ws + RA_VW) + (size_t)bg * SEQ * 64;
        smask[tid] = 0u;
        int tl[2], tok[2]; bf16x8 qf[2][2];
#pragma unroll
        for (int s = 0; s < 2; ++s) { tl[s] = 8 * wave + 4 * s + (l15 >> 2); tok[s] = b * SEQ + t0 + tl[s]; load_q(Q, (size_t)tok[s], g * 256 + (l15 & 3) * 64, quad, qf[s]); }
        float gate[2][3];
#pragma unroll
        for (int s = 0; s < 2; ++s)
#pragma unroll
            for (int br = 0; br < 3; ++br) gate[s][br] = GT[(size_t)tok[s] * 48 + br * 16 + g * 4 + (l15 & 3)];
        const float vmax = fmaxf(__uint_as_float(__hip_atomic_load((const unsigned*)(ws + WS_CTL) + CW_VMAX + layer * 8 + bg, __ATOMIC_RELAXED, __HIP_MEMORY_SCOPE_AGENT)), 1e-30f);
        bf16x8 qr[2][2];
#pragma unroll
        for (int s = 0; s < 2; ++s) { qr[s][0] = rope_frag(qf[s][0], CS + (size_t)tok[s] * 16, quad, lane); qr[s][1] = qf[s][1]; }
        float qn2[2];
#pragma unroll
        for (int s = 0; s < 2; ++s) { float n2 = 0.f;
#pragma unroll
            for (int ks = 0; ks < 2; ++ks) { const u32x4 w = __builtin_bit_cast(u32x4, qf[s][ks]);
#pragma unroll
                for (int e = 0; e < 4; ++e) { const float a = bflo(w[e]), b2 = bfhi(w[e]); n2 += a * a + b2 * b2; } }
            qn2[s] = sum_quads(n2); }
        const float kwmax2 = __uint_as_float(__hip_atomic_load((const unsigned*)(ws + WS_CTL) + CW_KWMAX + layer * 8 + bg, __ATOMIC_RELAXED, __HIP_MEMORY_SCOPE_AGENT));
        f32x4 out[2][4];
#pragma unroll
        for (int s = 0; s < 2; ++s)
#pragma unroll
            for (int dg = 0; dg < 4; ++dg) out[s][dg] = (f32x4){0.f, 0.f, 0.f, 0.f};
        Stage st;
        const int ntile = (4 * cur + 3 + 63) >> 6;
        int nval[2];
#pragma unroll
        for (int s = 0; s < 2; ++s) { const int t = t0 + tl[s]; nval[s] = t >= 31 ? ((t - 31) >> 4) + 1 : 0; }
        float l[2] = {0.f, 0.f};
        const float mcc[2] = {-sqrtf(qn2[0] * kcmax2) * 1.0001f * CEXP, -sqrtf(qn2[1] * kcmax2) * 1.0001f * CEXP};
        {   stage_load<false>(st, KC, VC, tid); stage_write<false>(st, kvb, tid); __syncthreads();
#pragma unroll 1
            for (int i = 0; i < ntile; ++i) {
                LAS unsigned char* buf = kvb + (i & 1) * KVB;
                if (i + 1 < ntile) stage_load<false>(st, KC + (size_t)(i + 1) * 4096, VC, tid); else stage_load<true>(st, KC, VC, tid);
#pragma unroll
                for (int s = 0; s < 2; ++s) { f32x4 dummy[4]; fixed_step<false>(buf, qf[s][0], qf[s][1], 0, nval[s] - 64 * i - 1, mcc[s], l[s], dummy, lane); }
                if (i + 1 < ntile) stage_write<false>(st, kvb + ((i + 1) & 1) * KVB, tid);
                __syncthreads();
            }
        }
        float invl[2], msafe[2];
#pragma unroll
        for (int s = 0; s < 2; ++s) { const float lt = sum_quads(l[s]); invl[s] = lt > 0.f ? 1.f / lt : 0.f; msafe[s] = -mcc[s] * (1.f / CEXP); }
        const int jbw0 = cur >= 8 ? cur - 8 : 0;
        {   float gcv[2] = {gate[0][0], gate[1][0]};
            float carry[2] = {0.f, 0.f};
            stage_write<true>(st, kvb, tid); __syncthreads();
#pragma unroll 1
            for (int i = 0; i < ntile; ++i) {
                LAS unsigned char* buf = kvb + (i & 1) * KVB;
                if (i + 1 < ntile) stage_load<true>(st, KC + (size_t)(i + 1) * 4096, VC + (size_t)(i + 1) * 4096, tid); else stage_load<true>(st, KW + (size_t)jbw0 * 4096, VW + (size_t)jbw0 * 4096, tid);
#pragma unroll
                for (int s = 0; s < 2; ++s) {
                    __builtin_amdgcn_sched_barrier(0);
                    f32x4 sc[4]; qk_slot(buf, qf[s][0], qf[s][1], lane, sc);
                    __builtin_amdgcn_sched_barrier(0);
                    const int hiq = nval[s] - 64 * i - 1 - 4 * quad; const float mc2 = -msafe[s] * CEXP;
#pragma unroll
                    for (int kg = 0; kg < 4; ++kg)
#pragma unroll
                        for (int k = 0; k < 4; ++k) sc[kg][k] = (16 * kg + k <= hiq) ? __builtin_amdgcn_exp2f(__builtin_fmaf(sc[kg][k], CEXP, mc2)) * invl[s] : 0.f;
                    bf16x8 pb[2]; pb[0] = pack_p(sc[0] * gcv[s], sc[1] * gcv[s]); pb[1] = pack_p(sc[2] * gcv[s], sc[3] * gcv[s]);
#pragma unroll
                    for (int kg = 0; kg < 4; ++kg) {
                        float a = (sc[kg][0] + sc[kg][1]) + (sc[kg][2] + 0.5f * sc[kg][3]), bq = 0.5f * sc[kg][3];
                        a += dppf<DPP_X1>(a); a += dppf<DPP_X2>(a); bq += dppf<DPP_X1>(bq); bq += dppf<DPP_X2>(bq);
                        const float fromprev = bperm(bq, (lane - 16) & 63);
                        const float add = quad == 0 ? carry[s] : fromprev;
                        carry[s] = bperm(bq, (lane + 48) & 63);
                        if ((l15 & 3) == 0) imp[(8 * wave + 4 * s + (l15 >> 2)) * IMP_LD + 16 * i + 4 * kg + quad] = a + add;
                    }
                    __builtin_amdgcn_sched_barrier(0);
                    pv_slot(buf + 8192, pb, out[s], lane);
                    __builtin_amdgcn_sched_barrier(0);
                }
                if (i + 1 < ntile) stage_write<true>(st, kvb + ((i + 1) & 1) * KVB, tid);
                __syncthreads();
            }
        }
        {   const int tl8 = lane >> 3, chunk = lane & 7, trow = (8 * wave + tl8) * IMP_LD;
            const int ncand = cur - 2;
            const int wsel = ((8 * wave + tl8) >> 5), bsel = (8 * wave + tl8) & 31;
            if (ncand > 0 && ncand <= 13) {
#pragma unroll
                for (int i = 0; i < 2; ++i) { const int j = 8 * i + chunk; if (j >= 1 && j <= cur - 2) __hip_atomic_fetch_or(smask + j * 2 + wsel, 1u << bsel, __ATOMIC_RELAXED, __HIP_MEMORY_SCOPE_WORKGROUP); }
            } else if (ncand > 13) {
                unsigned lv[13];
#pragma unroll
                for (int k = 0; k < 13; ++k) lv[k] = 0u;
                const int imax = (cur - 2) >> 3;
#pragma unroll 1
                for (int i = 0; i <= imax; ++i) {
                    const int j = 8 * i + chunk;
                    unsigned x = (j >= 1 && j <= cur - 2) ? ((__float_as_uint(imp[trow + j]) & 0xFFFFFF00u) | (unsigned)(255 - j)) : 0u;
                    if (__builtin_amdgcn_ballot_w64(x > lv[12]) != 0ull) {
#pragma unroll
                        for (int k = 0; k < 13; ++k) { const unsigned hi_ = lv[k] > x ? lv[k] : x, lo_ = lv[k] > x ? x : lv[k]; lv[k] = hi_; x = lo_; }
                    }
                }
#pragma unroll 1
                for (int r = 0; r < 13; ++r) {
                    unsigned bv = lv[0];
                    { const unsigned ov = (unsigned)dppi<DPP_X1>((int)bv); bv = ov > bv ? ov : bv; }
                    { const unsigned ov = (unsigned)dppi<DPP_X2>((int)bv); bv = ov > bv ? ov : bv; }
                    { const unsigned ov = (unsigned)dppi<DPP_HM>((int)bv); bv = ov > bv ? ov : bv; }
                    if (lv[0] == bv && bv != 0u) {
#pragma unroll
                        for (int k = 0; k < 12; ++k) lv[k] = lv[k + 1];
                        lv[12] = 0u;
                    }
                    if (chunk == 0 && bv != 0u) __hip_atomic_fetch_or(smask + (255 - (int)(bv & 0xFFu)) * 2 + wsel, 1u << bsel, __ATOMIC_RELAXED, __HIP_MEMORY_SCOPE_WORKGROUP);
                }
            }
        }
        __syncthreads();
        if (wave == 0) {
            int base = 0;
#pragma unroll 1
            for (int r = 0; r < 4; ++r) { const int j = 64 * r + lane; const bool on = (j <= cur) && (j == 0 || j >= cur - 1 || (smask[j * 2] | smask[j * 2 + 1]) != 0u);
                const unsigned long long bal = __builtin_amdgcn_ballot_w64(on); const int pos = base + __builtin_popcountll(bal & ((1ull << lane) - 1ull));
                if (on) blist[pos] = j; base += __builtin_popcountll(bal); }
            if (lane == 0) blist[259] = base;
        }
        __syncthreads();
        LAS float* stashf = imp + wave * 2048 + lane;
#pragma unroll
        for (int s = 0; s < 2; ++s)
#pragma unroll
            for (int dg = 0; dg < 4; ++dg)
#pragma unroll
                for (int c = 0; c < 4; ++c) stashf[(s * 16 + dg * 4 + c) * 64] = out[s][dg][c];
        {   const int jb0 = jbw0, nb = cur - jb0 + 1;
            f32x4 ob[2][4]; float ll[2] = {0.f, 0.f};
            const float mcw[2] = {-sqrtf(qn2[0] * kwmax2) * 1.0001f * CEXP, -sqrtf(qn2[1] * kwmax2) * 1.0001f * CEXP};
#pragma unroll
            for (int s = 0; s < 2; ++s)
#pragma unroll
                for (int dg = 0; dg < 4; ++dg) ob[s][dg] = (f32x4){0.f, 0.f, 0.f, 0.f};
            stage_write<true>(st, kvb, tid); __syncthreads();
#pragma unroll 1
            for (int i = 0; i < nb; ++i) {
                LAS unsigned char* buf = kvb + (i & 1) * KVB;
                const int j = jb0 + i;
                if (i + 1 < nb) stage_load<true>(st, KW + (size_t)(j + 1) * 4096, VW + (size_t)(j + 1) * 4096, tid);
#pragma unroll
                for (int s = 0; s < 2; ++s) {
                    const int lo = (j == cur - 8) ? tl[s] + 1 : 0, hi = (j == cur) ? tl[s] : 63;
                    fixed_step<true>(buf, qr[s][0], qr[s][1], lo, hi, mcw[s], ll[s], ob[s], lane);
                }
                if (i + 1 < nb) stage_write<true>(st, kvb + ((i + 1) & 1) * KVB, tid);
                __syncthreads();
            }
#pragma unroll
            for (int s = 0; s < 2; ++s) { const float lt = sum_quads(ll[s]); const float gw = gate[s][2] * (lt > 0.f ? 1.f / lt : 0.f);
#pragma unroll
                for (int dg = 0; dg < 4; ++dg)
#pragma unroll
                    for (int c = 0; c < 4; ++c) out[s][dg][c] = stashf[(s * 16 + dg * 4 + c) * 64] + ob[s][dg][c] * gw; }
        }
        LAS unsigned* stashb = (LAS unsigned*)(F.lds + L_KV) + wave * 1024 + lane;
        LAS unsigned char* Ql = F.lds + L_Q;
        LAS float* mrow = (LAS float*)(F.lds + L_ML); LAS int* lrow = (LAS int*)(mrow + 256);
        LAS int* Os = (LAS int*)imp;
        const float oscale = 1048576.f / vmax;
#pragma unroll
        for (int s = 0; s < 2; ++s) {
#pragma unroll
            for (int dg = 0; dg < 4; ++dg) { stashb[((s * 4 + dg) * 2 + 0) * 64] = pg8::cvt_pk_bf16(out[s][dg][0], out[s][dg][1]); stashb[((s * 4 + dg) * 2 + 1) * 64] = pg8::cvt_pk_bf16(out[s][dg][2], out[s][dg][3]); }
            const int row = tl[s] * 4 + (l15 & 3);
            *(LAS bf16x8*)(Ql + row * 128 + ((quad ^ (row & 7)) << 4)) = qr[s][0];
            *(LAS bf16x8*)(Ql + row * 128 + (((4 + quad) ^ (row & 7)) << 4)) = qr[s][1];
        }
        __syncthreads();
        for (int i = lane; i < 32 * OS_LD; i += 64) Os[wave * 32 * OS_LD + i] = 0;
        if (lane < 32) lrow[wave * 32 + lane] = 0;
        {
            const float kmax2 = __uint_as_float(__hip_atomic_load((const unsigned*)(ws + WS_CTL) + CW_KMAX + layer * 8 + bg, __ATOMIC_RELAXED, __HIP_MEMORY_SCOPE_AGENT));
#pragma unroll
            for (int s = 0; s < 2; ++s) { float n2 = 0.f;
#pragma unroll
                for (int ks = 0; ks < 2; ++ks) { const u32x4 w = __builtin_bit_cast(u32x4, qr[s][ks]);
#pragma unroll
                    for (int e = 0; e < 4; ++e) { const float a = bflo(w[e]), b2 = bfhi(w[e]); n2 += a * a + b2 * b2; } }
                n2 = sum_quads(n2);
                if (quad == 0) mrow[tl[s] * 4 + (l15 & 3)] = sqrtf(n2 * kmax2) * 1.0001f; } }
        __syncthreads();
        {   const int nb = blist[259];
            int lane2 = lane; asm volatile("" : "+v"(lane2));
            const unsigned char* VT = ws + RA_VST + (size_t)bg * 256 * 4096; const unsigned char* K8 = ws + RA_K8 + (size_t)bg * SEQ * 64;
            LAS int* tlist = (LAS int*)(F.lds + L_TOK) + wave * 64;
            asm volatile("" : "+v"(lane2));
            sel_pass2(K8, VT, nb, cur, wave, blist, smask, Ql, mrow, lrow, Os, __builtin_amdgcn_logf(oscale), LSCALE / oscale, tlist, lane2);
            __syncthreads();
        }
        asm volatile("" : "+v"(tok[0]), "+v"(tok[1]), "+v"(tl[0]), "+v"(tl[1]));
        const float oinv = vmax * (1.f / 1048576.f);
#pragma unroll
        for (int s = 0; s < 2; ++s) { const int row = tl[s] * 4 + (l15 & 3); const float lt = (float)lrow[row] * (1.f / LSCALE);
            const float gs = gate[s][1] * (lt > 0.f ? 1.f / lt : 0.f) * oinv;
#pragma unroll
            for (int dg = 0; dg < 4; ++dg) { const unsigned w0 = stashb[((s * 4 + dg) * 2 + 0) * 64], w1 = stashb[((s * 4 + dg) * 2 + 1) * 64];
                LAS const int* orow = Os + row * OS_LD + 16 * dg + 4 * quad;
                const float r0 = bflo(w0) + (float)orow[0] * gs, r1 = bfhi(w0) + (float)orow[1] * gs, r2 = bflo(w1) + (float)orow[2] * gs, r3 = bfhi(w1) + (float)orow[3] * gs;
                *(unsigned*)(ATT8 + (size_t)tok[s] * DM + g * 256 + (l15 & 3) * 64 + 16 * dg + 4 * quad) = pack_fp8x4(r0, r1, r2, r3); } }
        __syncthreads();
    }
}

DEVI void phase_swa_fast(Frame& F, const float* sinks) {
    using namespace fa;
    F.refresh();
    unsigned char* ws = F.ws;
    const bf16_t* Q = (const bf16_t*)(ws + RA_Q); unsigned char* ATT8 = ws + RA_ATT;
    const int tid = F.tid, lane = F.lane, wave = F.wave, quad = lane >> 4, l15 = lane & 15;
    LAS unsigned char* kvb = F.lds + L_KV;
#pragma unroll 1
    for (int ui = 0; ui < 8; ++ui) {
        const int bg = ui >> 1, b = bg >> 1, g = bg & 1, t0 = (F.vcu * 2 + (ui & 1)) * 32, cur = t0 >> 6;
        const bf16_t* KS = (const bf16_t*)(ws + WS_KSH) + (size_t)bg * SEQ * 64; const bf16_t* VS = (const bf16_t*)(ws + WS_VSH) + (size_t)bg * SEQ * 64;
        int tq[2]; size_t tok[2]; bf16x8 qf[2][2]; f32x4 o[2][4]; float mm[2], ll[2];
        const float sink_raw = sinks[g * 8 + (l15 & 7)] * 8.0f;
#pragma unroll
        for (int s = 0; s < 2; ++s) { tq[s] = t0 + 4 * wave + 2 * s + (l15 >> 3); tok[s] = (size_t)b * SEQ + tq[s]; load_q(Q, tok[s], g * 512 + (l15 & 7) * 64, quad, qf[s]);
            mm[s] = sink_raw; ll[s] = quad == 0 ? 1.f : 0.f;
#pragma unroll
            for (int dg = 0; dg < 4; ++dg) o[s][dg] = (f32x4){0.f, 0.f, 0.f, 0.f}; }
        const int jb0 = cur >= 2 ? cur - 2 : 0, nb = cur - jb0 + 1;
        Stage st; stage_load<true>(st, KS + (size_t)jb0 * 4096, VS + (size_t)jb0 * 4096, tid); stage_write<true>(st, kvb, tid); __syncthreads();
#pragma unroll 1
        for (int i = 0; i < nb; ++i) {
            LAS unsigned char* buf = kvb + (i & 1) * KVB;
            const int j = jb0 + i;
            if (i + 1 < nb) stage_load<true>(st, KS + (size_t)(j + 1) * 4096, VS + (size_t)(j + 1) * 4096, tid);
#pragma unroll
            for (int s = 0; s < 2; ++s) online_step<true>(buf, qf[s][0], qf[s][1], tq[s] - (SWA_WIN - 1) - 64 * j, tq[s] - 64 * j, mm[s], ll[s], o[s], lane);
            if (i + 1 < nb) stage_write<true>(st, kvb + ((i + 1) & 1) * KVB, tid);
            __syncthreads();
        }
#pragma unroll
        for (int s = 0; s < 2; ++s) { const float inv = 1.f / sum_quads(ll[s]);
#pragma unroll
            for (int dg = 0; dg < 4; ++dg)
                *(unsigned*)(ATT8 + tok[s] * DM + g * 512 + (l15 & 7) * 64 + 16 * dg + 4 * quad) = pack_fp8x4(o[s][dg][0] * inv, o[s][dg][1] * inv, o[s][dg][2] * inv, o[s][dg][3] * inv); }
    }
}

enum Kind { K_PRO = 0, K_NSA_IN, K_CMP_HID, K_CMP_OUT, K_NSA_ATT, K_SWA_IN, K_SWA_ATT, K_OUTPROJ, K_LN1, K_LN1R, K_FFN1, K_FFN2, K_LN2, K_SCATTER, K_MOE1, K_MOE2, K_LN2C, K_COUNT };
struct Args { const void* in[18]; float* out; unsigned char* ws; int ph_lo, ph_hi; };
struct PhaseEnt { int kind, layer; };
constexpr int NPH = 35;
static const PhaseEnt h_prog[NPH] = {
    {K_PRO, 0},
    {K_NSA_IN, 0}, {K_CMP_HID, 0}, {K_CMP_OUT, 0}, {K_NSA_ATT, 0}, {K_OUTPROJ, 0}, {K_LN1, 0}, {K_FFN1, 0}, {K_FFN2, 0}, {K_LN2, 0},
    {K_NSA_IN, 1}, {K_CMP_HID, 1}, {K_CMP_OUT, 1}, {K_NSA_ATT, 1}, {K_OUTPROJ, 1}, {K_LN1R, 1}, {K_SCATTER, 1}, {K_MOE1, 1}, {K_MOE2, 1}, {K_LN2C, 1},
    {K_SWA_IN, 2}, {K_SWA_ATT, 2}, {K_OUTPROJ, 2}, {K_LN1, 2}, {K_FFN1, 2}, {K_FFN2, 2}, {K_LN2, 2},
    {K_SWA_IN, 3}, {K_SWA_ATT, 3}, {K_OUTPROJ, 3}, {K_LN1R, 3}, {K_SCATTER, 3}, {K_MOE1, 3}, {K_MOE2, 3}, {K_LN2C, 3},
};

template <int KIND> DEVI void do_phase(Frame& F, int l) {
    unsigned char* ws = F.ws;
    unsigned* ctl = (unsigned*)(ws + WS_CTL);
    LAS unsigned char* ring = F.lds;
    const int bx = (int)blockIdx.x;
    if constexpr (KIND == K_PRO) { phase_prologue(F); }
    if constexpr (KIND == K_NSA_IN) { pg8::Gemm g{(const bf16_t*)(ws + WS_HB8), DM / 2, DM / 2, DM / 2}; pg8::StaticOrder S; S.init(MTOK / 256, A_INP / 256, F.G, bx, (const bf16_t*)(ws + WS_WINA) + (size_t)l * A_INP * DM / 2);
        EpiNsaIn E{ws, (const float*)(ws + WS_CS)}; pg8::gemm_phase<EpiNsaIn, pg8::StaticOrder, true, F8_WIN_SH>(ring, g, S, E, F.wave0); }
    if constexpr (KIND == K_CMP_HID) {
        const int kv = (bx >> 5) & 1;
        if (bx < 64) { pg8::Gemm g{(const bf16_t*)(ws + (kv ? RA_VCR : RA_KCR)), 1024, 2048, 2048};
            pg8::StaticOrder S; S.init(32, 1, 32, bx & 31, (const bf16_t*)(ws + WS_WC1) + (size_t)(l * 2 + kv) * 256 * 2048);
            EpiCmpHid E{(bf16_t*)(ws + RA_CH) + (size_t)kv * 8192 * 256, (const float*)(ctl + CW_BIASP) + (l * 2 + kv) * 256};
            pg8::gemm_phase(ring, g, S, E, F.wave0); }
        else phase_vs_transpose(F, l); }
    if constexpr (KIND == K_CMP_OUT) { pg8::Gemm g{(const bf16_t*)(ws + RA_CH), 256, 256, 256}; pg8::DualOrder S; S.init(64, 1, F.G, bx, (const bf16_t*)(ws + WS_WC2) + (size_t)(l * 2) * 256 * 256); S.estride = (size_t)256 * 256;
        EpiCmpOut E{(bf16_t*)(ws + RA_KC), (bf16_t*)(ws + RA_VC)}; pg8::gemm_phase(ring, g, S, E, F.wave0); }
#if NAIVE_NSA
    if constexpr (KIND == K_NSA_ATT) { phase_nsa_naive(F); }
#else
    if constexpr (KIND == K_NSA_ATT) { phase_nsa_fast(F, l); }
#endif
    if constexpr (KIND == K_SWA_IN) { pg8::Gemm g{(const bf16_t*)(ws + WS_HB8), DM / 2, DM / 2, DM / 2}; pg8::StaticOrder S;
        if (l == 2) S.init(MTOK / 256, 5, F.G, bx, (const bf16_t*)(ws + WS_WQKV2)); else S.init(MTOK / 256, 4, F.G, bx, (const bf16_t*)(ws + WS_WQB1));
        EpiSwaIn E{ws, (const float*)(ws + WS_CS)}; pg8::gemm_phase<EpiSwaIn, pg8::StaticOrder, true, F8_WIN_SH>(ring, g, S, E, F.wave0); }
#if NAIVE_SWA
    if constexpr (KIND == K_SWA_ATT) { phase_swa_naive(F, (const float*)ARG_IN(10) + (l - 2) * 16); }
#else
    if constexpr (KIND == K_SWA_ATT) { phase_swa_fast(F, (const float*)ARG_IN(10) + (l - 2) * 16); }
#endif
    if constexpr (KIND == K_OUTPROJ) { pg8::Gemm g{(const bf16_t*)(ws + RA_ATT), DM / 2, DM / 2, DM / 2}; pg8::StaticOrder S;
        S.init(MTOK / 256, 4, F.G, bx, l < 2 ? (const bf16_t*)(ws + WS_WOUTA) + (size_t)l * DM * DM / 2 : (const bf16_t*)(ws + WS_WOUTB) + (size_t)(l - 2) * DM * DM / 2);
        EpiResid E{(const bf16_t*)(ws + WS_HB), (bf16_t*)(ws + WS_Y)}; pg8::gemm_phase<EpiResid, pg8::StaticOrder, true, F8_WIN_SH>(ring, g, S, E, F.wave0); }
    if constexpr (KIND == K_LN1) { phase_ln<0, false, false>(F, l * 2, nullptr, 0); }
    if constexpr (KIND == K_LN1R) { phase_ln<0, true, false>(F, l * 2, nullptr, l >> 1); }
    if constexpr (KIND == K_FFN1) { pg8::Gemm g{(const bf16_t*)(ws + WS_HB), DM, DM, DM}; pg8::StaticOrder S; S.init(MTOK / 256, 2 * DFF / 256, F.G, bx, (const bf16_t*)(ws + WS_WDIN) + (size_t)(l >> 1) * 2 * DFF * DM);
        EpiSwiglu E{(bf16_t*)(ws + WS_ACT), DFF}; pg8::gemm_phase(ring, g, S, E, F.wave0); }
    if constexpr (KIND == K_FFN2) { pg8::Gemm g{(const bf16_t*)(ws + WS_ACT), DFF, DFF, DFF}; pg8::StaticOrder S; S.init(MTOK / 256, 4, F.G, bx, (const bf16_t*)(ws + WS_WDOUT) + (size_t)(l >> 1) * DM * DFF);
        EpiResid E{(const bf16_t*)(ws + WS_HB), (bf16_t*)(ws + WS_Y)}; pg8::gemm_phase(ring, g, S, E, F.wave0); }
    if constexpr (KIND == K_LN2) { phase_ln<0, false, false>(F, l * 2 + 1, nullptr, 0); }
    if constexpr (KIND == K_SCATTER) { phase_moe_scatter(F, l >> 1); }
    if constexpr (KIND == K_MOE1) { const int ml = l >> 1; int ts[9]; moe_tiles((const unsigned*)ctl + CW_MOE + ml * 64, ts);
        pg8::Gemm g{(const bf16_t*)(ws + WS_XB), DM / 2, DM / 2, DM / 2}; pg8::GroupedOrder S; S.init(ts[8], 2 * DFFE / 256, F.G, bx, (const bf16_t*)(ws + WS_WMIN) + (size_t)ml * 8 * DFFE * DM);
        S.t1 = ts[1]; S.t2 = ts[2]; S.t3 = ts[3]; S.t4 = ts[4]; S.t5 = ts[5]; S.t6 = ts[6]; S.t7 = ts[7]; S.estride = (size_t)DFFE * DM;
        EpiSwiglu8 E{ws + WS_ACT, DFFE}; pg8::gemm_phase<EpiSwiglu8, pg8::GroupedOrder, true, F8_WIN_SH>(ring, g, S, E, F.wave0); }
    if constexpr (KIND == K_MOE2) { const int ml = l >> 1; int ts[9]; moe_tiles((const unsigned*)ctl + CW_MOE + ml * 64, ts);
        pg8::Gemm g{(const bf16_t*)(ws + WS_ACT), DFFE / 2, DFFE / 2, DFFE / 2}; pg8::GroupedOrder S; S.init(256, 4, F.G, bx, (const bf16_t*)(ws + WS_WMOUT) + (size_t)ml * 8 * DM * DFFE / 2);
        S.t1 = ts[1]; S.t2 = ts[2]; S.t3 = ts[3]; S.t4 = ts[4]; S.t5 = ts[5]; S.t6 = ts[6]; S.t7 = ts[7]; S.estride = (size_t)DM * DFFE / 2;
        EpiBf16Out E{(bf16_t*)(ws + WS_YB)}; pg8::gemm_phase<EpiBf16Out, pg8::GroupedOrder, true, F8_WOUT_SH>(ring, g, S, E, F.wave0);
        pg8::Gemm g4{(const bf16_t*)(ws + WS_ACT), DFFE / 2, DFFE / 4, DFFE / 2}; pg8::SliceOrder S4; S4.nsl = (ts[8] - 256) * 8; S4.G = F.G; S4.c = (bx + 128) & 255; S4.kq = DFFE / 4;
        S4.bt = (const bf16_t*)(ws + WS_WMOUT) + (size_t)ml * 8 * DM * DFFE / 2; S4.t1 = ts[1]; S4.t2 = ts[2]; S4.t3 = ts[3]; S4.t4 = ts[4]; S4.t5 = ts[5]; S4.t6 = ts[6]; S4.t7 = ts[7]; S4.estride = (size_t)DM * DFFE / 2;
        EpiPart E4{(float*)(ws + WS_H)}; pg8::gemm_phase<EpiPart, pg8::SliceOrder, true, F8_WOUT_SH>(ring, g4, S4, E4, F.wave0); }
    if constexpr (KIND == K_LN2C) { if (l == DEPTH - 1) phase_ln<1, false, true>(F, l * 2 + 1, ARG_OUT(), 0); else phase_ln<1, false, false>(F, l * 2 + 1, nullptr, 0); }
}

DEVI void frame_init(Frame& F, unsigned char* lds_raw) {
    F.lds = (LAS unsigned char*)lds_raw; F.ws = ARG_WS();
    F.wave0 = wave_id_sgpr(); F.tid = threadIdx.x; F.lane = F.tid & 63; F.wave = F.wave0;
    F.G = gridDim.x; { const int bx = blockIdx.x; F.vcu = (F.G % 8 == 0) ? (bx % 8) * (F.G / 8) + bx / 8 : bx; }
}

#if !MK_SINGLE
template <int KIND> __global__ void __launch_bounds__(NWAVES * 64, 2) phase_kernel(Args args) {
    extern __shared__ __attribute__((aligned(16))) unsigned char lds_raw[];
    Frame F; frame_init(F, lds_raw);
    do_phase<KIND>(F, args.ph_lo);
}
template <int KIND> static void launch_kind(const Args& a, hipStream_t stream) {
    static bool attr = false;
    if (!attr) { (void)hipFuncSetAttribute((const void*)phase_kernel<KIND>, hipFuncAttributeMaxDynamicSharedMemorySize, LDS_BYTES); attr = true; }
    hipLaunchKernelGGL(phase_kernel<KIND>, dim3(256), dim3(NWAVES * 64), LDS_BYTES, stream, a);
}
#else
__global__ void __launch_bounds__(NWAVES * 64, 2) yoco_fwd(Args args) {
    extern __shared__ __attribute__((aligned(16))) unsigned char lds_raw[];
    Frame F; frame_init(F, lds_raw);
    volatile LAS unsigned* MISC = (volatile LAS unsigned*)(F.lds + MISC_OFF);
    for (int u = F.tid; u < 256; u += NWAVES * 64) MISC[u] = 0u;
    __syncthreads();
    XcdBarrier bar = xcd_barrier_post((unsigned*)(F.ws + WS_CTL) + CW_BAR, MISC + 8);
#ifndef DUP_KIND
#define DUP_KIND -1
#endif
#define PH(K, L, FIRST) do { do_phase<K>(F, L); if (FIRST) cg::this_grid().sync(); else xcd_barrier(bar); if (K == DUP_KIND) { do_phase<K>(F, L); xcd_barrier(bar); } } while (0)
    PH(K_PRO, 0, true);
#define NSA_LAYER(l) PH(K_NSA_IN, l, false); PH(K_CMP_HID, l, false); PH(K_CMP_OUT, l, false); PH(K_NSA_ATT, l, false); PH(K_OUTPROJ, l, false)
#define SWA_LAYER(l) PH(K_SWA_IN, l, false); PH(K_SWA_ATT, l, false); PH(K_OUTPROJ, l, false)
#define DENSE_FFN(l) PH(K_LN1, l, false); PH(K_FFN1, l, false); PH(K_FFN2, l, false); PH(K_LN2, l, false)
#define MOE_FFN(l, LAST) PH(K_LN1R, l, false); PH(K_SCATTER, l, false); PH(K_MOE1, l, false); PH(K_MOE2, l, false); do_phase<K_LN2C>(F, l); if (!(LAST)) xcd_barrier(bar); else if (DUP_KIND == 16) { xcd_barrier(bar); do_phase<K_LN2C>(F, l); }
    NSA_LAYER(0); DENSE_FFN(0);
    NSA_LAYER(1); MOE_FFN(1, false);
    SWA_LAYER(2); DENSE_FFN(2);
    SWA_LAYER(3); MOE_FFN(3, true);
}
#endif

extern "C" void kernel_launch(void* const* d_in, const int* in_sizes, int n_in, void* d_out, int out_size, void* d_ws, size_t ws_size, hipStream_t stream) {
    static int grid = 0;
    if (grid == 0) {
        if (n_in != 18 || out_size != MTOK * DM || ws_size < WS_END) { fprintf(stderr, "kernel_launch: unexpected shapes (n_in %d out %d ws %zu need %zu)\n", n_in, out_size, ws_size, (size_t)WS_END); grid = -1; return; }
        int dev = 0, cus = 0;
        (void)hipGetDevice(&dev); (void)hipDeviceGetAttribute(&cus, hipDeviceAttributeMultiprocessorCount, dev);
        if (cus < 256) { fprintf(stderr, "kernel_launch: needs 256 CUs, device has %d\n", cus); grid = -1; return; }
#if MK_SINGLE
        int per_cu = 0;
        (void)hipFuncSetAttribute((const void*)yoco_fwd, hipFuncAttributeMaxDynamicSharedMemorySize, LDS_BYTES);
        (void)hipOccupancyMaxActiveBlocksPerMultiprocessor(&per_cu, (const void*)yoco_fwd, NWAVES * 64, LDS_BYTES);
        if (per_cu < 1) fprintf(stderr, "kernel_launch: occupancy query says %d blocks per CU\n", per_cu);
        (void)hipGetLastError();
#endif
        grid = 256;
    }
    if (grid < 0) return;
    (void)hipMemsetAsync((char*)d_ws + WS_CTL, 0, CTL_BYTES, stream);
    Args a{};
    for (int i = 0; i < 18; ++i) a.in[i] = d_in[i];
    a.out = (float*)d_out; a.ws = (unsigned char*)d_ws;
#if MK_SINGLE
    a.ph_lo = 0; a.ph_hi = NPH;
    void* kargs[] = {&a};
    hipError_t e = hipLaunchCooperativeKernel((const void*)yoco_fwd, dim3(grid), dim3(NWAVES * 64), kargs, LDS_BYTES, stream);
    if (e != hipSuccess) fprintf(stderr, "cooperative launch failed: %s (grid %d)\n", hipGetErrorString(e), grid);
#else
    for (int p = 0; p < NPH; ++p) {
        a.ph_lo = h_prog[p].layer; a.ph_hi = 0;
        switch (h_prog[p].kind) {
#define LK(K) case K: launch_kind<K>(a, stream); break;
            LK(K_PRO) LK(K_NSA_IN) LK(K_CMP_HID) LK(K_CMP_OUT) LK(K_NSA_ATT) LK(K_SWA_IN) LK(K_SWA_ATT) LK(K_OUTPROJ) LK(K_LN1) LK(K_LN1R) LK(K_FFN1) LK(K_FFN2) LK(K_LN2) LK(K_SCATTER) LK(K_MOE1) LK(K_MOE2) LK(K_LN2C)
#undef LK
            default: break;
        }
    }
#endif
}
```

```cpp
#include <hip/hip_runtime.h>
#include <hip/hip_cooperative_groups.h>
#include <cstdio>
#include <cstdint>
namespace cg = cooperative_groups;

#ifndef DBG_DROP
#define DBG_DROP 0
#endif
#ifndef NAIVE_NSA
#define NAIVE_NSA 0
#endif
#ifndef NAIVE_SWA
#define NAIVE_SWA 0
#endif
#if NAIVE_NSA || NAIVE_SWA
#error "the naive attention references write bf16 attention rows; the out-projection now reads e4m3"
#endif
#ifndef MK_SINGLE
#define MK_SINGLE 1
#endif

#define DEVI __device__ __forceinline__
#define LAS __attribute__((address_space(3)))
#define GAS __attribute__((address_space(1)))
typedef unsigned short bf16_t;
typedef short bf16x8 __attribute__((ext_vector_type(8)));
typedef float f32x4 __attribute__((ext_vector_type(4)));
typedef float f32x2 __attribute__((ext_vector_type(2)));
typedef unsigned u32x4 __attribute__((ext_vector_type(4)));
typedef unsigned u32x2 __attribute__((ext_vector_type(2)));

constexpr int BATCH = 2, SEQ = 16384, MTOK = BATCH * SEQ, DM = 1024, DEPTH = 4;
constexpr int HD = 64;
constexpr int A_G = 4, A_R = 4, A_IN = 2608, A_INP = 2816;
constexpr int NCMP = 1023, CMP_HID = 256;
constexpr int NSLC = SEQ / 64, NSEL = 16, NSA_WIN = 512;
constexpr int B_G = 2, B_R = 8, SWA_WIN = 128;
constexpr int DFF = 2816, NEXP = 8, DFFE = 3584;
constexpr int CAP = MTOK * 2 + NEXP * 256;
constexpr float ALPHA = 1.6817928305074292f;
constexpr float LN_EPS = 1e-5f;
constexpr float QSCALE = 0.125f;

constexpr size_t al256(size_t x) { return (x + 255) & ~(size_t)255; }
constexpr size_t WS_CTL = 0, CTL_BYTES = 1u << 20;
constexpr size_t WS_WINA = CTL_BYTES;
constexpr size_t WS_WOUTA = WS_WINA + (size_t)2 * A_INP * DM * 2;
constexpr size_t WS_WC1 = WS_WOUTA + (size_t)2 * DM * DM * 2;
constexpr size_t WS_WC2 = WS_WC1 + (size_t)4 * 256 * 2048 * 2;
constexpr size_t WS_WQKV2 = WS_WC2 + (size_t)4 * 256 * 256 * 2;
constexpr size_t WS_WQB1 = WS_WQKV2 + (size_t)1280 * DM * 2;
constexpr size_t WS_WOUTB = WS_WQB1 + (size_t)DM * DM * 2;
constexpr size_t WS_WDIN = WS_WOUTB + (size_t)2 * DM * DM * 2;
constexpr size_t WS_WDOUT = WS_WDIN + (size_t)2 * 2 * DFF * DM * 2;
constexpr size_t WS_WMIN = WS_WDOUT + (size_t)2 * DM * DFF * 2;
constexpr size_t WS_WMOUT = WS_WMIN + (size_t)16 * 2 * DFFE * DM * 2;
constexpr size_t WS_HB8 = WS_WMIN + (size_t)16 * 2 * DFFE * DM;
constexpr size_t WS_WEND = WS_WMOUT + (size_t)16 * DM * DFFE * 2;
constexpr size_t WS_H = al256(WS_WEND);
constexpr size_t WS_Y = WS_H + (size_t)MTOK * DM * 4;
constexpr size_t WS_HB = WS_Y + (size_t)MTOK * DM * 4;
constexpr size_t WS_CS = WS_HB + (size_t)MTOK * DM * 2;
constexpr size_t WS_KSH = WS_CS + (size_t)MTOK * 16 * 4;
constexpr size_t WS_VSH = WS_KSH + (size_t)MTOK * 128 * 2;
constexpr size_t WS_ROUTE = WS_VSH + (size_t)MTOK * 128 * 2;
constexpr size_t WS_XB = WS_ROUTE + (size_t)MTOK * 2 * 4 * 4;
constexpr size_t WS_ACT = WS_XB + (size_t)CAP * DM * 2;
constexpr size_t WS_RA = WS_ACT + (size_t)CAP * DFFE * 2;
constexpr size_t SLAB = (size_t)MTOK * 256 * 2;
constexpr size_t RA_Q = WS_RA;
constexpr size_t RA_ATT = RA_Q + (size_t)MTOK * DM * 2;
constexpr size_t RA_KCR = RA_ATT + (size_t)MTOK * DM * 2;
constexpr size_t RA_VCR = RA_KCR + SLAB + 4096;
constexpr size_t RA_KS = RA_VCR + SLAB + 4096;
constexpr size_t RA_VS = RA_KS + SLAB;
constexpr size_t RA_KW = RA_VS + SLAB;
constexpr size_t RA_VW = RA_KW + SLAB;
constexpr size_t RA_GATE = RA_VW + SLAB;
constexpr size_t RA_KC = RA_GATE + (size_t)MTOK * 48 * 4;
constexpr size_t RA_VC = RA_KC + (size_t)8192 * 64 * 2;
constexpr size_t RA_CH = RA_VC + (size_t)8192 * 64 * 2;
constexpr size_t RA_VST = RA_CH + (size_t)2 * 8192 * 256 * 2;
constexpr size_t RA_K8 = RA_VST + SLAB / 2;
constexpr size_t RA_END = RA_VST + SLAB;
constexpr size_t WS_YB = WS_RA;
constexpr size_t YB_END = WS_YB + (size_t)CAP * DM * 4;
constexpr size_t WS_END = (RA_END > YB_END ? RA_END : YB_END);
static_assert(WS_END < (size_t)1879048192, "workspace map exceeds 4x the largest tensor");

constexpr int CW_BAR = 4096;
constexpr int CW_MOE = 16384;
constexpr int CW_WGCNT = 45056;
constexpr int CW_KWMAX = 40128;
constexpr int CW_KMAX = 40064;
constexpr int CW_VMAX = 40000;
constexpr int CW_BIASP = 32768;

constexpr int RING_BYTES = 131072;
constexpr int LDS_X = RING_BYTES;
constexpr int MISC_OFF = RING_BYTES + 16384;
constexpr int LDS_BYTES = MISC_OFF + 1024;

DEVI unsigned f2bf(float f) { unsigned u = __builtin_bit_cast(unsigned, f); return (u + 0x7fffu + ((u >> 16) & 1u)) >> 16; }
DEVI unsigned pk2(float lo, float hi) { return f2bf(lo) | (f2bf(hi) << 16); }
DEVI float bf2f(unsigned h) { return __builtin_bit_cast(float, h << 16); }
DEVI float bflo(unsigned w) { return __builtin_bit_cast(float, w << 16); }
DEVI float bfhi(unsigned w) { return __builtin_bit_cast(float, w & 0xffff0000u); }
DEVI float clamp8(float x) { return __builtin_amdgcn_fmed3f(x, -448.f, 448.f); }
DEVI unsigned pack_fp8x4(float a, float b, float c, float d) {
    const int w = __builtin_amdgcn_cvt_pk_fp8_f32(clamp8(a), clamp8(b), 0, false);
    return (unsigned)__builtin_amdgcn_cvt_pk_fp8_f32(clamp8(c), clamp8(d), w, true);
}
DEVI float shx(float v, int mask, int lane) { return __builtin_bit_cast(float, __builtin_amdgcn_ds_bpermute((lane ^ mask) << 2, __builtin_bit_cast(int, v))); }
DEVI int shxi(int v, int mask, int lane) { return __builtin_amdgcn_ds_bpermute((lane ^ mask) << 2, v); }
DEVI float wave_sum(float v, int lane) {
#pragma unroll
    for (int o = 1; o < 64; o <<= 1) v += shx(v, o, lane);
    return v;
}
DEVI float wave_max(float v, int lane) {
#pragma unroll
    for (int o = 1; o < 64; o <<= 1) v = fmaxf(v, shx(v, o, lane));
    return v;
}
DEVI int wave_id_sgpr() { return __builtin_amdgcn_readfirstlane((int)threadIdx.x >> 6); }
DEVI int opaque_tid(int wave) { asm volatile("" : "+s"(wave)); int l; asm volatile("v_mbcnt_lo_u32_b32 %0, -1, 0\n\tv_mbcnt_hi_u32_b32 %0, -1, %0" : "=v"(l)); return wave * 64 + l; }
#define LDS_WAIT() asm volatile("s_waitcnt lgkmcnt(0)" ::: "memory")
#define VM_WAIT() asm volatile("s_waitcnt vmcnt(0)" ::: "memory")

namespace pg8 {
constexpr int BM = 256, BK = 64, HALF = 128, HTB = HALF * BK * 2, STAGE_BYTES = 8 * HTB, NXCD = 8, WGM = 8;
DEVI int lds_byte(int r, int c) { const int st = (r >> 4) * 2 + (c >> 5), rr = r & 15, cc = c & 31, ob = rr * 64 + cc * 2; return st * 1024 + (ob ^ (((ob >> 9) & 1) << 5)); }
DEVI void stage_rc(int b, int& R, int& C) { const int st = b / 1024, sb = b % 1024, swz = sb ^ (((sb >> 9) & 1) << 5); R = (st >> 1) * 16 + swz / 64; C = (st & 1) * 32 + (swz % 64) / 2; }
DEVI int perm32(int rho) { const int n = rho >> 4, i = rho & 15; return 8 * (i >> 2) + 4 * n + (i & 3); }

struct Unit { int pm, pn; const bf16_t* bt; int koff, z; };
struct Gemm { const bf16_t* A; int lda; int K; int ldb; };

struct StaticOrder {
    int nM, nN, nwg, G, c; const bf16_t* bt;
    DEVI void init(int nM_, int nN_, int G_, int c_, const bf16_t* bt_) { nM = nM_; nN = nN_; nwg = nM * nN; G = G_; c = c_; bt = bt_; }
    DEVI bool tile(int i, int& pm, int& pn) const {
        const long L = (long)i * G + c; if (L >= nwg) return false;
        int wgid = (int)L; { const int q = nwg / NXCD, r = nwg % NXCD, xcd = wgid % NXCD, off = wgid / NXCD; wgid = (xcd < r ? xcd * (q + 1) : r * (q + 1) + (xcd - r) * q) + off; }
        const int nig = WGM * nN, gid = wgid / nig, fm = gid * WGM, gsz = (nM - fm) < WGM ? (nM - fm) : WGM;
        pm = fm + ((wgid % nig) % gsz); pn = (wgid % nig) / gsz; return true;
    }
    DEVI bool next(int i, Unit& u) const { if (!tile(i, u.pm, u.pn)) return false; u.bt = bt; u.koff = 0; u.z = 0; return true; }
};
struct GroupedOrder : StaticOrder {
    int t1, t2, t3, t4, t5, t6, t7; size_t estride;
    DEVI bool next(int i, Unit& u) const {
        if (!tile(i, u.pm, u.pn)) return false;
        const int tm = u.pm; const int e = (tm >= t1) + (tm >= t2) + (tm >= t3) + (tm >= t4) + (tm >= t5) + (tm >= t6) + (tm >= t7);
        u.bt = bt + (size_t)e * estride; u.koff = 0; u.z = 0; return true;
    }
};
struct SliceOrder {
    int nsl, G, c, kq; const bf16_t* bt; int t1, t2, t3, t4, t5, t6, t7; size_t estride;
    DEVI bool next(int i, Unit& u) const {
        const int L = i * G + c; if (L >= nsl) return false;
        u.pm = 256 + (L >> 3); u.pn = (L & 7) >> 1; u.z = L & 1; u.koff = u.z * kq;
        const int tm = u.pm; const int e = (tm >= t1) + (tm >= t2) + (tm >= t3) + (tm >= t4) + (tm >= t5) + (tm >= t6) + (tm >= t7);
        u.bt = bt + (size_t)e * estride; return true;
    }
};
struct DualOrder : StaticOrder {
    size_t estride;
    DEVI bool next(int i, Unit& u) const { if (!tile(i, u.pm, u.pn)) return false; u.bt = bt + (u.pm >= nM / 2 ? estride : 0); u.koff = 0; u.z = 0; return true; }
};

DEVI unsigned cvt_pk_bf16(float lo, float hi) { typedef __bf16 bf16x2_t __attribute__((ext_vector_type(2))); f32x2 v = {lo, hi}; bf16x2_t b = __builtin_convertvector(v, bf16x2_t); return __builtin_bit_cast(unsigned, b); }

typedef int v4i_t __attribute__((ext_vector_type(4)));
typedef int v8i_t __attribute__((ext_vector_type(8)));
template <int F8SH> DEVI void mma_block(f32x4 (&acc)[4][2], const bf16x8 (&At)[4][2], const bf16x8 (&Bt)[2][2]) {
    if constexpr (F8SH < 0) {
#pragma unroll
        for (int m = 0; m < 4; ++m)
#pragma unroll
            for (int n = 0; n < 2; ++n)
#pragma unroll
                for (int k = 0; k < 2; ++k) acc[m][n] = __builtin_amdgcn_mfma_f32_16x16x32_bf16(Bt[n][k], At[m][k], acc[m][n], 0, 0, 0);
    } else {
#pragma unroll
        for (int m = 0; m < 4; ++m)
#pragma unroll
            for (int n = 0; n < 2; ++n) {
                const v8i_t a8 = __builtin_shufflevector(__builtin_bit_cast(v4i_t, At[m][0]), __builtin_bit_cast(v4i_t, At[m][1]), 0, 1, 2, 3, 4, 5, 6, 7);
                const v8i_t b8 = __builtin_shufflevector(__builtin_bit_cast(v4i_t, Bt[n][0]), __builtin_bit_cast(v4i_t, Bt[n][1]), 0, 1, 2, 3, 4, 5, 6, 7);
                asm volatile("v_mfma_f32_16x16x128_f8f6f4 %0, %1, %2, %0" : "+v"(acc[m][n]) : "v"(b8), "v"(a8)); }
    }
}
template <class Epi, class Sched, bool ALIGN_EPI = true, int F8SH = -1>
DEVI void gemm_phase(LAS unsigned char* lds, const Gemm g, const Sched& S, const Epi& E, int wave0) {
    const int tid = opaque_tid(wave0), wid = __builtin_amdgcn_readfirstlane(tid >> 6), lane = tid & 63, wr = wid >> 2, wc = wid & 3, fr = lane & 15, fq = lane >> 4;
    const int K = g.K, nt = K / BK, lda = g.lda, ldb = g.ldb;
    unsigned voffA[2], voffB[2];
#pragma unroll
    for (int i = 0; i < 2; ++i) { int R, C; stage_rc(tid * 16 + i * 8192, R, C); const int Rb = Epi::PERM ? ((R & ~31) + perm32(R & 31)) : R;
        voffA[i] = (unsigned)(R * lda + C) * 2u; voffB[i] = (unsigned)(Rb * ldb + C) * 2u; }
    const size_t kstep = (size_t)(BK * 2);
    const size_t hstepA = (size_t)HALF * lda * 2, tstepA = 2 * hstepA;
    const size_t hstepB = (size_t)HALF * ldb * 2, tstepB = 2 * hstepB;
    const unsigned ldsw = (unsigned)wid * 1024u;
    const int aoff = lds_byte(wr * 64 + fr, fq * 8), boff = lds_byte(wc * 32 + fr, fq * 8);
#define PG8_SA(b, h) (((b) * 2 + (h)) * HTB)
#define PG8_SB(b, h) ((4 + (b) * 2 + (h)) * HTB)
#define PG8_STAGE(bufoff, gbase, voff) do { _Pragma("unroll") for (int _i = 0; _i < 2; ++_i) \
        __builtin_amdgcn_global_load_lds((const unsigned*)((const char*)(gbase) + (voff)[_i]), (LAS unsigned*)(lds + (bufoff) + ldsw + _i * 8192), 16, 0, 0); } while (0)
#define PG8_LDA(dst, b, h) do { _Pragma("unroll") for (int m = 0; m < 4; ++m) _Pragma("unroll") for (int k = 0; k < 2; ++k) dst[m][k] = *(const LAS bf16x8*)(lds + PG8_SA(b, h) + aoff + m * 2048 + k * 1024); } while (0)
#define PG8_LDB(dst, b, h) do { _Pragma("unroll") for (int n = 0; n < 2; ++n) _Pragma("unroll") for (int k = 0; k < 2; ++k) dst[n][k] = *(const LAS bf16x8*)(lds + PG8_SB(b, h) + boff + n * 2048 + k * 1024); } while (0)
#define PG8_MMA(ai, bj, At, Bt) do { __builtin_amdgcn_s_setprio(1); mma_block<F8SH>(acc[ai][bj], At, Bt); __builtin_amdgcn_s_setprio(0); } while (0)
#define PG8_WAIT_V(n) asm volatile("s_waitcnt vmcnt(" #n ")" ::: "memory")
#define PG8_WAIT_L(n) asm volatile("s_waitcnt lgkmcnt(" #n ")" ::: "memory")
#define PG8_BAR __builtin_amdgcn_s_barrier()
#define PG8_SCHED __builtin_amdgcn_sched_barrier(0)
    Unit cur, nxt; int ui = 0;
    if (!S.next(0, cur)) return;
    f32x4 acc[2][2][4][2];
#pragma unroll
    for (int a = 0; a < 2; ++a)
#pragma unroll
        for (int b = 0; b < 2; ++b)
#pragma unroll
            for (int m = 0; m < 4; ++m)
#pragma unroll
                for (int n = 0; n < 2; ++n) acc[a][b][m][n] = (f32x4){0.f, 0.f, 0.f, 0.f};
    bf16x8 At[4][2], B0[2][2], B1[2][2];
    const char* cA = (const char*)g.A + (size_t)cur.pm * tstepA + (size_t)cur.koff * 2; const char* cB = (const char*)cur.bt + (size_t)cur.pn * tstepB + (size_t)cur.koff * 2;
    PG8_STAGE(PG8_SB(0, 0), cB, voffB); PG8_STAGE(PG8_SB(0, 1), cB + hstepB, voffB); PG8_STAGE(PG8_SA(0, 0), cA, voffA); PG8_STAGE(PG8_SA(0, 1), cA + hstepA, voffA);
    if (wr == 1) PG8_BAR;
    PG8_WAIT_V(2); PG8_BAR;
    PG8_STAGE(PG8_SB(1, 0), cB + kstep, voffB); PG8_STAGE(PG8_SA(1, 0), cA + kstep, voffA); PG8_STAGE(PG8_SB(1, 1), cB + hstepB + kstep, voffB);
    PG8_WAIT_V(6); PG8_BAR;
    for (;;) {
        const bool has_next = S.next(ui + 1, nxt);
        const char* nA = has_next ? (const char*)g.A + (size_t)nxt.pm * tstepA + (size_t)nxt.koff * 2 : cA; const char* nB = has_next ? (const char*)nxt.bt + (size_t)nxt.pn * tstepB + (size_t)nxt.koff * 2 : cB;
#pragma unroll 1
        for (int t = 0; t < nt; t += 2) {
            const bool last = (t == nt - 2);
            const char* a1 = cA + (size_t)(t + 1) * kstep;
            const char* a2 = last ? nA : cA + (size_t)(t + 2) * kstep; const char* b2 = last ? nB : cB + (size_t)(t + 2) * kstep;
            const char* a3 = a2 + kstep; const char* b3 = b2 + kstep;
            PG8_LDB(B0, 0, 0); PG8_LDB(B1, 0, 1); PG8_SCHED; PG8_LDA(At, 0, 0); PG8_STAGE(PG8_SA(1, 1), a1 + hstepA, voffA);
            PG8_WAIT_V(8); PG8_WAIT_L(0); PG8_BAR; PG8_MMA(0, 0, At, B0); PG8_MMA(0, 1, At, B1); PG8_BAR; PG8_SCHED;
            PG8_LDA(At, 0, 1); PG8_STAGE(PG8_SB(0, 0), b2, voffB); PG8_STAGE(PG8_SB(0, 1), b2 + hstepB, voffB); PG8_STAGE(PG8_SA(0, 0), a2, voffA);
            PG8_WAIT_V(8); PG8_WAIT_L(0); PG8_BAR; PG8_MMA(1, 0, At, B0); PG8_MMA(1, 1, At, B1); PG8_BAR; PG8_SCHED;
            PG8_LDB(B0, 1, 0); PG8_LDB(B1, 1, 1); PG8_SCHED; PG8_LDA(At, 1, 0); PG8_STAGE(PG8_SA(0, 1), a2 + hstepA, voffA);
            PG8_WAIT_V(8); PG8_WAIT_L(0); PG8_BAR; PG8_MMA(0, 0, At, B0); PG8_MMA(0, 1, At, B1); PG8_BAR; PG8_SCHED;
            PG8_LDA(At, 1, 1); PG8_STAGE(PG8_SB(1, 0), b3, voffB); PG8_STAGE(PG8_SB(1, 1), b3 + hstepB, voffB); PG8_STAGE(PG8_SA(1, 0), a3, voffA);
            PG8_WAIT_V(8); PG8_WAIT_L(0); PG8_BAR; PG8_MMA(1, 0, At, B0); PG8_MMA(1, 1, At, B1); PG8_BAR; PG8_SCHED;
        }
        if constexpr (F8SH >= 0) { asm volatile("s_nop 15\n\ts_nop 15" ::: "memory"); PG8_SCHED; }
        if constexpr (F8SH >= 0) {
#pragma unroll
            for (int a = 0; a < 2; ++a)
#pragma unroll
                for (int b = 0; b < 2; ++b)
#pragma unroll
                    for (int m = 0; m < 4; ++m)
#pragma unroll
                        for (int n = 0; n < 2; ++n) acc[a][b][m][n] = acc[a][b][m][n] * (1.f / (float)(1 << F8SH));
        }
        if constexpr (ALIGN_EPI) { if (wr == 0) PG8_BAR; }
        E(acc, cur, wr, wc, fr, fq);
        if (!has_next) break;
#pragma unroll
        for (int a = 0; a < 2; ++a)
#pragma unroll
            for (int b = 0; b < 2; ++b)
#pragma unroll
                for (int m = 0; m < 4; ++m)
#pragma unroll
                    for (int n = 0; n < 2; ++n) acc[a][b][m][n] = (f32x4){0.f, 0.f, 0.f, 0.f};
        cur = nxt; cA = nA; cB = nB; ++ui;
        if constexpr (ALIGN_EPI) { if (wr == 1) PG8_BAR; }
    }
    PG8_WAIT_V(0);
    if constexpr (!ALIGN_EPI) { if (wr == 0) PG8_BAR; }
    PG8_BAR;
#undef PG8_SA
#undef PG8_SB
#undef PG8_STAGE
#undef PG8_LDA
#undef PG8_LDB
#undef PG8_MMA
#undef PG8_WAIT_V
#undef PG8_WAIT_L
#undef PG8_BAR
#undef PG8_SCHED
}
}

#define XB_TMO      128
#define XB_XCNT(j)  (256  + 64 * (j))
#define XB_XSUB(j)  (1280 + 64 * (j))
#define XB_XGEN(j)  (2304 + 64 * (j))
#define XB_TOP      3328
#define XB_TOPGEN   3392
#define XCD_BAR_WORDS 3456
#define XB_SPIN_CAP (1u << 22)
DEVI unsigned xb_ld(unsigned* p)              { return __hip_atomic_load(p, __ATOMIC_RELAXED, __HIP_MEMORY_SCOPE_AGENT); }
DEVI unsigned xb_add(unsigned* p, unsigned v) { return __hip_atomic_fetch_add(p, v, __ATOMIC_RELAXED, __HIP_MEMORY_SCOPE_AGENT); }
DEVI unsigned xb_xcc_id() { return (unsigned)__builtin_amdgcn_s_getreg((3 << 11) | 20) & 0xFu; }
#define XB_SPIN(cond, bar) do { unsigned _sp = 0; while (cond) { __builtin_amdgcn_s_sleep(1); \
    if ((++_sp & 255u) == 0u) { if (xb_ld(&(bar)[XB_TMO])) break; if (_sp > XB_SPIN_CAP) { atomicAdd(&(bar)[XB_TMO], 1u); break; } } } } while (0)
struct XcdBarrier { unsigned* bar; unsigned x; volatile LAS unsigned* st; };
DEVI XcdBarrier xcd_barrier_post(unsigned* bar, volatile LAS unsigned* st) {
    XcdBarrier b; b.bar = bar; b.x = xb_xcc_id(); b.st = st;
    if (threadIdx.x == 0) (void)xb_add(&bar[XB_XCNT(b.x)], 1u);
    return b;
}
DEVI void xcd_barrier_complete(unsigned* bar, unsigned x, unsigned& nloc, unsigned& nx) {
    const unsigned G = gridDim.x * gridDim.y * gridDim.z;
    unsigned sum, cnt, mine, sp = 0u;
    for (;;) {
        sum = 0u; cnt = 0u; mine = 0u;
#pragma unroll
        for (unsigned j = 0; j < 16; ++j) { const unsigned c = xb_ld(&bar[XB_XCNT(j)]); sum += c; cnt += (c > 0u) ? 1u : 0u; mine = (j == x) ? c : mine; }
        if (sum == G) break;
        __builtin_amdgcn_s_sleep(1);
        if ((++sp & 255u) == 0u) { if (xb_ld(&bar[XB_TMO])) break; if (sp > XB_SPIN_CAP) { atomicAdd(&bar[XB_TMO], 1u); break; } }
    }
    nloc = mine > 0u ? mine : 1u; nx = cnt > 0u ? cnt : 1u;
}
DEVI void xcd_barrier(const XcdBarrier& b) {
    asm volatile("s_waitcnt vmcnt(0)" ::: "memory");
    __syncthreads();
    if (threadIdx.x == 0) {
        unsigned* bar = b.bar;
        __builtin_amdgcn_s_waitcnt(0);
        unsigned nloc = b.st[0], nx = b.st[1];
        if (nloc == 0u) { xcd_barrier_complete(bar, b.x, nloc, nx); b.st[0] = nloc; b.st[1] = nx; }
        const unsigned old = xb_add(&bar[XB_XSUB(b.x)], 1u);
        const unsigned gen = old / nloc;
        if (old + 1u == (gen + 1u) * nloc) {
            __builtin_amdgcn_fence(__ATOMIC_RELEASE, "agent");
            asm volatile("s_waitcnt vmcnt(0)" ::: "memory");
            const unsigned og = xb_add(&bar[XB_TOP], 1u);
            const unsigned tg = og / nx;
            if (og + 1u == (tg + 1u) * nx) xb_add(&bar[XB_TOPGEN], 1u);
            else XB_SPIN(xb_ld(&bar[XB_TOPGEN]) == tg, bar);
            __builtin_amdgcn_fence(__ATOMIC_ACQUIRE, "agent");
            xb_add(&bar[XB_XGEN(b.x)], 1u);
            asm volatile("s_waitcnt vmcnt(0)" ::: "memory");
        } else {
            XB_SPIN(xb_ld(&bar[XB_XGEN(b.x)]) == gen, bar);
            __builtin_amdgcn_fence(__ATOMIC_ACQUIRE, "agent");
            asm volatile("s_waitcnt vmcnt(0)" ::: "memory");
        }
    }
    __syncthreads();
}

typedef const void* cvp_t;
DEVI const void* karg_ptr(int byte_off) { asm volatile("" : "+s"(byte_off)); const __attribute__((address_space(4))) char* kp = (const __attribute__((address_space(4))) char*)__builtin_amdgcn_kernarg_segment_ptr(); return *(const __attribute__((address_space(4))) cvp_t*)(kp + byte_off); }
#define ARG_IN(i) karg_ptr((i) * 8)
#define ARG_OUT() ((float*)karg_ptr(18 * 8))
#define ARG_WS() ((unsigned char*)karg_ptr(19 * 8))
struct Frame {
    LAS unsigned char* lds;
    unsigned char* ws;
    int tid, lane, wave, G, vcu, wave0;
    DEVI void refresh() { tid = opaque_tid(wave0); lane = tid & 63; wave = __builtin_amdgcn_readfirstlane(tid >> 6); }
};
constexpr int NWAVES = 8;
constexpr int F8_WIN_SH = 5, F8_WOUT_SH = 6;
constexpr float F8_WIN_MUL = 32.f, F8_WOUT_MUL = 64.f;

DEVI void transpose_item(const float* W, int K, int N, bf16_t* WT, int k0, int n0, int drow0, LAS float* scr, int lane, float f8mul) {
    const int nc = n0 + 4 * (lane & 7); const bool ok = nc < N;
#pragma unroll
    for (int i = 0; i < 8; ++i) { const int kk = 8 * i + (lane >> 3); const f32x4 v = ok ? *(const f32x4*)(W + (size_t)(k0 + kk) * N + nc) : (f32x4){0.f, 0.f, 0.f, 0.f};
        LAS float* d = scr + kk * 33 + 4 * (lane & 7); d[0] = v[0]; d[1] = v[1]; d[2] = v[2]; d[3] = v[3]; }
    LDS_WAIT(); asm volatile("" ::: "memory");
    const int c = lane & 7;
#pragma unroll
    for (int j = 0; j < 4; ++j) { const int n = (lane >> 3) + 8 * j; const LAS float* s = scr + (8 * c) * 33 + n;
        if (f8mul > 0.f) { u32x2 o8; o8[0] = pack_fp8x4(s[0 * 33] * f8mul, s[1 * 33] * f8mul, s[2 * 33] * f8mul, s[3 * 33] * f8mul); o8[1] = pack_fp8x4(s[4 * 33] * f8mul, s[5 * 33] * f8mul, s[6 * 33] * f8mul, s[7 * 33] * f8mul);
            *(u32x2*)((unsigned char*)WT + (size_t)(drow0 + n) * K + k0 + 8 * c) = o8; continue; }
        u32x4 o; o.x = pk2(s[0 * 33], s[1 * 33]); o.y = pk2(s[2 * 33], s[3 * 33]); o.z = pk2(s[4 * 33], s[5 * 33]); o.w = pk2(s[6 * 33], s[7 * 33]);
        *(u32x4*)(WT + (size_t)(drow0 + n) * K + k0 + 8 * c) = o; }
    LDS_WAIT(); asm volatile("" ::: "memory");
}
struct WFam { const float* src; size_t sstride; bf16_t* dst; size_t dstride; int count, K, N, Npad, mode; float f8mul; };
DEVI bool wfam_do(const WFam& f, int& it, LAS float* scr, int lane) {
    const int nkb = f.K / 64, nnb = f.Npad / 32, per = nkb * nnb, tot = per * f.count;
    if (it >= tot) { it -= tot; return false; }
    const int mi = it / per, r = it % per, kb = r / nnb, nb = r % nnb, n0 = nb * 32;
    int drow0 = n0;
    if (f.mode == 1) { const int F = f.N / 2; const int o = n0 < F ? n0 : n0 - F; drow0 = 256 * (o / 128) + (o % 128) + (n0 < F ? 0 : 128); }
    transpose_item(f.src + (size_t)mi * f.sstride, f.K, f.N, f.dst + (size_t)mi * f.dstride, kb * 64, n0, drow0, scr, lane, f.f8mul);
    return true;
}

DEVI void phase_prologue(Frame& F) {
    F.refresh();
    LAS float* scr = (LAS float*)(F.lds + F.wave * 16384);
    const int gw = F.vcu * NWAVES + F.wave, NGW = F.G * NWAVES;
    unsigned char* ws = F.ws;
    const WFam fam[11] = {
        {(const float*)ARG_IN(2), (size_t)DM * A_IN, (bf16_t*)(ws + WS_WINA), (size_t)A_INP * DM / 2, 2, DM, A_IN, A_INP, 0, F8_WIN_MUL},
        {(const float*)ARG_IN(3), (size_t)DM * DM, (bf16_t*)(ws + WS_WOUTA), (size_t)DM * DM / 2, 2, DM, DM, DM, 0, F8_WIN_MUL},
        {(const float*)ARG_IN(5), (size_t)2048 * 256, (bf16_t*)(ws + WS_WC1), (size_t)256 * 2048, 4, 2048, 256, 256, 0, 0.f},
        {(const float*)ARG_IN(6), (size_t)256 * 64, (bf16_t*)(ws + WS_WC2), (size_t)256 * 256, 4, 256, 64, 256, 0, 0.f},
        {(const float*)ARG_IN(8), (size_t)DM * DM, (bf16_t*)(ws + WS_WQKV2), 0, 1, DM, DM, DM, 0, F8_WIN_MUL},
        {(const float*)ARG_IN(7), 0, (bf16_t*)(ws + WS_WQKV2) + (size_t)DM * DM / 2, 0, 1, DM, 256, 256, 0, F8_WIN_MUL},
        {(const float*)ARG_IN(8) + (size_t)DM * DM, 0, (bf16_t*)(ws + WS_WQB1), 0, 1, DM, DM, DM, 0, F8_WIN_MUL},
        {(const float*)ARG_IN(9), (size_t)DM * DM, (bf16_t*)(ws + WS_WOUTB), (size_t)DM * DM / 2, 2, DM, DM, DM, 0, F8_WIN_MUL},
        {(const float*)ARG_IN(13), (size_t)DM * 2 * DFF, (bf16_t*)(ws + WS_WDIN), (size_t)2 * DFF * DM, 2, DM, 2 * DFF, 2 * DFF, 1, 0.f},
        {(const float*)ARG_IN(14), (size_t)DFF * DM, (bf16_t*)(ws + WS_WDOUT), (size_t)DM * DFF, 2, DFF, DM, DM, 0, 0.f},
        {(const float*)ARG_IN(16), (size_t)DM * 2 * DFFE, (bf16_t*)(ws + WS_WMIN), (size_t)DFFE * DM, 16, DM, 2 * DFFE, 2 * DFFE, 1, F8_WIN_MUL},
    };
    const WFam famo = {(const float*)ARG_IN(17), (size_t)DFFE * DM, (bf16_t*)(ws + WS_WMOUT), (size_t)DM * DFFE / 2, 16, DFFE, DM, DM, 0, F8_WOUT_MUL};
    int total = 0;
#pragma unroll
    for (int i = 0; i < 11; ++i) total += (fam[i].K / 64) * (fam[i].Npad / 32) * fam[i].count;
    total += (famo.K / 64) * (famo.Npad / 32) * famo.count;
    for (int it0 = gw; it0 < total; it0 += NGW) {
        int it = it0; bool done = false;
#pragma unroll
        for (int i = 0; i < 11; ++i) if (!done) done = wfam_do(fam[i], it, scr, F.lane);
        if (!done) wfam_do(famo, it, scr, F.lane);
    }
    { const float* x = (const float*)ARG_IN(0); bf16_t* hb = (bf16_t*)(ws + WS_HB);
      const size_t n8 = (size_t)MTOK * DM / 8;
      for (size_t i = (size_t)blockIdx.x * 512 + F.tid; i < n8; i += (size_t)F.G * 512) {
          const f32x4 v0 = *(const f32x4*)(x + i * 8), v1 = *(const f32x4*)(x + i * 8 + 4);
          u32x4 o; o.x = pk2(v0.x, v0.y); o.y = pk2(v0.z, v0.w); o.z = pk2(v1.x, v1.y); o.w = pk2(v1.z, v1.w);
          *(u32x4*)(hb + i * 8) = o;
          u32x2 o8; o8[0] = pack_fp8x4(v0.x, v0.y, v0.z, v0.w); o8[1] = pack_fp8x4(v1.x, v1.y, v1.z, v1.w); *(u32x2*)(ws + WS_HB8 + i * 8) = o8; } }
    { const int* pos = (const int*)ARG_IN(1); float* cs = (float*)(ws + WS_CS);
      for (int i = blockIdx.x * 512 + F.tid; i < MTOK * 8; i += F.G * 512) {
          const int tok = i >> 3, j = i & 7;
          const float invf = (float)exp2(-(double)j * (18.931568569324174 / 8.0));
          const double ang = (double)((float)pos[tok] * invf);
          const double n = rint(ang * 0.15915494309189535); const double r = ang - n * 6.283185307179586476925;
          const float rf = (float)r;
          cs[tok * 16 + j] = cosf(rf); cs[tok * 16 + 8 + j] = sinf(rf); } }
    { const float* cp = (const float*)ARG_IN(4); const float* w1 = (const float*)ARG_IN(5); float* bp = (float*)((unsigned*)(ws + WS_CTL) + CW_BIASP);
      if (gw < 1024) { const int mi = gw >> 8, c = gw & 255; float s = 0.f;
#pragma unroll 8
          for (int i = 0; i < 32; ++i) { const int f = i * 64 + F.lane; s += cp[(size_t)mi * 2048 + f] * w1[((size_t)mi * 2048 + f) * 256 + c]; }
          s = wave_sum(s, F.lane);
          if (F.lane == 0) bp[gw] = s; } }
}

typedef f32x4 AccT[2][2][4][2];

DEVI u32x4 pack8(const f32x4 a, const f32x4 b) { u32x4 w; w.x = pg8::cvt_pk_bf16(a[0], a[1]); w.y = pg8::cvt_pk_bf16(a[2], a[3]); w.z = pg8::cvt_pk_bf16(b[0], b[1]); w.w = pg8::cvt_pk_bf16(b[2], b[3]); return w; }
DEVI void rope8(f32x4& v0, f32x4& v1, int dhead, const float* csrow, int lane) {
    f32x4 p0, p1;
#pragma unroll
    for (int i = 0; i < 4; ++i) { p0[i] = shx(v0[i], 16, lane); p1[i] = shx(v1[i], 16, lane); }
    if (dhead < 16) {
        const f32x4 c0 = *(const f32x4*)(csrow), c1 = *(const f32x4*)(csrow + 4), s0 = *(const f32x4*)(csrow + 8), s1 = *(const f32x4*)(csrow + 12);
        if (dhead == 0) { v0 = v0 * c0 - p0 * s0; v1 = v1 * c1 - p1 * s1; }
        else            { v0 = v0 * c0 + p0 * s0; v1 = v1 * c1 + p1 * s1; }
    }
}

struct EpiNsaIn {
    static constexpr bool PERM = true;
    unsigned char* ws; const float* cs;
    DEVI void operator()(const AccT& acc, const pg8::Unit& u, int wr, int wc, int fr, int fq) const {
        const int pn = u.pn;
        if (pn < 4) {
            bf16_t* Q = (bf16_t*)(ws + RA_Q);
#pragma unroll
            for (int ai = 0; ai < 2; ++ai)
#pragma unroll
                for (int m = 0; m < 4; ++m) { const int row = u.pm * 256 + ai * 128 + wr * 64 + m * 16 + fr;
#pragma unroll
                    for (int bj = 0; bj < 2; ++bj) *(u32x4*)(Q + (size_t)row * DM + pn * 256 + bj * 128 + wc * 32 + fq * 8) = pack8(acc[ai][bj][m][0], acc[ai][bj][m][1]); }
        } else if (pn < 10) {
            const size_t base = pn == 4 ? RA_KCR : pn == 5 ? RA_VCR : pn == 6 ? RA_KS : pn == 7 ? RA_VS : pn == 8 ? RA_KW : RA_VW;
            bf16_t* T = (bf16_t*)(ws + base);
            const bool rot = (pn == 6 || pn == 8);
            const int dh = (wc & 1) * 32 + fq * 8;
#pragma unroll
            for (int ai = 0; ai < 2; ++ai)
#pragma unroll
                for (int m = 0; m < 4; ++m) { const int row = u.pm * 256 + ai * 128 + wr * 64 + m * 16 + fr; const int b = row / SEQ, t = row % SEQ;
#pragma unroll
                    for (int bj = 0; bj < 2; ++bj) { f32x4 v0 = acc[ai][bj][m][0], v1 = acc[ai][bj][m][1];
                        if (rot) rope8(v0, v1, dh, cs + (size_t)row * 16, fq * 16 + fr);
                        const int g = bj * 2 + (wc >> 1);
                        *(u32x4*)(T + ((size_t)(b * A_G + g) * SEQ + t) * HD + dh) = pack8(v0, v1); } }
        } else {
            float* G = (float*)(ws + RA_GATE);
            if (wc < 2) {
#pragma unroll
                for (int ai = 0; ai < 2; ++ai)
#pragma unroll
                    for (int m = 0; m < 4; ++m) { const int row = u.pm * 256 + ai * 128 + wr * 64 + m * 16 + fr;
#pragma unroll
                        for (int n = 0; n < 2; ++n) { const int c = wc * 32 + fq * 8 + n * 4;
                            if (c < 48) { f32x4 v = acc[ai][0][m][n]; f32x4 o;
#pragma unroll
                                for (int i = 0; i < 4; ++i) o[i] = 1.f / (1.f + __expf(-v[i]));
                                *(f32x4*)(G + (size_t)row * 48 + c) = o; } } }
            }
        }
    }
};
struct EpiSwaIn {
    static constexpr bool PERM = true;
    unsigned char* ws; const float* cs;
    DEVI void operator()(const AccT& acc, const pg8::Unit& u, int wr, int wc, int fr, int fq) const {
        const int pn = u.pn; const int dh = (wc & 1) * 32 + fq * 8;
        bf16_t* Q = (bf16_t*)(ws + RA_Q); bf16_t* KS = (bf16_t*)(ws + WS_KSH); bf16_t* VS = (bf16_t*)(ws + WS_VSH);
#pragma unroll
        for (int ai = 0; ai < 2; ++ai)
#pragma unroll
            for (int m = 0; m < 4; ++m) { const int row = u.pm * 256 + ai * 128 + wr * 64 + m * 16 + fr; const int b = row / SEQ, t = row % SEQ;
#pragma unroll
                for (int bj = 0; bj < 2; ++bj) { f32x4 v0 = acc[ai][bj][m][0], v1 = acc[ai][bj][m][1];
                    const bool rot = (pn < 4) || (bj == 0);
                    if (rot) rope8(v0, v1, dh, cs + (size_t)row * 16, fq * 16 + fr);
                    const u32x4 w = pack8(v0, v1);
                    if (pn < 4) *(u32x4*)(Q + (size_t)row * DM + pn * 256 + bj * 128 + wc * 32 + fq * 8) = w;
                    else { bf16_t* T = bj == 0 ? KS : VS; const int g = wc >> 1; *(u32x4*)(T + ((size_t)(b * B_G + g) * SEQ + t) * HD + dh) = w; } } }
    }
};
DEVI float gelu_tanh(float x) { const float u = 0.7978845608028654f * (x + 0.044715f * x * x * x); const float e = __expf(2.f * u); const float th = 1.f - 2.f / (e + 1.f); return 0.5f * x * (1.f + th); }
struct EpiCmpHid {
    static constexpr bool PERM = true;
    bf16_t* out; const float* bias;
    DEVI void operator()(const AccT& acc, const pg8::Unit& u, int wr, int wc, int fr, int fq) const {
        const float* bs = bias;
#pragma unroll
        for (int bj = 0; bj < 2; ++bj) { const int c = bj * 128 + wc * 32 + fq * 8; const f32x4 b0 = *(const f32x4*)(bs + c), b1 = *(const f32x4*)(bs + c + 4);
#pragma unroll
            for (int ai = 0; ai < 2; ++ai)
#pragma unroll
                for (int m = 0; m < 4; ++m) { const int row = u.pm * 256 + ai * 128 + wr * 64 + m * 16 + fr; f32x4 v0 = acc[ai][bj][m][0] + b0, v1 = acc[ai][bj][m][1] + b1;
#pragma unroll
                    for (int i = 0; i < 4; ++i) { v0[i] = gelu_tanh(v0[i]); v1[i] = gelu_tanh(v1[i]); }
                    *(u32x4*)(out + (size_t)row * 256 + c) = pack8(v0, v1); } }
    }
};
struct EpiCmpOut {
    static constexpr bool PERM = true;
    bf16_t* kc; bf16_t* vc;
    DEVI void operator()(const AccT& acc, const pg8::Unit& u, int wr, int wc, int fr, int fq) const {
        if (wc >= 2) return;
        bf16_t* T = u.pm >= 32 ? vc : kc; const int rbase = (u.pm & 31) * 256;
#pragma unroll
        for (int ai = 0; ai < 2; ++ai)
#pragma unroll
            for (int m = 0; m < 4; ++m) { const int row = rbase + ai * 128 + wr * 64 + m * 16 + fr;
                u32x4 w = pack8(acc[ai][0][m][0], acc[ai][0][m][1]);
                if ((row & 1023) == 1023) w = (u32x4){0u, 0u, 0u, 0u};
                *(u32x4*)(T + (size_t)row * 64 + wc * 32 + fq * 8) = w; }
    }
};
struct EpiResid {
    static constexpr bool PERM = true;
    const bf16_t* res; bf16_t* y;
    DEVI void operator()(const AccT& acc, const pg8::Unit& u, int wr, int wc, int fr, int fq) const {
#pragma unroll
        for (int ai = 0; ai < 2; ++ai)
#pragma unroll
            for (int m = 0; m < 4; ++m) { const size_t off = (size_t)(u.pm * 256 + ai * 128 + wr * 64 + m * 16 + fr) * DM + u.pn * 256 + wc * 32 + fq * 8;
#pragma unroll
                for (int bj = 0; bj < 2; ++bj) { const u32x4 r = *(const u32x4*)(res + off + bj * 128);
                    const f32x4 r0 = {bflo(r.x), bfhi(r.x), bflo(r.y), bfhi(r.y)}, r1 = {bflo(r.z), bfhi(r.z), bflo(r.w), bfhi(r.w)};
                    *(u32x4*)(y + off + bj * 128) = pack8(r0 * ALPHA + acc[ai][bj][m][0], r1 * ALPHA + acc[ai][bj][m][1]); } }
    }
};
struct EpiBf16Out {
    static constexpr bool PERM = true;
    bf16_t* y;
    DEVI void operator()(const AccT& acc, const pg8::Unit& u, int wr, int wc, int fr, int fq) const {
#pragma unroll
        for (int ai = 0; ai < 2; ++ai)
#pragma unroll
            for (int m = 0; m < 4; ++m) { const size_t off = (size_t)(u.pm * 256 + ai * 128 + wr * 64 + m * 16 + fr) * DM + u.pn * 256 + wc * 32 + fq * 8;
#pragma unroll
                for (int bj = 0; bj < 2; ++bj) *(u32x4*)(y + off + bj * 128) = pack8(acc[ai][bj][m][0], acc[ai][bj][m][1]); }
    }
};
struct EpiPart {
    static constexpr bool PERM = false;
    float* part;
    DEVI void operator()(const AccT& acc, const pg8::Unit& u, int wr, int wc, int fr, int fq) const {
        float* base = part + (size_t)((u.pm - 256) * 2 + u.z) * 256 * DM;
#pragma unroll
        for (int ai = 0; ai < 2; ++ai)
#pragma unroll
            for (int m = 0; m < 4; ++m) { const size_t off = (size_t)(ai * 128 + wr * 64 + m * 16 + fr) * DM + u.pn * 256 + wc * 32 + fq * 4;
#pragma unroll
                for (int bj = 0; bj < 2; ++bj)
#pragma unroll
                    for (int n = 0; n < 2; ++n) *(f32x4*)(base + off + bj * 128 + n * 16) = acc[ai][bj][m][n]; }
    }
};
struct EpiSwiglu {
    static constexpr bool PERM = true;
    bf16_t* act; int ld;
    DEVI void operator()(const AccT& acc, const pg8::Unit& u, int wr, int wc, int fr, int fq) const {
#pragma unroll
        for (int ai = 0; ai < 2; ++ai)
#pragma unroll
            for (int m = 0; m < 4; ++m) { const size_t row = (size_t)(u.pm * 256 + ai * 128 + wr * 64 + m * 16 + fr); f32x4 o[2];
#pragma unroll
                for (int n = 0; n < 2; ++n)
#pragma unroll
                    for (int i = 0; i < 4; ++i) { const float gv = acc[ai][0][m][n][i], uv = acc[ai][1][m][n][i]; o[n][i] = gv * __builtin_amdgcn_rcpf(1.f + __expf(-gv)) * uv; }
                *(u32x4*)(act + row * ld + u.pn * 128 + wc * 32 + fq * 8) = pack8(o[0], o[1]); }
    }
};

struct EpiSwiglu8 {
    static constexpr bool PERM = true;
    unsigned char* act; int ld;
    DEVI void operator()(const AccT& acc, const pg8::Unit& u, int wr, int wc, int fr, int fq) const {
#pragma unroll
        for (int ai = 0; ai < 2; ++ai)
#pragma unroll
            for (int m = 0; m < 4; ++m) { const size_t row = (size_t)(u.pm * 256 + ai * 128 + wr * 64 + m * 16 + fr); f32x4 o[2];
#pragma unroll
                for (int n = 0; n < 2; ++n)
#pragma unroll
                    for (int i = 0; i < 4; ++i) { const float gv = acc[ai][0][m][n][i], uv = acc[ai][1][m][n][i]; o[n][i] = gv * __builtin_amdgcn_rcpf(1.f + __expf(-gv)) * uv; }
                u32x2 w; w[0] = pack_fp8x4(o[0][0], o[0][1], o[0][2], o[0][3]); w[1] = pack_fp8x4(o[1][0], o[1][1], o[1][2], o[1][3]);
                *(u32x2*)(act + row * ld + u.pn * 128 + wc * 32 + fq * 8) = w; }
    }
};

DEVI void unpack8(const u32x4 w, float (&x)[8]) { x[0] = bflo(w.x); x[1] = bfhi(w.x); x[2] = bflo(w.y); x[3] = bfhi(w.y); x[4] = bflo(w.z); x[5] = bfhi(w.z); x[6] = bflo(w.w); x[7] = bfhi(w.w); }
DEVI void moe_row8(const bf16_t* YB, const float* PART, int p, int c, float (&x)[8]) {
    if (p < 65536) { unpack8(*(const u32x4*)(YB + (size_t)p * DM + c), x); return; }
    const float* q = PART + ((size_t)(((p >> 8) - 256) * 2) * 256 + (p & 255)) * DM + c;
    f32x4 a0 = *(const f32x4*)q, a1 = *(const f32x4*)(q + 4);
    a0 = a0 + *(const f32x4*)(q + (size_t)256 * DM); a1 = a1 + *(const f32x4*)(q + (size_t)256 * DM + 4);
    x[0] = a0[0]; x[1] = a0[1]; x[2] = a0[2]; x[3] = a0[3]; x[4] = a1[0]; x[5] = a1[1]; x[6] = a1[2]; x[7] = a1[3];
}
template <int MODE, bool ROUTER, bool FINAL>
DEVI void phase_ln(Frame& F, int lnidx, float* outp, int moe_layer) {
    F.refresh();
    unsigned char* ws = F.ws;
    const bf16_t* Y = (const bf16_t*)(ws + WS_Y); const bf16_t* YB = (const bf16_t*)(ws + WS_YB); const float* PART = (const float*)(ws + WS_H);
    bf16_t* HB = (bf16_t*)(ws + WS_HB);
    const float* gam = (const float*)ARG_IN(11) + (size_t)lnidx * DM; const float* bet = (const float*)ARG_IN(12) + (size_t)lnidx * DM;
    int* TOKE = (int*)(ws + WS_ROUTE); int* TOKR = TOKE + MTOK * 2; float* TOKW = (float*)(TOKR + MTOK * 2); int* TOKP = (int*)(TOKW + MTOK * 2);
    const float* wr_ = ROUTER ? (const float*)ARG_IN(15) + (size_t)moe_layer * DM * NEXP : nullptr;
    LAS int* lcnt = (LAS int*)(F.lds + LDS_X);
    LAS int* lrec = lcnt + 16;
    LAS int* lrank = lrec + 256;
    if (ROUTER) { if (F.tid < 16) lcnt[F.tid] = 0; __syncthreads(); }
    const int gw = F.vcu * NWAVES + F.wave, NGW = F.G * NWAVES;
    constexpr int RB = (MODE == 0) ? 4 : 2;
    const f32x4 g0_[2] = {*(const f32x4*)(gam + F.lane * 8), *(const f32x4*)(gam + 512 + F.lane * 8)}, g1_[2] = {*(const f32x4*)(gam + F.lane * 8 + 4), *(const f32x4*)(gam + 512 + F.lane * 8 + 4)};
    const f32x4 b0_[2] = {*(const f32x4*)(bet + F.lane * 8), *(const f32x4*)(bet + 512 + F.lane * 8)}, b1_[2] = {*(const f32x4*)(bet + F.lane * 8 + 4), *(const f32x4*)(bet + 512 + F.lane * 8 + 4)};
#pragma unroll 1
    for (int k0 = 0; k0 < 16; k0 += RB) {
        float v[RB][2][8];
        if (MODE == 0) {
            u32x4 raw[RB][2];
#pragma unroll
            for (int r = 0; r < RB; ++r)
#pragma unroll
                for (int j = 0; j < 2; ++j) raw[r][j] = *(const u32x4*)(Y + (size_t)(gw + (k0 + r) * NGW) * DM + j * 512 + F.lane * 8);
#pragma unroll
            for (int r = 0; r < RB; ++r)
#pragma unroll
                for (int j = 0; j < 2; ++j) unpack8(raw[r][j], v[r][j]);
        } else {
            int p0[RB], p1[RB]; float w0[RB], w1[RB];
#pragma unroll
            for (int r = 0; r < RB; ++r) { const int m = gw + (k0 + r) * NGW; p0[r] = TOKP[m * 2]; p1[r] = TOKP[m * 2 + 1]; w0[r] = TOKW[m * 2]; w1[r] = TOKW[m * 2 + 1]; }
            u32x4 hraw[RB][2];
#pragma unroll
            for (int r = 0; r < RB; ++r)
#pragma unroll
                for (int j = 0; j < 2; ++j) hraw[r][j] = *(const u32x4*)(HB + (size_t)(gw + (k0 + r) * NGW) * DM + j * 512 + F.lane * 8);
#pragma unroll
            for (int r = 0; r < RB; ++r)
#pragma unroll
                for (int j = 0; j < 2; ++j) { const int c = j * 512 + F.lane * 8; float h[8], a[8], b[8];
                    unpack8(hraw[r][j], h); moe_row8(YB, PART, p0[r], c, a); moe_row8(YB, PART, p1[r], c, b);
#pragma unroll
                    for (int i = 0; i < 8; ++i) v[r][j][i] = h[i] * ALPHA + a[i] * w0[r] + b[i] * w1[r]; }
        }
#pragma unroll
        for (int r = 0; r < RB; ++r) {
            const int m = gw + (k0 + r) * NGW;
            float s = 0.f;
#pragma unroll
            for (int j = 0; j < 2; ++j)
#pragma unroll
                for (int i = 0; i < 8; ++i) s += v[r][j][i];
            const float mean = wave_sum(s, F.lane) * (1.f / DM); float s2 = 0.f;
#pragma unroll
            for (int j = 0; j < 2; ++j)
#pragma unroll
                for (int i = 0; i < 8; ++i) { v[r][j][i] -= mean; s2 += v[r][j][i] * v[r][j][i]; }
            const float rstd = 1.f / sqrtf(wave_sum(s2, F.lane) * (1.f / DM) + LN_EPS);
#pragma unroll
            for (int j = 0; j < 2; ++j) { const int c = j * 512 + F.lane * 8;
#pragma unroll
                for (int i = 0; i < 4; ++i) { v[r][j][i] = v[r][j][i] * rstd * g0_[j][i] + b0_[j][i]; v[r][j][4 + i] = v[r][j][4 + i] * rstd * g1_[j][i] + b1_[j][i]; }
                if (FINAL) { *(f32x4*)(outp + (size_t)m * DM + c) = (f32x4){v[r][j][0], v[r][j][1], v[r][j][2], v[r][j][3]}; *(f32x4*)(outp + (size_t)m * DM + c + 4) = (f32x4){v[r][j][4], v[r][j][5], v[r][j][6], v[r][j][7]}; }
                else { u32x4 w; w.x = pk2(v[r][j][0], v[r][j][1]); w.y = pk2(v[r][j][2], v[r][j][3]); w.z = pk2(v[r][j][4], v[r][j][5]); w.w = pk2(v[r][j][6], v[r][j][7]); *(u32x4*)(HB + (size_t)m * DM + c) = w;
                    if (lnidx & 1) { u32x2 w8; w8[0] = pack_fp8x4(v[r][j][0], v[r][j][1], v[r][j][2], v[r][j][3]); w8[1] = pack_fp8x4(v[r][j][4], v[r][j][5], v[r][j][6], v[r][j][7]); *(u32x2*)(ws + WS_HB8 + (size_t)m * DM + c) = w8; } } }
            if (ROUTER) {
                float lg[NEXP];
#pragma unroll
                for (int e = 0; e < NEXP; ++e) lg[e] = 0.f;
#pragma unroll
                for (int j = 0; j < 2; ++j)
#pragma unroll
                    for (int i = 0; i < 8; ++i) { const int c = j * 512 + F.lane * 8 + i; const f32x4 w0 = *(const f32x4*)(wr_ + (size_t)c * NEXP), w1 = *(const f32x4*)(wr_ + (size_t)c * NEXP + 4); const float x = v[r][j][i];
                        lg[0] += x * w0.x; lg[1] += x * w0.y; lg[2] += x * w0.z; lg[3] += x * w0.w; lg[4] += x * w1.x; lg[5] += x * w1.y; lg[6] += x * w1.z; lg[7] += x * w1.w; }
#pragma unroll
                for (int e = 0; e < NEXP; ++e) lg[e] = wave_sum(lg[e], F.lane);
                int e0 = 0; float l0 = lg[0];
#pragma unroll
                for (int e = 1; e < NEXP; ++e) if (lg[e] > l0) { l0 = lg[e]; e0 = e; }
                int e1 = -1; float l1 = -3.4e38f;
#pragma unroll
                for (int e = 0; e < NEXP; ++e) if (e != e0 && lg[e] > l1) { l1 = lg[e]; e1 = e; }
                if (e1 < 0) e1 = (e0 + 1) & 7;
                const float g1 = 1.f / (1.f + __expf(l0 - l1)), g0 = 1.f - g1;
                if (F.lane == 0) {
                    const int idx = (F.wave * 16 + k0 + r) * 2;
                    lrec[idx] = m * 16 + e0; lrec[idx + 1] = m * 16 + e1;
                    TOKE[m * 2] = e0; TOKE[m * 2 + 1] = e1; TOKW[m * 2] = g0; TOKW[m * 2 + 1] = g1;
                }
            }
        }
    }
    if (ROUTER) {
        __syncthreads();
        unsigned* cnt = (unsigned*)(ws + WS_CTL) + CW_MOE + moe_layer * 64;
        int* wgcnt = (int*)(ws + WS_CTL) + CW_WGCNT + moe_layer * 2048 + (int)blockIdx.x * 8;
        LAS int* wcnt = lrank;
        int rec = 0, e = 0, r = 0;
        if (F.wave < 4) { rec = lrec[F.tid]; e = rec & 15;
            const unsigned long long lt = (1ull << F.lane) - 1ull;
#pragma unroll
            for (int x = 0; x < 8; ++x) { const unsigned long long b = __builtin_amdgcn_ballot_w64(e == x); if (e == x) r = __builtin_popcountll(b & lt); if (F.lane == 0) wcnt[F.wave * 8 + x] = __builtin_popcountll(b); } }
        __syncthreads();
        if (F.wave < 4) { for (int w = 0; w < F.wave; ++w) r += wcnt[w * 8 + e]; TOKR[(rec >> 4) * 2 + (F.tid & 1)] = r; }
        if (F.tid < 8) lcnt[F.tid] = wcnt[F.tid] + wcnt[8 + F.tid] + wcnt[16 + F.tid] + wcnt[24 + F.tid];
        __syncthreads();
        if (F.tid < 8) { wgcnt[F.tid] = lcnt[F.tid]; __hip_atomic_fetch_add(cnt + F.tid, (unsigned)lcnt[F.tid], __ATOMIC_RELAXED, __HIP_MEMORY_SCOPE_AGENT); }
    }
}

DEVI void moe_tiles(const unsigned* cnt, int (&ts)[9]) { ts[0] = 0;
#pragma unroll
    for (int e = 0; e < 8; ++e) ts[e + 1] = ts[e] + (int)((__hip_atomic_load(cnt + e, __ATOMIC_RELAXED, __HIP_MEMORY_SCOPE_AGENT) + 255u) >> 8); }
DEVI void phase_moe_scatter(Frame& F, int moe_layer) {
    F.refresh();
    unsigned char* ws = F.ws;
    const unsigned* cnt = (const unsigned*)(ws + WS_CTL) + CW_MOE + moe_layer * 64;
    int ts[9]; moe_tiles(cnt, ts);
    LAS int* wbase = (LAS int*)(F.lds + LDS_X);
    if (F.tid < 8) wbase[F.tid] = 0;
    __syncthreads();
    if (F.tid < (int)blockIdx.x) { const int* wc = (const int*)(ws + WS_CTL) + CW_WGCNT + moe_layer * 2048 + F.tid * 8;
        const u32x4 c0 = *(const u32x4*)wc, c1 = *(const u32x4*)(wc + 4);
#pragma unroll
        for (int e = 0; e < 4; ++e) { __hip_atomic_fetch_add(wbase + e, (int)c0[e], __ATOMIC_RELAXED, __HIP_MEMORY_SCOPE_WORKGROUP); __hip_atomic_fetch_add(wbase + 4 + e, (int)c1[e], __ATOMIC_RELAXED, __HIP_MEMORY_SCOPE_WORKGROUP); } }
    __syncthreads();
    const int* TOKE = (const int*)(ws + WS_ROUTE); const int* TOKR = TOKE + MTOK * 2; int* TOKP = (int*)(ws + WS_ROUTE) + MTOK * 6;
    const bf16_t* HB = (const bf16_t*)(ws + WS_HB); unsigned char* XB = ws + WS_XB;
    const int gw = F.vcu * NWAVES + F.wave, NGW = F.G * NWAVES;
#pragma unroll 1
    for (int k0 = 0; k0 < 16; k0 += 4) {
        u32x4 r0[4], r1[4]; int ee[4][2], rk[4][2];
#pragma unroll
        for (int q = 0; q < 4; ++q) { const int m = gw + (k0 + q) * NGW; r0[q] = *(const u32x4*)(HB + (size_t)m * DM + F.lane * 8); r1[q] = *(const u32x4*)(HB + (size_t)m * DM + 512 + F.lane * 8);
            ee[q][0] = TOKE[m * 2]; ee[q][1] = TOKE[m * 2 + 1]; rk[q][0] = TOKR[m * 2]; rk[q][1] = TOKR[m * 2 + 1]; }
#pragma unroll
        for (int q = 0; q < 4; ++q) { const int m = gw + (k0 + q) * NGW;
            u32x2 a8, b8; a8[0] = pack_fp8x4(bflo(r0[q][0]), bfhi(r0[q][0]), bflo(r0[q][1]), bfhi(r0[q][1])); a8[1] = pack_fp8x4(bflo(r0[q][2]), bfhi(r0[q][2]), bflo(r0[q][3]), bfhi(r0[q][3]));
            b8[0] = pack_fp8x4(bflo(r1[q][0]), bfhi(r1[q][0]), bflo(r1[q][1]), bfhi(r1[q][1])); b8[1] = pack_fp8x4(bflo(r1[q][2]), bfhi(r1[q][2]), bflo(r1[q][3]), bfhi(r1[q][3]));
#pragma unroll
            for (int k = 0; k < 2; ++k) { const int e = ee[q][k], r = rk[q][k];
                int st = 0;
#pragma unroll
                for (int j = 1; j < 8; ++j) st = (e >= j) ? ts[j] : st;
                const int pos = st * 256 + wbase[e] + r;
                *(u32x2*)(XB + (size_t)pos * DM + F.lane * 8) = a8; *(u32x2*)(XB + (size_t)pos * DM + 512 + F.lane * 8) = b8;
                if (F.lane == 0) TOKP[m * 2 + k] = pos; } }
    }
}

DEVI void phase_nsa_naive(Frame& F) {
    F.refresh();
    unsigned char* ws = F.ws;
    const bf16_t* Q = (const bf16_t*)(ws + RA_Q); bf16_t* ATT = (bf16_t*)(ws + RA_ATT);
    const bf16_t* KC = (const bf16_t*)(ws + RA_KC); const bf16_t* VC = (const bf16_t*)(ws + RA_VC);
    const bf16_t* KS = (const bf16_t*)(ws + RA_KS); const bf16_t* VS = (const bf16_t*)(ws + RA_VS);
    const bf16_t* KW = (const bf16_t*)(ws + RA_KW); const bf16_t* VW = (const bf16_t*)(ws + RA_VW);
    const float* GT = (const float*)(ws + RA_GATE); const float* CS = (const float*)(ws + WS_CS);
    LAS float* sc = (LAS float*)(F.lds + F.wave * 16384);
    LAS float* qs_ = (LAS float*)(F.lds + LDS_X + F.wave * 2048);
    LAS float* qr_ = qs_ + 256;
    const int lane = F.lane;
    const int gw = F.vcu * NWAVES + F.wave, NGW = F.G * NWAVES;
    for (int u = gw; u < MTOK * A_G; u += NGW) {
        const int bg = u / SEQ, t = u % SEQ, b = bg / A_G, g = bg % A_G; const int tok = b * SEQ + t;
        { const bf16_t* qp = Q + (size_t)tok * DM + g * 256 + lane * 4; const u32x2 w = *(const u32x2*)qp;
          float x[4] = {bflo(w.x), bfhi(w.x), bflo(w.y), bfhi(w.y)};
#pragma unroll
          for (int i = 0; i < 4; ++i) qs_[lane * 4 + i] = x[i];
          LDS_WAIT();
          const int d0 = (lane * 4) & 63;
#pragma unroll
          for (int i = 0; i < 4; ++i) { const int d = d0 + i; float v = x[i];
              if (d < 8) v = x[i] * CS[(size_t)tok * 16 + d] - qs_[lane * 4 + i + 8] * CS[(size_t)tok * 16 + 8 + d];
              else if (d < 16) v = x[i] * CS[(size_t)tok * 16 + d - 8] + qs_[lane * 4 + i - 8] * CS[(size_t)tok * 16 + d];
              qr_[lane * 4 + i] = v; }
          LDS_WAIT(); }
        float oc[4] = {0.f, 0.f, 0.f, 0.f}, os[4] = {0.f, 0.f, 0.f, 0.f}, ow[4] = {0.f, 0.f, 0.f, 0.f};
        const int cur = t >> 6;
        const int nv = t >= 31 ? ((t - 31) >> 4) + 1 : 0;
        float impv[4] = {0.f, 0.f, 0.f, 0.f};
        if (nv > 0) {
            const bf16_t* kc = KC + (size_t)bg * 1024 * 64; const bf16_t* vc = VC + (size_t)bg * 1024 * 64;
            float mx[4] = {-3.0e38f, -3.0e38f, -3.0e38f, -3.0e38f};
            for (int c = 0; c * 64 < nv; ++c) { const int n = c * 64 + lane;
                if (n < nv) { float s[4] = {0.f, 0.f, 0.f, 0.f}; LAS float* qs = qs_; asm volatile("" : "+v"(qs));
#pragma unroll 2
                    for (int d8 = 0; d8 < 8; ++d8) { const u32x4 w = *(const u32x4*)(kc + (size_t)n * 64 + d8 * 8);
                        const float kf[8] = {bflo(w.x), bfhi(w.x), bflo(w.y), bfhi(w.y), bflo(w.z), bfhi(w.z), bflo(w.w), bfhi(w.w)};
#pragma unroll
                        for (int r = 0; r < 4; ++r) { const f32x4 qa = *(const LAS f32x4*)(qs + r * 64 + d8 * 8), qb = *(const LAS f32x4*)(qs + r * 64 + d8 * 8 + 4);
                            s[r] += qa.x * kf[0] + qa.y * kf[1] + qa.z * kf[2] + qa.w * kf[3] + qb.x * kf[4] + qb.y * kf[5] + qb.z * kf[6] + qb.w * kf[7]; } }
#pragma unroll
                    for (int r = 0; r < 4; ++r) { s[r] *= QSCALE; mx[r] = fmaxf(mx[r], s[r]); }
                    *(LAS f32x4*)(sc + n * 4) = (f32x4){s[0], s[1], s[2], s[3]}; } }
            float l[4] = {0.f, 0.f, 0.f, 0.f};
#pragma unroll
            for (int r = 0; r < 4; ++r) mx[r] = wave_max(mx[r], lane);
            LDS_WAIT();
            for (int c = 0; c * 64 < nv; ++c) { const int n = c * 64 + lane;
                if (n < nv) { f32x4 s = *(const LAS f32x4*)(sc + n * 4);
#pragma unroll
                    for (int r = 0; r < 4; ++r) { s[r] = __expf(s[r] - mx[r]); l[r] += s[r]; }
                    *(LAS f32x4*)(sc + n * 4) = s; } }
#pragma unroll
            for (int r = 0; r < 4; ++r) l[r] = 1.f / wave_sum(l[r], lane);
            LDS_WAIT();
            for (int c = 0; c * 64 < nv; ++c) { const int n = c * 64 + lane;
                if (n < nv) { f32x4 s = *(const LAS f32x4*)(sc + n * 4);
#pragma unroll
                    for (int r = 0; r < 4; ++r) s[r] *= l[r];
                    *(LAS f32x4*)(sc + n * 4) = s; } }
            LDS_WAIT();
#pragma unroll 4
            for (int n = 0; n < nv; ++n) { const float v = bf2f(vc[(size_t)n * 64 + lane]); const f32x4 p = *(const LAS f32x4*)(sc + n * 4);
#pragma unroll
                for (int r = 0; r < 4; ++r) oc[r] += p[r] * v; }
#pragma unroll
            for (int i = 0; i < 4; ++i) { const int j = lane + 64 * i; float acc = 0.f;
#pragma unroll
                for (int k = -1; k <= 3; ++k) { const int n = 4 * j + k; if (n >= 0 && n < nv) { const f32x4 p = *(const LAS f32x4*)(sc + n * 4); const float ps = (p.x + p.y) + (p.z + p.w); acc += (k == -1 || k == 3) ? 0.5f * ps : ps; } }
                impv[i] = acc; }
        }
        float scv[4];
#pragma unroll
        for (int i = 0; i < 4; ++i) { const int j = lane + 64 * i; scv[i] = j > cur ? -1.f : ((j == 0 || j == cur || j == cur - 1) ? 1e9f : impv[i]); }
        LAS int* sel = (LAS int*)(F.lds + MISC_OFF + 256) + F.wave * 16;
#pragma unroll 1
        for (int k = 0; k < NSEL; ++k) {
            float bv = -2.f; int bi = 1 << 20;
#pragma unroll
            for (int i = 0; i < 4; ++i) { const int j = lane + 64 * i; if (scv[i] > bv) { bv = scv[i]; bi = j; } }
#pragma unroll
            for (int o = 1; o < 64; o <<= 1) { const float ov = shx(bv, o, lane); const int oi = shxi(bi, o, lane); if (ov > bv || (ov == bv && oi < bi)) { bv = ov; bi = oi; } }
            if (lane == 0) sel[k] = bi;
#pragma unroll
            for (int i = 0; i < 4; ++i) if (lane + 64 * i == bi) scv[i] = -3.f;
        }
        LDS_WAIT();
        {   const bf16_t* ks = KS + (size_t)bg * SEQ * 64; const bf16_t* vs = VS + (size_t)bg * SEQ * 64;
            float mx[4] = {-3.0e38f, -3.0e38f, -3.0e38f, -3.0e38f};
#pragma unroll 1
            for (int k = 0; k < NSEL; ++k) { const int pos = sel[k] * 64 + lane; const bool ok = pos <= t;
                float s[4] = {-1e30f, -1e30f, -1e30f, -1e30f};
                if (ok) { LAS float* qr = qr_; asm volatile("" : "+v"(qr));
#pragma unroll
                    for (int r = 0; r < 4; ++r) s[r] = 0.f;
#pragma unroll 2
                    for (int d8 = 0; d8 < 8; ++d8) { const u32x4 w = *(const u32x4*)(ks + (size_t)pos * 64 + d8 * 8);
                        const float kf[8] = {bflo(w.x), bfhi(w.x), bflo(w.y), bfhi(w.y), bflo(w.z), bfhi(w.z), bflo(w.w), bfhi(w.w)};
#pragma unroll
                        for (int r = 0; r < 4; ++r) { const f32x4 qa = *(const LAS f32x4*)(qr + r * 64 + d8 * 8), qb = *(const LAS f32x4*)(qr + r * 64 + d8 * 8 + 4);
                            s[r] += qa.x * kf[0] + qa.y * kf[1] + qa.z * kf[2] + qa.w * kf[3] + qb.x * kf[4] + qb.y * kf[5] + qb.z * kf[6] + qb.w * kf[7]; } }
#pragma unroll
                    for (int r = 0; r < 4; ++r) { s[r] *= QSCALE; mx[r] = fmaxf(mx[r], s[r]); } }
                *(LAS f32x4*)(sc + (k * 64 + lane) * 4) = (f32x4){s[0], s[1], s[2], s[3]}; }
            float l[4] = {0.f, 0.f, 0.f, 0.f};
#pragma unroll
            for (int r = 0; r < 4; ++r) mx[r] = wave_max(mx[r], lane);
            LDS_WAIT();
#pragma unroll 1
            for (int k = 0; k < NSEL; ++k) { const int pos = sel[k] * 64 + lane; const bool ok = pos <= t; f32x4 s = *(const LAS f32x4*)(sc + (k * 64 + lane) * 4);
#pragma unroll
                for (int r = 0; r < 4; ++r) { s[r] = ok ? __expf(s[r] - mx[r]) : 0.f; l[r] += s[r]; }
                *(LAS f32x4*)(sc + (k * 64 + lane) * 4) = s; }
#pragma unroll
            for (int r = 0; r < 4; ++r) l[r] = 1.f / wave_sum(l[r], lane);
            LDS_WAIT();
#pragma unroll 1
            for (int k = 0; k < NSEL; ++k) { const int p0 = sel[k] * 64; if (p0 > t) continue;
#pragma unroll 4
                for (int i = 0; i < 64; ++i) { const int pos = p0 + i; if (pos > t) break; const float v = bf2f(vs[(size_t)pos * 64 + lane]); const f32x4 p = *(const LAS f32x4*)(sc + (k * 64 + i) * 4);
#pragma unroll
                    for (int r = 0; r < 4; ++r) os[r] += p[r] * v; } }
#pragma unroll
            for (int r = 0; r < 4; ++r) os[r] *= l[r];
            LDS_WAIT();
        }
        {   const bf16_t* kw = KW + (size_t)bg * SEQ * 64; const bf16_t* vw = VW + (size_t)bg * SEQ * 64;
            float mx[4] = {-3.0e38f, -3.0e38f, -3.0e38f, -3.0e38f};
#pragma unroll 1
            for (int c = 0; c < 8; ++c) { const int pos = t - 511 + c * 64 + lane; const bool ok = pos >= 0;
                float s[4] = {-1e30f, -1e30f, -1e30f, -1e30f};
                if (ok) { LAS float* qr = qr_; asm volatile("" : "+v"(qr));
#pragma unroll
                    for (int r = 0; r < 4; ++r) s[r] = 0.f;
#pragma unroll 2
                    for (int d8 = 0; d8 < 8; ++d8) { const u32x4 w = *(const u32x4*)(kw + (size_t)pos * 64 + d8 * 8);
                        const float kf[8] = {bflo(w.x), bfhi(w.x), bflo(w.y), bfhi(w.y), bflo(w.z), bfhi(w.z), bflo(w.w), bfhi(w.w)};
#pragma unroll
                        for (int r = 0; r < 4; ++r) { const f32x4 qa = *(const LAS f32x4*)(qr + r * 64 + d8 * 8), qb = *(const LAS f32x4*)(qr + r * 64 + d8 * 8 + 4);
                            s[r] += qa.x * kf[0] + qa.y * kf[1] + qa.z * kf[2] + qa.w * kf[3] + qb.x * kf[4] + qb.y * kf[5] + qb.z * kf[6] + qb.w * kf[7]; } }
#pragma unroll
                    for (int r = 0; r < 4; ++r) { s[r] *= QSCALE; mx[r] = fmaxf(mx[r], s[r]); } }
                *(LAS f32x4*)(sc + (c * 64 + lane) * 4) = (f32x4){s[0], s[1], s[2], s[3]}; }
            float l[4] = {0.f, 0.f, 0.f, 0.f};
#pragma unroll
            for (int r = 0; r < 4; ++r) mx[r] = wave_max(mx[r], lane);
            LDS_WAIT();
#pragma unroll 1
            for (int c = 0; c < 8; ++c) { const int pos = t - 511 + c * 64 + lane; const bool ok = pos >= 0; f32x4 s = *(const LAS f32x4*)(sc + (c * 64 + lane) * 4);
#pragma unroll
                for (int r = 0; r < 4; ++r) { s[r] = ok ? __expf(s[r] - mx[r]) : 0.f; l[r] += s[r]; }
                *(LAS f32x4*)(sc + (c * 64 + lane) * 4) = s; }
#pragma unroll
            for (int r = 0; r < 4; ++r) l[r] = 1.f / wave_sum(l[r], lane);
            LDS_WAIT();
#pragma unroll 4
            for (int i = (t >= 511 ? 0 : 511 - t); i < 512; ++i) { const int pos = t - 511 + i; const float v = bf2f(vw[(size_t)pos * 64 + lane]); const f32x4 p = *(const LAS f32x4*)(sc + i * 4);
#pragma unroll
                for (int r = 0; r < 4; ++r) ow[r] += p[r] * v; }
#pragma unroll
            for (int r = 0; r < 4; ++r) ow[r] *= l[r];
            LDS_WAIT();
        }
#pragma unroll
        for (int r = 0; r < 4; ++r) { const float gc = GT[(size_t)tok * 48 + 0 * 16 + g * 4 + r], gs = GT[(size_t)tok * 48 + 1 * 16 + g * 4 + r], gwv = GT[(size_t)tok * 48 + 2 * 16 + g * 4 + r];
            const float o = ((DBG_DROP & 1) ? 0.f : gc * oc[r]) + ((DBG_DROP & 2) ? 0.f : gs * os[r]) + ((DBG_DROP & 4) ? 0.f : gwv * ow[r]);
            ATT[(size_t)tok * DM + g * 256 + r * 64 + lane] = (bf16_t)f2bf(o); }
    }
}

DEVI void phase_swa_naive(Frame& F, const float* sinks) {
    F.refresh();
    unsigned char* ws = F.ws;
    const bf16_t* Q = (const bf16_t*)(ws + RA_Q); bf16_t* ATT = (bf16_t*)(ws + RA_ATT);
    const bf16_t* KS = (const bf16_t*)(ws + WS_KSH); const bf16_t* VS = (const bf16_t*)(ws + WS_VSH);
    LAS float* sc = (LAS float*)(F.lds + F.wave * 16384);
    LAS float* qs_ = (LAS float*)(F.lds + LDS_X + F.wave * 2048);
    const int lane = F.lane;
    const int gw = F.vcu * NWAVES + F.wave, NGW = F.G * NWAVES;
    for (int u = gw; u < MTOK * B_G; u += NGW) {
        const int bg = u / SEQ, t = u % SEQ, b = bg / B_G, g = bg % B_G; const int tok = b * SEQ + t;
        { const u32x4 w = *(const u32x4*)(Q + (size_t)tok * DM + g * 512 + lane * 8);
          const float x[8] = {bflo(w.x), bfhi(w.x), bflo(w.y), bfhi(w.y), bflo(w.z), bfhi(w.z), bflo(w.w), bfhi(w.w)};
#pragma unroll
          for (int i = 0; i < 8; ++i) qs_[lane * 8 + i] = x[i];
          LDS_WAIT(); }
        const bf16_t* kp = KS + (size_t)bg * SEQ * 64; const bf16_t* vp = VS + (size_t)bg * SEQ * 64;
        float mx[8], l[8], o[8];
#pragma unroll
        for (int r = 0; r < 8; ++r) { mx[r] = sinks[g * 8 + r]; l[r] = 0.f; o[r] = 0.f; }
#pragma unroll 1
        for (int c = 0; c < 2; ++c) { const int pos = t - 127 + c * 64 + lane; const bool ok = pos >= 0;
            float s[8];
#pragma unroll
            for (int r = 0; r < 8; ++r) s[r] = -1e30f;
            if (ok) { LAS float* qs = qs_; asm volatile("" : "+v"(qs));
#pragma unroll
                for (int r = 0; r < 8; ++r) s[r] = 0.f;
#pragma unroll 1
                for (int d8 = 0; d8 < 8; ++d8) { const u32x4 w = *(const u32x4*)(kp + (size_t)pos * 64 + d8 * 8);
                    const float kf[8] = {bflo(w.x), bfhi(w.x), bflo(w.y), bfhi(w.y), bflo(w.z), bfhi(w.z), bflo(w.w), bfhi(w.w)};
#pragma unroll
                    for (int r = 0; r < 8; ++r) { const f32x4 qa = *(const LAS f32x4*)(qs + r * 64 + d8 * 8), qb = *(const LAS f32x4*)(qs + r * 64 + d8 * 8 + 4);
                        s[r] += qa.x * kf[0] + qa.y * kf[1] + qa.z * kf[2] + qa.w * kf[3] + qb.x * kf[4] + qb.y * kf[5] + qb.z * kf[6] + qb.w * kf[7]; } }
#pragma unroll
                for (int r = 0; r < 8; ++r) { s[r] *= QSCALE; mx[r] = fmaxf(mx[r], s[r]); } }
            *(LAS f32x4*)(sc + (c * 64 + lane) * 8) = (f32x4){s[0], s[1], s[2], s[3]}; *(LAS f32x4*)(sc + (c * 64 + lane) * 8 + 4) = (f32x4){s[4], s[5], s[6], s[7]}; }
#pragma unroll
        for (int r = 0; r < 8; ++r) mx[r] = wave_max(mx[r], lane);
        LDS_WAIT();
#pragma unroll
        for (int c = 0; c < 2; ++c) { const int pos = t - 127 + c * 64 + lane; const bool ok = pos >= 0;
            f32x4 s0 = *(const LAS f32x4*)(sc + (c * 64 + lane) * 8), s1 = *(const LAS f32x4*)(sc + (c * 64 + lane) * 8 + 4);
#pragma unroll
            for (int r = 0; r < 4; ++r) { s0[r] = ok ? __expf(s0[r] - mx[r]) : 0.f; l[r] += s0[r]; s1[r] = ok ? __expf(s1[r] - mx[r + 4]) : 0.f; l[r + 4] += s1[r]; }
            *(LAS f32x4*)(sc + (c * 64 + lane) * 8) = s0; *(LAS f32x4*)(sc + (c * 64 + lane) * 8 + 4) = s1; }
#pragma unroll
        for (int r = 0; r < 8; ++r) l[r] = 1.f / (wave_sum(l[r], lane) + __expf(sinks[g * 8 + r] - mx[r]));
        LDS_WAIT();
#pragma unroll 4
        for (int i = (t >= 127 ? 0 : 127 - t); i < 128; ++i) { const int pos = t - 127 + i; const float v = bf2f(vp[(size_t)pos * 64 + lane]);
            const f32x4 p0 = *(const LAS f32x4*)(sc + i * 8), p1 = *(const LAS f32x4*)(sc + i * 8 + 4);
#pragma unroll
            for (int r = 0; r < 4; ++r) { o[r] += p0[r] * v; o[r + 4] += p1[r] * v; } }
#pragma unroll
        for (int r = 0; r < 8; ++r) ATT[(size_t)tok * DM + g * 512 + r * 64 + lane] = (bf16_t)f2bf(o[r] * l[r]);
        LDS_WAIT();
    }
}

namespace fa {
typedef short v4i16_t __attribute__((ext_vector_type(4)));
constexpr float CEXP = 0.125f * 1.4426950408889634f;
constexpr float NEGINF = -__builtin_huge_valf();
constexpr int VLD = 160;
constexpr int KVB = 8192 + 64 * VLD;
constexpr int L_KV = 0;
constexpr int L_IMP = 2 * KVB;
constexpr int IMP_LD = 264;
constexpr int OS_LD = 65;
constexpr int L_Q = L_IMP + 64 * IMP_LD * 4;
constexpr int L_ML = L_Q + 32768;
constexpr int L_MASK = L_ML + 2048;
constexpr int L_LIST = L_MASK + 2048;
constexpr int L_TOK = L_LIST + 1056;
constexpr int L_END = L_TOK + 2048;
static_assert(256 * OS_LD * 4 <= 64 * IMP_LD * 4, "accumulator fits the importance table");
static_assert(L_END <= MISC_OFF, "attention LDS map");

struct Stage { u32x4 k, v; };
template <bool WITHV> DEVI void stage_load(Stage& s, const bf16_t* K, const bf16_t* V, int tid) { s.k = *(const u32x4*)((const char*)K + tid * 16); if (WITHV) s.v = *(const u32x4*)((const char*)V + tid * 16); }
template <bool WITHV> DEVI void stage_write(const Stage& s, LAS unsigned char* buf, int tid) {
    const int r = tid >> 3, c = tid & 7;
    *(LAS u32x4*)(buf + r * 128 + ((c ^ (r & 7)) << 4)) = s.k;
    if (WITHV) *(LAS u32x4*)(buf + 8192 + r * VLD + (c << 4)) = s.v;
}
DEVI float max_quads(float x) {
    auto a = __builtin_amdgcn_permlane16_swap(__float_as_uint(x), __float_as_uint(x), false, false); x = fmaxf(__uint_as_float(a[0]), __uint_as_float(a[1]));
    auto b = __builtin_amdgcn_permlane32_swap(__float_as_uint(x), __float_as_uint(x), false, false); return fmaxf(__uint_as_float(b[0]), __uint_as_float(b[1]));
}
DEVI float sum_quads(float x) {
    auto a = __builtin_amdgcn_permlane16_swap(__float_as_uint(x), __float_as_uint(x), false, false); x = __uint_as_float(a[0]) + __uint_as_float(a[1]);
    auto b = __builtin_amdgcn_permlane32_swap(__float_as_uint(x), __float_as_uint(x), false, false); return __uint_as_float(b[0]) + __uint_as_float(b[1]);
}
template <int CTRL> DEVI float dppf(float v) { return __int_as_float(__builtin_amdgcn_update_dpp(0, __float_as_int(v), CTRL, 0xF, 0xF, false)); }
template <int CTRL> DEVI int dppi(int v) { return __builtin_amdgcn_update_dpp(0, v, CTRL, 0xF, 0xF, false); }
DEVI float bperm(float v, int src_lane) { return __builtin_bit_cast(float, __builtin_amdgcn_ds_bpermute(src_lane << 2, __builtin_bit_cast(int, v))); }
#define DPP_X1 0xB1
#define DPP_X2 0x4E
#define DPP_HM 0x141

DEVI void qk_slot(LAS const unsigned char* kb, const bf16x8 q0, const bf16x8 q1, int lane, f32x4 (&s)[4], float z0 = 0.f) {
    const int l15 = lane & 15, quad = lane >> 4;
    LAS const unsigned char* p0 = kb + l15 * 128 + (((quad) ^ (l15 & 7)) << 4);
    LAS const unsigned char* p1 = kb + l15 * 128 + (((4 + quad) ^ (l15 & 7)) << 4);
#pragma unroll
    for (int kg = 0; kg < 4; ++kg) {
        const bf16x8 a0 = *(LAS const bf16x8*)(p0 + kg * 2048), a1 = *(LAS const bf16x8*)(p1 + kg * 2048);
        f32x4 z = {z0, z0, z0, z0};
        z = __builtin_amdgcn_mfma_f32_16x16x32_bf16(a0, q0, z, 0, 0, 0);
        s[kg] = __builtin_amdgcn_mfma_f32_16x16x32_bf16(a1, q1, z, 0, 0, 0);
    }
}
DEVI float mask_max(f32x4 (&s)[4], int lo, int hi, int quad) {
    float mx = NEGINF; const int loq = lo - 4 * quad, hiq = hi - 4 * quad;
#pragma unroll
    for (int kg = 0; kg < 4; ++kg)
#pragma unroll
        for (int i = 0; i < 4; ++i) { const bool ok = (16 * kg + i >= loq) & (16 * kg + i <= hiq); s[kg][i] = ok ? s[kg][i] : NEGINF; mx = fmaxf(mx, s[kg][i]); }
    return max_quads(mx);
}
DEVI bf16x8 pack_p(const f32x4 a, const f32x4 b) { u32x4 w; w.x = pg8::cvt_pk_bf16(a[0], a[1]); w.y = pg8::cvt_pk_bf16(a[2], a[3]); w.z = pg8::cvt_pk_bf16(b[0], b[1]); w.w = pg8::cvt_pk_bf16(b[2], b[3]); return __builtin_bit_cast(bf16x8, w); }
DEVI void pv_slot(LAS const unsigned char* vb, const bf16x8 (&pb)[2], f32x4 (&o)[4], int lane) {
    const int i = lane & 15, quad = lane >> 4;
    LAS const unsigned char* a0 = vb + (4 * quad + (i >> 2)) * VLD + ((i & 3) << 3);
#pragma unroll
    for (int ks2 = 0; ks2 < 2; ++ks2) {
#pragma unroll
        for (int dg = 0; dg < 4; ++dg) {
            const v4i16_t t0 = __builtin_amdgcn_ds_read_tr16_b64_v4i16((LAS v4i16_t*)(a0 + (32 * ks2) * VLD + 32 * dg));
            const v4i16_t t1 = __builtin_amdgcn_ds_read_tr16_b64_v4i16((LAS v4i16_t*)(a0 + (32 * ks2 + 16) * VLD + 32 * dg));
            const bf16x8 a = {t0[0], t0[1], t0[2], t0[3], t1[0], t1[1], t1[2], t1[3]};
            o[dg] = __builtin_amdgcn_mfma_f32_16x16x32_bf16(a, pb[ks2], o[dg], 0, 0, 0);
        }
    }
}
template <bool PV> DEVI void online_step(LAS const unsigned char* buf, const bf16x8 q0, const bf16x8 q1, int lo, int hi, float& m, float& l, f32x4 (&o)[4], int lane) {
    __builtin_amdgcn_sched_barrier(0);
    f32x4 s[4]; qk_slot(buf, q0, q1, lane, s);
    __builtin_amdgcn_sched_barrier(0);
    const int quad = lane >> 4;
    float mx;
    if (__builtin_amdgcn_ballot_w64((lo > 0) | (hi < 63)) != 0ull) mx = mask_max(s, lo, hi, quad);
    else { float a = fmaxf(fmaxf(s[0][0], s[0][1]), fmaxf(s[0][2], s[0][3])), b = fmaxf(fmaxf(s[1][0], s[1][1]), fmaxf(s[1][2], s[1][3]));
           a = fmaxf(a, fmaxf(fmaxf(s[2][0], s[2][1]), fmaxf(s[2][2], s[2][3]))); b = fmaxf(b, fmaxf(fmaxf(s[3][0], s[3][1]), fmaxf(s[3][2], s[3][3]))); mx = max_quads(fmaxf(a, b)); }
    const float mnew = fmaxf(m, mx);
    const float msafe = (mnew == NEGINF) ? 0.f : mnew;
    const float alpha = __builtin_amdgcn_exp2f((m - msafe) * CEXP);
    const float mc = -msafe * CEXP;
    float ps = 0.f;
#pragma unroll
    for (int kg = 0; kg < 4; ++kg)
#pragma unroll
        for (int i = 0; i < 4; ++i) { s[kg][i] = __builtin_amdgcn_exp2f(__builtin_fmaf(s[kg][i], CEXP, mc)); ps += s[kg][i]; }
    l = l * alpha + ps; m = mnew;
    if (PV) {
        if (__builtin_amdgcn_ballot_w64(alpha != 1.f) != 0ull) {
#pragma unroll
            for (int dg = 0; dg < 4; ++dg) o[dg] = o[dg] * alpha;
        }
        bf16x8 pb[2]; pb[0] = pack_p(s[0], s[1]); pb[1] = pack_p(s[2], s[3]);
        pv_slot(buf + 8192, pb, o, lane);
    }
    __builtin_amdgcn_sched_barrier(0);
}
typedef float f32x2p __attribute__((ext_vector_type(2)));
template <bool PV> DEVI void fixed_step(LAS const unsigned char* buf, const bf16x8 q0, const bf16x8 q1, int lo, int hi, float mc, float& l, f32x4 (&o)[4], int lane) {
    __builtin_amdgcn_sched_barrier(0);
    f32x4 s[4]; qk_slot(buf, q0, q1, lane, s, mc);
    __builtin_amdgcn_sched_barrier(0);
    const int quad = lane >> 4;
    f32x2p p2 = {0.f, 0.f};
    if (__builtin_amdgcn_ballot_w64((lo > 0) | (hi < 63)) != 0ull) { const int loq = lo - 4 * quad, hiq = hi - 4 * quad;
#pragma unroll
        for (int kg = 0; kg < 4; ++kg) {
#pragma unroll
            for (int i = 0; i < 4; ++i) { const bool ok = (16 * kg + i >= loq) & (16 * kg + i <= hiq); s[kg][i] = ok ? __builtin_amdgcn_exp2f(s[kg][i]) : 0.f; }
            p2 += (f32x2p){s[kg][0], s[kg][1]}; p2 += (f32x2p){s[kg][2], s[kg][3]}; }
    } else {
#pragma unroll
        for (int kg = 0; kg < 4; ++kg) {
#pragma unroll
            for (int i = 0; i < 4; ++i) s[kg][i] = __builtin_amdgcn_exp2f(s[kg][i]);
            p2 += (f32x2p){s[kg][0], s[kg][1]}; p2 += (f32x2p){s[kg][2], s[kg][3]}; }
    }
    l += p2[0] + p2[1];
    if (PV) { bf16x8 pb[2]; pb[0] = pack_p(s[0], s[1]); pb[1] = pack_p(s[2], s[3]); pv_slot(buf + 8192, pb, o, lane); }
    __builtin_amdgcn_sched_barrier(0);
}
DEVI bf16x8 scale_frag(const bf16x8 q, float c) { const u32x4 w = __builtin_bit_cast(u32x4, q); u32x4 o;
#pragma unroll
    for (int i = 0; i < 4; ++i) o[i] = pg8::cvt_pk_bf16(bflo(w[i]) * c, bfhi(w[i]) * c);
    return __builtin_bit_cast(bf16x8, o); }
DEVI float frag_norm2(const bf16x8 q0, const bf16x8 q1) { float n2 = 0.f; const u32x4 w0 = __builtin_bit_cast(u32x4, q0), w1 = __builtin_bit_cast(u32x4, q1);
#pragma unroll
    for (int e = 0; e < 4; ++e) { const float a = bflo(w0[e]), b = bfhi(w0[e]), c = bflo(w1[e]), d = bfhi(w1[e]); n2 += a * a + b * b + c * c + d * d; }
    return n2; }
DEVI void load_q(const bf16_t* Q, size_t tok, int hcol, int quad, bf16x8 (&qf)[2]) {
    const bf16_t* p = Q + tok * DM + hcol + quad * 8;
    qf[0] = *(const bf16x8*)p; qf[1] = *(const bf16x8*)(p + 32);
}
DEVI bf16x8 rope_frag(const bf16x8 q, const float* csrow, int quad, int lane) {
    const u32x4 w = __builtin_bit_cast(u32x4, q); u32x4 pw;
#pragma unroll
    for (int i = 0; i < 4; ++i) pw[i] = (unsigned)shxi((int)w[i], 16, lane);
    if (quad >= 2) return q;
    const f32x4 c0 = *(const f32x4*)csrow, c1 = *(const f32x4*)(csrow + 4), s0 = *(const f32x4*)(csrow + 8), s1 = *(const f32x4*)(csrow + 12);
    const float sg = quad == 0 ? -1.f : 1.f;
    float x[8], xp[8];
#pragma unroll
    for (int i = 0; i < 4; ++i) { x[2 * i] = bflo(w[i]); x[2 * i + 1] = bfhi(w[i]); xp[2 * i] = bflo(pw[i]); xp[2 * i + 1] = bfhi(pw[i]); }
    const float cc[8] = {c0[0], c0[1], c0[2], c0[3], c1[0], c1[1], c1[2], c1[3]}, ss[8] = {s0[0], s0[1], s0[2], s0[3], s1[0], s1[1], s1[2], s1[3]};
    u32x4 o;
#pragma unroll
    for (int i = 0; i < 4; ++i) o[i] = pg8::cvt_pk_bf16(x[2 * i] * cc[2 * i] + sg * xp[2 * i] * ss[2 * i], x[2 * i + 1] * cc[2 * i + 1] + sg * xp[2 * i + 1] * ss[2 * i + 1]);
    return __builtin_bit_cast(bf16x8, o);
}

struct KFr { bf16x8 k[4][2]; };
struct VFr { bf16x8 v[4][2]; };
constexpr float LSCALE = 1048576.f;
struct Raw8 { u32x4 k[4]; u32x4 v[4]; };
template <int OFF> DEVI void gld16(u32x4& d, const void* p) { asm volatile("global_load_dwordx4 %0, %1, off offset:%2" : "=v"(d) : "v"(p), "n"(OFF) : "memory"); }
DEVI void sel_load8(Raw8& r, const unsigned char* K8, const unsigned char* V8, int j, int lane) {
    const int l15 = lane & 15, quad = lane >> 4;
    const unsigned char* pk = K8 + ((size_t)(64 * j + l15)) * 64 + 16 * quad;
    const unsigned char* pv = V8 + (size_t)j * 4096 + l15 * 64 + 16 * quad;
    gld16<0>(r.k[0], pk); gld16<1024>(r.k[1], pk); gld16<2048>(r.k[2], pk); gld16<3072>(r.k[3], pk);
    gld16<0>(r.v[0], pv); gld16<1024>(r.v[1], pv); gld16<2048>(r.v[2], pv); gld16<3072>(r.v[3], pv);
}
template <int N> DEVI void sel_wait8(Raw8& r) {
    asm volatile("s_waitcnt vmcnt(%8)" : "+v"(r.k[0]), "+v"(r.k[1]), "+v"(r.k[2]), "+v"(r.k[3]), "+v"(r.v[0]), "+v"(r.v[1]), "+v"(r.v[2]), "+v"(r.v[3]) : "n"(N) : "memory");
    __builtin_amdgcn_sched_barrier(0);
}
typedef float f32x2v __attribute__((ext_vector_type(2)));
typedef __bf16 bf16x2v __attribute__((ext_vector_type(2)));
DEVI bf16x8 fp8x8_bf16(unsigned w0, unsigned w1) {
    u32x4 o;
    o[0] = __builtin_bit_cast(unsigned, __builtin_amdgcn_cvt_scalef32_pk_bf16_fp8(w0, 1.0f, false)); o[1] = __builtin_bit_cast(unsigned, __builtin_amdgcn_cvt_scalef32_pk_bf16_fp8(w0, 1.0f, true));
    o[2] = __builtin_bit_cast(unsigned, __builtin_amdgcn_cvt_scalef32_pk_bf16_fp8(w1, 1.0f, false)); o[3] = __builtin_bit_cast(unsigned, __builtin_amdgcn_cvt_scalef32_pk_bf16_fp8(w1, 1.0f, true));
    return __builtin_bit_cast(bf16x8, o);
}
DEVI void sel_expand(const Raw8& r, KFr& f, VFr& g) {
#pragma unroll
    for (int i = 0; i < 4; ++i) { f.k[i][0] = fp8x8_bf16(r.k[i][0], r.k[i][1]); f.k[i][1] = fp8x8_bf16(r.k[i][2], r.k[i][3]); g.v[i][0] = fp8x8_bf16(r.v[i][0], r.v[i][1]); g.v[i][1] = fp8x8_bf16(r.v[i][2], r.v[i][3]); }
}
template <bool PASS2> DEVI void sel_block(const KFr& f, const VFr& fv, int j, bool active, int cur, LAS const unsigned* smask, LAS const unsigned char* Ql, LAS float* mrow, LAS int* lrow, LAS int* Os, float lg2k, float lratio, LAS int* tlist, int lane) {
    const int l15 = lane & 15, quad = lane >> 4, mem = l15 >> 2;
    const bool forced = (j == 0) || (j >= cur - 1);
    int cnt = 0;
    if (active) {
        if (forced) cnt = 64;
        else { const unsigned lo = (unsigned)__builtin_amdgcn_readfirstlane((int)smask[2 * j]), hi = (unsigned)__builtin_amdgcn_readfirstlane((int)smask[2 * j + 1]);
            const unsigned long long mk = ((unsigned long long)hi << 32) | lo;
            cnt = __builtin_popcountll(mk);
            const bool mine = (mk >> lane) & 1ull; const int rank = __builtin_popcountll(mk & ((1ull << lane) - 1ull));
            if (mine) tlist[rank] = lane;
            LDS_WAIT(); }
    }
    const int ngroups = (cnt + 3) >> 2;
    const bool diag = (j == cur);
#pragma unroll 1
    for (int gi = 0; gi < ngroups; ++gi) {
        const int slot = 4 * gi + mem;
        const bool valid = slot < cnt;
        int mt = forced ? slot : tlist[slot];
        mt = valid ? mt : 0;
        const int row = mt * 4 + (l15 & 3);
        const bf16x8 q0 = *(LAS const bf16x8*)(Ql + row * 128 + (((2 * quad) ^ (row & 7)) << 4));
        const bf16x8 q1 = *(LAS const bf16x8*)(Ql + row * 128 + (((2 * quad + 1) ^ (row & 7)) << 4));
        f32x4 sc[4];
        const float mc = PASS2 ? lg2k - mrow[row] : 0.f;
#pragma unroll
        for (int kg = 0; kg < 4; ++kg) { f32x4 z = {mc, mc, mc, mc}; z = __builtin_amdgcn_mfma_f32_16x16x32_bf16(f.k[kg][0], q0, z, 0, 0, 0); sc[kg] = __builtin_amdgcn_mfma_f32_16x16x32_bf16(f.k[kg][1], q1, z, 0, 0, 0); }
        if (!PASS2) {
            float mx;
            if (diag) mx = mask_max(sc, 0, mt, quad);
            else { float a = fmaxf(fmaxf(sc[0][0], sc[0][1]), fmaxf(sc[0][2], sc[0][3])), b = fmaxf(fmaxf(sc[1][0], sc[1][1]), fmaxf(sc[1][2], sc[1][3]));
                   a = fmaxf(a, fmaxf(fmaxf(sc[2][0], sc[2][1]), fmaxf(sc[2][2], sc[2][3]))); b = fmaxf(b, fmaxf(fmaxf(sc[3][0], sc[3][1]), fmaxf(sc[3][2], sc[3][3]))); mx = max_quads(fmaxf(a, b)); }
            if (quad == 0 && valid) __hip_atomic_fetch_max(mrow + row, mx, __ATOMIC_RELAXED, __HIP_MEMORY_SCOPE_WORKGROUP);
        } else {
            f32x2p p2 = {0.f, 0.f};
            if (diag) { const int hiq = mt - 4 * quad;
#pragma unroll
                for (int kg = 0; kg < 4; ++kg) {
#pragma unroll
                    for (int i = 0; i < 4; ++i) sc[kg][i] = (16 * kg + i <= hiq) ? __builtin_amdgcn_exp2f(sc[kg][i]) : 0.f;
                    p2 += (f32x2p){sc[kg][0], sc[kg][1]}; p2 += (f32x2p){sc[kg][2], sc[kg][3]}; }
            } else {
#pragma unroll
                for (int kg = 0; kg < 4; ++kg) {
#pragma unroll
                    for (int i = 0; i < 4; ++i) sc[kg][i] = __builtin_amdgcn_exp2f(sc[kg][i]);
                    p2 += (f32x2p){sc[kg][0], sc[kg][1]}; p2 += (f32x2p){sc[kg][2], sc[kg][3]}; }
            }
            const float ps = sum_quads(p2[0] + p2[1]);
            if (quad == 0 && valid) __hip_atomic_fetch_add(lrow + row, (int)(ps * lratio), __ATOMIC_RELAXED, __HIP_MEMORY_SCOPE_WORKGROUP);
            bf16x8 pb[2]; pb[0] = pack_p(sc[0], sc[1]); pb[1] = pack_p(sc[2], sc[3]);
            LAS int* orow = Os + row * OS_LD + 4 * quad;
#pragma unroll
            for (int dh = 0; dh < 2; ++dh) {
                f32x4 o[2];
#pragma unroll
                for (int d2 = 0; d2 < 2; ++d2) { const int dg = dh * 2 + d2; f32x4 z = {0.f, 0.f, 0.f, 0.f}; z = __builtin_amdgcn_mfma_f32_16x16x32_bf16(fv.v[dg][0], pb[0], z, 0, 0, 0); o[d2] = __builtin_amdgcn_mfma_f32_16x16x32_bf16(fv.v[dg][1], pb[1], z, 0, 0, 0); }
                if (valid) {
#pragma unroll
                    for (int d2 = 0; d2 < 2; ++d2)
#pragma unroll
                        for (int c = 0; c < 4; ++c) __hip_atomic_fetch_add(orow + 16 * (dh * 2 + d2) + c, (int)o[d2][c], __ATOMIC_RELAXED, __HIP_MEMORY_SCOPE_WORKGROUP);
                }
                __builtin_amdgcn_sched_barrier(0);
            }
        }
    }
}
#define BL(i) __builtin_amdgcn_readfirstlane(blist[(i) < nb ? (i) : nb - 1])
DEVI void sel_pass2(const unsigned char* K8, const unsigned char* V8, int nb, int cur, int wave, LAS const int* blist, LAS const unsigned* smask, LAS const unsigned char* Ql, LAS float* mrow, LAS int* lrow, LAS int* Os, float lg2k, float lratio, LAS int* tlist, int lane) {
    if (wave >= nb) return;
    Raw8 ra, rb; KFr kf; VFr vf;
    asm volatile("s_waitcnt vmcnt(0)" ::: "memory");
    sel_load8(ra, K8, V8, BL(wave), lane);
#pragma unroll 1
    for (int bi = wave; bi < nb; bi += 16) {
        sel_load8(rb, K8, V8, BL(bi + 8), lane); sel_wait8<8>(ra);
        sel_expand(ra, kf, vf);
        sel_block<true>(kf, vf, BL(bi), true, cur, smask, Ql, mrow, lrow, Os, lg2k, lratio, tlist, lane);
        sel_load8(ra, K8, V8, BL(bi + 16), lane); sel_wait8<8>(rb);
        sel_expand(rb, kf, vf);
        sel_block<true>(kf, vf, BL(bi + 8), bi + 8 < nb, cur, smask, Ql, mrow, lrow, Os, lg2k, lratio, tlist, lane);
    }
    asm volatile("s_waitcnt vmcnt(0)" ::: "memory");
}
#undef BL
}


DEVI void phase_vs_transpose(Frame& F, int l) {
    F.refresh();
    unsigned char* ws = F.ws;
    const bf16_t* VS = (const bf16_t*)(ws + RA_VS); unsigned char* VT = ws + RA_VST; unsigned char* K8 = ws + RA_K8; const bf16_t* KSG = (const bf16_t*)(ws + RA_KS);
    LAS unsigned char* T = F.lds + F.wave * 9216;
    const int lane = F.lane, rr = lane >> 3, c = lane & 7, i16 = lane & 15, grp = lane >> 4;
    for (int it = ((int)blockIdx.x - 64) * NWAVES + F.wave; it < 2048; it += 192 * NWAVES) {
        const int bg = it >> 8, tile = it & 255;
        const bf16_t* vsrc = VS + ((size_t)bg * SEQ + tile * 64) * 64; const bf16_t* ksrc = KSG + ((size_t)bg * SEQ + tile * 64) * 64;
        const bf16_t* wsrc = (const bf16_t*)(ws + RA_KW) + ((size_t)bg * SEQ + tile * 64) * 64;
        unsigned char* kdst = K8 + ((size_t)bg * SEQ + tile * 64) * 64;
        u32x4 v[8], k[8], kw[8];
#pragma unroll
        for (int i = 0; i < 8; ++i) { v[i] = *(const u32x4*)(vsrc + (size_t)(8 * i + rr) * 64 + c * 8); k[i] = *(const u32x4*)(ksrc + (size_t)(8 * i + rr) * 64 + c * 8); kw[i] = *(const u32x4*)(wsrc + (size_t)(8 * i + rr) * 64 + c * 8); }
        float vmx = 0.f, kmx = 0.f, wmx = 0.f;
#pragma unroll
        for (int i = 0; i < 8; ++i) { float n2 = 0.f, w2 = 0.f;
            u32x2 k8; k8[0] = pack_fp8x4(bflo(k[i][0]), bfhi(k[i][0]), bflo(k[i][1]), bfhi(k[i][1])); k8[1] = pack_fp8x4(bflo(k[i][2]), bfhi(k[i][2]), bflo(k[i][3]), bfhi(k[i][3]));
            *(u32x2*)(kdst + (size_t)(8 * i + rr) * 64 + c * 8) = k8;
#pragma unroll
            for (int e = 0; e < 2; ++e) { const fa::f32x2v a = __builtin_amdgcn_cvt_pk_f32_fp8((int)k8[e], false), b2 = __builtin_amdgcn_cvt_pk_f32_fp8((int)k8[e], true); n2 += a[0] * a[0] + a[1] * a[1] + b2[0] * b2[0] + b2[1] * b2[1]; }
#pragma unroll
            for (int e = 0; e < 4; ++e) { const float a3 = bflo(kw[i][e]), b3 = bfhi(kw[i][e]); w2 += a3 * a3 + b3 * b3; }
            n2 += fa::dppf<DPP_X1>(n2); n2 += fa::dppf<DPP_X2>(n2); n2 += fa::dppf<DPP_HM>(n2);
            w2 += fa::dppf<DPP_X1>(w2); w2 += fa::dppf<DPP_X2>(w2); w2 += fa::dppf<DPP_HM>(w2);
            kmx = fmaxf(kmx, n2); wmx = fmaxf(wmx, w2);
            *(LAS u32x4*)(T + (8 * i + rr) * 144 + c * 16) = v[i]; }
        LDS_WAIT(); asm volatile("" ::: "memory");
        unsigned char* vdst = VT + ((size_t)bg * 256 + tile) * 4096;
#pragma unroll
        for (int dc = 0; dc < 4; ++dc) { u32x4 o;
#pragma unroll
            for (int n = 0; n < 4; ++n) { const int kg4 = n * 4 + grp;
                const fa::v4i16_t t = __builtin_amdgcn_ds_read_tr16_b64_v4i16((LAS fa::v4i16_t*)(T + (4 * kg4 + (i16 >> 2)) * 144 + (16 * dc + 4 * (i16 & 3)) * 2));
                const u32x2 tw = __builtin_bit_cast(u32x2, t);
                o[n] = pack_fp8x4(bflo(tw[0]), bfhi(tw[0]), bflo(tw[1]), bfhi(tw[1]));
                const fa::f32x2v a = __builtin_amdgcn_cvt_pk_f32_fp8((int)o[n], false), b2 = __builtin_amdgcn_cvt_pk_f32_fp8((int)o[n], true);
                vmx = fmaxf(vmx, fmaxf(fmaxf(fabsf(a[0]), fabsf(a[1])), fmaxf(fabsf(b2[0]), fabsf(b2[1])))); }
            *(u32x4*)(vdst + (16 * dc + i16) * 64 + 16 * grp) = o; }
        vmx = wave_max(vmx, lane); kmx = wave_max(kmx, lane); wmx = wave_max(wmx, lane);
        if (lane == 0) { atomicMax((unsigned*)(ws + WS_CTL) + CW_VMAX + l * 8 + bg, __float_as_uint(vmx)); atomicMax((unsigned*)(ws + WS_CTL) + CW_KMAX + l * 8 + bg, __float_as_uint(kmx));
            atomicMax((unsigned*)(ws + WS_CTL) + CW_KWMAX + l * 8 + bg, __float_as_uint(wmx)); }
        LDS_WAIT(); asm volatile("" ::: "memory");
    }
}

DEVI void phase_nsa_fast(Frame& F, int layer) {
    using namespace fa;
    F.refresh();
    unsigned char* ws = F.ws;
    const bf16_t* Q = (const bf16_t*)(ws + RA_Q); unsigned char* ATT8 = ws + RA_ATT;
    const float* GT = (const float*)(ws + RA_GATE); const float* CS = (const float*)(ws + WS_CS);
    const int wave = F.wave;
    LAS unsigned char* kvb = F.lds + L_KV;
    LAS float* imp = (LAS float*)(F.lds + L_IMP);
    LAS unsigned* smask = (LAS unsigned*)(F.lds + L_MASK);
    LAS int* blist = (LAS int*)(F.lds + L_LIST);
    float kcmax2;
    {   const int bg0 = F.vcu >> 5; const bf16_t* kc0 = (const bf16_t*)(ws + RA_KC) + (size_t)bg0 * 1024 * 64;
        float mx = 0.f;
        for (int i = F.tid; i < 1024 * 8; i += NWAVES * 64) { const u32x4 w = *(const u32x4*)(kc0 + (size_t)i * 8); float n2 = 0.f;
#pragma unroll
            for (int e = 0; e < 4; ++e) { const float a = bflo(w[e]), b2 = bfhi(w[e]); n2 += a * a + b2 * b2; }
            n2 += dppf<DPP_X1>(n2); n2 += dppf<DPP_X2>(n2); n2 += dppf<DPP_HM>(n2);
            mx = fmaxf(mx, n2); }
        mx = wave_max(mx, F.lane);
        LAS float* red = (LAS float*)(F.lds + L_END);
        if (F.lane == 0) red[wave] = mx;
        __syncthreads();
        kcmax2 = fmaxf(fmaxf(fmaxf(red[0], red[1]), fmaxf(red[2], red[3])), fmaxf(fmaxf(red[4], red[5]), fmaxf(red[6], red[7])));
        __syncthreads(); }
#pragma unroll 1
    for (int ui = 0; ui < 8; ++ui) {
        int lane = F.lane; asm volatile("" : "+v"(lane));
        const int tid = wave * 64 + lane, quad = lane >> 4, l15 = lane & 15;
        int tile = (F.vcu & 31) + 32 * (ui >> 1); if (ui & 1) tile = 255 - tile;
        const int bg = F.vcu >> 5, b = bg >> 2, g = bg & 3, cur = tile, t0 = tile * 64;
        const bf16_t* KC = (const bf16_t*)(ws + RA_KC) + (size_t)bg * 1024 * 64; const bf16_t* VC = (const bf16_t*)(ws + RA_VC) + (size_t)bg * 1024 * 64;
        const bf16_t* KS = (const bf16_t*)(ws + RA_KS) + (size_t)bg * SEQ * 64; const bf16_t* VS = (const bf16_t*)(ws + RA_VS) + (size_t)bg * SEQ * 64;
        const bf16_t* KW = (const bf16_t*)(ws + RA_KW) + (size_t)bg * SEQ * 64; const bf16_t* VW = (const bf16_t*)(ws + RA_VW) + (size_t)bg * SEQ * 64;
        smask[tid] = 0u;
        int tl[2], tok[2]; bf16x8 qf[2][2];
#pragma unroll
        for (int s = 0; s < 2; ++s) { tl[s] = 8 * wave + 4 * s + (l15 >> 2); tok[s] = b * SEQ + t0 + tl[s]; load_q(Q, (size_t)tok[s], g * 256 + (l15 & 3) * 64, quad, qf[s]); }
        float gate[2][3];
#pragma unroll
        for (int s = 0; s < 2; ++s)
#pragma unroll
            for (int br = 0; br < 3; ++br) gate[s][br] = GT[(size_t)tok[s] * 48 + br * 16 + g * 4 + (l15 & 3)];
        const float vmax = fmaxf(__uint_as_float(__hip_atomic_load((const unsigned*)(ws + WS_CTL) + CW_VMAX + layer * 8 + bg, __ATOMIC_RELAXED, __HIP_MEMORY_SCOPE_AGENT)), 1e-30f);
        bf16x8 qr[2][2];
#pragma unroll
        for (int s = 0; s < 2; ++s) { qr[s][0] = scale_frag(rope_frag(qf[s][0], CS + (size_t)tok[s] * 16, quad, lane), CEXP); qf[s][0] = scale_frag(qf[s][0], CEXP); qf[s][1] = scale_frag(qf[s][1], CEXP); qr[s][1] = qf[s][1]; }
        float qn2[2], qn2r[2];
#pragma unroll
        for (int s = 0; s < 2; ++s) { qn2[s] = sum_quads(frag_norm2(qf[s][0], qf[s][1])); qn2r[s] = sum_quads(frag_norm2(qr[s][0], qr[s][1])); }
        const float kwmax2 = __uint_as_float(__hip_atomic_load((const unsigned*)(ws + WS_CTL) + CW_KWMAX + layer * 8 + bg, __ATOMIC_RELAXED, __HIP_MEMORY_SCOPE_AGENT));
        f32x4 out[2][4];
#pragma unroll
        for (int s = 0; s < 2; ++s)
#pragma unroll
            for (int dg = 0; dg < 4; ++dg) out[s][dg] = (f32x4){0.f, 0.f, 0.f, 0.f};
        Stage st;
        const int ntile = (4 * cur + 3 + 63) >> 6;
        int nval[2];
#pragma unroll
        for (int s = 0; s < 2; ++s) { const int t = t0 + tl[s]; nval[s] = t >= 31 ? ((t - 31) >> 4) + 1 : 0; }
        float l[2] = {0.f, 0.f};
        const float mcc[2] = {-sqrtf(qn2[0] * kcmax2) * 1.0001f, -sqrtf(qn2[1] * kcmax2) * 1.0001f};
        {   stage_load<false>(st, KC, VC, tid); stage_write<false>(st, kvb, tid); __syncthreads();
#pragma unroll 1
            for (int i = 0; i < ntile; ++i) {
                LAS unsigned char* buf = kvb + (i & 1) * KVB;
                if (i + 1 < ntile) stage_load<false>(st, KC + (size_t)(i + 1) * 4096, VC, tid); else stage_load<true>(st, KC, VC, tid);
#pragma unroll
                for (int s = 0; s < 2; ++s) { f32x4 dummy[4]; fixed_step<false>(buf, qf[s][0], qf[s][1], 0, nval[s] - 64 * i - 1, mcc[s], l[s], dummy, lane); }
                if (i + 1 < ntile) stage_write<false>(st, kvb + ((i + 1) & 1) * KVB, tid);
                __syncthreads();
            }
        }
        float invl[2], msafe[2];
#pragma unroll
        for (int s = 0; s < 2; ++s) { const float lt = sum_quads(l[s]); invl[s] = lt > 0.f ? 1.f / lt : 0.f; msafe[s] = 0.f; }
        const int jbw0 = cur >= 8 ? cur - 8 : 0;
        {   float gcv[2] = {gate[0][0], gate[1][0]};
            float carry[2] = {0.f, 0.f};
            stage_write<true>(st, kvb, tid); __syncthreads();
#pragma unroll 1
            for (int i = 0; i < ntile; ++i) {
                LAS unsigned char* buf = kvb + (i & 1) * KVB;
                if (i + 1 < ntile) stage_load<true>(st, KC + (size_t)(i + 1) * 4096, VC + (size_t)(i + 1) * 4096, tid); else stage_load<true>(st, KW + (size_t)jbw0 * 4096, VW + (size_t)jbw0 * 4096, tid);
#pragma unroll
                for (int s = 0; s < 2; ++s) {
                    __builtin_amdgcn_sched_barrier(0);
                    f32x4 sc[4]; qk_slot(buf, qf[s][0], qf[s][1], lane, sc, mcc[s]);
                    __builtin_amdgcn_sched_barrier(0);
                    const int hiq = nval[s] - 64 * i - 1 - 4 * quad;
#pragma unroll
                    for (int kg = 0; kg < 4; ++kg)
#pragma unroll
                        for (int k = 0; k < 4; ++k) sc[kg][k] = (16 * kg + k <= hiq) ? __builtin_amdgcn_exp2f(sc[kg][k]) * invl[s] : 0.f;
                    bf16x8 pb[2]; pb[0] = pack_p(sc[0] * gcv[s], sc[1] * gcv[s]); pb[1] = pack_p(sc[2] * gcv[s], sc[3] * gcv[s]);
#pragma unroll
                    for (int kg = 0; kg < 4; ++kg) {
                        float a = (sc[kg][0] + sc[kg][1]) + (sc[kg][2] + 0.5f * sc[kg][3]), bq = 0.5f * sc[kg][3];
                        a += dppf<DPP_X1>(a); a += dppf<DPP_X2>(a); bq += dppf<DPP_X1>(bq); bq += dppf<DPP_X2>(bq);
                        const float fromprev = bperm(bq, (lane - 16) & 63);
                        const float add = quad == 0 ? carry[s] : fromprev;
                        carry[s] = bperm(bq, (lane + 48) & 63);
                        if ((l15 & 3) == 0) imp[(8 * wave + 4 * s + (l15 >> 2)) * IMP_LD + 16 * i + 4 * kg + quad] = a + add;
                    }
                    __builtin_amdgcn_sched_barrier(0);
                    pv_slot(buf + 8192, pb, out[s], lane);
                    __builtin_amdgcn_sched_barrier(0);
                }
                if (i + 1 < ntile) stage_write<true>(st, kvb + ((i + 1) & 1) * KVB, tid);
                __syncthreads();
            }
        }
        {   const int tl8 = lane >> 3, chunk = lane & 7, trow = (8 * wave + tl8) * IMP_LD;
            const int ncand = cur - 2;
            const int wsel = ((8 * wave + tl8) >> 5), bsel = (8 * wave + tl8) & 31;
            if (ncand > 0 && ncand <= 13) {
#pragma unroll
                for (int i = 0; i < 2; ++i) { const int j = 8 * i + chunk; if (j >= 1 && j <= cur - 2) __hip_atomic_fetch_or(smask + j * 2 + wsel, 1u << bsel, __ATOMIC_RELAXED, __HIP_MEMORY_SCOPE_WORKGROUP); }
            } else if (ncand > 13) {
                unsigned lv[13];
#pragma unroll
                for (int k = 0; k < 13; ++k) lv[k] = 0u;
                const int imax = (cur - 2) >> 3;
#pragma unroll 1
                for (int i = 0; i <= imax; ++i) {
                    const int j = 8 * i + chunk;
                    unsigned x = (j >= 1 && j <= cur - 2) ? ((__float_as_uint(imp[trow + j]) & 0xFFFFFF00u) | (unsigned)(255 - j)) : 0u;
                    if (__builtin_amdgcn_ballot_w64(x > lv[12]) != 0ull) {
#pragma unroll
                        for (int k = 0; k < 13; ++k) { const unsigned hi_ = lv[k] > x ? lv[k] : x, lo_ = lv[k] > x ? x : lv[k]; lv[k] = hi_; x = lo_; }
                    }
                }
#pragma unroll 1
                for (int r = 0; r < 13; ++r) {
                    unsigned bv = lv[0];
                    { const unsigned ov = (unsigned)dppi<DPP_X1>((int)bv); bv = ov > bv ? ov : bv; }
                    { const unsigned ov = (unsigned)dppi<DPP_X2>((int)bv); bv = ov > bv ? ov : bv; }
                    { const unsigned ov = (unsigned)dppi<DPP_HM>((int)bv); bv = ov > bv ? ov : bv; }
                    if (lv[0] == bv && bv != 0u) {
#pragma unroll
                        for (int k = 0; k < 12; ++k) lv[k] = lv[k + 1];
                        lv[12] = 0u;
                    }
                    if (chunk == 0 && bv != 0u) __hip_atomic_fetch_or(smask + (255 - (int)(bv & 0xFFu)) * 2 + wsel, 1u << bsel, __ATOMIC_RELAXED, __HIP_MEMORY_SCOPE_WORKGROUP);
                }
            }
        }
        __syncthreads();
        if (wave == 0) {
            int base = 0;
#pragma unroll 1
            for (int r = 0; r < 4; ++r) { const int j = 64 * r + lane; const bool on = (j <= cur) && (j == 0 || j >= cur - 1 || (smask[j * 2] | smask[j * 2 + 1]) != 0u);
                const unsigned long long bal = __builtin_amdgcn_ballot_w64(on); const int pos = base + __builtin_popcountll(bal & ((1ull << lane) - 1ull));
                if (on) blist[pos] = j; base += __builtin_popcountll(bal); }
            if (lane == 0) blist[259] = base;
        }
        __syncthreads();
        LAS float* stashf = imp + wave * 2048 + lane;
#pragma unroll
        for (int s = 0; s < 2; ++s)
#pragma unroll
            for (int dg = 0; dg < 4; ++dg)
#pragma unroll
                for (int c = 0; c < 4; ++c) stashf[(s * 16 + dg * 4 + c) * 64] = out[s][dg][c];
        {   const int jb0 = jbw0, nb = cur - jb0 + 1;
            f32x4 ob[2][4]; float ll[2] = {0.f, 0.f};
            const float mcw[2] = {-sqrtf(qn2r[0] * kwmax2) * 1.0001f, -sqrtf(qn2r[1] * kwmax2) * 1.0001f};
#pragma unroll
            for (int s = 0; s < 2; ++s)
#pragma unroll
                for (int dg = 0; dg < 4; ++dg) ob[s][dg] = (f32x4){0.f, 0.f, 0.f, 0.f};
            stage_write<true>(st, kvb, tid); __syncthreads();
#pragma unroll 1
            for (int i = 0; i < nb; ++i) {
                LAS unsigned char* buf = kvb + (i & 1) * KVB;
                const int j = jb0 + i;
                if (i + 1 < nb) stage_load<true>(st, KW + (size_t)(j + 1) * 4096, VW + (size_t)(j + 1) * 4096, tid);
#pragma unroll
                for (int s = 0; s < 2; ++s) {
                    const int lo = (j == cur - 8) ? tl[s] + 1 : 0, hi = (j == cur) ? tl[s] : 63;
                    fixed_step<true>(buf, qr[s][0], qr[s][1], lo, hi, mcw[s], ll[s], ob[s], lane);
                }
                if (i + 1 < nb) stage_write<true>(st, kvb + ((i + 1) & 1) * KVB, tid);
                __syncthreads();
            }
#pragma unroll
            for (int s = 0; s < 2; ++s) { const float lt = sum_quads(ll[s]); const float gw = gate[s][2] * (lt > 0.f ? 1.f / lt : 0.f);
#pragma unroll
                for (int dg = 0; dg < 4; ++dg)
#pragma unroll
                    for (int c = 0; c < 4; ++c) out[s][dg][c] = stashf[(s * 16 + dg * 4 + c) * 64] + ob[s][dg][c] * gw; }
        }
        LAS unsigned* stashb = (LAS unsigned*)(F.lds + L_KV) + wave * 1024 + lane;
        LAS unsigned char* Ql = F.lds + L_Q;
        LAS float* mrow = (LAS float*)(F.lds + L_ML); LAS int* lrow = (LAS int*)(mrow + 256);
        LAS int* Os = (LAS int*)imp;
        const float oscale = 1048576.f / vmax;
#pragma unroll
        for (int s = 0; s < 2; ++s) {
#pragma unroll
            for (int dg = 0; dg < 4; ++dg) { stashb[((s * 4 + dg) * 2 + 0) * 64] = pg8::cvt_pk_bf16(out[s][dg][0], out[s][dg][1]); stashb[((s * 4 + dg) * 2 + 1) * 64] = pg8::cvt_pk_bf16(out[s][dg][2], out[s][dg][3]); }
            const int row = tl[s] * 4 + (l15 & 3);
            *(LAS bf16x8*)(Ql + row * 128 + ((quad ^ (row & 7)) << 4)) = qr[s][0];
            *(LAS bf16x8*)(Ql + row * 128 + (((4 + quad) ^ (row & 7)) << 4)) = qr[s][1];
        }
        __syncthreads();
        for (int i = lane; i < 32 * OS_LD; i += 64) Os[wave * 32 * OS_LD + i] = 0;
        if (lane < 32) lrow[wave * 32 + lane] = 0;
        {
            const float kmax2 = __uint_as_float(__hip_atomic_load((const unsigned*)(ws + WS_CTL) + CW_KMAX + layer * 8 + bg, __ATOMIC_RELAXED, __HIP_MEMORY_SCOPE_AGENT));
#pragma unroll
            for (int s = 0; s < 2; ++s) if (quad == 0) mrow[tl[s] * 4 + (l15 & 3)] = sqrtf(qn2r[s] * kmax2) * 1.0001f; }
        __syncthreads();
        {   const int nb = blist[259];
            int lane2 = lane; asm volatile("" : "+v"(lane2));
            const unsigned char* VT = ws + RA_VST + (size_t)bg * 256 * 4096; const unsigned char* K8 = ws + RA_K8 + (size_t)bg * SEQ * 64;
            LAS int* tlist = (LAS int*)(F.lds + L_TOK) + wave * 64;
            asm volatile("" : "+v"(lane2));
            sel_pass2(K8, VT, nb, cur, wave, blist, smask, Ql, mrow, lrow, Os, __builtin_amdgcn_logf(oscale), LSCALE / oscale, tlist, lane2);
            __syncthreads();
        }
        asm volatile("" : "+v"(tok[0]), "+v"(tok[1]), "+v"(tl[0]), "+v"(tl[1]));
        const float oinv = vmax * (1.f / 1048576.f);
#pragma unroll
        for (int s = 0; s < 2; ++s) { const int row = tl[s] * 4 + (l15 & 3); const float lt = (float)lrow[row] * (1.f / LSCALE);
            const float gs = gate[s][1] * (lt > 0.f ? 1.f / lt : 0.f) * oinv;
#pragma unroll
            for (int dg = 0; dg < 4; ++dg) { const unsigned w0 = stashb[((s * 4 + dg) * 2 + 0) * 64], w1 = stashb[((s * 4 + dg) * 2 + 1) * 64];
                LAS const int* orow = Os + row * OS_LD + 16 * dg + 4 * quad;
                const float r0 = bflo(w0) + (float)orow[0] * gs, r1 = bfhi(w0) + (float)orow[1] * gs, r2 = bflo(w1) + (float)orow[2] * gs, r3 = bfhi(w1) + (float)orow[3] * gs;
                *(unsigned*)(ATT8 + (size_t)tok[s] * DM + g * 256 + (l15 & 3) * 64 + 16 * dg + 4 * quad) = pack_fp8x4(r0, r1, r2, r3); } }
        __syncthreads();
    }
}

DEVI void phase_swa_fast(Frame& F, const float* sinks) {
    using namespace fa;
    F.refresh();
    unsigned char* ws = F.ws;
    const bf16_t* Q = (const bf16_t*)(ws + RA_Q); unsigned char* ATT8 = ws + RA_ATT;
    const int tid = F.tid, lane = F.lane, wave = F.wave, quad = lane >> 4, l15 = lane & 15;
    LAS unsigned char* kvb = F.lds + L_KV;
#pragma unroll 1
    for (int ui = 0; ui < 8; ++ui) {
        const int bg = ui >> 1, b = bg >> 1, g = bg & 1, t0 = (F.vcu * 2 + (ui & 1)) * 32, cur = t0 >> 6;
        const bf16_t* KS = (const bf16_t*)(ws + WS_KSH) + (size_t)bg * SEQ * 64; const bf16_t* VS = (const bf16_t*)(ws + WS_VSH) + (size_t)bg * SEQ * 64;
        int tq[2]; size_t tok[2]; bf16x8 qf[2][2]; f32x4 o[2][4]; float mm[2], ll[2];
        const float sink_raw = sinks[g * 8 + (l15 & 7)] * 8.0f;
#pragma unroll
        for (int s = 0; s < 2; ++s) { tq[s] = t0 + 4 * wave + 2 * s + (l15 >> 3); tok[s] = (size_t)b * SEQ + tq[s]; load_q(Q, tok[s], g * 512 + (l15 & 7) * 64, quad, qf[s]);
            mm[s] = sink_raw; ll[s] = quad == 0 ? 1.f : 0.f;
#pragma unroll
            for (int dg = 0; dg < 4; ++dg) o[s][dg] = (f32x4){0.f, 0.f, 0.f, 0.f}; }
        const int jb0 = cur >= 2 ? cur - 2 : 0, nb = cur - jb0 + 1;
        Stage st; stage_load<true>(st, KS + (size_t)jb0 * 4096, VS + (size_t)jb0 * 4096, tid); stage_write<true>(st, kvb, tid); __syncthreads();
#pragma unroll 1
        for (int i = 0; i < nb; ++i) {
            LAS unsigned char* buf = kvb + (i & 1) * KVB;
            const int j = jb0 + i;
            if (i + 1 < nb) stage_load<true>(st, KS + (size_t)(j + 1) * 4096, VS + (size_t)(j + 1) * 4096, tid);
#pragma unroll
            for (int s = 0; s < 2; ++s) online_step<true>(buf, qf[s][0], qf[s][1], tq[s] - (SWA_WIN - 1) - 64 * j, tq[s] - 64 * j, mm[s], ll[s], o[s], lane);
            if (i + 1 < nb) stage_write<true>(st, kvb + ((i + 1) & 1) * KVB, tid);
            __syncthreads();
        }
#pragma unroll
        for (int s = 0; s < 2; ++s) { const float inv = 1.f / sum_quads(ll[s]);
#pragma unroll
            for (int dg = 0; dg < 4; ++dg)
                *(unsigned*)(ATT8 + tok[s] * DM + g * 512 + (l15 & 7) * 64 + 16 * dg + 4 * quad) = pack_fp8x4(o[s][dg][0] * inv, o[s][dg][1] * inv, o[s][dg][2] * inv, o[s][dg][3] * inv); }
    }
}

enum Kind { K_PRO = 0, K_NSA_IN, K_CMP_HID, K_CMP_OUT, K_NSA_ATT, K_SWA_IN, K_SWA_ATT, K_OUTPROJ, K_LN1, K_LN1R, K_FFN1, K_FFN2, K_LN2, K_SCATTER, K_MOE1, K_MOE2, K_LN2C, K_COUNT };
struct Args { const void* in[18]; float* out; unsigned char* ws; int ph_lo, ph_hi; };
struct PhaseEnt { int kind, layer; };
constexpr int NPH = 35;
static const PhaseEnt h_prog[NPH] = {
    {K_PRO, 0},
    {K_NSA_IN, 0}, {K_CMP_HID, 0}, {K_CMP_OUT, 0}, {K_NSA_ATT, 0}, {K_OUTPROJ, 0}, {K_LN1, 0}, {K_FFN1, 0}, {K_FFN2, 0}, {K_LN2, 0},
    {K_NSA_IN, 1}, {K_CMP_HID, 1}, {K_CMP_OUT, 1}, {K_NSA_ATT, 1}, {K_OUTPROJ, 1}, {K_LN1R, 1}, {K_SCATTER, 1}, {K_MOE1, 1}, {K_MOE2, 1}, {K_LN2C, 1},
    {K_SWA_IN, 2}, {K_SWA_ATT, 2}, {K_OUTPROJ, 2}, {K_LN1, 2}, {K_FFN1, 2}, {K_FFN2, 2}, {K_LN2, 2},
    {K_SWA_IN, 3}, {K_SWA_ATT, 3}, {K_OUTPROJ, 3}, {K_LN1R, 3}, {K_SCATTER, 3}, {K_MOE1, 3}, {K_MOE2, 3}, {K_LN2C, 3},
};

template <int KIND> DEVI void do_phase(Frame& F, int l) {
    unsigned char* ws = F.ws;
    unsigned* ctl = (unsigned*)(ws + WS_CTL);
    LAS unsigned char* ring = F.lds;
    const int bx = (int)blockIdx.x;
    if constexpr (KIND == K_PRO) { phase_prologue(F); }
    if constexpr (KIND == K_NSA_IN) { pg8::Gemm g{(const bf16_t*)(ws + WS_HB8), DM / 2, DM / 2, DM / 2}; pg8::StaticOrder S; S.init(MTOK / 256, A_INP / 256, F.G, bx, (const bf16_t*)(ws + WS_WINA) + (size_t)l * A_INP * DM / 2);
        EpiNsaIn E{ws, (const float*)(ws + WS_CS)}; pg8::gemm_phase<EpiNsaIn, pg8::StaticOrder, true, F8_WIN_SH>(ring, g, S, E, F.wave0); }
    if constexpr (KIND == K_CMP_HID) {
        const int kv = (bx >> 5) & 1;
        if (bx < 64) { pg8::Gemm g{(const bf16_t*)(ws + (kv ? RA_VCR : RA_KCR)), 1024, 2048, 2048};
            pg8::StaticOrder S; S.init(32, 1, 32, bx & 31, (const bf16_t*)(ws + WS_WC1) + (size_t)(l * 2 + kv) * 256 * 2048);
            EpiCmpHid E{(bf16_t*)(ws + RA_CH) + (size_t)kv * 8192 * 256, (const float*)(ctl + CW_BIASP) + (l * 2 + kv) * 256};
            pg8::gemm_phase(ring, g, S, E, F.wave0); }
        else phase_vs_transpose(F, l); }
    if constexpr (KIND == K_CMP_OUT) { pg8::Gemm g{(const bf16_t*)(ws + RA_CH), 256, 256, 256}; pg8::DualOrder S; S.init(64, 1, F.G, bx, (const bf16_t*)(ws + WS_WC2) + (size_t)(l * 2) * 256 * 256); S.estride = (size_t)256 * 256;
        EpiCmpOut E{(bf16_t*)(ws + RA_KC), (bf16_t*)(ws + RA_VC)}; pg8::gemm_phase(ring, g, S, E, F.wave0); }
#if NAIVE_NSA
    if constexpr (KIND == K_NSA_ATT) { phase_nsa_naive(F); }
#else
    if constexpr (KIND == K_NSA_ATT) { phase_nsa_fast(F, l); }
#endif
    if constexpr (KIND == K_SWA_IN) { pg8::Gemm g{(const bf16_t*)(ws + WS_HB8), DM / 2, DM / 2, DM / 2}; pg8::StaticOrder S;
        if (l == 2) S.init(MTOK / 256, 5, F.G, bx, (const bf16_t*)(ws + WS_WQKV2)); else S.init(MTOK / 256, 4, F.G, bx, (const bf16_t*)(ws + WS_WQB1));
        EpiSwaIn E{ws, (const float*)(ws + WS_CS)}; pg8::gemm_phase<EpiSwaIn, pg8::StaticOrder, true, F8_WIN_SH>(ring, g, S, E, F.wave0); }
#if NAIVE_SWA
    if constexpr (KIND == K_SWA_ATT) { phase_swa_naive(F, (const float*)ARG_IN(10) + (l - 2) * 16); }
#else
    if constexpr (KIND == K_SWA_ATT) { phase_swa_fast(F, (const float*)ARG_IN(10) + (l - 2) * 16); }
#endif
    if constexpr (KIND == K_OUTPROJ) { pg8::Gemm g{(const bf16_t*)(ws + RA_ATT), DM / 2, DM / 2, DM / 2}; pg8::StaticOrder S;
        S.init(MTOK / 256, 4, F.G, bx, l < 2 ? (const bf16_t*)(ws + WS_WOUTA) + (size_t)l * DM * DM / 2 : (const bf16_t*)(ws + WS_WOUTB) + (size_t)(l - 2) * DM * DM / 2);
        EpiResid E{(const bf16_t*)(ws + WS_HB), (bf16_t*)(ws + WS_Y)}; pg8::gemm_phase<EpiResid, pg8::StaticOrder, true, F8_WIN_SH>(ring, g, S, E, F.wave0); }
    if constexpr (KIND == K_LN1) { phase_ln<0, false, false>(F, l * 2, nullptr, 0); }
    if constexpr (KIND == K_LN1R) { phase_ln<0, true, false>(F, l * 2, nullptr, l >> 1); }
    if constexpr (KIND == K_FFN1) { pg8::Gemm g{(const bf16_t*)(ws + WS_HB), DM, DM, DM}; pg8::StaticOrder S; S.init(MTOK / 256, 2 * DFF / 256, F.G, bx, (const bf16_t*)(ws + WS_WDIN) + (size_t)(l >> 1) * 2 * DFF * DM);
        EpiSwiglu E{(bf16_t*)(ws + WS_ACT), DFF}; pg8::gemm_phase(ring, g, S, E, F.wave0); }
    if constexpr (KIND == K_FFN2) { pg8::Gemm g{(const bf16_t*)(ws + WS_ACT), DFF, DFF, DFF}; pg8::StaticOrder S; S.init(MTOK / 256, 4, F.G, bx, (const bf16_t*)(ws + WS_WDOUT) + (size_t)(l >> 1) * DM * DFF);
        EpiResid E{(const bf16_t*)(ws + WS_HB), (bf16_t*)(ws + WS_Y)}; pg8::gemm_phase(ring, g, S, E, F.wave0); }
    if constexpr (KIND == K_LN2) { phase_ln<0, false, false>(F, l * 2 + 1, nullptr, 0); }
    if constexpr (KIND == K_SCATTER) { phase_moe_scatter(F, l >> 1); }
    if constexpr (KIND == K_MOE1) { const int ml = l >> 1; int ts[9]; moe_tiles((const unsigned*)ctl + CW_MOE + ml * 64, ts);
        pg8::Gemm g{(const bf16_t*)(ws + WS_XB), DM / 2, DM / 2, DM / 2}; pg8::GroupedOrder S; S.init(ts[8], 2 * DFFE / 256, F.G, bx, (const bf16_t*)(ws + WS_WMIN) + (size_t)ml * 8 * DFFE * DM);
        S.t1 = ts[1]; S.t2 = ts[2]; S.t3 = ts[3]; S.t4 = ts[4]; S.t5 = ts[5]; S.t6 = ts[6]; S.t7 = ts[7]; S.estride = (size_t)DFFE * DM;
        EpiSwiglu8 E{ws + WS_ACT, DFFE}; pg8::gemm_phase<EpiSwiglu8, pg8::GroupedOrder, true, F8_WIN_SH>(ring, g, S, E, F.wave0); }
    if constexpr (KIND == K_MOE2) { const int ml = l >> 1; int ts[9]; moe_tiles((const unsigned*)ctl + CW_MOE + ml * 64, ts);
        pg8::Gemm g{(const bf16_t*)(ws + WS_ACT), DFFE / 2, DFFE / 2, DFFE / 2}; pg8::GroupedOrder S; S.init(256, 4, F.G, bx, (const bf16_t*)(ws + WS_WMOUT) + (size_t)ml * 8 * DM * DFFE / 2);
        S.t1 = ts[1]; S.t2 = ts[2]; S.t3 = ts[3]; S.t4 = ts[4]; S.t5 = ts[5]; S.t6 = ts[6]; S.t7 = ts[7]; S.estride = (size_t)DM * DFFE / 2;
        EpiBf16Out E{(bf16_t*)(ws + WS_YB)}; pg8::gemm_phase<EpiBf16Out, pg8::GroupedOrder, true, F8_WOUT_SH>(ring, g, S, E, F.wave0);
        pg8::Gemm g4{(const bf16_t*)(ws + WS_ACT), DFFE / 2, DFFE / 4, DFFE / 2}; pg8::SliceOrder S4; S4.nsl = (ts[8] - 256) * 8; S4.G = F.G; S4.c = (bx + 128) & 255; S4.kq = DFFE / 4;
        S4.bt = (const bf16_t*)(ws + WS_WMOUT) + (size_t)ml * 8 * DM * DFFE / 2; S4.t1 = ts[1]; S4.t2 = ts[2]; S4.t3 = ts[3]; S4.t4 = ts[4]; S4.t5 = ts[5]; S4.t6 = ts[6]; S4.t7 = ts[7]; S4.estride = (size_t)DM * DFFE / 2;
        EpiPart E4{(float*)(ws + WS_H)}; pg8::gemm_phase<EpiPart, pg8::SliceOrder, true, F8_WOUT_SH>(ring, g4, S4, E4, F.wave0); }
    if constexpr (KIND == K_LN2C) { if (l == DEPTH - 1) phase_ln<1, false, true>(F, l * 2 + 1, ARG_OUT(), 0); else phase_ln<1, false, false>(F, l * 2 + 1, nullptr, 0); }
}

DEVI void frame_init(Frame& F, unsigned char* lds_raw) {
    F.lds = (LAS unsigned char*)lds_raw; F.ws = ARG_WS();
    F.wave0 = wave_id_sgpr(); F.tid = threadIdx.x; F.lane = F.tid & 63; F.wave = F.wave0;
    F.G = gridDim.x; { const int bx = blockIdx.x; F.vcu = (F.G % 8 == 0) ? (bx % 8) * (F.G / 8) + bx / 8 : bx; }
}

#if !MK_SINGLE
template <int KIND> __global__ void __launch_bounds__(NWAVES * 64, 2) phase_kernel(Args args) {
    extern __shared__ __attribute__((aligned(16))) unsigned char lds_raw[];
    Frame F; frame_init(F, lds_raw);
    do_phase<KIND>(F, args.ph_lo);
}
template <int KIND> static void launch_kind(const Args& a, hipStream_t stream) {
    static bool attr = false;
    if (!attr) { (void)hipFuncSetAttribute((const void*)phase_kernel<KIND>, hipFuncAttributeMaxDynamicSharedMemorySize, LDS_BYTES); attr = true; }
    hipLaunchKernelGGL(phase_kernel<KIND>, dim3(256), dim3(NWAVES * 64), LDS_BYTES, stream, a);
}
#else
__global__ void __launch_bounds__(NWAVES * 64, 2) yoco_fwd(Args args) {
    extern __shared__ __attribute__((aligned(16))) unsigned char lds_raw[];
    Frame F; frame_init(F, lds_raw);
    volatile LAS unsigned* MISC = (volatile LAS unsigned*)(F.lds + MISC_OFF);
    for (int u = F.tid; u < 256; u += NWAVES * 64) MISC[u] = 0u;
    __syncthreads();
    XcdBarrier bar = xcd_barrier_post((unsigned*)(F.ws + WS_CTL) + CW_BAR, MISC + 8);
#ifndef DUP_KIND
#define DUP_KIND -1
#endif
#define PH(K, L, FIRST) do { do_phase<K>(F, L); if (FIRST) cg::this_grid().sync(); else xcd_barrier(bar); if (K == DUP_KIND) { do_phase<K>(F, L); xcd_barrier(bar); } } while (0)
    PH(K_PRO, 0, true);
#define NSA_LAYER(l) PH(K_NSA_IN, l, false); PH(K_CMP_HID, l, false); PH(K_CMP_OUT, l, false); PH(K_NSA_ATT, l, false); PH(K_OUTPROJ, l, false)
#define SWA_LAYER(l) PH(K_SWA_IN, l, false); PH(K_SWA_ATT, l, false); PH(K_OUTPROJ, l, false)
#define DENSE_FFN(l) PH(K_LN1, l, false); PH(K_FFN1, l, false); PH(K_FFN2, l, false); PH(K_LN2, l, false)
#define MOE_FFN(l, LAST) PH(K_LN1R, l, false); PH(K_SCATTER, l, false); PH(K_MOE1, l, false); PH(K_MOE2, l, false); do_phase<K_LN2C>(F, l); if (!(LAST)) xcd_barrier(bar); else if (DUP_KIND == 16) { xcd_barrier(bar); do_phase<K_LN2C>(F, l); }
    NSA_LAYER(0); DENSE_FFN(0);
    NSA_LAYER(1); MOE_FFN(1, false);
    SWA_LAYER(2); DENSE_FFN(2);
    SWA_LAYER(3); MOE_FFN(3, true);
}
#endif

extern "C" void kernel_launch(void* const* d_in, const int* in_sizes, int n_in, void* d_out, int out_size, void* d_ws, size_t ws_size, hipStream_t stream) {
    static int grid = 0;
    if (grid == 0) {
        if (n_in != 18 || out_size != MTOK * DM || ws_size < WS_END) { fprintf(stderr, "kernel_launch: unexpected shapes (n_in %d out %d ws %zu need %zu)\n", n_in, out_size, ws_size, (size_t)WS_END); grid = -1; return; }
        int dev = 0, cus = 0;
        (void)hipGetDevice(&dev); (void)hipDeviceGetAttribute(&cus, hipDeviceAttributeMultiprocessorCount, dev);
        if (cus < 256) { fprintf(stderr, "kernel_launch: needs 256 CUs, device has %d\n", cus); grid = -1; return; }
#if MK_SINGLE
        int per_cu = 0;
        (void)hipFuncSetAttribute((const void*)yoco_fwd, hipFuncAttributeMaxDynamicSharedMemorySize, LDS_BYTES);
        (void)hipOccupancyMaxActiveBlocksPerMultiprocessor(&per_cu, (const void*)yoco_fwd, NWAVES * 64, LDS_BYTES);
        if (per_cu < 1) fprintf(stderr, "kernel_launch: occupancy query says %d blocks per CU\n", per_cu);
        (void)hipGetLastError();
#endif
        grid = 256;
    }
    if (grid < 0) return;
    (void)hipMemsetAsync((char*)d_ws + WS_CTL, 0, CTL_BYTES, stream);
    Args a{};
    for (int i = 0; i < 18; ++i) a.in[i] = d_in[i];
    a.out = (float*)d_out; a.ws = (unsigned char*)d_ws;
#if MK_SINGLE
    a.ph_lo = 0; a.ph_hi = NPH;
    void* kargs[] = {&a};
    hipError_t e = hipLaunchCooperativeKernel((const void*)yoco_fwd, dim3(grid), dim3(NWAVES * 64), kargs, LDS_BYTES, stream);
    if (e != hipSuccess) fprintf(stderr, "cooperative launch failed: %s (grid %d)\n", hipGetErrorString(e), grid);
#else
    for (int p = 0; p < NPH; ++p) {
        a.ph_lo = h_prog[p].layer; a.ph_hi = 0;
        switch (h_prog[p].kind) {
#define LK(K) case K: launch_kind<K>(a, stream); break;
            LK(K_PRO) LK(K_NSA_IN) LK(K_CMP_HID) LK(K_CMP_OUT) LK(K_NSA_ATT) LK(K_SWA_IN) LK(K_SWA_ATT) LK(K_OUTPROJ) LK(K_LN1) LK(K_LN1R) LK(K_FFN1) LK(K_FFN2) LK(K_LN2) LK(K_SCATTER) LK(K_MOE1) LK(K_MOE2) LK(K_LN2C)
#undef LK
            default: break;
        }
    }
#endif
}
```
